# Optimizing an MI355X kernel written in HIP

```python
import jax
import jax.numpy as jnp
from jax import lax
import numpy as np

D_MODEL = 1024
BATCH = 4
SEQ = 4096
DEPTH = 1

GRID_W = 64
CTX_LEN = 256
D_LRU = D_MODEL // 2
LRU_BLOCKS = 8
LRU_BLOCK = D_LRU // LRU_BLOCKS
CONV_W = 4
CONV_PAD_LEFT = 1
LRU_C = 8.0
D_RWKV = D_MODEL // 2
RWKV_HEAD = 64
RWKV_HEADS = D_RWKV // RWKV_HEAD
DECAY_LORA = 64
ICLR_LORA = 64
GATE_LORA = 128
RWKV_SPLITS = (D_RWKV, 2 * D_RWKV, 3 * D_RWKV, 3 * D_RWKV + 2 * DECAY_LORA, 3 * D_RWKV + 2 * DECAY_LORA + 2 * ICLR_LORA)
D_RWKV_IN = RWKV_SPLITS[-1] + GATE_LORA
D_IN = 2 * D_LRU + D_RWKV_IN
D_MIX = D_LRU + D_RWKV
N_EXPERTS = 16
EC_FACTOR = 2
D_EXPERT = 1408
ALPHA = (2.0 * DEPTH) ** 0.25
BETA = (8.0 * DEPTH) ** -0.25
LN_EPS = 1e-5
GN_EPS = 64e-5
RMS_EPS = 1e-6

kernel_name = 'hymba_rglru_rwkv7_ecmoe_dit'


def layer_norm(z, g, b):
    zf = z.astype(jnp.float32)
    mu = jnp.mean(zf, -1, keepdims=True)
    var = jnp.mean(jnp.square(zf - mu), -1, keepdims=True)
    return ((zf - mu) * lax.rsqrt(var + LN_EPS) * g + b).astype(z.dtype)


def rms_norm(z, g):
    zf = z.astype(jnp.float32)
    return zf * lax.rsqrt(jnp.mean(zf * zf, -1, keepdims=True) + RMS_EPS) * g


def to_col_major(z, rows):
    b, t, ch = z.shape
    return z.reshape(b, rows, GRID_W, ch).transpose(0, 2, 1, 3).reshape(b, t, ch)


def from_col_major(z, rows):
    b, t, ch = z.shape
    return z.reshape(b, GRID_W, rows, ch).transpose(0, 2, 1, 3).reshape(b, t, ch)


def centred_dwconv(z, w, bias):
    t = z.shape[1]
    zp = jnp.pad(z, ((0, 0), (CONV_PAD_LEFT, CONV_W - 1 - CONV_PAD_LEFT), (0, 0)))
    out = bias + zp[:, 0:t] * w[0]
    for j in range(1, CONV_W):
        out = out + zp[:, j:j + t] * w[j]
    return out


def centred_shift(z, mu_prev, mu_next):
    zp = jnp.pad(z, ((0, 0), (1, 1), (0, 0)))
    return z + mu_prev * (zp[:, :-2] - z) + mu_next * (zp[:, 2:] - z)


def block_diag_linear(z, w, bias):
    b, t, _ = z.shape
    zh = z.reshape(b, t, LRU_BLOCKS, LRU_BLOCK)
    return jnp.einsum('bthi,hij->bthj', zh, w).reshape(b, t, D_LRU) + bias


def rglru_coeffs(z, wa, ba, wx, bx, lam):
    zf = z.astype(jnp.float32)
    r = jax.nn.sigmoid(block_diag_linear(zf, wa, ba))
    i = jax.nn.sigmoid(block_diag_linear(zf, wx, bx))
    log_a = -LRU_C * r * jax.nn.softplus(-lam.astype(jnp.float32))
    return jnp.exp(log_a), jnp.sqrt(-jnp.expm1(2.0 * log_a)) * i * zf


def linear_scan(a, b, h0, reverse):
    def combine(e1, e2):
        a1, b1 = e1
        a2, b2 = e2
        return a1 * a2, a2 * b1 + b2
    a_cum, b_cum = lax.associative_scan(combine, (a, b), reverse=reverse, axis=1)
    return b_cum + a_cum * h0[:, None, :]


def rglru_mixer(x_lat, x_ctx, need_ctx, conv_w, conv_b, wa, ba, wx, bx, lam):
    xl = centred_dwconv(x_lat, conv_w, conv_b)
    xc = centred_dwconv(x_ctx, conv_w, conv_b)
    y_lat = 0.0
    y_ctx = 0.0
    for d, rev in enumerate((False, True)):
        a_c, b_c = rglru_coeffs(xc, wa[d], ba[d], wx[d], bx[d], lam[d])
        h_c = linear_scan(a_c, b_c, jnp.zeros_like(b_c[:, 0]), rev)
        h0 = h_c[:, 0] if rev else h_c[:, -1]
        a_l, b_l = rglru_coeffs(xl, wa[d], ba[d], wx[d], bx[d], lam[d])
        y_lat = y_lat + linear_scan(a_l, b_l, h0, rev)
        if need_ctx:
            y_ctx = y_ctx + h_c
    return y_lat, (y_ctx if need_ctx else None)


def rwkv_prep(p, w0, w2, a0, a2, g2, k_k, k_a):
    pf = p.astype(jnp.float32)
    b, t, _ = pf.shape
    r, k, v, wlo, alo, glo = jnp.split(pf, RWKV_SPLITS, axis=-1)
    heads = lambda z: z.reshape(b, t, RWKV_HEADS, RWKV_HEAD)
    wlo = wlo.reshape(b, t, 2, DECAY_LORA)
    alo = alo.reshape(b, t, 2, ICLR_LORA)
    kk = heads(k * k_k)
    kk = kk / jnp.maximum(jnp.sqrt(jnp.sum(kk * kk, -1, keepdims=True)), 1e-12)
    decays, keys, removal = [], [], []
    for d in range(2):
        w_log = -jax.nn.softplus(-(w0[d] + jnp.tanh(wlo[:, :, d]) @ w2[d])) - 0.5
        iclr = jax.nn.sigmoid(a0[d] + alo[:, :, d] @ a2[d])
        decays.append(heads(jnp.exp(-jnp.exp(w_log))))
        keys.append(heads(k * (1.0 + (iclr - 1.0) * k_a)))
        removal.append(kk * heads(iclr))
    g = jax.nn.sigmoid(glo) @ g2
    return heads(r), heads(v), kk, decays, keys, removal, g


def rwkv_scan(r, w, k, v, kk, b_rm, s0, reverse):
    def step(s, inp):
        r_t, w_t, k_t, v_t, kk_t, b_t = inp
        sa = jnp.einsum('bhij,bhj->bhi', s, kk_t)
        s = s * w_t[:, :, None, :] - sa[..., None] * b_t[:, :, None, :] + v_t[..., None] * k_t[:, :, None, :]
        return s, jnp.einsum('bhij,bhj->bhi', s, r_t)
    xs = tuple(jnp.moveaxis(z, 1, 0) for z in (r, w, k, v, kk, b_rm))
    s_fin, y = lax.scan(step, s0, xs, reverse=reverse)
    return jnp.moveaxis(y, 0, 1), s_fin


def rwkv_readout(y, prep, r_k, gn_g, gn_b):
    r, v, _, _, keys, _, g = prep
    b, t = y.shape[:2]
    mu = jnp.mean(y, -1, keepdims=True)
    var = jnp.mean(jnp.square(y - mu), -1, keepdims=True)
    yn = (y - mu) * lax.rsqrt(var + GN_EPS) * gn_g.reshape(RWKV_HEADS, RWKV_HEAD) + gn_b.reshape(RWKV_HEADS, RWKV_HEAD)
    bonus = jnp.sum(r * (keys[0] + keys[1]) * r_k, -1, keepdims=True) * v
    return (yn + bonus).reshape(b, t, D_RWKV) * g


def rwkv_mixer(p_lat, p_ctx, need_ctx, mu_prev, mu_next, w0, w2, a0, a2, g2, k_k, k_a, r_k, gn_g, gn_b):
    lat = rwkv_prep(centred_shift(p_lat, mu_prev, mu_next), w0, w2, a0, a2, g2, k_k, k_a)
    ctx = rwkv_prep(centred_shift(p_ctx, mu_prev, mu_next), w0, w2, a0, a2, g2, k_k, k_a)
    b = p_lat.shape[0]
    y_lat = 0.0
    y_ctx = 0.0
    for d, rev in enumerate((False, True)):
        s0 = jnp.zeros((b, RWKV_HEADS, RWKV_HEAD, RWKV_HEAD), jnp.float32)
        yc, s_ctx = rwkv_scan(ctx[0], ctx[3][d], ctx[4][d], ctx[1], ctx[2], ctx[5][d], s0, rev)
        yl, _ = rwkv_scan(lat[0], lat[3][d], lat[4][d], lat[1], lat[2], lat[5][d], s_ctx, rev)
        y_lat = y_lat + yl
        y_ctx = y_ctx + yc
    out_lat = rwkv_readout(y_lat, lat, r_k, gn_g, gn_b)
    out_ctx = rwkv_readout(y_ctx, ctx, r_k, gn_g, gn_b) if need_ctx else None
    return out_lat, out_ctx


def hybrid_mixer(u_lat, u_ctx, rows, need_ctx, w_in, conv_w, conv_b, wa, ba, wx, bx, lam, lru_norm_g,
                 mu_prev, mu_next, w0, w2, a0, a2, g2, k_k, k_a, r_k, gn_g, gn_b, w_out):
    p_lat = u_lat @ w_in
    p_ctx = u_ctx @ w_in
    h_lat, h_ctx = rglru_mixer(p_lat[..., :D_LRU], p_ctx[..., :D_LRU], need_ctx, conv_w, conv_b, wa, ba, wx, bx, lam)
    lru_lat = rms_norm(h_lat * jax.nn.gelu(p_lat[..., D_LRU:2 * D_LRU].astype(jnp.float32)), lru_norm_g)
    o_lat, o_ctx = rwkv_mixer(to_col_major(p_lat[..., 2 * D_LRU:], rows), p_ctx[..., 2 * D_LRU:], need_ctx,
                              mu_prev, mu_next, w0, w2, a0, a2, g2, k_k, k_a, r_k, gn_g, gn_b)
    o_lat = from_col_major(o_lat, rows)
    y_lat = jnp.concatenate([lru_lat, o_lat], -1).astype(u_lat.dtype) @ w_out
    y_ctx = None
    if need_ctx:
        lru_ctx = rms_norm(h_ctx * jax.nn.gelu(p_ctx[..., D_LRU:2 * D_LRU].astype(jnp.float32)), lru_norm_g)
        y_ctx = jnp.concatenate([lru_ctx, o_ctx], -1).astype(u_ctx.dtype) @ w_out
    return y_lat, y_ctx


def expert_choice_ffn(u, w_router, w_gate, w_up, w_down):
    b, n, d = u.shape
    cap = EC_FACTOR * n // N_EXPERTS
    aff = jax.nn.softmax(jnp.einsum('bnd,de->bne', u, w_router).astype(jnp.float32), axis=-1)
    gate, idx = lax.top_k(jnp.swapaxes(aff, 1, 2), cap)
    xs = jax.vmap(lambda ub, ib: ub[ib])(u, idx)
    hid = jax.nn.silu(jnp.einsum('becd,edf->becf', xs, w_gate)) * jnp.einsum('becd,edf->becf', xs, w_up)
    ys = jnp.einsum('becf,efd->becd', hid, w_down) * gate[..., None].astype(u.dtype)
    return jax.vmap(lambda yb, ib: jnp.zeros((n, d), yb.dtype).at[ib.reshape(-1)].add(yb.reshape(-1, d)))(ys, idx)


def setup_inputs(seed: int = 0) -> dict:
    key = jax.random.key(seed)
    ks = iter(jax.random.split(key, 48))
    L = DEPTH

    def nrm(shape, scale):
        return scale * jax.random.normal(next(ks), shape, jnp.float32)

    def unif(shape, lo, hi):
        return jax.random.uniform(next(ks), shape, jnp.float32, lo, hi)

    lam_a = unif((L, 2, D_LRU), 0.9, 0.999) ** (1.0 / LRU_C)
    return {
        'x': nrm((BATCH, SEQ, D_MODEL), 1.0),
        'c': nrm((BATCH, D_MODEL), 1.0),
        'ctx': nrm((BATCH, CTX_LEN, D_MODEL), 1.0),
        'c_ctx': nrm((D_MODEL,), 1.0),
        'ln_in_g': 1.0 + nrm((D_MODEL,), 0.02),
        'ln_in_b': nrm((D_MODEL,), 0.02),
        'w_mod': nrm((L, D_MODEL, 6 * D_MODEL), 0.5 * D_MODEL ** -0.5),
        'b_mod': nrm((L, 6 * D_MODEL), 0.02),
        'w_in': nrm((L, D_MODEL, D_IN), D_MODEL ** -0.5),
        'lru_conv_w': nrm((L, CONV_W, D_LRU), CONV_W ** -0.5),
        'lru_conv_b': nrm((L, D_LRU), 0.02),
        'lru_wa': nrm((L, 2, LRU_BLOCKS, LRU_BLOCK, LRU_BLOCK), LRU_BLOCK ** -0.5),
        'lru_ba': nrm((L, 2, D_LRU), 0.02),
        'lru_wx': nrm((L, 2, LRU_BLOCKS, LRU_BLOCK, LRU_BLOCK), LRU_BLOCK ** -0.5),
        'lru_bx': nrm((L, 2, D_LRU), 0.02),
        'lru_lam': jnp.log(lam_a) - jnp.log1p(-lam_a),
        'lru_norm_g': 1.0 + nrm((L, D_LRU), 0.02),
        'rwkv_mu_prev': unif((L, D_RWKV_IN), 0.0, 0.5),
        'rwkv_mu_next': unif((L, D_RWKV_IN), 0.0, 0.5),
        'rwkv_w0': unif((L, 2, D_RWKV), -6.0, -1.0),
        'rwkv_w2': nrm((L, 2, DECAY_LORA, D_RWKV), 0.1),
        'rwkv_a0': nrm((L, 2, D_RWKV), 0.1),
        'rwkv_a2': nrm((L, 2, ICLR_LORA, D_RWKV), 0.5 * ICLR_LORA ** -0.5),
        'rwkv_g2': nrm((L, GATE_LORA, D_RWKV), GATE_LORA ** -0.5),
        'rwkv_k_k': 0.85 + nrm((L, D_RWKV), 0.02),
        'rwkv_k_a': 1.0 + nrm((L, D_RWKV), 0.02),
        'rwkv_r_k': nrm((L, RWKV_HEADS, RWKV_HEAD), 0.1),
        'rwkv_gn_g': 1.0 + nrm((L, D_RWKV), 0.02),
        'rwkv_gn_b': nrm((L, D_RWKV), 0.02),
        'w_out': nrm((L, D_MIX, D_MODEL), BETA * D_MIX ** -0.5),
        'ln1_g': 1.0 + nrm((L, D_MODEL), 0.02),
        'ln1_b': nrm((L, D_MODEL), 0.02),
        'w_router': nrm((L, D_MODEL, N_EXPERTS), D_MODEL ** -0.5),
        'w_gate': nrm((L, N_EXPERTS, D_MODEL, D_EXPERT), D_MODEL ** -0.5),
        'w_up': nrm((L, N_EXPERTS, D_MODEL, D_EXPERT), D_MODEL ** -0.5),
        'w_down': nrm((L, N_EXPERTS, D_EXPERT, D_MODEL), BETA * D_EXPERT ** -0.5),
        'ln2_g': 1.0 + nrm((L, D_MODEL), 0.02),
        'ln2_b': nrm((L, D_MODEL), 0.02),
    }


def reference(x, c, ctx, c_ctx, ln_in_g, ln_in_b, w_mod, b_mod, w_in, lru_conv_w, lru_conv_b, lru_wa, lru_ba,
              lru_wx, lru_bx, lru_lam, lru_norm_g, rwkv_mu_prev, rwkv_mu_next, rwkv_w0, rwkv_w2, rwkv_a0, rwkv_a2,
              rwkv_g2, rwkv_k_k, rwkv_k_a, rwkv_r_k, rwkv_gn_g, rwkv_gn_b, w_out, ln1_g, ln1_b, w_router, w_gate,
              w_up, w_down, ln2_g, ln2_b):
    rows = x.shape[1] // GRID_W
    h = layer_norm(x, ln_in_g, ln_in_b)
    hc = layer_norm(ctx, ln_in_g, ln_in_b)
    for l in range(DEPTH):
        need_ctx = l < DEPTH - 1
        mod = jax.nn.silu(c) @ w_mod[l] + b_mod[l]
        mod_c = jax.nn.silu(c_ctx) @ w_mod[l] + b_mod[l]
        sh1, sc1, gt1, sh2, sc2, gt2 = [m[:, None, :] for m in jnp.split(mod, 6, axis=-1)]
        sh1c, sc1c, gt1c, sh2c, sc2c, gt2c = jnp.split(mod_c, 6, axis=-1)
        y_lat, y_ctx = hybrid_mixer(
            h * (1.0 + sc1) + sh1, hc * (1.0 + sc1c) + sh1c, rows, need_ctx, w_in[l],
            lru_conv_w[l], lru_conv_b[l], lru_wa[l], lru_ba[l], lru_wx[l], lru_bx[l], lru_lam[l], lru_norm_g[l],
            rwkv_mu_prev[l], rwkv_mu_next[l], rwkv_w0[l], rwkv_w2[l], rwkv_a0[l], rwkv_a2[l], rwkv_g2[l],
            rwkv_k_k[l], rwkv_k_a[l], rwkv_r_k[l], rwkv_gn_g[l], rwkv_gn_b[l], w_out[l])
        h = layer_norm(ALPHA * h + gt1 * y_lat, ln1_g[l], ln1_b[l])
        y_ffn = expert_choice_ffn(h * (1.0 + sc2) + sh2, w_router[l], w_gate[l], w_up[l], w_down[l])
        h = layer_norm(ALPHA * h + gt2 * y_ffn, ln2_g[l], ln2_b[l])
        if need_ctx:
            hc = layer_norm(ALPHA * hc + gt1c * y_ctx, ln1_g[l], ln1_b[l])
            yc_ffn = expert_choice_ffn(hc * (1.0 + sc2c) + sh2c, w_router[l], w_gate[l], w_up[l], w_down[l])
            hc = layer_norm(ALPHA * hc + gt2c * yc_ffn, ln2_g[l], ln2_b[l])
    return h
```

```cpp
#ifndef HOST_EMU
#include <hip/hip_runtime.h>
#include <cstdio>
#endif
#include <cstdint>
#include <cstddef>

#ifdef CFG_SMALL
constexpr int D_MODEL = 256, BATCH = 2, SEQ = 256, GRID_W = 16, CTX_LEN = 64, LRU_BLOCKS = 2, N_EXPERTS = 4, D_EXPERT = 256;
#else
constexpr int D_MODEL = 1024, BATCH = 4, SEQ = 4096, GRID_W = 64, CTX_LEN = 256, LRU_BLOCKS = 8, N_EXPERTS = 16, D_EXPERT = 1408;
#endif
constexpr int ROWS = SEQ / GRID_W;
constexpr int D_LRU = D_MODEL / 2, LRU_BLOCK = 64;
constexpr int D_RWKV = D_MODEL / 2, HEADS = D_RWKV / 64;
constexpr int D_RWKV_IN = 3 * D_RWKV + 128 + 128 + 128;
constexpr int D_IN = 2 * D_LRU + D_RWKV_IN;
constexpr int D_MIX = D_LRU + D_RWKV;
constexpr int CAP = 2 * SEQ / N_EXPERTS;
constexpr int MLAT = BATCH * SEQ, MCTX = BATCH * CTX_LEN, MTOT = MLAT + MCTX;
constexpr int NMOD = BATCH + 1;
constexpr int RW0 = 2 * D_LRU;
constexpr float ALPHA_F = 1.189207115002721f;
constexpr float LN_EPS = 1e-5f, GN_EPS = 64e-5f, RMS_EPS = 1e-6f;
static_assert(LRU_BLOCKS * LRU_BLOCK == D_LRU, "lru blocks");
static_assert(CAP % 128 == 0 && D_IN % 128 == 0 && D_EXPERT % 128 == 0 && D_MODEL % 128 == 0 && MTOT % 128 == 0, "tile divisibility");

typedef unsigned short bf16_t;
typedef short bf16x8 __attribute__((ext_vector_type(8)));
typedef float f32x4 __attribute__((ext_vector_type(4)));
struct alignas(16) F4 { float x, y, z, w; };
struct alignas(8) U2 { unsigned x, y; };
struct alignas(16) U4 { unsigned x, y, z, w; };

#ifdef HOST_EMU
#define MFMA16(a, b, c) emu_mfma_16x16x32_bf16(a, b, c)
#else
#define MFMA16(a, b, c) __builtin_amdgcn_mfma_f32_16x16x32_bf16(a, b, c, 0, 0, 0)
#endif

__device__ __forceinline__ unsigned fbits(float f) { return __builtin_bit_cast(unsigned, f); }
__device__ __forceinline__ float bitsf(unsigned u) { return __builtin_bit_cast(float, u); }
__device__ __forceinline__ bf16_t f2bf(float f) { unsigned u = fbits(f); u += 0x7FFFu + ((u >> 16) & 1u); return (bf16_t)(u >> 16); }
__device__ __forceinline__ float bf2f(bf16_t h) { return bitsf(((unsigned)h) << 16); }
__device__ __forceinline__ unsigned pk2(float lo, float hi) { return (unsigned)f2bf(lo) | ((unsigned)f2bf(hi) << 16); }
__device__ __forceinline__ float sigmoidf_(float x) { return 1.0f / (1.0f + expf(-x)); }
__device__ __forceinline__ float siluf_(float x) { return x * sigmoidf_(x); }
__device__ __forceinline__ float softplusf_(float x) { return fmaxf(x, 0.0f) + log1pf(expf(-fabsf(x))); }
__device__ __forceinline__ float geluf_(float x) { return 0.5f * x * (1.0f + tanhf(0.7978845608028654f * (x + 0.044715f * x * x * x))); }
__device__ __forceinline__ float wave_sum(float v) {
#pragma unroll
    for (int o = 1; o < 64; o <<= 1) v += __shfl_xor(v, o);
    return v;
}

constexpr size_t al256(size_t x) { return (x + 255) & ~(size_t)255; }
constexpr int NLCH = BATCH * (SEQ / 64), NCCH = BATCH * (CTX_LEN / 64), NCH = NLCH + NCCH;
constexpr size_t WS_CTRL = 0;
constexpr size_t WS_MOD = 65536;
constexpr size_t WS_STATS = al256(WS_MOD + (size_t)NMOD * 6 * D_MODEL * 4);
constexpr size_t WS_SUMA = al256(WS_STATS + (size_t)MTOT * 2 * 4);
constexpr size_t WS_SUMH = al256(WS_SUMA + (size_t)2 * NCH * D_LRU * 4);
constexpr size_t WS_BON = al256(WS_SUMH + (size_t)2 * NCH * D_LRU * 4);
constexpr size_t WS_AFF = al256(WS_BON + (size_t)2 * MLAT * HEADS * 4);
constexpr size_t WS_IDX = al256(WS_AFF + (size_t)MLAT * N_EXPERTS * 4);
constexpr size_t WS_GATE = al256(WS_IDX + (size_t)BATCH * N_EXPERTS * CAP * 4);
constexpr size_t WS_R1 = al256(WS_GATE + (size_t)BATCH * N_EXPERTS * CAP * 4);
constexpr size_t R1_BYTES = (size_t)MTOT * D_IN * 2 > (size_t)MLAT * D_MODEL * 4 ? ((size_t)MTOT * D_IN * 2 > (size_t)BATCH * N_EXPERTS * CAP * D_EXPERT * 2 ? (size_t)MTOT * D_IN * 2 : (size_t)BATCH * N_EXPERTS * CAP * D_EXPERT * 2)
                                                                                  : ((size_t)MLAT * D_MODEL * 4 > (size_t)BATCH * N_EXPERTS * CAP * D_EXPERT * 2 ? (size_t)MLAT * D_MODEL * 4 : (size_t)BATCH * N_EXPERTS * CAP * D_EXPERT * 2);
constexpr size_t WS_R2 = al256(WS_R1 + R1_BYTES);
constexpr size_t WS_R3 = al256(WS_R2 + (size_t)MLAT * D_MODEL * 4);
constexpr size_t WS_R5 = al256(WS_R3 + (size_t)MTOT * D_MODEL * 2);
constexpr size_t WS_R6 = al256(WS_R5 + (size_t)MLAT * D_MODEL * 4);
constexpr size_t WS_END = al256(WS_R6 + (size_t)MLAT * D_MODEL * 2);

struct Params {
    const float *x, *c, *ctx, *c_ctx, *ln_in_g, *ln_in_b, *w_mod, *b_mod, *w_in, *lru_conv_w, *lru_conv_b, *lru_wa, *lru_ba, *lru_wx, *lru_bx, *lru_lam, *lru_norm_g,
        *mu_prev, *mu_next, *w0, *w2, *a0, *a2, *g2, *k_k, *k_a, *r_k, *gn_g, *gn_b, *w_out, *ln1_g, *ln1_b, *w_router, *w_gate, *w_up, *w_down, *ln2_g, *ln2_b;
    float* out;
    unsigned char* ws;
};
#define WSP(T, off) ((T*)(p.ws + (off)))

constexpr int SMEM_BYTES = 84 * 1024;

__device__ void phaseA(const Params& p, int bid, int nblk, char* smem) {
    float* sc = (float*)smem;
    float* red = sc + NMOD * D_MODEL;
    const int tid = threadIdx.x;
    for (int i = tid; i < NMOD * D_MODEL; i += 256) {
        const int r = i / D_MODEL, k = i % D_MODEL;
        const float v = (r < BATCH) ? p.c[r * D_MODEL + k] : p.c_ctx[k];
        sc[i] = siluf_(v);
    }
    __syncthreads();
    float* MOD = WSP(float, WS_MOD);
    const int col = tid & 63, kg = tid >> 6;
    for (int cb = bid; cb < 6 * D_MODEL / 64; cb += nblk) {
        const int n = cb * 64 + col;
        float acc[NMOD];
#pragma unroll
        for (int r = 0; r < NMOD; ++r) acc[r] = 0.f;
        for (int k = kg; k < D_MODEL; k += 4) {
            const float w = p.w_mod[(size_t)k * (6 * D_MODEL) + n];
#pragma unroll
            for (int r = 0; r < NMOD; ++r) acc[r] += sc[r * D_MODEL + k] * w;
        }
#pragma unroll
        for (int r = 0; r < NMOD; ++r) red[(kg * NMOD + r) * 64 + col] = acc[r];
        __syncthreads();
        if (kg == 0) {
#pragma unroll
            for (int r = 0; r < NMOD; ++r) {
                float s = p.b_mod[n];
                for (int g = 0; g < 4; ++g) s += red[(g * NMOD + r) * 64 + col];
                MOD[(size_t)r * 6 * D_MODEL + n] = s;
            }
        }
        __syncthreads();
    }
}

constexpr int NV = D_MODEL / 256;
__device__ void phaseB(const Params& p, int bid, int nblk, char* smem) {
    const int lane = threadIdx.x & 63, wave = threadIdx.x >> 6;
    const float* MOD = WSP(float, WS_MOD);
    float* STATS = WSP(float, WS_STATS);
    bf16_t* U = WSP(bf16_t, WS_R3);
    for (int row = bid * 4 + wave; row < MTOT; row += nblk * 4) {
        const float* xr = (row < MLAT) ? p.x + (size_t)row * D_MODEL : p.ctx + (size_t)(row - MLAT) * D_MODEL;
        const int mr = (row < MLAT) ? row / SEQ : BATCH;
        const float* md = MOD + (size_t)mr * 6 * D_MODEL;
        F4 v[NV]; float s = 0.f;
#pragma unroll
        for (int j = 0; j < NV; ++j) { v[j] = *(const F4*)(xr + j * 256 + lane * 4); s += (v[j].x + v[j].y) + (v[j].z + v[j].w); }
        const float mu = wave_sum(s) * (1.0f / D_MODEL);
        float s2 = 0.f;
#pragma unroll
        for (int j = 0; j < NV; ++j) { v[j].x -= mu; v[j].y -= mu; v[j].z -= mu; v[j].w -= mu; s2 += (v[j].x * v[j].x + v[j].y * v[j].y) + (v[j].z * v[j].z + v[j].w * v[j].w); }
        const float rstd = 1.0f / sqrtf(wave_sum(s2) * (1.0f / D_MODEL) + LN_EPS);
        if (lane == 0) { STATS[row * 2] = mu; STATS[row * 2 + 1] = rstd; }
#pragma unroll
        for (int j = 0; j < NV; ++j) {
            const int k = j * 256 + lane * 4;
            const F4 g = *(const F4*)(p.ln_in_g + k), b = *(const F4*)(p.ln_in_b + k), sh = *(const F4*)(md + k), sc = *(const F4*)(md + D_MODEL + k);
            const float h0 = v[j].x * rstd * g.x + b.x, h1 = v[j].y * rstd * g.y + b.y, h2 = v[j].z * rstd * g.z + b.z, h3 = v[j].w * rstd * g.w + b.w;
            U2 o; o.x = pk2(h0 * (1.f + sc.x) + sh.x, h1 * (1.f + sc.y) + sh.y); o.y = pk2(h2 * (1.f + sc.z) + sh.z, h3 * (1.f + sc.w) + sh.w);
            *(U2*)(U + (size_t)row * D_MODEL + k) = o;
        }
    }
}

constexpr int LDK = 72;
template <int NB, class Epi>
__device__ __forceinline__ void gemm_tile(char* smem, const bf16_t* A, int lda, const int* rowidx, int m0, const float* B0, const float* B1, int ldb, int n0, int K, Epi epi) {
    bf16_t* As = (bf16_t*)smem;
    bf16_t* Bs = As + 128 * LDK;
    const int tid = threadIdx.x, lane = tid & 63, wave = tid >> 6, wr = wave >> 1, wc = wave & 1;
    const int arow = tid >> 1, ahalf = tid & 1;
    const size_t agrow = rowidx ? (size_t)rowidx[m0 + arow] : (size_t)(m0 + arow);
    const bf16_t* aptr = A + agrow * lda + ahalf * 32;
    const int bn4 = tid & 31, bkg = tid >> 5;
    const float* bptr0 = B0 + (size_t)(bkg * 8) * ldb + n0 + bn4 * 4;
    const float* bptr1 = (NB == 2) ? B1 + (size_t)(bkg * 8) * ldb + n0 + bn4 * 4 : nullptr;
    U4 ar[4]; F4 br[NB][8];
    f32x4 acc[NB][4][4];
#pragma unroll
    for (int b = 0; b < NB; ++b)
#pragma unroll
        for (int i = 0; i < 4; ++i)
#pragma unroll
            for (int j = 0; j < 4; ++j) acc[b][i][j] = f32x4{0.f, 0.f, 0.f, 0.f};
    const int nk = K / 64;
#pragma unroll
    for (int j = 0; j < 4; ++j) ar[j] = *(const U4*)(aptr + j * 8);
#pragma unroll
    for (int j = 0; j < 8; ++j) { br[0][j] = *(const F4*)(bptr0 + (size_t)j * ldb); if (NB == 2) br[NB - 1][j] = *(const F4*)(bptr1 + (size_t)j * ldb); }
    for (int kt = 0; kt < nk; ++kt) {
        __syncthreads();
#pragma unroll
        for (int j = 0; j < 4; ++j) *(U4*)(As + arow * LDK + ahalf * 32 + j * 8) = ar[j];
#pragma unroll
        for (int b = 0; b < NB; ++b) {
#pragma unroll
            for (int c = 0; c < 4; ++c) {
                U4 o;
                const float* f0 = (const float*)&br[b][0]; const float* f1 = (const float*)&br[b][1]; const float* f2 = (const float*)&br[b][2]; const float* f3 = (const float*)&br[b][3];
                const float* f4 = (const float*)&br[b][4]; const float* f5 = (const float*)&br[b][5]; const float* f6 = (const float*)&br[b][6]; const float* f7 = (const float*)&br[b][7];
                o.x = pk2(f0[c], f1[c]); o.y = pk2(f2[c], f3[c]); o.z = pk2(f4[c], f5[c]); o.w = pk2(f6[c], f7[c]);
                *(U4*)(Bs + (size_t)b * 128 * LDK + (bn4 * 4 + c) * LDK + bkg * 8) = o;
            }
        }
        __syncthreads();
        if (kt + 1 < nk) {
            const int ko = (kt + 1) * 64;
#pragma unroll
            for (int j = 0; j < 4; ++j) ar[j] = *(const U4*)(aptr + ko + j * 8);
#pragma unroll
            for (int j = 0; j < 8; ++j) { br[0][j] = *(const F4*)(bptr0 + (size_t)(ko + j) * ldb); if (NB == 2) br[NB - 1][j] = *(const F4*)(bptr1 + (size_t)(ko + j) * ldb); }
        }
#pragma unroll
        for (int ks = 0; ks < 2; ++ks) {
            bf16x8 af[4];
#pragma unroll
            for (int mi = 0; mi < 4; ++mi) af[mi] = *(const bf16x8*)(As + (wr * 64 + mi * 16 + (lane & 15)) * LDK + ks * 32 + 8 * (lane >> 4));
#pragma unroll
            for (int b = 0; b < NB; ++b) {
#pragma unroll
                for (int ni = 0; ni < 4; ++ni) {
                    const bf16x8 bfr = *(const bf16x8*)(Bs + (size_t)b * 128 * LDK + (wc * 64 + ni * 16 + (lane & 15)) * LDK + ks * 32 + 8 * (lane >> 4));
#pragma unroll
                    for (int mi = 0; mi < 4; ++mi) acc[b][mi][ni] = MFMA16(bfr, af[mi], acc[b][mi][ni]);
                }
            }
        }
    }
#pragma unroll
    for (int mi = 0; mi < 4; ++mi)
#pragma unroll
        for (int ni = 0; ni < 4; ++ni) {
            const int ml = wr * 64 + mi * 16 + (lane & 15), nl = wc * 64 + ni * 16 + (lane >> 4) * 4;
            if (NB == 2) epi(ml, nl, acc[0][mi][ni], acc[NB - 1][mi][ni]); else epi(ml, nl, acc[0][mi][ni], acc[0][mi][ni]);
        }
    __syncthreads();
}

__device__ void phaseC(const Params& p, int bid, int nblk, char* smem) {
    const bf16_t* U = WSP(bf16_t, WS_R3);
    bf16_t* P = WSP(bf16_t, WS_R1);
    constexpr int NTN = D_IN / 128, NTM = MTOT / 128;
    for (int it = bid; it < NTN * NTM; it += nblk) {
        const int mt = it / NTN, nt = it % NTN;
        gemm_tile<1>(smem, U, D_MODEL, nullptr, mt * 128, p.w_in, nullptr, D_IN, nt * 128, D_MODEL, [&](int ml, int nl, f32x4 v, f32x4) {
            U2 o; o.x = pk2(v[0], v[1]); o.y = pk2(v[2], v[3]);
            *(U2*)(P + (size_t)(mt * 128 + ml) * D_IN + nt * 128 + nl) = o;
        });
    }
}

struct SeqChunk { int base_row; int t0; int len; };
__device__ __forceinline__ SeqChunk lru_chunk(int cg) {
    SeqChunk s;
    if (cg < NLCH) { const int b = cg / (SEQ / 64), ck = cg % (SEQ / 64); s.base_row = b * SEQ; s.t0 = ck * 64; s.len = SEQ; }
    else { const int c2 = cg - NLCH; const int b = c2 / (CTX_LEN / 64), ck = c2 % (CTX_LEN / 64); s.base_row = MLAT + b * CTX_LEN; s.t0 = ck * 64; s.len = CTX_LEN; }
    return s;
}
constexpr int LRU_XL = 0;
constexpr int LRU_W = 16384;
constexpr int LRU_A = LRU_W + 17152;
constexpr int LRU_B = LRU_A + 16384;
constexpr int LRU_X = LRU_B + 16384;
__device__ __forceinline__ void lru_conv(const Params& p, char* smem, const SeqChunk& sc, int cb) {
    const bf16_t* P = WSP(bf16_t, WS_R1);
    float* xl = (float*)(smem + LRU_XL); float* xin = (float*)(smem + LRU_W);
    const int tid = threadIdx.x;
    for (int i = tid; i < 67 * 64; i += 256) {
        const int tt = i >> 6, c = i & 63, t = sc.t0 - 1 + tt;
        xin[i] = (t >= 0 && t < sc.len) ? bf2f(P[(size_t)(sc.base_row + t) * D_IN + cb * 64 + c]) : 0.f;
    }
    __syncthreads();
    for (int i = tid; i < 64 * 64; i += 256) {
        const int tt = i >> 6, c = i & 63, ch = cb * 64 + c;
        xl[i] = p.lru_conv_b[ch] + xin[i] * p.lru_conv_w[ch] + xin[i + 64] * p.lru_conv_w[D_LRU + ch] + xin[i + 128] * p.lru_conv_w[2 * D_LRU + ch] + xin[i + 192] * p.lru_conv_w[3 * D_LRU + ch];
    }
    __syncthreads();
}
__device__ __forceinline__ void lru_gates(const Params& p, char* smem, int cb, int d) {
    float* xl = (float*)(smem + LRU_XL); float* W = (float*)(smem + LRU_W); float* Aa = (float*)(smem + LRU_A); float* Bb = (float*)(smem + LRU_B);
    const int tid = threadIdx.x, tt = tid >> 2, jq = tid & 3;
    float rg[16];
    for (int which = 0; which < 2; ++which) {
        const float* Wg = (which == 0 ? p.lru_wa : p.lru_wx) + ((size_t)(d * LRU_BLOCKS + cb)) * 64 * 64;
        const float* bias = (which == 0 ? p.lru_ba : p.lru_bx) + d * D_LRU + cb * 64;
        __syncthreads();
        for (int i = tid; i < 64 * 64; i += 256) W[i] = Wg[i];
        __syncthreads();
        float acc[16];
#pragma unroll
        for (int j = 0; j < 16; ++j) acc[j] = bias[jq * 16 + j];
        for (int i = 0; i < 64; ++i) {
            const float xv = xl[tt * 64 + i];
#pragma unroll
            for (int j = 0; j < 16; ++j) acc[j] += xv * W[i * 64 + jq * 16 + j];
        }
        if (which == 0) {
#pragma unroll
            for (int j = 0; j < 16; ++j) rg[j] = sigmoidf_(acc[j]);
        } else {
#pragma unroll
            for (int j = 0; j < 16; ++j) {
                const int c = jq * 16 + j;
                const float ig = sigmoidf_(acc[j]);
                const float sp = softplusf_(-p.lru_lam[d * D_LRU + cb * 64 + c]);
                const float la = -8.0f * rg[j] * sp;
                Aa[tt * 64 + c] = expf(la);
                Bb[tt * 64 + c] = sqrtf(-expm1f(2.0f * la)) * ig * xl[tt * 64 + c];
            }
        }
    }
    __syncthreads();
}

__device__ void phaseD(const Params& p, int bid, int nblk, char* smem) {
    float* SUMA = WSP(float, WS_SUMA); float* SUMH = WSP(float, WS_SUMH);
    float* Aa = (float*)(smem + LRU_A); float* Bb = (float*)(smem + LRU_B);
    const int tid = threadIdx.x;
    for (int it = bid; it < NCH * LRU_BLOCKS; it += nblk) {
        const int cg = it / LRU_BLOCKS, cb = it % LRU_BLOCKS;
        const SeqChunk sc = lru_chunk(cg);
        lru_conv(p, smem, sc, cb);
        for (int d = 0; d < 2; ++d) {
            lru_gates(p, smem, cb, d);
            if (tid < 64) {
                float ap = 1.f, h = 0.f;
                for (int s = 0; s < 64; ++s) { const int t = d ? 63 - s : s; const float a = Aa[t * 64 + tid]; h = a * h + Bb[t * 64 + tid]; ap *= a; }
                SUMA[((size_t)d * NCH + cg) * D_LRU + cb * 64 + tid] = ap;
                SUMH[((size_t)d * NCH + cg) * D_LRU + cb * 64 + tid] = h;
            }
            __syncthreads();
        }
    }
}

__device__ void phaseF(const Params& p, int bid, int nblk, char* smem) {
    const float* SUMA = WSP(float, WS_SUMA); const float* SUMH = WSP(float, WS_SUMH);
    const bf16_t* P = WSP(bf16_t, WS_R1);
    float* LRUV = WSP(float, WS_R5);
    bf16_t* MIX = WSP(bf16_t, WS_R3);
    float* Aa = (float*)(smem + LRU_A); float* Bb = (float*)(smem + LRU_B);
    float* carry = (float*)(smem + LRU_X);
    float* ssq = carry + 128;
    float* hs = (float*)(smem + LRU_X + 1024);
    const int tid = threadIdx.x;
    constexpr int NLB = SEQ / 64, NCB = CTX_LEN / 64;
    for (int cg = bid; cg < NLCH; cg += nblk) {
        const int b = cg / NLB, ck = cg % NLB;
        const SeqChunk sc = lru_chunk(cg);
        if (tid < 64) ssq[tid] = 0.f;
        for (int cb = 0; cb < LRU_BLOCKS; ++cb) {
            __syncthreads();
            if (tid < 128) {
                const int d = tid >> 6, c = cb * 64 + (tid & 63);
                float h = 0.f;
                const float* sa = SUMA + (size_t)d * NCH * D_LRU + c; const float* sh = SUMH + (size_t)d * NCH * D_LRU + c;
                if (d == 0) {
                    for (int q = 0; q < NCB; ++q) { const int g = NLCH + b * NCB + q; h = sa[(size_t)g * D_LRU] * h + sh[(size_t)g * D_LRU]; }
                    for (int q = 0; q < ck; ++q) { const int g = b * NLB + q; h = sa[(size_t)g * D_LRU] * h + sh[(size_t)g * D_LRU]; }
                } else {
                    for (int q = NCB - 1; q >= 0; --q) { const int g = NLCH + b * NCB + q; h = sa[(size_t)g * D_LRU] * h + sh[(size_t)g * D_LRU]; }
                    for (int q = NLB - 1; q > ck; --q) { const int g = b * NLB + q; h = sa[(size_t)g * D_LRU] * h + sh[(size_t)g * D_LRU]; }
                }
                carry[tid] = h;
            }
            lru_conv(p, smem, sc, cb);
            for (int d = 0; d < 2; ++d) {
                lru_gates(p, smem, cb, d);
                if (tid < 64) {
                    float h = carry[d * 64 + tid];
                    for (int s = 0; s < 64; ++s) {
                        const int t = d ? 63 - s : s;
                        h = Aa[t * 64 + tid] * h + Bb[t * 64 + tid];
                        if (d == 0) hs[t * 64 + tid] = h; else hs[t * 64 + tid] += h;
                    }
                }
                __syncthreads();
            }
            {
                const int tt = tid >> 2, jq = tid & 3;
                float s2 = 0.f;
                const size_t row = (size_t)(sc.base_row + sc.t0 + tt);
#pragma unroll
                for (int j = 0; j < 16; ++j) {
                    const int c = jq * 16 + j;
                    const float gt = bf2f(P[row * D_IN + D_LRU + cb * 64 + c]);
                    const float v = hs[tt * 64 + c] * geluf_(gt);
                    LRUV[row * D_LRU + cb * 64 + c] = v;
                    s2 += v * v;
                }
                s2 += __shfl_xor(s2, 1); s2 += __shfl_xor(s2, 2);
                if (jq == 0) ssq[tt] += s2;
            }
        }
        __syncthreads();
        for (int i = tid; i < 64 * (D_LRU / 4); i += 256) {
            const int tt = i / (D_LRU / 4), c4 = (i % (D_LRU / 4)) * 4;
            const size_t row = (size_t)(sc.base_row + sc.t0 + tt);
            const float rs = 1.0f / sqrtf(ssq[tt] * (1.0f / D_LRU) + RMS_EPS);
            const F4 v = *(const F4*)(LRUV + row * D_LRU + c4); const F4 g = *(const F4*)(p.lru_norm_g + c4);
            U2 o; o.x = pk2(v.x * rs * g.x, v.y * rs * g.y); o.y = pk2(v.z * rs * g.z, v.w * rs * g.w);
            *(U2*)(MIX + row * D_MIX + c4) = o;
        }
        __syncthreads();
    }
}

constexpr int RCH = 16;
__device__ __forceinline__ size_t rwkv_row(int seg, int b, int s) {
    if (seg == 0) return (size_t)(MLAT + b * CTX_LEN + s);
    const int r = s % ROWS, c = s / ROWS;
    return (size_t)(b * SEQ + r * GRID_W + c);
}
__device__ void phaseH(const Params& p, int bid, int nblk, char* smem) {
    const bf16_t* P = WSP(bf16_t, WS_R1);
    float* YR = WSP(float, WS_R2);
    float* BON = WSP(float, WS_BON);
    float* Z = (float*)smem;
    float* ZS = Z + (RCH + 2) * 320;
    float* SV = ZS + RCH * 320;
    float* YB = SV + RCH * 6 * 64;
    const int tid = threadIdx.x;
    for (int chain = bid; chain < BATCH * HEADS * 2; chain += nblk) {
        const int d = chain & 1, h = (chain >> 1) % HEADS, b = chain / (2 * HEADS);
        float st[16];
#pragma unroll
        for (int j = 0; j < 16; ++j) st[j] = 0.f;
        const int si = tid >> 2, sq = tid & 3;
        for (int seg = 0; seg < 2; ++seg) {
            const int len = seg == 0 ? CTX_LEN : SEQ;
            for (int cc = 0; cc < len / RCH; ++cc) {
                const int s_lo = (d == 0 ? cc : (len / RCH - 1 - cc)) * RCH;
                __syncthreads();
                for (int i = tid; i < (RCH + 2) * 320; i += 256) {
                    const int tt = i / 320, c = i % 320, s = s_lo - 1 + tt;
                    const int grp = c >> 6, j = c & 63;
                    const int ch = (grp < 3) ? grp * D_RWKV + h * 64 + j : (grp == 3 ? 3 * D_RWKV + d * 64 + j : 3 * D_RWKV + 128 + d * 64 + j);
                    Z[i] = (s >= 0 && s < len) ? bf2f(P[rwkv_row(seg, b, s) * D_IN + RW0 + ch]) : 0.f;
                }
                __syncthreads();
                for (int i = tid; i < RCH * 320; i += 256) {
                    const int tt = i / 320, c = i % 320;
                    const int grp = c >> 6, j = c & 63;
                    const int ch = (grp < 3) ? grp * D_RWKV + h * 64 + j : (grp == 3 ? 3 * D_RWKV + d * 64 + j : 3 * D_RWKV + 128 + d * 64 + j);
                    const float z = Z[(tt + 1) * 320 + c];
                    float v = z + p.mu_prev[ch] * (Z[tt * 320 + c] - z) + p.mu_next[ch] * (Z[(tt + 2) * 320 + c] - z);
                    if (grp == 3) v = tanhf(v);
                    ZS[i] = v;
                }
                __syncthreads();
                {
                    const int tt = tid >> 4, jg = tid & 15;
                    float wl[4], il[4];
#pragma unroll
                    for (int j = 0; j < 4; ++j) { wl[j] = p.w0[d * D_RWKV + h * 64 + jg * 4 + j]; il[j] = p.a0[d * D_RWKV + h * 64 + jg * 4 + j]; }
                    const float* w2p = p.w2 + (size_t)d * 64 * D_RWKV + h * 64 + jg * 4;
                    const float* a2p = p.a2 + (size_t)d * 64 * D_RWKV + h * 64 + jg * 4;
                    for (int i = 0; i < 64; ++i) {
                        const float tw = ZS[tt * 320 + 192 + i], ta = ZS[tt * 320 + 256 + i];
                        const F4 w2v = *(const F4*)(w2p + (size_t)i * D_RWKV), a2v = *(const F4*)(a2p + (size_t)i * D_RWKV);
                        wl[0] += tw * w2v.x; wl[1] += tw * w2v.y; wl[2] += tw * w2v.z; wl[3] += tw * w2v.w;
                        il[0] += ta * a2v.x; il[1] += ta * a2v.y; il[2] += ta * a2v.z; il[3] += ta * a2v.w;
                    }
                    float kkv[4], n2 = 0.f, bon = 0.f;
#pragma unroll
                    for (int j = 0; j < 4; ++j) {
                        const int jj = jg * 4 + j, ch = h * 64 + jj;
                        const float rr = ZS[tt * 320 + jj], kr = ZS[tt * 320 + 64 + jj], vr = ZS[tt * 320 + 128 + jj];
                        const float wlog = -softplusf_(-wl[j]) - 0.5f;
                        const float wdec = expf(-expf(wlog));
                        const float ic = sigmoidf_(il[j]);
                        const float kd = kr * (1.0f + (ic - 1.0f) * p.k_a[ch]);
                        kkv[j] = kr * p.k_k[ch];
                        n2 += kkv[j] * kkv[j];
                        bon += rr * kd * p.r_k[ch];
                        SV[(tt * 6 + 0) * 64 + jj] = rr; SV[(tt * 6 + 1) * 64 + jj] = wdec; SV[(tt * 6 + 2) * 64 + jj] = kd; SV[(tt * 6 + 3) * 64 + jj] = vr;
                        il[j] = ic;
                    }
#pragma unroll
                    for (int o = 1; o < 16; o <<= 1) { n2 += __shfl_xor(n2, o); bon += __shfl_xor(bon, o); }
                    const float inv = 1.0f / fmaxf(sqrtf(n2), 1e-12f);
#pragma unroll
                    for (int j = 0; j < 4; ++j) { const int jj = jg * 4 + j; const float kn = kkv[j] * inv; SV[(tt * 6 + 4) * 64 + jj] = kn; SV[(tt * 6 + 5) * 64 + jj] = kn * il[j]; }
                    if (seg == 1 && jg == 0) BON[((size_t)d * MLAT + (size_t)b * SEQ + s_lo + tt) * HEADS + h] = bon;
                }
                __syncthreads();
                for (int q = 0; q < RCH; ++q) {
                    const int tt = d ? RCH - 1 - q : q;
                    const float* sv = SV + tt * 6 * 64 + sq * 16;
                    float sa = 0.f;
#pragma unroll
                    for (int j = 0; j < 16; ++j) sa += st[j] * sv[4 * 64 + j];
                    sa += __shfl_xor(sa, 1); sa += __shfl_xor(sa, 2);
                    const float vi = SV[(tt * 6 + 3) * 64 + si];
                    float y = 0.f;
#pragma unroll
                    for (int j = 0; j < 16; ++j) {
                        st[j] = st[j] * sv[1 * 64 + j] - sa * sv[5 * 64 + j] + vi * sv[2 * 64 + j];
                        y += st[j] * sv[j];
                    }
                    y += __shfl_xor(y, 1); y += __shfl_xor(y, 2);
                    if (sq == 0) YB[tt * 64 + si] = y;
                }
                __syncthreads();
                if (seg == 1) {
                    for (int i = tid; i < RCH * 64; i += 256) {
                        const int tt = i >> 6, j = i & 63;
                        YR[((size_t)d * MLAT + (size_t)b * SEQ + s_lo + tt) * D_RWKV + h * 64 + j] = YB[i];
                    }
                }
            }
        }
    }
}

constexpr int ICH = 16;
__device__ void phaseI(const Params& p, int bid, int nblk, char* smem) {
    const bf16_t* P = WSP(bf16_t, WS_R1);
    const float* YR = WSP(float, WS_R2);
    const float* BON = WSP(float, WS_BON);
    bf16_t* MIX = WSP(bf16_t, WS_R3);
    float* ZG = (float*)smem;
    float* SG = ZG + (ICH + 2) * 128;
    const int tid = threadIdx.x, lane = tid & 63;
    for (int it = bid; it < MLAT / ICH; it += nblk) {
        const int b = it / (SEQ / ICH), n0 = (it % (SEQ / ICH)) * ICH;
        __syncthreads();
        for (int i = tid; i < (ICH + 2) * 128; i += 256) {
            const int tt = i >> 7, c = i & 127, s = n0 - 1 + tt;
            ZG[i] = (s >= 0 && s < SEQ) ? bf2f(P[rwkv_row(1, b, s) * D_IN + RW0 + 3 * D_RWKV + 256 + c]) : 0.f;
        }
        __syncthreads();
        for (int i = tid; i < ICH * 128; i += 256) {
            const int tt = i >> 7, c = i & 127, ch = 3 * D_RWKV + 256 + c;
            const float z = ZG[(tt + 1) * 128 + c];
            SG[i] = sigmoidf_(z + p.mu_prev[ch] * (ZG[tt * 128 + c] - z) + p.mu_next[ch] * (ZG[(tt + 2) * 128 + c] - z));
        }
        __syncthreads();
        for (int c = tid; c < D_RWKV; c += 256) {
            const int hh = c >> 6;
            float g[ICH];
#pragma unroll
            for (int t = 0; t < ICH; ++t) g[t] = 0.f;
            for (int i = 0; i < 128; ++i) {
                const float w = p.g2[(size_t)i * D_RWKV + c];
#pragma unroll
                for (int t = 0; t < ICH; ++t) g[t] += SG[t * 128 + i] * w;
            }
            const float gng = p.gn_g[c], gnb = p.gn_b[c];
            const int chv = 2 * D_RWKV + c;
            const float mp = p.mu_prev[chv], mn = p.mu_next[chv];
#pragma unroll
            for (int t = 0; t < ICH; ++t) {
                const int s = n0 + t;
                const size_t mrow = rwkv_row(1, b, s);
                const float z = bf2f(P[mrow * D_IN + RW0 + chv]);
                const float zp = (s > 0) ? bf2f(P[rwkv_row(1, b, s - 1) * D_IN + RW0 + chv]) : 0.f;
                const float zn = (s < SEQ - 1) ? bf2f(P[rwkv_row(1, b, s + 1) * D_IN + RW0 + chv]) : 0.f;
                const float v = z + mp * (zp - z) + mn * (zn - z);
                const size_t yi = ((size_t)b * SEQ + s) * D_RWKV + c;
                const float y = YR[yi] + YR[(size_t)MLAT * D_RWKV + yi];
                const float mu = wave_sum(y) * (1.0f / 64.0f);
                const float dv = y - mu;
                const float var = wave_sum(dv * dv) * (1.0f / 64.0f);
                const float yn = dv * (1.0f / sqrtf(var + GN_EPS)) * gng + gnb;
                const size_t bi = ((size_t)b * SEQ + s) * HEADS + hh;
                const float bonus = (BON[bi] + BON[(size_t)MLAT * HEADS + bi]) * v;
                MIX[mrow * D_MIX + D_LRU + c] = f2bf((yn + bonus) * g[t]);
            }
        }
    }
}

__device__ void phaseJ(const Params& p, int bid, int nblk, char* smem) {
    const bf16_t* MIX = WSP(bf16_t, WS_R3);
    float* YOUT = WSP(float, WS_R1);
    constexpr int NTN = D_MODEL / 128, NTM = MLAT / 128;
    for (int it = bid; it < NTN * NTM; it += nblk) {
        const int mt = it / NTN, nt = it % NTN;
        gemm_tile<1>(smem, MIX, D_MIX, nullptr, mt * 128, p.w_out, nullptr, D_MODEL, nt * 128, D_MIX, [&](int ml, int nl, f32x4 v, f32x4) {
            F4 o; o.x = v[0]; o.y = v[1]; o.z = v[2]; o.w = v[3];
            *(F4*)(YOUT + (size_t)(mt * 128 + ml) * D_MODEL + nt * 128 + nl) = o;
        });
    }
}

__device__ void phaseK(const Params& p, int bid, int nblk, char* smem) {
    const int lane = threadIdx.x & 63, wave = threadIdx.x >> 6;
    const float* MOD = WSP(float, WS_MOD); const float* STATS = WSP(float, WS_STATS);
    const float* YOUT = WSP(float, WS_R1);
    float* H1 = WSP(float, WS_R5); bf16_t* U2b = WSP(bf16_t, WS_R6); float* AFF = WSP(float, WS_AFF); float* YFFN = WSP(float, WS_R2);
    for (int row = bid * 4 + wave; row < MLAT; row += nblk * 4) {
        const float* xr = p.x + (size_t)row * D_MODEL;
        const float* md = MOD + (size_t)(row / SEQ) * 6 * D_MODEL;
        const float mu0 = STATS[row * 2], rs0 = STATS[row * 2 + 1];
        F4 v[NV]; float s = 0.f;
#pragma unroll
        for (int j = 0; j < NV; ++j) {
            const int k = j * 256 + lane * 4;
            const F4 xv = *(const F4*)(xr + k), g = *(const F4*)(p.ln_in_g + k), bb = *(const F4*)(p.ln_in_b + k), gt = *(const F4*)(md + 2 * D_MODEL + k), y = *(const F4*)(YOUT + (size_t)row * D_MODEL + k);
            v[j].x = ALPHA_F * ((xv.x - mu0) * rs0 * g.x + bb.x) + gt.x * y.x; v[j].y = ALPHA_F * ((xv.y - mu0) * rs0 * g.y + bb.y) + gt.y * y.y;
            v[j].z = ALPHA_F * ((xv.z - mu0) * rs0 * g.z + bb.z) + gt.z * y.z; v[j].w = ALPHA_F * ((xv.w - mu0) * rs0 * g.w + bb.w) + gt.w * y.w;
            s += (v[j].x + v[j].y) + (v[j].z + v[j].w);
        }
        const float mu = wave_sum(s) * (1.0f / D_MODEL);
        float s2 = 0.f;
#pragma unroll
        for (int j = 0; j < NV; ++j) { v[j].x -= mu; v[j].y -= mu; v[j].z -= mu; v[j].w -= mu; s2 += (v[j].x * v[j].x + v[j].y * v[j].y) + (v[j].z * v[j].z + v[j].w * v[j].w); }
        const float rstd = 1.0f / sqrtf(wave_sum(s2) * (1.0f / D_MODEL) + LN_EPS);
        float lg[N_EXPERTS];
#pragma unroll
        for (int e = 0; e < N_EXPERTS; ++e) lg[e] = 0.f;
#pragma unroll
        for (int j = 0; j < NV; ++j) {
            const int k = j * 256 + lane * 4;
            const F4 g = *(const F4*)(p.ln1_g + k), bb = *(const F4*)(p.ln1_b + k), sh = *(const F4*)(md + 3 * D_MODEL + k), sc = *(const F4*)(md + 4 * D_MODEL + k);
            F4 h; h.x = v[j].x * rstd * g.x + bb.x; h.y = v[j].y * rstd * g.y + bb.y; h.z = v[j].z * rstd * g.z + bb.z; h.w = v[j].w * rstd * g.w + bb.w;
            *(F4*)(H1 + (size_t)row * D_MODEL + k) = h;
            float u[4] = {h.x * (1.f + sc.x) + sh.x, h.y * (1.f + sc.y) + sh.y, h.z * (1.f + sc.z) + sh.z, h.w * (1.f + sc.w) + sh.w};
            U2 o; o.x = pk2(u[0], u[1]); o.y = pk2(u[2], u[3]);
            *(U2*)(U2b + (size_t)row * D_MODEL + k) = o;
            F4 zz; zz.x = zz.y = zz.z = zz.w = 0.f;
            *(F4*)(YFFN + (size_t)row * D_MODEL + k) = zz;
#pragma unroll
            for (int q = 0; q < 4; ++q) {
                const float* wr = p.w_router + (size_t)(k + q) * N_EXPERTS;
#pragma unroll
                for (int e = 0; e < N_EXPERTS; ++e) lg[e] += u[q] * wr[e];
            }
        }
        float mx = -3.0e38f;
#pragma unroll
        for (int e = 0; e < N_EXPERTS; ++e) { lg[e] = wave_sum(lg[e]); mx = fmaxf(mx, lg[e]); }
        float den = 0.f;
#pragma unroll
        for (int e = 0; e < N_EXPERTS; ++e) { lg[e] = expf(lg[e] - mx); den += lg[e]; }
        float mine = 0.f;
#pragma unroll
        for (int e = 0; e < N_EXPERTS; ++e) if (lane == e) mine = lg[e] / den;
        if (lane < N_EXPERTS) AFF[(size_t)row * N_EXPERTS + lane] = mine;
    }
}

__device__ __forceinline__ int block_sum_int(int v, int* red) {
    const int lane = threadIdx.x & 63, wave = threadIdx.x >> 6;
#pragma unroll
    for (int o = 1; o < 64; o <<= 1) v += __shfl_xor(v, o);
    __syncthreads();
    if (lane == 0) red[wave] = v;
    __syncthreads();
    return red[0] + red[1] + red[2] + red[3];
}
__device__ void phaseL(const Params& p, int bid, int nblk, char* smem) {
    const float* AFF = WSP(float, WS_AFF);
    int* IDX = WSP(int, WS_IDX); float* GATE = WSP(float, WS_GATE);
    unsigned* vals = (unsigned*)smem;
    int* red = (int*)(vals + SEQ);
    int* wsum = red + 8;
    const int tid = threadIdx.x, lane = tid & 63, wave = tid >> 6;
    constexpr int PER = SEQ / 256;
    for (int be = bid; be < BATCH * N_EXPERTS; be += nblk) {
        const int b = be / N_EXPERTS, e = be % N_EXPERTS;
        __syncthreads();
        for (int t = tid; t < SEQ; t += 256) vals[t] = fbits(AFF[((size_t)b * SEQ + t) * N_EXPERTS + e]);
        __syncthreads();
        unsigned lo = 0u, hi = 0x7F800000u;
        while (lo < hi) {
            const unsigned mid = lo + (hi - lo + 1u) / 2u;
            int c = 0;
            for (int t = tid; t < SEQ; t += 256) c += (vals[t] >= mid) ? 1 : 0;
            c = block_sum_int(c, red);
            if (c >= CAP) lo = mid; else hi = mid - 1u;
        }
        const unsigned T = lo;
        int cg = 0, ce = 0;
        for (int q = 0; q < PER; ++q) { const unsigned v = vals[tid * PER + q]; cg += (v > T) ? 1 : 0; ce += (v == T) ? 1 : 0; }
        int pg = cg, pe = ce;
#pragma unroll
        for (int o = 1; o < 64; o <<= 1) { const int a = __shfl_up(pg, o), bb = __shfl_up(pe, o); if (lane >= o) { pg += a; pe += bb; } }
        __syncthreads();
        if (lane == 63) { wsum[wave] = pg; wsum[4 + wave] = pe; }
        __syncthreads();
        int og = 0, oe = 0, totg = 0;
        for (int w = 0; w < 4; ++w) { if (w < wave) { og += wsum[w]; oe += wsum[4 + w]; } totg += wsum[w]; }
        int posg = og + pg - cg, pose = oe + pe - ce;
        const int need_eq = CAP - totg;
        for (int q = 0; q < PER; ++q) {
            const int t = tid * PER + q; const unsigned v = vals[t];
            int slot = -1;
            if (v > T) { slot = posg++; }
            else if (v == T) { if (pose < need_eq) slot = totg + pose; pose++; }
            if (slot >= 0) { IDX[(size_t)be * CAP + slot] = b * SEQ + t; GATE[(size_t)be * CAP + slot] = bitsf(v); }
        }
    }
}

__device__ void phaseM(const Params& p, int bid, int nblk, char* smem) {
    const bf16_t* U2b = WSP(bf16_t, WS_R6); const int* IDX = WSP(int, WS_IDX);
    bf16_t* HID = WSP(bf16_t, WS_R1);
    constexpr int NTN = D_EXPERT / 128, NTM = CAP / 128;
    for (int it = bid; it < BATCH * N_EXPERTS * NTM * NTN; it += nblk) {
        const int nt = it % NTN, mt = (it / NTN) % NTM, be = it / (NTN * NTM), e = be % N_EXPERTS;
        const float* wg = p.w_gate + (size_t)e * D_MODEL * D_EXPERT; const float* wu = p.w_up + (size_t)e * D_MODEL * D_EXPERT;
        gemm_tile<2>(smem, U2b, D_MODEL, IDX + (size_t)be * CAP, mt * 128, wg, wu, D_EXPERT, nt * 128, D_MODEL, [&](int ml, int nl, f32x4 g, f32x4 u) {
            U2 o; o.x = pk2(siluf_(g[0]) * u[0], siluf_(g[1]) * u[1]); o.y = pk2(siluf_(g[2]) * u[2], siluf_(g[3]) * u[3]);
            *(U2*)(HID + ((size_t)be * CAP + mt * 128 + ml) * D_EXPERT + nt * 128 + nl) = o;
        });
    }
}
__device__ void phaseN(const Params& p, int bid, int nblk, char* smem) {
    const bf16_t* HID = WSP(bf16_t, WS_R1); const int* IDX = WSP(int, WS_IDX); const float* GATE = WSP(float, WS_GATE);
    float* YFFN = WSP(float, WS_R2);
    constexpr int NTN = D_MODEL / 128, NTM = CAP / 128;
    for (int it = bid; it < BATCH * N_EXPERTS * NTM * NTN; it += nblk) {
        const int nt = it % NTN, mt = (it / NTN) % NTM, be = it / (NTN * NTM), e = be % N_EXPERTS;
        const float* wd = p.w_down + (size_t)e * D_EXPERT * D_MODEL;
        gemm_tile<1>(smem, HID + (size_t)be * CAP * D_EXPERT, D_EXPERT, nullptr, mt * 128, wd, nullptr, D_MODEL, nt * 128, D_EXPERT, [&](int ml, int nl, f32x4 v, f32x4) {
            const int slot = mt * 128 + ml;
            const float gt = GATE[(size_t)be * CAP + slot];
            float* dst = YFFN + (size_t)IDX[(size_t)be * CAP + slot] * D_MODEL + nt * 128 + nl;
            atomicAdd(dst + 0, gt * v[0]); atomicAdd(dst + 1, gt * v[1]); atomicAdd(dst + 2, gt * v[2]); atomicAdd(dst + 3, gt * v[3]);
        });
    }
}
__device__ void phaseO(const Params& p, int bid, int nblk, char* smem) {
    const int lane = threadIdx.x & 63, wave = threadIdx.x >> 6;
    const float* MOD = WSP(float, WS_MOD); const float* H1 = WSP(float, WS_R5); const float* YFFN = WSP(float, WS_R2);
    for (int row = bid * 4 + wave; row < MLAT; row += nblk * 4) {
        const float* md = MOD + (size_t)(row / SEQ) * 6 * D_MODEL;
        F4 v[NV]; float s = 0.f;
#pragma unroll
        for (int j = 0; j < NV; ++j) {
            const int k = j * 256 + lane * 4;
            const F4 h = *(const F4*)(H1 + (size_t)row * D_MODEL + k), y = *(const F4*)(YFFN + (size_t)row * D_MODEL + k), gt = *(const F4*)(md + 5 * D_MODEL + k);
            v[j].x = ALPHA_F * h.x + gt.x * y.x; v[j].y = ALPHA_F * h.y + gt.y * y.y; v[j].z = ALPHA_F * h.z + gt.z * y.z; v[j].w = ALPHA_F * h.w + gt.w * y.w;
            s += (v[j].x + v[j].y) + (v[j].z + v[j].w);
        }
        const float mu = wave_sum(s) * (1.0f / D_MODEL);
        float s2 = 0.f;
#pragma unroll
        for (int j = 0; j < NV; ++j) { v[j].x -= mu; v[j].y -= mu; v[j].z -= mu; v[j].w -= mu; s2 += (v[j].x * v[j].x + v[j].y * v[j].y) + (v[j].z * v[j].z + v[j].w * v[j].w); }
        const float rstd = 1.0f / sqrtf(wave_sum(s2) * (1.0f / D_MODEL) + LN_EPS);
#pragma unroll
        for (int j = 0; j < NV; ++j) {
            const int k = j * 256 + lane * 4;
            const F4 g = *(const F4*)(p.ln2_g + k), bb = *(const F4*)(p.ln2_b + k);
            F4 o; o.x = v[j].x * rstd * g.x + bb.x; o.y = v[j].y * rstd * g.y + bb.y; o.z = v[j].z * rstd * g.z + bb.z; o.w = v[j].w * rstd * g.w + bb.w;
            *(F4*)(p.out + (size_t)row * D_MODEL + k) = o;
        }
    }
}

#define PHASE_KERNEL(NAME) \
    __global__ void __launch_bounds__(256) k_##NAME(Params p) { __shared__ __attribute__((aligned(16))) char smem[SMEM_BYTES]; NAME(p, blockIdx.x, gridDim.x, smem); }
PHASE_KERNEL(phaseA) PHASE_KERNEL(phaseB) PHASE_KERNEL(phaseC) PHASE_KERNEL(phaseD) PHASE_KERNEL(phaseF) PHASE_KERNEL(phaseH) PHASE_KERNEL(phaseI)
PHASE_KERNEL(phaseJ) PHASE_KERNEL(phaseK) PHASE_KERNEL(phaseL) PHASE_KERNEL(phaseM) PHASE_KERNEL(phaseN) PHASE_KERNEL(phaseO)

#ifdef HOST_EMU
void emu_hook(const char* name, const Params& p);
#define LAUNCH(NAME, grid) do { EMU_LAUNCH(k_##NAME, grid, 256, p); emu_hook(#NAME, p); } while (0)
#else
#define LAUNCH(NAME, grid) hipLaunchKernelGGL(k_##NAME, dim3(grid), dim3(256), 0, stream, p)
#endif

extern "C" void kernel_launch(void* const* d_in, const int* in_sizes, int n_in, void* d_out, int out_size, void* d_ws, size_t ws_size, hipStream_t stream) {
    if (n_in != 38 || out_size != MLAT * D_MODEL || ws_size < WS_END) { fprintf(stderr, "kernel_launch: unexpected shapes (n_in %d out %d ws %zu need %zu)\n", n_in, out_size, ws_size, (size_t)WS_END); return; }
    Params p{};
    const float** f = (const float**)&p;
    for (int i = 0; i < 38; ++i) f[i] = (const float*)d_in[i];
    p.out = (float*)d_out; p.ws = (unsigned char*)d_ws;
    const int G = 512;
    LAUNCH(phaseA, 6 * D_MODEL / 64);
    LAUNCH(phaseB, G);
    LAUNCH(phaseC, G);
    LAUNCH(phaseD, G);
    LAUNCH(phaseF, NLCH < G ? NLCH : G);
    LAUNCH(phaseH, BATCH * HEADS * 2);
    LAUNCH(phaseI, G);
    LAUNCH(phaseJ, G);
    LAUNCH(phaseK, G);
    LAUNCH(phaseL, BATCH * N_EXPERTS);
    LAUNCH(phaseM, G);
    LAUNCH(phaseN, G);
    LAUNCH(phaseO, G);
}
```

```cpp
#ifndef HOST_EMU
#include <hip/hip_runtime.h>
#include <cstdio>
#endif
#include <cstdint>
#include <cstddef>

#ifdef CFG_SMALL
constexpr int D_MODEL = 256, BATCH = 2, SEQ = 256, GRID_W = 16, CTX_LEN = 64, LRU_BLOCKS = 2, N_EXPERTS = 4, D_EXPERT = 256;
#else
constexpr int D_MODEL = 1024, BATCH = 4, SEQ = 4096, GRID_W = 64, CTX_LEN = 256, LRU_BLOCKS = 8, N_EXPERTS = 16, D_EXPERT = 1408;
#endif
constexpr int ROWS = SEQ / GRID_W;
constexpr int D_LRU = D_MODEL / 2, LRU_BLOCK = 64;
constexpr int D_RWKV = D_MODEL / 2, HEADS = D_RWKV / 64;
constexpr int D_RWKV_IN = 3 * D_RWKV + 128 + 128 + 128;
constexpr int D_IN = 2 * D_LRU + D_RWKV_IN;
constexpr int D_MIX = D_LRU + D_RWKV;
constexpr int CAP = 2 * SEQ / N_EXPERTS;
constexpr int MLAT = BATCH * SEQ, MCTX = BATCH * CTX_LEN, MTOT = MLAT + MCTX;
constexpr int NMOD = BATCH + 1;
constexpr int RW0 = 2 * D_LRU;
constexpr float ALPHA_F = 1.189207115002721f;
constexpr float LN_EPS = 1e-5f, GN_EPS = 64e-5f, RMS_EPS = 1e-6f;
static_assert(LRU_BLOCKS * LRU_BLOCK == D_LRU, "lru blocks");
static_assert(CAP % 128 == 0 && D_IN % 128 == 0 && D_EXPERT % 64 == 0 && D_MODEL % 128 == 0 && MTOT % 128 == 0, "tile divisibility");

typedef unsigned short bf16_t;
typedef short bf16x8 __attribute__((ext_vector_type(8)));
typedef float f32x4 __attribute__((ext_vector_type(4)));
typedef unsigned u32x4 __attribute__((ext_vector_type(4)));
struct alignas(16) F4 { float x, y, z, w; };
struct alignas(8) U2 { unsigned x, y; };
struct alignas(16) U4 { unsigned x, y, z, w; };

#ifdef HOST_EMU
#define MFMA16(a, b, c) emu_mfma_16x16x32_bf16(a, b, c)
#else
#define MFMA16(a, b, c) __builtin_amdgcn_mfma_f32_16x16x32_bf16(a, b, c, 0, 0, 0)
#endif

__device__ __forceinline__ unsigned fbits(float f) { return __builtin_bit_cast(unsigned, f); }
__device__ __forceinline__ float bitsf(unsigned u) { return __builtin_bit_cast(float, u); }
__device__ __forceinline__ bf16_t f2bf(float f) { unsigned u = fbits(f); u += 0x7FFFu + ((u >> 16) & 1u); return (bf16_t)(u >> 16); }
__device__ __forceinline__ float bf2f(bf16_t h) { return bitsf(((unsigned)h) << 16); }
__device__ __forceinline__ unsigned pk2(float lo, float hi) { return (unsigned)f2bf(lo) | ((unsigned)f2bf(hi) << 16); }
__device__ __forceinline__ float sigmoidf_(float x) { return 1.0f / (1.0f + expf(-x)); }
__device__ __forceinline__ float siluf_(float x) { return x * sigmoidf_(x); }
__device__ __forceinline__ float softplusf_(float x) { return fmaxf(x, 0.0f) + log1pf(expf(-fabsf(x))); }
__device__ __forceinline__ float geluf_(float x) { return 0.5f * x * (1.0f + tanhf(0.7978845608028654f * (x + 0.044715f * x * x * x))); }
__device__ __forceinline__ float wave_sum(float v) {
#pragma unroll
    for (int o = 1; o < 64; o <<= 1) v += __shfl_xor(v, o);
    return v;
}

constexpr size_t al256(size_t x) { return (x + 255) & ~(size_t)255; }
constexpr int NLCH = BATCH * (SEQ / 64), NCCH = BATCH * (CTX_LEN / 64), NCH = NLCH + NCCH;
constexpr size_t WS_CTRL = 0;
constexpr size_t WS_MOD = 65536;
constexpr size_t WS_STATS = al256(WS_MOD + (size_t)NMOD * 6 * D_MODEL * 4);
constexpr size_t WS_SUMA = al256(WS_STATS + (size_t)MTOT * 2 * 4);
constexpr size_t WS_SUMH = al256(WS_SUMA + (size_t)2 * NCH * D_LRU * 4);
constexpr size_t WS_BON = al256(WS_SUMH + (size_t)2 * NCH * D_LRU * 4);
constexpr size_t WS_AFF = al256(WS_BON + (size_t)2 * MLAT * HEADS * 4);
constexpr size_t WS_IDX = al256(WS_AFF + (size_t)MLAT * N_EXPERTS * 4);
constexpr size_t WS_GATE = al256(WS_IDX + (size_t)BATCH * N_EXPERTS * CAP * 4);
constexpr size_t WS_R1 = al256(WS_GATE + (size_t)BATCH * N_EXPERTS * CAP * 4);
constexpr size_t R1_BYTES = (size_t)MTOT * D_IN * 2 > (size_t)MLAT * D_MODEL * 4 ? ((size_t)MTOT * D_IN * 2 > (size_t)BATCH * N_EXPERTS * CAP * D_EXPERT * 2 ? (size_t)MTOT * D_IN * 2 : (size_t)BATCH * N_EXPERTS * CAP * D_EXPERT * 2)
                                                                                  : ((size_t)MLAT * D_MODEL * 4 > (size_t)BATCH * N_EXPERTS * CAP * D_EXPERT * 2 ? (size_t)MLAT * D_MODEL * 4 : (size_t)BATCH * N_EXPERTS * CAP * D_EXPERT * 2);
constexpr size_t WS_R2 = al256(WS_R1 + R1_BYTES);
constexpr size_t WS_R3 = al256(WS_R2 + (size_t)MLAT * D_MODEL * 4);
constexpr size_t WS_R5 = al256(WS_R3 + (size_t)MTOT * D_MODEL * 2);
constexpr size_t WS_R6 = al256(WS_R5 + (size_t)MLAT * D_MODEL * 4);
constexpr size_t WS_END = al256(WS_R6 + (size_t)MLAT * D_MODEL * 2);

struct Params {
    const float *x, *c, *ctx, *c_ctx, *ln_in_g, *ln_in_b, *w_mod, *b_mod, *w_in, *lru_conv_w, *lru_conv_b, *lru_wa, *lru_ba, *lru_wx, *lru_bx, *lru_lam, *lru_norm_g,
        *mu_prev, *mu_next, *w0, *w2, *a0, *a2, *g2, *k_k, *k_a, *r_k, *gn_g, *gn_b, *w_out, *ln1_g, *ln1_b, *w_router, *w_gate, *w_up, *w_down, *ln2_g, *ln2_b;
    float* out;
    unsigned char* ws;
};
#define WSP(T, off) ((T*)(p.ws + (off)))

constexpr int SMEM_BYTES = 76 * 1024;

__device__ void phaseA(const Params& p, int bid, int nblk, char* smem) {
    float* sc = (float*)smem;
    float* red = sc + NMOD * D_MODEL;
    const int tid = threadIdx.x;
    for (int i = tid; i < NMOD * D_MODEL; i += 256) {
        const int r = i / D_MODEL, k = i % D_MODEL;
        const float v = (r < BATCH) ? p.c[r * D_MODEL + k] : p.c_ctx[k];
        sc[i] = siluf_(v);
    }
    __syncthreads();
    float* MOD = WSP(float, WS_MOD);
    const int col = tid & 63, kg = tid >> 6;
    for (int cb = bid; cb < 6 * D_MODEL / 64; cb += nblk) {
        const int n = cb * 64 + col;
        float acc[NMOD];
#pragma unroll
        for (int r = 0; r < NMOD; ++r) acc[r] = 0.f;
        for (int k = kg; k < D_MODEL; k += 4) {
            const float w = p.w_mod[(size_t)k * (6 * D_MODEL) + n];
#pragma unroll
            for (int r = 0; r < NMOD; ++r) acc[r] += sc[r * D_MODEL + k] * w;
        }
#pragma unroll
        for (int r = 0; r < NMOD; ++r) red[(kg * NMOD + r) * 64 + col] = acc[r];
        __syncthreads();
        if (kg == 0) {
#pragma unroll
            for (int r = 0; r < NMOD; ++r) {
                float s = p.b_mod[n];
                for (int g = 0; g < 4; ++g) s += red[(g * NMOD + r) * 64 + col];
                MOD[(size_t)r * 6 * D_MODEL + n] = s;
            }
        }
        __syncthreads();
    }
}

constexpr int NV = D_MODEL / 256;
__device__ __forceinline__ f32x4 ld4(const float* p) { return *(const f32x4*)p; }
__device__ __forceinline__ float hsum4(f32x4 v) { return (v[0] + v[1]) + (v[2] + v[3]); }
__device__ __forceinline__ U2 pack4(f32x4 v) { U2 o; o.x = pk2(v[0], v[1]); o.y = pk2(v[2], v[3]); return o; }
__device__ void phaseB(const Params& p, int bid, int nblk, char* smem) {
    const int lane = threadIdx.x & 63, wave = threadIdx.x >> 6;
    const float* MOD = WSP(float, WS_MOD);
    float* STATS = WSP(float, WS_STATS);
    bf16_t* U = WSP(bf16_t, WS_R3);
    for (int row = bid * 4 + wave; row < MTOT; row += nblk * 4) {
        const float* xr = (row < MLAT) ? p.x + (size_t)row * D_MODEL : p.ctx + (size_t)(row - MLAT) * D_MODEL;
        const int mr = (row < MLAT) ? row / SEQ : BATCH;
        const float* md = MOD + (size_t)mr * 6 * D_MODEL;
        f32x4 v0, v1, v2, v3; float s = 0.f;
        v0 = ld4(xr + lane * 4); s += hsum4(v0);
        if (NV > 1) { v1 = ld4(xr + 256 + lane * 4); s += hsum4(v1); } else v1 = f32x4{0.f, 0.f, 0.f, 0.f};
        if (NV > 2) { v2 = ld4(xr + 512 + lane * 4); v3 = ld4(xr + 768 + lane * 4); s += hsum4(v2) + hsum4(v3); } else { v2 = v1; v3 = v1; }
        const float mu = wave_sum(s) * (1.0f / D_MODEL);
        v0 -= mu; float s2 = hsum4(v0 * v0);
        if (NV > 1) { v1 -= mu; s2 += hsum4(v1 * v1); }
        if (NV > 2) { v2 -= mu; v3 -= mu; s2 += hsum4(v2 * v2) + hsum4(v3 * v3); }
        const float rstd = 1.0f / sqrtf(wave_sum(s2) * (1.0f / D_MODEL) + LN_EPS);
        if (lane == 0) { STATS[row * 2] = mu; STATS[row * 2 + 1] = rstd; }
#pragma unroll
        for (int j = 0; j < NV; ++j) {
            const int k = j * 256 + lane * 4;
            const f32x4 vv = (j == 0) ? v0 : (j == 1) ? v1 : (j == 2) ? v2 : v3;
            const f32x4 h = vv * rstd * ld4(p.ln_in_g + k) + ld4(p.ln_in_b + k);
            *(U2*)(U + (size_t)row * D_MODEL + k) = pack4(h * (1.0f + ld4(md + D_MODEL + k)) + ld4(md + k));
        }
    }
}

constexpr int LDK = 72;
template <bool DUAL, class Epi>
__device__ __forceinline__ void gemm_tile(char* smem, const bf16_t* A, int lda, const int* rowidx, int m0, const float* B0, const float* B1, int ldb, int n0, int K, Epi epi) {
    bf16_t* As = (bf16_t*)smem;
    bf16_t* Bs = As + 128 * LDK;
    const int tid = threadIdx.x, lane = tid & 63, wave = tid >> 6, wr = wave >> 1, wc = wave & 1;
    const int arow = tid >> 1, ahalf = tid & 1;
    const size_t agrow = rowidx ? (size_t)rowidx[m0 + arow] : (size_t)(m0 + arow);
    const bf16_t* aptr = A + agrow * lda + ahalf * 32;
    const int bn4 = tid & 31, bkg = tid >> 5;
    const float* bptr;
    if (DUAL) { const int ct = bn4 * 4, blk = ct >> 5; bptr = ((blk & 1) ? B1 : B0) + (size_t)(bkg * 8) * ldb + n0 + (blk >> 1) * 32 + (ct & 31); }
    else bptr = B0 + (size_t)(bkg * 8) * ldb + n0 + bn4 * 4;
    u32x4 ar[4]; f32x4 br[8];
    f32x4 acc[4][4];
#pragma unroll
    for (int i = 0; i < 4; ++i)
#pragma unroll
        for (int j = 0; j < 4; ++j) acc[i][j] = f32x4{0.f, 0.f, 0.f, 0.f};
    const int nk = K / 64;
#pragma unroll
    for (int j = 0; j < 4; ++j) ar[j] = *(const u32x4*)(aptr + j * 8);
#pragma unroll
    for (int j = 0; j < 8; ++j) br[j] = *(const f32x4*)(bptr + (size_t)j * ldb);
    for (int kt = 0; kt < nk; ++kt) {
        __syncthreads();
#pragma unroll
        for (int j = 0; j < 4; ++j) *(u32x4*)(As + arow * LDK + ahalf * 32 + j * 8) = ar[j];
#pragma unroll
        for (int c = 0; c < 4; ++c) {
            u32x4 o;
            o[0] = pk2(br[0][c], br[1][c]); o[1] = pk2(br[2][c], br[3][c]); o[2] = pk2(br[4][c], br[5][c]); o[3] = pk2(br[6][c], br[7][c]);
            *(u32x4*)(Bs + (bn4 * 4 + c) * LDK + bkg * 8) = o;
        }
        __syncthreads();
        if (kt + 1 < nk) {
            const int ko = (kt + 1) * 64;
#pragma unroll
            for (int j = 0; j < 4; ++j) ar[j] = *(const u32x4*)(aptr + ko + j * 8);
#pragma unroll
            for (int j = 0; j < 8; ++j) br[j] = *(const f32x4*)(bptr + (size_t)(ko + j) * ldb);
        }
#pragma unroll
        for (int ks = 0; ks < 2; ++ks) {
            bf16x8 af[4];
#pragma unroll
            for (int mi = 0; mi < 4; ++mi) af[mi] = *(const bf16x8*)(As + (wr * 64 + mi * 16 + (lane & 15)) * LDK + ks * 32 + 8 * (lane >> 4));
#pragma unroll
            for (int ni = 0; ni < 4; ++ni) {
                const bf16x8 bfr = *(const bf16x8*)(Bs + (wc * 64 + ni * 16 + (lane & 15)) * LDK + ks * 32 + 8 * (lane >> 4));
#pragma unroll
                for (int mi = 0; mi < 4; ++mi) acc[mi][ni] = MFMA16(bfr, af[mi], acc[mi][ni]);
            }
        }
    }
#pragma unroll
    for (int mi = 0; mi < 4; ++mi) {
        const int ml = wr * 64 + mi * 16 + (lane & 15);
        if (DUAL) {
#pragma unroll
            for (int ni = 0; ni < 2; ++ni) epi(ml, wc * 32 + ni * 16 + (lane >> 4) * 4, acc[mi][ni], acc[mi][ni + 2]);
        } else {
#pragma unroll
            for (int ni = 0; ni < 4; ++ni) epi(ml, wc * 64 + ni * 16 + (lane >> 4) * 4, acc[mi][ni], acc[mi][ni]);
        }
    }
    __syncthreads();
}

__device__ void phaseC(const Params& p, int bid, int nblk, char* smem) {
    const bf16_t* U = WSP(bf16_t, WS_R3);
    bf16_t* P = WSP(bf16_t, WS_R1);
    constexpr int NTN = D_IN / 128, NTM = MTOT / 128;
    for (int it = bid; it < NTN * NTM; it += nblk) {
        const int mt = it / NTN, nt = it % NTN;
        gemm_tile<false>(smem, U, D_MODEL, nullptr, mt * 128, p.w_in, nullptr, D_IN, nt * 128, D_MODEL, [&](int ml, int nl, f32x4 v, f32x4) {
            U2 o; o.x = pk2(v[0], v[1]); o.y = pk2(v[2], v[3]);
            *(U2*)(P + (size_t)(mt * 128 + ml) * D_IN + nt * 128 + nl) = o;
        });
    }
}

struct SeqChunk { int base_row; int t0; int len; };
__device__ __forceinline__ SeqChunk lru_chunk(int cg) {
    SeqChunk s;
    if (cg < NLCH) { const int b = cg / (SEQ / 64), ck = cg % (SEQ / 64); s.base_row = b * SEQ; s.t0 = ck * 64; s.len = SEQ; }
    else { const int c2 = cg - NLCH; const int b = c2 / (CTX_LEN / 64), ck = c2 % (CTX_LEN / 64); s.base_row = MLAT + b * CTX_LEN; s.t0 = ck * 64; s.len = CTX_LEN; }
    return s;
}
constexpr int LRU_XL = 0;
constexpr int LRU_W = 16384;
constexpr int LRU_A = LRU_W + 8704;
constexpr int LRU_B = LRU_A + 16384;
constexpr int LRU_X = LRU_B + 16384;
__device__ __forceinline__ void lru_conv(const Params& p, char* smem, const SeqChunk& sc, int cb) {
    const bf16_t* P = WSP(bf16_t, WS_R1);
    float* xl = (float*)(smem + LRU_XL); bf16_t* xin = (bf16_t*)(smem + LRU_W);
    const int tid = threadIdx.x;
    for (int i = tid; i < 67 * 64; i += 256) {
        const int tt = i >> 6, c = i & 63, t = sc.t0 - 1 + tt;
        xin[i] = (t >= 0 && t < sc.len) ? P[(size_t)(sc.base_row + t) * D_IN + cb * 64 + c] : (bf16_t)0;
    }
    __syncthreads();
    for (int i = tid; i < 64 * 64; i += 256) {
        const int c = i & 63, ch = cb * 64 + c;
        xl[i] = p.lru_conv_b[ch] + bf2f(xin[i]) * p.lru_conv_w[ch] + bf2f(xin[i + 64]) * p.lru_conv_w[D_LRU + ch] + bf2f(xin[i + 128]) * p.lru_conv_w[2 * D_LRU + ch] + bf2f(xin[i + 192]) * p.lru_conv_w[3 * D_LRU + ch];
    }
    __syncthreads();
}
__device__ __forceinline__ void lru_gates(const Params& p, char* smem, int cb, int d) {
    float* xl = (float*)(smem + LRU_XL); bf16_t* W = (bf16_t*)(smem + LRU_W); float* Aa = (float*)(smem + LRU_A); float* Bb = (float*)(smem + LRU_B);
    const int tid = threadIdx.x, tt = tid >> 2, jq = tid & 3;
    float rg[16];
    for (int which = 0; which < 2; ++which) {
        const float* Wg = (which == 0 ? p.lru_wa : p.lru_wx) + ((size_t)(d * LRU_BLOCKS + cb)) * 64 * 64;
        const float* bias = (which == 0 ? p.lru_ba : p.lru_bx) + d * D_LRU + cb * 64;
        __syncthreads();
        for (int i = tid; i < 64 * 64; i += 256) W[i] = f2bf(Wg[i]);
        __syncthreads();
        float acc[16];
#pragma unroll
        for (int j = 0; j < 16; ++j) acc[j] = bias[jq * 16 + j];
        for (int i = 0; i < 64; ++i) {
            const float xv = xl[tt * 64 + i];
#pragma unroll
            for (int j = 0; j < 16; ++j) acc[j] += xv * bf2f(W[i * 64 + jq * 16 + j]);
        }
        if (which == 0) {
#pragma unroll
            for (int j = 0; j < 16; ++j) rg[j] = sigmoidf_(acc[j]);
        } else {
#pragma unroll
            for (int j = 0; j < 16; ++j) {
                const int c = jq * 16 + j;
                const float ig = sigmoidf_(acc[j]);
                const float sp = softplusf_(-p.lru_lam[d * D_LRU + cb * 64 + c]);
                const float la = -8.0f * rg[j] * sp;
                Aa[tt * 64 + c] = expf(la);
                Bb[tt * 64 + c] = sqrtf(-expm1f(2.0f * la)) * ig * xl[tt * 64 + c];
            }
        }
    }
    __syncthreads();
}

__device__ void phaseD(const Params& p, int bid, int nblk, char* smem) {
    float* SUMA = WSP(float, WS_SUMA); float* SUMH = WSP(float, WS_SUMH);
    float* Aa = (float*)(smem + LRU_A); float* Bb = (float*)(smem + LRU_B);
    const int tid = threadIdx.x;
    for (int it = bid; it < NCH * LRU_BLOCKS; it += nblk) {
        const int cg = it / LRU_BLOCKS, cb = it % LRU_BLOCKS;
        const SeqChunk sc = lru_chunk(cg);
        lru_conv(p, smem, sc, cb);
        for (int d = 0; d < 2; ++d) {
            lru_gates(p, smem, cb, d);
            if (tid < 64) {
                float ap = 1.f, h = 0.f;
                for (int s = 0; s < 64; ++s) { const int t = d ? 63 - s : s; const float a = Aa[t * 64 + tid]; h = a * h + Bb[t * 64 + tid]; ap *= a; }
                SUMA[((size_t)d * NCH + cg) * D_LRU + cb * 64 + tid] = ap;
                SUMH[((size_t)d * NCH + cg) * D_LRU + cb * 64 + tid] = h;
            }
            __syncthreads();
        }
    }
}

__device__ void phaseF(const Params& p, int bid, int nblk, char* smem) {
    const float* SUMA = WSP(float, WS_SUMA); const float* SUMH = WSP(float, WS_SUMH);
    const bf16_t* P = WSP(bf16_t, WS_R1);
    float* LRUV = WSP(float, WS_R5);
    bf16_t* MIX = WSP(bf16_t, WS_R3);
    float* Aa = (float*)(smem + LRU_A); float* Bb = (float*)(smem + LRU_B);
    float* carry = (float*)(smem + LRU_X);
    float* ssq = carry + 128;
    float* hs = (float*)(smem + LRU_X + 1024);
    const int tid = threadIdx.x;
    constexpr int NLB = SEQ / 64, NCB = CTX_LEN / 64;
    for (int cg = bid; cg < NLCH; cg += nblk) {
        const int b = cg / NLB, ck = cg % NLB;
        const SeqChunk sc = lru_chunk(cg);
        if (tid < 64) ssq[tid] = 0.f;
        for (int cb = 0; cb < LRU_BLOCKS; ++cb) {
            __syncthreads();
            if (tid < 128) {
                const int d = tid >> 6, c = cb * 64 + (tid & 63);
                float h = 0.f;
                const float* sa = SUMA + (size_t)d * NCH * D_LRU + c; const float* sh = SUMH + (size_t)d * NCH * D_LRU + c;
                if (d == 0) {
                    for (int q = 0; q < NCB; ++q) { const int g = NLCH + b * NCB + q; h = sa[(size_t)g * D_LRU] * h + sh[(size_t)g * D_LRU]; }
                    for (int q = 0; q < ck; ++q) { const int g = b * NLB + q; h = sa[(size_t)g * D_LRU] * h + sh[(size_t)g * D_LRU]; }
                } else {
                    for (int q = NCB - 1; q >= 0; --q) { const int g = NLCH + b * NCB + q; h = sa[(size_t)g * D_LRU] * h + sh[(size_t)g * D_LRU]; }
                    for (int q = NLB - 1; q > ck; --q) { const int g = b * NLB + q; h = sa[(size_t)g * D_LRU] * h + sh[(size_t)g * D_LRU]; }
                }
                carry[tid] = h;
            }
            lru_conv(p, smem, sc, cb);
            for (int d = 0; d < 2; ++d) {
                lru_gates(p, smem, cb, d);
                if (tid < 64) {
                    float h = carry[d * 64 + tid];
                    for (int s = 0; s < 64; ++s) {
                        const int t = d ? 63 - s : s;
                        h = Aa[t * 64 + tid] * h + Bb[t * 64 + tid];
                        if (d == 0) hs[t * 64 + tid] = h; else hs[t * 64 + tid] += h;
                    }
                }
                __syncthreads();
            }
            {
                const int tt = tid >> 2, jq = tid & 3;
                float s2 = 0.f;
                const size_t row = (size_t)(sc.base_row + sc.t0 + tt);
#pragma unroll
                for (int j = 0; j < 16; ++j) {
                    const int c = jq * 16 + j;
                    const float gt = bf2f(P[row * D_IN + D_LRU + cb * 64 + c]);
                    const float v = hs[tt * 64 + c] * geluf_(gt);
                    LRUV[row * D_LRU + cb * 64 + c] = v;
                    s2 += v * v;
                }
                s2 += __shfl_xor(s2, 1); s2 += __shfl_xor(s2, 2);
                if (jq == 0) ssq[tt] += s2;
            }
        }
        __syncthreads();
        for (int i = tid; i < 64 * (D_LRU / 4); i += 256) {
            const int tt = i / (D_LRU / 4), c4 = (i % (D_LRU / 4)) * 4;
            const size_t row = (size_t)(sc.base_row + sc.t0 + tt);
            const float rs = 1.0f / sqrtf(ssq[tt] * (1.0f / D_LRU) + RMS_EPS);
            const F4 v = *(const F4*)(LRUV + row * D_LRU + c4); const F4 g = *(const F4*)(p.lru_norm_g + c4);
            U2 o; o.x = pk2(v.x * rs * g.x, v.y * rs * g.y); o.y = pk2(v.z * rs * g.z, v.w * rs * g.w);
            *(U2*)(MIX + row * D_MIX + c4) = o;
        }
        __syncthreads();
    }
}

constexpr int RCH = 16;
__device__ __forceinline__ size_t rwkv_row(int seg, int b, int s) {
    if (seg == 0) return (size_t)(MLAT + b * CTX_LEN + s);
    const int r = s % ROWS, c = s / ROWS;
    return (size_t)(b * SEQ + r * GRID_W + c);
}
__device__ void phaseH(const Params& p, int bid, int nblk, char* smem) {
    const bf16_t* P = WSP(bf16_t, WS_R1);
    float* YR = WSP(float, WS_R2);
    float* BON = WSP(float, WS_BON);
    float* Z = (float*)smem;
    float* ZS = Z + (RCH + 2) * 320;
    float* SV = ZS + RCH * 320;
    float* YB = SV + RCH * 6 * 64;
    const int tid = threadIdx.x;
    for (int chain = bid; chain < BATCH * HEADS * 2; chain += nblk) {
        const int d = chain & 1, h = (chain >> 1) % HEADS, b = chain / (2 * HEADS);
        float st[16];
#pragma unroll
        for (int j = 0; j < 16; ++j) st[j] = 0.f;
        const int si = tid >> 2, sq = tid & 3;
        for (int seg = 0; seg < 2; ++seg) {
            const int len = seg == 0 ? CTX_LEN : SEQ;
            for (int cc = 0; cc < len / RCH; ++cc) {
                const int s_lo = (d == 0 ? cc : (len / RCH - 1 - cc)) * RCH;
                __syncthreads();
                for (int i = tid; i < (RCH + 2) * 320; i += 256) {
                    const int tt = i / 320, c = i % 320, s = s_lo - 1 + tt;
                    const int grp = c >> 6, j = c & 63;
                    const int ch = (grp < 3) ? grp * D_RWKV + h * 64 + j : (grp == 3 ? 3 * D_RWKV + d * 64 + j : 3 * D_RWKV + 128 + d * 64 + j);
                    Z[i] = (s >= 0 && s < len) ? bf2f(P[rwkv_row(seg, b, s) * D_IN + RW0 + ch]) : 0.f;
                }
                __syncthreads();
                for (int i = tid; i < RCH * 320; i += 256) {
                    const int tt = i / 320, c = i % 320;
                    const int grp = c >> 6, j = c & 63;
                    const int ch = (grp < 3) ? grp * D_RWKV + h * 64 + j : (grp == 3 ? 3 * D_RWKV + d * 64 + j : 3 * D_RWKV + 128 + d * 64 + j);
                    const float z = Z[(tt + 1) * 320 + c];
                    float v = z + p.mu_prev[ch] * (Z[tt * 320 + c] - z) + p.mu_next[ch] * (Z[(tt + 2) * 320 + c] - z);
                    if (grp == 3) v = tanhf(v);
                    ZS[i] = v;
                }
                __syncthreads();
                {
                    const int tt = tid >> 4, jg = tid & 15;
                    float wl[4], il[4];
#pragma unroll
                    for (int j = 0; j < 4; ++j) { wl[j] = p.w0[d * D_RWKV + h * 64 + jg * 4 + j]; il[j] = p.a0[d * D_RWKV + h * 64 + jg * 4 + j]; }
                    const float* w2p = p.w2 + (size_t)d * 64 * D_RWKV + h * 64 + jg * 4;
                    const float* a2p = p.a2 + (size_t)d * 64 * D_RWKV + h * 64 + jg * 4;
                    for (int i = 0; i < 64; ++i) {
                        const float tw = ZS[tt * 320 + 192 + i], ta = ZS[tt * 320 + 256 + i];
                        const F4 w2v = *(const F4*)(w2p + (size_t)i * D_RWKV), a2v = *(const F4*)(a2p + (size_t)i * D_RWKV);
                        wl[0] += tw * w2v.x; wl[1] += tw * w2v.y; wl[2] += tw * w2v.z; wl[3] += tw * w2v.w;
                        il[0] += ta * a2v.x; il[1] += ta * a2v.y; il[2] += ta * a2v.z; il[3] += ta * a2v.w;
                    }
                    float kkv[4], n2 = 0.f, bon = 0.f;
#pragma unroll
                    for (int j = 0; j < 4; ++j) {
                        const int jj = jg * 4 + j, ch = h * 64 + jj;
                        const float rr = ZS[tt * 320 + jj], kr = ZS[tt * 320 + 64 + jj], vr = ZS[tt * 320 + 128 + jj];
                        const float wlog = -softplusf_(-wl[j]) - 0.5f;
                        const float wdec = expf(-expf(wlog));
                        const float ic = sigmoidf_(il[j]);
                        const float kd = kr * (1.0f + (ic - 1.0f) * p.k_a[ch]);
                        kkv[j] = kr * p.k_k[ch];
                        n2 += kkv[j] * kkv[j];
                        bon += rr * kd * p.r_k[ch];
                        SV[(tt * 6 + 0) * 64 + jj] = rr; SV[(tt * 6 + 1) * 64 + jj] = wdec; SV[(tt * 6 + 2) * 64 + jj] = kd; SV[(tt * 6 + 3) * 64 + jj] = vr;
                        il[j] = ic;
                    }
#pragma unroll
                    for (int o = 1; o < 16; o <<= 1) { n2 += __shfl_xor(n2, o); bon += __shfl_xor(bon, o); }
                    const float inv = 1.0f / fmaxf(sqrtf(n2), 1e-12f);
#pragma unroll
                    for (int j = 0; j < 4; ++j) { const int jj = jg * 4 + j; const float kn = kkv[j] * inv; SV[(tt * 6 + 4) * 64 + jj] = kn; SV[(tt * 6 + 5) * 64 + jj] = kn * il[j]; }
                    if (seg == 1 && jg == 0) BON[((size_t)d * MLAT + (size_t)b * SEQ + s_lo + tt) * HEADS + h] = bon;
                }
                __syncthreads();
                for (int q = 0; q < RCH; ++q) {
                    const int tt = d ? RCH - 1 - q : q;
                    const float* sv = SV + tt * 6 * 64 + sq * 16;
                    float sa = 0.f;
#pragma unroll
                    for (int j = 0; j < 16; ++j) sa += st[j] * sv[4 * 64 + j];
                    sa += __shfl_xor(sa, 1); sa += __shfl_xor(sa, 2);
                    const float vi = SV[(tt * 6 + 3) * 64 + si];
                    float y = 0.f;
#pragma unroll
                    for (int j = 0; j < 16; ++j) {
                        st[j] = st[j] * sv[1 * 64 + j] - sa * sv[5 * 64 + j] + vi * sv[2 * 64 + j];
                        y += st[j] * sv[j];
                    }
                    y += __shfl_xor(y, 1); y += __shfl_xor(y, 2);
                    if (sq == 0) YB[tt * 64 + si] = y;
                }
                __syncthreads();
                if (seg == 1) {
                    for (int i = tid; i < RCH * 64; i += 256) {
                        const int tt = i >> 6, j = i & 63;
                        YR[((size_t)d * MLAT + (size_t)b * SEQ + s_lo + tt) * D_RWKV + h * 64 + j] = YB[i];
                    }
                }
            }
        }
    }
}

constexpr int ICH = 16;
__device__ void phaseI(const Params& p, int bid, int nblk, char* smem) {
    const bf16_t* P = WSP(bf16_t, WS_R1);
    const float* YR = WSP(float, WS_R2);
    const float* BON = WSP(float, WS_BON);
    bf16_t* MIX = WSP(bf16_t, WS_R3);
    float* ZG = (float*)smem;
    float* SG = ZG + (ICH + 2) * 128;
    const int tid = threadIdx.x, lane = tid & 63;
    for (int it = bid; it < MLAT / ICH; it += nblk) {
        const int b = it / (SEQ / ICH), n0 = (it % (SEQ / ICH)) * ICH;
        __syncthreads();
        for (int i = tid; i < (ICH + 2) * 128; i += 256) {
            const int tt = i >> 7, c = i & 127, s = n0 - 1 + tt;
            ZG[i] = (s >= 0 && s < SEQ) ? bf2f(P[rwkv_row(1, b, s) * D_IN + RW0 + 3 * D_RWKV + 256 + c]) : 0.f;
        }
        __syncthreads();
        for (int i = tid; i < ICH * 128; i += 256) {
            const int tt = i >> 7, c = i & 127, ch = 3 * D_RWKV + 256 + c;
            const float z = ZG[(tt + 1) * 128 + c];
            SG[i] = sigmoidf_(z + p.mu_prev[ch] * (ZG[tt * 128 + c] - z) + p.mu_next[ch] * (ZG[(tt + 2) * 128 + c] - z));
        }
        __syncthreads();
        for (int c = tid; c < D_RWKV; c += 256) {
            const int hh = c >> 6;
            float g[ICH];
#pragma unroll
            for (int t = 0; t < ICH; ++t) g[t] = 0.f;
            for (int i = 0; i < 128; ++i) {
                const float w = p.g2[(size_t)i * D_RWKV + c];
#pragma unroll
                for (int t = 0; t < ICH; ++t) g[t] += SG[t * 128 + i] * w;
            }
            const float gng = p.gn_g[c], gnb = p.gn_b[c];
            const int chv = 2 * D_RWKV + c;
            const float mp = p.mu_prev[chv], mn = p.mu_next[chv];
#pragma unroll
            for (int t = 0; t < ICH; ++t) {
                const int s = n0 + t;
                const size_t mrow = rwkv_row(1, b, s);
                const float z = bf2f(P[mrow * D_IN + RW0 + chv]);
                const float zp = (s > 0) ? bf2f(P[rwkv_row(1, b, s - 1) * D_IN + RW0 + chv]) : 0.f;
                const float zn = (s < SEQ - 1) ? bf2f(P[rwkv_row(1, b, s + 1) * D_IN + RW0 + chv]) : 0.f;
                const float v = z + mp * (zp - z) + mn * (zn - z);
                const size_t yi = ((size_t)b * SEQ + s) * D_RWKV + c;
                const float y = YR[yi] + YR[(size_t)MLAT * D_RWKV + yi];
                const float mu = wave_sum(y) * (1.0f / 64.0f);
                const float dv = y - mu;
                const float var = wave_sum(dv * dv) * (1.0f / 64.0f);
                const float yn = dv * (1.0f / sqrtf(var + GN_EPS)) * gng + gnb;
                const size_t bi = ((size_t)b * SEQ + s) * HEADS + hh;
                const float bonus = (BON[bi] + BON[(size_t)MLAT * HEADS + bi]) * v;
                MIX[mrow * D_MIX + D_LRU + c] = f2bf((yn + bonus) * g[t]);
            }
        }
    }
}

__device__ void phaseJ(const Params& p, int bid, int nblk, char* smem) {
    const bf16_t* MIX = WSP(bf16_t, WS_R3);
    float* YOUT = WSP(float, WS_R1);
    constexpr int NTN = D_MODEL / 128, NTM = MLAT / 128;
    for (int it = bid; it < NTN * NTM; it += nblk) {
        const int mt = it / NTN, nt = it % NTN;
        gemm_tile<false>(smem, MIX, D_MIX, nullptr, mt * 128, p.w_out, nullptr, D_MODEL, nt * 128, D_MIX, [&](int ml, int nl, f32x4 v, f32x4) {
            F4 o; o.x = v[0]; o.y = v[1]; o.z = v[2]; o.w = v[3];
            *(F4*)(YOUT + (size_t)(mt * 128 + ml) * D_MODEL + nt * 128 + nl) = o;
        });
    }
}

__device__ void phaseK(const Params& p, int bid, int nblk, char* smem) {
    const int lane = threadIdx.x & 63, wave = threadIdx.x >> 6;
    const float* MOD = WSP(float, WS_MOD); const float* STATS = WSP(float, WS_STATS);
    const float* YOUT = WSP(float, WS_R1);
    float* H1 = WSP(float, WS_R5); bf16_t* U2b = WSP(bf16_t, WS_R6); float* AFF = WSP(float, WS_AFF); float* YFFN = WSP(float, WS_R2);
    for (int row = bid * 4 + wave; row < MLAT; row += nblk * 4) {
        const float* xr = p.x + (size_t)row * D_MODEL;
        const float* md = MOD + (size_t)(row / SEQ) * 6 * D_MODEL;
        const float mu0 = STATS[row * 2], rs0 = STATS[row * 2 + 1];
        f32x4 v0, v1, v2, v3; float s = 0.f;
#define PK_LOAD(V, J) { const int k = (J) * 256 + lane * 4; \
            V = ALPHA_F * ((ld4(xr + k) - mu0) * rs0 * ld4(p.ln_in_g + k) + ld4(p.ln_in_b + k)) + ld4(md + 2 * D_MODEL + k) * ld4(YOUT + (size_t)row * D_MODEL + k); s += hsum4(V); }
        PK_LOAD(v0, 0)
        if (NV > 1) PK_LOAD(v1, 1) else v1 = f32x4{0.f, 0.f, 0.f, 0.f};
        if (NV > 2) { PK_LOAD(v2, 2) PK_LOAD(v3, 3) } else { v2 = v1; v3 = v1; }
#undef PK_LOAD
        const float mu = wave_sum(s) * (1.0f / D_MODEL);
        v0 -= mu; float s2 = hsum4(v0 * v0);
        if (NV > 1) { v1 -= mu; s2 += hsum4(v1 * v1); }
        if (NV > 2) { v2 -= mu; v3 -= mu; s2 += hsum4(v2 * v2) + hsum4(v3 * v3); }
        const float rstd = 1.0f / sqrtf(wave_sum(s2) * (1.0f / D_MODEL) + LN_EPS);
        float lg[N_EXPERTS];
#pragma unroll
        for (int e = 0; e < N_EXPERTS; ++e) lg[e] = 0.f;
#pragma unroll
        for (int j = 0; j < NV; ++j) {
            const int k = j * 256 + lane * 4;
            const f32x4 vv = (j == 0) ? v0 : (j == 1) ? v1 : (j == 2) ? v2 : v3;
            const f32x4 h = vv * rstd * ld4(p.ln1_g + k) + ld4(p.ln1_b + k);
            *(f32x4*)(H1 + (size_t)row * D_MODEL + k) = h;
            const f32x4 u = h * (1.0f + ld4(md + 4 * D_MODEL + k)) + ld4(md + 3 * D_MODEL + k);
            *(U2*)(U2b + (size_t)row * D_MODEL + k) = pack4(u);
            *(f32x4*)(YFFN + (size_t)row * D_MODEL + k) = f32x4{0.f, 0.f, 0.f, 0.f};
#pragma unroll
            for (int q = 0; q < 4; ++q) {
                const float* wr = p.w_router + (size_t)(k + q) * N_EXPERTS;
#pragma unroll
                for (int e4 = 0; e4 < N_EXPERTS / 4; ++e4) {
                    const f32x4 w = ld4(wr + e4 * 4);
                    lg[e4 * 4 + 0] += u[q] * w[0]; lg[e4 * 4 + 1] += u[q] * w[1]; lg[e4 * 4 + 2] += u[q] * w[2]; lg[e4 * 4 + 3] += u[q] * w[3];
                }
            }
        }
        float mx = -3.0e38f;
#pragma unroll
        for (int e = 0; e < N_EXPERTS; ++e) { lg[e] = wave_sum(lg[e]); mx = fmaxf(mx, lg[e]); }
        float den = 0.f;
#pragma unroll
        for (int e = 0; e < N_EXPERTS; ++e) { lg[e] = expf(lg[e] - mx); den += lg[e]; }
        float mine = 0.f;
#pragma unroll
        for (int e = 0; e < N_EXPERTS; ++e) mine = (lane == e) ? lg[e] : mine;
        if (lane < N_EXPERTS) AFF[(size_t)row * N_EXPERTS + lane] = mine / den;
    }
}

__device__ __forceinline__ int block_sum_int(int v, int* red) {
    const int lane = threadIdx.x & 63, wave = threadIdx.x >> 6;
#pragma unroll
    for (int o = 1; o < 64; o <<= 1) v += __shfl_xor(v, o);
    __syncthreads();
    if (lane == 0) red[wave] = v;
    __syncthreads();
    return red[0] + red[1] + red[2] + red[3];
}
__device__ void phaseL(const Params& p, int bid, int nblk, char* smem) {
    const float* AFF = WSP(float, WS_AFF);
    int* IDX = WSP(int, WS_IDX); float* GATE = WSP(float, WS_GATE);
    unsigned* vals = (unsigned*)smem;
    int* red = (int*)(vals + SEQ);
    int* wsum = red + 8;
    const int tid = threadIdx.x, lane = tid & 63, wave = tid >> 6;
    constexpr int PER = SEQ / 256;
    for (int be = bid; be < BATCH * N_EXPERTS; be += nblk) {
        const int b = be / N_EXPERTS, e = be % N_EXPERTS;
        __syncthreads();
        for (int t = tid; t < SEQ; t += 256) vals[t] = fbits(AFF[((size_t)b * SEQ + t) * N_EXPERTS + e]);
        __syncthreads();
        unsigned lo = 0u, hi = 0x7F800000u;
        while (lo < hi) {
            const unsigned mid = lo + (hi - lo + 1u) / 2u;
            int c = 0;
            for (int t = tid; t < SEQ; t += 256) c += (vals[t] >= mid) ? 1 : 0;
            c = block_sum_int(c, red);
            if (c >= CAP) lo = mid; else hi = mid - 1u;
        }
        const unsigned T = lo;
        int cg = 0, ce = 0;
        for (int q = 0; q < PER; ++q) { const unsigned v = vals[tid * PER + q]; cg += (v > T) ? 1 : 0; ce += (v == T) ? 1 : 0; }
        int pg = cg, pe = ce;
#pragma unroll
        for (int o = 1; o < 64; o <<= 1) { const int a = __shfl_up(pg, o), bb = __shfl_up(pe, o); if (lane >= o) { pg += a; pe += bb; } }
        __syncthreads();
        if (lane == 63) { wsum[wave] = pg; wsum[4 + wave] = pe; }
        __syncthreads();
        int og = 0, oe = 0, totg = 0;
        for (int w = 0; w < 4; ++w) { if (w < wave) { og += wsum[w]; oe += wsum[4 + w]; } totg += wsum[w]; }
        int posg = og + pg - cg, pose = oe + pe - ce;
        const int need_eq = CAP - totg;
        for (int q = 0; q < PER; ++q) {
            const int t = tid * PER + q; const unsigned v = vals[t];
            int slot = -1;
            if (v > T) { slot = posg++; }
            else if (v == T) { if (pose < need_eq) slot = totg + pose; pose++; }
            if (slot >= 0) { IDX[(size_t)be * CAP + slot] = b * SEQ + t; GATE[(size_t)be * CAP + slot] = bitsf(v); }
        }
    }
}

__device__ void phaseM(const Params& p, int bid, int nblk, char* smem) {
    const bf16_t* U2b = WSP(bf16_t, WS_R6); const int* IDX = WSP(int, WS_IDX);
    bf16_t* HID = WSP(bf16_t, WS_R1);
    constexpr int NTN = D_EXPERT / 64, NTM = CAP / 128;
    for (int it = bid; it < BATCH * N_EXPERTS * NTM * NTN; it += nblk) {
        const int nt = it % NTN, mt = (it / NTN) % NTM, be = it / (NTN * NTM), e = be % N_EXPERTS;
        const float* wg = p.w_gate + (size_t)e * D_MODEL * D_EXPERT; const float* wu = p.w_up + (size_t)e * D_MODEL * D_EXPERT;
        gemm_tile<true>(smem, U2b, D_MODEL, IDX + (size_t)be * CAP, mt * 128, wg, wu, D_EXPERT, nt * 64, D_MODEL, [&](int ml, int nl, f32x4 g, f32x4 u) {
            U2 o; o.x = pk2(siluf_(g[0]) * u[0], siluf_(g[1]) * u[1]); o.y = pk2(siluf_(g[2]) * u[2], siluf_(g[3]) * u[3]);
            *(U2*)(HID + ((size_t)be * CAP + mt * 128 + ml) * D_EXPERT + nt * 64 + nl) = o;
        });
    }
}
__device__ void phaseN(const Params& p, int bid, int nblk, char* smem) {
    const bf16_t* HID = WSP(bf16_t, WS_R1); const int* IDX = WSP(int, WS_IDX); const float* GATE = WSP(float, WS_GATE);
    float* YFFN = WSP(float, WS_R2);
    constexpr int NTN = D_MODEL / 128, NTM = CAP / 128;
    for (int it = bid; it < BATCH * N_EXPERTS * NTM * NTN; it += nblk) {
        const int nt = it % NTN, mt = (it / NTN) % NTM, be = it / (NTN * NTM), e = be % N_EXPERTS;
        const float* wd = p.w_down + (size_t)e * D_EXPERT * D_MODEL;
        gemm_tile<false>(smem, HID + (size_t)be * CAP * D_EXPERT, D_EXPERT, nullptr, mt * 128, wd, nullptr, D_MODEL, nt * 128, D_EXPERT, [&](int ml, int nl, f32x4 v, f32x4) {
            const int slot = mt * 128 + ml;
            const float gt = GATE[(size_t)be * CAP + slot];
            float* dst = YFFN + (size_t)IDX[(size_t)be * CAP + slot] * D_MODEL + nt * 128 + nl;
            atomicAdd(dst + 0, gt * v[0]); atomicAdd(dst + 1, gt * v[1]); atomicAdd(dst + 2, gt * v[2]); atomicAdd(dst + 3, gt * v[3]);
        });
    }
}
__device__ void phaseO(const Params& p, int bid, int nblk, char* smem) {
    const int lane = threadIdx.x & 63, wave = threadIdx.x >> 6;
    const float* MOD = WSP(float, WS_MOD); const float* H1 = WSP(float, WS_R5); const float* YFFN = WSP(float, WS_R2);
    for (int row = bid * 4 + wave; row < MLAT; row += nblk * 4) {
        const float* md = MOD + (size_t)(row / SEQ) * 6 * D_MODEL;
        f32x4 v0, v1, v2, v3; float s = 0.f;
#define PO_LOAD(V, J) { const int k = (J) * 256 + lane * 4; V = ALPHA_F * ld4(H1 + (size_t)row * D_MODEL + k) + ld4(md + 5 * D_MODEL + k) * ld4(YFFN + (size_t)row * D_MODEL + k); s += hsum4(V); }
        PO_LOAD(v0, 0)
        if (NV > 1) PO_LOAD(v1, 1) else v1 = f32x4{0.f, 0.f, 0.f, 0.f};
        if (NV > 2) { PO_LOAD(v2, 2) PO_LOAD(v3, 3) } else { v2 = v1; v3 = v1; }
#undef PO_LOAD
        const float mu = wave_sum(s) * (1.0f / D_MODEL);
        v0 -= mu; float s2 = hsum4(v0 * v0);
        if (NV > 1) { v1 -= mu; s2 += hsum4(v1 * v1); }
        if (NV > 2) { v2 -= mu; v3 -= mu; s2 += hsum4(v2 * v2) + hsum4(v3 * v3); }
        const float rstd = 1.0f / sqrtf(wave_sum(s2) * (1.0f / D_MODEL) + LN_EPS);
#pragma unroll
        for (int j = 0; j < NV; ++j) {
            const int k = j * 256 + lane * 4;
            const f32x4 vv = (j == 0) ? v0 : (j == 1) ? v1 : (j == 2) ? v2 : v3;
            *(f32x4*)(p.out + (size_t)row * D_MODEL + k) = vv * rstd * ld4(p.ln2_g + k) + ld4(p.ln2_b + k);
        }
    }
}

#define XB_TMO      128
#define XB_XCNT(j)  (256  + 64 * (j))
#define XB_XSUB(j)  (1280 + 64 * (j))
#define XB_XGEN(j)  (2304 + 64 * (j))
#define XB_TOP      3328
#define XB_TOPGEN   3392
#define XCD_BAR_WORDS 3456
#define XB_SPIN_CAP (1u << 22)
#ifndef HOST_EMU
__device__ __forceinline__ unsigned xb_ld(unsigned* p) { return __hip_atomic_load(p, __ATOMIC_RELAXED, __HIP_MEMORY_SCOPE_AGENT); }
__device__ __forceinline__ unsigned xb_add(unsigned* p, unsigned v) { return __hip_atomic_fetch_add(p, v, __ATOMIC_RELAXED, __HIP_MEMORY_SCOPE_AGENT); }
__device__ __forceinline__ unsigned xb_xcc_id() { return (unsigned)__builtin_amdgcn_s_getreg((3 << 11) | 20) & 0xFu; }
#define XB_SPIN(cond, bar) do { unsigned _sp = 0; while (cond) { __builtin_amdgcn_s_sleep(1); \
    if ((++_sp & 255u) == 0u) { if (xb_ld(&(bar)[XB_TMO])) break; if (_sp > XB_SPIN_CAP) { atomicAdd(&(bar)[XB_TMO], 1u); break; } } } } while (0)
struct XcdBarrier { unsigned* bar; unsigned x; unsigned* st; };
__device__ __forceinline__ XcdBarrier xcd_barrier_post(unsigned* bar, unsigned* st) {
    XcdBarrier b; b.bar = bar; b.x = xb_xcc_id(); b.st = st;
    if (threadIdx.x == 0) (void)xb_add(&bar[XB_XCNT(b.x)], 1u);
    return b;
}
__device__ __forceinline__ void xcd_barrier_complete(unsigned* bar, unsigned x, unsigned& nloc, unsigned& nx) {
    const unsigned G = gridDim.x;
    unsigned sum, cnt, mine, sp = 0u;
    for (;;) {
        sum = 0u; cnt = 0u; mine = 0u;
#pragma unroll
        for (unsigned j = 0; j < 16; ++j) { const unsigned c = xb_ld(&bar[XB_XCNT(j)]); sum += c; cnt += (c > 0u) ? 1u : 0u; mine = (j == x) ? c : mine; }
        if (sum == G) break;
        __builtin_amdgcn_s_sleep(1);
        if ((++sp & 255u) == 0u) { if (xb_ld(&bar[XB_TMO])) break; if (sp > XB_SPIN_CAP) { atomicAdd(&bar[XB_TMO], 1u); break; } }
    }
    nloc = mine > 0u ? mine : 1u; nx = cnt > 0u ? cnt : 1u;
}
__device__ __forceinline__ void grid_barrier(const XcdBarrier& b) {
    asm volatile("s_waitcnt vmcnt(0)" ::: "memory");
    __syncthreads();
    if (threadIdx.x == 0) {
        unsigned* bar = b.bar;
        __builtin_amdgcn_s_waitcnt(0);
        volatile unsigned* st = b.st;
        unsigned nloc = st[0], nx = st[1];
        if (nloc == 0u) { xcd_barrier_complete(bar, b.x, nloc, nx); st[0] = nloc; st[1] = nx; }
        const unsigned old = xb_add(&bar[XB_XSUB(b.x)], 1u);
        const unsigned gen = old / nloc;
        if (old + 1u == (gen + 1u) * nloc) {
            __builtin_amdgcn_fence(__ATOMIC_RELEASE, "agent");
            asm volatile("s_waitcnt vmcnt(0)" ::: "memory");
            const unsigned og = xb_add(&bar[XB_TOP], 1u);
            const unsigned tg = og / nx;
            if (og + 1u == (tg + 1u) * nx) xb_add(&bar[XB_TOPGEN], 1u);
            else XB_SPIN(xb_ld(&bar[XB_TOPGEN]) == tg, bar);
            __builtin_amdgcn_fence(__ATOMIC_ACQUIRE, "agent");
            xb_add(&bar[XB_XGEN(b.x)], 1u);
            asm volatile("s_waitcnt vmcnt(0)" ::: "memory");
        } else {
            XB_SPIN(xb_ld(&bar[XB_XGEN(b.x)]) == gen, bar);
            __builtin_amdgcn_fence(__ATOMIC_ACQUIRE, "agent");
            asm volatile("s_waitcnt vmcnt(0)" ::: "memory");
        }
    }
    __syncthreads();
}
#else
struct XcdBarrier { int dummy; };
__device__ __forceinline__ XcdBarrier xcd_barrier_post(unsigned*, unsigned*) { return XcdBarrier{0}; }
__device__ __forceinline__ void grid_barrier(const XcdBarrier&) { __syncthreads(); }
#endif

__global__ void __launch_bounds__(256, 2) fused_forward(Params p) {
    __shared__ __attribute__((aligned(16))) char smem[SMEM_BYTES];
    __shared__ __attribute__((aligned(16))) unsigned xb_words[4];
    if (threadIdx.x == 0) { xb_words[0] = 0u; xb_words[1] = 0u; xb_words[2] = 0u; xb_words[3] = 0u; }
    __syncthreads();
    const XcdBarrier gb = xcd_barrier_post(WSP(unsigned, WS_CTRL), xb_words);
    const int bid = blockIdx.x, nblk = gridDim.x;
    phaseA(p, bid, nblk, smem); grid_barrier(gb);
    phaseB(p, bid, nblk, smem); grid_barrier(gb);
    phaseC(p, bid, nblk, smem); grid_barrier(gb);
    phaseD(p, bid, nblk, smem); grid_barrier(gb);
    phaseF(p, bid, nblk, smem); grid_barrier(gb);
    phaseH(p, bid, nblk, smem); grid_barrier(gb);
    phaseI(p, bid, nblk, smem); grid_barrier(gb);
    phaseJ(p, bid, nblk, smem); grid_barrier(gb);
    phaseK(p, bid, nblk, smem); grid_barrier(gb);
    phaseL(p, bid, nblk, smem); grid_barrier(gb);
    phaseM(p, bid, nblk, smem); grid_barrier(gb);
    phaseN(p, bid, nblk, smem); grid_barrier(gb);
    phaseO(p, bid, nblk, smem);
}

#ifdef MULTI_LAUNCH
#define PHASE_KERNEL(NAME) \
    __global__ void __launch_bounds__(256) k_##NAME(Params p) { __shared__ __attribute__((aligned(16))) char smem[SMEM_BYTES]; NAME(p, blockIdx.x, gridDim.x, smem); }
PHASE_KERNEL(phaseA) PHASE_KERNEL(phaseB) PHASE_KERNEL(phaseC) PHASE_KERNEL(phaseD) PHASE_KERNEL(phaseF) PHASE_KERNEL(phaseH) PHASE_KERNEL(phaseI)
PHASE_KERNEL(phaseJ) PHASE_KERNEL(phaseK) PHASE_KERNEL(phaseL) PHASE_KERNEL(phaseM) PHASE_KERNEL(phaseN) PHASE_KERNEL(phaseO)
#ifdef HOST_EMU
void emu_hook(const char* name, const Params& p);
#define LAUNCH(NAME, grid) do { EMU_LAUNCH(k_##NAME, grid, 256, p); emu_hook(#NAME, p); } while (0)
#else
#define LAUNCH(NAME, grid) hipLaunchKernelGGL(k_##NAME, dim3(grid), dim3(256), 0, stream, p)
#endif
#endif

extern "C" void kernel_launch(void* const* d_in, const int* in_sizes, int n_in, void* d_out, int out_size, void* d_ws, size_t ws_size, hipStream_t stream) {
    if (n_in != 38 || out_size != MLAT * D_MODEL || ws_size < WS_END) { fprintf(stderr, "kernel_launch: unexpected shapes (n_in %d out %d ws %zu need %zu)\n", n_in, out_size, ws_size, (size_t)WS_END); return; }
    Params p{};
    const float** f = (const float**)&p;
    for (int i = 0; i < 38; ++i) f[i] = (const float*)d_in[i];
    p.out = (float*)d_out; p.ws = (unsigned char*)d_ws;
#ifdef MULTI_LAUNCH
    const int G = 512;
    LAUNCH(phaseA, 6 * D_MODEL / 64);
    LAUNCH(phaseB, G);
    LAUNCH(phaseC, G);
    LAUNCH(phaseD, G);
    LAUNCH(phaseF, NLCH < G ? NLCH : G);
    LAUNCH(phaseH, BATCH * HEADS * 2);
    LAUNCH(phaseI, G);
    LAUNCH(phaseJ, G);
    LAUNCH(phaseK, G);
    LAUNCH(phaseL, BATCH * N_EXPERTS);
    LAUNCH(phaseM, G);
    LAUNCH(phaseN, G);
    LAUNCH(phaseO, G);
#elif defined(HOST_EMU)
    EMU_LAUNCH(fused_forward, 1, 256, p);
#else
    static int grid_blocks = 0;
    if (!grid_blocks) {
        int dev = 0, cus = 0, per_cu = 0;
        (void)hipGetDevice(&dev);
        (void)hipDeviceGetAttribute(&cus, hipDeviceAttributeMultiprocessorCount, dev);
        (void)hipOccupancyMaxActiveBlocksPerMultiprocessor(&per_cu, fused_forward, 256, 0);
        if (per_cu > 2) per_cu = 2;
        if (per_cu < 1) { fprintf(stderr, "kernel_launch: occupancy query returned %d blocks per CU\n", per_cu); per_cu = 1; }
        grid_blocks = cus * per_cu;
    }
    (void)hipMemsetAsync((char*)d_ws + WS_CTRL, 0, XCD_BAR_WORDS * 4, stream);
    void* args[] = {&p};
    hipError_t e = hipLaunchCooperativeKernel((void*)fused_forward, dim3(grid_blocks), dim3(256), args, 0, stream);
    if (e != hipSuccess) fprintf(stderr, "cooperative launch failed: %s (grid %d)\n", hipGetErrorString(e), grid_blocks);
#endif
}
```

```cpp
#ifndef HOST_EMU
#include <hip/hip_runtime.h>
#include <cstdio>
#endif
#include <cstdint>
#include <cstddef>

#ifdef CFG_SMALL
constexpr int D_MODEL = 256, BATCH = 2, SEQ = 256, GRID_W = 16, CTX_LEN = 64, LRU_BLOCKS = 2, N_EXPERTS = 4, D_EXPERT = 256;
#else
constexpr int D_MODEL = 1024, BATCH = 4, SEQ = 4096, GRID_W = 64, CTX_LEN = 256, LRU_BLOCKS = 8, N_EXPERTS = 16, D_EXPERT = 1408;
#endif
constexpr int ROWS = SEQ / GRID_W;
constexpr int D_LRU = D_MODEL / 2, LRU_BLOCK = 64;
constexpr int D_RWKV = D_MODEL / 2, HEADS = D_RWKV / 64;
constexpr int D_RWKV_IN = 3 * D_RWKV + 128 + 128 + 128;
constexpr int D_IN = 2 * D_LRU + D_RWKV_IN;
constexpr int D_MIX = D_LRU + D_RWKV;
constexpr int CAP = 2 * SEQ / N_EXPERTS;
constexpr int MLAT = BATCH * SEQ, MCTX = BATCH * CTX_LEN, MTOT = MLAT + MCTX;
constexpr int NMOD = BATCH + 1;
constexpr int RW0 = 2 * D_LRU;
constexpr float ALPHA_F = 1.189207115002721f;
constexpr float LN_EPS = 1e-5f, GN_EPS = 64e-5f, RMS_EPS = 1e-6f;
static_assert(LRU_BLOCKS * LRU_BLOCK == D_LRU, "lru blocks");
static_assert(CAP % 128 == 0 && D_IN % 128 == 0 && D_EXPERT % 64 == 0 && D_MODEL % 128 == 0 && MTOT % 128 == 0, "tile divisibility");

typedef unsigned short bf16_t;
typedef short bf16x8 __attribute__((ext_vector_type(8)));
typedef float f32x4 __attribute__((ext_vector_type(4)));
typedef unsigned u32x4 __attribute__((ext_vector_type(4)));
struct alignas(16) F4 { float x, y, z, w; };
typedef unsigned U2 __attribute__((ext_vector_type(2)));
struct alignas(16) U4 { unsigned x, y, z, w; };

#ifdef HOST_EMU
#define MFMA16(a, b, c) emu_mfma_16x16x32_bf16(a, b, c)
#else
#define MFMA16(a, b, c) __builtin_amdgcn_mfma_f32_16x16x32_bf16(a, b, c, 0, 0, 0)
#endif

__device__ __forceinline__ unsigned fbits(float f) { return __builtin_bit_cast(unsigned, f); }
__device__ __forceinline__ float bitsf(unsigned u) { return __builtin_bit_cast(float, u); }
__device__ __forceinline__ bf16_t f2bf(float f) { unsigned u = fbits(f); u += 0x7FFFu + ((u >> 16) & 1u); return (bf16_t)(u >> 16); }
__device__ __forceinline__ float bf2f(bf16_t h) { return bitsf(((unsigned)h) << 16); }
__device__ __forceinline__ unsigned pk2(float lo, float hi) { return (unsigned)f2bf(lo) | ((unsigned)f2bf(hi) << 16); }
__device__ __forceinline__ float sigmoidf_(float x) { return 1.0f / (1.0f + expf(-x)); }
__device__ __forceinline__ float siluf_(float x) { return x * sigmoidf_(x); }
__device__ __forceinline__ float softplusf_(float x) { return fmaxf(x, 0.0f) + log1pf(expf(-fabsf(x))); }
__device__ __forceinline__ float geluf_(float x) { return 0.5f * x * (1.0f + tanhf(0.7978845608028654f * (x + 0.044715f * x * x * x))); }
__device__ __forceinline__ float wave_sum(float v) {
#pragma unroll
    for (int o = 1; o < 64; o <<= 1) v += __shfl_xor(v, o);
    return v;
}

constexpr size_t al256(size_t x) { return (x + 255) & ~(size_t)255; }
constexpr int NLCH = BATCH * (SEQ / 64), NCCH = BATCH * (CTX_LEN / 64), NCH = NLCH + NCCH;
constexpr size_t WS_CTRL = 0;
constexpr size_t WS_MOD = 65536;
constexpr size_t WS_STATS = al256(WS_MOD + (size_t)NMOD * 6 * D_MODEL * 4);
constexpr size_t WS_SUMA = al256(WS_STATS + (size_t)MTOT * 2 * 4);
constexpr size_t WS_SUMH = al256(WS_SUMA + (size_t)2 * NCH * D_LRU * 4);
constexpr size_t WS_BON = al256(WS_SUMH + (size_t)2 * NCH * D_LRU * 4);
constexpr size_t WS_AFF = al256(WS_BON + (size_t)2 * MLAT * HEADS * 4 + 4096 * 64);
constexpr size_t WS_IDX = al256(WS_AFF + (size_t)MLAT * N_EXPERTS * 4);
constexpr size_t WS_GATE = al256(WS_IDX + (size_t)BATCH * N_EXPERTS * CAP * 4);
constexpr size_t WS_SLOT = al256(WS_GATE + (size_t)BATCH * N_EXPERTS * CAP * 4);
constexpr size_t WS_R1 = al256(WS_SLOT + (size_t)MLAT * N_EXPERTS * 4);
constexpr size_t R1_BYTES = (size_t)MTOT * D_IN * 2 > (size_t)MLAT * D_MODEL * 4 ? ((size_t)MTOT * D_IN * 2 > (size_t)BATCH * N_EXPERTS * CAP * D_EXPERT * 2 ? (size_t)MTOT * D_IN * 2 : (size_t)BATCH * N_EXPERTS * CAP * D_EXPERT * 2)
                                                                                  : ((size_t)MLAT * D_MODEL * 4 > (size_t)BATCH * N_EXPERTS * CAP * D_EXPERT * 2 ? (size_t)MLAT * D_MODEL * 4 : (size_t)BATCH * N_EXPERTS * CAP * D_EXPERT * 2);
constexpr size_t WS_R3 = al256(WS_R1 + R1_BYTES);
constexpr int RC = 32;
constexpr int NCC = CTX_LEN / RC, NLC = SEQ / RC, NCK = NCC + NLC, NCHAIN = BATCH * HEADS * 2;
constexpr size_t CH_PM = 0, CH_SA = 8192, CH_QT = 16384, CH_Y0 = 20480, CH_BYTES = 24576;
constexpr size_t WS_CH = al256(WS_R3 + (size_t)MTOT * D_MODEL * 2);
constexpr size_t CH_TOTAL = (size_t)NCHAIN * NCK * CH_BYTES;
constexpr size_t WS_R5 = WS_CH;
constexpr size_t WS_R2 = al256(WS_R5 + (size_t)MLAT * D_MODEL * 4);
constexpr size_t WS_R6 = al256(WS_R2 + (size_t)MLAT * D_MODEL * 4);
constexpr size_t WS_LATE_END = al256(WS_R6 + (size_t)MLAT * D_MODEL * 2);
constexpr size_t WS_END = (WS_CH + CH_TOTAL > WS_LATE_END) ? al256(WS_CH + CH_TOTAL) : WS_LATE_END;
constexpr size_t WS_RBON = WS_BON;
static_assert((size_t)NCHAIN * NCK * RC * 4 <= (size_t)2 * MLAT * HEADS * 4 + 4096 * 64, "bonus buffer");

struct Params {
    const float *x, *c, *ctx, *c_ctx, *ln_in_g, *ln_in_b, *w_mod, *b_mod, *w_in, *lru_conv_w, *lru_conv_b, *lru_wa, *lru_ba, *lru_wx, *lru_bx, *lru_lam, *lru_norm_g,
        *mu_prev, *mu_next, *w0, *w2, *a0, *a2, *g2, *k_k, *k_a, *r_k, *gn_g, *gn_b, *w_out, *ln1_g, *ln1_b, *w_router, *w_gate, *w_up, *w_down, *ln2_g, *ln2_b;
    float* out;
    unsigned char* ws;
};
#define WSP(T, off) ((T*)(p.ws + (off)))

constexpr int SMEM_BYTES = 76 * 1024;

__device__ void phaseA(const Params& p, int bid, int nblk, char* smem) {
    float* sc = (float*)smem;
    float* red = sc + NMOD * D_MODEL;
    const int tid = threadIdx.x;
    for (int i = tid; i < NMOD * D_MODEL; i += 256) {
        const int r = i / D_MODEL, k = i % D_MODEL;
        const float v = (r < BATCH) ? p.c[r * D_MODEL + k] : p.c_ctx[k];
        sc[i] = siluf_(v);
    }
    __syncthreads();
    float* MOD = WSP(float, WS_MOD);
    const int col = tid & 63, kg = tid >> 6;
    for (int cb = bid; cb < 6 * D_MODEL / 64; cb += nblk) {
        const int n = cb * 64 + col;
        float acc[NMOD];
#pragma unroll
        for (int r = 0; r < NMOD; ++r) acc[r] = 0.f;
        for (int k = kg; k < D_MODEL; k += 4) {
            const float w = p.w_mod[(size_t)k * (6 * D_MODEL) + n];
#pragma unroll
            for (int r = 0; r < NMOD; ++r) acc[r] += sc[r * D_MODEL + k] * w;
        }
#pragma unroll
        for (int r = 0; r < NMOD; ++r) red[(kg * NMOD + r) * 64 + col] = acc[r];
        __syncthreads();
        if (kg == 0) {
#pragma unroll
            for (int r = 0; r < NMOD; ++r) {
                float s = p.b_mod[n];
                for (int g = 0; g < 4; ++g) s += red[(g * NMOD + r) * 64 + col];
                MOD[(size_t)r * 6 * D_MODEL + n] = s;
            }
        }
        __syncthreads();
    }
}

constexpr int NV = D_MODEL / 256;
__device__ __forceinline__ f32x4 ld4(const float* p) { return *(const f32x4*)p; }
__device__ __forceinline__ float hsum4(f32x4 v) { return (v[0] + v[1]) + (v[2] + v[3]); }
__device__ __forceinline__ U2 pack4(f32x4 v) { U2 o; o.x = pk2(v[0], v[1]); o.y = pk2(v[2], v[3]); return o; }
__device__ void phaseB(const Params& p, int bid, int nblk, char* smem) {
    const int lane = threadIdx.x & 63, wave = threadIdx.x >> 6;
    const float* MOD = WSP(float, WS_MOD);
    float* STATS = WSP(float, WS_STATS);
    bf16_t* U = WSP(bf16_t, WS_R3);
    for (int row = bid * 4 + wave; row < MTOT; row += nblk * 4) {
        const float* xr = (row < MLAT) ? p.x + (size_t)row * D_MODEL : p.ctx + (size_t)(row - MLAT) * D_MODEL;
        const int mr = (row < MLAT) ? row / SEQ : BATCH;
        const float* md = MOD + (size_t)mr * 6 * D_MODEL;
        f32x4 v0, v1, v2, v3; float s = 0.f;
        v0 = ld4(xr + lane * 4); s += hsum4(v0);
        if (NV > 1) { v1 = ld4(xr + 256 + lane * 4); s += hsum4(v1); } else v1 = f32x4{0.f, 0.f, 0.f, 0.f};
        if (NV > 2) { v2 = ld4(xr + 512 + lane * 4); v3 = ld4(xr + 768 + lane * 4); s += hsum4(v2) + hsum4(v3); } else { v2 = v1; v3 = v1; }
        const float mu = wave_sum(s) * (1.0f / D_MODEL);
        v0 -= mu; float s2 = hsum4(v0 * v0);
        if (NV > 1) { v1 -= mu; s2 += hsum4(v1 * v1); }
        if (NV > 2) { v2 -= mu; v3 -= mu; s2 += hsum4(v2 * v2) + hsum4(v3 * v3); }
        const float rstd = 1.0f / sqrtf(wave_sum(s2) * (1.0f / D_MODEL) + LN_EPS);
        if (lane == 0) { STATS[row * 2] = mu; STATS[row * 2 + 1] = rstd; }
#pragma unroll
        for (int j = 0; j < NV; ++j) {
            const int k = j * 256 + lane * 4;
            const f32x4 vv = (j == 0) ? v0 : (j == 1) ? v1 : (j == 2) ? v2 : v3;
            const f32x4 h = vv * rstd * ld4(p.ln_in_g + k) + ld4(p.ln_in_b + k);
            *(U2*)(U + (size_t)row * D_MODEL + k) = pack4(h * (1.0f + ld4(md + D_MODEL + k)) + ld4(md + k));
        }
    }
}

constexpr int LDK = 72;
template <bool DUAL, class Epi>
__device__ __forceinline__ void gemm_tile(char* smem, const bf16_t* A, int lda, const int* rowidx, int m0, const float* B0, const float* B1, int ldb, int n0, int K, Epi epi) {
    bf16_t* As = (bf16_t*)smem;
    bf16_t* Bs = As + 128 * LDK;
    const int tid = threadIdx.x, lane = tid & 63, wave = tid >> 6, wr = wave >> 1, wc = wave & 1;
    const int arow = tid >> 1, ahalf = tid & 1;
    const size_t agrow = rowidx ? (size_t)rowidx[m0 + arow] : (size_t)(m0 + arow);
    const bf16_t* aptr = A + agrow * lda + ahalf * 32;
    const int bn4 = tid & 31, bkg = tid >> 5;
    const float* bptr;
    if (DUAL) { const int ct = bn4 * 4, blk = ct >> 5; bptr = ((blk & 1) ? B1 : B0) + (size_t)(bkg * 8) * ldb + n0 + (blk >> 1) * 32 + (ct & 31); }
    else bptr = B0 + (size_t)(bkg * 8) * ldb + n0 + bn4 * 4;
    u32x4 ar[4]; f32x4 br[8];
    f32x4 acc[4][4];
#pragma unroll
    for (int i = 0; i < 4; ++i)
#pragma unroll
        for (int j = 0; j < 4; ++j) acc[i][j] = f32x4{0.f, 0.f, 0.f, 0.f};
    const int nk = K / 64;
#pragma unroll
    for (int j = 0; j < 4; ++j) ar[j] = *(const u32x4*)(aptr + j * 8);
#pragma unroll
    for (int j = 0; j < 8; ++j) br[j] = *(const f32x4*)(bptr + (size_t)j * ldb);
    for (int kt = 0; kt < nk; ++kt) {
        __syncthreads();
#pragma unroll
        for (int j = 0; j < 4; ++j) *(u32x4*)(As + arow * LDK + ahalf * 32 + j * 8) = ar[j];
#pragma unroll
        for (int c = 0; c < 4; ++c) {
            u32x4 o;
            o[0] = pk2(br[0][c], br[1][c]); o[1] = pk2(br[2][c], br[3][c]); o[2] = pk2(br[4][c], br[5][c]); o[3] = pk2(br[6][c], br[7][c]);
            *(u32x4*)(Bs + (bn4 * 4 + c) * LDK + bkg * 8) = o;
        }
        __syncthreads();
        if (kt + 1 < nk) {
            const int ko = (kt + 1) * 64;
#pragma unroll
            for (int j = 0; j < 4; ++j) ar[j] = *(const u32x4*)(aptr + ko + j * 8);
#pragma unroll
            for (int j = 0; j < 8; ++j) br[j] = *(const f32x4*)(bptr + (size_t)(ko + j) * ldb);
        }
#pragma unroll
        for (int ks = 0; ks < 2; ++ks) {
            bf16x8 af[4];
#pragma unroll
            for (int mi = 0; mi < 4; ++mi) af[mi] = *(const bf16x8*)(As + (wr * 64 + mi * 16 + (lane & 15)) * LDK + ks * 32 + 8 * (lane >> 4));
#pragma unroll
            for (int ni = 0; ni < 4; ++ni) {
                const bf16x8 bfr = *(const bf16x8*)(Bs + (wc * 64 + ni * 16 + (lane & 15)) * LDK + ks * 32 + 8 * (lane >> 4));
#pragma unroll
                for (int mi = 0; mi < 4; ++mi) acc[mi][ni] = MFMA16(bfr, af[mi], acc[mi][ni]);
            }
        }
    }
#pragma unroll
    for (int mi = 0; mi < 4; ++mi) {
        const int ml = wr * 64 + mi * 16 + (lane & 15);
        if (DUAL) {
#pragma unroll
            for (int ni = 0; ni < 2; ++ni) epi(ml, wc * 32 + ni * 16 + (lane >> 4) * 4, acc[mi][ni], acc[mi][ni + 2]);
        } else {
#pragma unroll
            for (int ni = 0; ni < 4; ++ni) epi(ml, wc * 64 + ni * 16 + (lane >> 4) * 4, acc[mi][ni], acc[mi][ni]);
        }
    }
    __syncthreads();
}

__device__ void phaseC(const Params& p, int bid, int nblk, char* smem) {
    const bf16_t* U = WSP(bf16_t, WS_R3);
    bf16_t* P = WSP(bf16_t, WS_R1);
    constexpr int NTN = D_IN / 128, NTM = MTOT / 128;
    for (int it = bid; it < NTN * NTM; it += nblk) {
        const int mt = it / NTN, nt = it % NTN;
        gemm_tile<false>(smem, U, D_MODEL, nullptr, mt * 128, p.w_in, nullptr, D_IN, nt * 128, D_MODEL, [&](int ml, int nl, f32x4 v, f32x4) {
            U2 o; o.x = pk2(v[0], v[1]); o.y = pk2(v[2], v[3]);
            *(U2*)(P + (size_t)(mt * 128 + ml) * D_IN + nt * 128 + nl) = o;
        });
    }
}

struct SeqChunk { int base_row; int t0; int len; };
__device__ __forceinline__ SeqChunk lru_chunk(int cg) {
    SeqChunk s;
    if (cg < NLCH) { const int b = cg / (SEQ / 64), ck = cg % (SEQ / 64); s.base_row = b * SEQ; s.t0 = ck * 64; s.len = SEQ; }
    else { const int c2 = cg - NLCH; const int b = c2 / (CTX_LEN / 64), ck = c2 % (CTX_LEN / 64); s.base_row = MLAT + b * CTX_LEN; s.t0 = ck * 64; s.len = CTX_LEN; }
    return s;
}
constexpr int LRU_XL = 0;
constexpr int LRU_W = 16384;
constexpr int LRU_A = LRU_W + 8704;
constexpr int LRU_B = LRU_A + 16384;
constexpr int LRU_X = LRU_B + 16384;
__device__ __forceinline__ void lru_conv(const Params& p, char* smem, const SeqChunk& sc, int cb) {
    const bf16_t* P = WSP(bf16_t, WS_R1);
    float* xl = (float*)(smem + LRU_XL); bf16_t* xin = (bf16_t*)(smem + LRU_W);
    const int tid = threadIdx.x;
    for (int i = tid; i < 67 * 64; i += 256) {
        const int tt = i >> 6, c = i & 63, t = sc.t0 - 1 + tt;
        xin[i] = (t >= 0 && t < sc.len) ? P[(size_t)(sc.base_row + t) * D_IN + cb * 64 + c] : (bf16_t)0;
    }
    __syncthreads();
    for (int i = tid; i < 64 * 64; i += 256) {
        const int c = i & 63, ch = cb * 64 + c;
        xl[i] = p.lru_conv_b[ch] + bf2f(xin[i]) * p.lru_conv_w[ch] + bf2f(xin[i + 64]) * p.lru_conv_w[D_LRU + ch] + bf2f(xin[i + 128]) * p.lru_conv_w[2 * D_LRU + ch] + bf2f(xin[i + 192]) * p.lru_conv_w[3 * D_LRU + ch];
    }
    __syncthreads();
}
__device__ __forceinline__ void lru_gates(const Params& p, char* smem, int cb, int d) {
    float* xl = (float*)(smem + LRU_XL); bf16_t* W = (bf16_t*)(smem + LRU_W); float* Aa = (float*)(smem + LRU_A); float* Bb = (float*)(smem + LRU_B);
    const int tid = threadIdx.x, tt = tid >> 2, jq = tid & 3;
    float rg[16];
    for (int which = 0; which < 2; ++which) {
        const float* Wg = (which == 0 ? p.lru_wa : p.lru_wx) + ((size_t)(d * LRU_BLOCKS + cb)) * 64 * 64;
        const float* bias = (which == 0 ? p.lru_ba : p.lru_bx) + d * D_LRU + cb * 64;
        __syncthreads();
        for (int i = tid; i < 64 * 64; i += 256) W[i] = f2bf(Wg[i]);
        __syncthreads();
        float acc[16];
#pragma unroll
        for (int j = 0; j < 16; ++j) acc[j] = bias[jq * 16 + j];
        for (int i = 0; i < 64; ++i) {
            const float xv = xl[tt * 64 + i];
#pragma unroll
            for (int j = 0; j < 16; ++j) acc[j] += xv * bf2f(W[i * 64 + jq * 16 + j]);
        }
        if (which == 0) {
#pragma unroll
            for (int j = 0; j < 16; ++j) rg[j] = sigmoidf_(acc[j]);
        } else {
#pragma unroll
            for (int j = 0; j < 16; ++j) {
                const int c = jq * 16 + j;
                const float ig = sigmoidf_(acc[j]);
                const float sp = softplusf_(-p.lru_lam[d * D_LRU + cb * 64 + c]);
                const float la = -8.0f * rg[j] * sp;
                Aa[tt * 64 + c] = expf(la);
                Bb[tt * 64 + c] = sqrtf(-expm1f(2.0f * la)) * ig * xl[tt * 64 + c];
            }
        }
    }
    __syncthreads();
}

__device__ void phaseD(const Params& p, int bid, int nblk, char* smem) {
    float* SUMA = WSP(float, WS_SUMA); float* SUMH = WSP(float, WS_SUMH);
    float* Aa = (float*)(smem + LRU_A); float* Bb = (float*)(smem + LRU_B);
    const int tid = threadIdx.x;
    for (int it = bid; it < NCH * LRU_BLOCKS; it += nblk) {
        const int cg = it / LRU_BLOCKS, cb = it % LRU_BLOCKS;
        const SeqChunk sc = lru_chunk(cg);
        lru_conv(p, smem, sc, cb);
        for (int d = 0; d < 2; ++d) {
            lru_gates(p, smem, cb, d);
            if (tid < 64) {
                float ap = 1.f, h = 0.f;
                for (int s = 0; s < 64; ++s) { const int t = d ? 63 - s : s; const float a = Aa[t * 64 + tid]; h = a * h + Bb[t * 64 + tid]; ap *= a; }
                SUMA[((size_t)d * NCH + cg) * D_LRU + cb * 64 + tid] = ap;
                SUMH[((size_t)d * NCH + cg) * D_LRU + cb * 64 + tid] = h;
            }
            __syncthreads();
        }
    }
}

__device__ void phaseF(const Params& p, int bid, int nblk, char* smem) {
    const float* SUMA = WSP(float, WS_SUMA); const float* SUMH = WSP(float, WS_SUMH);
    const bf16_t* P = WSP(bf16_t, WS_R1);
    float* LRUV = WSP(float, WS_R5);
    bf16_t* MIX = WSP(bf16_t, WS_R3);
    float* Aa = (float*)(smem + LRU_A); float* Bb = (float*)(smem + LRU_B);
    float* carry = (float*)(smem + LRU_X);
    float* ssq = carry + 128;
    float* hs = (float*)(smem + LRU_X + 1024);
    const int tid = threadIdx.x;
    constexpr int NLB = SEQ / 64, NCB = CTX_LEN / 64;
    for (int cg = bid; cg < NLCH; cg += nblk) {
        const int b = cg / NLB, ck = cg % NLB;
        const SeqChunk sc = lru_chunk(cg);
        if (tid < 64) ssq[tid] = 0.f;
        for (int cb = 0; cb < LRU_BLOCKS; ++cb) {
            __syncthreads();
            if (tid < 128) {
                const int d = tid >> 6, c = cb * 64 + (tid & 63);
                float h = 0.f;
                const float* sa = SUMA + (size_t)d * NCH * D_LRU + c; const float* sh = SUMH + (size_t)d * NCH * D_LRU + c;
                if (d == 0) {
                    for (int q = 0; q < NCB; ++q) { const int g = NLCH + b * NCB + q; h = sa[(size_t)g * D_LRU] * h + sh[(size_t)g * D_LRU]; }
                    for (int q = 0; q < ck; ++q) { const int g = b * NLB + q; h = sa[(size_t)g * D_LRU] * h + sh[(size_t)g * D_LRU]; }
                } else {
                    for (int q = NCB - 1; q >= 0; --q) { const int g = NLCH + b * NCB + q; h = sa[(size_t)g * D_LRU] * h + sh[(size_t)g * D_LRU]; }
                    for (int q = NLB - 1; q > ck; --q) { const int g = b * NLB + q; h = sa[(size_t)g * D_LRU] * h + sh[(size_t)g * D_LRU]; }
                }
                carry[tid] = h;
            }
            lru_conv(p, smem, sc, cb);
            for (int d = 0; d < 2; ++d) {
                lru_gates(p, smem, cb, d);
                if (tid < 64) {
                    float h = carry[d * 64 + tid];
                    for (int s = 0; s < 64; ++s) {
                        const int t = d ? 63 - s : s;
                        h = Aa[t * 64 + tid] * h + Bb[t * 64 + tid];
                        if (d == 0) hs[t * 64 + tid] = h; else hs[t * 64 + tid] += h;
                    }
                }
                __syncthreads();
            }
            {
                const int tt = tid >> 2, jq = tid & 3;
                float s2 = 0.f;
                const size_t row = (size_t)(sc.base_row + sc.t0 + tt);
#pragma unroll
                for (int j = 0; j < 16; ++j) {
                    const int c = jq * 16 + j;
                    const float gt = bf2f(P[row * D_IN + D_LRU + cb * 64 + c]);
                    const float v = hs[tt * 64 + c] * geluf_(gt);
                    LRUV[row * D_LRU + cb * 64 + c] = v;
                    s2 += v * v;
                }
                s2 += __shfl_xor(s2, 1); s2 += __shfl_xor(s2, 2);
                if (jq == 0) ssq[tt] += s2;
            }
        }
        __syncthreads();
        for (int i = tid; i < 64 * (D_LRU / 4); i += 256) {
            const int tt = i / (D_LRU / 4), c4 = (i % (D_LRU / 4)) * 4;
            const size_t row = (size_t)(sc.base_row + sc.t0 + tt);
            const float rs = 1.0f / sqrtf(ssq[tt] * (1.0f / D_LRU) + RMS_EPS);
            const F4 v = *(const F4*)(LRUV + row * D_LRU + c4); const F4 g = *(const F4*)(p.lru_norm_g + c4);
            U2 o; o.x = pk2(v.x * rs * g.x, v.y * rs * g.y); o.y = pk2(v.z * rs * g.z, v.w * rs * g.w);
            *(U2*)(MIX + row * D_MIX + c4) = o;
        }
        __syncthreads();
    }
}

#ifdef HOST_EMU
#define FEXP(x) expf(x)
#else
#define FEXP(x) __expf(x)
#endif
__device__ __forceinline__ float fsigm(float x) { return 1.0f / (1.0f + FEXP(-x)); }
__device__ __forceinline__ size_t rwkv_row(int seg, int b, int s) {
    if (seg == 0) return (size_t)(MLAT + b * CTX_LEN + s);
    const int r = s % ROWS, c = s / ROWS;
    return (size_t)(b * SEQ + r * GRID_W + c);
}
__device__ __forceinline__ void chunk_info(int d, int c, int& seg, int& p0, int& len) {
    if (c < NCC) { seg = 0; len = CTX_LEN; p0 = (d == 0 ? c : NCC - 1 - c) * RC; }
    else { const int cc = c - NCC; seg = 1; len = SEQ; p0 = (d == 0 ? cc : NLC - 1 - cc) * RC; }
}
__device__ __forceinline__ void unpack8(const u32x4 v, float* o) {
    o[0] = bitsf(v[0] << 16); o[1] = bitsf(v[0] & 0xFFFF0000u); o[2] = bitsf(v[1] << 16); o[3] = bitsf(v[1] & 0xFFFF0000u);
    o[4] = bitsf(v[2] << 16); o[5] = bitsf(v[2] & 0xFFFF0000u); o[6] = bitsf(v[3] << 16); o[7] = bitsf(v[3] & 0xFFFF0000u);
}
__device__ __forceinline__ void shifted8(const Params& p, const bf16_t* P, int seg, int b, int pos, int len, int ch0, float* o) {
    float z[8], zp[8], zn[8];
    unpack8(*(const u32x4*)(P + rwkv_row(seg, b, pos) * D_IN + RW0 + ch0), z);
    if (pos > 0) unpack8(*(const u32x4*)(P + rwkv_row(seg, b, pos - 1) * D_IN + RW0 + ch0), zp); else { for (int i = 0; i < 8; ++i) zp[i] = 0.f; }
    if (pos < len - 1) unpack8(*(const u32x4*)(P + rwkv_row(seg, b, pos + 1) * D_IN + RW0 + ch0), zn); else { for (int i = 0; i < 8; ++i) zn[i] = 0.f; }
    const f32x4 mp0 = ld4(p.mu_prev + ch0), mp1 = ld4(p.mu_prev + ch0 + 4), mn0 = ld4(p.mu_next + ch0), mn1 = ld4(p.mu_next + ch0 + 4);
#pragma unroll
    for (int i = 0; i < 4; ++i) { o[i] = z[i] + mp0[i] * (zp[i] - z[i]) + mn0[i] * (zn[i] - z[i]); o[4 + i] = z[4 + i] + mp1[i] * (zp[4 + i] - z[4 + i]) + mn1[i] * (zn[4 + i] - z[4 + i]); }
}
constexpr int LT = 72, LJ = 40;
constexpr int R_RF = 0, R_KF = 8192, R_VF = 16384, R_LW = 24576, R_IC = 32768;
constexpr int R_NBA = 0;
constexpr int R_NKA = 4608, R_MBR = R_NKA + 2560, R_MKR = R_MBR + 2560;
constexpr int R_XU = R_MKR + 2560;
constexpr int R_WA = R_XU + 8448, R_U0 = R_WA + 5120;
static_assert(R_U0 + 5120 <= 40960, "rwkv scratch");
constexpr int R_O = 40960;
constexpr int R_AH = R_O, R_BH = R_AH + 4608, R_KH = R_BH + 4608, R_RH = R_KH + 4608;
constexpr int R_VT = R_RH + 4608, R_BHT = R_VT + 5120, R_KHT = R_BHT + 5120;
constexpr int R_GC = R_KHT + 5120, R_TOT = R_GC + 256, R_END = R_TOT + 1024;
constexpr int R_TW = R_O, R_TA = R_TW + 4608, R_W2T = R_TA + 4608, R_A2T = R_W2T + 9216;
static_assert(R_A2T + 9216 <= R_END && R_END <= SMEM_BYTES, "rwkv lds");

template <int NYT, int KS>
__device__ __forceinline__ void mmT(f32x4* acc, const bf16_t* X, int ldx, int xs, const bf16_t* Y, int ldy, int lane) {
#pragma unroll
    for (int ks = 0; ks < KS; ++ks) {
        const bf16x8 xf = *(const bf16x8*)(X + (xs * 16 + (lane & 15)) * ldx + ks * 32 + 8 * (lane >> 4));
#pragma unroll
        for (int nb = 0; nb < NYT; ++nb) {
            const bf16x8 yf = *(const bf16x8*)(Y + (nb * 16 + (lane & 15)) * ldy + ks * 32 + 8 * (lane >> 4));
            acc[nb] = MFMA16(xf, yf, acc[nb]);
        }
    }
}

__device__ void phaseR1(const Params& p, int bid, int nblk, char* smem) {
    const bf16_t* P = WSP(bf16_t, WS_R1);
    unsigned char* CH = p.ws + WS_CH;
    float* RBON = WSP(float, WS_RBON);
    float* Rf = (float*)(smem + R_RF); float* Kf = (float*)(smem + R_KF); float* Vf = (float*)(smem + R_VF); float* LW = (float*)(smem + R_LW); float* IC = (float*)(smem + R_IC);
    float* NbaT = (float*)(smem + R_NBA); bf16_t* NkaT = (bf16_t*)(smem + R_NKA); bf16_t* MbrT = (bf16_t*)(smem + R_MBR); bf16_t* MkrT = (bf16_t*)(smem + R_MKR);
    float* Xu = (float*)(smem + R_XU); bf16_t* Wa = (bf16_t*)(smem + R_WA); bf16_t* U0 = (bf16_t*)(smem + R_U0);
    bf16_t* Ah = (bf16_t*)(smem + R_AH); bf16_t* Bh = (bf16_t*)(smem + R_BH); bf16_t* Kh = (bf16_t*)(smem + R_KH); bf16_t* Rh = (bf16_t*)(smem + R_RH);
    bf16_t* VT = (bf16_t*)(smem + R_VT); bf16_t* BhT = (bf16_t*)(smem + R_BHT); bf16_t* KhT = (bf16_t*)(smem + R_KHT);
    float* GC = (float*)(smem + R_GC); float* TOT = (float*)(smem + R_TOT);
    bf16_t* TW = (bf16_t*)(smem + R_TW); bf16_t* TA = (bf16_t*)(smem + R_TA); bf16_t* W2T = (bf16_t*)(smem + R_W2T); bf16_t* A2T = (bf16_t*)(smem + R_A2T);
    const int tid = threadIdx.x, lane = tid & 63, wave = tid >> 6, q = lane >> 4, l15 = lane & 15;
    constexpr int NITEM = NCHAIN * NCK;
    const int per = (NITEM + nblk - 1) / nblk;
    const int it0 = bid * per, it1 = (it0 + per < NITEM) ? it0 + per : NITEM;
    for (int it = it0; it < it1; ++it) {
        const int chain = it / NCK, c = it % NCK;
        const int d = chain & 1, h = (chain >> 1) % HEADS, b = chain / (2 * HEADS);
        int seg, p0, len; chunk_info(d, c, seg, p0, len);
        unsigned char* chp = CH + (size_t)it * CH_BYTES;
        __syncthreads();
#pragma unroll 1
        for (int idx = tid; idx < RC * 40; idx += 256) {
            const int tau = idx / 40, g = idx % 40, grp = g >> 3, j0 = (g & 7) * 8;
            const int pos = p0 + (d ? RC - 1 - tau : tau);
            const int ch0 = (grp < 3) ? grp * D_RWKV + h * 64 + j0 : (grp == 3 ? 3 * D_RWKV + d * 64 + j0 : 3 * D_RWKV + 128 + d * 64 + j0);
            float o[8]; shifted8(p, P, seg, b, pos, len, ch0, o);
            if (grp < 3) {
                float* dst = (grp == 0 ? Rf : grp == 1 ? Kf : Vf) + tau * 64 + j0;
                *(f32x4*)dst = f32x4{o[0], o[1], o[2], o[3]}; *(f32x4*)(dst + 4) = f32x4{o[4], o[5], o[6], o[7]};
            } else if (grp == 3) {
                u32x4 w;
#pragma unroll
                for (int i = 0; i < 4; ++i) { const float t0 = 2.0f / (1.0f + FEXP(-2.0f * o[2 * i])) - 1.0f, t1 = 2.0f / (1.0f + FEXP(-2.0f * o[2 * i + 1])) - 1.0f; w[i] = pk2(t0, t1); }
                *(u32x4*)(TW + tau * LT + j0) = w;
            } else {
                u32x4 w; w[0] = pk2(o[0], o[1]); w[1] = pk2(o[2], o[3]); w[2] = pk2(o[4], o[5]); w[3] = pk2(o[6], o[7]);
                *(u32x4*)(TA + tau * LT + j0) = w;
            }
        }
#pragma unroll 2
        for (int idx = tid; idx < 2 * 64 * 16; idx += 256) {
            const int which = idx >> 10, i = (idx >> 4) & 63, j4 = (idx & 15) * 4;
            const f32x4 wv = ld4((which ? p.a2 : p.w2) + ((size_t)d * 64 + i) * D_RWKV + h * 64 + j4);
            bf16_t* dst = (which ? A2T : W2T) + j4 * LT + i;
            dst[0] = f2bf(wv[0]); dst[LT] = f2bf(wv[1]); dst[2 * LT] = f2bf(wv[2]); dst[3 * LT] = f2bf(wv[3]);
        }
        __syncthreads();
        {
            f32x4 aw[2] = {f32x4{0.f, 0.f, 0.f, 0.f}, f32x4{0.f, 0.f, 0.f, 0.f}}, ai[2] = {f32x4{0.f, 0.f, 0.f, 0.f}, f32x4{0.f, 0.f, 0.f, 0.f}};
            mmT<2, 2>(aw, W2T, LT, wave, TW, LT, lane);
            mmT<2, 2>(ai, A2T, LT, wave, TA, LT, lane);
            const int j = wave * 16 + q * 4;
            const f32x4 w0v = ld4(p.w0 + d * D_RWKV + h * 64 + j), a0v = ld4(p.a0 + d * D_RWKV + h * 64 + j);
#pragma unroll
            for (int nb = 0; nb < 2; ++nb) {
                const int tau = nb * 16 + l15;
                f32x4 lw, ic;
#pragma unroll
                for (int r = 0; r < 4; ++r) { lw[r] = -0.6065306597126334f * fsigm(w0v[r] + aw[nb][r]); ic[r] = fsigm(a0v[r] + ai[nb][r]); }
                *(f32x4*)(LW + tau * 64 + j) = lw; *(f32x4*)(IC + tau * 64 + j) = ic;
            }
        }
        __syncthreads();
        {
            const int j = lane, t0 = wave * 8, chj = h * 64 + j;
            const float kkc = p.k_k[chj], kac = p.k_a[chj], rkc = p.r_k[chj];
            float cum[8], kd[8], kkn[8], icv[8], rr[8], vv[8], run = 0.f;
#pragma unroll
            for (int i = 0; i < 8; ++i) {
                const int t = t0 + i;
                run += LW[t * 64 + j]; cum[i] = run;
                const float kr = Kf[t * 64 + j]; icv[i] = IC[t * 64 + j]; rr[i] = Rf[t * 64 + j]; vv[i] = Vf[t * 64 + j];
                kd[i] = kr * (1.0f + (icv[i] - 1.0f) * kac);
                const float kk = kr * kkc;
                const float n2 = wave_sum(kk * kk);
                kkn[i] = kk / fmaxf(sqrtf(n2), 1e-12f);
                const float bon = wave_sum(rr[i] * kd[i] * rkc);
                if (lane == 0) RBON[(size_t)it * RC + t] = bon;
            }
            TOT[wave * 64 + j] = run;
            __syncthreads();
            float off = 0.f;
            for (int w = 0; w < wave; ++w) off += TOT[w * 64 + j];
            u32x4 vt, bt, kt;
            float e_prev = 0.f;
#pragma unroll
            for (int i = 0; i < 8; ++i) {
                const int t = t0 + i;
                const float cu = off + cum[i], cprev = (i == 0) ? off : off + cum[i - 1];
                const float g = FEXP(cu), gi = FEXP(-cu), gm = FEXP(cprev);
                const float ah = -kkn[i] * gm, bh = kkn[i] * icv[i] * gi, kh = kd[i] * gi, rh = rr[i] * g;
                Ah[t * LT + j] = f2bf(ah); Bh[t * LT + j] = f2bf(bh); Kh[t * LT + j] = f2bf(kh); Rh[t * LT + j] = f2bf(rh);
                if (i & 1) { vt[i >> 1] = pk2(e_prev, vv[i]); bt[i >> 1] = (bt[i >> 1] & 0xFFFFu) | ((unsigned)f2bf(bh) << 16); kt[i >> 1] = (kt[i >> 1] & 0xFFFFu) | ((unsigned)f2bf(kh) << 16); }
                else { e_prev = vv[i]; bt[i >> 1] = f2bf(bh); kt[i >> 1] = f2bf(kh); }
                if (t == RC - 1) GC[j] = g;
            }
            *(u32x4*)(VT + j * LJ + t0) = vt; *(u32x4*)(BhT + j * LJ + t0) = bt; *(u32x4*)(KhT + j * LJ + t0) = kt;
        }
        __syncthreads();
        {
            const bf16_t* X = (wave & 1) ? Kh : Bh;
            const bf16_t* Y = (wave < 2) ? Ah : Rh;
#pragma unroll
            for (int xs = 0; xs < 2; ++xs) {
                f32x4 acc[2] = {f32x4{0.f, 0.f, 0.f, 0.f}, f32x4{0.f, 0.f, 0.f, 0.f}};
                mmT<2, 2>(acc, X, LT, xs, Y, LT, lane);
#pragma unroll
                for (int nb = 0; nb < 2; ++nb) {
                    const int t = nb * 16 + l15, s0 = xs * 16 + q * 4;
                    f32x4 v = acc[nb];
#pragma unroll
                    for (int r = 0; r < 4; ++r) { const int sidx = s0 + r; const bool keep = (wave < 2) ? (sidx < t) : (sidx <= t); v[r] = keep ? v[r] : 0.f; }
                    if (wave == 0) { *(f32x4*)(NbaT + t * 36 + s0) = v; }
                    else { bf16_t* dst = (wave == 1 ? NkaT : wave == 2 ? MbrT : MkrT) + t * LJ + s0; *(U2*)dst = pack4(v); }
                }
            }
        }
        __syncthreads();
        {
#pragma unroll
            for (int xs = 0; xs < 2; ++xs) {
                f32x4 acc[1] = {f32x4{0.f, 0.f, 0.f, 0.f}};
                mmT<1, 1>(acc, NkaT, LJ, xs, VT + wave * 16 * LJ, LJ, lane);
                const int i = wave * 16 + l15, tb = xs * 16 + q * 4;
                Xu[i * 33 + tb] = acc[0][0]; Xu[i * 33 + tb + 1] = acc[0][1]; Xu[i * 33 + tb + 2] = acc[0][2]; Xu[i * 33 + tb + 3] = acc[0][3];
            }
        }
        __syncthreads();
        if (tid < 128) {
            const int m = tid & 63, which = tid >> 6;
            float w[RC];
#pragma unroll
            for (int t = 0; t < RC; ++t) w[t] = 0.f;
#pragma unroll 1
            for (int t = 0; t < RC; ++t) {
                float acc = which ? Xu[m * 33 + t] : bf2f(Ah[t * LT + m]);
#pragma unroll
                for (int s4 = 0; s4 < RC / 4; ++s4) {
                    const f32x4 n = *(const f32x4*)(NbaT + t * 36 + s4 * 4);
                    acc += w[s4 * 4] * n[0] + w[s4 * 4 + 1] * n[1] + w[s4 * 4 + 2] * n[2] + w[s4 * 4 + 3] * n[3];
                }
#pragma unroll
                for (int s2 = 0; s2 < RC; ++s2) w[s2] = (s2 == t) ? acc : w[s2];
            }
            bf16_t* dst = (which ? U0 : Wa) + m * LJ;
#pragma unroll
            for (int t8 = 0; t8 < RC / 8; ++t8) {
                u32x4 o; o[0] = pk2(w[t8 * 8], w[t8 * 8 + 1]); o[1] = pk2(w[t8 * 8 + 2], w[t8 * 8 + 3]); o[2] = pk2(w[t8 * 8 + 4], w[t8 * 8 + 5]); o[3] = pk2(w[t8 * 8 + 6], w[t8 * 8 + 7]);
                *(u32x4*)(dst + t8 * 8) = o;
            }
        }
        __syncthreads();
        {
            bf16_t* gPm = (bf16_t*)(chp + CH_PM); bf16_t* gSA = (bf16_t*)(chp + CH_SA); bf16_t* gQT = (bf16_t*)(chp + CH_QT); bf16_t* gY0 = (bf16_t*)(chp + CH_Y0);
            const int x0 = wave * 16 + q * 4;
            {
                f32x4 acc[4] = {f32x4{0.f, 0.f, 0.f, 0.f}, f32x4{0.f, 0.f, 0.f, 0.f}, f32x4{0.f, 0.f, 0.f, 0.f}, f32x4{0.f, 0.f, 0.f, 0.f}};
                mmT<4, 1>(acc, Wa, LJ, wave, BhT, LJ, lane);
#pragma unroll
                for (int nb = 0; nb < 4; ++nb) {
                    const int jp = nb * 16 + l15; const float g = GC[jp];
                    f32x4 v = acc[nb];
#pragma unroll
                    for (int r = 0; r < 4; ++r) v[r] = (v[r] + ((x0 + r == jp) ? 1.0f : 0.0f)) * g;
                    *(U2*)(gPm + jp * 64 + x0) = pack4(v);
                }
            }
            {
                f32x4 acc[4] = {f32x4{0.f, 0.f, 0.f, 0.f}, f32x4{0.f, 0.f, 0.f, 0.f}, f32x4{0.f, 0.f, 0.f, 0.f}, f32x4{0.f, 0.f, 0.f, 0.f}};
                mmT<4, 1>(acc, BhT, LJ, wave, U0, LJ, lane);
                mmT<4, 1>(acc, KhT, LJ, wave, VT, LJ, lane);
                const f32x4 g = *(const f32x4*)(GC + x0);
#pragma unroll
                for (int nb = 0; nb < 4; ++nb) *(U2*)(gSA + (nb * 16 + l15) * 64 + x0) = pack4(acc[nb] * g);
            }
            if (seg == 1) {
                {
                    f32x4 acc[2] = {f32x4{0.f, 0.f, 0.f, 0.f}, f32x4{0.f, 0.f, 0.f, 0.f}};
                    mmT<2, 1>(acc, Wa, LJ, wave, MbrT, LJ, lane);
#pragma unroll
                    for (int nb = 0; nb < 2; ++nb) {
                        const int t = nb * 16 + l15;
                        f32x4 v = acc[nb];
#pragma unroll
                        for (int r = 0; r < 4; ++r) v[r] += bf2f(Rh[t * LT + x0 + r]);
                        *(U2*)(gQT + t * 64 + x0) = pack4(v);
                    }
                }
                {
                    f32x4 acc[2] = {f32x4{0.f, 0.f, 0.f, 0.f}, f32x4{0.f, 0.f, 0.f, 0.f}};
                    mmT<2, 1>(acc, U0, LJ, wave, MbrT, LJ, lane);
                    mmT<2, 1>(acc, VT, LJ, wave, MkrT, LJ, lane);
#pragma unroll
                    for (int nb = 0; nb < 2; ++nb) *(U2*)(gY0 + (nb * 16 + l15) * 64 + x0) = pack4(acc[nb]);
                }
            }
        }
    }
}

__device__ __forceinline__ U2 ldu2(const bf16_t* p) { return *(const U2*)p; }
__device__ void phaseR2(const Params& p, int bid, int nblk, char* smem) {
    unsigned char* CH = p.ws + WS_CH;
    const int lane = threadIdx.x & 63, wave = threadIdx.x >> 6, q = lane >> 4, l15 = lane & 15;
    for (int chain = bid; chain < NCHAIN; chain += nblk) {
        const int i = wave * 16 + l15;
        f32x4 st[4];
#pragma unroll
        for (int nt = 0; nt < 4; ++nt) st[nt] = f32x4{0.f, 0.f, 0.f, 0.f};
        for (int c = 0; c < NCK; ++c) {
            unsigned char* chp = CH + ((size_t)chain * NCK + c) * CH_BYTES;
            const bf16_t* gPm = (const bf16_t*)(chp + CH_PM); bf16_t* gSA = (bf16_t*)(chp + CH_SA);
            U2 af[4][2][2];
#pragma unroll
            for (int mt = 0; mt < 4; ++mt)
#pragma unroll
                for (int ks = 0; ks < 2; ++ks) { af[mt][ks][0] = ldu2(gPm + (mt * 16 + l15) * 64 + 32 * ks + 4 * q); af[mt][ks][1] = ldu2(gPm + (mt * 16 + l15) * 64 + 32 * ks + 16 + 4 * q); }
            U2 sa[4];
#pragma unroll
            for (int nt = 0; nt < 4; ++nt) sa[nt] = ldu2(gSA + i * 64 + nt * 16 + 4 * q);
            bf16x8 bfr[2];
#pragma unroll
            for (int ks = 0; ks < 2; ++ks) {
                const U2 lo = pack4(st[2 * ks]), hi = pack4(st[2 * ks + 1]);
                u32x4 t; t[0] = lo.x; t[1] = lo.y; t[2] = hi.x; t[3] = hi.y;
                bfr[ks] = __builtin_bit_cast(bf16x8, t);
                *(U2*)(gSA + i * 64 + (2 * ks) * 16 + 4 * q) = lo; *(U2*)(gSA + i * 64 + (2 * ks + 1) * 16 + 4 * q) = hi;
            }
#pragma unroll
            for (int nt = 0; nt < 4; ++nt) {
                f32x4 acc = f32x4{bitsf(sa[nt].x << 16), bitsf(sa[nt].x & 0xFFFF0000u), bitsf(sa[nt].y << 16), bitsf(sa[nt].y & 0xFFFF0000u)};
#pragma unroll
                for (int ks = 0; ks < 2; ++ks) {
                    u32x4 t; t[0] = af[nt][ks][0].x; t[1] = af[nt][ks][0].y; t[2] = af[nt][ks][1].x; t[3] = af[nt][ks][1].y;
                    acc = MFMA16(__builtin_bit_cast(bf16x8, t), bfr[ks], acc);
                }
                st[nt] = acc;
            }
        }
    }
}

__device__ void phaseR3(const Params& p, int bid, int nblk, char* smem) {
    const bf16_t* P = WSP(bf16_t, WS_R1);
    const unsigned char* CH = p.ws + WS_CH;
    const float* RBON = WSP(float, WS_RBON);
    bf16_t* MIX = WSP(bf16_t, WS_R3);
    float* red = (float*)smem;
    const int tid = threadIdx.x, lane = tid & 63, wave = tid >> 6, q = lane >> 4, l15 = lane & 15;
    for (int it = bid; it < BATCH * HEADS * NLC; it += nblk) {
        const int pc = it % NLC, h = (it / NLC) % HEADS, b = it / (NLC * HEADS);
        const int i0 = wave * 16 + q * 4;
        f32x4 y[2] = {f32x4{0.f, 0.f, 0.f, 0.f}, f32x4{0.f, 0.f, 0.f, 0.f}};
        float bon[2] = {0.f, 0.f};
#pragma unroll
        for (int d = 0; d < 2; ++d) {
            const int chain = (b * HEADS + h) * 2 + d, c = NCC + (d ? NLC - 1 - pc : pc);
            const size_t item = (size_t)chain * NCK + c;
            const unsigned char* chp = CH + item * CH_BYTES;
            const bf16_t* gS = (const bf16_t*)(chp + CH_SA); const bf16_t* gQT = (const bf16_t*)(chp + CH_QT); const bf16_t* gY0 = (const bf16_t*)(chp + CH_Y0);
#pragma unroll
            for (int nb = 0; nb < 2; ++nb) {
                const int pl = nb * 16 + l15, tau = d ? RC - 1 - pl : pl;
                const U2 y0 = ldu2(gY0 + tau * 64 + i0);
                f32x4 acc = f32x4{bitsf(y0.x << 16), bitsf(y0.x & 0xFFFF0000u), bitsf(y0.y << 16), bitsf(y0.y & 0xFFFF0000u)};
#pragma unroll
                for (int ks = 0; ks < 2; ++ks) {
                    const bf16x8 xf = *(const bf16x8*)(gS + (wave * 16 + l15) * 64 + ks * 32 + 8 * q);
                    const bf16x8 yf = *(const bf16x8*)(gQT + tau * 64 + ks * 32 + 8 * q);
                    acc = MFMA16(xf, yf, acc);
                }
                y[nb] += acc;
                bon[nb] += RBON[item * RC + tau];
            }
        }
        f32x4 g[2] = {f32x4{0.f, 0.f, 0.f, 0.f}, f32x4{0.f, 0.f, 0.f, 0.f}};
#pragma unroll
        for (int ks = 0; ks < 4; ++ks) {
            bf16x8 xf;
#pragma unroll
            for (int jj = 0; jj < 8; ++jj) xf[jj] = (short)f2bf(p.g2[(size_t)(ks * 32 + 8 * q + jj) * D_RWKV + h * 64 + wave * 16 + l15]);
#pragma unroll
            for (int nb = 0; nb < 2; ++nb) {
                const int pos = pc * RC + nb * 16 + l15;
                float o[8]; shifted8(p, P, 1, b, pos, SEQ, 3 * D_RWKV + 256 + ks * 32 + 8 * q, o);
                u32x4 t; t[0] = pk2(fsigm(o[0]), fsigm(o[1])); t[1] = pk2(fsigm(o[2]), fsigm(o[3])); t[2] = pk2(fsigm(o[4]), fsigm(o[5])); t[3] = pk2(fsigm(o[6]), fsigm(o[7]));
                g[nb] = MFMA16(xf, __builtin_bit_cast(bf16x8, t), g[nb]);
            }
        }
        float s1[2], s2[2];
#pragma unroll
        for (int nb = 0; nb < 2; ++nb) {
            float a = hsum4(y[nb]), bq = hsum4(y[nb] * y[nb]);
            a += __shfl_xor(a, 16); a += __shfl_xor(a, 32); bq += __shfl_xor(bq, 16); bq += __shfl_xor(bq, 32);
            s1[nb] = a; s2[nb] = bq;
        }
        __syncthreads();
        if (q == 0) { red[(0 * 4 + wave) * 32 + l15] = s1[0]; red[(0 * 4 + wave) * 32 + 16 + l15] = s1[1]; red[(1 * 4 + wave) * 32 + l15] = s2[0]; red[(1 * 4 + wave) * 32 + 16 + l15] = s2[1]; }
        __syncthreads();
        const f32x4 gng = ld4(p.gn_g + h * 64 + i0), gnb = ld4(p.gn_b + h * 64 + i0);
#pragma unroll
        for (int nb = 0; nb < 2; ++nb) {
            const int pl = nb * 16 + l15, pos = pc * RC + pl;
            float t1 = 0.f, t2 = 0.f;
#pragma unroll
            for (int w = 0; w < 4; ++w) { t1 += red[(0 * 4 + w) * 32 + pl]; t2 += red[(1 * 4 + w) * 32 + pl]; }
            const float mu = t1 * (1.0f / 64.0f), var = fmaxf(t2 * (1.0f / 64.0f) - mu * mu, 0.f), rstd = 1.0f / sqrtf(var + GN_EPS);
            const int chv = 2 * D_RWKV + h * 64 + i0;
            const size_t mrow = rwkv_row(1, b, pos);
            const U2 zc = ldu2(P + mrow * D_IN + RW0 + chv);
            U2 zp; zp.x = 0u; zp.y = 0u; U2 zn = zp;
            if (pos > 0) zp = ldu2(P + rwkv_row(1, b, pos - 1) * D_IN + RW0 + chv);
            if (pos < SEQ - 1) zn = ldu2(P + rwkv_row(1, b, pos + 1) * D_IN + RW0 + chv);
            const f32x4 z = f32x4{bitsf(zc.x << 16), bitsf(zc.x & 0xFFFF0000u), bitsf(zc.y << 16), bitsf(zc.y & 0xFFFF0000u)};
            const f32x4 zpv = f32x4{bitsf(zp.x << 16), bitsf(zp.x & 0xFFFF0000u), bitsf(zp.y << 16), bitsf(zp.y & 0xFFFF0000u)};
            const f32x4 znv = f32x4{bitsf(zn.x << 16), bitsf(zn.x & 0xFFFF0000u), bitsf(zn.y << 16), bitsf(zn.y & 0xFFFF0000u)};
            const f32x4 v = z + ld4(p.mu_prev + chv) * (zpv - z) + ld4(p.mu_next + chv) * (znv - z);
            const f32x4 yn = (y[nb] - mu) * rstd * gng + gnb;
            *(U2*)(MIX + mrow * D_MIX + D_LRU + h * 64 + i0) = pack4((yn + bon[nb] * v) * g[nb]);
        }
    }
}

__device__ void phaseJ(const Params& p, int bid, int nblk, char* smem) {
    const bf16_t* MIX = WSP(bf16_t, WS_R3);
    float* YOUT = WSP(float, WS_R1);
    constexpr int NTN = D_MODEL / 128, NTM = MLAT / 128;
    for (int it = bid; it < NTN * NTM; it += nblk) {
        const int mt = it / NTN, nt = it % NTN;
        gemm_tile<false>(smem, MIX, D_MIX, nullptr, mt * 128, p.w_out, nullptr, D_MODEL, nt * 128, D_MIX, [&](int ml, int nl, f32x4 v, f32x4) {
            F4 o; o.x = v[0]; o.y = v[1]; o.z = v[2]; o.w = v[3];
            *(F4*)(YOUT + (size_t)(mt * 128 + ml) * D_MODEL + nt * 128 + nl) = o;
        });
    }
}

__device__ void phaseK(const Params& p, int bid, int nblk, char* smem) {
    const int lane = threadIdx.x & 63, wave = threadIdx.x >> 6;
    const float* MOD = WSP(float, WS_MOD); const float* STATS = WSP(float, WS_STATS);
    const float* YOUT = WSP(float, WS_R1);
    float* H1 = WSP(float, WS_R5); bf16_t* U2b = WSP(bf16_t, WS_R6); float* AFF = WSP(float, WS_AFF);
    for (int row = bid * 4 + wave; row < MLAT; row += nblk * 4) {
        const float* xr = p.x + (size_t)row * D_MODEL;
        const float* md = MOD + (size_t)(row / SEQ) * 6 * D_MODEL;
        const float mu0 = STATS[row * 2], rs0 = STATS[row * 2 + 1];
        f32x4 v0, v1, v2, v3; float s = 0.f;
#define PK_LOAD(V, J) { const int k = (J) * 256 + lane * 4; \
            V = ALPHA_F * ((ld4(xr + k) - mu0) * rs0 * ld4(p.ln_in_g + k) + ld4(p.ln_in_b + k)) + ld4(md + 2 * D_MODEL + k) * ld4(YOUT + (size_t)row * D_MODEL + k); s += hsum4(V); }
        PK_LOAD(v0, 0)
        if (NV > 1) PK_LOAD(v1, 1) else v1 = f32x4{0.f, 0.f, 0.f, 0.f};
        if (NV > 2) { PK_LOAD(v2, 2) PK_LOAD(v3, 3) } else { v2 = v1; v3 = v1; }
#undef PK_LOAD
        const float mu = wave_sum(s) * (1.0f / D_MODEL);
        v0 -= mu; float s2 = hsum4(v0 * v0);
        if (NV > 1) { v1 -= mu; s2 += hsum4(v1 * v1); }
        if (NV > 2) { v2 -= mu; v3 -= mu; s2 += hsum4(v2 * v2) + hsum4(v3 * v3); }
        const float rstd = 1.0f / sqrtf(wave_sum(s2) * (1.0f / D_MODEL) + LN_EPS);
        float lg[N_EXPERTS];
#pragma unroll
        for (int e = 0; e < N_EXPERTS; ++e) lg[e] = 0.f;
#pragma unroll
        for (int j = 0; j < NV; ++j) {
            const int k = j * 256 + lane * 4;
            const f32x4 vv = (j == 0) ? v0 : (j == 1) ? v1 : (j == 2) ? v2 : v3;
            const f32x4 h = vv * rstd * ld4(p.ln1_g + k) + ld4(p.ln1_b + k);
            *(f32x4*)(H1 + (size_t)row * D_MODEL + k) = h;
            const f32x4 u = h * (1.0f + ld4(md + 4 * D_MODEL + k)) + ld4(md + 3 * D_MODEL + k);
            *(U2*)(U2b + (size_t)row * D_MODEL + k) = pack4(u);
#pragma unroll
            for (int q = 0; q < 4; ++q) {
                const float* wr = p.w_router + (size_t)(k + q) * N_EXPERTS;
#pragma unroll
                for (int e4 = 0; e4 < N_EXPERTS / 4; ++e4) {
                    const f32x4 w = ld4(wr + e4 * 4);
                    lg[e4 * 4 + 0] += u[q] * w[0]; lg[e4 * 4 + 1] += u[q] * w[1]; lg[e4 * 4 + 2] += u[q] * w[2]; lg[e4 * 4 + 3] += u[q] * w[3];
                }
            }
        }
        float mx = -3.0e38f;
#pragma unroll
        for (int e = 0; e < N_EXPERTS; ++e) { lg[e] = wave_sum(lg[e]); mx = fmaxf(mx, lg[e]); }
        float den = 0.f;
#pragma unroll
        for (int e = 0; e < N_EXPERTS; ++e) { lg[e] = expf(lg[e] - mx); den += lg[e]; }
        float mine = 0.f;
#pragma unroll
        for (int e = 0; e < N_EXPERTS; ++e) mine = (lane == e) ? lg[e] : mine;
        if (lane < N_EXPERTS) AFF[(size_t)row * N_EXPERTS + lane] = mine / den;
    }
}

__device__ __forceinline__ int block_sum_int(int v, int* red) {
    const int lane = threadIdx.x & 63, wave = threadIdx.x >> 6;
#pragma unroll
    for (int o = 1; o < 64; o <<= 1) v += __shfl_xor(v, o);
    __syncthreads();
    if (lane == 0) red[wave] = v;
    __syncthreads();
    return red[0] + red[1] + red[2] + red[3];
}
__device__ void phaseL(const Params& p, int bid, int nblk, char* smem) {
    const float* AFF = WSP(float, WS_AFF);
    int* IDX = WSP(int, WS_IDX); float* GATE = WSP(float, WS_GATE); int* SLOTOF = WSP(int, WS_SLOT);
    unsigned* vals = (unsigned*)smem;
    int* red = (int*)(vals + SEQ);
    int* wsum = red + 8;
    const int tid = threadIdx.x, lane = tid & 63, wave = tid >> 6;
    constexpr int PER = SEQ / 256;
    for (int be = bid; be < BATCH * N_EXPERTS; be += nblk) {
        const int b = be / N_EXPERTS, e = be % N_EXPERTS;
        __syncthreads();
        for (int t = tid; t < SEQ; t += 256) vals[t] = fbits(AFF[((size_t)b * SEQ + t) * N_EXPERTS + e]);
        __syncthreads();
        unsigned lo = 0u, hi = 0x7F800000u;
        while (lo < hi) {
            const unsigned mid = lo + (hi - lo + 1u) / 2u;
            int c = 0;
            for (int t = tid; t < SEQ; t += 256) c += (vals[t] >= mid) ? 1 : 0;
            c = block_sum_int(c, red);
            if (c >= CAP) lo = mid; else hi = mid - 1u;
        }
        const unsigned T = lo;
        int cg = 0, ce = 0;
        for (int q = 0; q < PER; ++q) { const unsigned v = vals[tid * PER + q]; cg += (v > T) ? 1 : 0; ce += (v == T) ? 1 : 0; }
        int pg = cg, pe = ce;
#pragma unroll
        for (int o = 1; o < 64; o <<= 1) { const int a = __shfl_up(pg, o), bb = __shfl_up(pe, o); if (lane >= o) { pg += a; pe += bb; } }
        __syncthreads();
        if (lane == 63) { wsum[wave] = pg; wsum[4 + wave] = pe; }
        __syncthreads();
        int og = 0, oe = 0, totg = 0;
        for (int w = 0; w < 4; ++w) { if (w < wave) { og += wsum[w]; oe += wsum[4 + w]; } totg += wsum[w]; }
        int posg = og + pg - cg, pose = oe + pe - ce;
        const int need_eq = CAP - totg;
        for (int q = 0; q < PER; ++q) {
            const int t = tid * PER + q; const unsigned v = vals[t];
            int slot = -1;
            if (v > T) { slot = posg++; }
            else if (v == T) { if (pose < need_eq) slot = totg + pose; pose++; }
            if (slot >= 0) { IDX[(size_t)be * CAP + slot] = b * SEQ + t; GATE[(size_t)be * CAP + slot] = bitsf(v); }
            SLOTOF[((size_t)b * SEQ + t) * N_EXPERTS + e] = slot;
        }
    }
}

__device__ void phaseM(const Params& p, int bid, int nblk, char* smem) {
    const bf16_t* U2b = WSP(bf16_t, WS_R6); const int* IDX = WSP(int, WS_IDX);
    bf16_t* HID = WSP(bf16_t, WS_R1);
    constexpr int NTN = D_EXPERT / 64, NTM = CAP / 128;
    for (int it = bid; it < BATCH * N_EXPERTS * NTM * NTN; it += nblk) {
        const int nt = it % NTN, mt = (it / NTN) % NTM, be = it / (NTN * NTM), e = be % N_EXPERTS;
        const float* wg = p.w_gate + (size_t)e * D_MODEL * D_EXPERT; const float* wu = p.w_up + (size_t)e * D_MODEL * D_EXPERT;
        gemm_tile<true>(smem, U2b, D_MODEL, IDX + (size_t)be * CAP, mt * 128, wg, wu, D_EXPERT, nt * 64, D_MODEL, [&](int ml, int nl, f32x4 g, f32x4 u) {
            U2 o; o.x = pk2(siluf_(g[0]) * u[0], siluf_(g[1]) * u[1]); o.y = pk2(siluf_(g[2]) * u[2], siluf_(g[3]) * u[3]);
            *(U2*)(HID + ((size_t)be * CAP + mt * 128 + ml) * D_EXPERT + nt * 64 + nl) = o;
        });
    }
}
__device__ void phaseN(const Params& p, int bid, int nblk, char* smem) {
    const bf16_t* HID = WSP(bf16_t, WS_R1); const float* GATE = WSP(float, WS_GATE);
    bf16_t* YS = WSP(bf16_t, WS_R2);
    constexpr int NTN = D_MODEL / 128, NTM = CAP / 128;
    for (int it = bid; it < BATCH * N_EXPERTS * NTM * NTN; it += nblk) {
        const int nt = it % NTN, mt = (it / NTN) % NTM, be = it / (NTN * NTM), e = be % N_EXPERTS;
        const float* wd = p.w_down + (size_t)e * D_EXPERT * D_MODEL;
        gemm_tile<false>(smem, HID + (size_t)be * CAP * D_EXPERT, D_EXPERT, nullptr, mt * 128, wd, nullptr, D_MODEL, nt * 128, D_EXPERT, [&](int ml, int nl, f32x4 v, f32x4) {
            const int slot = mt * 128 + ml;
            const float gt = GATE[(size_t)be * CAP + slot];
            *(U2*)(YS + ((size_t)be * CAP + slot) * D_MODEL + nt * 128 + nl) = pack4(v * gt);
        });
    }
}
__device__ void phaseO(const Params& p, int bid, int nblk, char* smem) {
    const int lane = threadIdx.x & 63, wave = threadIdx.x >> 6;
    const float* MOD = WSP(float, WS_MOD); const float* H1 = WSP(float, WS_R5); const bf16_t* YS = WSP(bf16_t, WS_R2); const int* SLOTOF = WSP(int, WS_SLOT);
    for (int row = bid * 4 + wave; row < MLAT; row += nblk * 4) {
        const float* md = MOD + (size_t)(row / SEQ) * 6 * D_MODEL;
        f32x4 v0, v1, v2, v3; float s = 0.f;
        f32x4 y0 = f32x4{0.f, 0.f, 0.f, 0.f}, y1 = y0, y2 = y0, y3 = y0;
        const int myslot = (lane < N_EXPERTS) ? SLOTOF[(size_t)row * N_EXPERTS + lane] : -1;
        const int bbase = (row / SEQ) * N_EXPERTS;
        for (int e = 0; e < N_EXPERTS; ++e) {
            const int sl = __shfl(myslot, e);
            if (sl >= 0) {
                const bf16_t* yr = YS + ((size_t)(bbase + e) * CAP + sl) * D_MODEL + lane * 4;
                { const U2 u = *(const U2*)yr; y0 += f32x4{bitsf(u.x << 16), bitsf(u.x & 0xFFFF0000u), bitsf(u.y << 16), bitsf(u.y & 0xFFFF0000u)}; }
                if (NV > 1) { const U2 u = *(const U2*)(yr + 256); y1 += f32x4{bitsf(u.x << 16), bitsf(u.x & 0xFFFF0000u), bitsf(u.y << 16), bitsf(u.y & 0xFFFF0000u)}; }
                if (NV > 2) { const U2 u = *(const U2*)(yr + 512); y2 += f32x4{bitsf(u.x << 16), bitsf(u.x & 0xFFFF0000u), bitsf(u.y << 16), bitsf(u.y & 0xFFFF0000u)};
                              const U2 w = *(const U2*)(yr + 768); y3 += f32x4{bitsf(w.x << 16), bitsf(w.x & 0xFFFF0000u), bitsf(w.y << 16), bitsf(w.y & 0xFFFF0000u)}; }
            }
        }
#define PO_LOAD(V, J) { const int k = (J) * 256 + lane * 4; const f32x4 yy = ((J) == 0) ? y0 : ((J) == 1) ? y1 : ((J) == 2) ? y2 : y3; V = ALPHA_F * ld4(H1 + (size_t)row * D_MODEL + k) + ld4(md + 5 * D_MODEL + k) * yy; s += hsum4(V); }
        PO_LOAD(v0, 0)
        if (NV > 1) PO_LOAD(v1, 1) else v1 = f32x4{0.f, 0.f, 0.f, 0.f};
        if (NV > 2) { PO_LOAD(v2, 2) PO_LOAD(v3, 3) } else { v2 = v1; v3 = v1; }
#undef PO_LOAD
        const float mu = wave_sum(s) * (1.0f / D_MODEL);
        v0 -= mu; float s2 = hsum4(v0 * v0);
        if (NV > 1) { v1 -= mu; s2 += hsum4(v1 * v1); }
        if (NV > 2) { v2 -= mu; v3 -= mu; s2 += hsum4(v2 * v2) + hsum4(v3 * v3); }
        const float rstd = 1.0f / sqrtf(wave_sum(s2) * (1.0f / D_MODEL) + LN_EPS);
#pragma unroll
        for (int j = 0; j < NV; ++j) {
            const int k = j * 256 + lane * 4;
            const f32x4 vv = (j == 0) ? v0 : (j == 1) ? v1 : (j == 2) ? v2 : v3;
            *(f32x4*)(p.out + (size_t)row * D_MODEL + k) = vv * rstd * ld4(p.ln2_g + k) + ld4(p.ln2_b + k);
        }
    }
}

#define XB_TMO      128
#define XB_XCNT(j)  (256  + 64 * (j))
#define XB_XSUB(j)  (1280 + 64 * (j))
#define XB_XGEN(j)  (2304 + 64 * (j))
#define XB_TOP      3328
#define XB_TOPGEN   3392
#define XCD_BAR_WORDS 3456
#define XB_SPIN_CAP (1u << 22)
#ifndef HOST_EMU
__device__ __forceinline__ unsigned xb_ld(unsigned* p) { return __hip_atomic_load(p, __ATOMIC_RELAXED, __HIP_MEMORY_SCOPE_AGENT); }
__device__ __forceinline__ unsigned xb_add(unsigned* p, unsigned v) { return __hip_atomic_fetch_add(p, v, __ATOMIC_RELAXED, __HIP_MEMORY_SCOPE_AGENT); }
__device__ __forceinline__ unsigned xb_xcc_id() { return (unsigned)__builtin_amdgcn_s_getreg((3 << 11) | 20) & 0xFu; }
#define XB_SPIN(cond, bar) do { unsigned _sp = 0; while (cond) { __builtin_amdgcn_s_sleep(1); \
    if ((++_sp & 255u) == 0u) { if (xb_ld(&(bar)[XB_TMO])) break; if (_sp > XB_SPIN_CAP) { atomicAdd(&(bar)[XB_TMO], 1u); break; } } } } while (0)
struct XcdBarrier { unsigned* bar; unsigned x; unsigned* st; };
__device__ __forceinline__ XcdBarrier xcd_barrier_post(unsigned* bar, unsigned* st) {
    XcdBarrier b; b.bar = bar; b.x = xb_xcc_id(); b.st = st;
    if (threadIdx.x == 0) (void)xb_add(&bar[XB_XCNT(b.x)], 1u);
    return b;
}
__device__ __forceinline__ void xcd_barrier_complete(unsigned* bar, unsigned x, unsigned& nloc, unsigned& nx) {
    const unsigned G = gridDim.x;
    unsigned sum, cnt, mine, sp = 0u;
    for (;;) {
        sum = 0u; cnt = 0u; mine = 0u;
#pragma unroll
        for (unsigned j = 0; j < 16; ++j) { const unsigned c = xb_ld(&bar[XB_XCNT(j)]); sum += c; cnt += (c > 0u) ? 1u : 0u; mine = (j == x) ? c : mine; }
        if (sum == G) break;
        __builtin_amdgcn_s_sleep(1);
        if ((++sp & 255u) == 0u) { if (xb_ld(&bar[XB_TMO])) break; if (sp > XB_SPIN_CAP) { atomicAdd(&bar[XB_TMO], 1u); break; } }
    }
    nloc = mine > 0u ? mine : 1u; nx = cnt > 0u ? cnt : 1u;
}
__device__ __forceinline__ void grid_barrier(const XcdBarrier& b) {
    asm volatile("s_waitcnt vmcnt(0)" ::: "memory");
    __syncthreads();
    if (threadIdx.x == 0) {
        unsigned* bar = b.bar;
        __builtin_amdgcn_s_waitcnt(0);
        volatile unsigned* st = b.st;
        unsigned nloc = st[0], nx = st[1];
        if (nloc == 0u) { xcd_barrier_complete(bar, b.x, nloc, nx); st[0] = nloc; st[1] = nx; }
        const unsigned old = xb_add(&bar[XB_XSUB(b.x)], 1u);
        const unsigned gen = old / nloc;
        if (old + 1u == (gen + 1u) * nloc) {
            __builtin_amdgcn_fence(__ATOMIC_RELEASE, "agent");
            asm volatile("s_waitcnt vmcnt(0)" ::: "memory");
            const unsigned og = xb_add(&bar[XB_TOP], 1u);
            const unsigned tg = og / nx;
            if (og + 1u == (tg + 1u) * nx) xb_add(&bar[XB_TOPGEN], 1u);
            else XB_SPIN(xb_ld(&bar[XB_TOPGEN]) == tg, bar);
            __builtin_amdgcn_fence(__ATOMIC_ACQUIRE, "agent");
            xb_add(&bar[XB_XGEN(b.x)], 1u);
            asm volatile("s_waitcnt vmcnt(0)" ::: "memory");
        } else {
            XB_SPIN(xb_ld(&bar[XB_XGEN(b.x)]) == gen, bar);
            __builtin_amdgcn_fence(__ATOMIC_ACQUIRE, "agent");
            asm volatile("s_waitcnt vmcnt(0)" ::: "memory");
        }
    }
    __syncthreads();
}
#else
struct XcdBarrier { int dummy; };
__device__ __forceinline__ XcdBarrier xcd_barrier_post(unsigned*, unsigned*) { return XcdBarrier{0}; }
__device__ __forceinline__ void grid_barrier(const XcdBarrier&) { __syncthreads(); }
#endif

__global__ void __launch_bounds__(256, 2) fused_forward(Params p) {
    __shared__ __attribute__((aligned(16))) char smem[SMEM_BYTES];
    __shared__ __attribute__((aligned(16))) unsigned xb_words[4];
    if (threadIdx.x == 0) { xb_words[0] = 0u; xb_words[1] = 0u; xb_words[2] = 0u; xb_words[3] = 0u; }
    __syncthreads();
    const XcdBarrier gb = xcd_barrier_post(WSP(unsigned, WS_CTRL), xb_words);
    const int bid = blockIdx.x, nblk = gridDim.x;
    phaseA(p, bid, nblk, smem); grid_barrier(gb);
    phaseB(p, bid, nblk, smem); grid_barrier(gb);
    phaseC(p, bid, nblk, smem); grid_barrier(gb);
    phaseD(p, bid, nblk, smem); grid_barrier(gb);
    phaseF(p, bid, nblk, smem); grid_barrier(gb);
    phaseR1(p, bid, nblk, smem); grid_barrier(gb);
    phaseR2(p, bid, nblk, smem); grid_barrier(gb);
    phaseR3(p, bid, nblk, smem); grid_barrier(gb);
    phaseJ(p, bid, nblk, smem); grid_barrier(gb);
    phaseK(p, bid, nblk, smem); grid_barrier(gb);
    phaseL(p, bid, nblk, smem); grid_barrier(gb);
    phaseM(p, bid, nblk, smem); grid_barrier(gb);
    phaseN(p, bid, nblk, smem); grid_barrier(gb);
    phaseO(p, bid, nblk, smem);
}

#ifdef MULTI_LAUNCH
#define PHASE_KERNEL(NAME) \
    __global__ void __launch_bounds__(256) k_##NAME(Params p) { __shared__ __attribute__((aligned(16))) char smem[SMEM_BYTES]; NAME(p, blockIdx.x, gridDim.x, smem); }
PHASE_KERNEL(phaseA) PHASE_KERNEL(phaseB) PHASE_KERNEL(phaseC) PHASE_KERNEL(phaseD) PHASE_KERNEL(phaseF) PHASE_KERNEL(phaseR1) PHASE_KERNEL(phaseR2) PHASE_KERNEL(phaseR3)
PHASE_KERNEL(phaseJ) PHASE_KERNEL(phaseK) PHASE_KERNEL(phaseL) PHASE_KERNEL(phaseM) PHASE_KERNEL(phaseN) PHASE_KERNEL(phaseO)
#ifdef HOST_EMU
void emu_hook(const char* name, const Params& p);
#define LAUNCH(NAME, grid) do { EMU_LAUNCH(k_##NAME, grid, 256, p); emu_hook(#NAME, p); } while (0)
#else
#define LAUNCH(NAME, grid) hipLaunchKernelGGL(k_##NAME, dim3(grid), dim3(256), 0, stream, p)
#endif
#endif

extern "C" void kernel_launch(void* const* d_in, const int* in_sizes, int n_in, void* d_out, int out_size, void* d_ws, size_t ws_size, hipStream_t stream) {
    if (n_in != 38 || out_size != MLAT * D_MODEL || ws_size < WS_END) { fprintf(stderr, "kernel_launch: unexpected shapes (n_in %d out %d ws %zu need %zu)\n", n_in, out_size, ws_size, (size_t)WS_END); return; }
    Params p{};
    const float** f = (const float**)&p;
    for (int i = 0; i < 38; ++i) f[i] = (const float*)d_in[i];
    p.out = (float*)d_out; p.ws = (unsigned char*)d_ws;
#ifdef MULTI_LAUNCH
    const int G = 512;
    LAUNCH(phaseA, 6 * D_MODEL / 64);
    LAUNCH(phaseB, G);
    LAUNCH(phaseC, G);
    LAUNCH(phaseD, G);
    LAUNCH(phaseF, NLCH < G ? NLCH : G);
    LAUNCH(phaseR1, G);
    LAUNCH(phaseR2, NCHAIN);
    LAUNCH(phaseR3, G);
    LAUNCH(phaseJ, G);
    LAUNCH(phaseK, G);
    LAUNCH(phaseL, BATCH * N_EXPERTS);
    LAUNCH(phaseM, G);
    LAUNCH(phaseN, G);
    LAUNCH(phaseO, G);
#elif defined(HOST_EMU)
    EMU_LAUNCH(fused_forward, 1, 256, p);
#else
    static int grid_blocks = 0;
    if (!grid_blocks) {
        int dev = 0, cus = 0, per_cu = 0;
        (void)hipGetDevice(&dev);
        (void)hipDeviceGetAttribute(&cus, hipDeviceAttributeMultiprocessorCount, dev);
        (void)hipOccupancyMaxActiveBlocksPerMultiprocessor(&per_cu, fused_forward, 256, 0);
        if (per_cu > 2) per_cu = 2;
        if (per_cu < 1) { fprintf(stderr, "kernel_launch: occupancy query returned %d blocks per CU\n", per_cu); per_cu = 1; }
        grid_blocks = cus * per_cu;
    }
    (void)hipMemsetAsync((char*)d_ws + WS_CTRL, 0, XCD_BAR_WORDS * 4, stream);
    void* args[] = {&p};
    hipError_t e = hipLaunchCooperativeKernel((void*)fused_forward, dim3(grid_blocks), dim3(256), args, 0, stream);
    if (e != hipSuccess) fprintf(stderr, "cooperative launch failed: %s (grid %d)\n", hipGetErrorString(e), grid_blocks);
#endif
}
```

```cpp
#ifndef HOST_EMU
#include <hip/hip_runtime.h>
#include <cstdio>
#endif
#include <cstdint>
#include <cstddef>

#ifdef CFG_SMALL
constexpr int D_MODEL = 256, BATCH = 2, SEQ = 256, GRID_W = 16, CTX_LEN = 64, LRU_BLOCKS = 2, N_EXPERTS = 4, D_EXPERT = 256;
#else
constexpr int D_MODEL = 1024, BATCH = 4, SEQ = 4096, GRID_W = 64, CTX_LEN = 256, LRU_BLOCKS = 8, N_EXPERTS = 16, D_EXPERT = 1408;
#endif
constexpr int ROWS = SEQ / GRID_W;
constexpr int D_LRU = D_MODEL / 2, LRU_BLOCK = 64;
constexpr int D_RWKV = D_MODEL / 2, HEADS = D_RWKV / 64;
constexpr int D_RWKV_IN = 3 * D_RWKV + 128 + 128 + 128;
constexpr int D_IN = 2 * D_LRU + D_RWKV_IN;
constexpr int D_MIX = D_LRU + D_RWKV;
constexpr int CAP = 2 * SEQ / N_EXPERTS;
constexpr int MLAT = BATCH * SEQ, MCTX = BATCH * CTX_LEN, MTOT = MLAT + MCTX;
constexpr int NMOD = BATCH + 1;
constexpr int RW0 = 2 * D_LRU;
constexpr float ALPHA_F = 1.189207115002721f;
constexpr float LN_EPS = 1e-5f, GN_EPS = 64e-5f, RMS_EPS = 1e-6f;
static_assert(LRU_BLOCKS * LRU_BLOCK == D_LRU, "lru blocks");
static_assert(CAP % 128 == 0 && D_IN % 128 == 0 && D_EXPERT % 64 == 0 && D_MODEL % 128 == 0 && MTOT % 128 == 0, "tile divisibility");

typedef unsigned short bf16_t;
typedef short bf16x8 __attribute__((ext_vector_type(8)));
typedef float f32x4 __attribute__((ext_vector_type(4)));
typedef unsigned u32x4 __attribute__((ext_vector_type(4)));
struct alignas(16) F4 { float x, y, z, w; };
typedef unsigned U2 __attribute__((ext_vector_type(2)));
struct alignas(16) U4 { unsigned x, y, z, w; };

#ifdef HOST_EMU
#define MFMA16(a, b, c) emu_mfma_16x16x32_bf16(a, b, c)
#else
#define MFMA16(a, b, c) __builtin_amdgcn_mfma_f32_16x16x32_bf16(a, b, c, 0, 0, 0)
#endif

__device__ __forceinline__ unsigned fbits(float f) { return __builtin_bit_cast(unsigned, f); }
__device__ __forceinline__ float bitsf(unsigned u) { return __builtin_bit_cast(float, u); }
__device__ __forceinline__ bf16_t f2bf(float f) { unsigned u = fbits(f); u += 0x7FFFu + ((u >> 16) & 1u); return (bf16_t)(u >> 16); }
__device__ __forceinline__ float bf2f(bf16_t h) { return bitsf(((unsigned)h) << 16); }
__device__ __forceinline__ unsigned pk2(float lo, float hi) { return (unsigned)f2bf(lo) | ((unsigned)f2bf(hi) << 16); }
__device__ __forceinline__ float sigmoidf_(float x) { return 1.0f / (1.0f + expf(-x)); }
__device__ __forceinline__ float siluf_(float x) { return x * sigmoidf_(x); }
__device__ __forceinline__ float softplusf_(float x) { return fmaxf(x, 0.0f) + log1pf(expf(-fabsf(x))); }
__device__ __forceinline__ float geluf_(float x) { return 0.5f * x * (1.0f + tanhf(0.7978845608028654f * (x + 0.044715f * x * x * x))); }
__device__ __forceinline__ float wave_sum(float v) {
#pragma unroll
    for (int o = 1; o < 64; o <<= 1) v += __shfl_xor(v, o);
    return v;
}

constexpr size_t al256(size_t x) { return (x + 255) & ~(size_t)255; }
constexpr int NLCH = BATCH * (SEQ / 64), NCCH = BATCH * (CTX_LEN / 64), NCH = NLCH + NCCH;
constexpr size_t WS_CTRL = 0;
constexpr size_t WS_MOD = 65536;
constexpr size_t WS_STATS = al256(WS_MOD + (size_t)NMOD * 6 * D_MODEL * 4);
constexpr size_t WS_SUMA = al256(WS_STATS + (size_t)MTOT * 2 * 4);
constexpr size_t WS_SUMH = al256(WS_SUMA + (size_t)2 * NCH * D_LRU * 4);
constexpr size_t WS_CARRY = al256(WS_SUMH + (size_t)2 * NCH * D_LRU * 4);
constexpr size_t WS_SSQP = al256(WS_CARRY + (size_t)2 * NLCH * D_LRU * 4);
constexpr size_t WS_RINV = al256(WS_SSQP + (size_t)MLAT * LRU_BLOCKS * 4);
constexpr size_t WS_BON = al256(WS_RINV + (size_t)MLAT * 4);
constexpr size_t WS_AFF = al256(WS_BON + (size_t)2 * MLAT * HEADS * 4 + 4096 * 64);
constexpr size_t WS_IDX = al256(WS_AFF + (size_t)MLAT * N_EXPERTS * 4);
constexpr size_t WS_GATE = al256(WS_IDX + (size_t)BATCH * N_EXPERTS * CAP * 4);
constexpr size_t WS_SLOT = al256(WS_GATE + (size_t)BATCH * N_EXPERTS * CAP * 4);
constexpr size_t WS_R1 = al256(WS_SLOT + (size_t)MLAT * N_EXPERTS * 4);
constexpr size_t R1_BYTES = (size_t)MTOT * D_IN * 2 > (size_t)MLAT * D_MODEL * 4 ? ((size_t)MTOT * D_IN * 2 > (size_t)BATCH * N_EXPERTS * CAP * D_EXPERT * 2 ? (size_t)MTOT * D_IN * 2 : (size_t)BATCH * N_EXPERTS * CAP * D_EXPERT * 2)
                                                                                  : ((size_t)MLAT * D_MODEL * 4 > (size_t)BATCH * N_EXPERTS * CAP * D_EXPERT * 2 ? (size_t)MLAT * D_MODEL * 4 : (size_t)BATCH * N_EXPERTS * CAP * D_EXPERT * 2);
constexpr size_t WS_R3 = al256(WS_R1 + R1_BYTES);
constexpr int RC = 32;
constexpr int NCC = CTX_LEN / RC, NLC = SEQ / RC, NCK = NCC + NLC, NCHAIN = BATCH * HEADS * 2;
constexpr size_t CH_PM = 0, CH_SA = 8192, CH_QT = 16384, CH_Y0 = 20480, CH_BYTES = 24576;
constexpr size_t WS_CH = al256(WS_R3 + (size_t)MTOT * D_MODEL * 2);
constexpr size_t CH_TOTAL = (size_t)NCHAIN * NCK * CH_BYTES;
constexpr size_t WS_R5 = WS_CH;
constexpr size_t WS_R2 = al256(WS_R5 + (size_t)MLAT * D_MODEL * 4);
constexpr size_t WS_R6 = al256(WS_R2 + (size_t)MLAT * D_MODEL * 4);
constexpr size_t WS_LATE_END = al256(WS_R6 + (size_t)MLAT * D_MODEL * 2);
constexpr size_t WS_END = (WS_CH + CH_TOTAL > WS_LATE_END) ? al256(WS_CH + CH_TOTAL) : WS_LATE_END;
constexpr size_t WS_RBON = WS_BON;
static_assert((size_t)NCHAIN * NCK * RC * 4 <= (size_t)2 * MLAT * HEADS * 4 + 4096 * 64, "bonus buffer");

struct Params {
    const float *x, *c, *ctx, *c_ctx, *ln_in_g, *ln_in_b, *w_mod, *b_mod, *w_in, *lru_conv_w, *lru_conv_b, *lru_wa, *lru_ba, *lru_wx, *lru_bx, *lru_lam, *lru_norm_g,
        *mu_prev, *mu_next, *w0, *w2, *a0, *a2, *g2, *k_k, *k_a, *r_k, *gn_g, *gn_b, *w_out, *ln1_g, *ln1_b, *w_router, *w_gate, *w_up, *w_down, *ln2_g, *ln2_b;
    float* out;
    unsigned char* ws;
};
#define WSP(T, off) ((T*)(p.ws + (off)))

constexpr int SMEM_BYTES = 76 * 1024;

__device__ void phaseA(const Params& p, int bid, int nblk, char* smem) {
    float* sc = (float*)smem;
    float* red = sc + NMOD * D_MODEL;
    const int tid = threadIdx.x;
    for (int i = tid; i < NMOD * D_MODEL; i += 256) {
        const int r = i / D_MODEL, k = i % D_MODEL;
        const float v = (r < BATCH) ? p.c[r * D_MODEL + k] : p.c_ctx[k];
        sc[i] = siluf_(v);
    }
    __syncthreads();
    float* MOD = WSP(float, WS_MOD);
    const int col = tid & 63, kg = tid >> 6;
    for (int cb = bid; cb < 6 * D_MODEL / 64; cb += nblk) {
        const int n = cb * 64 + col;
        float acc[NMOD];
#pragma unroll
        for (int r = 0; r < NMOD; ++r) acc[r] = 0.f;
        for (int k = kg; k < D_MODEL; k += 4) {
            const float w = p.w_mod[(size_t)k * (6 * D_MODEL) + n];
#pragma unroll
            for (int r = 0; r < NMOD; ++r) acc[r] += sc[r * D_MODEL + k] * w;
        }
#pragma unroll
        for (int r = 0; r < NMOD; ++r) red[(kg * NMOD + r) * 64 + col] = acc[r];
        __syncthreads();
        if (kg == 0) {
#pragma unroll
            for (int r = 0; r < NMOD; ++r) {
                float s = p.b_mod[n];
                for (int g = 0; g < 4; ++g) s += red[(g * NMOD + r) * 64 + col];
                MOD[(size_t)r * 6 * D_MODEL + n] = s;
            }
        }
        __syncthreads();
    }
}

constexpr int NV = D_MODEL / 256;
__device__ __forceinline__ f32x4 ld4(const float* p) { return *(const f32x4*)p; }
__device__ __forceinline__ float hsum4(f32x4 v) { return (v[0] + v[1]) + (v[2] + v[3]); }
__device__ __forceinline__ U2 pack4(f32x4 v) { U2 o; o.x = pk2(v[0], v[1]); o.y = pk2(v[2], v[3]); return o; }
__device__ void phaseB(const Params& p, int bid, int nblk, char* smem) {
    const int lane = threadIdx.x & 63, wave = threadIdx.x >> 6;
    const float* MOD = WSP(float, WS_MOD);
    float* STATS = WSP(float, WS_STATS);
    bf16_t* U = WSP(bf16_t, WS_R3);
    for (int row = bid * 4 + wave; row < MTOT; row += nblk * 4) {
        const float* xr = (row < MLAT) ? p.x + (size_t)row * D_MODEL : p.ctx + (size_t)(row - MLAT) * D_MODEL;
        const int mr = (row < MLAT) ? row / SEQ : BATCH;
        const float* md = MOD + (size_t)mr * 6 * D_MODEL;
        f32x4 v0, v1, v2, v3; float s = 0.f;
        v0 = ld4(xr + lane * 4); s += hsum4(v0);
        if (NV > 1) { v1 = ld4(xr + 256 + lane * 4); s += hsum4(v1); } else v1 = f32x4{0.f, 0.f, 0.f, 0.f};
        if (NV > 2) { v2 = ld4(xr + 512 + lane * 4); v3 = ld4(xr + 768 + lane * 4); s += hsum4(v2) + hsum4(v3); } else { v2 = v1; v3 = v1; }
        const float mu = wave_sum(s) * (1.0f / D_MODEL);
        v0 -= mu; float s2 = hsum4(v0 * v0);
        if (NV > 1) { v1 -= mu; s2 += hsum4(v1 * v1); }
        if (NV > 2) { v2 -= mu; v3 -= mu; s2 += hsum4(v2 * v2) + hsum4(v3 * v3); }
        const float rstd = 1.0f / sqrtf(wave_sum(s2) * (1.0f / D_MODEL) + LN_EPS);
        if (lane == 0) { STATS[row * 2] = mu; STATS[row * 2 + 1] = rstd; }
#pragma unroll
        for (int j = 0; j < NV; ++j) {
            const int k = j * 256 + lane * 4;
            const f32x4 vv = (j == 0) ? v0 : (j == 1) ? v1 : (j == 2) ? v2 : v3;
            const f32x4 h = vv * rstd * ld4(p.ln_in_g + k) + ld4(p.ln_in_b + k);
            *(U2*)(U + (size_t)row * D_MODEL + k) = pack4(h * (1.0f + ld4(md + D_MODEL + k)) + ld4(md + k));
        }
    }
}

constexpr int LDK = 72;
template <bool DUAL, class Epi>
__device__ __forceinline__ void gemm_tile(char* smem, const bf16_t* A, int lda, const int* rowidx, int m0, const float* B0, const float* B1, int ldb, int n0, int K, Epi epi, const float* rowscale = nullptr, int kscale = 0) {
    bf16_t* As = (bf16_t*)smem;
    bf16_t* Bs = As + 128 * LDK;
    const int tid = threadIdx.x, lane = tid & 63, wave = tid >> 6, wr = wave >> 1, wc = wave & 1;
    const int arow = tid >> 1, ahalf = tid & 1;
    const size_t agrow = rowidx ? (size_t)rowidx[m0 + arow] : (size_t)(m0 + arow);
    const bf16_t* aptr = A + agrow * lda + ahalf * 32;
    const int bn4 = tid & 31, bkg = tid >> 5;
    const float* bptr;
    if (DUAL) { const int ct = bn4 * 4, blk = ct >> 5; bptr = ((blk & 1) ? B1 : B0) + (size_t)(bkg * 8) * ldb + n0 + (blk >> 1) * 32 + (ct & 31); }
    else bptr = B0 + (size_t)(bkg * 8) * ldb + n0 + bn4 * 4;
    u32x4 ar[4]; f32x4 br[8];
    f32x4 acc[4][4];
#pragma unroll
    for (int i = 0; i < 4; ++i)
#pragma unroll
        for (int j = 0; j < 4; ++j) acc[i][j] = f32x4{0.f, 0.f, 0.f, 0.f};
    const int nk = K / 64;
#pragma unroll
    for (int j = 0; j < 4; ++j) ar[j] = *(const u32x4*)(aptr + j * 8);
#pragma unroll
    for (int j = 0; j < 8; ++j) br[j] = *(const f32x4*)(bptr + (size_t)j * ldb);
    for (int kt = 0; kt < nk; ++kt) {
        __syncthreads();
#pragma unroll
        for (int j = 0; j < 4; ++j) *(u32x4*)(As + arow * LDK + ahalf * 32 + j * 8) = ar[j];
#pragma unroll
        for (int c = 0; c < 4; ++c) {
            u32x4 o;
            o[0] = pk2(br[0][c], br[1][c]); o[1] = pk2(br[2][c], br[3][c]); o[2] = pk2(br[4][c], br[5][c]); o[3] = pk2(br[6][c], br[7][c]);
            *(u32x4*)(Bs + (bn4 * 4 + c) * LDK + bkg * 8) = o;
        }
        __syncthreads();
        if (kt + 1 < nk) {
            const int ko = (kt + 1) * 64;
#pragma unroll
            for (int j = 0; j < 4; ++j) ar[j] = *(const u32x4*)(aptr + ko + j * 8);
#pragma unroll
            for (int j = 0; j < 8; ++j) br[j] = *(const f32x4*)(bptr + (size_t)(ko + j) * ldb);
        }
#pragma unroll
        for (int ks = 0; ks < 2; ++ks) {
            bf16x8 af[4];
#pragma unroll
            for (int mi = 0; mi < 4; ++mi) af[mi] = *(const bf16x8*)(As + (wr * 64 + mi * 16 + (lane & 15)) * LDK + ks * 32 + 8 * (lane >> 4));
#pragma unroll
            for (int ni = 0; ni < 4; ++ni) {
                const bf16x8 bfr = *(const bf16x8*)(Bs + (wc * 64 + ni * 16 + (lane & 15)) * LDK + ks * 32 + 8 * (lane >> 4));
#pragma unroll
                for (int mi = 0; mi < 4; ++mi) acc[mi][ni] = MFMA16(bfr, af[mi], acc[mi][ni]);
            }
        }
        if (rowscale && kt + 1 == kscale) {
#pragma unroll
            for (int mi = 0; mi < 4; ++mi) {
                const float rs = rowscale[m0 + wr * 64 + mi * 16 + (lane & 15)];
#pragma unroll
                for (int ni = 0; ni < 4; ++ni) acc[mi][ni] *= rs;
            }
        }
    }
#pragma unroll
    for (int mi = 0; mi < 4; ++mi) {
        const int ml = wr * 64 + mi * 16 + (lane & 15);
        if (DUAL) {
#pragma unroll
            for (int ni = 0; ni < 2; ++ni) epi(ml, wc * 32 + ni * 16 + (lane >> 4) * 4, acc[mi][ni], acc[mi][ni + 2]);
        } else {
#pragma unroll
            for (int ni = 0; ni < 4; ++ni) epi(ml, wc * 64 + ni * 16 + (lane >> 4) * 4, acc[mi][ni], acc[mi][ni]);
        }
    }
    __syncthreads();
}

__device__ void phaseC(const Params& p, int bid, int nblk, char* smem) {
    const bf16_t* U = WSP(bf16_t, WS_R3);
    bf16_t* P = WSP(bf16_t, WS_R1);
    constexpr int NTN = D_IN / 128, NTM = MTOT / 128;
    for (int it = bid; it < NTN * NTM; it += nblk) {
        const int mt = it / NTN, nt = it % NTN;
        gemm_tile<false>(smem, U, D_MODEL, nullptr, mt * 128, p.w_in, nullptr, D_IN, nt * 128, D_MODEL, [&](int ml, int nl, f32x4 v, f32x4) {
            U2 o; o.x = pk2(v[0], v[1]); o.y = pk2(v[2], v[3]);
            *(U2*)(P + (size_t)(mt * 128 + ml) * D_IN + nt * 128 + nl) = o;
        });
    }
}

#ifdef HOST_EMU
#define FEXP(x) expf(x)
#else
#define FEXP(x) __expf(x)
#endif
__device__ __forceinline__ float fsigm(float x) { return 1.0f / (1.0f + FEXP(-x)); }
template <int NYT, int KS>
__device__ __forceinline__ void mmT(f32x4* acc, const bf16_t* X, int ldx, int xs, const bf16_t* Y, int ldy, int lane) {
#pragma unroll
    for (int ks = 0; ks < KS; ++ks) {
        const bf16x8 xf = *(const bf16x8*)(X + (xs * 16 + (lane & 15)) * ldx + ks * 32 + 8 * (lane >> 4));
#pragma unroll
        for (int nb = 0; nb < NYT; ++nb) {
            const bf16x8 yf = *(const bf16x8*)(Y + (nb * 16 + (lane & 15)) * ldy + ks * 32 + 8 * (lane >> 4));
            acc[nb] = MFMA16(xf, yf, acc[nb]);
        }
    }
}

struct SeqChunk { int base_row; int t0; int len; };
__device__ __forceinline__ SeqChunk lru_chunk(int cg) {
    SeqChunk s;
    if (cg < NLCH) { const int b = cg / (SEQ / 64), ck = cg % (SEQ / 64); s.base_row = b * SEQ; s.t0 = ck * 64; s.len = SEQ; }
    else { const int c2 = cg - NLCH; const int b = c2 / (CTX_LEN / 64), ck = c2 % (CTX_LEN / 64); s.base_row = MLAT + b * CTX_LEN; s.t0 = ck * 64; s.len = CTX_LEN; }
    return s;
}
constexpr int L_XIN = 0;
constexpr int L_GT = 8704;
constexpr int L_XB = L_GT + 9216;
constexpr int L_WT = L_XB + 9216;
constexpr int L_CP = L_WT + 36864;
constexpr int L_END = L_CP + 4096;
static_assert(L_END <= SMEM_BYTES, "lru lds");
__device__ __forceinline__ void lru_load_w(const Params& p, char* smem, int cb) {
    bf16_t* WT = (bf16_t*)(smem + L_WT);
    const int tid = threadIdx.x;
    for (int idx = tid; idx < 4 * 64 * 16; idx += 256) {
        const int m = idx >> 10, i = (idx >> 4) & 63, j4 = (idx & 15) * 4, d = m >> 1;
        const f32x4 w = ld4(((m & 1) ? p.lru_wx : p.lru_wa) + ((size_t)(d * LRU_BLOCKS + cb) * 64 + i) * 64 + j4);
        bf16_t* dst = WT + (m * 64 + j4) * 72 + i;
        dst[0] = f2bf(w[0]); dst[72] = f2bf(w[1]); dst[144] = f2bf(w[2]); dst[216] = f2bf(w[3]);
    }
}
struct LruOut { float a[2][4][4], b[2][4][4]; };
template <bool FINAL>
__device__ __forceinline__ void lru_item(const Params& p, char* smem, int cg, int cb) {
    const bf16_t* P = WSP(bf16_t, WS_R1);
    bf16_t* XIN = (bf16_t*)(smem + L_XIN); bf16_t* GT = (bf16_t*)(smem + L_GT); bf16_t* XB = (bf16_t*)(smem + L_XB); const bf16_t* WT = (const bf16_t*)(smem + L_WT);
    float* CP = (float*)(smem + L_CP);
    const int tid = threadIdx.x, lane = tid & 63, wave = tid >> 6, q = lane >> 4, l15 = lane & 15;
    const SeqChunk sc = lru_chunk(cg);
    __syncthreads();
    for (int idx = tid; idx < 67 * 8; idx += 256) {
        const int tt = idx >> 3, c8 = (idx & 7) * 8, t = sc.t0 - 1 + tt;
        u32x4 v = u32x4{0u, 0u, 0u, 0u};
        if (t >= 0 && t < sc.len) v = *(const u32x4*)(P + (size_t)(sc.base_row + t) * D_IN + cb * 64 + c8);
        *(u32x4*)(XIN + tt * 64 + c8) = v;
    }
    if (FINAL) {
        for (int idx = tid; idx < 64 * 8; idx += 256) {
            const int tt = idx >> 3, c8 = (idx & 7) * 8;
            *(u32x4*)(GT + tt * 72 + c8) = *(const u32x4*)(P + (size_t)(sc.base_row + sc.t0 + tt) * D_IN + D_LRU + cb * 64 + c8);
        }
    }
    __syncthreads();
    {
        const int c = tid & 63, ch = cb * 64 + c;
        const float w0 = p.lru_conv_w[ch], w1 = p.lru_conv_w[D_LRU + ch], w2 = p.lru_conv_w[2 * D_LRU + ch], w3 = p.lru_conv_w[3 * D_LRU + ch], bc = p.lru_conv_b[ch];
#pragma unroll 4
        for (int tt = tid >> 6; tt < 64; tt += 4)
            XB[tt * 72 + c] = f2bf(bc + bf2f(XIN[tt * 64 + c]) * w0 + bf2f(XIN[(tt + 1) * 64 + c]) * w1 + bf2f(XIN[(tt + 2) * 64 + c]) * w2 + bf2f(XIN[(tt + 3) * 64 + c]) * w3);
    }
    __syncthreads();
    float hs[4][4];
    float av[4][4], bv[4][4];
#pragma unroll
    for (int d = 0; d < 2; ++d) {
        f32x4 ga[4], gx[4];
#pragma unroll
        for (int nb = 0; nb < 4; ++nb) { ga[nb] = f32x4{0.f, 0.f, 0.f, 0.f}; gx[nb] = f32x4{0.f, 0.f, 0.f, 0.f}; }
        mmT<4, 2>(ga, XB, 72, wave, WT + (2 * d) * 64 * 72, 72, lane);
        mmT<4, 2>(gx, XB, 72, wave, WT + (2 * d + 1) * 64 * 72, 72, lane);
        float cA[4], cH[4];
#pragma unroll
        for (int nb = 0; nb < 4; ++nb) {
            const int ch = cb * 64 + nb * 16 + l15;
            const float ba = p.lru_ba[d * D_LRU + ch], bx = p.lru_bx[d * D_LRU + ch];
            const float sp8 = -8.0f * softplusf_(-p.lru_lam[d * D_LRU + ch]);
#pragma unroll
            for (int r = 0; r < 4; ++r) {
                const float rg = fsigm(ga[nb][r] + ba), ig = fsigm(gx[nb][r] + bx);
                const float a = FEXP(sp8 * rg);
                const float xv = bf2f(XB[(wave * 16 + q * 4 + r) * 72 + nb * 16 + l15]);
                av[nb][r] = a; bv[nb][r] = sqrtf(fmaxf(1.0f - a * a, 0.f)) * ig * xv;
            }
            float A, H;
            if (d == 0) { A = av[nb][0]; H = bv[nb][0];
#pragma unroll
                for (int r = 1; r < 4; ++r) { H = H * av[nb][r] + bv[nb][r]; A *= av[nb][r]; } }
            else { A = av[nb][3]; H = bv[nb][3];
#pragma unroll
                for (int r = 2; r >= 0; --r) { H = H * av[nb][r] + bv[nb][r]; A *= av[nb][r]; } }
#pragma unroll
            for (int st = 1; st <= 2; st <<= 1) {
                const float pA = d == 0 ? __shfl_up(A, 16 * st) : __shfl_down(A, 16 * st), pH = d == 0 ? __shfl_up(H, 16 * st) : __shfl_down(H, 16 * st);
                const bool has = d == 0 ? (q >= st) : (q + st <= 3);
                if (has) { H = pH * A + H; A = pA * A; }
            }
            cA[nb] = A; cH[nb] = H;
            const bool last = d == 0 ? (q == 3) : (q == 0);
            if (last) { CP[((d * 4 + wave) * 64 + nb * 16 + l15) * 2] = A; CP[((d * 4 + wave) * 64 + nb * 16 + l15) * 2 + 1] = H; }
        }
        __syncthreads();
        if (!FINAL) {
            if (wave == 0 && q == 0) {
#pragma unroll
                for (int nb = 0; nb < 4; ++nb) {
                    const int c = nb * 16 + l15;
                    float A = 1.f, H = 0.f;
#pragma unroll
                    for (int w = 0; w < 4; ++w) { const int ww = d == 0 ? w : 3 - w; const float wa = CP[((d * 4 + ww) * 64 + c) * 2], wh = CP[((d * 4 + ww) * 64 + c) * 2 + 1]; H = H * wa + wh; A *= wa; }
                    WSP(float, WS_SUMA)[((size_t)d * NCH + cg) * D_LRU + cb * 64 + c] = A;
                    WSP(float, WS_SUMH)[((size_t)d * NCH + cg) * D_LRU + cb * 64 + c] = H;
                }
            }
        } else {
#pragma unroll
            for (int nb = 0; nb < 4; ++nb) {
                const int c = nb * 16 + l15;
                float h = WSP(float, WS_CARRY)[((size_t)d * NLCH + cg) * D_LRU + cb * 64 + c];
#pragma unroll
                for (int w = 0; w < 3; ++w) { const int ww = d == 0 ? w : 3 - w; const bool use = d == 0 ? (ww < wave) : (ww > wave);
                    if (use) h = h * CP[((d * 4 + ww) * 64 + c) * 2] + CP[((d * 4 + ww) * 64 + c) * 2 + 1]; }
                const float eA = d == 0 ? __shfl_up(cA[nb], 16) : __shfl_down(cA[nb], 16), eH = d == 0 ? __shfl_up(cH[nb], 16) : __shfl_down(cH[nb], 16);
                const bool first = d == 0 ? (q == 0) : (q == 3);
                if (!first) h = h * eA + eH;
                if (d == 0) {
#pragma unroll
                    for (int r = 0; r < 4; ++r) { h = h * av[nb][r] + bv[nb][r]; hs[nb][r] = h; }
                } else {
#pragma unroll
                    for (int r = 3; r >= 0; --r) { h = h * av[nb][r] + bv[nb][r]; hs[nb][r] += h; }
                }
            }
        }
        __syncthreads();
    }
    if (FINAL) {
        float ss[4] = {0.f, 0.f, 0.f, 0.f};
#pragma unroll
        for (int nb = 0; nb < 4; ++nb) {
            const float gn = p.lru_norm_g[cb * 64 + nb * 16 + l15];
#pragma unroll
            for (int r = 0; r < 4; ++r) {
                const int tt = wave * 16 + q * 4 + r;
                const float v = hs[nb][r] * geluf_(bf2f(GT[tt * 72 + nb * 16 + l15]));
                ss[r] += v * v;
                XB[tt * 72 + nb * 16 + l15] = f2bf(v * gn);
            }
        }
#pragma unroll
        for (int r = 0; r < 4; ++r) {
#pragma unroll
            for (int o = 1; o < 16; o <<= 1) ss[r] += __shfl_xor(ss[r], o);
            if (l15 == 0) WSP(float, WS_SSQP)[(size_t)(sc.base_row + sc.t0 + wave * 16 + q * 4 + r) * LRU_BLOCKS + cb] = ss[r];
        }
        __syncthreads();
        bf16_t* MIX = WSP(bf16_t, WS_R3);
        for (int idx = tid; idx < 64 * 8; idx += 256) {
            const int tt = idx >> 3, c8 = (idx & 7) * 8;
            *(u32x4*)(MIX + (size_t)(sc.base_row + sc.t0 + tt) * D_MIX + cb * 64 + c8) = *(const u32x4*)(XB + tt * 72 + c8);
        }
    }
}
__device__ void phaseD(const Params& p, int bid, int nblk, char* smem) {
    int cur = -1;
    for (int it = bid; it < NCH * LRU_BLOCKS; it += nblk) {
        const int cb = it % LRU_BLOCKS, cg = it / LRU_BLOCKS;
        if (cb != cur) { __syncthreads(); lru_load_w(p, smem, cb); cur = cb; }
        lru_item<false>(p, smem, cg, cb);
    }
}
__device__ void phaseE(const Params& p, int bid, int nblk, char* smem) {
    const float* SUMA = WSP(float, WS_SUMA); const float* SUMH = WSP(float, WS_SUMH); float* CARRY = WSP(float, WS_CARRY);
    constexpr int NLB = SEQ / 64, NCB = CTX_LEN / 64;
    for (int g = bid * 256 + threadIdx.x; g < BATCH * 2 * D_LRU; g += nblk * 256) {
        const int c = g % D_LRU, d = (g / D_LRU) & 1, b = g / (2 * D_LRU);
        const float* sa = SUMA + (size_t)d * NCH * D_LRU + c; const float* sh = SUMH + (size_t)d * NCH * D_LRU + c;
        float* cr = CARRY + (size_t)d * NLCH * D_LRU + c;
        float h = 0.f;
        if (d == 0) {
            for (int q2 = 0; q2 < NCB; ++q2) { const int gi = NLCH + b * NCB + q2; h = sa[(size_t)gi * D_LRU] * h + sh[(size_t)gi * D_LRU]; }
            for (int q2 = 0; q2 < NLB; ++q2) { const int gi = b * NLB + q2; cr[(size_t)gi * D_LRU] = h; h = sa[(size_t)gi * D_LRU] * h + sh[(size_t)gi * D_LRU]; }
        } else {
            for (int q2 = NCB - 1; q2 >= 0; --q2) { const int gi = NLCH + b * NCB + q2; h = sa[(size_t)gi * D_LRU] * h + sh[(size_t)gi * D_LRU]; }
            for (int q2 = NLB - 1; q2 >= 0; --q2) { const int gi = b * NLB + q2; cr[(size_t)gi * D_LRU] = h; h = sa[(size_t)gi * D_LRU] * h + sh[(size_t)gi * D_LRU]; }
        }
    }
}
__device__ void phaseF(const Params& p, int bid, int nblk, char* smem) {
    int cur = -1;
    for (int it = bid; it < NLCH * LRU_BLOCKS; it += nblk) {
        const int cb = it % LRU_BLOCKS, cg = it / LRU_BLOCKS;
        if (cb != cur) { __syncthreads(); lru_load_w(p, smem, cb); cur = cb; }
        lru_item<true>(p, smem, cg, cb);
    }
}

__device__ __forceinline__ size_t rwkv_row(int seg, int b, int s) {
    if (seg == 0) return (size_t)(MLAT + b * CTX_LEN + s);
    const int r = s % ROWS, c = s / ROWS;
    return (size_t)(b * SEQ + r * GRID_W + c);
}
__device__ __forceinline__ void chunk_info(int d, int c, int& seg, int& p0, int& len) {
    if (c < NCC) { seg = 0; len = CTX_LEN; p0 = (d == 0 ? c : NCC - 1 - c) * RC; }
    else { const int cc = c - NCC; seg = 1; len = SEQ; p0 = (d == 0 ? cc : NLC - 1 - cc) * RC; }
}
__device__ __forceinline__ void unpack8(const u32x4 v, float* o) {
    o[0] = bitsf(v[0] << 16); o[1] = bitsf(v[0] & 0xFFFF0000u); o[2] = bitsf(v[1] << 16); o[3] = bitsf(v[1] & 0xFFFF0000u);
    o[4] = bitsf(v[2] << 16); o[5] = bitsf(v[2] & 0xFFFF0000u); o[6] = bitsf(v[3] << 16); o[7] = bitsf(v[3] & 0xFFFF0000u);
}
__device__ __forceinline__ void shifted8(const Params& p, const bf16_t* P, int seg, int b, int pos, int len, int ch0, float* o) {
    float z[8], zp[8], zn[8];
    unpack8(*(const u32x4*)(P + rwkv_row(seg, b, pos) * D_IN + RW0 + ch0), z);
    if (pos > 0) unpack8(*(const u32x4*)(P + rwkv_row(seg, b, pos - 1) * D_IN + RW0 + ch0), zp); else { for (int i = 0; i < 8; ++i) zp[i] = 0.f; }
    if (pos < len - 1) unpack8(*(const u32x4*)(P + rwkv_row(seg, b, pos + 1) * D_IN + RW0 + ch0), zn); else { for (int i = 0; i < 8; ++i) zn[i] = 0.f; }
    const f32x4 mp0 = ld4(p.mu_prev + ch0), mp1 = ld4(p.mu_prev + ch0 + 4), mn0 = ld4(p.mu_next + ch0), mn1 = ld4(p.mu_next + ch0 + 4);
#pragma unroll
    for (int i = 0; i < 4; ++i) { o[i] = z[i] + mp0[i] * (zp[i] - z[i]) + mn0[i] * (zn[i] - z[i]); o[4 + i] = z[4 + i] + mp1[i] * (zp[4 + i] - z[4 + i]) + mn1[i] * (zn[4 + i] - z[4 + i]); }
}
constexpr int LT = 72, LJ = 40;
constexpr int R_RF = 0, R_KF = 8192, R_VF = 16384, R_LW = 24576, R_IC = 32768;
constexpr int R_NBA = 0;
constexpr int R_NKA = 4608, R_MBR = R_NKA + 2560, R_MKR = R_MBR + 2560;
constexpr int R_XU = R_MKR + 2560;
constexpr int R_WA = R_XU + 8448, R_U0 = R_WA + 5120;
static_assert(R_U0 + 5120 <= 40960, "rwkv scratch");
constexpr int R_O = 40960;
constexpr int R_AH = R_O, R_BH = R_AH + 4608, R_KH = R_BH + 4608, R_RH = R_KH + 4608;
constexpr int R_VT = R_RH + 4608, R_BHT = R_VT + 5120, R_KHT = R_BHT + 5120;
constexpr int R_GC = R_KHT + 5120, R_TOT = R_GC + 256, R_END = R_TOT + 1024;
constexpr int R_TW = R_O, R_TA = R_TW + 4608, R_W2T = R_TA + 4608, R_A2T = R_W2T + 9216;
static_assert(R_A2T + 9216 <= R_END && R_END <= SMEM_BYTES, "rwkv lds");

__device__ void phaseR1(const Params& p, int bid, int nblk, char* smem) {
    const bf16_t* P = WSP(bf16_t, WS_R1);
    unsigned char* CH = p.ws + WS_CH;
    float* RBON = WSP(float, WS_RBON);
    float* Rf = (float*)(smem + R_RF); float* Kf = (float*)(smem + R_KF); float* Vf = (float*)(smem + R_VF); float* LW = (float*)(smem + R_LW); float* IC = (float*)(smem + R_IC);
    float* NbaT = (float*)(smem + R_NBA); bf16_t* NkaT = (bf16_t*)(smem + R_NKA); bf16_t* MbrT = (bf16_t*)(smem + R_MBR); bf16_t* MkrT = (bf16_t*)(smem + R_MKR);
    float* Xu = (float*)(smem + R_XU); bf16_t* Wa = (bf16_t*)(smem + R_WA); bf16_t* U0 = (bf16_t*)(smem + R_U0);
    bf16_t* Ah = (bf16_t*)(smem + R_AH); bf16_t* Bh = (bf16_t*)(smem + R_BH); bf16_t* Kh = (bf16_t*)(smem + R_KH); bf16_t* Rh = (bf16_t*)(smem + R_RH);
    bf16_t* VT = (bf16_t*)(smem + R_VT); bf16_t* BhT = (bf16_t*)(smem + R_BHT); bf16_t* KhT = (bf16_t*)(smem + R_KHT);
    float* GC = (float*)(smem + R_GC); float* TOT = (float*)(smem + R_TOT);
    bf16_t* TW = (bf16_t*)(smem + R_TW); bf16_t* TA = (bf16_t*)(smem + R_TA); bf16_t* W2T = (bf16_t*)(smem + R_W2T); bf16_t* A2T = (bf16_t*)(smem + R_A2T);
    const int tid = threadIdx.x, lane = tid & 63, wave = tid >> 6, q = lane >> 4, l15 = lane & 15;
    constexpr int NITEM = NCHAIN * NCK;
    const int per = (NITEM + nblk - 1) / nblk;
    const int it0 = bid * per, it1 = (it0 + per < NITEM) ? it0 + per : NITEM;
    for (int it = it0; it < it1; ++it) {
        const int chain = it / NCK, c = it % NCK;
        const int d = chain & 1, h = (chain >> 1) % HEADS, b = chain / (2 * HEADS);
        int seg, p0, len; chunk_info(d, c, seg, p0, len);
        unsigned char* chp = CH + (size_t)it * CH_BYTES;
        __syncthreads();
        {
#pragma unroll
            for (int kb = 0; kb < 5; kb += 3) {
            u32x4 zc[3], zp[3], zn[3];
#pragma unroll
            for (int k = 0; k < 3; ++k) if (kb + k < 5) {
                const int idx = tid + 256 * (kb + k), tau = idx / 40, g = idx % 40, grp = g >> 3, j0 = (g & 7) * 8;
                const int pos = p0 + (d ? RC - 1 - tau : tau);
                const int ch0 = (grp < 3) ? grp * D_RWKV + h * 64 + j0 : (grp == 3 ? 3 * D_RWKV + d * 64 + j0 : 3 * D_RWKV + 128 + d * 64 + j0);
                const u32x4 zero = u32x4{0u, 0u, 0u, 0u};
                zc[k] = *(const u32x4*)(P + rwkv_row(seg, b, pos) * D_IN + RW0 + ch0);
                zp[k] = (pos > 0) ? *(const u32x4*)(P + rwkv_row(seg, b, pos - 1) * D_IN + RW0 + ch0) : zero;
                zn[k] = (pos < len - 1) ? *(const u32x4*)(P + rwkv_row(seg, b, pos + 1) * D_IN + RW0 + ch0) : zero;
            }
#pragma unroll
            for (int k = 0; k < 3; ++k) if (kb + k < 5) {
                const int idx = tid + 256 * (kb + k), tau = idx / 40, g = idx % 40, grp = g >> 3, j0 = (g & 7) * 8;
                const int ch0 = (grp < 3) ? grp * D_RWKV + h * 64 + j0 : (grp == 3 ? 3 * D_RWKV + d * 64 + j0 : 3 * D_RWKV + 128 + d * 64 + j0);
                float z[8], zpv[8], znv[8], o[8];
                unpack8(zc[k], z); unpack8(zp[k], zpv); unpack8(zn[k], znv);
                const f32x4 mp0 = ld4(p.mu_prev + ch0), mp1 = ld4(p.mu_prev + ch0 + 4), mn0 = ld4(p.mu_next + ch0), mn1 = ld4(p.mu_next + ch0 + 4);
#pragma unroll
                for (int e = 0; e < 4; ++e) { o[e] = z[e] + mp0[e] * (zpv[e] - z[e]) + mn0[e] * (znv[e] - z[e]); o[4 + e] = z[4 + e] + mp1[e] * (zpv[4 + e] - z[4 + e]) + mn1[e] * (znv[4 + e] - z[4 + e]); }
                if (grp < 3) {
                    float* dst = (grp == 0 ? Rf : grp == 1 ? Kf : Vf) + tau * 64 + j0;
                    *(f32x4*)dst = f32x4{o[0], o[1], o[2], o[3]}; *(f32x4*)(dst + 4) = f32x4{o[4], o[5], o[6], o[7]};
                } else if (grp == 3) {
                    u32x4 w;
#pragma unroll
                    for (int e = 0; e < 4; ++e) { const float t0 = 2.0f / (1.0f + FEXP(-2.0f * o[2 * e])) - 1.0f, t1 = 2.0f / (1.0f + FEXP(-2.0f * o[2 * e + 1])) - 1.0f; w[e] = pk2(t0, t1); }
                    *(u32x4*)(TW + tau * LT + j0) = w;
                } else {
                    u32x4 w; w[0] = pk2(o[0], o[1]); w[1] = pk2(o[2], o[3]); w[2] = pk2(o[4], o[5]); w[3] = pk2(o[6], o[7]);
                    *(u32x4*)(TA + tau * LT + j0) = w;
                }
            }
            }
            f32x4 wv[8];
#pragma unroll
            for (int k = 0; k < 8; ++k) {
                const int idx = tid + 256 * k, which = idx >> 10, i = (idx >> 4) & 63, j4 = (idx & 15) * 4;
                wv[k] = ld4((which ? p.a2 : p.w2) + ((size_t)d * 64 + i) * D_RWKV + h * 64 + j4);
            }
#pragma unroll
            for (int k = 0; k < 8; ++k) {
                const int idx = tid + 256 * k, which = idx >> 10, i = (idx >> 4) & 63, j4 = (idx & 15) * 4;
                bf16_t* dst = (which ? A2T : W2T) + j4 * LT + i;
                dst[0] = f2bf(wv[k][0]); dst[LT] = f2bf(wv[k][1]); dst[2 * LT] = f2bf(wv[k][2]); dst[3 * LT] = f2bf(wv[k][3]);
            }
        }
        __syncthreads();
        {
            f32x4 aw[2] = {f32x4{0.f, 0.f, 0.f, 0.f}, f32x4{0.f, 0.f, 0.f, 0.f}}, ai[2] = {f32x4{0.f, 0.f, 0.f, 0.f}, f32x4{0.f, 0.f, 0.f, 0.f}};
            mmT<2, 2>(aw, W2T, LT, wave, TW, LT, lane);
            mmT<2, 2>(ai, A2T, LT, wave, TA, LT, lane);
            const int j = wave * 16 + q * 4;
            const f32x4 w0v = ld4(p.w0 + d * D_RWKV + h * 64 + j), a0v = ld4(p.a0 + d * D_RWKV + h * 64 + j);
#pragma unroll
            for (int nb = 0; nb < 2; ++nb) {
                const int tau = nb * 16 + l15;
                f32x4 lw, ic;
#pragma unroll
                for (int r = 0; r < 4; ++r) { lw[r] = -0.6065306597126334f * fsigm(w0v[r] + aw[nb][r]); ic[r] = fsigm(a0v[r] + ai[nb][r]); }
                *(f32x4*)(LW + tau * 64 + j) = lw; *(f32x4*)(IC + tau * 64 + j) = ic;
            }
        }
        __syncthreads();
        {
            const int j = lane, t0 = wave * 8, chj = h * 64 + j;
            const float kkc = p.k_k[chj], kac = p.k_a[chj], rkc = p.r_k[chj];
            float cum[8], kd[8], kkn[8], icv[8], rr[8], vv[8], run = 0.f;
#pragma unroll
            for (int i = 0; i < 8; ++i) {
                const int t = t0 + i;
                run += LW[t * 64 + j]; cum[i] = run;
                const float kr = Kf[t * 64 + j]; icv[i] = IC[t * 64 + j]; rr[i] = Rf[t * 64 + j]; vv[i] = Vf[t * 64 + j];
                kd[i] = kr * (1.0f + (icv[i] - 1.0f) * kac);
                const float kk = kr * kkc;
                const float n2 = wave_sum(kk * kk);
                kkn[i] = kk / fmaxf(sqrtf(n2), 1e-12f);
                const float bon = wave_sum(rr[i] * kd[i] * rkc);
                if (lane == 0) RBON[(size_t)it * RC + t] = bon;
            }
            TOT[wave * 64 + j] = run;
            __syncthreads();
            float off = 0.f;
            for (int w = 0; w < wave; ++w) off += TOT[w * 64 + j];
            u32x4 vt, bt, kt;
            float e_prev = 0.f;
#pragma unroll
            for (int i = 0; i < 8; ++i) {
                const int t = t0 + i;
                const float cu = off + cum[i], cprev = (i == 0) ? off : off + cum[i - 1];
                const float g = FEXP(cu), gi = FEXP(-cu), gm = FEXP(cprev);
                const float ah = -kkn[i] * gm, bh = kkn[i] * icv[i] * gi, kh = kd[i] * gi, rh = rr[i] * g;
                Ah[t * LT + j] = f2bf(ah); Bh[t * LT + j] = f2bf(bh); Kh[t * LT + j] = f2bf(kh); Rh[t * LT + j] = f2bf(rh);
                if (i & 1) { vt[i >> 1] = pk2(e_prev, vv[i]); bt[i >> 1] = (bt[i >> 1] & 0xFFFFu) | ((unsigned)f2bf(bh) << 16); kt[i >> 1] = (kt[i >> 1] & 0xFFFFu) | ((unsigned)f2bf(kh) << 16); }
                else { e_prev = vv[i]; bt[i >> 1] = f2bf(bh); kt[i >> 1] = f2bf(kh); }
                if (t == RC - 1) GC[j] = g;
            }
            *(u32x4*)(VT + j * LJ + t0) = vt; *(u32x4*)(BhT + j * LJ + t0) = bt; *(u32x4*)(KhT + j * LJ + t0) = kt;
        }
        __syncthreads();
        {
            const bf16_t* X = (wave & 1) ? Kh : Bh;
            const bf16_t* Y = (wave < 2) ? Ah : Rh;
#pragma unroll
            for (int xs = 0; xs < 2; ++xs) {
                f32x4 acc[2] = {f32x4{0.f, 0.f, 0.f, 0.f}, f32x4{0.f, 0.f, 0.f, 0.f}};
                mmT<2, 2>(acc, X, LT, xs, Y, LT, lane);
#pragma unroll
                for (int nb = 0; nb < 2; ++nb) {
                    const int t = nb * 16 + l15, s0 = xs * 16 + q * 4;
                    f32x4 v = acc[nb];
#pragma unroll
                    for (int r = 0; r < 4; ++r) { const int sidx = s0 + r; const bool keep = (wave < 2) ? (sidx < t) : (sidx <= t); v[r] = keep ? v[r] : 0.f; }
                    if (wave == 0) { *(f32x4*)(NbaT + t * 36 + s0) = v; }
                    else { bf16_t* dst = (wave == 1 ? NkaT : wave == 2 ? MbrT : MkrT) + t * LJ + s0; *(U2*)dst = pack4(v); }
                }
            }
        }
        __syncthreads();
        {
#pragma unroll
            for (int xs = 0; xs < 2; ++xs) {
                f32x4 acc[1] = {f32x4{0.f, 0.f, 0.f, 0.f}};
                mmT<1, 1>(acc, NkaT, LJ, xs, VT + wave * 16 * LJ, LJ, lane);
                const int i = wave * 16 + l15, tb = xs * 16 + q * 4;
                Xu[i * 33 + tb] = acc[0][0]; Xu[i * 33 + tb + 1] = acc[0][1]; Xu[i * 33 + tb + 2] = acc[0][2]; Xu[i * 33 + tb + 3] = acc[0][3];
            }
        }
        __syncthreads();
        if (tid < 128) {
            const int m = tid & 63, which = tid >> 6;
            float w[RC];
#pragma unroll
            for (int t = 0; t < RC; ++t) w[t] = 0.f;
#pragma unroll 1
            for (int t = 0; t < RC; ++t) {
                float acc = which ? Xu[m * 33 + t] : bf2f(Ah[t * LT + m]);
#pragma unroll
                for (int s4 = 0; s4 < RC / 4; ++s4) {
                    const f32x4 n = *(const f32x4*)(NbaT + t * 36 + s4 * 4);
                    acc += w[s4 * 4] * n[0] + w[s4 * 4 + 1] * n[1] + w[s4 * 4 + 2] * n[2] + w[s4 * 4 + 3] * n[3];
                }
#pragma unroll
                for (int s2 = 0; s2 < RC; ++s2) w[s2] = (s2 == t) ? acc : w[s2];
            }
            bf16_t* dst = (which ? U0 : Wa) + m * LJ;
#pragma unroll
            for (int t8 = 0; t8 < RC / 8; ++t8) {
                u32x4 o; o[0] = pk2(w[t8 * 8], w[t8 * 8 + 1]); o[1] = pk2(w[t8 * 8 + 2], w[t8 * 8 + 3]); o[2] = pk2(w[t8 * 8 + 4], w[t8 * 8 + 5]); o[3] = pk2(w[t8 * 8 + 6], w[t8 * 8 + 7]);
                *(u32x4*)(dst + t8 * 8) = o;
            }
        }
        __syncthreads();
        {
            bf16_t* gPm = (bf16_t*)(chp + CH_PM); bf16_t* gSA = (bf16_t*)(chp + CH_SA); bf16_t* gQT = (bf16_t*)(chp + CH_QT); bf16_t* gY0 = (bf16_t*)(chp + CH_Y0);
            const int x0 = wave * 16 + q * 4;
            {
                f32x4 acc[4] = {f32x4{0.f, 0.f, 0.f, 0.f}, f32x4{0.f, 0.f, 0.f, 0.f}, f32x4{0.f, 0.f, 0.f, 0.f}, f32x4{0.f, 0.f, 0.f, 0.f}};
                mmT<4, 1>(acc, Wa, LJ, wave, BhT, LJ, lane);
#pragma unroll
                for (int nb = 0; nb < 4; ++nb) {
                    const int jp = nb * 16 + l15; const float g = GC[jp];
                    f32x4 v = acc[nb];
#pragma unroll
                    for (int r = 0; r < 4; ++r) v[r] = (v[r] + ((x0 + r == jp) ? 1.0f : 0.0f)) * g;
                    *(U2*)(gPm + jp * 64 + x0) = pack4(v);
                }
            }
            {
                f32x4 acc[4] = {f32x4{0.f, 0.f, 0.f, 0.f}, f32x4{0.f, 0.f, 0.f, 0.f}, f32x4{0.f, 0.f, 0.f, 0.f}, f32x4{0.f, 0.f, 0.f, 0.f}};
                mmT<4, 1>(acc, BhT, LJ, wave, U0, LJ, lane);
                mmT<4, 1>(acc, KhT, LJ, wave, VT, LJ, lane);
                const f32x4 g = *(const f32x4*)(GC + x0);
#pragma unroll
                for (int nb = 0; nb < 4; ++nb) *(U2*)(gSA + (nb * 16 + l15) * 64 + x0) = pack4(acc[nb] * g);
            }
            if (seg == 1) {
                {
                    f32x4 acc[2] = {f32x4{0.f, 0.f, 0.f, 0.f}, f32x4{0.f, 0.f, 0.f, 0.f}};
                    mmT<2, 1>(acc, Wa, LJ, wave, MbrT, LJ, lane);
#pragma unroll
                    for (int nb = 0; nb < 2; ++nb) {
                        const int t = nb * 16 + l15;
                        f32x4 v = acc[nb];
#pragma unroll
                        for (int r = 0; r < 4; ++r) v[r] += bf2f(Rh[t * LT + x0 + r]);
                        *(U2*)(gQT + t * 64 + x0) = pack4(v);
                    }
                }
                {
                    f32x4 acc[2] = {f32x4{0.f, 0.f, 0.f, 0.f}, f32x4{0.f, 0.f, 0.f, 0.f}};
                    mmT<2, 1>(acc, U0, LJ, wave, MbrT, LJ, lane);
                    mmT<2, 1>(acc, VT, LJ, wave, MkrT, LJ, lane);
#pragma unroll
                    for (int nb = 0; nb < 2; ++nb) *(U2*)(gY0 + (nb * 16 + l15) * 64 + x0) = pack4(acc[nb]);
                }
            }
        }
    }
}

__device__ __forceinline__ U2 ldu2(const bf16_t* p) { return *(const U2*)p; }
__device__ __forceinline__ void r2_load(u32x4 (&AF)[8], U2 (&SA)[4], const unsigned char* chbase, int c, int i, int q, int l15) {
    const unsigned char* chp = chbase + (size_t)(c < NCK ? c : NCK - 1) * CH_BYTES;
    const bf16_t* gPm = (const bf16_t*)(chp + CH_PM) + l15 * 64 + 4 * q; const bf16_t* gSA = (const bf16_t*)(chp + CH_SA) + i * 64 + 4 * q;
#pragma unroll
    for (int mt = 0; mt < 4; ++mt)
#pragma unroll
        for (int ks = 0; ks < 2; ++ks) {
            const U2 lo = ldu2(gPm + mt * 1024 + 32 * ks), hi = ldu2(gPm + mt * 1024 + 32 * ks + 16);
            AF[mt * 2 + ks] = u32x4{lo.x, lo.y, hi.x, hi.y};
        }
#pragma unroll
    for (int nt = 0; nt < 4; ++nt) SA[nt] = ldu2(gSA + nt * 16);
}
__device__ __forceinline__ void r2_step(f32x4 (&st)[4], const u32x4 (&AF)[8], const U2 (&SA)[4], unsigned char* chbase, int c, int i, int q) {
    if (c >= NCK) return;
    bf16_t* gSA = (bf16_t*)(chbase + (size_t)c * CH_BYTES + CH_SA) + i * 64 + 4 * q;
    bf16x8 bfr[2];
#pragma unroll
    for (int ks = 0; ks < 2; ++ks) {
        const U2 lo = pack4(st[2 * ks]), hi = pack4(st[2 * ks + 1]);
        bfr[ks] = __builtin_bit_cast(bf16x8, u32x4{lo.x, lo.y, hi.x, hi.y});
        *(U2*)(gSA + (2 * ks) * 16) = lo; *(U2*)(gSA + (2 * ks + 1) * 16) = hi;
    }
#pragma unroll
    for (int nt = 0; nt < 4; ++nt) {
        f32x4 acc = f32x4{bitsf(SA[nt].x << 16), bitsf(SA[nt].x & 0xFFFF0000u), bitsf(SA[nt].y << 16), bitsf(SA[nt].y & 0xFFFF0000u)};
#pragma unroll
        for (int ks = 0; ks < 2; ++ks) acc = MFMA16(__builtin_bit_cast(bf16x8, AF[nt * 2 + ks]), bfr[ks], acc);
        st[nt] = acc;
    }
}
__device__ void phaseR2(const Params& p, int bid, int nblk, char* smem) {
    unsigned char* CH = p.ws + WS_CH;
    const int lane = threadIdx.x & 63, wave = threadIdx.x >> 6, q = lane >> 4, l15 = lane & 15;
    for (int chain = bid; chain < NCHAIN; chain += nblk) {
        const int i = wave * 16 + l15;
        unsigned char* chbase = CH + (size_t)chain * NCK * CH_BYTES;
        f32x4 st[4];
#pragma unroll
        for (int nt = 0; nt < 4; ++nt) st[nt] = f32x4{0.f, 0.f, 0.f, 0.f};
        u32x4 a0[8], a1[8], a2[8]; U2 s0[4], s1[4], s2[4];
        r2_load(a0, s0, chbase, 0, i, q, l15); r2_load(a1, s1, chbase, 1, i, q, l15);
#pragma unroll 1
        for (int c = 0; c < NCK; c += 3) {
            r2_load(a2, s2, chbase, c + 2, i, q, l15); r2_step(st, a0, s0, chbase, c, i, q);
            r2_load(a0, s0, chbase, c + 3, i, q, l15); r2_step(st, a1, s1, chbase, c + 1, i, q);
            r2_load(a1, s1, chbase, c + 4, i, q, l15); r2_step(st, a2, s2, chbase, c + 2, i, q);
        }
    }
}

__device__ void phaseR3(const Params& p, int bid, int nblk, char* smem) {
    const bf16_t* P = WSP(bf16_t, WS_R1);
    const unsigned char* CH = p.ws + WS_CH;
    const float* RBON = WSP(float, WS_RBON);
    bf16_t* MIX = WSP(bf16_t, WS_R3);
    float* red = (float*)smem;
    const int tid = threadIdx.x, lane = tid & 63, wave = tid >> 6, q = lane >> 4, l15 = lane & 15;
    for (int m = bid * 256 + tid; m < MLAT; m += nblk * 256) {
        const float* sp = WSP(float, WS_SSQP) + (size_t)m * LRU_BLOCKS;
        float sq = 0.f;
#pragma unroll
        for (int c = 0; c < LRU_BLOCKS; ++c) sq += sp[c];
        WSP(float, WS_RINV)[m] = 1.0f / sqrtf(sq * (1.0f / D_LRU) + RMS_EPS);
    }
    for (int it = bid; it < BATCH * HEADS * NLC; it += nblk) {
        const int pc = it % NLC, h = (it / NLC) % HEADS, b = it / (NLC * HEADS);
        const int i0 = wave * 16 + q * 4;
        f32x4 y[2] = {f32x4{0.f, 0.f, 0.f, 0.f}, f32x4{0.f, 0.f, 0.f, 0.f}};
        float bon[2] = {0.f, 0.f};
#pragma unroll
        for (int d = 0; d < 2; ++d) {
            const int chain = (b * HEADS + h) * 2 + d, c = NCC + (d ? NLC - 1 - pc : pc);
            const size_t item = (size_t)chain * NCK + c;
            const unsigned char* chp = CH + item * CH_BYTES;
            const bf16_t* gS = (const bf16_t*)(chp + CH_SA); const bf16_t* gQT = (const bf16_t*)(chp + CH_QT); const bf16_t* gY0 = (const bf16_t*)(chp + CH_Y0);
#pragma unroll
            for (int nb = 0; nb < 2; ++nb) {
                const int pl = nb * 16 + l15, tau = d ? RC - 1 - pl : pl;
                const U2 y0 = ldu2(gY0 + tau * 64 + i0);
                f32x4 acc = f32x4{bitsf(y0.x << 16), bitsf(y0.x & 0xFFFF0000u), bitsf(y0.y << 16), bitsf(y0.y & 0xFFFF0000u)};
#pragma unroll
                for (int ks = 0; ks < 2; ++ks) {
                    const bf16x8 xf = *(const bf16x8*)(gS + (wave * 16 + l15) * 64 + ks * 32 + 8 * q);
                    const bf16x8 yf = *(const bf16x8*)(gQT + tau * 64 + ks * 32 + 8 * q);
                    acc = MFMA16(xf, yf, acc);
                }
                y[nb] += acc;
                bon[nb] += RBON[item * RC + tau];
            }
        }
        f32x4 g[2] = {f32x4{0.f, 0.f, 0.f, 0.f}, f32x4{0.f, 0.f, 0.f, 0.f}};
#pragma unroll
        for (int ks = 0; ks < 4; ++ks) {
            bf16x8 xf;
#pragma unroll
            for (int jj = 0; jj < 8; ++jj) xf[jj] = (short)f2bf(p.g2[(size_t)(ks * 32 + 8 * q + jj) * D_RWKV + h * 64 + wave * 16 + l15]);
#pragma unroll
            for (int nb = 0; nb < 2; ++nb) {
                const int pos = pc * RC + nb * 16 + l15;
                float o[8]; shifted8(p, P, 1, b, pos, SEQ, 3 * D_RWKV + 256 + ks * 32 + 8 * q, o);
                u32x4 t; t[0] = pk2(fsigm(o[0]), fsigm(o[1])); t[1] = pk2(fsigm(o[2]), fsigm(o[3])); t[2] = pk2(fsigm(o[4]), fsigm(o[5])); t[3] = pk2(fsigm(o[6]), fsigm(o[7]));
                g[nb] = MFMA16(xf, __builtin_bit_cast(bf16x8, t), g[nb]);
            }
        }
        float s1[2], s2[2];
#pragma unroll
        for (int nb = 0; nb < 2; ++nb) {
            float a = hsum4(y[nb]), bq = hsum4(y[nb] * y[nb]);
            a += __shfl_xor(a, 16); a += __shfl_xor(a, 32); bq += __shfl_xor(bq, 16); bq += __shfl_xor(bq, 32);
            s1[nb] = a; s2[nb] = bq;
        }
        __syncthreads();
        if (q == 0) { red[(0 * 4 + wave) * 32 + l15] = s1[0]; red[(0 * 4 + wave) * 32 + 16 + l15] = s1[1]; red[(1 * 4 + wave) * 32 + l15] = s2[0]; red[(1 * 4 + wave) * 32 + 16 + l15] = s2[1]; }
        __syncthreads();
        const f32x4 gng = ld4(p.gn_g + h * 64 + i0), gnb = ld4(p.gn_b + h * 64 + i0);
#pragma unroll
        for (int nb = 0; nb < 2; ++nb) {
            const int pl = nb * 16 + l15, pos = pc * RC + pl;
            float t1 = 0.f, t2 = 0.f;
#pragma unroll
            for (int w = 0; w < 4; ++w) { t1 += red[(0 * 4 + w) * 32 + pl]; t2 += red[(1 * 4 + w) * 32 + pl]; }
            const float mu = t1 * (1.0f / 64.0f), var = fmaxf(t2 * (1.0f / 64.0f) - mu * mu, 0.f), rstd = 1.0f / sqrtf(var + GN_EPS);
            const int chv = 2 * D_RWKV + h * 64 + i0;
            const size_t mrow = rwkv_row(1, b, pos);
            const U2 zc = ldu2(P + mrow * D_IN + RW0 + chv);
            U2 zp; zp.x = 0u; zp.y = 0u; U2 zn = zp;
            if (pos > 0) zp = ldu2(P + rwkv_row(1, b, pos - 1) * D_IN + RW0 + chv);
            if (pos < SEQ - 1) zn = ldu2(P + rwkv_row(1, b, pos + 1) * D_IN + RW0 + chv);
            const f32x4 z = f32x4{bitsf(zc.x << 16), bitsf(zc.x & 0xFFFF0000u), bitsf(zc.y << 16), bitsf(zc.y & 0xFFFF0000u)};
            const f32x4 zpv = f32x4{bitsf(zp.x << 16), bitsf(zp.x & 0xFFFF0000u), bitsf(zp.y << 16), bitsf(zp.y & 0xFFFF0000u)};
            const f32x4 znv = f32x4{bitsf(zn.x << 16), bitsf(zn.x & 0xFFFF0000u), bitsf(zn.y << 16), bitsf(zn.y & 0xFFFF0000u)};
            const f32x4 v = z + ld4(p.mu_prev + chv) * (zpv - z) + ld4(p.mu_next + chv) * (znv - z);
            const f32x4 yn = (y[nb] - mu) * rstd * gng + gnb;
            *(U2*)(MIX + mrow * D_MIX + D_LRU + h * 64 + i0) = pack4((yn + bon[nb] * v) * g[nb]);
        }
    }
}

__device__ void phaseJ(const Params& p, int bid, int nblk, char* smem) {
    const bf16_t* MIX = WSP(bf16_t, WS_R3);
    float* YOUT = WSP(float, WS_R1);
    constexpr int NTN = D_MODEL / 128, NTM = MLAT / 128;
    const float* RINV = WSP(float, WS_RINV);
    for (int it = bid; it < NTN * NTM; it += nblk) {
        const int mt = it / NTN, nt = it % NTN;
        gemm_tile<false>(smem, MIX, D_MIX, nullptr, mt * 128, p.w_out, nullptr, D_MODEL, nt * 128, D_MIX, [&](int ml, int nl, f32x4 v, f32x4) {
            *(f32x4*)(YOUT + (size_t)(mt * 128 + ml) * D_MODEL + nt * 128 + nl) = v;
        }, RINV, D_LRU / 64);
    }
}

__device__ void phaseK(const Params& p, int bid, int nblk, char* smem) {
    const int lane = threadIdx.x & 63, wave = threadIdx.x >> 6;
    const float* MOD = WSP(float, WS_MOD); const float* STATS = WSP(float, WS_STATS);
    const float* YOUT = WSP(float, WS_R1);
    float* H1 = WSP(float, WS_R5); bf16_t* U2b = WSP(bf16_t, WS_R6); float* AFF = WSP(float, WS_AFF);
    for (int row = bid * 4 + wave; row < MLAT; row += nblk * 4) {
        const float* xr = p.x + (size_t)row * D_MODEL;
        const float* md = MOD + (size_t)(row / SEQ) * 6 * D_MODEL;
        const float mu0 = STATS[row * 2], rs0 = STATS[row * 2 + 1];
        f32x4 v0, v1, v2, v3; float s = 0.f;
#define PK_LOAD(V, J) { const int k = (J) * 256 + lane * 4; \
            V = ALPHA_F * ((ld4(xr + k) - mu0) * rs0 * ld4(p.ln_in_g + k) + ld4(p.ln_in_b + k)) + ld4(md + 2 * D_MODEL + k) * ld4(YOUT + (size_t)row * D_MODEL + k); s += hsum4(V); }
        PK_LOAD(v0, 0)
        if (NV > 1) PK_LOAD(v1, 1) else v1 = f32x4{0.f, 0.f, 0.f, 0.f};
        if (NV > 2) { PK_LOAD(v2, 2) PK_LOAD(v3, 3) } else { v2 = v1; v3 = v1; }
#undef PK_LOAD
        const float mu = wave_sum(s) * (1.0f / D_MODEL);
        v0 -= mu; float s2 = hsum4(v0 * v0);
        if (NV > 1) { v1 -= mu; s2 += hsum4(v1 * v1); }
        if (NV > 2) { v2 -= mu; v3 -= mu; s2 += hsum4(v2 * v2) + hsum4(v3 * v3); }
        const float rstd = 1.0f / sqrtf(wave_sum(s2) * (1.0f / D_MODEL) + LN_EPS);
        float lg[N_EXPERTS];
#pragma unroll
        for (int e = 0; e < N_EXPERTS; ++e) lg[e] = 0.f;
#pragma unroll
        for (int j = 0; j < NV; ++j) {
            const int k = j * 256 + lane * 4;
            const f32x4 vv = (j == 0) ? v0 : (j == 1) ? v1 : (j == 2) ? v2 : v3;
            const f32x4 h = vv * rstd * ld4(p.ln1_g + k) + ld4(p.ln1_b + k);
            *(f32x4*)(H1 + (size_t)row * D_MODEL + k) = h;
            const f32x4 u = h * (1.0f + ld4(md + 4 * D_MODEL + k)) + ld4(md + 3 * D_MODEL + k);
            *(U2*)(U2b + (size_t)row * D_MODEL + k) = pack4(u);
#pragma unroll
            for (int q = 0; q < 4; ++q) {
                const float* wr = p.w_router + (size_t)(k + q) * N_EXPERTS;
#pragma unroll
                for (int e4 = 0; e4 < N_EXPERTS / 4; ++e4) {
                    const f32x4 w = ld4(wr + e4 * 4);
                    lg[e4 * 4 + 0] += u[q] * w[0]; lg[e4 * 4 + 1] += u[q] * w[1]; lg[e4 * 4 + 2] += u[q] * w[2]; lg[e4 * 4 + 3] += u[q] * w[3];
                }
            }
        }
        float mx = -3.0e38f;
#pragma unroll
        for (int e = 0; e < N_EXPERTS; ++e) { lg[e] = wave_sum(lg[e]); mx = fmaxf(mx, lg[e]); }
        float den = 0.f;
#pragma unroll
        for (int e = 0; e < N_EXPERTS; ++e) { lg[e] = expf(lg[e] - mx); den += lg[e]; }
        float mine = 0.f;
#pragma unroll
        for (int e = 0; e < N_EXPERTS; ++e) mine = (lane == e) ? lg[e] : mine;
        if (lane < N_EXPERTS) AFF[(size_t)row * N_EXPERTS + lane] = mine / den;
    }
}

__device__ __forceinline__ int block_sum_int(int v, int* red) {
    const int lane = threadIdx.x & 63, wave = threadIdx.x >> 6;
#pragma unroll
    for (int o = 1; o < 64; o <<= 1) v += __shfl_xor(v, o);
    __syncthreads();
    if (lane == 0) red[wave] = v;
    __syncthreads();
    return red[0] + red[1] + red[2] + red[3];
}
__device__ void phaseL(const Params& p, int bid, int nblk, char* smem) {
    const float* AFF = WSP(float, WS_AFF);
    int* IDX = WSP(int, WS_IDX); float* GATE = WSP(float, WS_GATE); int* SLOTOF = WSP(int, WS_SLOT);
    unsigned* vals = (unsigned*)smem;
    int* red = (int*)(vals + SEQ);
    int* wsum = red + 8;
    const int tid = threadIdx.x, lane = tid & 63, wave = tid >> 6;
    constexpr int PER = SEQ / 256;
    for (int be = bid; be < BATCH * N_EXPERTS; be += nblk) {
        const int b = be / N_EXPERTS, e = be % N_EXPERTS;
        __syncthreads();
        for (int t = tid; t < SEQ; t += 256) vals[t] = fbits(AFF[((size_t)b * SEQ + t) * N_EXPERTS + e]);
        __syncthreads();
        unsigned lo = 0u, hi = 0x7F800000u;
        while (lo < hi) {
            const unsigned mid = lo + (hi - lo + 1u) / 2u;
            int c = 0;
            for (int t = tid; t < SEQ; t += 256) c += (vals[t] >= mid) ? 1 : 0;
            c = block_sum_int(c, red);
            if (c >= CAP) lo = mid; else hi = mid - 1u;
        }
        const unsigned T = lo;
        int cg = 0, ce = 0;
        for (int q = 0; q < PER; ++q) { const unsigned v = vals[tid * PER + q]; cg += (v > T) ? 1 : 0; ce += (v == T) ? 1 : 0; }
        int pg = cg, pe = ce;
#pragma unroll
        for (int o = 1; o < 64; o <<= 1) { const int a = __shfl_up(pg, o), bb = __shfl_up(pe, o); if (lane >= o) { pg += a; pe += bb; } }
        __syncthreads();
        if (lane == 63) { wsum[wave] = pg; wsum[4 + wave] = pe; }
        __syncthreads();
        int og = 0, oe = 0, totg = 0;
        for (int w = 0; w < 4; ++w) { if (w < wave) { og += wsum[w]; oe += wsum[4 + w]; } totg += wsum[w]; }
        int posg = og + pg - cg, pose = oe + pe - ce;
        const int need_eq = CAP - totg;
        for (int q = 0; q < PER; ++q) {
            const int t = tid * PER + q; const unsigned v = vals[t];
            int slot = -1;
            if (v > T) { slot = posg++; }
            else if (v == T) { if (pose < need_eq) slot = totg + pose; pose++; }
            if (slot >= 0) { IDX[(size_t)be * CAP + slot] = b * SEQ + t; GATE[(size_t)be * CAP + slot] = bitsf(v); }
            SLOTOF[((size_t)b * SEQ + t) * N_EXPERTS + e] = slot;
        }
    }
}

__device__ void phaseM(const Params& p, int bid, int nblk, char* smem) {
    const bf16_t* U2b = WSP(bf16_t, WS_R6); const int* IDX = WSP(int, WS_IDX);
    bf16_t* HID = WSP(bf16_t, WS_R1);
    constexpr int NTN = D_EXPERT / 64, NTM = CAP / 128;
    for (int it = bid; it < BATCH * N_EXPERTS * NTM * NTN; it += nblk) {
        const int nt = it % NTN, mt = (it / NTN) % NTM, be = it / (NTN * NTM), e = be % N_EXPERTS;
        const float* wg = p.w_gate + (size_t)e * D_MODEL * D_EXPERT; const float* wu = p.w_up + (size_t)e * D_MODEL * D_EXPERT;
        gemm_tile<true>(smem, U2b, D_MODEL, IDX + (size_t)be * CAP, mt * 128, wg, wu, D_EXPERT, nt * 64, D_MODEL, [&](int ml, int nl, f32x4 g, f32x4 u) {
            U2 o; o.x = pk2(siluf_(g[0]) * u[0], siluf_(g[1]) * u[1]); o.y = pk2(siluf_(g[2]) * u[2], siluf_(g[3]) * u[3]);
            *(U2*)(HID + ((size_t)be * CAP + mt * 128 + ml) * D_EXPERT + nt * 64 + nl) = o;
        });
    }
}
__device__ void phaseN(const Params& p, int bid, int nblk, char* smem) {
    const bf16_t* HID = WSP(bf16_t, WS_R1); const float* GATE = WSP(float, WS_GATE);
    bf16_t* YS = WSP(bf16_t, WS_R2);
    constexpr int NTN = D_MODEL / 128, NTM = CAP / 128;
    for (int it = bid; it < BATCH * N_EXPERTS * NTM * NTN; it += nblk) {
        const int nt = it % NTN, mt = (it / NTN) % NTM, be = it / (NTN * NTM), e = be % N_EXPERTS;
        const float* wd = p.w_down + (size_t)e * D_EXPERT * D_MODEL;
        gemm_tile<false>(smem, HID + (size_t)be * CAP * D_EXPERT, D_EXPERT, nullptr, mt * 128, wd, nullptr, D_MODEL, nt * 128, D_EXPERT, [&](int ml, int nl, f32x4 v, f32x4) {
            const int slot = mt * 128 + ml;
            const float gt = GATE[(size_t)be * CAP + slot];
            *(U2*)(YS + ((size_t)be * CAP + slot) * D_MODEL + nt * 128 + nl) = pack4(v * gt);
        });
    }
}
__device__ void phaseO(const Params& p, int bid, int nblk, char* smem) {
    const int lane = threadIdx.x & 63, wave = threadIdx.x >> 6;
    const float* MOD = WSP(float, WS_MOD); const float* H1 = WSP(float, WS_R5); const bf16_t* YS = WSP(bf16_t, WS_R2); const int* SLOTOF = WSP(int, WS_SLOT);
    for (int row = bid * 4 + wave; row < MLAT; row += nblk * 4) {
        const float* md = MOD + (size_t)(row / SEQ) * 6 * D_MODEL;
        f32x4 v0, v1, v2, v3; float s = 0.f;
        f32x4 y0 = f32x4{0.f, 0.f, 0.f, 0.f}, y1 = y0, y2 = y0, y3 = y0;
        const int myslot = (lane < N_EXPERTS) ? SLOTOF[(size_t)row * N_EXPERTS + lane] : -1;
        const int bbase = (row / SEQ) * N_EXPERTS;
        for (int e = 0; e < N_EXPERTS; ++e) {
            const int sl = __shfl(myslot, e);
            if (sl >= 0) {
                const bf16_t* yr = YS + ((size_t)(bbase + e) * CAP + sl) * D_MODEL + lane * 4;
                { const U2 u = *(const U2*)yr; y0 += f32x4{bitsf(u.x << 16), bitsf(u.x & 0xFFFF0000u), bitsf(u.y << 16), bitsf(u.y & 0xFFFF0000u)}; }
                if (NV > 1) { const U2 u = *(const U2*)(yr + 256); y1 += f32x4{bitsf(u.x << 16), bitsf(u.x & 0xFFFF0000u), bitsf(u.y << 16), bitsf(u.y & 0xFFFF0000u)}; }
                if (NV > 2) { const U2 u = *(const U2*)(yr + 512); y2 += f32x4{bitsf(u.x << 16), bitsf(u.x & 0xFFFF0000u), bitsf(u.y << 16), bitsf(u.y & 0xFFFF0000u)};
                              const U2 w = *(const U2*)(yr + 768); y3 += f32x4{bitsf(w.x << 16), bitsf(w.x & 0xFFFF0000u), bitsf(w.y << 16), bitsf(w.y & 0xFFFF0000u)}; }
            }
        }
#define PO_LOAD(V, J) { const int k = (J) * 256 + lane * 4; const f32x4 yy = ((J) == 0) ? y0 : ((J) == 1) ? y1 : ((J) == 2) ? y2 : y3; V = ALPHA_F * ld4(H1 + (size_t)row * D_MODEL + k) + ld4(md + 5 * D_MODEL + k) * yy; s += hsum4(V); }
        PO_LOAD(v0, 0)
        if (NV > 1) PO_LOAD(v1, 1) else v1 = f32x4{0.f, 0.f, 0.f, 0.f};
        if (NV > 2) { PO_LOAD(v2, 2) PO_LOAD(v3, 3) } else { v2 = v1; v3 = v1; }
#undef PO_LOAD
        const float mu = wave_sum(s) * (1.0f / D_MODEL);
        v0 -= mu; float s2 = hsum4(v0 * v0);
        if (NV > 1) { v1 -= mu; s2 += hsum4(v1 * v1); }
        if (NV > 2) { v2 -= mu; v3 -= mu; s2 += hsum4(v2 * v2) + hsum4(v3 * v3); }
        const float rstd = 1.0f / sqrtf(wave_sum(s2) * (1.0f / D_MODEL) + LN_EPS);
#pragma unroll
        for (int j = 0; j < NV; ++j) {
            const int k = j * 256 + lane * 4;
            const f32x4 vv = (j == 0) ? v0 : (j == 1) ? v1 : (j == 2) ? v2 : v3;
            *(f32x4*)(p.out + (size_t)row * D_MODEL + k) = vv * rstd * ld4(p.ln2_g + k) + ld4(p.ln2_b + k);
        }
    }
}

#define XB_TMO      128
#define XB_XCNT(j)  (256  + 64 * (j))
#define XB_XSUB(j)  (1280 + 64 * (j))
#define XB_XGEN(j)  (2304 + 64 * (j))
#define XB_TOP      3328
#define XB_TOPGEN   3392
#define XCD_BAR_WORDS 3456
#define XB_SPIN_CAP (1u << 22)
#ifndef HOST_EMU
__device__ __forceinline__ unsigned xb_ld(unsigned* p) { return __hip_atomic_load(p, __ATOMIC_RELAXED, __HIP_MEMORY_SCOPE_AGENT); }
__device__ __forceinline__ unsigned xb_add(unsigned* p, unsigned v) { return __hip_atomic_fetch_add(p, v, __ATOMIC_RELAXED, __HIP_MEMORY_SCOPE_AGENT); }
__device__ __forceinline__ unsigned xb_xcc_id() { return (unsigned)__builtin_amdgcn_s_getreg((3 << 11) | 20) & 0xFu; }
#define XB_SPIN(cond, bar) do { unsigned _sp = 0; while (cond) { __builtin_amdgcn_s_sleep(1); \
    if ((++_sp & 255u) == 0u) { if (xb_ld(&(bar)[XB_TMO])) break; if (_sp > XB_SPIN_CAP) { atomicAdd(&(bar)[XB_TMO], 1u); break; } } } } while (0)
struct XcdBarrier { unsigned* bar; unsigned x; unsigned* st; };
__device__ __forceinline__ XcdBarrier xcd_barrier_post(unsigned* bar, unsigned* st) {
    XcdBarrier b; b.bar = bar; b.x = xb_xcc_id(); b.st = st;
    if (threadIdx.x == 0) (void)xb_add(&bar[XB_XCNT(b.x)], 1u);
    return b;
}
__device__ __forceinline__ void xcd_barrier_complete(unsigned* bar, unsigned x, unsigned& nloc, unsigned& nx) {
    const unsigned G = gridDim.x;
    unsigned sum, cnt, mine, sp = 0u;
    for (;;) {
        sum = 0u; cnt = 0u; mine = 0u;
#pragma unroll
        for (unsigned j = 0; j < 16; ++j) { const unsigned c = xb_ld(&bar[XB_XCNT(j)]); sum += c; cnt += (c > 0u) ? 1u : 0u; mine = (j == x) ? c : mine; }
        if (sum == G) break;
        __builtin_amdgcn_s_sleep(1);
        if ((++sp & 255u) == 0u) { if (xb_ld(&bar[XB_TMO])) break; if (sp > XB_SPIN_CAP) { atomicAdd(&bar[XB_TMO], 1u); break; } }
    }
    nloc = mine > 0u ? mine : 1u; nx = cnt > 0u ? cnt : 1u;
}
__device__ __forceinline__ void grid_barrier(const XcdBarrier& b) {
    asm volatile("s_waitcnt vmcnt(0)" ::: "memory");
    __syncthreads();
    if (threadIdx.x == 0) {
        unsigned* bar = b.bar;
        __builtin_amdgcn_s_waitcnt(0);
        volatile unsigned* st = b.st;
        unsigned nloc = st[0], nx = st[1];
        if (nloc == 0u) { xcd_barrier_complete(bar, b.x, nloc, nx); st[0] = nloc; st[1] = nx; }
        const unsigned old = xb_add(&bar[XB_XSUB(b.x)], 1u);
        const unsigned gen = old / nloc;
        if (old + 1u == (gen + 1u) * nloc) {
            __builtin_amdgcn_fence(__ATOMIC_RELEASE, "agent");
            asm volatile("s_waitcnt vmcnt(0)" ::: "memory");
            const unsigned og = xb_add(&bar[XB_TOP], 1u);
            const unsigned tg = og / nx;
            if (og + 1u == (tg + 1u) * nx) xb_add(&bar[XB_TOPGEN], 1u);
            else XB_SPIN(xb_ld(&bar[XB_TOPGEN]) == tg, bar);
            __builtin_amdgcn_fence(__ATOMIC_ACQUIRE, "agent");
            xb_add(&bar[XB_XGEN(b.x)], 1u);
            asm volatile("s_waitcnt vmcnt(0)" ::: "memory");
        } else {
            XB_SPIN(xb_ld(&bar[XB_XGEN(b.x)]) == gen, bar);
            __builtin_amdgcn_fence(__ATOMIC_ACQUIRE, "agent");
            asm volatile("s_waitcnt vmcnt(0)" ::: "memory");
        }
    }
    __syncthreads();
}
#else
struct XcdBarrier { int dummy; };
__device__ __forceinline__ XcdBarrier xcd_barrier_post(unsigned*, unsigned*) { return XcdBarrier{0}; }
__device__ __forceinline__ void grid_barrier(const XcdBarrier&) { __syncthreads(); }
#endif

__global__ void __launch_bounds__(256, 2) fused_forward(Params p) {
    __shared__ __attribute__((aligned(16))) char smem[SMEM_BYTES];
    __shared__ __attribute__((aligned(16))) unsigned xb_words[4];
    if (threadIdx.x == 0) { xb_words[0] = 0u; xb_words[1] = 0u; xb_words[2] = 0u; xb_words[3] = 0u; }
    __syncthreads();
    const XcdBarrier gb = xcd_barrier_post(WSP(unsigned, WS_CTRL), xb_words);
    const int bid = blockIdx.x, nblk = gridDim.x;
    phaseA(p, bid, nblk, smem); grid_barrier(gb);
    phaseB(p, bid, nblk, smem); grid_barrier(gb);
    phaseC(p, bid, nblk, smem); grid_barrier(gb);
    phaseD(p, bid, nblk, smem); grid_barrier(gb);
    phaseE(p, bid, nblk, smem); grid_barrier(gb);
    phaseF(p, bid, nblk, smem); grid_barrier(gb);
    phaseR1(p, bid, nblk, smem); grid_barrier(gb);
    phaseR2(p, bid, nblk, smem); grid_barrier(gb);
    phaseR3(p, bid, nblk, smem); grid_barrier(gb);
    phaseJ(p, bid, nblk, smem); grid_barrier(gb);
    phaseK(p, bid, nblk, smem); grid_barrier(gb);
    phaseL(p, bid, nblk, smem); grid_barrier(gb);
    phaseM(p, bid, nblk, smem); grid_barrier(gb);
    phaseN(p, bid, nblk, smem); grid_barrier(gb);
    phaseO(p, bid, nblk, smem);
}

#ifdef MULTI_LAUNCH
#define PHASE_KERNEL(NAME) \
    __global__ void __launch_bounds__(256) k_##NAME(Params p) { __shared__ __attribute__((aligned(16))) char smem[SMEM_BYTES]; NAME(p, blockIdx.x, gridDim.x, smem); }
PHASE_KERNEL(phaseA) PHASE_KERNEL(phaseB) PHASE_KERNEL(phaseC) PHASE_KERNEL(phaseD) PHASE_KERNEL(phaseE) PHASE_KERNEL(phaseF) PHASE_KERNEL(phaseR1) PHASE_KERNEL(phaseR2) PHASE_KERNEL(phaseR3)
PHASE_KERNEL(phaseJ) PHASE_KERNEL(phaseK) PHASE_KERNEL(phaseL) PHASE_KERNEL(phaseM) PHASE_KERNEL(phaseN) PHASE_KERNEL(phaseO)
#ifdef HOST_EMU
void emu_hook(const char* name, const Params& p);
#define LAUNCH(NAME, grid) do { EMU_LAUNCH(k_##NAME, grid, 256, p); emu_hook(#NAME, p); } while (0)
#else
#define LAUNCH(NAME, grid) hipLaunchKernelGGL(k_##NAME, dim3(grid), dim3(256), 0, stream, p)
#endif
#endif

extern "C" void kernel_launch(void* const* d_in, const int* in_sizes, int n_in, void* d_out, int out_size, void* d_ws, size_t ws_size, hipStream_t stream) {
    if (n_in != 38 || out_size != MLAT * D_MODEL || ws_size < WS_END) { fprintf(stderr, "kernel_launch: unexpected shapes (n_in %d out %d ws %zu need %zu)\n", n_in, out_size, ws_size, (size_t)WS_END); return; }
    Params p{};
    const float** f = (const float**)&p;
    for (int i = 0; i < 38; ++i) f[i] = (const float*)d_in[i];
    p.out = (float*)d_out; p.ws = (unsigned char*)d_ws;
#ifdef MULTI_LAUNCH
    const int G = 512;
    LAUNCH(phaseA, 6 * D_MODEL / 64);
    LAUNCH(phaseB, G);
    LAUNCH(phaseC, G);
    LAUNCH(phaseD, G);
    LAUNCH(phaseE, 16);
    LAUNCH(phaseF, G);
    LAUNCH(phaseR1, G);
    LAUNCH(phaseR2, NCHAIN);
    LAUNCH(phaseR3, G);
    LAUNCH(phaseJ, G);
    LAUNCH(phaseK, G);
    LAUNCH(phaseL, BATCH * N_EXPERTS);
    LAUNCH(phaseM, G);
    LAUNCH(phaseN, G);
    LAUNCH(phaseO, G);
#elif defined(HOST_EMU)
    EMU_LAUNCH(fused_forward, 1, 256, p);
#else
    static int grid_blocks = 0;
    if (!grid_blocks) {
        int dev = 0, cus = 0, per_cu = 0;
        (void)hipGetDevice(&dev);
        (void)hipDeviceGetAttribute(&cus, hipDeviceAttributeMultiprocessorCount, dev);
        (void)hipOccupancyMaxActiveBlocksPerMultiprocessor(&per_cu, fused_forward, 256, 0);
        if (per_cu > 2) per_cu = 2;
        if (per_cu < 1) { fprintf(stderr, "kernel_launch: occupancy query returned %d blocks per CU\n", per_cu); per_cu = 1; }
        grid_blocks = cus * per_cu;
    }
    (void)hipMemsetAsync((char*)d_ws + WS_CTRL, 0, XCD_BAR_WORDS * 4, stream);
    void* args[] = {&p};
    hipError_t e = hipLaunchCooperativeKernel((void*)fused_forward, dim3(grid_blocks), dim3(256), args, 0, stream);
    if (e != hipSuccess) fprintf(stderr, "cooperative launch failed: %s (grid %d)\n", hipGetErrorString(e), grid_blocks);
#endif
}
```

```cpp
#ifndef HOST_EMU
#include <hip/hip_runtime.h>
#include <cstdio>
#endif
#include <cstdint>
#include <cstddef>

#ifdef CFG_SMALL
constexpr int D_MODEL = 256, BATCH = 2, SEQ = 256, GRID_W = 16, CTX_LEN = 64, LRU_BLOCKS = 2, N_EXPERTS = 4, D_EXPERT = 256;
#else
constexpr int D_MODEL = 1024, BATCH = 4, SEQ = 4096, GRID_W = 64, CTX_LEN = 256, LRU_BLOCKS = 8, N_EXPERTS = 16, D_EXPERT = 1408;
#endif
constexpr int ROWS = SEQ / GRID_W;
constexpr int D_LRU = D_MODEL / 2, LRU_BLOCK = 64;
constexpr int D_RWKV = D_MODEL / 2, HEADS = D_RWKV / 64;
constexpr int D_RWKV_IN = 3 * D_RWKV + 128 + 128 + 128;
constexpr int D_IN = 2 * D_LRU + D_RWKV_IN;
constexpr int D_MIX = D_LRU + D_RWKV;
constexpr int CAP = 2 * SEQ / N_EXPERTS;
constexpr int MLAT = BATCH * SEQ, MCTX = BATCH * CTX_LEN, MTOT = MLAT + MCTX;
constexpr int NMOD = BATCH + 1;
constexpr int RW0 = 2 * D_LRU;
constexpr float ALPHA_F = 1.189207115002721f;
constexpr float LN_EPS = 1e-5f, GN_EPS = 64e-5f, RMS_EPS = 1e-6f;
static_assert(LRU_BLOCKS * LRU_BLOCK == D_LRU, "lru blocks");
static_assert(CAP % 128 == 0 && D_IN % 128 == 0 && D_EXPERT % 64 == 0 && D_MODEL % 128 == 0 && MTOT % 128 == 0, "tile divisibility");

typedef unsigned short bf16_t;
typedef short bf16x8 __attribute__((ext_vector_type(8)));
typedef float f32x4 __attribute__((ext_vector_type(4)));
typedef unsigned u32x4 __attribute__((ext_vector_type(4)));
struct alignas(16) F4 { float x, y, z, w; };
typedef unsigned U2 __attribute__((ext_vector_type(2)));
struct alignas(16) U4 { unsigned x, y, z, w; };

#ifdef HOST_EMU
#define MFMA16(a, b, c) emu_mfma_16x16x32_bf16(a, b, c)
#define MFMAF32(a, b, c) emu_mfma_16x16x4_f32(a, b, c)
#else
#define MFMA16(a, b, c) __builtin_amdgcn_mfma_f32_16x16x32_bf16(a, b, c, 0, 0, 0)
#define MFMAF32(a, b, c) __builtin_amdgcn_mfma_f32_16x16x4f32(a, b, c, 0, 0, 0)
#endif

__device__ __forceinline__ unsigned fbits(float f) { return __builtin_bit_cast(unsigned, f); }
__device__ __forceinline__ float bitsf(unsigned u) { return __builtin_bit_cast(float, u); }
__device__ __forceinline__ bf16_t f2bf(float f) { unsigned u = fbits(f); u += 0x7FFFu + ((u >> 16) & 1u); return (bf16_t)(u >> 16); }
__device__ __forceinline__ float bf2f(bf16_t h) { return bitsf(((unsigned)h) << 16); }
#ifdef HOST_EMU
__device__ __forceinline__ unsigned pk2(float lo, float hi) { return (unsigned)f2bf(lo) | ((unsigned)f2bf(hi) << 16); }
#else
typedef float f32x2_t __attribute__((ext_vector_type(2)));
typedef __bf16 bf16x2_t __attribute__((ext_vector_type(2)));
__device__ __forceinline__ unsigned pk2(float lo, float hi) { return __builtin_bit_cast(unsigned, __builtin_convertvector(f32x2_t{lo, hi}, bf16x2_t)); }
#endif
__device__ __forceinline__ float sigmoidf_(float x) { return 1.0f / (1.0f + expf(-x)); }
__device__ __forceinline__ float siluf_(float x) { return x * sigmoidf_(x); }
__device__ __forceinline__ float softplusf_(float x) { return fmaxf(x, 0.0f) + log1pf(expf(-fabsf(x))); }
__device__ __forceinline__ float geluf_(float x) { return 0.5f * x * (1.0f + tanhf(0.7978845608028654f * (x + 0.044715f * x * x * x))); }
__device__ __forceinline__ float wave_sum(float v) {
#pragma unroll
    for (int o = 1; o < 64; o <<= 1) v += __shfl_xor(v, o);
    return v;
}

constexpr size_t al256(size_t x) { return (x + 255) & ~(size_t)255; }
constexpr int NLCH = BATCH * (SEQ / 64), NCCH = BATCH * (CTX_LEN / 64), NCH = NLCH + NCCH;
constexpr size_t WS_CTRL = 0;
constexpr size_t WS_MOD = 65536;
constexpr size_t WS_STATS = al256(WS_MOD + (size_t)NMOD * 6 * D_MODEL * 4);
constexpr size_t WS_SUMA = al256(WS_STATS + (size_t)MTOT * 2 * 4);
constexpr size_t WS_SUMH = al256(WS_SUMA + (size_t)2 * NCH * D_LRU * 4);
constexpr size_t WS_CARRY = al256(WS_SUMH + (size_t)2 * NCH * D_LRU * 4);
constexpr size_t WS_SSQP = al256(WS_CARRY + (size_t)2 * NLCH * D_LRU * 4);
constexpr size_t WS_RINV = al256(WS_SSQP + (size_t)MLAT * LRU_BLOCKS * 4);
constexpr size_t WS_BON = al256(WS_RINV + (size_t)MLAT * 4);
constexpr size_t WS_AFF = al256(WS_BON + (size_t)2 * MLAT * HEADS * 4 + 4096 * 64);
constexpr size_t WS_IDX = al256(WS_AFF + (size_t)MLAT * N_EXPERTS * 4);
constexpr size_t WS_GATE = al256(WS_IDX + (size_t)BATCH * N_EXPERTS * CAP * 4);
constexpr size_t WS_SLOT = al256(WS_GATE + (size_t)BATCH * N_EXPERTS * CAP * 4);
constexpr size_t WS_R1 = al256(WS_SLOT + (size_t)MLAT * N_EXPERTS * 4);
constexpr size_t R1_BYTES = (size_t)MTOT * D_IN * 2 > (size_t)MLAT * D_MODEL * 4 ? ((size_t)MTOT * D_IN * 2 > (size_t)BATCH * N_EXPERTS * CAP * D_EXPERT * 2 ? (size_t)MTOT * D_IN * 2 : (size_t)BATCH * N_EXPERTS * CAP * D_EXPERT * 2)
                                                                                  : ((size_t)MLAT * D_MODEL * 4 > (size_t)BATCH * N_EXPERTS * CAP * D_EXPERT * 2 ? (size_t)MLAT * D_MODEL * 4 : (size_t)BATCH * N_EXPERTS * CAP * D_EXPERT * 2);
constexpr size_t WS_R3 = al256(WS_R1 + R1_BYTES);
constexpr int RC = 32;
constexpr int NCC = CTX_LEN / RC, NLC = SEQ / RC, NCK = NCC + NLC, NCHAIN = BATCH * HEADS * 2;
constexpr size_t CH_PM = 0, CH_SA = 8192, CH_QT = 16384, CH_Y0 = 20480, CH_BYTES = 24576;
constexpr size_t WS_CH = al256(WS_R3 + (size_t)MTOT * D_MODEL * 2);
constexpr size_t CH_TOTAL = (size_t)NCHAIN * NCK * CH_BYTES;
constexpr size_t WS_R5 = WS_CH;
constexpr size_t WS_R2 = al256(WS_R5 + (size_t)MLAT * D_MODEL * 4);
constexpr size_t WS_R6 = al256(WS_R2 + (size_t)MLAT * D_MODEL * 4);
constexpr size_t WS_LATE_END = al256(WS_R6 + (size_t)MLAT * D_MODEL * 2);
constexpr size_t WS_END = (WS_CH + CH_TOTAL > WS_LATE_END) ? al256(WS_CH + CH_TOTAL) : WS_LATE_END;
constexpr size_t WS_RBON = WS_BON;
static_assert((size_t)NCHAIN * NCK * RC * 4 <= (size_t)2 * MLAT * HEADS * 4 + 4096 * 64, "bonus buffer");

struct Params {
    const float *x, *c, *ctx, *c_ctx, *ln_in_g, *ln_in_b, *w_mod, *b_mod, *w_in, *lru_conv_w, *lru_conv_b, *lru_wa, *lru_ba, *lru_wx, *lru_bx, *lru_lam, *lru_norm_g,
        *mu_prev, *mu_next, *w0, *w2, *a0, *a2, *g2, *k_k, *k_a, *r_k, *gn_g, *gn_b, *w_out, *ln1_g, *ln1_b, *w_router, *w_gate, *w_up, *w_down, *ln2_g, *ln2_b;
    float* out;
    unsigned char* ws;
};
#define WSP(T, off) ((T*)(p.ws + (off)))

constexpr int SMEM_BYTES = 76 * 1024;

__device__ void phaseA(const Params& p, int bid, int nblk, char* smem) {
    float* sc = (float*)smem;
    float* red = sc + NMOD * D_MODEL;
    const int tid = threadIdx.x;
    for (int i = tid; i < NMOD * D_MODEL; i += 256) {
        const int r = i / D_MODEL, k = i % D_MODEL;
        const float v = (r < BATCH) ? p.c[r * D_MODEL + k] : p.c_ctx[k];
        sc[i] = siluf_(v);
    }
    __syncthreads();
    float* MOD = WSP(float, WS_MOD);
    const int col = tid & 63, kg = tid >> 6;
    for (int cb = bid; cb < 6 * D_MODEL / 64; cb += nblk) {
        const int n = cb * 64 + col;
        float acc[NMOD];
#pragma unroll
        for (int r = 0; r < NMOD; ++r) acc[r] = 0.f;
        for (int k = kg; k < D_MODEL; k += 4) {
            const float w = p.w_mod[(size_t)k * (6 * D_MODEL) + n];
#pragma unroll
            for (int r = 0; r < NMOD; ++r) acc[r] += sc[r * D_MODEL + k] * w;
        }
#pragma unroll
        for (int r = 0; r < NMOD; ++r) red[(kg * NMOD + r) * 64 + col] = acc[r];
        __syncthreads();
        if (kg == 0) {
#pragma unroll
            for (int r = 0; r < NMOD; ++r) {
                float s = p.b_mod[n];
                for (int g = 0; g < 4; ++g) s += red[(g * NMOD + r) * 64 + col];
                MOD[(size_t)r * 6 * D_MODEL + n] = s;
            }
        }
        __syncthreads();
    }
}

constexpr int NV = D_MODEL / 256;
__device__ __forceinline__ f32x4 ld4(const float* p) { return *(const f32x4*)p; }
__device__ __forceinline__ float hsum4(f32x4 v) { return (v[0] + v[1]) + (v[2] + v[3]); }
__device__ __forceinline__ U2 pack4(f32x4 v) { U2 o; o.x = pk2(v[0], v[1]); o.y = pk2(v[2], v[3]); return o; }
__device__ void phaseB(const Params& p, int bid, int nblk, char* smem) {
    const int lane = threadIdx.x & 63, wave = threadIdx.x >> 6;
    const float* MOD = WSP(float, WS_MOD);
    float* STATS = WSP(float, WS_STATS);
    bf16_t* U = WSP(bf16_t, WS_R3);
    for (int row = bid * 4 + wave; row < MTOT; row += nblk * 4) {
        const float* xr = (row < MLAT) ? p.x + (size_t)row * D_MODEL : p.ctx + (size_t)(row - MLAT) * D_MODEL;
        const int mr = (row < MLAT) ? row / SEQ : BATCH;
        const float* md = MOD + (size_t)mr * 6 * D_MODEL;
        f32x4 v0, v1, v2, v3; float s = 0.f;
        v0 = ld4(xr + lane * 4); s += hsum4(v0);
        if (NV > 1) { v1 = ld4(xr + 256 + lane * 4); s += hsum4(v1); } else v1 = f32x4{0.f, 0.f, 0.f, 0.f};
        if (NV > 2) { v2 = ld4(xr + 512 + lane * 4); v3 = ld4(xr + 768 + lane * 4); s += hsum4(v2) + hsum4(v3); } else { v2 = v1; v3 = v1; }
        const float mu = wave_sum(s) * (1.0f / D_MODEL);
        v0 -= mu; float s2 = hsum4(v0 * v0);
        if (NV > 1) { v1 -= mu; s2 += hsum4(v1 * v1); }
        if (NV > 2) { v2 -= mu; v3 -= mu; s2 += hsum4(v2 * v2) + hsum4(v3 * v3); }
        const float rstd = 1.0f / sqrtf(wave_sum(s2) * (1.0f / D_MODEL) + LN_EPS);
        if (lane == 0) { STATS[row * 2] = mu; STATS[row * 2 + 1] = rstd; }
#pragma unroll
        for (int j = 0; j < NV; ++j) {
            const int k = j * 256 + lane * 4;
            const f32x4 vv = (j == 0) ? v0 : (j == 1) ? v1 : (j == 2) ? v2 : v3;
            const f32x4 h = vv * rstd * ld4(p.ln_in_g + k) + ld4(p.ln_in_b + k);
            *(U2*)(U + (size_t)row * D_MODEL + k) = pack4(h * (1.0f + ld4(md + D_MODEL + k)) + ld4(md + k));
        }
    }
}

constexpr int LDK = 64;
__device__ __forceinline__ int bswz(int n) { return ((n >> 2) ^ n) & 7; }
template <bool DUAL, class Epi>
__device__ __forceinline__ void gemm_tile(char* smem, const bf16_t* A, int lda, const int* rowidx, int m0, const float* B0, const float* B1, int ldb, int n0, int K, Epi epi, const float* rowscale = nullptr, int kscale = 0) {
    bf16_t* As = (bf16_t*)smem;
    bf16_t* Bs = As + 128 * LDK;
    const int tid = threadIdx.x, lane = tid & 63, wave = tid >> 6, wr = wave >> 1, wc = wave & 1, l15 = lane & 15, q = lane >> 4;
    const int ach = tid & 7, ar0 = tid >> 3;
    const bf16_t* aptr[4];
#pragma unroll
    for (int j = 0; j < 4; ++j) { const int r = m0 + ar0 + 32 * j; aptr[j] = A + (rowidx ? (size_t)rowidx[r] : (size_t)r) * lda + ach * 8; }
    const int bn4 = tid & 31, bkg = tid >> 5;
    const float* bptr;
    if (DUAL) { const int ct = bn4 * 4, blk = ct >> 5; bptr = ((blk & 1) ? B1 : B0) + (size_t)(bkg * 8) * ldb + n0 + (blk >> 1) * 32 + (ct & 31); }
    else bptr = B0 + (size_t)(bkg * 8) * ldb + n0 + bn4 * 4;
    bf16_t* awr = As + ar0 * LDK + ((ach ^ (ar0 & 7)) * 8);
    u32x4 ar[4]; f32x4 br[8];
    f32x4 acc[4][4];
#pragma unroll
    for (int i = 0; i < 4; ++i)
#pragma unroll
        for (int j = 0; j < 4; ++j) acc[i][j] = f32x4{0.f, 0.f, 0.f, 0.f};
    const int nk = K / 64;
#pragma unroll
    for (int j = 0; j < 4; ++j) ar[j] = *(const u32x4*)(aptr[j]);
#pragma unroll
    for (int j = 0; j < 8; ++j) br[j] = *(const f32x4*)(bptr + (size_t)j * ldb);
    for (int kt = 0; kt < nk; ++kt) {
        __syncthreads();
#pragma unroll
        for (int j = 0; j < 4; ++j) *(u32x4*)(awr + 32 * j * LDK) = ar[j];
#pragma unroll
        for (int c = 0; c < 4; ++c) {
            u32x4 o;
            o[0] = pk2(br[0][c], br[1][c]); o[1] = pk2(br[2][c], br[3][c]); o[2] = pk2(br[4][c], br[5][c]); o[3] = pk2(br[6][c], br[7][c]);
            const int n = bn4 * 4 + c;
            *(u32x4*)(Bs + n * LDK + ((bkg ^ bswz(n)) * 8)) = o;
        }
        __syncthreads();
        if (kt + 1 < nk) {
            const int ko = (kt + 1) * 64;
#pragma unroll
            for (int j = 0; j < 4; ++j) ar[j] = *(const u32x4*)(aptr[j] + ko);
#pragma unroll
            for (int j = 0; j < 8; ++j) br[j] = *(const f32x4*)(bptr + (size_t)(ko + j) * ldb);
        }
#pragma unroll
        for (int ks = 0; ks < 2; ++ks) {
            bf16x8 af[4];
#pragma unroll
            for (int mi = 0; mi < 4; ++mi) af[mi] = *(const bf16x8*)(As + (wr * 64 + mi * 16 + l15) * LDK + (((ks * 4 + q) ^ (l15 & 7)) * 8));
#pragma unroll
            for (int ni = 0; ni < 4; ++ni) {
                const int n = wc * 64 + ni * 16 + l15;
                const bf16x8 bfr = *(const bf16x8*)(Bs + n * LDK + (((ks * 4 + q) ^ bswz(n)) * 8));
#pragma unroll
                for (int mi = 0; mi < 4; ++mi) acc[mi][ni] = MFMA16(bfr, af[mi], acc[mi][ni]);
            }
        }
        if (rowscale && kt + 1 == kscale) {
#pragma unroll
            for (int mi = 0; mi < 4; ++mi) {
                const float rs = rowscale[m0 + wr * 64 + mi * 16 + l15];
#pragma unroll
                for (int ni = 0; ni < 4; ++ni) acc[mi][ni] *= rs;
            }
        }
    }
#pragma unroll
    for (int mi = 0; mi < 4; ++mi) {
        const int ml = wr * 64 + mi * 16 + l15;
        if (DUAL) {
#pragma unroll
            for (int ni = 0; ni < 2; ++ni) epi(ml, wc * 32 + ni * 16 + q * 4, acc[mi][ni], acc[mi][ni + 2]);
        } else {
#pragma unroll
            for (int ni = 0; ni < 4; ++ni) epi(ml, wc * 64 + ni * 16 + q * 4, acc[mi][ni], acc[mi][ni]);
        }
    }
    __syncthreads();
}

__device__ __forceinline__ int xcd_vbid(int bid, int nblk) { return (nblk % 8 == 0) ? (bid % 8) * (nblk / 8) + bid / 8 : bid; }
__device__ void phaseC(const Params& p, int bid, int nblk, char* smem) {
    const bf16_t* U = WSP(bf16_t, WS_R3);
    bf16_t* P = WSP(bf16_t, WS_R1);
    constexpr int NTN = D_IN / 128, NTM = MTOT / 128;
    constexpr int GM = (NTM % 8 == 0) ? 8 : 1;
    for (int it = xcd_vbid(bid, nblk); it < NTN * NTM; it += nblk) {
        const int mg = it / (GM * NTN), r = it % (GM * NTN), nt = r / GM, mt = mg * GM + (r % GM);
        gemm_tile<false>(smem, U, D_MODEL, nullptr, mt * 128, p.w_in, nullptr, D_IN, nt * 128, D_MODEL, [&](int ml, int nl, f32x4 v, f32x4) {
            U2 o; o.x = pk2(v[0], v[1]); o.y = pk2(v[2], v[3]);
            *(U2*)(P + (size_t)(mt * 128 + ml) * D_IN + nt * 128 + nl) = o;
        });
    }
}

#ifdef HOST_EMU
#define FEXP(x) expf(x)
#else
#define FEXP(x) __expf(x)
#endif
__device__ __forceinline__ float fsigm(float x) { return 1.0f / (1.0f + FEXP(-x)); }
template <int NYT, int KS>
__device__ __forceinline__ void mmT(f32x4* acc, const bf16_t* X, int ldx, int xs, const bf16_t* Y, int ldy, int lane) {
#pragma unroll
    for (int ks = 0; ks < KS; ++ks) {
        const bf16x8 xf = *(const bf16x8*)(X + (xs * 16 + (lane & 15)) * ldx + ks * 32 + 8 * (lane >> 4));
#pragma unroll
        for (int nb = 0; nb < NYT; ++nb) {
            const bf16x8 yf = *(const bf16x8*)(Y + (nb * 16 + (lane & 15)) * ldy + ks * 32 + 8 * (lane >> 4));
            acc[nb] = MFMA16(xf, yf, acc[nb]);
        }
    }
}

struct SeqChunk { int base_row; int t0; int len; };
__device__ __forceinline__ SeqChunk lru_chunk(int cg) {
    SeqChunk s;
    if (cg < NLCH) { const int b = cg / (SEQ / 64), ck = cg % (SEQ / 64); s.base_row = b * SEQ; s.t0 = ck * 64; s.len = SEQ; }
    else { const int c2 = cg - NLCH; const int b = c2 / (CTX_LEN / 64), ck = c2 % (CTX_LEN / 64); s.base_row = MLAT + b * CTX_LEN; s.t0 = ck * 64; s.len = CTX_LEN; }
    return s;
}
constexpr int L_XIN = 0;
constexpr int L_GT = 8704;
constexpr int L_XB = L_GT + 9216;
constexpr int L_WT = L_XB + 9216;
constexpr int L_CP = L_WT + 36864;
constexpr int L_END = L_CP + 4096;
static_assert(L_END <= SMEM_BYTES, "lru lds");
__device__ __forceinline__ void lru_load_w(const Params& p, char* smem, int cb) {
    bf16_t* WT = (bf16_t*)(smem + L_WT);
    const int tid = threadIdx.x;
    for (int idx = tid; idx < 4 * 64 * 16; idx += 256) {
        const int m = idx >> 10, i = (idx >> 4) & 63, j4 = (idx & 15) * 4, d = m >> 1;
        const f32x4 w = ld4(((m & 1) ? p.lru_wx : p.lru_wa) + ((size_t)(d * LRU_BLOCKS + cb) * 64 + i) * 64 + j4);
        bf16_t* dst = WT + (m * 64 + j4) * 72 + i;
        dst[0] = f2bf(w[0]); dst[72] = f2bf(w[1]); dst[144] = f2bf(w[2]); dst[216] = f2bf(w[3]);
    }
}
struct LruOut { float a[2][4][4], b[2][4][4]; };
template <bool FINAL>
__device__ __forceinline__ void lru_item(const Params& p, char* smem, int cg, int cb) {
    const bf16_t* P = WSP(bf16_t, WS_R1);
    bf16_t* XIN = (bf16_t*)(smem + L_XIN); bf16_t* GT = (bf16_t*)(smem + L_GT); bf16_t* XB = (bf16_t*)(smem + L_XB); const bf16_t* WT = (const bf16_t*)(smem + L_WT);
    float* CP = (float*)(smem + L_CP);
    const int tid = threadIdx.x, lane = tid & 63, wave = tid >> 6, q = lane >> 4, l15 = lane & 15;
    const SeqChunk sc = lru_chunk(cg);
    __syncthreads();
    for (int idx = tid; idx < 67 * 8; idx += 256) {
        const int tt = idx >> 3, c8 = (idx & 7) * 8, t = sc.t0 - 1 + tt;
        u32x4 v = u32x4{0u, 0u, 0u, 0u};
        if (t >= 0 && t < sc.len) v = *(const u32x4*)(P + (size_t)(sc.base_row + t) * D_IN + cb * 64 + c8);
        *(u32x4*)(XIN + tt * 64 + c8) = v;
    }
    if (FINAL) {
        for (int idx = tid; idx < 64 * 8; idx += 256) {
            const int tt = idx >> 3, c8 = (idx & 7) * 8;
            *(u32x4*)(GT + tt * 72 + c8) = *(const u32x4*)(P + (size_t)(sc.base_row + sc.t0 + tt) * D_IN + D_LRU + cb * 64 + c8);
        }
    }
    __syncthreads();
    {
        const int c = tid & 63, ch = cb * 64 + c;
        const float w0 = p.lru_conv_w[ch], w1 = p.lru_conv_w[D_LRU + ch], w2 = p.lru_conv_w[2 * D_LRU + ch], w3 = p.lru_conv_w[3 * D_LRU + ch], bc = p.lru_conv_b[ch];
#pragma unroll 4
        for (int tt = tid >> 6; tt < 64; tt += 4)
            XB[tt * 72 + c] = f2bf(bc + bf2f(XIN[tt * 64 + c]) * w0 + bf2f(XIN[(tt + 1) * 64 + c]) * w1 + bf2f(XIN[(tt + 2) * 64 + c]) * w2 + bf2f(XIN[(tt + 3) * 64 + c]) * w3);
    }
    __syncthreads();
    float hs[4][4];
    float av[4][4], bv[4][4];
#pragma unroll
    for (int d = 0; d < 2; ++d) {
        f32x4 ga[4], gx[4];
#pragma unroll
        for (int nb = 0; nb < 4; ++nb) { ga[nb] = f32x4{0.f, 0.f, 0.f, 0.f}; gx[nb] = f32x4{0.f, 0.f, 0.f, 0.f}; }
        mmT<4, 2>(ga, XB, 72, wave, WT + (2 * d) * 64 * 72, 72, lane);
        mmT<4, 2>(gx, XB, 72, wave, WT + (2 * d + 1) * 64 * 72, 72, lane);
        float cA[4], cH[4];
#pragma unroll
        for (int nb = 0; nb < 4; ++nb) {
            const int ch = cb * 64 + nb * 16 + l15;
            const float ba = p.lru_ba[d * D_LRU + ch], bx = p.lru_bx[d * D_LRU + ch];
            const float sp8 = -8.0f * softplusf_(-p.lru_lam[d * D_LRU + ch]);
#pragma unroll
            for (int r = 0; r < 4; ++r) {
                const float rg = fsigm(ga[nb][r] + ba), ig = fsigm(gx[nb][r] + bx);
                const float a = FEXP(sp8 * rg);
                const float xv = bf2f(XB[(wave * 16 + q * 4 + r) * 72 + nb * 16 + l15]);
                av[nb][r] = a; bv[nb][r] = sqrtf(fmaxf(1.0f - a * a, 0.f)) * ig * xv;
            }
            float A, H;
            if (d == 0) { A = av[nb][0]; H = bv[nb][0];
#pragma unroll
                for (int r = 1; r < 4; ++r) { H = H * av[nb][r] + bv[nb][r]; A *= av[nb][r]; } }
            else { A = av[nb][3]; H = bv[nb][3];
#pragma unroll
                for (int r = 2; r >= 0; --r) { H = H * av[nb][r] + bv[nb][r]; A *= av[nb][r]; } }
#pragma unroll
            for (int st = 1; st <= 2; st <<= 1) {
                const float pA = d == 0 ? __shfl_up(A, 16 * st) : __shfl_down(A, 16 * st), pH = d == 0 ? __shfl_up(H, 16 * st) : __shfl_down(H, 16 * st);
                const bool has = d == 0 ? (q >= st) : (q + st <= 3);
                if (has) { H = pH * A + H; A = pA * A; }
            }
            cA[nb] = A; cH[nb] = H;
            const bool last = d == 0 ? (q == 3) : (q == 0);
            if (last) { CP[((d * 4 + wave) * 64 + nb * 16 + l15) * 2] = A; CP[((d * 4 + wave) * 64 + nb * 16 + l15) * 2 + 1] = H; }
        }
        __syncthreads();
        if (!FINAL) {
            if (wave == 0 && q == 0) {
#pragma unroll
                for (int nb = 0; nb < 4; ++nb) {
                    const int c = nb * 16 + l15;
                    float A = 1.f, H = 0.f;
#pragma unroll
                    for (int w = 0; w < 4; ++w) { const int ww = d == 0 ? w : 3 - w; const float wa = CP[((d * 4 + ww) * 64 + c) * 2], wh = CP[((d * 4 + ww) * 64 + c) * 2 + 1]; H = H * wa + wh; A *= wa; }
                    WSP(float, WS_SUMA)[((size_t)d * NCH + cg) * D_LRU + cb * 64 + c] = A;
                    WSP(float, WS_SUMH)[((size_t)d * NCH + cg) * D_LRU + cb * 64 + c] = H;
                }
            }
        } else {
#pragma unroll
            for (int nb = 0; nb < 4; ++nb) {
                const int c = nb * 16 + l15;
                float h = WSP(float, WS_CARRY)[((size_t)d * NLCH + cg) * D_LRU + cb * 64 + c];
#pragma unroll
                for (int w = 0; w < 3; ++w) { const int ww = d == 0 ? w : 3 - w; const bool use = d == 0 ? (ww < wave) : (ww > wave);
                    if (use) h = h * CP[((d * 4 + ww) * 64 + c) * 2] + CP[((d * 4 + ww) * 64 + c) * 2 + 1]; }
                const float eA = d == 0 ? __shfl_up(cA[nb], 16) : __shfl_down(cA[nb], 16), eH = d == 0 ? __shfl_up(cH[nb], 16) : __shfl_down(cH[nb], 16);
                const bool first = d == 0 ? (q == 0) : (q == 3);
                if (!first) h = h * eA + eH;
                if (d == 0) {
#pragma unroll
                    for (int r = 0; r < 4; ++r) { h = h * av[nb][r] + bv[nb][r]; hs[nb][r] = h; }
                } else {
#pragma unroll
                    for (int r = 3; r >= 0; --r) { h = h * av[nb][r] + bv[nb][r]; hs[nb][r] += h; }
                }
            }
        }
        __syncthreads();
    }
    if (FINAL) {
        float ss[4] = {0.f, 0.f, 0.f, 0.f};
#pragma unroll
        for (int nb = 0; nb < 4; ++nb) {
            const float gn = p.lru_norm_g[cb * 64 + nb * 16 + l15];
#pragma unroll
            for (int r = 0; r < 4; ++r) {
                const int tt = wave * 16 + q * 4 + r;
                const float v = hs[nb][r] * geluf_(bf2f(GT[tt * 72 + nb * 16 + l15]));
                ss[r] += v * v;
                XB[tt * 72 + nb * 16 + l15] = f2bf(v * gn);
            }
        }
#pragma unroll
        for (int r = 0; r < 4; ++r) {
#pragma unroll
            for (int o = 1; o < 16; o <<= 1) ss[r] += __shfl_xor(ss[r], o);
            if (l15 == 0) WSP(float, WS_SSQP)[(size_t)(sc.base_row + sc.t0 + wave * 16 + q * 4 + r) * LRU_BLOCKS + cb] = ss[r];
        }
        __syncthreads();
        bf16_t* MIX = WSP(bf16_t, WS_R3);
        for (int idx = tid; idx < 64 * 8; idx += 256) {
            const int tt = idx >> 3, c8 = (idx & 7) * 8;
            *(u32x4*)(MIX + (size_t)(sc.base_row + sc.t0 + tt) * D_MIX + cb * 64 + c8) = *(const u32x4*)(XB + tt * 72 + c8);
        }
    }
}
__device__ void phaseD(const Params& p, int bid, int nblk, char* smem) {
    int cur = -1;
    for (int it = bid; it < NCH * LRU_BLOCKS; it += nblk) {
        const int cb = it % LRU_BLOCKS, cg = it / LRU_BLOCKS;
        if (cb != cur) { __syncthreads(); lru_load_w(p, smem, cb); cur = cb; }
        lru_item<false>(p, smem, cg, cb);
    }
}
__device__ void phaseE(const Params& p, int bid, int nblk, char* smem) {
    const float* SUMA = WSP(float, WS_SUMA); const float* SUMH = WSP(float, WS_SUMH); float* CARRY = WSP(float, WS_CARRY);
    constexpr int NLB = SEQ / 64, NCB = CTX_LEN / 64;
    for (int g = bid * 256 + threadIdx.x; g < BATCH * 2 * D_LRU; g += nblk * 256) {
        const int c = g % D_LRU, d = (g / D_LRU) & 1, b = g / (2 * D_LRU);
        const float* sa = SUMA + (size_t)d * NCH * D_LRU + c; const float* sh = SUMH + (size_t)d * NCH * D_LRU + c;
        float* cr = CARRY + (size_t)d * NLCH * D_LRU + c;
        float h = 0.f;
        if (d == 0) {
            for (int q2 = 0; q2 < NCB; ++q2) { const int gi = NLCH + b * NCB + q2; h = sa[(size_t)gi * D_LRU] * h + sh[(size_t)gi * D_LRU]; }
            for (int q2 = 0; q2 < NLB; ++q2) { const int gi = b * NLB + q2; cr[(size_t)gi * D_LRU] = h; h = sa[(size_t)gi * D_LRU] * h + sh[(size_t)gi * D_LRU]; }
        } else {
            for (int q2 = NCB - 1; q2 >= 0; --q2) { const int gi = NLCH + b * NCB + q2; h = sa[(size_t)gi * D_LRU] * h + sh[(size_t)gi * D_LRU]; }
            for (int q2 = NLB - 1; q2 >= 0; --q2) { const int gi = b * NLB + q2; cr[(size_t)gi * D_LRU] = h; h = sa[(size_t)gi * D_LRU] * h + sh[(size_t)gi * D_LRU]; }
        }
    }
}
__device__ void phaseF(const Params& p, int bid, int nblk, char* smem) {
    int cur = -1;
    for (int it = bid; it < NLCH * LRU_BLOCKS; it += nblk) {
        const int cb = it % LRU_BLOCKS, cg = it / LRU_BLOCKS;
        if (cb != cur) { __syncthreads(); lru_load_w(p, smem, cb); cur = cb; }
        lru_item<true>(p, smem, cg, cb);
    }
}

__device__ __forceinline__ size_t rwkv_row(int seg, int b, int s) {
    if (seg == 0) return (size_t)(MLAT + b * CTX_LEN + s);
    const int r = s % ROWS, c = s / ROWS;
    return (size_t)(b * SEQ + r * GRID_W + c);
}
__device__ __forceinline__ void chunk_info(int d, int c, int& seg, int& p0, int& len) {
    if (c < NCC) { seg = 0; len = CTX_LEN; p0 = (d == 0 ? c : NCC - 1 - c) * RC; }
    else { const int cc = c - NCC; seg = 1; len = SEQ; p0 = (d == 0 ? cc : NLC - 1 - cc) * RC; }
}
__device__ __forceinline__ void unpack8(const u32x4 v, float* o) {
    o[0] = bitsf(v[0] << 16); o[1] = bitsf(v[0] & 0xFFFF0000u); o[2] = bitsf(v[1] << 16); o[3] = bitsf(v[1] & 0xFFFF0000u);
    o[4] = bitsf(v[2] << 16); o[5] = bitsf(v[2] & 0xFFFF0000u); o[6] = bitsf(v[3] << 16); o[7] = bitsf(v[3] & 0xFFFF0000u);
}
__device__ __forceinline__ void shifted8(const Params& p, const bf16_t* P, int seg, int b, int pos, int len, int ch0, float* o) {
    float z[8], zp[8], zn[8];
    unpack8(*(const u32x4*)(P + rwkv_row(seg, b, pos) * D_IN + RW0 + ch0), z);
    if (pos > 0) unpack8(*(const u32x4*)(P + rwkv_row(seg, b, pos - 1) * D_IN + RW0 + ch0), zp); else { for (int i = 0; i < 8; ++i) zp[i] = 0.f; }
    if (pos < len - 1) unpack8(*(const u32x4*)(P + rwkv_row(seg, b, pos + 1) * D_IN + RW0 + ch0), zn); else { for (int i = 0; i < 8; ++i) zn[i] = 0.f; }
    const f32x4 mp0 = ld4(p.mu_prev + ch0), mp1 = ld4(p.mu_prev + ch0 + 4), mn0 = ld4(p.mu_next + ch0), mn1 = ld4(p.mu_next + ch0 + 4);
#pragma unroll
    for (int i = 0; i < 4; ++i) { o[i] = z[i] + mp0[i] * (zp[i] - z[i]) + mn0[i] * (zn[i] - z[i]); o[4 + i] = z[4 + i] + mp1[i] * (zp[4 + i] - z[4 + i]) + mn1[i] * (zn[4 + i] - z[4 + i]); }
}
constexpr int LT = 72, LJ = 40;
constexpr int R_RF = 0, R_KF = 8192, R_VF = 16384, R_LW = 24576, R_IC = 32768;
constexpr int R_NKA = 0, R_MBR = 2560, R_MKR = 5120;
constexpr int R_XU = 7680;
constexpr int R_IA = R_XU + 8448, R_IB = R_IA + 4608, R_PA = R_IB + 4608, R_PB = R_PA + 4608;
constexpr int R_WA = R_IB, R_U0 = R_WA + 5120;
static_assert(R_U0 + 5120 <= R_PB + 4608 && R_PB + 4608 <= 40960, "rwkv scratch");
constexpr int R_O = 40960;
constexpr int R_AH = R_O, R_BH = R_AH + 4608, R_KH = R_BH + 4608, R_RH = R_KH + 4608;
constexpr int R_VT = R_RH + 4608, R_BHT = R_VT + 5120, R_KHT = R_BHT + 5120;
constexpr int R_GC = R_KHT + 5120, R_TOT = R_GC + 256, R_END = R_TOT + 1024;
constexpr int R_TW = R_O, R_TA = R_TW + 4608, R_W2T = R_TA + 4608, R_A2T = R_W2T + 9216;
static_assert(R_A2T + 9216 <= R_END && R_END <= SMEM_BYTES, "rwkv lds");

__device__ void phaseR1(const Params& p, int bid, int nblk, char* smem) {
    const bf16_t* P = WSP(bf16_t, WS_R1);
    unsigned char* CH = p.ws + WS_CH;
    float* RBON = WSP(float, WS_RBON);
    float* Rf = (float*)(smem + R_RF); float* Kf = (float*)(smem + R_KF); float* Vf = (float*)(smem + R_VF); float* LW = (float*)(smem + R_LW); float* IC = (float*)(smem + R_IC);
    float* IA = (float*)(smem + R_IA); float* IB = (float*)(smem + R_IB); float* PA = (float*)(smem + R_PA); float* PB = (float*)(smem + R_PB); bf16_t* NkaT = (bf16_t*)(smem + R_NKA); bf16_t* MbrT = (bf16_t*)(smem + R_MBR); bf16_t* MkrT = (bf16_t*)(smem + R_MKR);
    float* Xu = (float*)(smem + R_XU); bf16_t* Wa = (bf16_t*)(smem + R_WA); bf16_t* U0 = (bf16_t*)(smem + R_U0);
    bf16_t* Ah = (bf16_t*)(smem + R_AH); bf16_t* Bh = (bf16_t*)(smem + R_BH); bf16_t* Kh = (bf16_t*)(smem + R_KH); bf16_t* Rh = (bf16_t*)(smem + R_RH);
    bf16_t* VT = (bf16_t*)(smem + R_VT); bf16_t* BhT = (bf16_t*)(smem + R_BHT); bf16_t* KhT = (bf16_t*)(smem + R_KHT);
    float* GC = (float*)(smem + R_GC); float* TOT = (float*)(smem + R_TOT);
    bf16_t* TW = (bf16_t*)(smem + R_TW); bf16_t* TA = (bf16_t*)(smem + R_TA); bf16_t* W2T = (bf16_t*)(smem + R_W2T); bf16_t* A2T = (bf16_t*)(smem + R_A2T);
    const int tid = threadIdx.x, lane = tid & 63, wave = tid >> 6, q = lane >> 4, l15 = lane & 15;
    constexpr int NITEM = NCHAIN * NCK;
    const int per = (NITEM + nblk - 1) / nblk;
    const int it0 = bid * per, it1 = (it0 + per < NITEM) ? it0 + per : NITEM;
    for (int it = it0; it < it1; ++it) {
        const int chain = it / NCK, c = it % NCK;
        const int d = chain & 1, h = (chain >> 1) % HEADS, b = chain / (2 * HEADS);
        int seg, p0, len; chunk_info(d, c, seg, p0, len);
        unsigned char* chp = CH + (size_t)it * CH_BYTES;
        __syncthreads();
        {
#pragma unroll
            for (int kb = 0; kb < 5; kb += 3) {
            u32x4 zc[3], zp[3], zn[3];
#pragma unroll
            for (int k = 0; k < 3; ++k) if (kb + k < 5) {
                const int idx = tid + 256 * (kb + k), tau = idx / 40, g = idx % 40, grp = g >> 3, j0 = (g & 7) * 8;
                const int pos = p0 + (d ? RC - 1 - tau : tau);
                const int ch0 = (grp < 3) ? grp * D_RWKV + h * 64 + j0 : (grp == 3 ? 3 * D_RWKV + d * 64 + j0 : 3 * D_RWKV + 128 + d * 64 + j0);
                const u32x4 zero = u32x4{0u, 0u, 0u, 0u};
                zc[k] = *(const u32x4*)(P + rwkv_row(seg, b, pos) * D_IN + RW0 + ch0);
                zp[k] = (pos > 0) ? *(const u32x4*)(P + rwkv_row(seg, b, pos - 1) * D_IN + RW0 + ch0) : zero;
                zn[k] = (pos < len - 1) ? *(const u32x4*)(P + rwkv_row(seg, b, pos + 1) * D_IN + RW0 + ch0) : zero;
            }
#pragma unroll
            for (int k = 0; k < 3; ++k) if (kb + k < 5) {
                const int idx = tid + 256 * (kb + k), tau = idx / 40, g = idx % 40, grp = g >> 3, j0 = (g & 7) * 8;
                const int ch0 = (grp < 3) ? grp * D_RWKV + h * 64 + j0 : (grp == 3 ? 3 * D_RWKV + d * 64 + j0 : 3 * D_RWKV + 128 + d * 64 + j0);
                float z[8], zpv[8], znv[8], o[8];
                unpack8(zc[k], z); unpack8(zp[k], zpv); unpack8(zn[k], znv);
                const f32x4 mp0 = ld4(p.mu_prev + ch0), mp1 = ld4(p.mu_prev + ch0 + 4), mn0 = ld4(p.mu_next + ch0), mn1 = ld4(p.mu_next + ch0 + 4);
#pragma unroll
                for (int e = 0; e < 4; ++e) { o[e] = z[e] + mp0[e] * (zpv[e] - z[e]) + mn0[e] * (znv[e] - z[e]); o[4 + e] = z[4 + e] + mp1[e] * (zpv[4 + e] - z[4 + e]) + mn1[e] * (znv[4 + e] - z[4 + e]); }
                if (grp < 3) {
                    float* dst = (grp == 0 ? Rf : grp == 1 ? Kf : Vf) + tau * 64 + j0;
                    *(f32x4*)dst = f32x4{o[0], o[1], o[2], o[3]}; *(f32x4*)(dst + 4) = f32x4{o[4], o[5], o[6], o[7]};
                } else if (grp == 3) {
                    u32x4 w;
#pragma unroll
                    for (int e = 0; e < 4; ++e) { const float t0 = 2.0f / (1.0f + FEXP(-2.0f * o[2 * e])) - 1.0f, t1 = 2.0f / (1.0f + FEXP(-2.0f * o[2 * e + 1])) - 1.0f; w[e] = pk2(t0, t1); }
                    *(u32x4*)(TW + tau * LT + j0) = w;
                } else {
                    u32x4 w; w[0] = pk2(o[0], o[1]); w[1] = pk2(o[2], o[3]); w[2] = pk2(o[4], o[5]); w[3] = pk2(o[6], o[7]);
                    *(u32x4*)(TA + tau * LT + j0) = w;
                }
            }
            }
            f32x4 wv[8];
#pragma unroll
            for (int k = 0; k < 8; ++k) {
                const int idx = tid + 256 * k, which = idx >> 10, i = (idx >> 4) & 63, j4 = (idx & 15) * 4;
                wv[k] = ld4((which ? p.a2 : p.w2) + ((size_t)d * 64 + i) * D_RWKV + h * 64 + j4);
            }
#pragma unroll
            for (int k = 0; k < 8; ++k) {
                const int idx = tid + 256 * k, which = idx >> 10, i = (idx >> 4) & 63, j4 = (idx & 15) * 4;
                bf16_t* dst = (which ? A2T : W2T) + j4 * LT + i;
                dst[0] = f2bf(wv[k][0]); dst[LT] = f2bf(wv[k][1]); dst[2 * LT] = f2bf(wv[k][2]); dst[3 * LT] = f2bf(wv[k][3]);
            }
        }
        __syncthreads();
        {
            f32x4 aw[2] = {f32x4{0.f, 0.f, 0.f, 0.f}, f32x4{0.f, 0.f, 0.f, 0.f}}, ai[2] = {f32x4{0.f, 0.f, 0.f, 0.f}, f32x4{0.f, 0.f, 0.f, 0.f}};
            mmT<2, 2>(aw, W2T, LT, wave, TW, LT, lane);
            mmT<2, 2>(ai, A2T, LT, wave, TA, LT, lane);
            const int j = wave * 16 + q * 4;
            const f32x4 w0v = ld4(p.w0 + d * D_RWKV + h * 64 + j), a0v = ld4(p.a0 + d * D_RWKV + h * 64 + j);
#pragma unroll
            for (int nb = 0; nb < 2; ++nb) {
                const int tau = nb * 16 + l15;
                f32x4 lw, ic;
#pragma unroll
                for (int r = 0; r < 4; ++r) { lw[r] = -0.6065306597126334f * fsigm(w0v[r] + aw[nb][r]); ic[r] = fsigm(a0v[r] + ai[nb][r]); }
                *(f32x4*)(LW + tau * 64 + j) = lw; *(f32x4*)(IC + tau * 64 + j) = ic;
            }
        }
        __syncthreads();
        {
            const int j = lane, t0 = wave * 8, chj = h * 64 + j;
            const float kkc = p.k_k[chj], kac = p.k_a[chj], rkc = p.r_k[chj];
            float cum[8], kd[8], kkn[8], icv[8], rr[8], vv[8], run = 0.f;
#pragma unroll
            for (int i = 0; i < 8; ++i) {
                const int t = t0 + i;
                run += LW[t * 64 + j]; cum[i] = run;
                const float kr = Kf[t * 64 + j]; icv[i] = IC[t * 64 + j]; rr[i] = Rf[t * 64 + j]; vv[i] = Vf[t * 64 + j];
                kd[i] = kr * (1.0f + (icv[i] - 1.0f) * kac);
                const float kk = kr * kkc;
                const float n2 = wave_sum(kk * kk);
                kkn[i] = kk / fmaxf(sqrtf(n2), 1e-12f);
                const float bon = wave_sum(rr[i] * kd[i] * rkc);
                if (lane == 0) RBON[(size_t)it * RC + t] = bon;
            }
            TOT[wave * 64 + j] = run;
            __syncthreads();
            float off = 0.f;
            for (int w = 0; w < wave; ++w) off += TOT[w * 64 + j];
            u32x4 vt, bt, kt;
            float e_prev = 0.f;
#pragma unroll
            for (int i = 0; i < 8; ++i) {
                const int t = t0 + i;
                const float cu = off + cum[i], cprev = (i == 0) ? off : off + cum[i - 1];
                const float g = FEXP(cu), gi = FEXP(-cu), gm = FEXP(cprev);
                const float ah = -kkn[i] * gm, bh = kkn[i] * icv[i] * gi, kh = kd[i] * gi, rh = rr[i] * g;
                Ah[t * LT + j] = f2bf(ah); Bh[t * LT + j] = f2bf(bh); Kh[t * LT + j] = f2bf(kh); Rh[t * LT + j] = f2bf(rh);
                if (i & 1) { vt[i >> 1] = pk2(e_prev, vv[i]); bt[i >> 1] = (bt[i >> 1] & 0xFFFFu) | ((unsigned)f2bf(bh) << 16); kt[i >> 1] = (kt[i >> 1] & 0xFFFFu) | ((unsigned)f2bf(kh) << 16); }
                else { e_prev = vv[i]; bt[i >> 1] = f2bf(bh); kt[i >> 1] = f2bf(kh); }
                if (t == RC - 1) GC[j] = g;
            }
            *(u32x4*)(VT + j * LJ + t0) = vt; *(u32x4*)(BhT + j * LJ + t0) = bt; *(u32x4*)(KhT + j * LJ + t0) = kt;
        }
        __syncthreads();
        {
            const bf16_t* X = (wave == 0) ? Ah : (wave & 1) ? Kh : Bh;
            const bf16_t* Y = (wave == 0) ? Bh : (wave == 1) ? Ah : Rh;
#pragma unroll
            for (int xs = 0; xs < 2; ++xs) {
                f32x4 acc[2] = {f32x4{0.f, 0.f, 0.f, 0.f}, f32x4{0.f, 0.f, 0.f, 0.f}};
                mmT<2, 2>(acc, X, LT, xs, Y, LT, lane);
#pragma unroll
                for (int nb = 0; nb < 2; ++nb) {
                    const int yy = nb * 16 + l15, x0 = xs * 16 + q * 4;
                    f32x4 v = acc[nb];
#pragma unroll
                    for (int r = 0; r < 4; ++r) { const int xx = x0 + r; const bool keep = (wave == 0) ? (yy < xx) : (wave == 1) ? (xx < yy) : (xx <= yy); v[r] = keep ? v[r] : 0.f; }
                    if (wave == 0) { *(f32x4*)(PA + yy * 36 + x0) = v; f32x4 t0 = v; for (int r = 0; r < 4; ++r) t0[r] += (x0 + r == yy) ? 1.0f : 0.0f; *(f32x4*)(IA + yy * 36 + x0) = t0; }
                    else { bf16_t* dst = (wave == 1 ? NkaT : wave == 2 ? MbrT : MkrT) + yy * LJ + x0; *(U2*)dst = pack4(v); }
                }
            }
        }
        __syncthreads();
        {
#pragma unroll
            for (int xs = 0; xs < 2; ++xs) {
                f32x4 acc[1] = {f32x4{0.f, 0.f, 0.f, 0.f}};
                mmT<1, 1>(acc, NkaT, LJ, xs, VT + wave * 16 * LJ, LJ, lane);
                const int i = wave * 16 + l15, tb = xs * 16 + q * 4;
                Xu[i * 33 + tb] = acc[0][0]; Xu[i * 33 + tb + 1] = acc[0][1]; Xu[i * 33 + tb + 2] = acc[0][2]; Xu[i * 33 + tb + 3] = acc[0][3];
            }
        }
        __syncthreads();
        {
            auto mm32 = [&](float* Z, const float* init, const float* L, const float* R, int ti, int tj) {
                f32x4 acc = f32x4{0.f, 0.f, 0.f, 0.f};
                if (init) { for (int r = 0; r < 4; ++r) acc[r] = init[(ti * 16 + q * 4 + r) * 36 + tj * 16 + l15]; }
#pragma unroll
                for (int k0 = 0; k0 < 32; k0 += 4) acc = MFMAF32(L[(ti * 16 + l15) * 36 + k0 + q], R[(k0 + q) * 36 + tj * 16 + l15], acc);
#pragma unroll
                for (int r = 0; r < 4; ++r) Z[(ti * 16 + q * 4 + r) * 36 + tj * 16 + l15] = acc[r];
            };
            const int ti = wave >> 1, tj = wave & 1;
            mm32(PB, nullptr, PA, PA, ti, tj);
            __syncthreads();
            mm32(IB, IA, IA, PB, ti, tj); mm32(PA, nullptr, PB, PB, ti, tj);
            __syncthreads();
            mm32(IA, IB, IB, PA, ti, tj); mm32(PB, nullptr, PA, PA, ti, tj);
            __syncthreads();
            mm32(IB, IA, IA, PB, ti, tj); mm32(PA, nullptr, PB, PB, ti, tj);
            __syncthreads();
            f32x4 accw[2], accu[2];
            mm32(IA, IB, IB, PA, ti, tj);
            __syncthreads();
#pragma unroll
            for (int tc = 0; tc < 2; ++tc) { accw[tc] = f32x4{0.f, 0.f, 0.f, 0.f}; accu[tc] = f32x4{0.f, 0.f, 0.f, 0.f}; }
#pragma unroll
            for (int k0 = 0; k0 < 32; k0 += 4) {
                const float la = bf2f(Ah[(k0 + q) * LT + wave * 16 + l15]), lu = Xu[(wave * 16 + l15) * 33 + k0 + q];
#pragma unroll
                for (int tc = 0; tc < 2; ++tc) { const float rv = IA[(k0 + q) * 36 + tc * 16 + l15]; accw[tc] = MFMAF32(la, rv, accw[tc]); accu[tc] = MFMAF32(lu, rv, accu[tc]); }
            }
            __syncthreads();
#pragma unroll
            for (int tc = 0; tc < 2; ++tc)
#pragma unroll
                for (int r = 0; r < 4; ++r) { const int row = wave * 16 + q * 4 + r, col = tc * 16 + l15; Wa[row * LJ + col] = f2bf(accw[tc][r]); U0[row * LJ + col] = f2bf(accu[tc][r]); }
        }
        __syncthreads();
        {
            bf16_t* gPm = (bf16_t*)(chp + CH_PM); bf16_t* gSA = (bf16_t*)(chp + CH_SA); bf16_t* gQT = (bf16_t*)(chp + CH_QT); bf16_t* gY0 = (bf16_t*)(chp + CH_Y0);
            const int x0 = wave * 16 + q * 4;
            {
                f32x4 acc[4] = {f32x4{0.f, 0.f, 0.f, 0.f}, f32x4{0.f, 0.f, 0.f, 0.f}, f32x4{0.f, 0.f, 0.f, 0.f}, f32x4{0.f, 0.f, 0.f, 0.f}};
                mmT<4, 1>(acc, Wa, LJ, wave, BhT, LJ, lane);
#pragma unroll
                for (int nb = 0; nb < 4; ++nb) {
                    const int jp = nb * 16 + l15; const float g = GC[jp];
                    f32x4 v = acc[nb];
#pragma unroll
                    for (int r = 0; r < 4; ++r) v[r] = (v[r] + ((x0 + r == jp) ? 1.0f : 0.0f)) * g;
                    *(U2*)(gPm + jp * 64 + x0) = pack4(v);
                }
            }
            {
                f32x4 acc[4] = {f32x4{0.f, 0.f, 0.f, 0.f}, f32x4{0.f, 0.f, 0.f, 0.f}, f32x4{0.f, 0.f, 0.f, 0.f}, f32x4{0.f, 0.f, 0.f, 0.f}};
                mmT<4, 1>(acc, BhT, LJ, wave, U0, LJ, lane);
                mmT<4, 1>(acc, KhT, LJ, wave, VT, LJ, lane);
                const f32x4 g = *(const f32x4*)(GC + x0);
#pragma unroll
                for (int nb = 0; nb < 4; ++nb) *(U2*)(gSA + (nb * 16 + l15) * 64 + x0) = pack4(acc[nb] * g);
            }
            if (seg == 1) {
                {
                    f32x4 acc[2] = {f32x4{0.f, 0.f, 0.f, 0.f}, f32x4{0.f, 0.f, 0.f, 0.f}};
                    mmT<2, 1>(acc, Wa, LJ, wave, MbrT, LJ, lane);
#pragma unroll
                    for (int nb = 0; nb < 2; ++nb) {
                        const int t = nb * 16 + l15;
                        f32x4 v = acc[nb];
#pragma unroll
                        for (int r = 0; r < 4; ++r) v[r] += bf2f(Rh[t * LT + x0 + r]);
                        *(U2*)(gQT + t * 64 + x0) = pack4(v);
                    }
                }
                {
                    f32x4 acc[2] = {f32x4{0.f, 0.f, 0.f, 0.f}, f32x4{0.f, 0.f, 0.f, 0.f}};
                    mmT<2, 1>(acc, U0, LJ, wave, MbrT, LJ, lane);
                    mmT<2, 1>(acc, VT, LJ, wave, MkrT, LJ, lane);
#pragma unroll
                    for (int nb = 0; nb < 2; ++nb) *(U2*)(gY0 + (nb * 16 + l15) * 64 + x0) = pack4(acc[nb]);
                }
            }
        }
    }
}

__device__ __forceinline__ U2 ldu2(const bf16_t* p) { return *(const U2*)p; }
constexpr int R2D = 6, R2LD = 72;
__device__ void phaseR2(const Params& p, int bid, int nblk, char* smem) {
    unsigned char* CH = p.ws + WS_CH;
    bf16_t* PL = (bf16_t*)smem;
    const int tid = threadIdx.x, lane = tid & 63, wave = tid >> 6, q = lane >> 4, l15 = lane & 15;
    const int lrow = wave * 16 + (lane >> 2), lcol = (lane & 3) * 16;
    for (int chain = bid; chain < NCHAIN; chain += nblk) {
        const int i = wave * 16 + l15;
        unsigned char* chbase = CH + (size_t)chain * NCK * CH_BYTES;
        f32x4 st[4];
#pragma unroll
        for (int nt = 0; nt < 4; ++nt) st[nt] = f32x4{0.f, 0.f, 0.f, 0.f};
        u32x4 pq[R2D][2]; U2 sa[R2D][4];
#pragma unroll
        for (int k = 0; k < R2D; ++k) {
            const unsigned char* chp = chbase + (size_t)(k < NCK ? k : NCK - 1) * CH_BYTES;
            const bf16_t* gp = (const bf16_t*)(chp + CH_PM) + lrow * 64 + lcol;
            pq[k][0] = *(const u32x4*)gp; pq[k][1] = *(const u32x4*)(gp + 8);
#pragma unroll
            for (int nt = 0; nt < 4; ++nt) sa[k][nt] = ldu2((const bf16_t*)(chp + CH_SA) + i * 64 + nt * 16 + 4 * q);
        }
#pragma unroll 1
        for (int c0 = 0; c0 < NCK; c0 += R2D) {
#pragma unroll
            for (int k = 0; k < R2D; ++k) {
                const int c = c0 + k;
                if (c < NCK) {
                bf16_t* pl = PL + (k & 1) * 64 * R2LD;
                *(u32x4*)(pl + lrow * R2LD + lcol) = pq[k][0]; *(u32x4*)(pl + lrow * R2LD + lcol + 8) = pq[k][1];
                const U2 s0 = sa[k][0], s1 = sa[k][1], s2 = sa[k][2], s3 = sa[k][3];
                {
                    const int cn = (c + R2D < NCK) ? c + R2D : NCK - 1;
                    const unsigned char* chp = chbase + (size_t)cn * CH_BYTES;
                    const bf16_t* gp = (const bf16_t*)(chp + CH_PM) + lrow * 64 + lcol;
                    pq[k][0] = *(const u32x4*)gp; pq[k][1] = *(const u32x4*)(gp + 8);
#pragma unroll
                    for (int nt = 0; nt < 4; ++nt) sa[k][nt] = ldu2((const bf16_t*)(chp + CH_SA) + i * 64 + nt * 16 + 4 * q);
                }
                __syncthreads();
                bf16_t* gSA = (bf16_t*)(chbase + (size_t)c * CH_BYTES + CH_SA) + i * 64 + 4 * q;
                bf16x8 bfr[2];
#pragma unroll
                for (int ks = 0; ks < 2; ++ks) {
                    const U2 lo = pack4(st[2 * ks]), hi = pack4(st[2 * ks + 1]);
                    bfr[ks] = __builtin_bit_cast(bf16x8, u32x4{lo.x, lo.y, hi.x, hi.y});
                    *(U2*)(gSA + (2 * ks) * 16) = lo; *(U2*)(gSA + (2 * ks + 1) * 16) = hi;
                }
#pragma unroll
                for (int nt = 0; nt < 4; ++nt) {
                    const U2 sv = nt == 0 ? s0 : nt == 1 ? s1 : nt == 2 ? s2 : s3;
                    f32x4 acc = f32x4{bitsf(sv.x << 16), bitsf(sv.x & 0xFFFF0000u), bitsf(sv.y << 16), bitsf(sv.y & 0xFFFF0000u)};
#pragma unroll
                    for (int ks = 0; ks < 2; ++ks) {
                        const U2 lo = *(const U2*)(pl + (nt * 16 + l15) * R2LD + 32 * ks + 4 * q), hi = *(const U2*)(pl + (nt * 16 + l15) * R2LD + 32 * ks + 16 + 4 * q);
                        acc = MFMA16(__builtin_bit_cast(bf16x8, u32x4{lo.x, lo.y, hi.x, hi.y}), bfr[ks], acc);
                    }
                    st[nt] = acc;
                }
                }
            }
        }
        __syncthreads();
    }
}

__device__ void phaseR3(const Params& p, int bid, int nblk, char* smem) {
    const bf16_t* P = WSP(bf16_t, WS_R1);
    const unsigned char* CH = p.ws + WS_CH;
    const float* RBON = WSP(float, WS_RBON);
    bf16_t* MIX = WSP(bf16_t, WS_R3);
    float* red = (float*)smem;
    const int tid = threadIdx.x, lane = tid & 63, wave = tid >> 6, q = lane >> 4, l15 = lane & 15;
    for (int m = bid * 256 + tid; m < MLAT; m += nblk * 256) {
        const float* sp = WSP(float, WS_SSQP) + (size_t)m * LRU_BLOCKS;
        float sq = 0.f;
#pragma unroll
        for (int c = 0; c < LRU_BLOCKS; ++c) sq += sp[c];
        WSP(float, WS_RINV)[m] = 1.0f / sqrtf(sq * (1.0f / D_LRU) + RMS_EPS);
    }
    for (int it = bid; it < BATCH * HEADS * NLC; it += nblk) {
        const int pc = it % NLC, h = (it / NLC) % HEADS, b = it / (NLC * HEADS);
        const int i0 = wave * 16 + q * 4;
        f32x4 y[2] = {f32x4{0.f, 0.f, 0.f, 0.f}, f32x4{0.f, 0.f, 0.f, 0.f}};
        float bon[2] = {0.f, 0.f};
#pragma unroll
        for (int d = 0; d < 2; ++d) {
            const int chain = (b * HEADS + h) * 2 + d, c = NCC + (d ? NLC - 1 - pc : pc);
            const size_t item = (size_t)chain * NCK + c;
            const unsigned char* chp = CH + item * CH_BYTES;
            const bf16_t* gS = (const bf16_t*)(chp + CH_SA); const bf16_t* gQT = (const bf16_t*)(chp + CH_QT); const bf16_t* gY0 = (const bf16_t*)(chp + CH_Y0);
#pragma unroll
            for (int nb = 0; nb < 2; ++nb) {
                const int pl = nb * 16 + l15, tau = d ? RC - 1 - pl : pl;
                const U2 y0 = ldu2(gY0 + tau * 64 + i0);
                f32x4 acc = f32x4{bitsf(y0.x << 16), bitsf(y0.x & 0xFFFF0000u), bitsf(y0.y << 16), bitsf(y0.y & 0xFFFF0000u)};
#pragma unroll
                for (int ks = 0; ks < 2; ++ks) {
                    const bf16x8 xf = *(const bf16x8*)(gS + (wave * 16 + l15) * 64 + ks * 32 + 8 * q);
                    const bf16x8 yf = *(const bf16x8*)(gQT + tau * 64 + ks * 32 + 8 * q);
                    acc = MFMA16(xf, yf, acc);
                }
                y[nb] += acc;
                bon[nb] += RBON[item * RC + tau];
            }
        }
        f32x4 g[2] = {f32x4{0.f, 0.f, 0.f, 0.f}, f32x4{0.f, 0.f, 0.f, 0.f}};
#pragma unroll
        for (int ks = 0; ks < 4; ++ks) {
            bf16x8 xf;
#pragma unroll
            for (int jj = 0; jj < 8; ++jj) xf[jj] = (short)f2bf(p.g2[(size_t)(ks * 32 + 8 * q + jj) * D_RWKV + h * 64 + wave * 16 + l15]);
#pragma unroll
            for (int nb = 0; nb < 2; ++nb) {
                const int pos = pc * RC + nb * 16 + l15;
                float o[8]; shifted8(p, P, 1, b, pos, SEQ, 3 * D_RWKV + 256 + ks * 32 + 8 * q, o);
                u32x4 t; t[0] = pk2(fsigm(o[0]), fsigm(o[1])); t[1] = pk2(fsigm(o[2]), fsigm(o[3])); t[2] = pk2(fsigm(o[4]), fsigm(o[5])); t[3] = pk2(fsigm(o[6]), fsigm(o[7]));
                g[nb] = MFMA16(xf, __builtin_bit_cast(bf16x8, t), g[nb]);
            }
        }
        float s1[2], s2[2];
#pragma unroll
        for (int nb = 0; nb < 2; ++nb) {
            float a = hsum4(y[nb]), bq = hsum4(y[nb] * y[nb]);
            a += __shfl_xor(a, 16); a += __shfl_xor(a, 32); bq += __shfl_xor(bq, 16); bq += __shfl_xor(bq, 32);
            s1[nb] = a; s2[nb] = bq;
        }
        __syncthreads();
        if (q == 0) { red[(0 * 4 + wave) * 32 + l15] = s1[0]; red[(0 * 4 + wave) * 32 + 16 + l15] = s1[1]; red[(1 * 4 + wave) * 32 + l15] = s2[0]; red[(1 * 4 + wave) * 32 + 16 + l15] = s2[1]; }
        __syncthreads();
        const f32x4 gng = ld4(p.gn_g + h * 64 + i0), gnb = ld4(p.gn_b + h * 64 + i0);
#pragma unroll
        for (int nb = 0; nb < 2; ++nb) {
            const int pl = nb * 16 + l15, pos = pc * RC + pl;
            float t1 = 0.f, t2 = 0.f;
#pragma unroll
            for (int w = 0; w < 4; ++w) { t1 += red[(0 * 4 + w) * 32 + pl]; t2 += red[(1 * 4 + w) * 32 + pl]; }
            const float mu = t1 * (1.0f / 64.0f), var = fmaxf(t2 * (1.0f / 64.0f) - mu * mu, 0.f), rstd = 1.0f / sqrtf(var + GN_EPS);
            const int chv = 2 * D_RWKV + h * 64 + i0;
            const size_t mrow = rwkv_row(1, b, pos);
            const U2 zc = ldu2(P + mrow * D_IN + RW0 + chv);
            U2 zp; zp.x = 0u; zp.y = 0u; U2 zn = zp;
            if (pos > 0) zp = ldu2(P + rwkv_row(1, b, pos - 1) * D_IN + RW0 + chv);
            if (pos < SEQ - 1) zn = ldu2(P + rwkv_row(1, b, pos + 1) * D_IN + RW0 + chv);
            const f32x4 z = f32x4{bitsf(zc.x << 16), bitsf(zc.x & 0xFFFF0000u), bitsf(zc.y << 16), bitsf(zc.y & 0xFFFF0000u)};
            const f32x4 zpv = f32x4{bitsf(zp.x << 16), bitsf(zp.x & 0xFFFF0000u), bitsf(zp.y << 16), bitsf(zp.y & 0xFFFF0000u)};
            const f32x4 znv = f32x4{bitsf(zn.x << 16), bitsf(zn.x & 0xFFFF0000u), bitsf(zn.y << 16), bitsf(zn.y & 0xFFFF0000u)};
            const f32x4 v = z + ld4(p.mu_prev + chv) * (zpv - z) + ld4(p.mu_next + chv) * (znv - z);
            const f32x4 yn = (y[nb] - mu) * rstd * gng + gnb;
            *(U2*)(MIX + mrow * D_MIX + D_LRU + h * 64 + i0) = pack4((yn + bon[nb] * v) * g[nb]);
        }
    }
}

__device__ void phaseJ(const Params& p, int bid, int nblk, char* smem) {
    const bf16_t* MIX = WSP(bf16_t, WS_R3);
    float* YOUT = WSP(float, WS_R1);
    constexpr int NTN = D_MODEL / 128, NTM = MLAT / 128;
    const float* RINV = WSP(float, WS_RINV);
    constexpr int GM = (NTM % 8 == 0) ? 8 : 1;
    for (int it = xcd_vbid(bid, nblk); it < NTN * NTM; it += nblk) {
        const int mg = it / (GM * NTN), r = it % (GM * NTN), nt = r / GM, mt = mg * GM + (r % GM);
        gemm_tile<false>(smem, MIX, D_MIX, nullptr, mt * 128, p.w_out, nullptr, D_MODEL, nt * 128, D_MIX, [&](int ml, int nl, f32x4 v, f32x4) {
            *(f32x4*)(YOUT + (size_t)(mt * 128 + ml) * D_MODEL + nt * 128 + nl) = v;
        }, RINV, D_LRU / 64);
    }
}

__device__ void phaseK(const Params& p, int bid, int nblk, char* smem) {
    const int lane = threadIdx.x & 63, wave = threadIdx.x >> 6;
    const float* MOD = WSP(float, WS_MOD); const float* STATS = WSP(float, WS_STATS);
    const float* YOUT = WSP(float, WS_R1);
    float* H1 = WSP(float, WS_R5); bf16_t* U2b = WSP(bf16_t, WS_R6); float* AFF = WSP(float, WS_AFF);
    for (int row = bid * 4 + wave; row < MLAT; row += nblk * 4) {
        const float* xr = p.x + (size_t)row * D_MODEL;
        const float* md = MOD + (size_t)(row / SEQ) * 6 * D_MODEL;
        const float mu0 = STATS[row * 2], rs0 = STATS[row * 2 + 1];
        f32x4 v0, v1, v2, v3; float s = 0.f;
#define PK_LOAD(V, J) { const int k = (J) * 256 + lane * 4; \
            V = ALPHA_F * ((ld4(xr + k) - mu0) * rs0 * ld4(p.ln_in_g + k) + ld4(p.ln_in_b + k)) + ld4(md + 2 * D_MODEL + k) * ld4(YOUT + (size_t)row * D_MODEL + k); s += hsum4(V); }
        PK_LOAD(v0, 0)
        if (NV > 1) PK_LOAD(v1, 1) else v1 = f32x4{0.f, 0.f, 0.f, 0.f};
        if (NV > 2) { PK_LOAD(v2, 2) PK_LOAD(v3, 3) } else { v2 = v1; v3 = v1; }
#undef PK_LOAD
        const float mu = wave_sum(s) * (1.0f / D_MODEL);
        v0 -= mu; float s2 = hsum4(v0 * v0);
        if (NV > 1) { v1 -= mu; s2 += hsum4(v1 * v1); }
        if (NV > 2) { v2 -= mu; v3 -= mu; s2 += hsum4(v2 * v2) + hsum4(v3 * v3); }
        const float rstd = 1.0f / sqrtf(wave_sum(s2) * (1.0f / D_MODEL) + LN_EPS);
        float lg[N_EXPERTS];
#pragma unroll
        for (int e = 0; e < N_EXPERTS; ++e) lg[e] = 0.f;
#pragma unroll
        for (int j = 0; j < NV; ++j) {
            const int k = j * 256 + lane * 4;
            const f32x4 vv = (j == 0) ? v0 : (j == 1) ? v1 : (j == 2) ? v2 : v3;
            const f32x4 h = vv * rstd * ld4(p.ln1_g + k) + ld4(p.ln1_b + k);
            *(f32x4*)(H1 + (size_t)row * D_MODEL + k) = h;
            const f32x4 u = h * (1.0f + ld4(md + 4 * D_MODEL + k)) + ld4(md + 3 * D_MODEL + k);
            *(U2*)(U2b + (size_t)row * D_MODEL + k) = pack4(u);
#pragma unroll
            for (int q = 0; q < 4; ++q) {
                const float* wr = p.w_router + (size_t)(k + q) * N_EXPERTS;
#pragma unroll
                for (int e4 = 0; e4 < N_EXPERTS / 4; ++e4) {
                    const f32x4 w = ld4(wr + e4 * 4);
                    lg[e4 * 4 + 0] += u[q] * w[0]; lg[e4 * 4 + 1] += u[q] * w[1]; lg[e4 * 4 + 2] += u[q] * w[2]; lg[e4 * 4 + 3] += u[q] * w[3];
                }
            }
        }
        float mx = -3.0e38f;
#pragma unroll
        for (int e = 0; e < N_EXPERTS; ++e) { lg[e] = wave_sum(lg[e]); mx = fmaxf(mx, lg[e]); }
        float den = 0.f;
#pragma unroll
        for (int e = 0; e < N_EXPERTS; ++e) { lg[e] = expf(lg[e] - mx); den += lg[e]; }
        float mine = 0.f;
#pragma unroll
        for (int e = 0; e < N_EXPERTS; ++e) mine = (lane == e) ? lg[e] : mine;
        if (lane < N_EXPERTS) AFF[(size_t)row * N_EXPERTS + lane] = mine / den;
    }
}

__device__ __forceinline__ int block_sum_int(int v, int* red) {
    const int lane = threadIdx.x & 63, wave = threadIdx.x >> 6;
#pragma unroll
    for (int o = 1; o < 64; o <<= 1) v += __shfl_xor(v, o);
    __syncthreads();
    if (lane == 0) red[wave] = v;
    __syncthreads();
    return red[0] + red[1] + red[2] + red[3];
}
__device__ void phaseL(const Params& p, int bid, int nblk, char* smem) {
    const float* AFF = WSP(float, WS_AFF);
    int* IDX = WSP(int, WS_IDX); float* GATE = WSP(float, WS_GATE); int* SLOTOF = WSP(int, WS_SLOT);
    unsigned* vals = (unsigned*)smem;
    int* red = (int*)(vals + SEQ);
    int* wsum = red + 8;
    const int tid = threadIdx.x, lane = tid & 63, wave = tid >> 6;
    constexpr int PER = SEQ / 256;
    for (int be = bid; be < BATCH * N_EXPERTS; be += nblk) {
        const int b = be / N_EXPERTS, e = be % N_EXPERTS;
        __syncthreads();
        for (int t = tid; t < SEQ; t += 256) vals[t] = fbits(AFF[((size_t)b * SEQ + t) * N_EXPERTS + e]);
        __syncthreads();
        unsigned lo = 0u, hi = 0x7F800000u;
        while (lo < hi) {
            const unsigned mid = lo + (hi - lo + 1u) / 2u;
            int c = 0;
            for (int t = tid; t < SEQ; t += 256) c += (vals[t] >= mid) ? 1 : 0;
            c = block_sum_int(c, red);
            if (c >= CAP) lo = mid; else hi = mid - 1u;
        }
        const unsigned T = lo;
        int cg = 0, ce = 0;
        for (int q = 0; q < PER; ++q) { const unsigned v = vals[tid * PER + q]; cg += (v > T) ? 1 : 0; ce += (v == T) ? 1 : 0; }
        int pg = cg, pe = ce;
#pragma unroll
        for (int o = 1; o < 64; o <<= 1) { const int a = __shfl_up(pg, o), bb = __shfl_up(pe, o); if (lane >= o) { pg += a; pe += bb; } }
        __syncthreads();
        if (lane == 63) { wsum[wave] = pg; wsum[4 + wave] = pe; }
        __syncthreads();
        int og = 0, oe = 0, totg = 0;
        for (int w = 0; w < 4; ++w) { if (w < wave) { og += wsum[w]; oe += wsum[4 + w]; } totg += wsum[w]; }
        int posg = og + pg - cg, pose = oe + pe - ce;
        const int need_eq = CAP - totg;
        for (int q = 0; q < PER; ++q) {
            const int t = tid * PER + q; const unsigned v = vals[t];
            int slot = -1;
            if (v > T) { slot = posg++; }
            else if (v == T) { if (pose < need_eq) slot = totg + pose; pose++; }
            if (slot >= 0) { IDX[(size_t)be * CAP + slot] = b * SEQ + t; GATE[(size_t)be * CAP + slot] = bitsf(v); }
            SLOTOF[((size_t)b * SEQ + t) * N_EXPERTS + e] = slot;
        }
    }
}

__device__ void phaseM(const Params& p, int bid, int nblk, char* smem) {
    const bf16_t* U2b = WSP(bf16_t, WS_R6); const int* IDX = WSP(int, WS_IDX);
    bf16_t* HID = WSP(bf16_t, WS_R1);
    constexpr int NTN = D_EXPERT / 64, NTM = CAP / 128;
    for (int it = xcd_vbid(bid, nblk); it < BATCH * N_EXPERTS * NTM * NTN; it += nblk) {
        const int mt = it % NTM, b = (it / NTM) % BATCH, nt = (it / (NTM * BATCH)) % NTN, e = it / (NTM * BATCH * NTN), be = b * N_EXPERTS + e;
        const float* wg = p.w_gate + (size_t)e * D_MODEL * D_EXPERT; const float* wu = p.w_up + (size_t)e * D_MODEL * D_EXPERT;
        gemm_tile<true>(smem, U2b, D_MODEL, IDX + (size_t)be * CAP, mt * 128, wg, wu, D_EXPERT, nt * 64, D_MODEL, [&](int ml, int nl, f32x4 g, f32x4 u) {
            U2 o; o.x = pk2(siluf_(g[0]) * u[0], siluf_(g[1]) * u[1]); o.y = pk2(siluf_(g[2]) * u[2], siluf_(g[3]) * u[3]);
            *(U2*)(HID + ((size_t)be * CAP + mt * 128 + ml) * D_EXPERT + nt * 64 + nl) = o;
        });
    }
}
__device__ void phaseN(const Params& p, int bid, int nblk, char* smem) {
    const bf16_t* HID = WSP(bf16_t, WS_R1); const float* GATE = WSP(float, WS_GATE);
    bf16_t* YS = WSP(bf16_t, WS_R2);
    constexpr int NTN = D_MODEL / 128, NTM = CAP / 128;
    for (int it = xcd_vbid(bid, nblk); it < BATCH * N_EXPERTS * NTM * NTN; it += nblk) {
        const int mt = it % NTM, b = (it / NTM) % BATCH, nt = (it / (NTM * BATCH)) % NTN, e = it / (NTM * BATCH * NTN), be = b * N_EXPERTS + e;
        const float* wd = p.w_down + (size_t)e * D_EXPERT * D_MODEL;
        gemm_tile<false>(smem, HID + (size_t)be * CAP * D_EXPERT, D_EXPERT, nullptr, mt * 128, wd, nullptr, D_MODEL, nt * 128, D_EXPERT, [&](int ml, int nl, f32x4 v, f32x4) {
            const int slot = mt * 128 + ml;
            const float gt = GATE[(size_t)be * CAP + slot];
            *(U2*)(YS + ((size_t)be * CAP + slot) * D_MODEL + nt * 128 + nl) = pack4(v * gt);
        });
    }
}
__device__ void phaseO(const Params& p, int bid, int nblk, char* smem) {
    const int lane = threadIdx.x & 63, wave = threadIdx.x >> 6;
    const float* MOD = WSP(float, WS_MOD); const float* H1 = WSP(float, WS_R5); const bf16_t* YS = WSP(bf16_t, WS_R2); const int* SLOTOF = WSP(int, WS_SLOT);
    for (int row = bid * 4 + wave; row < MLAT; row += nblk * 4) {
        const float* md = MOD + (size_t)(row / SEQ) * 6 * D_MODEL;
        f32x4 v0, v1, v2, v3; float s = 0.f;
        f32x4 y0 = f32x4{0.f, 0.f, 0.f, 0.f}, y1 = y0, y2 = y0, y3 = y0;
        const int myslot = (lane < N_EXPERTS) ? SLOTOF[(size_t)row * N_EXPERTS + lane] : -1;
        const int bbase = (row / SEQ) * N_EXPERTS;
        for (int e = 0; e < N_EXPERTS; ++e) {
            const int sl = __shfl(myslot, e);
            if (sl >= 0) {
                const bf16_t* yr = YS + ((size_t)(bbase + e) * CAP + sl) * D_MODEL + lane * 4;
                { const U2 u = *(const U2*)yr; y0 += f32x4{bitsf(u.x << 16), bitsf(u.x & 0xFFFF0000u), bitsf(u.y << 16), bitsf(u.y & 0xFFFF0000u)}; }
                if (NV > 1) { const U2 u = *(const U2*)(yr + 256); y1 += f32x4{bitsf(u.x << 16), bitsf(u.x & 0xFFFF0000u), bitsf(u.y << 16), bitsf(u.y & 0xFFFF0000u)}; }
                if (NV > 2) { const U2 u = *(const U2*)(yr + 512); y2 += f32x4{bitsf(u.x << 16), bitsf(u.x & 0xFFFF0000u), bitsf(u.y << 16), bitsf(u.y & 0xFFFF0000u)};
                              const U2 w = *(const U2*)(yr + 768); y3 += f32x4{bitsf(w.x << 16), bitsf(w.x & 0xFFFF0000u), bitsf(w.y << 16), bitsf(w.y & 0xFFFF0000u)}; }
            }
        }
#define PO_LOAD(V, J) { const int k = (J) * 256 + lane * 4; const f32x4 yy = ((J) == 0) ? y0 : ((J) == 1) ? y1 : ((J) == 2) ? y2 : y3; V = ALPHA_F * ld4(H1 + (size_t)row * D_MODEL + k) + ld4(md + 5 * D_MODEL + k) * yy; s += hsum4(V); }
        PO_LOAD(v0, 0)
        if (NV > 1) PO_LOAD(v1, 1) else v1 = f32x4{0.f, 0.f, 0.f, 0.f};
        if (NV > 2) { PO_LOAD(v2, 2) PO_LOAD(v3, 3) } else { v2 = v1; v3 = v1; }
#undef PO_LOAD
        const float mu = wave_sum(s) * (1.0f / D_MODEL);
        v0 -= mu; float s2 = hsum4(v0 * v0);
        if (NV > 1) { v1 -= mu; s2 += hsum4(v1 * v1); }
        if (NV > 2) { v2 -= mu; v3 -= mu; s2 += hsum4(v2 * v2) + hsum4(v3 * v3); }
        const float rstd = 1.0f / sqrtf(wave_sum(s2) * (1.0f / D_MODEL) + LN_EPS);
#pragma unroll
        for (int j = 0; j < NV; ++j) {
            const int k = j * 256 + lane * 4;
            const f32x4 vv = (j == 0) ? v0 : (j == 1) ? v1 : (j == 2) ? v2 : v3;
            *(f32x4*)(p.out + (size_t)row * D_MODEL + k) = vv * rstd * ld4(p.ln2_g + k) + ld4(p.ln2_b + k);
        }
    }
}

#define XB_TMO      128
#define XB_XCNT(j)  (256  + 64 * (j))
#define XB_XSUB(j)  (1280 + 64 * (j))
#define XB_XGEN(j)  (2304 + 64 * (j))
#define XB_TOP      3328
#define XB_TOPGEN   3392
#define XCD_BAR_WORDS 3456
#define XB_SPIN_CAP (1u << 22)
#ifndef HOST_EMU
__device__ __forceinline__ unsigned xb_ld(unsigned* p) { return __hip_atomic_load(p, __ATOMIC_RELAXED, __HIP_MEMORY_SCOPE_AGENT); }
__device__ __forceinline__ unsigned xb_add(unsigned* p, unsigned v) { return __hip_atomic_fetch_add(p, v, __ATOMIC_RELAXED, __HIP_MEMORY_SCOPE_AGENT); }
__device__ __forceinline__ unsigned xb_xcc_id() { return (unsigned)__builtin_amdgcn_s_getreg((3 << 11) | 20) & 0xFu; }
#define XB_SPIN(cond, bar) do { unsigned _sp = 0; while (cond) { __builtin_amdgcn_s_sleep(1); \
    if ((++_sp & 255u) == 0u) { if (xb_ld(&(bar)[XB_TMO])) break; if (_sp > XB_SPIN_CAP) { atomicAdd(&(bar)[XB_TMO], 1u); break; } } } } while (0)
struct XcdBarrier { unsigned* bar; unsigned x; unsigned* st; };
__device__ __forceinline__ XcdBarrier xcd_barrier_post(unsigned* bar, unsigned* st) {
    XcdBarrier b; b.bar = bar; b.x = xb_xcc_id(); b.st = st;
    if (threadIdx.x == 0) (void)xb_add(&bar[XB_XCNT(b.x)], 1u);
    return b;
}
__device__ __forceinline__ void xcd_barrier_complete(unsigned* bar, unsigned x, unsigned& nloc, unsigned& nx) {
    const unsigned G = gridDim.x;
    unsigned sum, cnt, mine, sp = 0u;
    for (;;) {
        sum = 0u; cnt = 0u; mine = 0u;
#pragma unroll
        for (unsigned j = 0; j < 16; ++j) { const unsigned c = xb_ld(&bar[XB_XCNT(j)]); sum += c; cnt += (c > 0u) ? 1u : 0u; mine = (j == x) ? c : mine; }
        if (sum == G) break;
        __builtin_amdgcn_s_sleep(1);
        if ((++sp & 255u) == 0u) { if (xb_ld(&bar[XB_TMO])) break; if (sp > XB_SPIN_CAP) { atomicAdd(&bar[XB_TMO], 1u); break; } }
    }
    nloc = mine > 0u ? mine : 1u; nx = cnt > 0u ? cnt : 1u;
}
__device__ __forceinline__ void grid_barrier(const XcdBarrier& b) {
    asm volatile("s_waitcnt vmcnt(0)" ::: "memory");
    __syncthreads();
    if (threadIdx.x == 0) {
        unsigned* bar = b.bar;
        __builtin_amdgcn_s_waitcnt(0);
        volatile unsigned* st = b.st;
        unsigned nloc = st[0], nx = st[1];
        if (nloc == 0u) { xcd_barrier_complete(bar, b.x, nloc, nx); st[0] = nloc; st[1] = nx; }
        const unsigned old = xb_add(&bar[XB_XSUB(b.x)], 1u);
        const unsigned gen = old / nloc;
        if (old + 1u == (gen + 1u) * nloc) {
            __builtin_amdgcn_fence(__ATOMIC_RELEASE, "agent");
            asm volatile("s_waitcnt vmcnt(0)" ::: "memory");
            const unsigned og = xb_add(&bar[XB_TOP], 1u);
            const unsigned tg = og / nx;
            if (og + 1u == (tg + 1u) * nx) xb_add(&bar[XB_TOPGEN], 1u);
            else XB_SPIN(xb_ld(&bar[XB_TOPGEN]) == tg, bar);
            __builtin_amdgcn_fence(__ATOMIC_ACQUIRE, "agent");
            xb_add(&bar[XB_XGEN(b.x)], 1u);
            asm volatile("s_waitcnt vmcnt(0)" ::: "memory");
        } else {
            XB_SPIN(xb_ld(&bar[XB_XGEN(b.x)]) == gen, bar);
            __builtin_amdgcn_fence(__ATOMIC_ACQUIRE, "agent");
            asm volatile("s_waitcnt vmcnt(0)" ::: "memory");
        }
    }
    __syncthreads();
}
#else
struct XcdBarrier { int dummy; };
__device__ __forceinline__ XcdBarrier xcd_barrier_post(unsigned*, unsigned*) { return XcdBarrier{0}; }
__device__ __forceinline__ void grid_barrier(const XcdBarrier&) { __syncthreads(); }
#endif

__global__ void __launch_bounds__(256, 2) fused_forward(Params p) {
    __shared__ __attribute__((aligned(16))) char smem[SMEM_BYTES];
    __shared__ __attribute__((aligned(16))) unsigned xb_words[4];
    if (threadIdx.x == 0) { xb_words[0] = 0u; xb_words[1] = 0u; xb_words[2] = 0u; xb_words[3] = 0u; }
    __syncthreads();
    const XcdBarrier gb = xcd_barrier_post(WSP(unsigned, WS_CTRL), xb_words);
    const int bid = blockIdx.x, nblk = gridDim.x;
    phaseA(p, bid, nblk, smem); grid_barrier(gb);
    phaseB(p, bid, nblk, smem); grid_barrier(gb);
    phaseC(p, bid, nblk, smem); grid_barrier(gb);
    phaseD(p, bid, nblk, smem); grid_barrier(gb);
    phaseE(p, bid, nblk, smem); grid_barrier(gb);
    phaseF(p, bid, nblk, smem); grid_barrier(gb);
    phaseR1(p, bid, nblk, smem); grid_barrier(gb);
    phaseR2(p, bid, nblk, smem); grid_barrier(gb);
    phaseR3(p, bid, nblk, smem); grid_barrier(gb);
    phaseJ(p, bid, nblk, smem); grid_barrier(gb);
    phaseK(p, bid, nblk, smem); grid_barrier(gb);
    phaseL(p, bid, nblk, smem); grid_barrier(gb);
    phaseM(p, bid, nblk, smem); grid_barrier(gb);
    phaseN(p, bid, nblk, smem); grid_barrier(gb);
    phaseO(p, bid, nblk, smem);
}

#ifdef MULTI_LAUNCH
#define PHASE_KERNEL(NAME) \
    __global__ void __launch_bounds__(256) k_##NAME(Params p) { __shared__ __attribute__((aligned(16))) char smem[SMEM_BYTES]; NAME(p, blockIdx.x, gridDim.x, smem); }
PHASE_KERNEL(phaseA) PHASE_KERNEL(phaseB) PHASE_KERNEL(phaseC) PHASE_KERNEL(phaseD) PHASE_KERNEL(phaseE) PHASE_KERNEL(phaseF) PHASE_KERNEL(phaseR1) PHASE_KERNEL(phaseR2) PHASE_KERNEL(phaseR3)
PHASE_KERNEL(phaseJ) PHASE_KERNEL(phaseK) PHASE_KERNEL(phaseL) PHASE_KERNEL(phaseM) PHASE_KERNEL(phaseN) PHASE_KERNEL(phaseO)
#ifdef HOST_EMU
void emu_hook(const char* name, const Params& p);
#define LAUNCH(NAME, grid) do { EMU_LAUNCH(k_##NAME, grid, 256, p); emu_hook(#NAME, p); } while (0)
#else
#define LAUNCH(NAME, grid) hipLaunchKernelGGL(k_##NAME, dim3(grid), dim3(256), 0, stream, p)
#endif
#endif

extern "C" void kernel_launch(void* const* d_in, const int* in_sizes, int n_in, void* d_out, int out_size, void* d_ws, size_t ws_size, hipStream_t stream) {
    if (n_in != 38 || out_size != MLAT * D_MODEL || ws_size < WS_END) { fprintf(stderr, "kernel_launch: unexpected shapes (n_in %d out %d ws %zu need %zu)\n", n_in, out_size, ws_size, (size_t)WS_END); return; }
    Params p{};
    const float** f = (const float**)&p;
    for (int i = 0; i < 38; ++i) f[i] = (const float*)d_in[i];
    p.out = (float*)d_out; p.ws = (unsigned char*)d_ws;
#ifdef MULTI_LAUNCH
    const int G = 512;
    LAUNCH(phaseA, 6 * D_MODEL / 64);
    LAUNCH(phaseB, G);
    LAUNCH(phaseC, G);
    LAUNCH(phaseD, G);
    LAUNCH(phaseE, 16);
    LAUNCH(phaseF, G);
    LAUNCH(phaseR1, G);
    LAUNCH(phaseR2, NCHAIN);
    LAUNCH(phaseR3, G);
    LAUNCH(phaseJ, G);
    LAUNCH(phaseK, G);
    LAUNCH(phaseL, BATCH * N_EXPERTS);
    LAUNCH(phaseM, G);
    LAUNCH(phaseN, G);
    LAUNCH(phaseO, G);
#elif defined(HOST_EMU)
    EMU_LAUNCH(fused_forward, 1, 256, p);
#else
    static int grid_blocks = 0;
    if (!grid_blocks) {
        int dev = 0, cus = 0, per_cu = 0;
        (void)hipGetDevice(&dev);
        (void)hipDeviceGetAttribute(&cus, hipDeviceAttributeMultiprocessorCount, dev);
        (void)hipOccupancyMaxActiveBlocksPerMultiprocessor(&per_cu, fused_forward, 256, 0);
        if (per_cu > 2) per_cu = 2;
        if (per_cu < 1) { fprintf(stderr, "kernel_launch: occupancy query returned %d blocks per CU\n", per_cu); per_cu = 1; }
        grid_blocks = cus * per_cu;
    }
    (void)hipMemsetAsync((char*)d_ws + WS_CTRL, 0, XCD_BAR_WORDS * 4, stream);
    void* args[] = {&p};
    hipError_t e = hipLaunchCooperativeKernel((void*)fused_forward, dim3(grid_blocks), dim3(256), args, 0, stream);
    if (e != hipSuccess) fprintf(stderr, "cooperative launch failed: %s (grid %d)\n", hipGetErrorString(e), grid_blocks);
#endif
}
```

```cpp
#ifndef HOST_EMU
#include <hip/hip_runtime.h>
#include <cstdio>
#endif
#include <cstdint>
#include <cstddef>

#ifdef CFG_SMALL
constexpr int D_MODEL = 256, BATCH = 2, SEQ = 256, GRID_W = 16, CTX_LEN = 64, LRU_BLOCKS = 2, N_EXPERTS = 4, D_EXPERT = 256;
#else
constexpr int D_MODEL = 1024, BATCH = 4, SEQ = 4096, GRID_W = 64, CTX_LEN = 256, LRU_BLOCKS = 8, N_EXPERTS = 16, D_EXPERT = 1408;
#endif
constexpr int ROWS = SEQ / GRID_W;
constexpr int D_LRU = D_MODEL / 2, LRU_BLOCK = 64;
constexpr int D_RWKV = D_MODEL / 2, HEADS = D_RWKV / 64;
constexpr int D_RWKV_IN = 3 * D_RWKV + 128 + 128 + 128;
constexpr int D_IN = 2 * D_LRU + D_RWKV_IN;
constexpr int D_MIX = D_LRU + D_RWKV;
constexpr int CAP = 2 * SEQ / N_EXPERTS;
constexpr int MLAT = BATCH * SEQ, MCTX = BATCH * CTX_LEN, MTOT = MLAT + MCTX;
constexpr int NMOD = BATCH + 1;
constexpr int RW0 = 2 * D_LRU;
constexpr float ALPHA_F = 1.189207115002721f;
constexpr float LN_EPS = 1e-5f, GN_EPS = 64e-5f, RMS_EPS = 1e-6f;
static_assert(LRU_BLOCKS * LRU_BLOCK == D_LRU, "lru blocks");
static_assert(CAP % 128 == 0 && D_IN % 128 == 0 && D_EXPERT % 64 == 0 && D_MODEL % 128 == 0 && MTOT % 128 == 0, "tile divisibility");

typedef unsigned short bf16_t;
typedef short bf16x8 __attribute__((ext_vector_type(8)));
typedef float f32x4 __attribute__((ext_vector_type(4)));
typedef unsigned u32x4 __attribute__((ext_vector_type(4)));
typedef float f32x2_e __attribute__((ext_vector_type(2)));
struct alignas(16) F4 { float x, y, z, w; };
typedef unsigned U2 __attribute__((ext_vector_type(2)));
struct alignas(16) U4 { unsigned x, y, z, w; };

#ifdef HOST_EMU
#define MFMA16(a, b, c) emu_mfma_16x16x32_bf16(a, b, c)
#define MFMAF32(a, b, c) emu_mfma_16x16x4_f32(a, b, c)
#else
#define MFMA16(a, b, c) __builtin_amdgcn_mfma_f32_16x16x32_bf16(a, b, c, 0, 0, 0)
#define MFMAF32(a, b, c) __builtin_amdgcn_mfma_f32_16x16x4f32(a, b, c, 0, 0, 0)
#endif

__device__ __forceinline__ unsigned fbits(float f) { return __builtin_bit_cast(unsigned, f); }
__device__ __forceinline__ float bitsf(unsigned u) { return __builtin_bit_cast(float, u); }
__device__ __forceinline__ bf16_t f2bf(float f) { unsigned u = fbits(f); u += 0x7FFFu + ((u >> 16) & 1u); return (bf16_t)(u >> 16); }
__device__ __forceinline__ float bf2f(bf16_t h) { return bitsf(((unsigned)h) << 16); }
#ifdef HOST_EMU
__device__ __forceinline__ unsigned pk2(float lo, float hi) { return (unsigned)f2bf(lo) | ((unsigned)f2bf(hi) << 16); }
#else
typedef float f32x2_t __attribute__((ext_vector_type(2)));
typedef __bf16 bf16x2_t __attribute__((ext_vector_type(2)));
__device__ __forceinline__ unsigned pk2(float lo, float hi) { return __builtin_bit_cast(unsigned, __builtin_convertvector(f32x2_t{lo, hi}, bf16x2_t)); }
#endif
__device__ __forceinline__ float sigmoidf_(float x) { return 1.0f / (1.0f + expf(-x)); }
__device__ __forceinline__ float softplusf_(float x) { return fmaxf(x, 0.0f) + log1pf(expf(-fabsf(x))); }
#ifdef HOST_EMU
#define FEXP(x) expf(x)
#else
#define FEXP(x) __expf(x)
#endif
#ifdef HOST_EMU
__device__ __forceinline__ float frcp(float x) { return 1.0f / x; }
__device__ __forceinline__ float frsq(float x) { return 1.0f / sqrtf(x); }
__device__ __forceinline__ float fsqrt(float x) { return sqrtf(x); }
#else
__device__ __forceinline__ float frcp(float x) { return __builtin_amdgcn_rcpf(x); }
__device__ __forceinline__ float frsq(float x) { return __builtin_amdgcn_rsqf(x); }
__device__ __forceinline__ float fsqrt(float x) { return __builtin_amdgcn_sqrtf(x); }
#endif
__device__ __forceinline__ float fsigm(float x) { return frcp(1.0f + FEXP(-x)); }
__device__ __forceinline__ float siluf_(float x) { return x * fsigm(x); }
__device__ __forceinline__ float geluf_(float x) { return x * fsigm(1.5957691216057308f * (x + 0.044715f * x * x * x)); }
__device__ __forceinline__ float wave_sum(float v) {
#pragma unroll
    for (int o = 1; o < 64; o <<= 1) v += __shfl_xor(v, o);
    return v;
}

constexpr size_t al256(size_t x) { return (x + 255) & ~(size_t)255; }
constexpr int NLCH = BATCH * (SEQ / 64), NCCH = BATCH * (CTX_LEN / 64), NCH = NLCH + NCCH;
constexpr size_t WS_CTRL = 0;
constexpr size_t WS_MOD = 65536;
constexpr size_t WS_STATS = al256(WS_MOD + (size_t)NMOD * 6 * D_MODEL * 4);
constexpr size_t WS_SUMA = al256(WS_STATS + (size_t)MTOT * 2 * 4);
constexpr size_t WS_SUMH = al256(WS_SUMA + (size_t)2 * NCH * D_LRU * 4);
constexpr size_t WS_CARRY = al256(WS_SUMH + (size_t)2 * NCH * D_LRU * 4);
constexpr size_t WS_SSQP = al256(WS_CARRY + (size_t)2 * NLCH * D_LRU * 4);
constexpr size_t WS_RINV = al256(WS_SSQP + (size_t)MLAT * LRU_BLOCKS * 4);
constexpr size_t WS_BON = al256(WS_RINV + (size_t)MLAT * 4);
constexpr size_t WS_AFF = al256(WS_BON + (size_t)2 * MLAT * HEADS * 4 + 4096 * 64);
constexpr size_t WS_IDX = al256(WS_AFF + (size_t)MLAT * N_EXPERTS * 4);
constexpr size_t WS_GATE = al256(WS_IDX + (size_t)BATCH * N_EXPERTS * CAP * 4);
constexpr size_t WS_SLOT = al256(WS_GATE + (size_t)BATCH * N_EXPERTS * CAP * 4);
constexpr size_t WS_R1 = al256(WS_SLOT + (size_t)MLAT * N_EXPERTS * 4);
constexpr size_t R1_BYTES = (size_t)MTOT * D_IN * 2 > (size_t)MLAT * D_MODEL * 4 ? ((size_t)MTOT * D_IN * 2 > (size_t)BATCH * N_EXPERTS * CAP * D_EXPERT * 2 ? (size_t)MTOT * D_IN * 2 : (size_t)BATCH * N_EXPERTS * CAP * D_EXPERT * 2)
                                                                                  : ((size_t)MLAT * D_MODEL * 4 > (size_t)BATCH * N_EXPERTS * CAP * D_EXPERT * 2 ? (size_t)MLAT * D_MODEL * 4 : (size_t)BATCH * N_EXPERTS * CAP * D_EXPERT * 2);
constexpr size_t WS_R3 = al256(WS_R1 + R1_BYTES);
constexpr int RC = 32;
constexpr int NCC = CTX_LEN / RC, NLC = SEQ / RC, NCK = NCC + NLC, NCHAIN = BATCH * HEADS * 2;
constexpr size_t CH_PM = 0, CH_SA = 8192, CH_QT = 16384, CH_Y0 = 20480, CH_BYTES = 24576;
constexpr size_t WS_CH = al256(WS_R3 + (size_t)MTOT * D_MODEL * 2);
constexpr size_t CH_TOTAL = (size_t)NCHAIN * NCK * CH_BYTES;
constexpr size_t WS_R5 = WS_CH;
constexpr size_t WS_R2 = al256(WS_R5 + (size_t)MLAT * D_MODEL * 4);
constexpr size_t WS_R6 = al256(WS_R2 + (size_t)MLAT * D_MODEL * 4);
constexpr size_t WS_LATE_END = al256(WS_R6 + (size_t)MLAT * D_MODEL * 2);
constexpr size_t WS_END = (WS_CH + CH_TOTAL > WS_LATE_END) ? al256(WS_CH + CH_TOTAL) : WS_LATE_END;
constexpr size_t WS_RBON = WS_BON;
static_assert((size_t)NCHAIN * NCK * RC * 4 <= (size_t)2 * MLAT * HEADS * 4 + 4096 * 64, "bonus buffer");

struct Params {
    const float *x, *c, *ctx, *c_ctx, *ln_in_g, *ln_in_b, *w_mod, *b_mod, *w_in, *lru_conv_w, *lru_conv_b, *lru_wa, *lru_ba, *lru_wx, *lru_bx, *lru_lam, *lru_norm_g,
        *mu_prev, *mu_next, *w0, *w2, *a0, *a2, *g2, *k_k, *k_a, *r_k, *gn_g, *gn_b, *w_out, *ln1_g, *ln1_b, *w_router, *w_gate, *w_up, *w_down, *ln2_g, *ln2_b;
    float* out;
    unsigned char* ws;
};
#define WSP(T, off) ((T*)(p.ws + (off)))

constexpr int SMEM_BYTES = 76 * 1024;

__device__ void phaseA(const Params& p, int bid, int nblk, char* smem) {
    float* sc = (float*)smem;
    float* red = sc + NMOD * D_MODEL;
    const int tid = threadIdx.x;
    if (bid >= 6 * D_MODEL / 16) return;
    for (int i = tid; i < NMOD * D_MODEL; i += 256) {
        const int r = i / D_MODEL, k = i % D_MODEL;
        const float v = (r < BATCH) ? p.c[r * D_MODEL + k] : p.c_ctx[k];
        sc[i] = siluf_(v);
    }
    __syncthreads();
    float* MOD = WSP(float, WS_MOD);
    const int col = tid & 15, kg = tid >> 4;
    constexpr int KPT = D_MODEL / 16;
    for (int cb = bid; cb < 6 * D_MODEL / 16; cb += nblk) {
        const int n = cb * 16 + col;
        float acc[NMOD];
#pragma unroll
        for (int r = 0; r < NMOD; ++r) acc[r] = 0.f;
        const float* wp = p.w_mod + (size_t)(kg * KPT) * (6 * D_MODEL) + n;
#pragma unroll 16
        for (int kk = 0; kk < KPT; ++kk) {
            const float w = wp[(size_t)kk * (6 * D_MODEL)];
#pragma unroll
            for (int r = 0; r < NMOD; ++r) acc[r] += sc[r * D_MODEL + kg * KPT + kk] * w;
        }
#pragma unroll
        for (int r = 0; r < NMOD; ++r) red[(kg * NMOD + r) * 16 + col] = acc[r];
        __syncthreads();
        if (tid < NMOD * 16) {
            const int r = tid >> 4, c2 = tid & 15;
            float s2 = p.b_mod[cb * 16 + c2];
#pragma unroll
            for (int g = 0; g < 16; ++g) s2 += red[(g * NMOD + r) * 16 + c2];
            MOD[(size_t)r * 6 * D_MODEL + cb * 16 + c2] = s2;
        }
        __syncthreads();
    }
}

constexpr int NV = D_MODEL / 256;
__device__ __forceinline__ f32x4 ld4(const float* p) { return *(const f32x4*)p; }
__device__ __forceinline__ float hsum4(f32x4 v) { return (v[0] + v[1]) + (v[2] + v[3]); }
__device__ __forceinline__ U2 pack4(f32x4 v) { U2 o; o.x = pk2(v[0], v[1]); o.y = pk2(v[2], v[3]); return o; }
__device__ void phaseB(const Params& p, int bid, int nblk, char* smem) {
    const int lane = threadIdx.x & 63, wave = threadIdx.x >> 6;
    const float* MOD = WSP(float, WS_MOD);
    float* STATS = WSP(float, WS_STATS);
    bf16_t* U = WSP(bf16_t, WS_R3);
    for (int row = bid * 4 + wave; row < MTOT; row += nblk * 4) {
        const float* xr = (row < MLAT) ? p.x + (size_t)row * D_MODEL : p.ctx + (size_t)(row - MLAT) * D_MODEL;
        const int mr = (row < MLAT) ? row / SEQ : BATCH;
        const float* md = MOD + (size_t)mr * 6 * D_MODEL;
        f32x4 v0, v1, v2, v3; float s = 0.f;
        v0 = ld4(xr + lane * 4); s += hsum4(v0);
        if (NV > 1) { v1 = ld4(xr + 256 + lane * 4); s += hsum4(v1); } else v1 = f32x4{0.f, 0.f, 0.f, 0.f};
        if (NV > 2) { v2 = ld4(xr + 512 + lane * 4); v3 = ld4(xr + 768 + lane * 4); s += hsum4(v2) + hsum4(v3); } else { v2 = v1; v3 = v1; }
        const float mu = wave_sum(s) * (1.0f / D_MODEL);
        v0 -= mu; float s2 = hsum4(v0 * v0);
        if (NV > 1) { v1 -= mu; s2 += hsum4(v1 * v1); }
        if (NV > 2) { v2 -= mu; v3 -= mu; s2 += hsum4(v2 * v2) + hsum4(v3 * v3); }
        const float rstd = frsq(wave_sum(s2) * (1.0f / D_MODEL) + LN_EPS);
        if (lane == 0) { STATS[row * 2] = mu; STATS[row * 2 + 1] = rstd; }
#pragma unroll
        for (int j = 0; j < NV; ++j) {
            const int k = j * 256 + lane * 4;
            const f32x4 vv = (j == 0) ? v0 : (j == 1) ? v1 : (j == 2) ? v2 : v3;
            const f32x4 h = vv * rstd * ld4(p.ln_in_g + k) + ld4(p.ln_in_b + k);
            *(U2*)(U + (size_t)row * D_MODEL + k) = pack4(h * (1.0f + ld4(md + D_MODEL + k)) + ld4(md + k));
        }
    }
}

constexpr int LDK = 64;
__device__ __forceinline__ int bswz(int n) { return ((n >> 2) ^ n) & 7; }
template <bool DUAL, class Epi>
__device__ __forceinline__ void gemm_tile(char* smem, const bf16_t* A, int lda, const int* rowidx, int m0, const float* B0, const float* B1, int ldb, int n0, int K, Epi epi, const float* rowscale = nullptr, int kscale = 0) {
    bf16_t* As = (bf16_t*)smem;
    bf16_t* Bs = As + 128 * LDK;
    const int tid = threadIdx.x, lane = tid & 63, wave = tid >> 6, wr = wave >> 1, wc = wave & 1, l15 = lane & 15, q = lane >> 4;
    const int ach = tid & 7, ar0 = tid >> 3;
    const bf16_t* aptr[4];
#pragma unroll
    for (int j = 0; j < 4; ++j) { const int r = m0 + ar0 + 32 * j; aptr[j] = A + (rowidx ? (size_t)rowidx[r] : (size_t)r) * lda + ach * 8; }
    const int bn4 = tid & 31, bkg = tid >> 5;
    const float* bptr;
    if (DUAL) { const int ct = bn4 * 4, blk = ct >> 5; bptr = ((blk & 1) ? B1 : B0) + (size_t)(bkg * 8) * ldb + n0 + (blk >> 1) * 32 + (ct & 31); }
    else bptr = B0 + (size_t)(bkg * 8) * ldb + n0 + bn4 * 4;
    bf16_t* awr = As + ar0 * LDK + ((ach ^ (ar0 & 7)) * 8);
    u32x4 ar[4]; f32x4 br[8];
    f32x4 acc[4][4];
#pragma unroll
    for (int i = 0; i < 4; ++i)
#pragma unroll
        for (int j = 0; j < 4; ++j) acc[i][j] = f32x4{0.f, 0.f, 0.f, 0.f};
    const int nk = K / 64;
#pragma unroll
    for (int j = 0; j < 4; ++j) ar[j] = *(const u32x4*)(aptr[j]);
#pragma unroll
    for (int j = 0; j < 8; ++j) br[j] = *(const f32x4*)(bptr + (size_t)j * ldb);
    for (int kt = 0; kt < nk; ++kt) {
        __syncthreads();
#pragma unroll
        for (int j = 0; j < 4; ++j) *(u32x4*)(awr + 32 * j * LDK) = ar[j];
#pragma unroll
        for (int c = 0; c < 4; ++c) {
            u32x4 o;
            o[0] = pk2(br[0][c], br[1][c]); o[1] = pk2(br[2][c], br[3][c]); o[2] = pk2(br[4][c], br[5][c]); o[3] = pk2(br[6][c], br[7][c]);
            const int n = bn4 * 4 + c;
            *(u32x4*)(Bs + n * LDK + ((bkg ^ bswz(n)) * 8)) = o;
        }
        __syncthreads();
        if (kt + 1 < nk) {
            const int ko = (kt + 1) * 64;
#pragma unroll
            for (int j = 0; j < 4; ++j) ar[j] = *(const u32x4*)(aptr[j] + ko);
#pragma unroll
            for (int j = 0; j < 8; ++j) br[j] = *(const f32x4*)(bptr + (size_t)(ko + j) * ldb);
        }
#pragma unroll
        for (int ks = 0; ks < 2; ++ks) {
            bf16x8 af[4];
#pragma unroll
            for (int mi = 0; mi < 4; ++mi) af[mi] = *(const bf16x8*)(As + (wr * 64 + mi * 16 + l15) * LDK + (((ks * 4 + q) ^ (l15 & 7)) * 8));
#pragma unroll
            for (int ni = 0; ni < 4; ++ni) {
                const int n = wc * 64 + ni * 16 + l15;
                const bf16x8 bfr = *(const bf16x8*)(Bs + n * LDK + (((ks * 4 + q) ^ bswz(n)) * 8));
#pragma unroll
                for (int mi = 0; mi < 4; ++mi) acc[mi][ni] = MFMA16(bfr, af[mi], acc[mi][ni]);
            }
        }
        if (rowscale && kt + 1 == kscale) {
#pragma unroll
            for (int mi = 0; mi < 4; ++mi) {
                const float rs = rowscale[m0 + wr * 64 + mi * 16 + l15];
#pragma unroll
                for (int ni = 0; ni < 4; ++ni) acc[mi][ni] *= rs;
            }
        }
    }
#pragma unroll
    for (int mi = 0; mi < 4; ++mi) {
        const int ml = wr * 64 + mi * 16 + l15;
        if (DUAL) {
#pragma unroll
            for (int ni = 0; ni < 2; ++ni) epi(ml, wc * 32 + ni * 16 + q * 4, acc[mi][ni], acc[mi][ni + 2]);
        } else {
#pragma unroll
            for (int ni = 0; ni < 4; ++ni) epi(ml, wc * 64 + ni * 16 + q * 4, acc[mi][ni], acc[mi][ni]);
        }
    }
    __syncthreads();
}

__device__ __forceinline__ int xcd_vbid(int bid, int nblk) { return (nblk % 8 == 0) ? (bid % 8) * (nblk / 8) + bid / 8 : bid; }
__device__ void phaseC(const Params& p, int bid, int nblk, char* smem) {
    const bf16_t* U = WSP(bf16_t, WS_R3);
    bf16_t* P = WSP(bf16_t, WS_R1);
    constexpr int NTN = D_IN / 128, NTM = MTOT / 128;
    constexpr int GM = (NTM % 8 == 0) ? 8 : 1;
    for (int it = xcd_vbid(bid, nblk); it < NTN * NTM; it += nblk) {
        const int mg = it / (GM * NTN), r = it % (GM * NTN), nt = r / GM, mt = mg * GM + (r % GM);
        gemm_tile<false>(smem, U, D_MODEL, nullptr, mt * 128, p.w_in, nullptr, D_IN, nt * 128, D_MODEL, [&](int ml, int nl, f32x4 v, f32x4) {
            U2 o; o.x = pk2(v[0], v[1]); o.y = pk2(v[2], v[3]);
            *(U2*)(P + (size_t)(mt * 128 + ml) * D_IN + nt * 128 + nl) = o;
        });
    }
}

template <int NYT, int KS>
__device__ __forceinline__ void mmT(f32x4* acc, const bf16_t* X, int ldx, int xs, const bf16_t* Y, int ldy, int lane) {
#pragma unroll
    for (int ks = 0; ks < KS; ++ks) {
        const bf16x8 xf = *(const bf16x8*)(X + (xs * 16 + (lane & 15)) * ldx + ks * 32 + 8 * (lane >> 4));
#pragma unroll
        for (int nb = 0; nb < NYT; ++nb) {
            const bf16x8 yf = *(const bf16x8*)(Y + (nb * 16 + (lane & 15)) * ldy + ks * 32 + 8 * (lane >> 4));
            acc[nb] = MFMA16(xf, yf, acc[nb]);
        }
    }
}

struct SeqChunk { int base_row; int t0; int len; };
__device__ __forceinline__ SeqChunk lru_chunk(int cg) {
    SeqChunk s;
    if (cg < NLCH) { const int b = cg / (SEQ / 64), ck = cg % (SEQ / 64); s.base_row = b * SEQ; s.t0 = ck * 64; s.len = SEQ; }
    else { const int c2 = cg - NLCH; const int b = c2 / (CTX_LEN / 64), ck = c2 % (CTX_LEN / 64); s.base_row = MLAT + b * CTX_LEN; s.t0 = ck * 64; s.len = CTX_LEN; }
    return s;
}
constexpr int L_XIN = 0;
constexpr int L_GT = 8704;
constexpr int L_XB = L_GT + 9216;
constexpr int L_WT = L_XB + 9216;
constexpr int L_CP = L_WT + 36864;
constexpr int L_END = L_CP + 4096;
static_assert(L_END <= SMEM_BYTES, "lru lds");
__device__ __forceinline__ void lru_load_w(const Params& p, char* smem, int cb) {
    bf16_t* WT = (bf16_t*)(smem + L_WT);
    const int tid = threadIdx.x;
    for (int idx = tid; idx < 4 * 64 * 16; idx += 256) {
        const int m = idx >> 10, i = (idx >> 4) & 63, j4 = (idx & 15) * 4, d = m >> 1;
        const f32x4 w = ld4(((m & 1) ? p.lru_wx : p.lru_wa) + ((size_t)(d * LRU_BLOCKS + cb) * 64 + i) * 64 + j4);
        bf16_t* dst = WT + (m * 64 + j4) * 72 + i;
        dst[0] = f2bf(w[0]); dst[72] = f2bf(w[1]); dst[144] = f2bf(w[2]); dst[216] = f2bf(w[3]);
    }
}
struct LruOut { float a[2][4][4], b[2][4][4]; };
template <bool FINAL>
__device__ __forceinline__ void lru_item(const Params& p, char* smem, int cg, int cb) {
    const bf16_t* P = WSP(bf16_t, WS_R1);
    bf16_t* XIN = (bf16_t*)(smem + L_XIN); bf16_t* GT = (bf16_t*)(smem + L_GT); bf16_t* XB = (bf16_t*)(smem + L_XB); const bf16_t* WT = (const bf16_t*)(smem + L_WT);
    float* CP = (float*)(smem + L_CP);
    const int tid = threadIdx.x, lane = tid & 63, wave = tid >> 6, q = lane >> 4, l15 = lane & 15;
    const SeqChunk sc = lru_chunk(cg);
    __syncthreads();
    for (int idx = tid; idx < 67 * 8; idx += 256) {
        const int tt = idx >> 3, c8 = (idx & 7) * 8, t = sc.t0 - 1 + tt;
        u32x4 v = u32x4{0u, 0u, 0u, 0u};
        if (t >= 0 && t < sc.len) v = *(const u32x4*)(P + (size_t)(sc.base_row + t) * D_IN + cb * 64 + c8);
        *(u32x4*)(XIN + tt * 64 + c8) = v;
    }
    if (FINAL) {
        for (int idx = tid; idx < 64 * 8; idx += 256) {
            const int tt = idx >> 3, c8 = (idx & 7) * 8;
            *(u32x4*)(GT + tt * 72 + c8) = *(const u32x4*)(P + (size_t)(sc.base_row + sc.t0 + tt) * D_IN + D_LRU + cb * 64 + c8);
        }
    }
    __syncthreads();
    {
        const int c = tid & 63, ch = cb * 64 + c;
        const float w0 = p.lru_conv_w[ch], w1 = p.lru_conv_w[D_LRU + ch], w2 = p.lru_conv_w[2 * D_LRU + ch], w3 = p.lru_conv_w[3 * D_LRU + ch], bc = p.lru_conv_b[ch];
#pragma unroll 4
        for (int tt = tid >> 6; tt < 64; tt += 4)
            XB[tt * 72 + c] = f2bf(bc + bf2f(XIN[tt * 64 + c]) * w0 + bf2f(XIN[(tt + 1) * 64 + c]) * w1 + bf2f(XIN[(tt + 2) * 64 + c]) * w2 + bf2f(XIN[(tt + 3) * 64 + c]) * w3);
    }
    __syncthreads();
    float hs[4][4];
    float av[4][4], bv[4][4];
#pragma unroll
    for (int d = 0; d < 2; ++d) {
        f32x4 ga[4], gx[4];
#pragma unroll
        for (int nb = 0; nb < 4; ++nb) { ga[nb] = f32x4{0.f, 0.f, 0.f, 0.f}; gx[nb] = f32x4{0.f, 0.f, 0.f, 0.f}; }
        mmT<4, 2>(ga, XB, 72, wave, WT + (2 * d) * 64 * 72, 72, lane);
        mmT<4, 2>(gx, XB, 72, wave, WT + (2 * d + 1) * 64 * 72, 72, lane);
        float cA[4], cH[4];
#pragma unroll
        for (int nb = 0; nb < 4; ++nb) {
            const int ch = cb * 64 + nb * 16 + l15;
            const float ba = p.lru_ba[d * D_LRU + ch], bx = p.lru_bx[d * D_LRU + ch];
            const float sp8 = -8.0f * softplusf_(-p.lru_lam[d * D_LRU + ch]);
#pragma unroll
            for (int r = 0; r < 4; ++r) {
                const float rg = fsigm(ga[nb][r] + ba), ig = fsigm(gx[nb][r] + bx);
                const float a = FEXP(sp8 * rg);
                const float xv = bf2f(XB[(wave * 16 + q * 4 + r) * 72 + nb * 16 + l15]);
                av[nb][r] = a; bv[nb][r] = fsqrt(fmaxf(1.0f - a * a, 0.f)) * ig * xv;
            }
            float A, H;
            if (d == 0) { A = av[nb][0]; H = bv[nb][0];
#pragma unroll
                for (int r = 1; r < 4; ++r) { H = H * av[nb][r] + bv[nb][r]; A *= av[nb][r]; } }
            else { A = av[nb][3]; H = bv[nb][3];
#pragma unroll
                for (int r = 2; r >= 0; --r) { H = H * av[nb][r] + bv[nb][r]; A *= av[nb][r]; } }
#pragma unroll
            for (int st = 1; st <= 2; st <<= 1) {
                const float pA = d == 0 ? __shfl_up(A, 16 * st) : __shfl_down(A, 16 * st), pH = d == 0 ? __shfl_up(H, 16 * st) : __shfl_down(H, 16 * st);
                const bool has = d == 0 ? (q >= st) : (q + st <= 3);
                if (has) { H = pH * A + H; A = pA * A; }
            }
            cA[nb] = A; cH[nb] = H;
            const bool last = d == 0 ? (q == 3) : (q == 0);
            if (last) { CP[((d * 4 + wave) * 64 + nb * 16 + l15) * 2] = A; CP[((d * 4 + wave) * 64 + nb * 16 + l15) * 2 + 1] = H; }
        }
        __syncthreads();
        if (!FINAL) {
            if (wave == 0 && q == 0) {
#pragma unroll
                for (int nb = 0; nb < 4; ++nb) {
                    const int c = nb * 16 + l15;
                    float A = 1.f, H = 0.f;
#pragma unroll
                    for (int w = 0; w < 4; ++w) { const int ww = d == 0 ? w : 3 - w; const float wa = CP[((d * 4 + ww) * 64 + c) * 2], wh = CP[((d * 4 + ww) * 64 + c) * 2 + 1]; H = H * wa + wh; A *= wa; }
                    WSP(float, WS_SUMA)[((size_t)d * NCH + cg) * D_LRU + cb * 64 + c] = A;
                    WSP(float, WS_SUMH)[((size_t)d * NCH + cg) * D_LRU + cb * 64 + c] = H;
                }
            }
        } else {
#pragma unroll
            for (int nb = 0; nb < 4; ++nb) {
                const int c = nb * 16 + l15;
                float h = WSP(float, WS_CARRY)[((size_t)d * NLCH + cg) * D_LRU + cb * 64 + c];
#pragma unroll
                for (int w = 0; w < 3; ++w) { const int ww = d == 0 ? w : 3 - w; const bool use = d == 0 ? (ww < wave) : (ww > wave);
                    if (use) h = h * CP[((d * 4 + ww) * 64 + c) * 2] + CP[((d * 4 + ww) * 64 + c) * 2 + 1]; }
                const float eA = d == 0 ? __shfl_up(cA[nb], 16) : __shfl_down(cA[nb], 16), eH = d == 0 ? __shfl_up(cH[nb], 16) : __shfl_down(cH[nb], 16);
                const bool first = d == 0 ? (q == 0) : (q == 3);
                if (!first) h = h * eA + eH;
                if (d == 0) {
#pragma unroll
                    for (int r = 0; r < 4; ++r) { h = h * av[nb][r] + bv[nb][r]; hs[nb][r] = h; }
                } else {
#pragma unroll
                    for (int r = 3; r >= 0; --r) { h = h * av[nb][r] + bv[nb][r]; hs[nb][r] += h; }
                }
            }
        }
        __syncthreads();
    }
    if (FINAL) {
        float ss[4] = {0.f, 0.f, 0.f, 0.f};
#pragma unroll
        for (int nb = 0; nb < 4; ++nb) {
            const float gn = p.lru_norm_g[cb * 64 + nb * 16 + l15];
#pragma unroll
            for (int r = 0; r < 4; ++r) {
                const int tt = wave * 16 + q * 4 + r;
                const float v = hs[nb][r] * geluf_(bf2f(GT[tt * 72 + nb * 16 + l15]));
                ss[r] += v * v;
                XB[tt * 72 + nb * 16 + l15] = f2bf(v * gn);
            }
        }
#pragma unroll
        for (int r = 0; r < 4; ++r) {
#pragma unroll
            for (int o = 1; o < 16; o <<= 1) ss[r] += __shfl_xor(ss[r], o);
            if (l15 == 0) WSP(float, WS_SSQP)[(size_t)(sc.base_row + sc.t0 + wave * 16 + q * 4 + r) * LRU_BLOCKS + cb] = ss[r];
        }
        __syncthreads();
        bf16_t* MIX = WSP(bf16_t, WS_R3);
        for (int idx = tid; idx < 64 * 8; idx += 256) {
            const int tt = idx >> 3, c8 = (idx & 7) * 8;
            *(u32x4*)(MIX + (size_t)(sc.base_row + sc.t0 + tt) * D_MIX + cb * 64 + c8) = *(const u32x4*)(XB + tt * 72 + c8);
        }
    }
}
__device__ void phaseD(const Params& p, int bid, int nblk, char* smem) {
    int cur = -1;
    for (int it = bid; it < NCH * LRU_BLOCKS; it += nblk) {
        const int cb = it % LRU_BLOCKS, cg = it / LRU_BLOCKS;
        if (cb != cur) { __syncthreads(); lru_load_w(p, smem, cb); cur = cb; }
        lru_item<false>(p, smem, cg, cb);
    }
}
__device__ void phaseE(const Params& p, int bid, int nblk, char* smem) {
    const float* SUMA = WSP(float, WS_SUMA); const float* SUMH = WSP(float, WS_SUMH); float* CARRY = WSP(float, WS_CARRY);
    constexpr int NLB = SEQ / 64, NCB = CTX_LEN / 64;
    for (int g = bid * 256 + threadIdx.x; g < BATCH * 2 * D_LRU; g += nblk * 256) {
        const int c = g % D_LRU, d = (g / D_LRU) & 1, b = g / (2 * D_LRU);
        const float* sa = SUMA + (size_t)d * NCH * D_LRU + c; const float* sh = SUMH + (size_t)d * NCH * D_LRU + c;
        float* cr = CARRY + (size_t)d * NLCH * D_LRU + c;
        float h = 0.f;
        if (d == 0) {
            for (int q2 = 0; q2 < NCB; ++q2) { const int gi = NLCH + b * NCB + q2; h = sa[(size_t)gi * D_LRU] * h + sh[(size_t)gi * D_LRU]; }
            for (int q2 = 0; q2 < NLB; ++q2) { const int gi = b * NLB + q2; cr[(size_t)gi * D_LRU] = h; h = sa[(size_t)gi * D_LRU] * h + sh[(size_t)gi * D_LRU]; }
        } else {
            for (int q2 = NCB - 1; q2 >= 0; --q2) { const int gi = NLCH + b * NCB + q2; h = sa[(size_t)gi * D_LRU] * h + sh[(size_t)gi * D_LRU]; }
            for (int q2 = NLB - 1; q2 >= 0; --q2) { const int gi = b * NLB + q2; cr[(size_t)gi * D_LRU] = h; h = sa[(size_t)gi * D_LRU] * h + sh[(size_t)gi * D_LRU]; }
        }
    }
}
__device__ void phaseF(const Params& p, int bid, int nblk, char* smem) {
    int cur = -1;
    for (int it = bid; it < NLCH * LRU_BLOCKS; it += nblk) {
        const int cb = it % LRU_BLOCKS, cg = it / LRU_BLOCKS;
        if (cb != cur) { __syncthreads(); lru_load_w(p, smem, cb); cur = cb; }
        lru_item<true>(p, smem, cg, cb);
    }
}

__device__ __forceinline__ size_t rwkv_row(int seg, int b, int s) {
    if (seg == 0) return (size_t)(MLAT + b * CTX_LEN + s);
    const int r = s % ROWS, c = s / ROWS;
    return (size_t)(b * SEQ + r * GRID_W + c);
}
__device__ __forceinline__ void chunk_info(int d, int c, int& seg, int& p0, int& len) {
    if (c < NCC) { seg = 0; len = CTX_LEN; p0 = (d == 0 ? c : NCC - 1 - c) * RC; }
    else { const int cc = c - NCC; seg = 1; len = SEQ; p0 = (d == 0 ? cc : NLC - 1 - cc) * RC; }
}
__device__ __forceinline__ void unpack8(const u32x4 v, float* o) {
    o[0] = bitsf(v[0] << 16); o[1] = bitsf(v[0] & 0xFFFF0000u); o[2] = bitsf(v[1] << 16); o[3] = bitsf(v[1] & 0xFFFF0000u);
    o[4] = bitsf(v[2] << 16); o[5] = bitsf(v[2] & 0xFFFF0000u); o[6] = bitsf(v[3] << 16); o[7] = bitsf(v[3] & 0xFFFF0000u);
}
__device__ __forceinline__ void shifted8(const Params& p, const bf16_t* P, int seg, int b, int pos, int len, int ch0, float* o) {
    float z[8], zp[8], zn[8];
    unpack8(*(const u32x4*)(P + rwkv_row(seg, b, pos) * D_IN + RW0 + ch0), z);
    if (pos > 0) unpack8(*(const u32x4*)(P + rwkv_row(seg, b, pos - 1) * D_IN + RW0 + ch0), zp); else { for (int i = 0; i < 8; ++i) zp[i] = 0.f; }
    if (pos < len - 1) unpack8(*(const u32x4*)(P + rwkv_row(seg, b, pos + 1) * D_IN + RW0 + ch0), zn); else { for (int i = 0; i < 8; ++i) zn[i] = 0.f; }
    const f32x4 mp0 = ld4(p.mu_prev + ch0), mp1 = ld4(p.mu_prev + ch0 + 4), mn0 = ld4(p.mu_next + ch0), mn1 = ld4(p.mu_next + ch0 + 4);
#pragma unroll
    for (int i = 0; i < 4; ++i) { o[i] = z[i] + mp0[i] * (zp[i] - z[i]) + mn0[i] * (zn[i] - z[i]); o[4 + i] = z[4 + i] + mp1[i] * (zp[4 + i] - z[4 + i]) + mn1[i] * (zn[4 + i] - z[4 + i]); }
}
constexpr int LT = 72, LJ = 40;
constexpr int R_RF = 0, R_KF = 8192, R_VF = 16384, R_LW = 24576, R_IC = 32768;
constexpr int R_NKA = 0, R_MBR = 2560, R_MKR = 5120;
constexpr int R_XU = 7680;
constexpr int R_IA = R_XU + 8448, R_IB = R_IA + 4608, R_PA = R_IB + 4608, R_PB = R_PA + 4608;
constexpr int R_WA = R_IB, R_U0 = R_WA + 5120;
static_assert(R_U0 + 5120 <= R_PB + 4608 && R_PB + 4608 <= 40960, "rwkv scratch");
constexpr int R_O = 40960;
constexpr int R_AH = R_O, R_BH = R_AH + 4608, R_KH = R_BH + 4608, R_RH = R_KH + 4608;
constexpr int R_VT = R_RH + 4608, R_BHT = R_VT + 5120, R_KHT = R_BHT + 5120;
constexpr int R_GC = R_KHT + 5120, R_TOT = R_GC + 256, R_END = R_TOT + 1024;
constexpr int R_TW = R_O, R_TA = R_TW + 4608, R_W2T = R_TA + 4608, R_A2T = R_W2T + 9216;
static_assert(R_A2T + 9216 <= R_END && R_END <= SMEM_BYTES, "rwkv lds");

__device__ void phaseR1(const Params& p, int bid, int nblk, char* smem) {
    const bf16_t* P = WSP(bf16_t, WS_R1);
    unsigned char* CH = p.ws + WS_CH;
    float* RBON = WSP(float, WS_RBON);
    float* Rf = (float*)(smem + R_RF); float* Kf = (float*)(smem + R_KF); float* Vf = (float*)(smem + R_VF); float* LW = (float*)(smem + R_LW); float* IC = (float*)(smem + R_IC);
    float* IA = (float*)(smem + R_IA); float* IB = (float*)(smem + R_IB); float* PA = (float*)(smem + R_PA); float* PB = (float*)(smem + R_PB); bf16_t* NkaT = (bf16_t*)(smem + R_NKA); bf16_t* MbrT = (bf16_t*)(smem + R_MBR); bf16_t* MkrT = (bf16_t*)(smem + R_MKR);
    float* Xu = (float*)(smem + R_XU); bf16_t* Wa = (bf16_t*)(smem + R_WA); bf16_t* U0 = (bf16_t*)(smem + R_U0);
    bf16_t* Ah = (bf16_t*)(smem + R_AH); bf16_t* Bh = (bf16_t*)(smem + R_BH); bf16_t* Kh = (bf16_t*)(smem + R_KH); bf16_t* Rh = (bf16_t*)(smem + R_RH);
    bf16_t* VT = (bf16_t*)(smem + R_VT); bf16_t* BhT = (bf16_t*)(smem + R_BHT); bf16_t* KhT = (bf16_t*)(smem + R_KHT);
    float* GC = (float*)(smem + R_GC); float* TOT = (float*)(smem + R_TOT);
    bf16_t* TW = (bf16_t*)(smem + R_TW); bf16_t* TA = (bf16_t*)(smem + R_TA); bf16_t* W2T = (bf16_t*)(smem + R_W2T); bf16_t* A2T = (bf16_t*)(smem + R_A2T);
    const int tid = threadIdx.x, lane = tid & 63, wave = tid >> 6, q = lane >> 4, l15 = lane & 15;
    constexpr int NITEM = NCHAIN * NCK;
    const int per = (NITEM + nblk - 1) / nblk;
    const int it0 = bid * per, it1 = (it0 + per < NITEM) ? it0 + per : NITEM;
    for (int it = it0; it < it1; ++it) {
        const int chain = it / NCK, c = it % NCK;
        const int d = chain & 1, h = (chain >> 1) % HEADS, b = chain / (2 * HEADS);
        int seg, p0, len; chunk_info(d, c, seg, p0, len);
        unsigned char* chp = CH + (size_t)it * CH_BYTES;
        __syncthreads();
        {
            f32x4 wv[8];
#pragma unroll
            for (int k = 0; k < 8; ++k) {
                const int idx = tid + 256 * k, which = idx >> 10, i = (idx >> 4) & 63, j4 = (idx & 15) * 4;
                wv[k] = ld4((which ? p.a2 : p.w2) + ((size_t)d * 64 + i) * D_RWKV + h * 64 + j4);
            }
#pragma unroll
            for (int kb = 0; kb < 5; kb += 3) {
            u32x4 zc[3], zp[3], zn[3];
#pragma unroll
            for (int k = 0; k < 3; ++k) if (kb + k < 5) {
                const int idx = tid + 256 * (kb + k), tau = idx / 40, g = idx % 40, grp = g >> 3, j0 = (g & 7) * 8;
                const int pos = p0 + (d ? RC - 1 - tau : tau);
                const int ch0 = (grp < 3) ? grp * D_RWKV + h * 64 + j0 : (grp == 3 ? 3 * D_RWKV + d * 64 + j0 : 3 * D_RWKV + 128 + d * 64 + j0);
                const u32x4 zero = u32x4{0u, 0u, 0u, 0u};
                zc[k] = *(const u32x4*)(P + rwkv_row(seg, b, pos) * D_IN + RW0 + ch0);
                zp[k] = (pos > 0) ? *(const u32x4*)(P + rwkv_row(seg, b, pos - 1) * D_IN + RW0 + ch0) : zero;
                zn[k] = (pos < len - 1) ? *(const u32x4*)(P + rwkv_row(seg, b, pos + 1) * D_IN + RW0 + ch0) : zero;
            }
#pragma unroll
            for (int k = 0; k < 3; ++k) if (kb + k < 5) {
                const int idx = tid + 256 * (kb + k), tau = idx / 40, g = idx % 40, grp = g >> 3, j0 = (g & 7) * 8;
                const int ch0 = (grp < 3) ? grp * D_RWKV + h * 64 + j0 : (grp == 3 ? 3 * D_RWKV + d * 64 + j0 : 3 * D_RWKV + 128 + d * 64 + j0);
                float z[8], zpv[8], znv[8], o[8];
                unpack8(zc[k], z); unpack8(zp[k], zpv); unpack8(zn[k], znv);
                const f32x4 mp0 = ld4(p.mu_prev + ch0), mp1 = ld4(p.mu_prev + ch0 + 4), mn0 = ld4(p.mu_next + ch0), mn1 = ld4(p.mu_next + ch0 + 4);
#pragma unroll
                for (int e = 0; e < 4; ++e) { o[e] = z[e] + mp0[e] * (zpv[e] - z[e]) + mn0[e] * (znv[e] - z[e]); o[4 + e] = z[4 + e] + mp1[e] * (zpv[4 + e] - z[4 + e]) + mn1[e] * (znv[4 + e] - z[4 + e]); }
                if (grp < 3) {
                    float* dst = (grp == 0 ? Rf : grp == 1 ? Kf : Vf) + tau * 64 + j0;
                    *(f32x4*)dst = f32x4{o[0], o[1], o[2], o[3]}; *(f32x4*)(dst + 4) = f32x4{o[4], o[5], o[6], o[7]};
                } else if (grp == 3) {
                    u32x4 w;
#pragma unroll
                    for (int e = 0; e < 4; ++e) { const float t0 = 2.0f * frcp(1.0f + FEXP(-2.0f * o[2 * e])) - 1.0f, t1 = 2.0f * frcp(1.0f + FEXP(-2.0f * o[2 * e + 1])) - 1.0f; w[e] = pk2(t0, t1); }
                    *(u32x4*)(TW + tau * LT + j0) = w;
                } else {
                    u32x4 w; w[0] = pk2(o[0], o[1]); w[1] = pk2(o[2], o[3]); w[2] = pk2(o[4], o[5]); w[3] = pk2(o[6], o[7]);
                    *(u32x4*)(TA + tau * LT + j0) = w;
                }
            }
            }
#pragma unroll
            for (int k = 0; k < 8; ++k) {
                const int idx = tid + 256 * k, which = idx >> 10, i = (idx >> 4) & 63, j4 = (idx & 15) * 4;
                bf16_t* dst = (which ? A2T : W2T) + j4 * LT + i;
                dst[0] = f2bf(wv[k][0]); dst[LT] = f2bf(wv[k][1]); dst[2 * LT] = f2bf(wv[k][2]); dst[3 * LT] = f2bf(wv[k][3]);
            }
        }
        __syncthreads();
        {
            f32x4 aw[2] = {f32x4{0.f, 0.f, 0.f, 0.f}, f32x4{0.f, 0.f, 0.f, 0.f}}, ai[2] = {f32x4{0.f, 0.f, 0.f, 0.f}, f32x4{0.f, 0.f, 0.f, 0.f}};
            mmT<2, 2>(aw, W2T, LT, wave, TW, LT, lane);
            mmT<2, 2>(ai, A2T, LT, wave, TA, LT, lane);
            const int j = wave * 16 + q * 4;
            const f32x4 w0v = ld4(p.w0 + d * D_RWKV + h * 64 + j), a0v = ld4(p.a0 + d * D_RWKV + h * 64 + j);
#pragma unroll
            for (int nb = 0; nb < 2; ++nb) {
                const int tau = nb * 16 + l15;
                f32x4 lw, ic;
#pragma unroll
                for (int r = 0; r < 4; ++r) { lw[r] = -0.6065306597126334f * fsigm(w0v[r] + aw[nb][r]); ic[r] = fsigm(a0v[r] + ai[nb][r]); }
                *(f32x4*)(LW + tau * 64 + j) = lw; *(f32x4*)(IC + tau * 64 + j) = ic;
            }
        }
        __syncthreads();
        {
            const int j = lane, t0 = wave * 8, chj = h * 64 + j;
            const float kkc = p.k_k[chj], kac = p.k_a[chj], rkc = p.r_k[chj];
            float cum[8], kd[8], kkn[8], icv[8], rr[8], vv[8], run = 0.f;
#pragma unroll
            for (int i = 0; i < 8; ++i) {
                const int t = t0 + i;
                run += LW[t * 64 + j]; cum[i] = run;
                const float kr = Kf[t * 64 + j]; icv[i] = IC[t * 64 + j]; rr[i] = Rf[t * 64 + j]; vv[i] = Vf[t * 64 + j];
                kd[i] = kr * (1.0f + (icv[i] - 1.0f) * kac);
                const float kk = kr * kkc;
                const float n2 = wave_sum(kk * kk);
                kkn[i] = kk * frsq(fmaxf(n2, 1e-24f));
                const float bon = wave_sum(rr[i] * kd[i] * rkc);
                if (lane == 0) RBON[(size_t)it * RC + t] = bon;
            }
            TOT[wave * 64 + j] = run;
            __syncthreads();
            float off = 0.f;
            for (int w = 0; w < wave; ++w) off += TOT[w * 64 + j];
            u32x4 vt, bt, kt;
            float e_prev = 0.f;
#pragma unroll
            for (int i = 0; i < 8; ++i) {
                const int t = t0 + i;
                const float cu = off + cum[i], cprev = (i == 0) ? off : off + cum[i - 1];
                const float g = FEXP(cu), gi = FEXP(-cu), gm = FEXP(cprev);
                const float ah = -kkn[i] * gm, bh = kkn[i] * icv[i] * gi, kh = kd[i] * gi, rh = rr[i] * g;
                Ah[t * LT + j] = f2bf(ah); Bh[t * LT + j] = f2bf(bh); Kh[t * LT + j] = f2bf(kh); Rh[t * LT + j] = f2bf(rh);
                if (i & 1) { vt[i >> 1] = pk2(e_prev, vv[i]); bt[i >> 1] = (bt[i >> 1] & 0xFFFFu) | ((unsigned)f2bf(bh) << 16); kt[i >> 1] = (kt[i >> 1] & 0xFFFFu) | ((unsigned)f2bf(kh) << 16); }
                else { e_prev = vv[i]; bt[i >> 1] = f2bf(bh); kt[i >> 1] = f2bf(kh); }
                if (t == RC - 1) GC[j] = g;
            }
            *(u32x4*)(VT + j * LJ + t0) = vt; *(u32x4*)(BhT + j * LJ + t0) = bt; *(u32x4*)(KhT + j * LJ + t0) = kt;
        }
        __syncthreads();
        {
            const bf16_t* X = (wave == 0) ? Ah : (wave & 1) ? Kh : Bh;
            const bf16_t* Y = (wave == 0) ? Bh : (wave == 1) ? Ah : Rh;
#pragma unroll
            for (int xs = 0; xs < 2; ++xs) {
                f32x4 acc[2] = {f32x4{0.f, 0.f, 0.f, 0.f}, f32x4{0.f, 0.f, 0.f, 0.f}};
                mmT<2, 2>(acc, X, LT, xs, Y, LT, lane);
#pragma unroll
                for (int nb = 0; nb < 2; ++nb) {
                    const int yy = nb * 16 + l15, x0 = xs * 16 + q * 4;
                    f32x4 v = acc[nb];
#pragma unroll
                    for (int r = 0; r < 4; ++r) { const int xx = x0 + r; const bool keep = (wave == 0) ? (yy < xx) : (wave == 1) ? (xx < yy) : (xx <= yy); v[r] = keep ? v[r] : 0.f; }
                    if (wave == 0) { *(f32x4*)(PA + yy * 36 + x0) = v; f32x4 t0 = v; for (int r = 0; r < 4; ++r) t0[r] += (x0 + r == yy) ? 1.0f : 0.0f; *(f32x4*)(IA + yy * 36 + x0) = t0; }
                    else { bf16_t* dst = (wave == 1 ? NkaT : wave == 2 ? MbrT : MkrT) + yy * LJ + x0; *(U2*)dst = pack4(v); }
                }
            }
        }
        __syncthreads();
        {
#pragma unroll
            for (int xs = 0; xs < 2; ++xs) {
                f32x4 acc[1] = {f32x4{0.f, 0.f, 0.f, 0.f}};
                mmT<1, 1>(acc, NkaT, LJ, xs, VT + wave * 16 * LJ, LJ, lane);
                const int i = wave * 16 + l15, tb = xs * 16 + q * 4;
                Xu[i * 33 + tb] = acc[0][0]; Xu[i * 33 + tb + 1] = acc[0][1]; Xu[i * 33 + tb + 2] = acc[0][2]; Xu[i * 33 + tb + 3] = acc[0][3];
            }
        }
        __syncthreads();
        {
            auto mm32 = [&](float* Z, const float* init, const float* L, const float* R, int ti, int tj) {
                f32x4 acc = f32x4{0.f, 0.f, 0.f, 0.f};
                if (init) { for (int r = 0; r < 4; ++r) acc[r] = init[(ti * 16 + q * 4 + r) * 36 + tj * 16 + l15]; }
#pragma unroll
                for (int k0 = 0; k0 < 32; k0 += 4) acc = MFMAF32(L[(ti * 16 + l15) * 36 + k0 + q], R[(k0 + q) * 36 + tj * 16 + l15], acc);
#pragma unroll
                for (int r = 0; r < 4; ++r) Z[(ti * 16 + q * 4 + r) * 36 + tj * 16 + l15] = acc[r];
            };
            const int ti = wave >> 1, tj = wave & 1;
            mm32(PB, nullptr, PA, PA, ti, tj);
            __syncthreads();
            mm32(IB, IA, IA, PB, ti, tj); mm32(PA, nullptr, PB, PB, ti, tj);
            __syncthreads();
            mm32(IA, IB, IB, PA, ti, tj); mm32(PB, nullptr, PA, PA, ti, tj);
            __syncthreads();
            mm32(IB, IA, IA, PB, ti, tj); mm32(PA, nullptr, PB, PB, ti, tj);
            __syncthreads();
            f32x4 accw[2], accu[2];
            mm32(IA, IB, IB, PA, ti, tj);
            __syncthreads();
#pragma unroll
            for (int tc = 0; tc < 2; ++tc) { accw[tc] = f32x4{0.f, 0.f, 0.f, 0.f}; accu[tc] = f32x4{0.f, 0.f, 0.f, 0.f}; }
#pragma unroll
            for (int k0 = 0; k0 < 32; k0 += 4) {
                const float la = bf2f(Ah[(k0 + q) * LT + wave * 16 + l15]), lu = Xu[(wave * 16 + l15) * 33 + k0 + q];
#pragma unroll
                for (int tc = 0; tc < 2; ++tc) { const float rv = IA[(k0 + q) * 36 + tc * 16 + l15]; accw[tc] = MFMAF32(la, rv, accw[tc]); accu[tc] = MFMAF32(lu, rv, accu[tc]); }
            }
            __syncthreads();
#pragma unroll
            for (int tc = 0; tc < 2; ++tc)
#pragma unroll
                for (int r = 0; r < 4; ++r) { const int row = wave * 16 + q * 4 + r, col = tc * 16 + l15; Wa[row * LJ + col] = f2bf(accw[tc][r]); U0[row * LJ + col] = f2bf(accu[tc][r]); }
        }
        __syncthreads();
        {
            bf16_t* gPm = (bf16_t*)(chp + CH_PM); bf16_t* gSA = (bf16_t*)(chp + CH_SA); bf16_t* gQT = (bf16_t*)(chp + CH_QT); bf16_t* gY0 = (bf16_t*)(chp + CH_Y0);
            const int x0 = wave * 16 + q * 4;
            {
                f32x4 acc[4] = {f32x4{0.f, 0.f, 0.f, 0.f}, f32x4{0.f, 0.f, 0.f, 0.f}, f32x4{0.f, 0.f, 0.f, 0.f}, f32x4{0.f, 0.f, 0.f, 0.f}};
                mmT<4, 1>(acc, Wa, LJ, wave, BhT, LJ, lane);
#pragma unroll
                for (int nb = 0; nb < 4; ++nb) {
                    const int jp = nb * 16 + l15; const float g = GC[jp];
                    f32x4 v = acc[nb];
#pragma unroll
                    for (int r = 0; r < 4; ++r) v[r] = (v[r] + ((x0 + r == jp) ? 1.0f : 0.0f)) * g;
                    *(U2*)(gPm + jp * 64 + x0) = pack4(v);
                }
            }
            {
                f32x4 acc[4] = {f32x4{0.f, 0.f, 0.f, 0.f}, f32x4{0.f, 0.f, 0.f, 0.f}, f32x4{0.f, 0.f, 0.f, 0.f}, f32x4{0.f, 0.f, 0.f, 0.f}};
                mmT<4, 1>(acc, BhT, LJ, wave, U0, LJ, lane);
                mmT<4, 1>(acc, KhT, LJ, wave, VT, LJ, lane);
                const f32x4 g = *(const f32x4*)(GC + x0);
#pragma unroll
                for (int nb = 0; nb < 4; ++nb) *(U2*)(gSA + (nb * 16 + l15) * 64 + x0) = pack4(acc[nb] * g);
            }
            if (seg == 1) {
                {
                    f32x4 acc[2] = {f32x4{0.f, 0.f, 0.f, 0.f}, f32x4{0.f, 0.f, 0.f, 0.f}};
                    mmT<2, 1>(acc, Wa, LJ, wave, MbrT, LJ, lane);
#pragma unroll
                    for (int nb = 0; nb < 2; ++nb) {
                        const int t = nb * 16 + l15;
                        f32x4 v = acc[nb];
#pragma unroll
                        for (int r = 0; r < 4; ++r) v[r] += bf2f(Rh[t * LT + x0 + r]);
                        *(U2*)(gQT + t * 64 + x0) = pack4(v);
                    }
                }
                {
                    f32x4 acc[2] = {f32x4{0.f, 0.f, 0.f, 0.f}, f32x4{0.f, 0.f, 0.f, 0.f}};
                    mmT<2, 1>(acc, U0, LJ, wave, MbrT, LJ, lane);
                    mmT<2, 1>(acc, VT, LJ, wave, MkrT, LJ, lane);
#pragma unroll
                    for (int nb = 0; nb < 2; ++nb) *(U2*)(gY0 + (nb * 16 + l15) * 64 + x0) = pack4(acc[nb]);
                }
            }
        }
    }
}

__device__ __forceinline__ U2 ldu2(const bf16_t* p) { return *(const U2*)p; }
constexpr int R2D = 6, R2LD = 72;
__device__ void phaseR2(const Params& p, int bid, int nblk, char* smem) {
    unsigned char* CH = p.ws + WS_CH;
    bf16_t* PL = (bf16_t*)smem;
    const int tid = threadIdx.x, lane = tid & 63, wave = tid >> 6, q = lane >> 4, l15 = lane & 15;
    const int lrow = wave * 16 + (lane >> 2), lcol = (lane & 3) * 16;
    for (int chain = bid; chain < NCHAIN; chain += nblk) {
        const int i = wave * 16 + l15;
        unsigned char* chbase = CH + (size_t)chain * NCK * CH_BYTES;
        f32x4 st[4];
#pragma unroll
        for (int nt = 0; nt < 4; ++nt) st[nt] = f32x4{0.f, 0.f, 0.f, 0.f};
        u32x4 pq[R2D][2]; U2 sa[R2D][4];
#pragma unroll
        for (int k = 0; k < R2D; ++k) {
            const unsigned char* chp = chbase + (size_t)(k < NCK ? k : NCK - 1) * CH_BYTES;
            const bf16_t* gp = (const bf16_t*)(chp + CH_PM) + lrow * 64 + lcol;
            pq[k][0] = *(const u32x4*)gp; pq[k][1] = *(const u32x4*)(gp + 8);
#pragma unroll
            for (int nt = 0; nt < 4; ++nt) sa[k][nt] = ldu2((const bf16_t*)(chp + CH_SA) + i * 64 + nt * 16 + 4 * q);
        }
#pragma unroll 1
        for (int c0 = 0; c0 < NCK; c0 += R2D) {
#pragma unroll
            for (int k = 0; k < R2D; ++k) {
                const int c = c0 + k;
                if (c < NCK) {
                bf16_t* pl = PL + (k & 1) * 64 * R2LD;
                *(u32x4*)(pl + lrow * R2LD + lcol) = pq[k][0]; *(u32x4*)(pl + lrow * R2LD + lcol + 8) = pq[k][1];
                const U2 s0 = sa[k][0], s1 = sa[k][1], s2 = sa[k][2], s3 = sa[k][3];
                {
                    const int cn = (c + R2D < NCK) ? c + R2D : NCK - 1;
                    const unsigned char* chp = chbase + (size_t)cn * CH_BYTES;
                    const bf16_t* gp = (const bf16_t*)(chp + CH_PM) + lrow * 64 + lcol;
                    pq[k][0] = *(const u32x4*)gp; pq[k][1] = *(const u32x4*)(gp + 8);
#pragma unroll
                    for (int nt = 0; nt < 4; ++nt) sa[k][nt] = ldu2((const bf16_t*)(chp + CH_SA) + i * 64 + nt * 16 + 4 * q);
                }
                __syncthreads();
                bf16_t* gSA = (bf16_t*)(chbase + (size_t)c * CH_BYTES + CH_SA) + i * 64 + 4 * q;
                bf16x8 bfr[2];
#pragma unroll
                for (int ks = 0; ks < 2; ++ks) {
                    const U2 lo = pack4(st[2 * ks]), hi = pack4(st[2 * ks + 1]);
                    bfr[ks] = __builtin_bit_cast(bf16x8, u32x4{lo.x, lo.y, hi.x, hi.y});
                    *(U2*)(gSA + (2 * ks) * 16) = lo; *(U2*)(gSA + (2 * ks + 1) * 16) = hi;
                }
#pragma unroll
                for (int nt = 0; nt < 4; ++nt) {
                    const U2 sv = nt == 0 ? s0 : nt == 1 ? s1 : nt == 2 ? s2 : s3;
                    f32x4 acc = f32x4{bitsf(sv.x << 16), bitsf(sv.x & 0xFFFF0000u), bitsf(sv.y << 16), bitsf(sv.y & 0xFFFF0000u)};
#pragma unroll
                    for (int ks = 0; ks < 2; ++ks) {
                        const U2 lo = *(const U2*)(pl + (nt * 16 + l15) * R2LD + 32 * ks + 4 * q), hi = *(const U2*)(pl + (nt * 16 + l15) * R2LD + 32 * ks + 16 + 4 * q);
                        acc = MFMA16(__builtin_bit_cast(bf16x8, u32x4{lo.x, lo.y, hi.x, hi.y}), bfr[ks], acc);
                    }
                    st[nt] = acc;
                }
                }
            }
        }
        __syncthreads();
    }
}

__device__ void phaseR3(const Params& p, int bid, int nblk, char* smem) {
    const bf16_t* P = WSP(bf16_t, WS_R1);
    const unsigned char* CH = p.ws + WS_CH;
    const float* RBON = WSP(float, WS_RBON);
    bf16_t* MIX = WSP(bf16_t, WS_R3);
    float* red = (float*)smem;
    const int tid = threadIdx.x, lane = tid & 63, wave = tid >> 6, q = lane >> 4, l15 = lane & 15;
    for (int m = bid * 256 + tid; m < MLAT; m += nblk * 256) {
        const float* sp = WSP(float, WS_SSQP) + (size_t)m * LRU_BLOCKS;
        float sq = 0.f;
#pragma unroll
        for (int c = 0; c < LRU_BLOCKS; ++c) sq += sp[c];
        WSP(float, WS_RINV)[m] = frsq(sq * (1.0f / D_LRU) + RMS_EPS);
    }
    bf16_t* G2T = (bf16_t*)(smem + 1024);
    const int nbh = nblk / HEADS;
    int hcur = -1;
    const bool uniform = (nbh > 0) && (nblk % HEADS == 0);
    const int nrest = BATCH * NLC;
    for (int itx = uniform ? (bid % nbh) : bid; itx < (uniform ? nrest : nrest * HEADS); itx += uniform ? nbh : nblk) {
        int h, rest;
        if (uniform) { h = bid / nbh; rest = itx; } else { h = itx % HEADS; rest = itx / HEADS; }
        const int pc = rest % NLC, b = rest / NLC;
        if (h != hcur) {
            __syncthreads();
            for (int idx = tid; idx < 128 * 16; idx += 256) {
                const int c = idx >> 4, i4 = (idx & 15) * 4;
                const f32x4 w = ld4(p.g2 + (size_t)c * D_RWKV + h * 64 + i4);
                bf16_t* dst = G2T + i4 * 136 + c;
                dst[0] = f2bf(w[0]); dst[136] = f2bf(w[1]); dst[272] = f2bf(w[2]); dst[408] = f2bf(w[3]);
            }
            hcur = h;
            __syncthreads();
        }
        const int i0 = wave * 16 + q * 4;
        f32x4 y[2] = {f32x4{0.f, 0.f, 0.f, 0.f}, f32x4{0.f, 0.f, 0.f, 0.f}};
        float bon[2] = {0.f, 0.f};
#pragma unroll
        for (int d = 0; d < 2; ++d) {
            const int chain = (b * HEADS + h) * 2 + d, c = NCC + (d ? NLC - 1 - pc : pc);
            const size_t item = (size_t)chain * NCK + c;
            const unsigned char* chp = CH + item * CH_BYTES;
            const bf16_t* gS = (const bf16_t*)(chp + CH_SA); const bf16_t* gQT = (const bf16_t*)(chp + CH_QT); const bf16_t* gY0 = (const bf16_t*)(chp + CH_Y0);
#pragma unroll
            for (int nb = 0; nb < 2; ++nb) {
                const int pl = nb * 16 + l15, tau = d ? RC - 1 - pl : pl;
                const U2 y0 = ldu2(gY0 + tau * 64 + i0);
                f32x4 acc = f32x4{bitsf(y0.x << 16), bitsf(y0.x & 0xFFFF0000u), bitsf(y0.y << 16), bitsf(y0.y & 0xFFFF0000u)};
#pragma unroll
                for (int ks = 0; ks < 2; ++ks) {
                    const bf16x8 xf = *(const bf16x8*)(gS + (wave * 16 + l15) * 64 + ks * 32 + 8 * q);
                    const bf16x8 yf = *(const bf16x8*)(gQT + tau * 64 + ks * 32 + 8 * q);
                    acc = MFMA16(xf, yf, acc);
                }
                y[nb] += acc;
                bon[nb] += RBON[item * RC + tau];
            }
        }
        f32x4 g[2] = {f32x4{0.f, 0.f, 0.f, 0.f}, f32x4{0.f, 0.f, 0.f, 0.f}};
#pragma unroll
        for (int ks = 0; ks < 4; ++ks) {
            const bf16x8 xf = *(const bf16x8*)(G2T + (wave * 16 + l15) * 136 + ks * 32 + 8 * q);
#pragma unroll
            for (int nb = 0; nb < 2; ++nb) {
                const int pos = pc * RC + nb * 16 + l15;
                float o[8]; shifted8(p, P, 1, b, pos, SEQ, 3 * D_RWKV + 256 + ks * 32 + 8 * q, o);
                u32x4 t; t[0] = pk2(fsigm(o[0]), fsigm(o[1])); t[1] = pk2(fsigm(o[2]), fsigm(o[3])); t[2] = pk2(fsigm(o[4]), fsigm(o[5])); t[3] = pk2(fsigm(o[6]), fsigm(o[7]));
                g[nb] = MFMA16(xf, __builtin_bit_cast(bf16x8, t), g[nb]);
            }
        }
        float s1[2], s2[2];
#pragma unroll
        for (int nb = 0; nb < 2; ++nb) {
            float a = hsum4(y[nb]), bq = hsum4(y[nb] * y[nb]);
            a += __shfl_xor(a, 16); a += __shfl_xor(a, 32); bq += __shfl_xor(bq, 16); bq += __shfl_xor(bq, 32);
            s1[nb] = a; s2[nb] = bq;
        }
        __syncthreads();
        if (q == 0) { red[(0 * 4 + wave) * 32 + l15] = s1[0]; red[(0 * 4 + wave) * 32 + 16 + l15] = s1[1]; red[(1 * 4 + wave) * 32 + l15] = s2[0]; red[(1 * 4 + wave) * 32 + 16 + l15] = s2[1]; }
        __syncthreads();
        const f32x4 gng = ld4(p.gn_g + h * 64 + i0), gnb = ld4(p.gn_b + h * 64 + i0);
#pragma unroll
        for (int nb = 0; nb < 2; ++nb) {
            const int pl = nb * 16 + l15, pos = pc * RC + pl;
            float t1 = 0.f, t2 = 0.f;
#pragma unroll
            for (int w = 0; w < 4; ++w) { t1 += red[(0 * 4 + w) * 32 + pl]; t2 += red[(1 * 4 + w) * 32 + pl]; }
            const float mu = t1 * (1.0f / 64.0f), var = fmaxf(t2 * (1.0f / 64.0f) - mu * mu, 0.f), rstd = frsq(var + GN_EPS);
            const int chv = 2 * D_RWKV + h * 64 + i0;
            const size_t mrow = rwkv_row(1, b, pos);
            const U2 zc = ldu2(P + mrow * D_IN + RW0 + chv);
            U2 zp; zp.x = 0u; zp.y = 0u; U2 zn = zp;
            if (pos > 0) zp = ldu2(P + rwkv_row(1, b, pos - 1) * D_IN + RW0 + chv);
            if (pos < SEQ - 1) zn = ldu2(P + rwkv_row(1, b, pos + 1) * D_IN + RW0 + chv);
            const f32x4 z = f32x4{bitsf(zc.x << 16), bitsf(zc.x & 0xFFFF0000u), bitsf(zc.y << 16), bitsf(zc.y & 0xFFFF0000u)};
            const f32x4 zpv = f32x4{bitsf(zp.x << 16), bitsf(zp.x & 0xFFFF0000u), bitsf(zp.y << 16), bitsf(zp.y & 0xFFFF0000u)};
            const f32x4 znv = f32x4{bitsf(zn.x << 16), bitsf(zn.x & 0xFFFF0000u), bitsf(zn.y << 16), bitsf(zn.y & 0xFFFF0000u)};
            const f32x4 v = z + ld4(p.mu_prev + chv) * (zpv - z) + ld4(p.mu_next + chv) * (znv - z);
            const f32x4 yn = (y[nb] - mu) * rstd * gng + gnb;
            *(U2*)(MIX + mrow * D_MIX + D_LRU + h * 64 + i0) = pack4((yn + bon[nb] * v) * g[nb]);
        }
    }
}

__device__ void phaseJ(const Params& p, int bid, int nblk, char* smem) {
    const bf16_t* MIX = WSP(bf16_t, WS_R3);
    float* YOUT = WSP(float, WS_R1);
    constexpr int NTN = D_MODEL / 128, NTM = MLAT / 128;
    const float* RINV = WSP(float, WS_RINV);
    constexpr int GM = (NTM % 8 == 0) ? 8 : 1;
    for (int it = xcd_vbid(bid, nblk); it < NTN * NTM; it += nblk) {
        const int mg = it / (GM * NTN), r = it % (GM * NTN), nt = r / GM, mt = mg * GM + (r % GM);
        gemm_tile<false>(smem, MIX, D_MIX, nullptr, mt * 128, p.w_out, nullptr, D_MODEL, nt * 128, D_MIX, [&](int ml, int nl, f32x4 v, f32x4) {
            *(f32x4*)(YOUT + (size_t)(mt * 128 + ml) * D_MODEL + nt * 128 + nl) = v;
        }, RINV, D_LRU / 64);
    }
}

constexpr int KUL = D_MODEL + 2;
static_assert((16 * KUL + 4 * 256) * 4 <= SMEM_BYTES && N_EXPERTS <= 16 && MLAT % 16 == 0, "phase K lds");
__device__ void phaseK(const Params& p, int bid, int nblk, char* smem) {
    const int tid = threadIdx.x, lane = tid & 63, wave = tid >> 6, q = lane >> 4, l15 = lane & 15;
    const float* MOD = WSP(float, WS_MOD); const float* STATS = WSP(float, WS_STATS);
    const float* YOUT = WSP(float, WS_R1);
    float* H1 = WSP(float, WS_R5); bf16_t* U2b = WSP(bf16_t, WS_R6); float* AFF = WSP(float, WS_AFF);
    float* UL = (float*)smem;
    float* PL = UL + 16 * KUL;
    for (int rb = bid; rb < MLAT / 16; rb += nblk) {
        __syncthreads();
#pragma unroll 1
        for (int rr = 0; rr < 4; ++rr) {
            const int lr = wave * 4 + rr, row = rb * 16 + lr;
            const float* xr = p.x + (size_t)row * D_MODEL;
            const float* md = MOD + (size_t)(row / SEQ) * 6 * D_MODEL;
            const float mu0 = STATS[row * 2], rs0 = STATS[row * 2 + 1];
            f32x4 v0, v1, v2, v3; float s = 0.f;
#define PK_LOAD(V, J) { const int k = (J) * 256 + lane * 4; \
            V = ALPHA_F * ((ld4(xr + k) - mu0) * rs0 * ld4(p.ln_in_g + k) + ld4(p.ln_in_b + k)) + ld4(md + 2 * D_MODEL + k) * ld4(YOUT + (size_t)row * D_MODEL + k); s += hsum4(V); }
            PK_LOAD(v0, 0)
            if (NV > 1) PK_LOAD(v1, 1) else v1 = f32x4{0.f, 0.f, 0.f, 0.f};
            if (NV > 2) { PK_LOAD(v2, 2) PK_LOAD(v3, 3) } else { v2 = v1; v3 = v1; }
#undef PK_LOAD
            const float mu = wave_sum(s) * (1.0f / D_MODEL);
            v0 -= mu; float s2 = hsum4(v0 * v0);
            if (NV > 1) { v1 -= mu; s2 += hsum4(v1 * v1); }
            if (NV > 2) { v2 -= mu; v3 -= mu; s2 += hsum4(v2 * v2) + hsum4(v3 * v3); }
            const float rstd = frsq(wave_sum(s2) * (1.0f / D_MODEL) + LN_EPS);
#pragma unroll
            for (int j = 0; j < NV; ++j) {
                const int k = j * 256 + lane * 4;
                const f32x4 vv = (j == 0) ? v0 : (j == 1) ? v1 : (j == 2) ? v2 : v3;
                const f32x4 h = vv * rstd * ld4(p.ln1_g + k) + ld4(p.ln1_b + k);
                *(f32x4*)(H1 + (size_t)row * D_MODEL + k) = h;
                const f32x4 u = h * (1.0f + ld4(md + 4 * D_MODEL + k)) + ld4(md + 3 * D_MODEL + k);
                *(U2*)(U2b + (size_t)row * D_MODEL + k) = pack4(u);
                float* ul = UL + lr * KUL + k;
                *(f32x2_e*)ul = f32x2_e{u[0], u[1]}; *(f32x2_e*)(ul + 2) = f32x2_e{u[2], u[3]};
            }
        }
        __syncthreads();
        {
            f32x4 acc = f32x4{0.f, 0.f, 0.f, 0.f};
            const int kq0 = wave * (D_MODEL / 4);
#pragma unroll 8
            for (int s4 = 0; s4 < D_MODEL / 16; ++s4) {
                const int k = kq0 + s4 * 4 + q;
                const float av = UL[l15 * KUL + k];
                const float bv = (l15 < N_EXPERTS) ? p.w_router[(size_t)k * N_EXPERTS + l15] : 0.f;
                acc = MFMAF32(av, bv, acc);
            }
#pragma unroll
            for (int r = 0; r < 4; ++r) PL[wave * 256 + (q * 4 + r) * 16 + l15] = acc[r];
        }
        __syncthreads();
        {
            const int lr = tid >> 4, e = tid & 15;
            const bool valid = e < N_EXPERTS;
            float lg = PL[tid] + PL[256 + tid] + PL[512 + tid] + PL[768 + tid];
            float mx = valid ? lg : -3.0e38f;
#pragma unroll
            for (int o = 1; o < 16; o <<= 1) mx = fmaxf(mx, __shfl_xor(mx, o));
            const float ex = valid ? expf(lg - mx) : 0.f;
            float den = ex;
#pragma unroll
            for (int o = 1; o < 16; o <<= 1) den += __shfl_xor(den, o);
            if (valid) AFF[(size_t)(rb * 16 + lr) * N_EXPERTS + e] = ex / den;
        }
    }
}

__device__ __forceinline__ int block_sum_int(int v, int* red) {
    const int lane = threadIdx.x & 63, wave = threadIdx.x >> 6;
#pragma unroll
    for (int o = 1; o < 64; o <<= 1) v += __shfl_xor(v, o);
    __syncthreads();
    if (lane == 0) red[wave] = v;
    __syncthreads();
    return red[0] + red[1] + red[2] + red[3];
}
__device__ void phaseL(const Params& p, int bid, int nblk, char* smem) {
    const float* AFF = WSP(float, WS_AFF);
    int* IDX = WSP(int, WS_IDX); float* GATE = WSP(float, WS_GATE); int* SLOTOF = WSP(int, WS_SLOT);
    unsigned* vals = (unsigned*)smem;
    int* red = (int*)(vals + SEQ);
    int* wsum = red + 8;
    const int tid = threadIdx.x, lane = tid & 63, wave = tid >> 6;
    constexpr int PER = SEQ / 256;
    for (int be = bid; be < BATCH * N_EXPERTS; be += nblk) {
        const int b = be / N_EXPERTS, e = be % N_EXPERTS;
        __syncthreads();
        for (int t = tid; t < SEQ; t += 256) vals[t] = fbits(AFF[((size_t)b * SEQ + t) * N_EXPERTS + e]);
        __syncthreads();
        unsigned lo = 0u, hi = 0x7F800000u;
        while (lo < hi) {
            const unsigned mid = lo + (hi - lo + 1u) / 2u;
            int c = 0;
            for (int t = tid; t < SEQ; t += 256) c += (vals[t] >= mid) ? 1 : 0;
            c = block_sum_int(c, red);
            if (c >= CAP) lo = mid; else hi = mid - 1u;
        }
        const unsigned T = lo;
        int cg = 0, ce = 0;
        for (int q = 0; q < PER; ++q) { const unsigned v = vals[tid * PER + q]; cg += (v > T) ? 1 : 0; ce += (v == T) ? 1 : 0; }
        int pg = cg, pe = ce;
#pragma unroll
        for (int o = 1; o < 64; o <<= 1) { const int a = __shfl_up(pg, o), bb = __shfl_up(pe, o); if (lane >= o) { pg += a; pe += bb; } }
        __syncthreads();
        if (lane == 63) { wsum[wave] = pg; wsum[4 + wave] = pe; }
        __syncthreads();
        int og = 0, oe = 0, totg = 0;
        for (int w = 0; w < 4; ++w) { if (w < wave) { og += wsum[w]; oe += wsum[4 + w]; } totg += wsum[w]; }
        int posg = og + pg - cg, pose = oe + pe - ce;
        const int need_eq = CAP - totg;
        for (int q = 0; q < PER; ++q) {
            const int t = tid * PER + q; const unsigned v = vals[t];
            int slot = -1;
            if (v > T) { slot = posg++; }
            else if (v == T) { if (pose < need_eq) slot = totg + pose; pose++; }
            if (slot >= 0) { IDX[(size_t)be * CAP + slot] = b * SEQ + t; GATE[(size_t)be * CAP + slot] = bitsf(v); }
            SLOTOF[((size_t)b * SEQ + t) * N_EXPERTS + e] = slot;
        }
    }
}

__device__ void phaseM(const Params& p, int bid, int nblk, char* smem) {
    const bf16_t* U2b = WSP(bf16_t, WS_R6); const int* IDX = WSP(int, WS_IDX);
    bf16_t* HID = WSP(bf16_t, WS_R1);
    constexpr int NTN = D_EXPERT / 64, NTM = CAP / 128;
    for (int it = xcd_vbid(bid, nblk); it < BATCH * N_EXPERTS * NTM * NTN; it += nblk) {
        const int mt = it % NTM, b = (it / NTM) % BATCH, nt = (it / (NTM * BATCH)) % NTN, e = it / (NTM * BATCH * NTN), be = b * N_EXPERTS + e;
        const float* wg = p.w_gate + (size_t)e * D_MODEL * D_EXPERT; const float* wu = p.w_up + (size_t)e * D_MODEL * D_EXPERT;
        gemm_tile<true>(smem, U2b, D_MODEL, IDX + (size_t)be * CAP, mt * 128, wg, wu, D_EXPERT, nt * 64, D_MODEL, [&](int ml, int nl, f32x4 g, f32x4 u) {
            U2 o; o.x = pk2(siluf_(g[0]) * u[0], siluf_(g[1]) * u[1]); o.y = pk2(siluf_(g[2]) * u[2], siluf_(g[3]) * u[3]);
            *(U2*)(HID + ((size_t)be * CAP + mt * 128 + ml) * D_EXPERT + nt * 64 + nl) = o;
        });
    }
}
__device__ void phaseN(const Params& p, int bid, int nblk, char* smem) {
    const bf16_t* HID = WSP(bf16_t, WS_R1); const float* GATE = WSP(float, WS_GATE);
    bf16_t* YS = WSP(bf16_t, WS_R2);
    constexpr int NTN = D_MODEL / 128, NTM = CAP / 128;
    for (int it = xcd_vbid(bid, nblk); it < BATCH * N_EXPERTS * NTM * NTN; it += nblk) {
        const int mt = it % NTM, b = (it / NTM) % BATCH, nt = (it / (NTM * BATCH)) % NTN, e = it / (NTM * BATCH * NTN), be = b * N_EXPERTS + e;
        const float* wd = p.w_down + (size_t)e * D_EXPERT * D_MODEL;
        gemm_tile<false>(smem, HID + (size_t)be * CAP * D_EXPERT, D_EXPERT, nullptr, mt * 128, wd, nullptr, D_MODEL, nt * 128, D_EXPERT, [&](int ml, int nl, f32x4 v, f32x4) {
            const int slot = mt * 128 + ml;
            const float gt = GATE[(size_t)be * CAP + slot];
            *(U2*)(YS + ((size_t)be * CAP + slot) * D_MODEL + nt * 128 + nl) = pack4(v * gt);
        });
    }
}
__device__ void phaseO(const Params& p, int bid, int nblk, char* smem) {
    const int lane = threadIdx.x & 63, wave = threadIdx.x >> 6;
    const float* MOD = WSP(float, WS_MOD); const float* H1 = WSP(float, WS_R5); const bf16_t* YS = WSP(bf16_t, WS_R2); const int* SLOTOF = WSP(int, WS_SLOT);
    for (int row = bid * 4 + wave; row < MLAT; row += nblk * 4) {
        const float* md = MOD + (size_t)(row / SEQ) * 6 * D_MODEL;
        f32x4 v0, v1, v2, v3; float s = 0.f;
        f32x4 y0 = f32x4{0.f, 0.f, 0.f, 0.f}, y1 = y0, y2 = y0, y3 = y0;
        const int myslot = (lane < N_EXPERTS) ? SLOTOF[(size_t)row * N_EXPERTS + lane] : -1;
        const int bbase = (row / SEQ) * N_EXPERTS;
        for (int e = 0; e < N_EXPERTS; ++e) {
            const int sl = __shfl(myslot, e);
            if (sl >= 0) {
                const bf16_t* yr = YS + ((size_t)(bbase + e) * CAP + sl) * D_MODEL + lane * 4;
                { const U2 u = *(const U2*)yr; y0 += f32x4{bitsf(u.x << 16), bitsf(u.x & 0xFFFF0000u), bitsf(u.y << 16), bitsf(u.y & 0xFFFF0000u)}; }
                if (NV > 1) { const U2 u = *(const U2*)(yr + 256); y1 += f32x4{bitsf(u.x << 16), bitsf(u.x & 0xFFFF0000u), bitsf(u.y << 16), bitsf(u.y & 0xFFFF0000u)}; }
                if (NV > 2) { const U2 u = *(const U2*)(yr + 512); y2 += f32x4{bitsf(u.x << 16), bitsf(u.x & 0xFFFF0000u), bitsf(u.y << 16), bitsf(u.y & 0xFFFF0000u)};
                              const U2 w = *(const U2*)(yr + 768); y3 += f32x4{bitsf(w.x << 16), bitsf(w.x & 0xFFFF0000u), bitsf(w.y << 16), bitsf(w.y & 0xFFFF0000u)}; }
            }
        }
#define PO_LOAD(V, J) { const int k = (J) * 256 + lane * 4; const f32x4 yy = ((J) == 0) ? y0 : ((J) == 1) ? y1 : ((J) == 2) ? y2 : y3; V = ALPHA_F * ld4(H1 + (size_t)row * D_MODEL + k) + ld4(md + 5 * D_MODEL + k) * yy; s += hsum4(V); }
        PO_LOAD(v0, 0)
        if (NV > 1) PO_LOAD(v1, 1) else v1 = f32x4{0.f, 0.f, 0.f, 0.f};
        if (NV > 2) { PO_LOAD(v2, 2) PO_LOAD(v3, 3) } else { v2 = v1; v3 = v1; }
#undef PO_LOAD
        const float mu = wave_sum(s) * (1.0f / D_MODEL);
        v0 -= mu; float s2 = hsum4(v0 * v0);
        if (NV > 1) { v1 -= mu; s2 += hsum4(v1 * v1); }
        if (NV > 2) { v2 -= mu; v3 -= mu; s2 += hsum4(v2 * v2) + hsum4(v3 * v3); }
        const float rstd = frsq(wave_sum(s2) * (1.0f / D_MODEL) + LN_EPS);
#pragma unroll
        for (int j = 0; j < NV; ++j) {
            const int k = j * 256 + lane * 4;
            const f32x4 vv = (j == 0) ? v0 : (j == 1) ? v1 : (j == 2) ? v2 : v3;
            *(f32x4*)(p.out + (size_t)row * D_MODEL + k) = vv * rstd * ld4(p.ln2_g + k) + ld4(p.ln2_b + k);
        }
    }
}

#define XB_TMO      128
#define XB_XCNT(j)  (256  + 64 * (j))
#define XB_XSUB(j)  (1280 + 64 * (j))
#define XB_XGEN(j)  (2304 + 64 * (j))
#define XB_TOP      3328
#define XB_TOPGEN   3392
#define XCD_BAR_WORDS 3456
#define XB_SPIN_CAP (1u << 22)
#ifndef HOST_EMU
__device__ __forceinline__ unsigned xb_ld(unsigned* p) { return __hip_atomic_load(p, __ATOMIC_RELAXED, __HIP_MEMORY_SCOPE_AGENT); }
__device__ __forceinline__ unsigned xb_add(unsigned* p, unsigned v) { return __hip_atomic_fetch_add(p, v, __ATOMIC_RELAXED, __HIP_MEMORY_SCOPE_AGENT); }
__device__ __forceinline__ unsigned xb_xcc_id() { return (unsigned)__builtin_amdgcn_s_getreg((3 << 11) | 20) & 0xFu; }
#define XB_SPIN(cond, bar) do { unsigned _sp = 0; while (cond) { __builtin_amdgcn_s_sleep(1); \
    if ((++_sp & 255u) == 0u) { if (xb_ld(&(bar)[XB_TMO])) break; if (_sp > XB_SPIN_CAP) { atomicAdd(&(bar)[XB_TMO], 1u); break; } } } } while (0)
struct XcdBarrier { unsigned* bar; unsigned x; unsigned* st; };
__device__ __forceinline__ XcdBarrier xcd_barrier_post(unsigned* bar, unsigned* st) {
    XcdBarrier b; b.bar = bar; b.x = xb_xcc_id(); b.st = st;
    if (threadIdx.x == 0) (void)xb_add(&bar[XB_XCNT(b.x)], 1u);
    return b;
}
__device__ __forceinline__ void xcd_barrier_complete(unsigned* bar, unsigned x, unsigned& nloc, unsigned& nx) {
    const unsigned G = gridDim.x;
    unsigned sum, cnt, mine, sp = 0u;
    for (;;) {
        sum = 0u; cnt = 0u; mine = 0u;
#pragma unroll
        for (unsigned j = 0; j < 16; ++j) { const unsigned c = xb_ld(&bar[XB_XCNT(j)]); sum += c; cnt += (c > 0u) ? 1u : 0u; mine = (j == x) ? c : mine; }
        if (sum == G) break;
        __builtin_amdgcn_s_sleep(1);
        if ((++sp & 255u) == 0u) { if (xb_ld(&bar[XB_TMO])) break; if (sp > XB_SPIN_CAP) { atomicAdd(&bar[XB_TMO], 1u); break; } }
    }
    nloc = mine > 0u ? mine : 1u; nx = cnt > 0u ? cnt : 1u;
}
__device__ __forceinline__ void grid_barrier(const XcdBarrier& b) {
    asm volatile("s_waitcnt vmcnt(0)" ::: "memory");
    __syncthreads();
    if (threadIdx.x == 0) {
        unsigned* bar = b.bar;
        __builtin_amdgcn_s_waitcnt(0);
        volatile unsigned* st = b.st;
        unsigned nloc = st[0], nx = st[1];
        if (nloc == 0u) { xcd_barrier_complete(bar, b.x, nloc, nx); st[0] = nloc; st[1] = nx; }
        const unsigned old = xb_add(&bar[XB_XSUB(b.x)], 1u);
        const unsigned gen = old / nloc;
        if (old + 1u == (gen + 1u) * nloc) {
            __builtin_amdgcn_fence(__ATOMIC_RELEASE, "agent");
            asm volatile("s_waitcnt vmcnt(0)" ::: "memory");
            const unsigned og = xb_add(&bar[XB_TOP], 1u);
            const unsigned tg = og / nx;
            if (og + 1u == (tg + 1u) * nx) xb_add(&bar[XB_TOPGEN], 1u);
            else XB_SPIN(xb_ld(&bar[XB_TOPGEN]) == tg, bar);
            __builtin_amdgcn_fence(__ATOMIC_ACQUIRE, "agent");
            xb_add(&bar[XB_XGEN(b.x)], 1u);
            asm volatile("s_waitcnt vmcnt(0)" ::: "memory");
        } else {
            XB_SPIN(xb_ld(&bar[XB_XGEN(b.x)]) == gen, bar);
            __builtin_amdgcn_fence(__ATOMIC_ACQUIRE, "agent");
            asm volatile("s_waitcnt vmcnt(0)" ::: "memory");
        }
    }
    __syncthreads();
}
#else
struct XcdBarrier { int dummy; };
__device__ __forceinline__ XcdBarrier xcd_barrier_post(unsigned*, unsigned*) { return XcdBarrier{0}; }
__device__ __forceinline__ void grid_barrier(const XcdBarrier&) { __syncthreads(); }
#endif

__global__ void __launch_bounds__(256, 2) fused_forward(Params p) {
    __shared__ __attribute__((aligned(16))) char smem[SMEM_BYTES];
    __shared__ __attribute__((aligned(16))) unsigned xb_words[4];
    if (threadIdx.x == 0) { xb_words[0] = 0u; xb_words[1] = 0u; xb_words[2] = 0u; xb_words[3] = 0u; }
    __syncthreads();
    const XcdBarrier gb = xcd_barrier_post(WSP(unsigned, WS_CTRL), xb_words);
    const int bid = blockIdx.x, nblk = gridDim.x;
    phaseA(p, bid, nblk, smem); grid_barrier(gb);
    phaseB(p, bid, nblk, smem); grid_barrier(gb);
    phaseC(p, bid, nblk, smem); grid_barrier(gb);
    phaseD(p, bid, nblk, smem); grid_barrier(gb);
    phaseE(p, bid, nblk, smem); grid_barrier(gb);
    phaseF(p, bid, nblk, smem); grid_barrier(gb);
    phaseR1(p, bid, nblk, smem); grid_barrier(gb);
    phaseR2(p, bid, nblk, smem); grid_barrier(gb);
    phaseR3(p, bid, nblk, smem); grid_barrier(gb);
    phaseJ(p, bid, nblk, smem); grid_barrier(gb);
    phaseK(p, bid, nblk, smem); grid_barrier(gb);
    phaseL(p, bid, nblk, smem); grid_barrier(gb);
    phaseM(p, bid, nblk, smem); grid_barrier(gb);
    phaseN(p, bid, nblk, smem); grid_barrier(gb);
    phaseO(p, bid, nblk, smem);
}

#ifdef MULTI_LAUNCH
#define PHASE_KERNEL(NAME) \
    __global__ void __launch_bounds__(256) k_##NAME(Params p) { __shared__ __attribute__((aligned(16))) char smem[SMEM_BYTES]; NAME(p, blockIdx.x, gridDim.x, smem); }
PHASE_KERNEL(phaseA) PHASE_KERNEL(phaseB) PHASE_KERNEL(phaseC) PHASE_KERNEL(phaseD) PHASE_KERNEL(phaseE) PHASE_KERNEL(phaseF) PHASE_KERNEL(phaseR1) PHASE_KERNEL(phaseR2) PHASE_KERNEL(phaseR3)
PHASE_KERNEL(phaseJ) PHASE_KERNEL(phaseK) PHASE_KERNEL(phaseL) PHASE_KERNEL(phaseM) PHASE_KERNEL(phaseN) PHASE_KERNEL(phaseO)
#ifdef HOST_EMU
void emu_hook(const char* name, const Params& p);
#define LAUNCH(NAME, grid) do { EMU_LAUNCH(k_##NAME, grid, 256, p); emu_hook(#NAME, p); } while (0)
#else
#define LAUNCH(NAME, grid) hipLaunchKernelGGL(k_##NAME, dim3(grid), dim3(256), 0, stream, p)
#endif
#endif

extern "C" void kernel_launch(void* const* d_in, const int* in_sizes, int n_in, void* d_out, int out_size, void* d_ws, size_t ws_size, hipStream_t stream) {
    if (n_in != 38 || out_size != MLAT * D_MODEL || ws_size < WS_END) { fprintf(stderr, "kernel_launch: unexpected shapes (n_in %d out %d ws %zu need %zu)\n", n_in, out_size, ws_size, (size_t)WS_END); return; }
    Params p{};
    const float** f = (const float**)&p;
    for (int i = 0; i < 38; ++i) f[i] = (const float*)d_in[i];
    p.out = (float*)d_out; p.ws = (unsigned char*)d_ws;
#ifdef MULTI_LAUNCH
    const int G = 512;
    LAUNCH(phaseA, 6 * D_MODEL / 16);
    LAUNCH(phaseB, G);
    LAUNCH(phaseC, G);
    LAUNCH(phaseD, G);
    LAUNCH(phaseE, 16);
    LAUNCH(phaseF, G);
    LAUNCH(phaseR1, G);
    LAUNCH(phaseR2, NCHAIN);
    LAUNCH(phaseR3, G);
    LAUNCH(phaseJ, G);
    LAUNCH(phaseK, G);
    LAUNCH(phaseL, BATCH * N_EXPERTS);
    LAUNCH(phaseM, G);
    LAUNCH(phaseN, G);
    LAUNCH(phaseO, G);
#elif defined(HOST_EMU)
    EMU_LAUNCH(fused_forward, 1, 256, p);
#else
    static int grid_blocks = 0;
    if (!grid_blocks) {
        int dev = 0, cus = 0, per_cu = 0;
        (void)hipGetDevice(&dev);
        (void)hipDeviceGetAttribute(&cus, hipDeviceAttributeMultiprocessorCount, dev);
        (void)hipOccupancyMaxActiveBlocksPerMultiprocessor(&per_cu, fused_forward, 256, 0);
        if (per_cu > 2) per_cu = 2;
        if (per_cu < 1) { fprintf(stderr, "kernel_launch: occupancy query returned %d blocks per CU\n", per_cu); per_cu = 1; }
        grid_blocks = cus * per_cu;
    }
    (void)hipMemsetAsync((char*)d_ws + WS_CTRL, 0, XCD_BAR_WORDS * 4, stream);
    void* args[] = {&p};
    hipError_t e = hipLaunchCooperativeKernel((void*)fused_forward, dim3(grid_blocks), dim3(256), args, 0, stream);
    if (e != hipSuccess) fprintf(stderr, "cooperative launch failed: %s (grid %d)\n", hipGetErrorString(e), grid_blocks);
#endif
}
```

```cpp
#ifndef HOST_EMU
#include <hip/hip_runtime.h>
#include <cstdio>
#endif
#include <cstdint>
#include <cstddef>

#ifdef CFG_SMALL
constexpr int D_MODEL = 256, BATCH = 2, SEQ = 256, GRID_W = 16, CTX_LEN = 64, LRU_BLOCKS = 2, N_EXPERTS = 4, D_EXPERT = 256;
#else
constexpr int D_MODEL = 1024, BATCH = 4, SEQ = 4096, GRID_W = 64, CTX_LEN = 256, LRU_BLOCKS = 8, N_EXPERTS = 16, D_EXPERT = 1408;
#endif
constexpr int ROWS = SEQ / GRID_W;
constexpr int D_LRU = D_MODEL / 2, LRU_BLOCK = 64;
constexpr int D_RWKV = D_MODEL / 2, HEADS = D_RWKV / 64;
constexpr int D_RWKV_IN = 3 * D_RWKV + 128 + 128 + 128;
constexpr int D_IN = 2 * D_LRU + D_RWKV_IN;
constexpr int D_MIX = D_LRU + D_RWKV;
constexpr int CAP = 2 * SEQ / N_EXPERTS;
constexpr int MLAT = BATCH * SEQ, MCTX = BATCH * CTX_LEN, MTOT = MLAT + MCTX;
constexpr int NMOD = BATCH + 1;
constexpr int RW0 = 2 * D_LRU;
constexpr float ALPHA_F = 1.189207115002721f;
constexpr float LN_EPS = 1e-5f, GN_EPS = 64e-5f, RMS_EPS = 1e-6f;
static_assert(LRU_BLOCKS * LRU_BLOCK == D_LRU, "lru blocks");
static_assert(CAP % 128 == 0 && D_IN % 128 == 0 && D_EXPERT % 64 == 0 && D_MODEL % 128 == 0 && MTOT % 128 == 0 && D_MIX % 64 == 0, "tile divisibility");

typedef unsigned short bf16_t;
typedef short bf16x8 __attribute__((ext_vector_type(8)));
typedef float f32x4 __attribute__((ext_vector_type(4)));
typedef unsigned u32x4 __attribute__((ext_vector_type(4)));
typedef float f32x2_e __attribute__((ext_vector_type(2)));
struct alignas(16) F4 { float x, y, z, w; };
typedef unsigned U2 __attribute__((ext_vector_type(2)));
struct alignas(16) U4 { unsigned x, y, z, w; };

#ifdef HOST_EMU
#define MFMA16(a, b, c) emu_mfma_16x16x32_bf16(a, b, c)
#define MFMAF32(a, b, c) emu_mfma_16x16x4_f32(a, b, c)
#else
#define MFMA16(a, b, c) __builtin_amdgcn_mfma_f32_16x16x32_bf16(a, b, c, 0, 0, 0)
#define MFMAF32(a, b, c) __builtin_amdgcn_mfma_f32_16x16x4f32(a, b, c, 0, 0, 0)
#endif

__device__ __forceinline__ unsigned fbits(float f) { return __builtin_bit_cast(unsigned, f); }
__device__ __forceinline__ float bitsf(unsigned u) { return __builtin_bit_cast(float, u); }
__device__ __forceinline__ bf16_t f2bf(float f) { unsigned u = fbits(f); u += 0x7FFFu + ((u >> 16) & 1u); return (bf16_t)(u >> 16); }
__device__ __forceinline__ float bf2f(bf16_t h) { return bitsf(((unsigned)h) << 16); }
#ifdef HOST_EMU
__device__ __forceinline__ unsigned pk2(float lo, float hi) { return (unsigned)f2bf(lo) | ((unsigned)f2bf(hi) << 16); }
#else
typedef float f32x2_t __attribute__((ext_vector_type(2)));
typedef __bf16 bf16x2_t __attribute__((ext_vector_type(2)));
__device__ __forceinline__ unsigned pk2(float lo, float hi) { return __builtin_bit_cast(unsigned, __builtin_convertvector(f32x2_t{lo, hi}, bf16x2_t)); }
#endif
__device__ __forceinline__ float sigmoidf_(float x) { return 1.0f / (1.0f + expf(-x)); }
__device__ __forceinline__ float softplusf_(float x) { return fmaxf(x, 0.0f) + log1pf(expf(-fabsf(x))); }
#ifdef HOST_EMU
#define FEXP(x) expf(x)
#else
#define FEXP(x) __expf(x)
#endif
#ifdef HOST_EMU
__device__ __forceinline__ float frcp(float x) { return 1.0f / x; }
__device__ __forceinline__ float frsq(float x) { return 1.0f / sqrtf(x); }
__device__ __forceinline__ float fsqrt(float x) { return sqrtf(x); }
#else
__device__ __forceinline__ float frcp(float x) { return __builtin_amdgcn_rcpf(x); }
__device__ __forceinline__ float frsq(float x) { return __builtin_amdgcn_rsqf(x); }
__device__ __forceinline__ float fsqrt(float x) { return __builtin_amdgcn_sqrtf(x); }
#endif
__device__ __forceinline__ float fsigm(float x) { return frcp(1.0f + FEXP(-x)); }
__device__ __forceinline__ float siluf_(float x) { return x * fsigm(x); }
__device__ __forceinline__ float geluf_(float x) { return x * fsigm(1.5957691216057308f * (x + 0.044715f * x * x * x)); }
__device__ __forceinline__ float wave_sum(float v) {
#pragma unroll
    for (int o = 1; o < 64; o <<= 1) v += __shfl_xor(v, o);
    return v;
}

constexpr size_t al256(size_t x) { return (x + 255) & ~(size_t)255; }
constexpr int NLCH = BATCH * (SEQ / 64), NCCH = BATCH * (CTX_LEN / 64), NCH = NLCH + NCCH;
constexpr size_t WS_CTRL = 0;
constexpr size_t WS_MOD = 65536;
constexpr size_t WS_STATS = al256(WS_MOD + (size_t)NMOD * 6 * D_MODEL * 4);
constexpr size_t WS_SUMA = al256(WS_STATS + (size_t)MTOT * 2 * 4);
constexpr size_t WS_SUMH = al256(WS_SUMA + (size_t)2 * NCH * D_LRU * 4);
constexpr size_t WS_CARRY = al256(WS_SUMH + (size_t)2 * NCH * D_LRU * 4);
constexpr size_t WS_SSQP = al256(WS_CARRY + (size_t)2 * NLCH * D_LRU * 4);
constexpr size_t WS_RINV = al256(WS_SSQP + (size_t)MLAT * LRU_BLOCKS * 4);
constexpr size_t WS_BON = al256(WS_RINV + (size_t)MLAT * 4);
constexpr size_t WS_AFF = al256(WS_BON + (size_t)2 * MLAT * HEADS * 4 + 4096 * 64);
constexpr size_t WS_IDX = al256(WS_AFF + (size_t)MLAT * N_EXPERTS * 4);
constexpr size_t WS_GATE = al256(WS_IDX + (size_t)BATCH * N_EXPERTS * CAP * 4);
constexpr size_t WS_SLOT = al256(WS_GATE + (size_t)BATCH * N_EXPERTS * CAP * 4);
constexpr size_t WS_WBIN = al256(WS_SLOT + (size_t)MLAT * N_EXPERTS * 4);
constexpr size_t WS_WBOUT = al256(WS_WBIN + (size_t)D_IN * D_MODEL * 2);
constexpr size_t WS_R1 = al256(WS_WBOUT + (size_t)D_MODEL * D_MIX * 2);
constexpr size_t R1_BYTES = (size_t)MTOT * D_IN * 2 > (size_t)MLAT * D_MODEL * 4 ? ((size_t)MTOT * D_IN * 2 > (size_t)BATCH * N_EXPERTS * CAP * D_EXPERT * 2 ? (size_t)MTOT * D_IN * 2 : (size_t)BATCH * N_EXPERTS * CAP * D_EXPERT * 2)
                                                                                  : ((size_t)MLAT * D_MODEL * 4 > (size_t)BATCH * N_EXPERTS * CAP * D_EXPERT * 2 ? (size_t)MLAT * D_MODEL * 4 : (size_t)BATCH * N_EXPERTS * CAP * D_EXPERT * 2);
constexpr size_t WS_R3 = al256(WS_R1 + R1_BYTES);
constexpr int RC = 32;
constexpr int NCC = CTX_LEN / RC, NLC = SEQ / RC, NCK = NCC + NLC, NCHAIN = BATCH * HEADS * 2;
constexpr size_t CH_PM = 0, CH_SA = 8192, CH_QT = 16384, CH_Y0 = 20480, CH_BYTES = 24576;
constexpr size_t WS_CH = al256(WS_R3 + (size_t)MTOT * D_MODEL * 2);
constexpr size_t CH_TOTAL = (size_t)NCHAIN * NCK * CH_BYTES;
constexpr size_t WS_R5 = WS_CH;
constexpr size_t WS_LA = al256(WS_R5 + (size_t)MLAT * D_MODEL * 4);
constexpr size_t WS_R6 = WS_LA, WS_R2 = WS_LA;
constexpr size_t WEXP_BYTES = (size_t)D_MODEL * D_EXPERT * 2;
constexpr size_t WS_WG = al256(WS_LA + (size_t)MLAT * D_MODEL * 2);
constexpr size_t WS_WU = WS_WG + (size_t)N_EXPERTS * WEXP_BYTES;
constexpr int NE_R3 = ((size_t)MTOT * D_MODEL * 2 / WEXP_BYTES) < (size_t)N_EXPERTS ? (int)((size_t)MTOT * D_MODEL * 2 / WEXP_BYTES) : N_EXPERTS;
constexpr size_t WS_WD2 = WS_WU + (size_t)N_EXPERTS * WEXP_BYTES;
constexpr size_t WS_LATE_END = al256(WS_WD2 + (size_t)(N_EXPERTS - NE_R3) * WEXP_BYTES);
static_assert(WS_LA + (size_t)BATCH * N_EXPERTS * CAP * D_MODEL * 2 <= WS_WD2, "YS must not reach the w_down copies");
constexpr size_t WS_END = (WS_CH + CH_TOTAL > WS_LATE_END) ? al256(WS_CH + CH_TOTAL) : WS_LATE_END;
constexpr size_t WS_RBON = WS_BON;
static_assert((size_t)NCHAIN * NCK * RC * 4 <= (size_t)2 * MLAT * HEADS * 4 + 4096 * 64, "bonus buffer");

struct Params {
    const float *x, *c, *ctx, *c_ctx, *ln_in_g, *ln_in_b, *w_mod, *b_mod, *w_in, *lru_conv_w, *lru_conv_b, *lru_wa, *lru_ba, *lru_wx, *lru_bx, *lru_lam, *lru_norm_g,
        *mu_prev, *mu_next, *w0, *w2, *a0, *a2, *g2, *k_k, *k_a, *r_k, *gn_g, *gn_b, *w_out, *ln1_g, *ln1_b, *w_router, *w_gate, *w_up, *w_down, *ln2_g, *ln2_b;
    float* out;
    unsigned char* ws;
};
#define WSP(T, off) ((T*)(p.ws + (off)))
__device__ __forceinline__ size_t wdown_off(int e) { return e < NE_R3 ? WS_R3 + (size_t)e * WEXP_BYTES : WS_WD2 + (size_t)(e - NE_R3) * WEXP_BYTES; }

constexpr int SMEM_BYTES = 76 * 1024;

__device__ __forceinline__ f32x4 ld4(const float* p) { return *(const f32x4*)p; }
__device__ __forceinline__ float hsum4(f32x4 v) { return (v[0] + v[1]) + (v[2] + v[3]); }
__device__ __forceinline__ U2 pack4(f32x4 v) { U2 o; o.x = pk2(v[0], v[1]); o.y = pk2(v[2], v[3]); return o; }
__device__ __forceinline__ void convert_transpose(const float* src, bf16_t* dst, int K, int N, int t0, int t1, int tstride, char* smem) {
    float* T = (float*)smem;
    const int tid = threadIdx.x, r = tid >> 4, c4 = (tid & 15) * 4, ntn = N / 64;
    f32x4 v[4];
    if (t0 < t1) { const int kt = t0 / ntn, nt = t0 % ntn;
#pragma unroll
        for (int j = 0; j < 4; ++j) v[j] = ld4(src + (size_t)(kt * 64 + r + 16 * j) * N + nt * 64 + c4); }
    for (int t = t0; t < t1; t += tstride) {
        const int kt = t / ntn, nt = t % ntn;
        __syncthreads();
#pragma unroll
        for (int j = 0; j < 4; ++j) { float* d = T + (r + 16 * j) * 65 + c4; d[0] = v[j][0]; d[1] = v[j][1]; d[2] = v[j][2]; d[3] = v[j][3]; }
        __syncthreads();
        if (t + tstride < t1) { const int kt2 = (t + tstride) / ntn, nt2 = (t + tstride) % ntn;
#pragma unroll
            for (int j = 0; j < 4; ++j) v[j] = ld4(src + (size_t)(kt2 * 64 + r + 16 * j) * N + nt2 * 64 + c4); }
        const int n = tid >> 2, kc = (tid & 3) * 16;
        u32x4 o0, o1;
#pragma unroll
        for (int i = 0; i < 4; ++i) { o0[i] = pk2(T[(kc + 2 * i) * 65 + n], T[(kc + 2 * i + 1) * 65 + n]); o1[i] = pk2(T[(kc + 8 + 2 * i) * 65 + n], T[(kc + 9 + 2 * i) * 65 + n]); }
        bf16_t* d = dst + (size_t)(nt * 64 + n) * K + kt * 64 + kc;
        *(u32x4*)d = o0; *(u32x4*)(d + 8) = o1;
    }
    __syncthreads();
}
__device__ void convert_experts(const Params& p, int vb, int nvb, char* smem) {
    constexpr int TPM = (D_MODEL / 64) * (D_EXPERT / 64);
    for (int m = 0; m < N_EXPERTS * 3; ++m) {
        const int e = m / 3, which = m % 3;
        const float* src = (which == 0 ? p.w_gate : which == 1 ? p.w_up : p.w_down) + (size_t)e * D_MODEL * D_EXPERT;
        bf16_t* dst = which == 0 ? WSP(bf16_t, WS_WG + (size_t)e * WEXP_BYTES) : which == 1 ? WSP(bf16_t, WS_WU + (size_t)e * WEXP_BYTES) : WSP(bf16_t, wdown_off(e));
        const int K = which == 2 ? D_EXPERT : D_MODEL, N = which == 2 ? D_MODEL : D_EXPERT;
        const int first = ((vb - (m * TPM) % nvb) % nvb + nvb) % nvb;
        convert_transpose(src, dst, K, N, first, TPM, nvb, smem);
    }
}

__device__ void phaseA(const Params& p, int bid, int nblk, char* smem) {
    float* sc = (float*)smem;
    float* red = sc + NMOD * D_MODEL;
    const int tid = threadIdx.x;
    constexpr int NA = 6 * D_MODEL / 16;
    {
        const bool spare = nblk > NA + 32;
        const int vb = spare ? bid - NA : bid, nvb = spare ? nblk - NA : nblk;
        if (!spare || bid >= NA) {
            constexpr int T1 = (D_MODEL / 64) * (D_IN / 64), T2 = (D_MIX / 64) * (D_MODEL / 64);
            convert_transpose(p.w_in, WSP(bf16_t, WS_WBIN), D_MODEL, D_IN, vb, T1, nvb, smem);
            convert_transpose(p.w_out, WSP(bf16_t, WS_WBOUT), D_MIX, D_MODEL, ((vb - T1 % nvb) % nvb + nvb) % nvb, T2, nvb, smem);
        }
        if (spare && bid >= NA) return;
    }
    if (bid >= NA) return;
    __syncthreads();
    for (int i = tid; i < NMOD * D_MODEL; i += 256) {
        const int r = i / D_MODEL, k = i % D_MODEL;
        const float v = (r < BATCH) ? p.c[r * D_MODEL + k] : p.c_ctx[k];
        sc[i] = siluf_(v);
    }
    __syncthreads();
    float* MOD = WSP(float, WS_MOD);
    const int col = tid & 15, kg = tid >> 4;
    constexpr int KPT = D_MODEL / 16;
    for (int cb = bid; cb < 6 * D_MODEL / 16; cb += nblk) {
        const int n = cb * 16 + col;
        float acc[NMOD];
#pragma unroll
        for (int r = 0; r < NMOD; ++r) acc[r] = 0.f;
        const float* wp = p.w_mod + (size_t)(kg * KPT) * (6 * D_MODEL) + n;
#pragma unroll 16
        for (int kk = 0; kk < KPT; ++kk) {
            const float w = wp[(size_t)kk * (6 * D_MODEL)];
#pragma unroll
            for (int r = 0; r < NMOD; ++r) acc[r] += sc[r * D_MODEL + kg * KPT + kk] * w;
        }
#pragma unroll
        for (int r = 0; r < NMOD; ++r) red[(kg * NMOD + r) * 16 + col] = acc[r];
        __syncthreads();
        if (tid < NMOD * 16) {
            const int r = tid >> 4, c2 = tid & 15;
            float s2 = p.b_mod[cb * 16 + c2];
#pragma unroll
            for (int g = 0; g < 16; ++g) s2 += red[(g * NMOD + r) * 16 + c2];
            MOD[(size_t)r * 6 * D_MODEL + cb * 16 + c2] = s2;
        }
        __syncthreads();
    }
}

constexpr int NV = D_MODEL / 256;
__device__ void phaseB(const Params& p, int bid, int nblk, char* smem) {
    const int lane = threadIdx.x & 63, wave = threadIdx.x >> 6;
    const float* MOD = WSP(float, WS_MOD);
    float* STATS = WSP(float, WS_STATS);
    bf16_t* U = WSP(bf16_t, WS_R3);
    for (int row = bid * 4 + wave; row < MTOT; row += nblk * 4) {
        const float* xr = (row < MLAT) ? p.x + (size_t)row * D_MODEL : p.ctx + (size_t)(row - MLAT) * D_MODEL;
        const int mr = (row < MLAT) ? row / SEQ : BATCH;
        const float* md = MOD + (size_t)mr * 6 * D_MODEL;
        f32x4 v0, v1, v2, v3; float s = 0.f;
        v0 = ld4(xr + lane * 4); s += hsum4(v0);
        if (NV > 1) { v1 = ld4(xr + 256 + lane * 4); s += hsum4(v1); } else v1 = f32x4{0.f, 0.f, 0.f, 0.f};
        if (NV > 2) { v2 = ld4(xr + 512 + lane * 4); v3 = ld4(xr + 768 + lane * 4); s += hsum4(v2) + hsum4(v3); } else { v2 = v1; v3 = v1; }
        const float mu = wave_sum(s) * (1.0f / D_MODEL);
        v0 -= mu; float s2 = hsum4(v0 * v0);
        if (NV > 1) { v1 -= mu; s2 += hsum4(v1 * v1); }
        if (NV > 2) { v2 -= mu; v3 -= mu; s2 += hsum4(v2 * v2) + hsum4(v3 * v3); }
        const float rstd = frsq(wave_sum(s2) * (1.0f / D_MODEL) + LN_EPS);
        if (lane == 0) { STATS[row * 2] = mu; STATS[row * 2 + 1] = rstd; }
#pragma unroll
        for (int j = 0; j < NV; ++j) {
            const int k = j * 256 + lane * 4;
            const f32x4 vv = (j == 0) ? v0 : (j == 1) ? v1 : (j == 2) ? v2 : v3;
            const f32x4 h = vv * rstd * ld4(p.ln_in_g + k) + ld4(p.ln_in_b + k);
            *(U2*)(U + (size_t)row * D_MODEL + k) = pack4(h * (1.0f + ld4(md + D_MODEL + k)) + ld4(md + k));
        }
    }
}

constexpr int LDK = 64;
template <int MI, bool DUAL, class Epi>
__device__ __forceinline__ void gemm_tile(char* smem, const bf16_t* A, int lda, const int* rowidx, int m0, const bf16_t* Bt0, const bf16_t* Bt1, int ldb, int n0, int K, Epi epi, const float* rowscale = nullptr, int kscale = 0) {
    constexpr int BM = 32 * MI;
    bf16_t* As = (bf16_t*)smem;
    bf16_t* Bs = As + BM * LDK;
    const int tid = threadIdx.x, lane = tid & 63, wave = tid >> 6, wr = wave >> 1, wc = wave & 1, l15 = lane & 15, q = lane >> 4;
    const int ch = tid & 7, r0 = tid >> 3;
    unsigned aoff[MI], boff[4];
#pragma unroll
    for (int j = 0; j < MI; ++j) { const int r = m0 + r0 + 32 * j; aoff[j] = (unsigned)(rowidx ? rowidx[r] : r) * (unsigned)lda + ch * 8; }
#pragma unroll
    for (int j = 0; j < 4; ++j) boff[j] = (unsigned)(n0 + (DUAL ? (j >> 1) * 32 + r0 : r0 + 32 * j)) * (unsigned)ldb + ch * 8;
    const int wofs = r0 * LDK + ((ch ^ (r0 & 7)) * 8);
    u32x4 ar[MI], br[4];
    f32x4 acc[MI][4];
#pragma unroll
    for (int i = 0; i < MI; ++i)
#pragma unroll
        for (int j = 0; j < 4; ++j) acc[i][j] = f32x4{0.f, 0.f, 0.f, 0.f};
    const int nk = K / 64;
#pragma unroll
    for (int j = 0; j < MI; ++j) ar[j] = *(const u32x4*)(A + aoff[j]);
#pragma unroll
    for (int j = 0; j < 4; ++j) br[j] = *(const u32x4*)(((DUAL && (j & 1)) ? Bt1 : Bt0) + boff[j]);
    for (int kt = 0; kt < nk; ++kt) {
        __syncthreads();
#pragma unroll
        for (int j = 0; j < MI; ++j) *(u32x4*)(As + wofs + 32 * j * LDK) = ar[j];
#pragma unroll
        for (int j = 0; j < 4; ++j) *(u32x4*)(Bs + wofs + 32 * j * LDK) = br[j];
        __syncthreads();
        if (kt + 1 < nk) {
            const int ko = (kt + 1) * 64;
#pragma unroll
            for (int j = 0; j < MI; ++j) ar[j] = *(const u32x4*)(A + aoff[j] + ko);
#pragma unroll
            for (int j = 0; j < 4; ++j) br[j] = *(const u32x4*)(((DUAL && (j & 1)) ? Bt1 : Bt0) + boff[j] + ko);
        }
#pragma unroll
        for (int ks = 0; ks < 2; ++ks) {
            const int cofs = ((ks * 4 + q) ^ (l15 & 7)) * 8;
            bf16x8 bfr[4];
#pragma unroll
            for (int ni = 0; ni < 4; ++ni) bfr[ni] = *(const bf16x8*)(Bs + (wc * 64 + ni * 16 + l15) * LDK + cofs);
#pragma unroll
            for (int mi = 0; mi < MI; ++mi) {
                const bf16x8 af = *(const bf16x8*)(As + (wr * (16 * MI) + mi * 16 + l15) * LDK + cofs);
#pragma unroll
                for (int ni = 0; ni < 4; ++ni) acc[mi][ni] = MFMA16(bfr[ni], af, acc[mi][ni]);
            }
        }
        if (rowscale && kt + 1 == kscale) {
#pragma unroll
            for (int mi = 0; mi < MI; ++mi) {
                const float rs = rowscale[m0 + wr * (16 * MI) + mi * 16 + l15];
#pragma unroll
                for (int ni = 0; ni < 4; ++ni) acc[mi][ni] *= rs;
            }
        }
    }
#pragma unroll
    for (int mi = 0; mi < MI; ++mi) {
        const int ml = wr * (16 * MI) + mi * 16 + l15;
        if (DUAL) {
#pragma unroll
            for (int ni = 0; ni < 2; ++ni) epi(ml, wc * 32 + ni * 16 + q * 4, acc[mi][ni], acc[mi][ni + 2]);
        } else {
#pragma unroll
            for (int ni = 0; ni < 4; ++ni) epi(ml, wc * 64 + ni * 16 + q * 4, acc[mi][ni], acc[mi][ni]);
        }
    }
    __syncthreads();
}

__device__ __forceinline__ int xcd_vbid(int bid, int nblk) { return (nblk % 8 == 0) ? (bid % 8) * (nblk / 8) + bid / 8 : bid; }
constexpr int MI_C = (MTOT % 256 == 0) ? 8 : 4, MI_J = (MLAT % 256 == 0) ? 8 : 4, MI_E = (CAP % 256 == 0) ? 8 : 4;
__device__ void phaseC(const Params& p, int bid, int nblk, char* smem) {
    const bf16_t* U = WSP(bf16_t, WS_R3); const bf16_t* WB = WSP(bf16_t, WS_WBIN);
    bf16_t* P = WSP(bf16_t, WS_R1);
    constexpr int BM = 32 * MI_C, NTN = D_IN / 128, NTM = MTOT / BM;
    constexpr int GM = (NTM % 8 == 0) ? 8 : (NTM % 4 == 0) ? 4 : 1;
    for (int it = xcd_vbid(bid, nblk); it < NTN * NTM; it += nblk) {
        const int mg = it / (GM * NTN), r = it % (GM * NTN), nt = r / GM, mt = mg * GM + (r % GM);
        gemm_tile<MI_C, false>(smem, U, D_MODEL, nullptr, mt * BM, WB, nullptr, D_MODEL, nt * 128, D_MODEL, [&](int ml, int nl, f32x4 v, f32x4) {
            *(U2*)(P + (size_t)(mt * BM + ml) * D_IN + nt * 128 + nl) = pack4(v);
        });
    }
}


template <int NYT, int KS>
__device__ __forceinline__ void mmT(f32x4* acc, const bf16_t* X, int ldx, int xs, const bf16_t* Y, int ldy, int lane) {
#pragma unroll
    for (int ks = 0; ks < KS; ++ks) {
        const bf16x8 xf = *(const bf16x8*)(X + (xs * 16 + (lane & 15)) * ldx + ks * 32 + 8 * (lane >> 4));
#pragma unroll
        for (int nb = 0; nb < NYT; ++nb) {
            const bf16x8 yf = *(const bf16x8*)(Y + (nb * 16 + (lane & 15)) * ldy + ks * 32 + 8 * (lane >> 4));
            acc[nb] = MFMA16(xf, yf, acc[nb]);
        }
    }
}

struct SeqChunk { int base_row; int t0; int len; };
__device__ __forceinline__ SeqChunk lru_chunk(int cg) {
    SeqChunk s;
    if (cg < NLCH) { const int b = cg / (SEQ / 64), ck = cg % (SEQ / 64); s.base_row = b * SEQ; s.t0 = ck * 64; s.len = SEQ; }
    else { const int c2 = cg - NLCH; const int b = c2 / (CTX_LEN / 64), ck = c2 % (CTX_LEN / 64); s.base_row = MLAT + b * CTX_LEN; s.t0 = ck * 64; s.len = CTX_LEN; }
    return s;
}
constexpr int L_XIN = 0;
constexpr int L_GT = 8704;
constexpr int L_XB = L_GT + 9216;
constexpr int L_WT = L_XB + 9216;
constexpr int L_CP = L_WT + 36864;
constexpr int L_END = L_CP + 4096;
static_assert(L_END <= SMEM_BYTES, "lru lds");
__device__ __forceinline__ void lru_load_w(const Params& p, char* smem, int cb) {
    bf16_t* WT = (bf16_t*)(smem + L_WT);
    const int tid = threadIdx.x;
    for (int idx = tid; idx < 4 * 64 * 16; idx += 256) {
        const int m = idx >> 10, i = (idx >> 4) & 63, j4 = (idx & 15) * 4, d = m >> 1;
        const f32x4 w = ld4(((m & 1) ? p.lru_wx : p.lru_wa) + ((size_t)(d * LRU_BLOCKS + cb) * 64 + i) * 64 + j4);
        bf16_t* dst = WT + (m * 64 + j4) * 72 + i;
        dst[0] = f2bf(w[0]); dst[72] = f2bf(w[1]); dst[144] = f2bf(w[2]); dst[216] = f2bf(w[3]);
    }
}
struct LruOut { float a[2][4][4], b[2][4][4]; };
template <bool FINAL>
__device__ __forceinline__ void lru_item(const Params& p, char* smem, int cg, int cb) {
    const bf16_t* P = WSP(bf16_t, WS_R1);
    bf16_t* XIN = (bf16_t*)(smem + L_XIN); bf16_t* GT = (bf16_t*)(smem + L_GT); bf16_t* XB = (bf16_t*)(smem + L_XB); const bf16_t* WT = (const bf16_t*)(smem + L_WT);
    float* CP = (float*)(smem + L_CP);
    const int tid = threadIdx.x, lane = tid & 63, wave = tid >> 6, q = lane >> 4, l15 = lane & 15;
    const SeqChunk sc = lru_chunk(cg);
    __syncthreads();
    for (int idx = tid; idx < 67 * 8; idx += 256) {
        const int tt = idx >> 3, c8 = (idx & 7) * 8, t = sc.t0 - 1 + tt;
        u32x4 v = u32x4{0u, 0u, 0u, 0u};
        if (t >= 0 && t < sc.len) v = *(const u32x4*)(P + (size_t)(sc.base_row + t) * D_IN + cb * 64 + c8);
        *(u32x4*)(XIN + tt * 64 + c8) = v;
    }
    if (FINAL) {
        for (int idx = tid; idx < 64 * 8; idx += 256) {
            const int tt = idx >> 3, c8 = (idx & 7) * 8;
            *(u32x4*)(GT + tt * 72 + c8) = *(const u32x4*)(P + (size_t)(sc.base_row + sc.t0 + tt) * D_IN + D_LRU + cb * 64 + c8);
        }
    }
    __syncthreads();
    {
        const int c = tid & 63, ch = cb * 64 + c;
        const float w0 = p.lru_conv_w[ch], w1 = p.lru_conv_w[D_LRU + ch], w2 = p.lru_conv_w[2 * D_LRU + ch], w3 = p.lru_conv_w[3 * D_LRU + ch], bc = p.lru_conv_b[ch];
#pragma unroll 4
        for (int tt = tid >> 6; tt < 64; tt += 4)
            XB[tt * 72 + c] = f2bf(bc + bf2f(XIN[tt * 64 + c]) * w0 + bf2f(XIN[(tt + 1) * 64 + c]) * w1 + bf2f(XIN[(tt + 2) * 64 + c]) * w2 + bf2f(XIN[(tt + 3) * 64 + c]) * w3);
    }
    __syncthreads();
    float hs[4][4];
    float av[4][4], bv[4][4];
#pragma unroll
    for (int d = 0; d < 2; ++d) {
        f32x4 ga[4], gx[4];
#pragma unroll
        for (int nb = 0; nb < 4; ++nb) { ga[nb] = f32x4{0.f, 0.f, 0.f, 0.f}; gx[nb] = f32x4{0.f, 0.f, 0.f, 0.f}; }
        mmT<4, 2>(ga, XB, 72, wave, WT + (2 * d) * 64 * 72, 72, lane);
        mmT<4, 2>(gx, XB, 72, wave, WT + (2 * d + 1) * 64 * 72, 72, lane);
        float cA[4], cH[4];
#pragma unroll
        for (int nb = 0; nb < 4; ++nb) {
            const int ch = cb * 64 + nb * 16 + l15;
            const float ba = p.lru_ba[d * D_LRU + ch], bx = p.lru_bx[d * D_LRU + ch];
            const float sp8 = -8.0f * softplusf_(-p.lru_lam[d * D_LRU + ch]);
#pragma unroll
            for (int r = 0; r < 4; ++r) {
                const float rg = fsigm(ga[nb][r] + ba), ig = fsigm(gx[nb][r] + bx);
                const float a = FEXP(sp8 * rg);
                const float xv = bf2f(XB[(wave * 16 + q * 4 + r) * 72 + nb * 16 + l15]);
                av[nb][r] = a; bv[nb][r] = fsqrt(fmaxf(1.0f - a * a, 0.f)) * ig * xv;
            }
            float A, H;
            if (d == 0) { A = av[nb][0]; H = bv[nb][0];
#pragma unroll
                for (int r = 1; r < 4; ++r) { H = H * av[nb][r] + bv[nb][r]; A *= av[nb][r]; } }
            else { A = av[nb][3]; H = bv[nb][3];
#pragma unroll
                for (int r = 2; r >= 0; --r) { H = H * av[nb][r] + bv[nb][r]; A *= av[nb][r]; } }
#pragma unroll
            for (int st = 1; st <= 2; st <<= 1) {
                const float pA = d == 0 ? __shfl_up(A, 16 * st) : __shfl_down(A, 16 * st), pH = d == 0 ? __shfl_up(H, 16 * st) : __shfl_down(H, 16 * st);
                const bool has = d == 0 ? (q >= st) : (q + st <= 3);
                if (has) { H = pH * A + H; A = pA * A; }
            }
            cA[nb] = A; cH[nb] = H;
            const bool last = d == 0 ? (q == 3) : (q == 0);
            if (last) { CP[((d * 4 + wave) * 64 + nb * 16 + l15) * 2] = A; CP[((d * 4 + wave) * 64 + nb * 16 + l15) * 2 + 1] = H; }
        }
        __syncthreads();
        if (!FINAL) {
            if (wave == 0 && q == 0) {
#pragma unroll
                for (int nb = 0; nb < 4; ++nb) {
                    const int c = nb * 16 + l15;
                    float A = 1.f, H = 0.f;
#pragma unroll
                    for (int w = 0; w < 4; ++w) { const int ww = d == 0 ? w : 3 - w; const float wa = CP[((d * 4 + ww) * 64 + c) * 2], wh = CP[((d * 4 + ww) * 64 + c) * 2 + 1]; H = H * wa + wh; A *= wa; }
                    WSP(float, WS_SUMA)[((size_t)d * NCH + cg) * D_LRU + cb * 64 + c] = A;
                    WSP(float, WS_SUMH)[((size_t)d * NCH + cg) * D_LRU + cb * 64 + c] = H;
                }
            }
        } else {
#pragma unroll
            for (int nb = 0; nb < 4; ++nb) {
                const int c = nb * 16 + l15;
                float h = WSP(float, WS_CARRY)[((size_t)d * NLCH + cg) * D_LRU + cb * 64 + c];
#pragma unroll
                for (int w = 0; w < 3; ++w) { const int ww = d == 0 ? w : 3 - w; const bool use = d == 0 ? (ww < wave) : (ww > wave);
                    if (use) h = h * CP[((d * 4 + ww) * 64 + c) * 2] + CP[((d * 4 + ww) * 64 + c) * 2 + 1]; }
                const float eA = d == 0 ? __shfl_up(cA[nb], 16) : __shfl_down(cA[nb], 16), eH = d == 0 ? __shfl_up(cH[nb], 16) : __shfl_down(cH[nb], 16);
                const bool first = d == 0 ? (q == 0) : (q == 3);
                if (!first) h = h * eA + eH;
                if (d == 0) {
#pragma unroll
                    for (int r = 0; r < 4; ++r) { h = h * av[nb][r] + bv[nb][r]; hs[nb][r] = h; }
                } else {
#pragma unroll
                    for (int r = 3; r >= 0; --r) { h = h * av[nb][r] + bv[nb][r]; hs[nb][r] += h; }
                }
            }
        }
        __syncthreads();
    }
    if (FINAL) {
        float ss[4] = {0.f, 0.f, 0.f, 0.f};
#pragma unroll
        for (int nb = 0; nb < 4; ++nb) {
            const float gn = p.lru_norm_g[cb * 64 + nb * 16 + l15];
#pragma unroll
            for (int r = 0; r < 4; ++r) {
                const int tt = wave * 16 + q * 4 + r;
                const float v = hs[nb][r] * geluf_(bf2f(GT[tt * 72 + nb * 16 + l15]));
                ss[r] += v * v;
                XB[tt * 72 + nb * 16 + l15] = f2bf(v * gn);
            }
        }
#pragma unroll
        for (int r = 0; r < 4; ++r) {
#pragma unroll
            for (int o = 1; o < 16; o <<= 1) ss[r] += __shfl_xor(ss[r], o);
            if (l15 == 0) WSP(float, WS_SSQP)[(size_t)(sc.base_row + sc.t0 + wave * 16 + q * 4 + r) * LRU_BLOCKS + cb] = ss[r];
        }
        __syncthreads();
        bf16_t* MIX = WSP(bf16_t, WS_R3);
        for (int idx = tid; idx < 64 * 8; idx += 256) {
            const int tt = idx >> 3, c8 = (idx & 7) * 8;
            *(u32x4*)(MIX + (size_t)(sc.base_row + sc.t0 + tt) * D_MIX + cb * 64 + c8) = *(const u32x4*)(XB + tt * 72 + c8);
        }
    }
}
__device__ void phaseD(const Params& p, int bid, int nblk, char* smem) {
    int cur = -1;
    for (int it = bid; it < NCH * LRU_BLOCKS; it += nblk) {
        const int cb = it % LRU_BLOCKS, cg = it / LRU_BLOCKS;
        if (cb != cur) { __syncthreads(); lru_load_w(p, smem, cb); cur = cb; }
        lru_item<false>(p, smem, cg, cb);
    }
}
__device__ void phaseE(const Params& p, int bid, int nblk, char* smem) {
    const float* SUMA = WSP(float, WS_SUMA); const float* SUMH = WSP(float, WS_SUMH); float* CARRY = WSP(float, WS_CARRY);
    constexpr int NLB = SEQ / 64, NCB = CTX_LEN / 64;
    for (int g = bid * 256 + threadIdx.x; g < BATCH * 2 * D_LRU; g += nblk * 256) {
        const int c = g % D_LRU, d = (g / D_LRU) & 1, b = g / (2 * D_LRU);
        const float* sa = SUMA + (size_t)d * NCH * D_LRU + c; const float* sh = SUMH + (size_t)d * NCH * D_LRU + c;
        float* cr = CARRY + (size_t)d * NLCH * D_LRU + c;
        float h = 0.f;
        if (d == 0) {
            for (int q2 = 0; q2 < NCB; ++q2) { const int gi = NLCH + b * NCB + q2; h = sa[(size_t)gi * D_LRU] * h + sh[(size_t)gi * D_LRU]; }
            for (int q2 = 0; q2 < NLB; ++q2) { const int gi = b * NLB + q2; cr[(size_t)gi * D_LRU] = h; h = sa[(size_t)gi * D_LRU] * h + sh[(size_t)gi * D_LRU]; }
        } else {
            for (int q2 = NCB - 1; q2 >= 0; --q2) { const int gi = NLCH + b * NCB + q2; h = sa[(size_t)gi * D_LRU] * h + sh[(size_t)gi * D_LRU]; }
            for (int q2 = NLB - 1; q2 >= 0; --q2) { const int gi = b * NLB + q2; cr[(size_t)gi * D_LRU] = h; h = sa[(size_t)gi * D_LRU] * h + sh[(size_t)gi * D_LRU]; }
        }
    }
}
__device__ void phaseF(const Params& p, int bid, int nblk, char* smem) {
    int cur = -1;
    for (int it = bid; it < NLCH * LRU_BLOCKS; it += nblk) {
        const int cb = it % LRU_BLOCKS, cg = it / LRU_BLOCKS;
        if (cb != cur) { __syncthreads(); lru_load_w(p, smem, cb); cur = cb; }
        lru_item<true>(p, smem, cg, cb);
    }
}

__device__ __forceinline__ size_t rwkv_row(int seg, int b, int s) {
    if (seg == 0) return (size_t)(MLAT + b * CTX_LEN + s);
    const int r = s % ROWS, c = s / ROWS;
    return (size_t)(b * SEQ + r * GRID_W + c);
}
__device__ __forceinline__ void chunk_info(int d, int c, int& seg, int& p0, int& len) {
    if (c < NCC) { seg = 0; len = CTX_LEN; p0 = (d == 0 ? c : NCC - 1 - c) * RC; }
    else { const int cc = c - NCC; seg = 1; len = SEQ; p0 = (d == 0 ? cc : NLC - 1 - cc) * RC; }
}
__device__ __forceinline__ void unpack8(const u32x4 v, float* o) {
    o[0] = bitsf(v[0] << 16); o[1] = bitsf(v[0] & 0xFFFF0000u); o[2] = bitsf(v[1] << 16); o[3] = bitsf(v[1] & 0xFFFF0000u);
    o[4] = bitsf(v[2] << 16); o[5] = bitsf(v[2] & 0xFFFF0000u); o[6] = bitsf(v[3] << 16); o[7] = bitsf(v[3] & 0xFFFF0000u);
}
__device__ __forceinline__ void shifted8(const Params& p, const bf16_t* P, int seg, int b, int pos, int len, int ch0, float* o) {
    float z[8], zp[8], zn[8];
    unpack8(*(const u32x4*)(P + rwkv_row(seg, b, pos) * D_IN + RW0 + ch0), z);
    if (pos > 0) unpack8(*(const u32x4*)(P + rwkv_row(seg, b, pos - 1) * D_IN + RW0 + ch0), zp); else { for (int i = 0; i < 8; ++i) zp[i] = 0.f; }
    if (pos < len - 1) unpack8(*(const u32x4*)(P + rwkv_row(seg, b, pos + 1) * D_IN + RW0 + ch0), zn); else { for (int i = 0; i < 8; ++i) zn[i] = 0.f; }
    const f32x4 mp0 = ld4(p.mu_prev + ch0), mp1 = ld4(p.mu_prev + ch0 + 4), mn0 = ld4(p.mu_next + ch0), mn1 = ld4(p.mu_next + ch0 + 4);
#pragma unroll
    for (int i = 0; i < 4; ++i) { o[i] = z[i] + mp0[i] * (zp[i] - z[i]) + mn0[i] * (zn[i] - z[i]); o[4 + i] = z[4 + i] + mp1[i] * (zp[4 + i] - z[4 + i]) + mn1[i] * (zn[4 + i] - z[4 + i]); }
}
constexpr int LT = 72, LJ = 40;
constexpr int R_RF = 0, R_KF = 8192, R_VF = 16384, R_LW = 24576, R_IC = 32768;
constexpr int R_NKA = 0, R_MBR = 2560, R_MKR = 5120;
constexpr int R_XU = 7680;
constexpr int R_IA = R_XU + 8448, R_IB = R_IA + 4608, R_PA = R_IB + 4608, R_PB = R_PA + 4608;
constexpr int R_WA = R_IB, R_U0 = R_WA + 5120;
static_assert(R_U0 + 5120 <= R_PB + 4608 && R_PB + 4608 <= 40960, "rwkv scratch");
constexpr int R_O = 40960;
constexpr int R_AH = R_O, R_BH = R_AH + 4608, R_KH = R_BH + 4608, R_RH = R_KH + 4608;
constexpr int R_VT = R_RH + 4608, R_BHT = R_VT + 5120, R_KHT = R_BHT + 5120;
constexpr int R_GC = R_KHT + 5120, R_TOT = R_GC + 256, R_END = R_TOT + 1024;
constexpr int R_TW = R_O, R_TA = R_TW + 4608, R_W2T = R_TA + 4608, R_A2T = R_W2T + 9216;
static_assert(R_A2T + 9216 <= R_END && R_END <= SMEM_BYTES, "rwkv lds");

__device__ void phaseR1(const Params& p, int bid, int nblk, char* smem) {
    const bf16_t* P = WSP(bf16_t, WS_R1);
    unsigned char* CH = p.ws + WS_CH;
    float* RBON = WSP(float, WS_RBON);
    float* Rf = (float*)(smem + R_RF); float* Kf = (float*)(smem + R_KF); float* Vf = (float*)(smem + R_VF); float* LW = (float*)(smem + R_LW); float* IC = (float*)(smem + R_IC);
    float* IA = (float*)(smem + R_IA); float* IB = (float*)(smem + R_IB); float* PA = (float*)(smem + R_PA); float* PB = (float*)(smem + R_PB); bf16_t* NkaT = (bf16_t*)(smem + R_NKA); bf16_t* MbrT = (bf16_t*)(smem + R_MBR); bf16_t* MkrT = (bf16_t*)(smem + R_MKR);
    float* Xu = (float*)(smem + R_XU); bf16_t* Wa = (bf16_t*)(smem + R_WA); bf16_t* U0 = (bf16_t*)(smem + R_U0);
    bf16_t* Ah = (bf16_t*)(smem + R_AH); bf16_t* Bh = (bf16_t*)(smem + R_BH); bf16_t* Kh = (bf16_t*)(smem + R_KH); bf16_t* Rh = (bf16_t*)(smem + R_RH);
    bf16_t* VT = (bf16_t*)(smem + R_VT); bf16_t* BhT = (bf16_t*)(smem + R_BHT); bf16_t* KhT = (bf16_t*)(smem + R_KHT);
    float* GC = (float*)(smem + R_GC); float* TOT = (float*)(smem + R_TOT);
    bf16_t* TW = (bf16_t*)(smem + R_TW); bf16_t* TA = (bf16_t*)(smem + R_TA); bf16_t* W2T = (bf16_t*)(smem + R_W2T); bf16_t* A2T = (bf16_t*)(smem + R_A2T);
    const int tid = threadIdx.x, lane = tid & 63, wave = tid >> 6, q = lane >> 4, l15 = lane & 15;
    constexpr int NITEM = NCHAIN * NCK;
    const int per = (NITEM + nblk - 1) / nblk;
    const int it0 = bid * per, it1 = (it0 + per < NITEM) ? it0 + per : NITEM;
    for (int it = it0; it < it1; ++it) {
        const int chain = it / NCK, c = it % NCK;
        const int d = chain & 1, h = (chain >> 1) % HEADS, b = chain / (2 * HEADS);
        int seg, p0, len; chunk_info(d, c, seg, p0, len);
        unsigned char* chp = CH + (size_t)it * CH_BYTES;
        __syncthreads();
        {
            f32x4 wv[8];
#pragma unroll
            for (int k = 0; k < 8; ++k) {
                const int idx = tid + 256 * k, which = idx >> 10, i = (idx >> 4) & 63, j4 = (idx & 15) * 4;
                wv[k] = ld4((which ? p.a2 : p.w2) + ((size_t)d * 64 + i) * D_RWKV + h * 64 + j4);
            }
#pragma unroll
            for (int kb = 0; kb < 5; kb += 2) {
            u32x4 zc[2], zp[2], zn[2];
#pragma unroll
            for (int k = 0; k < 2; ++k) if (kb + k < 5) {
                const int idx = tid + 256 * (kb + k), tau = idx / 40, g = idx % 40, grp = g >> 3, j0 = (g & 7) * 8;
                const int pos = p0 + (d ? RC - 1 - tau : tau);
                const int ch0 = (grp < 3) ? grp * D_RWKV + h * 64 + j0 : (grp == 3 ? 3 * D_RWKV + d * 64 + j0 : 3 * D_RWKV + 128 + d * 64 + j0);
                const u32x4 zero = u32x4{0u, 0u, 0u, 0u};
                zc[k] = *(const u32x4*)(P + rwkv_row(seg, b, pos) * D_IN + RW0 + ch0);
                zp[k] = (pos > 0) ? *(const u32x4*)(P + rwkv_row(seg, b, pos - 1) * D_IN + RW0 + ch0) : zero;
                zn[k] = (pos < len - 1) ? *(const u32x4*)(P + rwkv_row(seg, b, pos + 1) * D_IN + RW0 + ch0) : zero;
            }
#pragma unroll
            for (int k = 0; k < 2; ++k) if (kb + k < 5) {
                const int idx = tid + 256 * (kb + k), tau = idx / 40, g = idx % 40, grp = g >> 3, j0 = (g & 7) * 8;
                const int ch0 = (grp < 3) ? grp * D_RWKV + h * 64 + j0 : (grp == 3 ? 3 * D_RWKV + d * 64 + j0 : 3 * D_RWKV + 128 + d * 64 + j0);
                float z[8], zpv[8], znv[8], o[8];
                unpack8(zc[k], z); unpack8(zp[k], zpv); unpack8(zn[k], znv);
                const f32x4 mp0 = ld4(p.mu_prev + ch0), mp1 = ld4(p.mu_prev + ch0 + 4), mn0 = ld4(p.mu_next + ch0), mn1 = ld4(p.mu_next + ch0 + 4);
#pragma unroll
                for (int e = 0; e < 4; ++e) { o[e] = z[e] + mp0[e] * (zpv[e] - z[e]) + mn0[e] * (znv[e] - z[e]); o[4 + e] = z[4 + e] + mp1[e] * (zpv[4 + e] - z[4 + e]) + mn1[e] * (znv[4 + e] - z[4 + e]); }
                if (grp < 3) {
                    float* dst = (grp == 0 ? Rf : grp == 1 ? Kf : Vf) + tau * 64 + j0;
                    *(f32x4*)dst = f32x4{o[0], o[1], o[2], o[3]}; *(f32x4*)(dst + 4) = f32x4{o[4], o[5], o[6], o[7]};
                } else if (grp == 3) {
                    u32x4 w;
#pragma unroll
                    for (int e = 0; e < 4; ++e) { const float t0 = 2.0f * frcp(1.0f + FEXP(-2.0f * o[2 * e])) - 1.0f, t1 = 2.0f * frcp(1.0f + FEXP(-2.0f * o[2 * e + 1])) - 1.0f; w[e] = pk2(t0, t1); }
                    *(u32x4*)(TW + tau * LT + j0) = w;
                } else {
                    u32x4 w; w[0] = pk2(o[0], o[1]); w[1] = pk2(o[2], o[3]); w[2] = pk2(o[4], o[5]); w[3] = pk2(o[6], o[7]);
                    *(u32x4*)(TA + tau * LT + j0) = w;
                }
            }
            }
#pragma unroll
            for (int k = 0; k < 8; ++k) {
                const int idx = tid + 256 * k, which = idx >> 10, i = (idx >> 4) & 63, j4 = (idx & 15) * 4;
                bf16_t* dst = (which ? A2T : W2T) + j4 * LT + i;
                dst[0] = f2bf(wv[k][0]); dst[LT] = f2bf(wv[k][1]); dst[2 * LT] = f2bf(wv[k][2]); dst[3 * LT] = f2bf(wv[k][3]);
            }
        }
        __syncthreads();
        {
            f32x4 aw[2] = {f32x4{0.f, 0.f, 0.f, 0.f}, f32x4{0.f, 0.f, 0.f, 0.f}}, ai[2] = {f32x4{0.f, 0.f, 0.f, 0.f}, f32x4{0.f, 0.f, 0.f, 0.f}};
            mmT<2, 2>(aw, W2T, LT, wave, TW, LT, lane);
            mmT<2, 2>(ai, A2T, LT, wave, TA, LT, lane);
            const int j = wave * 16 + q * 4;
            const f32x4 w0v = ld4(p.w0 + d * D_RWKV + h * 64 + j), a0v = ld4(p.a0 + d * D_RWKV + h * 64 + j);
#pragma unroll
            for (int nb = 0; nb < 2; ++nb) {
                const int tau = nb * 16 + l15;
                f32x4 lw, ic;
#pragma unroll
                for (int r = 0; r < 4; ++r) { lw[r] = -0.6065306597126334f * fsigm(w0v[r] + aw[nb][r]); ic[r] = fsigm(a0v[r] + ai[nb][r]); }
                *(f32x4*)(LW + tau * 64 + j) = lw; *(f32x4*)(IC + tau * 64 + j) = ic;
            }
        }
        __syncthreads();
        {
            const int j = lane, t0 = wave * 8, chj = h * 64 + j;
            const float kkc = p.k_k[chj], kac = p.k_a[chj], rkc = p.r_k[chj];
            float cum[8], kd[8], kkn[8], icv[8], rr[8], vv[8], run = 0.f;
#pragma unroll
            for (int i = 0; i < 8; ++i) {
                const int t = t0 + i;
                run += LW[t * 64 + j]; cum[i] = run;
                const float kr = Kf[t * 64 + j]; icv[i] = IC[t * 64 + j]; rr[i] = Rf[t * 64 + j]; vv[i] = Vf[t * 64 + j];
                kd[i] = kr * (1.0f + (icv[i] - 1.0f) * kac);
                const float kk = kr * kkc;
                const float n2 = wave_sum(kk * kk);
                kkn[i] = kk * frsq(fmaxf(n2, 1e-24f));
                const float bon = wave_sum(rr[i] * kd[i] * rkc);
                if (lane == 0) RBON[(size_t)it * RC + t] = bon;
            }
            TOT[wave * 64 + j] = run;
            __syncthreads();
            float off = 0.f;
            for (int w = 0; w < wave; ++w) off += TOT[w * 64 + j];
            u32x4 vt, bt, kt;
            float e_prev = 0.f;
#pragma unroll
            for (int i = 0; i < 8; ++i) {
                const int t = t0 + i;
                const float cu = off + cum[i], cprev = (i == 0) ? off : off + cum[i - 1];
                const float g = FEXP(cu), gi = FEXP(-cu), gm = FEXP(cprev);
                const float ah = -kkn[i] * gm, bh = kkn[i] * icv[i] * gi, kh = kd[i] * gi, rh = rr[i] * g;
                Ah[t * LT + j] = f2bf(ah); Bh[t * LT + j] = f2bf(bh); Kh[t * LT + j] = f2bf(kh); Rh[t * LT + j] = f2bf(rh);
                if (i & 1) { vt[i >> 1] = pk2(e_prev, vv[i]); bt[i >> 1] = (bt[i >> 1] & 0xFFFFu) | ((unsigned)f2bf(bh) << 16); kt[i >> 1] = (kt[i >> 1] & 0xFFFFu) | ((unsigned)f2bf(kh) << 16); }
                else { e_prev = vv[i]; bt[i >> 1] = f2bf(bh); kt[i >> 1] = f2bf(kh); }
                if (t == RC - 1) GC[j] = g;
            }
            *(u32x4*)(VT + j * LJ + t0) = vt; *(u32x4*)(BhT + j * LJ + t0) = bt; *(u32x4*)(KhT + j * LJ + t0) = kt;
        }
        __syncthreads();
        {
            const bf16_t* X = (wave == 0) ? Ah : (wave & 1) ? Kh : Bh;
            const bf16_t* Y = (wave == 0) ? Bh : (wave == 1) ? Ah : Rh;
#pragma unroll
            for (int xs = 0; xs < 2; ++xs) {
                f32x4 acc[2] = {f32x4{0.f, 0.f, 0.f, 0.f}, f32x4{0.f, 0.f, 0.f, 0.f}};
                mmT<2, 2>(acc, X, LT, xs, Y, LT, lane);
#pragma unroll
                for (int nb = 0; nb < 2; ++nb) {
                    const int yy = nb * 16 + l15, x0 = xs * 16 + q * 4;
                    f32x4 v = acc[nb];
#pragma unroll
                    for (int r = 0; r < 4; ++r) { const int xx = x0 + r; const bool keep = (wave == 0) ? (yy < xx) : (wave == 1) ? (xx < yy) : (xx <= yy); v[r] = keep ? v[r] : 0.f; }
                    if (wave == 0) { *(f32x4*)(PA + yy * 36 + x0) = v; f32x4 t0 = v; for (int r = 0; r < 4; ++r) t0[r] += (x0 + r == yy) ? 1.0f : 0.0f; *(f32x4*)(IA + yy * 36 + x0) = t0; }
                    else { bf16_t* dst = (wave == 1 ? NkaT : wave == 2 ? MbrT : MkrT) + yy * LJ + x0; *(U2*)dst = pack4(v); }
                }
            }
        }
        __syncthreads();
        {
#pragma unroll
            for (int xs = 0; xs < 2; ++xs) {
                f32x4 acc[1] = {f32x4{0.f, 0.f, 0.f, 0.f}};
                mmT<1, 1>(acc, NkaT, LJ, xs, VT + wave * 16 * LJ, LJ, lane);
                const int i = wave * 16 + l15, tb = xs * 16 + q * 4;
                Xu[i * 33 + tb] = acc[0][0]; Xu[i * 33 + tb + 1] = acc[0][1]; Xu[i * 33 + tb + 2] = acc[0][2]; Xu[i * 33 + tb + 3] = acc[0][3];
            }
        }
        __syncthreads();
        {
            auto mm32 = [&](float* Z, const float* init, const float* L, const float* R, int ti, int tj) {
                f32x4 acc = f32x4{0.f, 0.f, 0.f, 0.f};
                if (init) { for (int r = 0; r < 4; ++r) acc[r] = init[(ti * 16 + q * 4 + r) * 36 + tj * 16 + l15]; }
#pragma unroll
                for (int k0 = 0; k0 < 32; k0 += 4) acc = MFMAF32(L[(ti * 16 + l15) * 36 + k0 + q], R[(k0 + q) * 36 + tj * 16 + l15], acc);
#pragma unroll
                for (int r = 0; r < 4; ++r) Z[(ti * 16 + q * 4 + r) * 36 + tj * 16 + l15] = acc[r];
            };
            const int ti = wave >> 1, tj = wave & 1;
            mm32(PB, nullptr, PA, PA, ti, tj);
            __syncthreads();
            mm32(IB, IA, IA, PB, ti, tj); mm32(PA, nullptr, PB, PB, ti, tj);
            __syncthreads();
            mm32(IA, IB, IB, PA, ti, tj); mm32(PB, nullptr, PA, PA, ti, tj);
            __syncthreads();
            mm32(IB, IA, IA, PB, ti, tj); mm32(PA, nullptr, PB, PB, ti, tj);
            __syncthreads();
            f32x4 accw[2], accu[2];
            mm32(IA, IB, IB, PA, ti, tj);
            __syncthreads();
#pragma unroll
            for (int tc = 0; tc < 2; ++tc) { accw[tc] = f32x4{0.f, 0.f, 0.f, 0.f}; accu[tc] = f32x4{0.f, 0.f, 0.f, 0.f}; }
#pragma unroll
            for (int k0 = 0; k0 < 32; k0 += 4) {
                const float la = bf2f(Ah[(k0 + q) * LT + wave * 16 + l15]), lu = Xu[(wave * 16 + l15) * 33 + k0 + q];
#pragma unroll
                for (int tc = 0; tc < 2; ++tc) { const float rv = IA[(k0 + q) * 36 + tc * 16 + l15]; accw[tc] = MFMAF32(la, rv, accw[tc]); accu[tc] = MFMAF32(lu, rv, accu[tc]); }
            }
            __syncthreads();
#pragma unroll
            for (int tc = 0; tc < 2; ++tc)
#pragma unroll
                for (int r = 0; r < 4; ++r) { const int row = wave * 16 + q * 4 + r, col = tc * 16 + l15; Wa[row * LJ + col] = f2bf(accw[tc][r]); U0[row * LJ + col] = f2bf(accu[tc][r]); }
        }
        __syncthreads();
        {
            bf16_t* gPm = (bf16_t*)(chp + CH_PM); bf16_t* gSA = (bf16_t*)(chp + CH_SA); bf16_t* gQT = (bf16_t*)(chp + CH_QT); bf16_t* gY0 = (bf16_t*)(chp + CH_Y0);
            const int x0 = wave * 16 + q * 4;
            {
                f32x4 acc[4] = {f32x4{0.f, 0.f, 0.f, 0.f}, f32x4{0.f, 0.f, 0.f, 0.f}, f32x4{0.f, 0.f, 0.f, 0.f}, f32x4{0.f, 0.f, 0.f, 0.f}};
                mmT<4, 1>(acc, Wa, LJ, wave, BhT, LJ, lane);
#pragma unroll
                for (int nb = 0; nb < 4; ++nb) {
                    const int jp = nb * 16 + l15; const float g = GC[jp];
                    f32x4 v = acc[nb];
#pragma unroll
                    for (int r = 0; r < 4; ++r) v[r] = (v[r] + ((x0 + r == jp) ? 1.0f : 0.0f)) * g;
                    *(U2*)(gPm + jp * 64 + x0) = pack4(v);
                }
            }
            {
                f32x4 acc[4] = {f32x4{0.f, 0.f, 0.f, 0.f}, f32x4{0.f, 0.f, 0.f, 0.f}, f32x4{0.f, 0.f, 0.f, 0.f}, f32x4{0.f, 0.f, 0.f, 0.f}};
                mmT<4, 1>(acc, BhT, LJ, wave, U0, LJ, lane);
                mmT<4, 1>(acc, KhT, LJ, wave, VT, LJ, lane);
                const f32x4 g = *(const f32x4*)(GC + x0);
#pragma unroll
                for (int nb = 0; nb < 4; ++nb) *(U2*)(gSA + (nb * 16 + l15) * 64 + x0) = pack4(acc[nb] * g);
            }
            if (seg == 1) {
                {
                    f32x4 acc[2] = {f32x4{0.f, 0.f, 0.f, 0.f}, f32x4{0.f, 0.f, 0.f, 0.f}};
                    mmT<2, 1>(acc, Wa, LJ, wave, MbrT, LJ, lane);
#pragma unroll
                    for (int nb = 0; nb < 2; ++nb) {
                        const int t = nb * 16 + l15;
                        f32x4 v = acc[nb];
#pragma unroll
                        for (int r = 0; r < 4; ++r) v[r] += bf2f(Rh[t * LT + x0 + r]);
                        *(U2*)(gQT + t * 64 + x0) = pack4(v);
                    }
                }
                {
                    f32x4 acc[2] = {f32x4{0.f, 0.f, 0.f, 0.f}, f32x4{0.f, 0.f, 0.f, 0.f}};
                    mmT<2, 1>(acc, U0, LJ, wave, MbrT, LJ, lane);
                    mmT<2, 1>(acc, VT, LJ, wave, MkrT, LJ, lane);
#pragma unroll
                    for (int nb = 0; nb < 2; ++nb) *(U2*)(gY0 + (nb * 16 + l15) * 64 + x0) = pack4(acc[nb]);
                }
            }
        }
    }
}

__device__ __forceinline__ U2 ldu2(const bf16_t* p) { return *(const U2*)p; }
constexpr int R2D = 6, R2LD = 72;
__device__ void phaseR2(const Params& p, int bid, int nblk, char* smem) {
    unsigned char* CH = p.ws + WS_CH;
    bf16_t* PL = (bf16_t*)smem;
    const int tid = threadIdx.x, lane = tid & 63, wave = tid >> 6, q = lane >> 4, l15 = lane & 15;
    const int lrow = wave * 16 + (lane >> 2), lcol = (lane & 3) * 16;
    for (int chain = bid; chain < NCHAIN; chain += nblk) {
        const int i = wave * 16 + l15;
        unsigned char* chbase = CH + (size_t)chain * NCK * CH_BYTES;
        f32x4 st[4];
#pragma unroll
        for (int nt = 0; nt < 4; ++nt) st[nt] = f32x4{0.f, 0.f, 0.f, 0.f};
        u32x4 pq[R2D][2]; U2 sa[R2D][4];
#pragma unroll
        for (int k = 0; k < R2D; ++k) {
            const unsigned char* chp = chbase + (size_t)(k < NCK ? k : NCK - 1) * CH_BYTES;
            const bf16_t* gp = (const bf16_t*)(chp + CH_PM) + lrow * 64 + lcol;
            pq[k][0] = *(const u32x4*)gp; pq[k][1] = *(const u32x4*)(gp + 8);
#pragma unroll
            for (int nt = 0; nt < 4; ++nt) sa[k][nt] = ldu2((const bf16_t*)(chp + CH_SA) + i * 64 + nt * 16 + 4 * q);
        }
#pragma unroll 1
        for (int c0 = 0; c0 < NCK; c0 += R2D) {
#pragma unroll
            for (int k = 0; k < R2D; ++k) {
                const int c = c0 + k;
                if (c < NCK) {
                bf16_t* pl = PL + (k & 1) * 64 * R2LD;
                *(u32x4*)(pl + lrow * R2LD + lcol) = pq[k][0]; *(u32x4*)(pl + lrow * R2LD + lcol + 8) = pq[k][1];
                const U2 s0 = sa[k][0], s1 = sa[k][1], s2 = sa[k][2], s3 = sa[k][3];
                {
                    const int cn = (c + R2D < NCK) ? c + R2D : NCK - 1;
                    const unsigned char* chp = chbase + (size_t)cn * CH_BYTES;
                    const bf16_t* gp = (const bf16_t*)(chp + CH_PM) + lrow * 64 + lcol;
                    pq[k][0] = *(const u32x4*)gp; pq[k][1] = *(const u32x4*)(gp + 8);
#pragma unroll
                    for (int nt = 0; nt < 4; ++nt) sa[k][nt] = ldu2((const bf16_t*)(chp + CH_SA) + i * 64 + nt * 16 + 4 * q);
                }
                __syncthreads();
                bf16_t* gSA = (bf16_t*)(chbase + (size_t)c * CH_BYTES + CH_SA) + i * 64 + 4 * q;
                bf16x8 bfr[2];
#pragma unroll
                for (int ks = 0; ks < 2; ++ks) {
                    const U2 lo = pack4(st[2 * ks]), hi = pack4(st[2 * ks + 1]);
                    bfr[ks] = __builtin_bit_cast(bf16x8, u32x4{lo.x, lo.y, hi.x, hi.y});
                    *(U2*)(gSA + (2 * ks) * 16) = lo; *(U2*)(gSA + (2 * ks + 1) * 16) = hi;
                }
#pragma unroll
                for (int nt = 0; nt < 4; ++nt) {
                    const U2 sv = nt == 0 ? s0 : nt == 1 ? s1 : nt == 2 ? s2 : s3;
                    f32x4 acc = f32x4{bitsf(sv.x << 16), bitsf(sv.x & 0xFFFF0000u), bitsf(sv.y << 16), bitsf(sv.y & 0xFFFF0000u)};
#pragma unroll
                    for (int ks = 0; ks < 2; ++ks) {
                        const U2 lo = *(const U2*)(pl + (nt * 16 + l15) * R2LD + 32 * ks + 4 * q), hi = *(const U2*)(pl + (nt * 16 + l15) * R2LD + 32 * ks + 16 + 4 * q);
                        acc = MFMA16(__builtin_bit_cast(bf16x8, u32x4{lo.x, lo.y, hi.x, hi.y}), bfr[ks], acc);
                    }
                    st[nt] = acc;
                }
                }
            }
        }
        __syncthreads();
    }
}

__device__ void phaseR3(const Params& p, int bid, int nblk, char* smem) {
    const bf16_t* P = WSP(bf16_t, WS_R1);
    const unsigned char* CH = p.ws + WS_CH;
    const float* RBON = WSP(float, WS_RBON);
    bf16_t* MIX = WSP(bf16_t, WS_R3);
    float* red = (float*)smem;
    const int tid = threadIdx.x, lane = tid & 63, wave = tid >> 6, q = lane >> 4, l15 = lane & 15;
    for (int m = bid * 256 + tid; m < MLAT; m += nblk * 256) {
        const float* sp = WSP(float, WS_SSQP) + (size_t)m * LRU_BLOCKS;
        float sq = 0.f;
#pragma unroll
        for (int c = 0; c < LRU_BLOCKS; ++c) sq += sp[c];
        WSP(float, WS_RINV)[m] = frsq(sq * (1.0f / D_LRU) + RMS_EPS);
    }
    bf16_t* G2T = (bf16_t*)(smem + 1024);
    const int nbh = nblk / HEADS;
    int hcur = -1;
    const bool uniform = (nbh > 0) && (nblk % HEADS == 0);
    const int nrest = BATCH * NLC;
    for (int itx = uniform ? (bid % nbh) : bid; itx < (uniform ? nrest : nrest * HEADS); itx += uniform ? nbh : nblk) {
        int h, rest;
        if (uniform) { h = bid / nbh; rest = itx; } else { h = itx % HEADS; rest = itx / HEADS; }
        const int pc = rest % NLC, b = rest / NLC;
        if (h != hcur) {
            __syncthreads();
            for (int idx = tid; idx < 128 * 16; idx += 256) {
                const int c = idx >> 4, i4 = (idx & 15) * 4;
                const f32x4 w = ld4(p.g2 + (size_t)c * D_RWKV + h * 64 + i4);
                bf16_t* dst = G2T + i4 * 136 + c;
                dst[0] = f2bf(w[0]); dst[136] = f2bf(w[1]); dst[272] = f2bf(w[2]); dst[408] = f2bf(w[3]);
            }
            hcur = h;
            __syncthreads();
        }
        const int i0 = wave * 16 + q * 4;
        f32x4 y[2] = {f32x4{0.f, 0.f, 0.f, 0.f}, f32x4{0.f, 0.f, 0.f, 0.f}};
        float bon[2] = {0.f, 0.f};
#pragma unroll
        for (int d = 0; d < 2; ++d) {
            const int chain = (b * HEADS + h) * 2 + d, c = NCC + (d ? NLC - 1 - pc : pc);
            const size_t item = (size_t)chain * NCK + c;
            const unsigned char* chp = CH + item * CH_BYTES;
            const bf16_t* gS = (const bf16_t*)(chp + CH_SA); const bf16_t* gQT = (const bf16_t*)(chp + CH_QT); const bf16_t* gY0 = (const bf16_t*)(chp + CH_Y0);
#pragma unroll
            for (int nb = 0; nb < 2; ++nb) {
                const int pl = nb * 16 + l15, tau = d ? RC - 1 - pl : pl;
                const U2 y0 = ldu2(gY0 + tau * 64 + i0);
                f32x4 acc = f32x4{bitsf(y0.x << 16), bitsf(y0.x & 0xFFFF0000u), bitsf(y0.y << 16), bitsf(y0.y & 0xFFFF0000u)};
#pragma unroll
                for (int ks = 0; ks < 2; ++ks) {
                    const bf16x8 xf = *(const bf16x8*)(gS + (wave * 16 + l15) * 64 + ks * 32 + 8 * q);
                    const bf16x8 yf = *(const bf16x8*)(gQT + tau * 64 + ks * 32 + 8 * q);
                    acc = MFMA16(xf, yf, acc);
                }
                y[nb] += acc;
                bon[nb] += RBON[item * RC + tau];
            }
        }
        f32x4 g[2] = {f32x4{0.f, 0.f, 0.f, 0.f}, f32x4{0.f, 0.f, 0.f, 0.f}};
#pragma unroll
        for (int ks = 0; ks < 4; ++ks) {
            const bf16x8 xf = *(const bf16x8*)(G2T + (wave * 16 + l15) * 136 + ks * 32 + 8 * q);
#pragma unroll
            for (int nb = 0; nb < 2; ++nb) {
                const int pos = pc * RC + nb * 16 + l15;
                float o[8]; shifted8(p, P, 1, b, pos, SEQ, 3 * D_RWKV + 256 + ks * 32 + 8 * q, o);
                u32x4 t; t[0] = pk2(fsigm(o[0]), fsigm(o[1])); t[1] = pk2(fsigm(o[2]), fsigm(o[3])); t[2] = pk2(fsigm(o[4]), fsigm(o[5])); t[3] = pk2(fsigm(o[6]), fsigm(o[7]));
                g[nb] = MFMA16(xf, __builtin_bit_cast(bf16x8, t), g[nb]);
            }
        }
        float s1[2], s2[2];
#pragma unroll
        for (int nb = 0; nb < 2; ++nb) {
            float a = hsum4(y[nb]), bq = hsum4(y[nb] * y[nb]);
            a += __shfl_xor(a, 16); a += __shfl_xor(a, 32); bq += __shfl_xor(bq, 16); bq += __shfl_xor(bq, 32);
            s1[nb] = a; s2[nb] = bq;
        }
        __syncthreads();
        if (q == 0) { red[(0 * 4 + wave) * 32 + l15] = s1[0]; red[(0 * 4 + wave) * 32 + 16 + l15] = s1[1]; red[(1 * 4 + wave) * 32 + l15] = s2[0]; red[(1 * 4 + wave) * 32 + 16 + l15] = s2[1]; }
        __syncthreads();
        const f32x4 gng = ld4(p.gn_g + h * 64 + i0), gnb = ld4(p.gn_b + h * 64 + i0);
#pragma unroll
        for (int nb = 0; nb < 2; ++nb) {
            const int pl = nb * 16 + l15, pos = pc * RC + pl;
            float t1 = 0.f, t2 = 0.f;
#pragma unroll
            for (int w = 0; w < 4; ++w) { t1 += red[(0 * 4 + w) * 32 + pl]; t2 += red[(1 * 4 + w) * 32 + pl]; }
            const float mu = t1 * (1.0f / 64.0f), var = fmaxf(t2 * (1.0f / 64.0f) - mu * mu, 0.f), rstd = frsq(var + GN_EPS);
            const int chv = 2 * D_RWKV + h * 64 + i0;
            const size_t mrow = rwkv_row(1, b, pos);
            const U2 zc = ldu2(P + mrow * D_IN + RW0 + chv);
            U2 zp; zp.x = 0u; zp.y = 0u; U2 zn = zp;
            if (pos > 0) zp = ldu2(P + rwkv_row(1, b, pos - 1) * D_IN + RW0 + chv);
            if (pos < SEQ - 1) zn = ldu2(P + rwkv_row(1, b, pos + 1) * D_IN + RW0 + chv);
            const f32x4 z = f32x4{bitsf(zc.x << 16), bitsf(zc.x & 0xFFFF0000u), bitsf(zc.y << 16), bitsf(zc.y & 0xFFFF0000u)};
            const f32x4 zpv = f32x4{bitsf(zp.x << 16), bitsf(zp.x & 0xFFFF0000u), bitsf(zp.y << 16), bitsf(zp.y & 0xFFFF0000u)};
            const f32x4 znv = f32x4{bitsf(zn.x << 16), bitsf(zn.x & 0xFFFF0000u), bitsf(zn.y << 16), bitsf(zn.y & 0xFFFF0000u)};
            const f32x4 v = z + ld4(p.mu_prev + chv) * (zpv - z) + ld4(p.mu_next + chv) * (znv - z);
            const f32x4 yn = (y[nb] - mu) * rstd * gng + gnb;
            *(U2*)(MIX + mrow * D_MIX + D_LRU + h * 64 + i0) = pack4((yn + bon[nb] * v) * g[nb]);
        }
    }
}

__device__ void phaseJ(const Params& p, int bid, int nblk, char* smem) {
    const bf16_t* MIX = WSP(bf16_t, WS_R3); const bf16_t* WB = WSP(bf16_t, WS_WBOUT);
    float* YOUT = WSP(float, WS_R1);
    const float* RINV = WSP(float, WS_RINV);
    constexpr int BM = 32 * MI_J, NTN = D_MODEL / 128, NTM = MLAT / BM;
    constexpr int GM = (NTM % 8 == 0) ? 8 : 1;
    for (int it = xcd_vbid(bid, nblk); it < NTN * NTM; it += nblk) {
        const int mg = it / (GM * NTN), r = it % (GM * NTN), nt = r / GM, mt = mg * GM + (r % GM);
        gemm_tile<MI_J, false>(smem, MIX, D_MIX, nullptr, mt * BM, WB, nullptr, D_MIX, nt * 128, D_MIX, [&](int ml, int nl, f32x4 v, f32x4) {
            *(f32x4*)(YOUT + (size_t)(mt * BM + ml) * D_MODEL + nt * 128 + nl) = v;
        }, RINV, D_LRU / 64);
    }
}

constexpr int KUL = D_MODEL + 2;
static_assert((16 * KUL + 4 * 256) * 4 <= SMEM_BYTES && N_EXPERTS <= 16 && MLAT % 16 == 0, "phase K lds");
__device__ void phaseK(const Params& p, int bid, int nblk, char* smem) {
    const int tid = threadIdx.x, lane = tid & 63, wave = tid >> 6, q = lane >> 4, l15 = lane & 15;
    const float* MOD = WSP(float, WS_MOD); const float* STATS = WSP(float, WS_STATS);
    const float* YOUT = WSP(float, WS_R1);
    float* H1 = WSP(float, WS_R5); bf16_t* U2b = WSP(bf16_t, WS_R6); float* AFF = WSP(float, WS_AFF);
    float* UL = (float*)smem;
    float* PL = UL + 16 * KUL;
    for (int rb = bid; rb < MLAT / 16; rb += nblk) {
        __syncthreads();
#pragma unroll 1
        for (int rr = 0; rr < 4; ++rr) {
            const int lr = wave * 4 + rr, row = rb * 16 + lr;
            const float* xr = p.x + (size_t)row * D_MODEL;
            const float* md = MOD + (size_t)(row / SEQ) * 6 * D_MODEL;
            const float mu0 = STATS[row * 2], rs0 = STATS[row * 2 + 1];
            f32x4 v0, v1, v2, v3; float s = 0.f;
#define PK_LOAD(V, J) { const int k = (J) * 256 + lane * 4; \
            V = ALPHA_F * ((ld4(xr + k) - mu0) * rs0 * ld4(p.ln_in_g + k) + ld4(p.ln_in_b + k)) + ld4(md + 2 * D_MODEL + k) * ld4(YOUT + (size_t)row * D_MODEL + k); s += hsum4(V); }
            PK_LOAD(v0, 0)
            if (NV > 1) PK_LOAD(v1, 1) else v1 = f32x4{0.f, 0.f, 0.f, 0.f};
            if (NV > 2) { PK_LOAD(v2, 2) PK_LOAD(v3, 3) } else { v2 = v1; v3 = v1; }
#undef PK_LOAD
            const float mu = wave_sum(s) * (1.0f / D_MODEL);
            v0 -= mu; float s2 = hsum4(v0 * v0);
            if (NV > 1) { v1 -= mu; s2 += hsum4(v1 * v1); }
            if (NV > 2) { v2 -= mu; v3 -= mu; s2 += hsum4(v2 * v2) + hsum4(v3 * v3); }
            const float rstd = frsq(wave_sum(s2) * (1.0f / D_MODEL) + LN_EPS);
#pragma unroll
            for (int j = 0; j < NV; ++j) {
                const int k = j * 256 + lane * 4;
                const f32x4 vv = (j == 0) ? v0 : (j == 1) ? v1 : (j == 2) ? v2 : v3;
                const f32x4 h = vv * rstd * ld4(p.ln1_g + k) + ld4(p.ln1_b + k);
                *(f32x4*)(H1 + (size_t)row * D_MODEL + k) = h;
                const f32x4 u = h * (1.0f + ld4(md + 4 * D_MODEL + k)) + ld4(md + 3 * D_MODEL + k);
                *(U2*)(U2b + (size_t)row * D_MODEL + k) = pack4(u);
                float* ul = UL + lr * KUL + k;
                *(f32x2_e*)ul = f32x2_e{u[0], u[1]}; *(f32x2_e*)(ul + 2) = f32x2_e{u[2], u[3]};
            }
        }
        __syncthreads();
        {
            f32x4 acc = f32x4{0.f, 0.f, 0.f, 0.f};
            const int kq0 = wave * (D_MODEL / 4);
#pragma unroll 8
            for (int s4 = 0; s4 < D_MODEL / 16; ++s4) {
                const int k = kq0 + s4 * 4 + q;
                const float av = UL[l15 * KUL + k];
                const float bv = (l15 < N_EXPERTS) ? p.w_router[(size_t)k * N_EXPERTS + l15] : 0.f;
                acc = MFMAF32(av, bv, acc);
            }
#pragma unroll
            for (int r = 0; r < 4; ++r) PL[wave * 256 + (q * 4 + r) * 16 + l15] = acc[r];
        }
        __syncthreads();
        {
            const int lr = tid >> 4, e = tid & 15;
            const bool valid = e < N_EXPERTS;
            float lg = PL[tid] + PL[256 + tid] + PL[512 + tid] + PL[768 + tid];
            float mx = valid ? lg : -3.0e38f;
#pragma unroll
            for (int o = 1; o < 16; o <<= 1) mx = fmaxf(mx, __shfl_xor(mx, o));
            const float ex = valid ? expf(lg - mx) : 0.f;
            float den = ex;
#pragma unroll
            for (int o = 1; o < 16; o <<= 1) den += __shfl_xor(den, o);
            if (valid) AFF[(size_t)(rb * 16 + lr) * N_EXPERTS + e] = ex / den;
        }
    }
}

__device__ __forceinline__ int block_sum_int(int v, int* red) {
    const int lane = threadIdx.x & 63, wave = threadIdx.x >> 6;
#pragma unroll
    for (int o = 1; o < 64; o <<= 1) v += __shfl_xor(v, o);
    __syncthreads();
    if (lane == 0) red[wave] = v;
    __syncthreads();
    return red[0] + red[1] + red[2] + red[3];
}
__device__ void phaseL(const Params& p, int bid, int nblk, char* smem) {
    const float* AFF = WSP(float, WS_AFF);
    int* IDX = WSP(int, WS_IDX); float* GATE = WSP(float, WS_GATE); int* SLOTOF = WSP(int, WS_SLOT);
    unsigned* vals = (unsigned*)smem;
    int* red = (int*)(vals + SEQ);
    int* wsum = red + 8;
    const int tid = threadIdx.x, lane = tid & 63, wave = tid >> 6;
    constexpr int PER = SEQ / 256;
    {
        constexpr int NL = BATCH * N_EXPERTS;
        const bool spare = nblk > NL + 32;
        if (spare ? (bid >= NL) : true) convert_experts(p, spare ? bid - NL : bid, spare ? nblk - NL : nblk, smem);
        if (spare && bid >= NL) return;
        __syncthreads();
    }
    for (int be = bid; be < BATCH * N_EXPERTS; be += nblk) {
        const int b = be / N_EXPERTS, e = be % N_EXPERTS;
        __syncthreads();
        for (int t = tid; t < SEQ; t += 256) vals[t] = fbits(AFF[((size_t)b * SEQ + t) * N_EXPERTS + e]);
        __syncthreads();
        unsigned lo = 0u, hi = 0x7F800000u;
        while (lo < hi) {
            const unsigned mid = lo + (hi - lo + 1u) / 2u;
            int c = 0;
            for (int t = tid; t < SEQ; t += 256) c += (vals[t] >= mid) ? 1 : 0;
            c = block_sum_int(c, red);
            if (c >= CAP) lo = mid; else hi = mid - 1u;
        }
        const unsigned T = lo;
        int cg = 0, ce = 0;
        for (int q = 0; q < PER; ++q) { const unsigned v = vals[tid * PER + q]; cg += (v > T) ? 1 : 0; ce += (v == T) ? 1 : 0; }
        int pg = cg, pe = ce;
#pragma unroll
        for (int o = 1; o < 64; o <<= 1) { const int a = __shfl_up(pg, o), bb = __shfl_up(pe, o); if (lane >= o) { pg += a; pe += bb; } }
        __syncthreads();
        if (lane == 63) { wsum[wave] = pg; wsum[4 + wave] = pe; }
        __syncthreads();
        int og = 0, oe = 0, totg = 0;
        for (int w = 0; w < 4; ++w) { if (w < wave) { og += wsum[w]; oe += wsum[4 + w]; } totg += wsum[w]; }
        int posg = og + pg - cg, pose = oe + pe - ce;
        const int need_eq = CAP - totg;
        for (int q = 0; q < PER; ++q) {
            const int t = tid * PER + q; const unsigned v = vals[t];
            int slot = -1;
            if (v > T) { slot = posg++; }
            else if (v == T) { if (pose < need_eq) slot = totg + pose; pose++; }
            if (slot >= 0) { IDX[(size_t)be * CAP + slot] = b * SEQ + t; GATE[(size_t)be * CAP + slot] = bitsf(v); }
            SLOTOF[((size_t)b * SEQ + t) * N_EXPERTS + e] = slot;
        }
    }
}

__device__ void phaseM(const Params& p, int bid, int nblk, char* smem) {
    const bf16_t* U2b = WSP(bf16_t, WS_R6); const int* IDX = WSP(int, WS_IDX);
    bf16_t* HID = WSP(bf16_t, WS_R1);
    constexpr int BM = 32 * MI_E, NTN = D_EXPERT / 64, NTM = CAP / BM;
    for (int it = xcd_vbid(bid, nblk); it < BATCH * N_EXPERTS * NTM * NTN; it += nblk) {
        const int mt = it % NTM, b = (it / NTM) % BATCH, nt = (it / (NTM * BATCH)) % NTN, e = it / (NTM * BATCH * NTN), be = b * N_EXPERTS + e;
        const bf16_t* wg = WSP(bf16_t, WS_WG + (size_t)e * WEXP_BYTES); const bf16_t* wu = WSP(bf16_t, WS_WU + (size_t)e * WEXP_BYTES);
        gemm_tile<MI_E, true>(smem, U2b, D_MODEL, IDX + (size_t)be * CAP, mt * BM, wg, wu, D_MODEL, nt * 64, D_MODEL, [&](int ml, int nl, f32x4 g, f32x4 u) {
            U2 o; o.x = pk2(siluf_(g[0]) * u[0], siluf_(g[1]) * u[1]); o.y = pk2(siluf_(g[2]) * u[2], siluf_(g[3]) * u[3]);
            *(U2*)(HID + ((size_t)be * CAP + mt * BM + ml) * D_EXPERT + nt * 64 + nl) = o;
        });
    }
}
__device__ void phaseN(const Params& p, int bid, int nblk, char* smem) {
    const bf16_t* HID = WSP(bf16_t, WS_R1); const float* GATE = WSP(float, WS_GATE);
    bf16_t* YS = WSP(bf16_t, WS_R2);
    constexpr int BM = 32 * MI_E, NTN = D_MODEL / 128, NTM = CAP / BM;
    for (int it = xcd_vbid(bid, nblk); it < BATCH * N_EXPERTS * NTM * NTN; it += nblk) {
        const int mt = it % NTM, b = (it / NTM) % BATCH, nt = (it / (NTM * BATCH)) % NTN, e = it / (NTM * BATCH * NTN), be = b * N_EXPERTS + e;
        const bf16_t* wd = WSP(bf16_t, wdown_off(e));
        gemm_tile<MI_E, false>(smem, HID + (size_t)be * CAP * D_EXPERT, D_EXPERT, nullptr, mt * BM, wd, nullptr, D_EXPERT, nt * 128, D_EXPERT, [&](int ml, int nl, f32x4 v, f32x4) {
            const int slot = mt * BM + ml;
            const float gt = GATE[(size_t)be * CAP + slot];
            *(U2*)(YS + ((size_t)be * CAP + slot) * D_MODEL + nt * 128 + nl) = pack4(v * gt);
        });
    }
}
__device__ void phaseO(const Params& p, int bid, int nblk, char* smem) {
    const int lane = threadIdx.x & 63, wave = threadIdx.x >> 6;
    const float* MOD = WSP(float, WS_MOD); const float* H1 = WSP(float, WS_R5); const bf16_t* YS = WSP(bf16_t, WS_R2); const int* SLOTOF = WSP(int, WS_SLOT);
    for (int row = bid * 4 + wave; row < MLAT; row += nblk * 4) {
        const float* md = MOD + (size_t)(row / SEQ) * 6 * D_MODEL;
        f32x4 v0, v1, v2, v3; float s = 0.f;
        f32x4 y0 = f32x4{0.f, 0.f, 0.f, 0.f}, y1 = y0, y2 = y0, y3 = y0;
        const int myslot = (lane < N_EXPERTS) ? SLOTOF[(size_t)row * N_EXPERTS + lane] : -1;
        const int bbase = (row / SEQ) * N_EXPERTS;
        for (int e = 0; e < N_EXPERTS; ++e) {
            const int sl = __shfl(myslot, e);
            if (sl >= 0) {
                const bf16_t* yr = YS + ((size_t)(bbase + e) * CAP + sl) * D_MODEL + lane * 4;
                { const U2 u = *(const U2*)yr; y0 += f32x4{bitsf(u.x << 16), bitsf(u.x & 0xFFFF0000u), bitsf(u.y << 16), bitsf(u.y & 0xFFFF0000u)}; }
                if (NV > 1) { const U2 u = *(const U2*)(yr + 256); y1 += f32x4{bitsf(u.x << 16), bitsf(u.x & 0xFFFF0000u), bitsf(u.y << 16), bitsf(u.y & 0xFFFF0000u)}; }
                if (NV > 2) { const U2 u = *(const U2*)(yr + 512); y2 += f32x4{bitsf(u.x << 16), bitsf(u.x & 0xFFFF0000u), bitsf(u.y << 16), bitsf(u.y & 0xFFFF0000u)};
                              const U2 w = *(const U2*)(yr + 768); y3 += f32x4{bitsf(w.x << 16), bitsf(w.x & 0xFFFF0000u), bitsf(w.y << 16), bitsf(w.y & 0xFFFF0000u)}; }
            }
        }
#define PO_LOAD(V, J) { const int k = (J) * 256 + lane * 4; const f32x4 yy = ((J) == 0) ? y0 : ((J) == 1) ? y1 : ((J) == 2) ? y2 : y3; V = ALPHA_F * ld4(H1 + (size_t)row * D_MODEL + k) + ld4(md + 5 * D_MODEL + k) * yy; s += hsum4(V); }
        PO_LOAD(v0, 0)
        if (NV > 1) PO_LOAD(v1, 1) else v1 = f32x4{0.f, 0.f, 0.f, 0.f};
        if (NV > 2) { PO_LOAD(v2, 2) PO_LOAD(v3, 3) } else { v2 = v1; v3 = v1; }
#undef PO_LOAD
        const float mu = wave_sum(s) * (1.0f / D_MODEL);
        v0 -= mu; float s2 = hsum4(v0 * v0);
        if (NV > 1) { v1 -= mu; s2 += hsum4(v1 * v1); }
        if (NV > 2) { v2 -= mu; v3 -= mu; s2 += hsum4(v2 * v2) + hsum4(v3 * v3); }
        const float rstd = frsq(wave_sum(s2) * (1.0f / D_MODEL) + LN_EPS);
#pragma unroll
        for (int j = 0; j < NV; ++j) {
            const int k = j * 256 + lane * 4;
            const f32x4 vv = (j == 0) ? v0 : (j == 1) ? v1 : (j == 2) ? v2 : v3;
            *(f32x4*)(p.out + (size_t)row * D_MODEL + k) = vv * rstd * ld4(p.ln2_g + k) + ld4(p.ln2_b + k);
        }
    }
}

#define XB_TMO      128
#define XB_XCNT(j)  (256  + 64 * (j))
#define XB_XSUB(j)  (1280 + 64 * (j))
#define XB_XGEN(j)  (2304 + 64 * (j))
#define XB_TOP      3328
#define XB_TOPGEN   3392
#define XCD_BAR_WORDS 3456
#define XB_SPIN_CAP (1u << 22)
#ifndef HOST_EMU
__device__ __forceinline__ unsigned xb_ld(unsigned* p) { return __hip_atomic_load(p, __ATOMIC_RELAXED, __HIP_MEMORY_SCOPE_AGENT); }
__device__ __forceinline__ unsigned xb_add(unsigned* p, unsigned v) { return __hip_atomic_fetch_add(p, v, __ATOMIC_RELAXED, __HIP_MEMORY_SCOPE_AGENT); }
__device__ __forceinline__ unsigned xb_xcc_id() { return (unsigned)__builtin_amdgcn_s_getreg((3 << 11) | 20) & 0xFu; }
#define XB_SPIN(cond, bar) do { unsigned _sp = 0; while (cond) { __builtin_amdgcn_s_sleep(1); \
    if ((++_sp & 255u) == 0u) { if (xb_ld(&(bar)[XB_TMO])) break; if (_sp > XB_SPIN_CAP) { atomicAdd(&(bar)[XB_TMO], 1u); break; } } } } while (0)
#define XB_LAS __attribute__((address_space(3)))
struct XcdBarrier { unsigned off; unsigned x; volatile XB_LAS unsigned* st; unsigned G; };
__device__ __forceinline__ XcdBarrier xcd_barrier_post(unsigned* ctrl, unsigned off, volatile XB_LAS unsigned* st, unsigned G, bool member = true) {
    XcdBarrier b; b.off = off; b.x = xb_xcc_id(); b.st = st; b.G = G; unsigned* bar = ctrl + off;
    if (!member) return b;
    if (threadIdx.x == 0) (void)xb_add(&bar[XB_XCNT(b.x)], 1u);
    return b;
}
__device__ __forceinline__ void xcd_barrier_complete(unsigned* bar, unsigned x, unsigned& nloc, unsigned& nx, unsigned G) {
    unsigned sum, cnt, mine, sp = 0u;
    for (;;) {
        sum = 0u; cnt = 0u; mine = 0u;
#pragma unroll
        for (unsigned j = 0; j < 16; ++j) { const unsigned c = xb_ld(&bar[XB_XCNT(j)]); sum += c; cnt += (c > 0u) ? 1u : 0u; mine = (j == x) ? c : mine; }
        if (sum == G) break;
        __builtin_amdgcn_s_sleep(1);
        if ((++sp & 255u) == 0u) { if (xb_ld(&bar[XB_TMO])) break; if (sp > XB_SPIN_CAP) { atomicAdd(&bar[XB_TMO], 1u); break; } }
    }
    nloc = mine > 0u ? mine : 1u; nx = cnt > 0u ? cnt : 1u;
}
__device__ __forceinline__ void grid_barrier(const XcdBarrier& b, unsigned* ctrl) {
    asm volatile("s_waitcnt vmcnt(0)" ::: "memory");
    __syncthreads();
    if (threadIdx.x == 0) {
        unsigned* bar = ctrl + b.off;
        __builtin_amdgcn_s_waitcnt(0);
        volatile XB_LAS unsigned* st = b.st;
        unsigned nloc = st[0], nx = st[1];
        if (nloc == 0u) { xcd_barrier_complete(bar, b.x, nloc, nx, b.G); st[0] = nloc; st[1] = nx; }
        const unsigned old = xb_add(&bar[XB_XSUB(b.x)], 1u);
        const unsigned gen = old / nloc;
        if (old + 1u == (gen + 1u) * nloc) {
            __builtin_amdgcn_fence(__ATOMIC_RELEASE, "agent");
            asm volatile("s_waitcnt vmcnt(0)" ::: "memory");
            const unsigned og = xb_add(&bar[XB_TOP], 1u);
            const unsigned tg = og / nx;
            if (og + 1u == (tg + 1u) * nx) xb_add(&bar[XB_TOPGEN], 1u);
            else XB_SPIN(xb_ld(&bar[XB_TOPGEN]) == tg, bar);
            __builtin_amdgcn_fence(__ATOMIC_ACQUIRE, "agent");
            xb_add(&bar[XB_XGEN(b.x)], 1u);
            asm volatile("s_waitcnt vmcnt(0)" ::: "memory");
        } else {
            XB_SPIN(xb_ld(&bar[XB_XGEN(b.x)]) == gen, bar);
            __builtin_amdgcn_fence(__ATOMIC_ACQUIRE, "agent");
            asm volatile("s_waitcnt vmcnt(0)" ::: "memory");
        }
    }
    __syncthreads();
}
#else
struct XcdBarrier { int dummy; };
__device__ __forceinline__ void grid_barrier(const XcdBarrier&, unsigned*) { __syncthreads(); }
#endif

__global__ void __launch_bounds__(256, 2) fused_forward(Params p) {
    __shared__ __attribute__((aligned(16))) char smem[SMEM_BYTES];
    __shared__ __attribute__((aligned(16))) unsigned xb_words[4];
    if (threadIdx.x == 0) { xb_words[0] = 0u; xb_words[1] = 0u; xb_words[2] = 0u; xb_words[3] = 0u; }
    __syncthreads();
    const int bid = blockIdx.x, nblk = gridDim.x;
    const bool split = nblk >= 2 * NCHAIN;
#ifdef HOST_EMU
    const XcdBarrier gb{0}; const XcdBarrier gs{0};
#else
    const XcdBarrier gb = xcd_barrier_post(WSP(unsigned, WS_CTRL), 0u, (volatile XB_LAS unsigned*)xb_words, (unsigned)nblk);
    const XcdBarrier gs = xcd_barrier_post(WSP(unsigned, WS_CTRL), (unsigned)XCD_BAR_WORDS, (volatile XB_LAS unsigned*)xb_words + 2, (unsigned)(nblk - NCHAIN), split && bid >= NCHAIN);
#endif
    phaseA(p, bid, nblk, smem); grid_barrier(gb, WSP(unsigned, WS_CTRL));
    phaseB(p, bid, nblk, smem); grid_barrier(gb, WSP(unsigned, WS_CTRL));
    phaseC(p, bid, nblk, smem); grid_barrier(gb, WSP(unsigned, WS_CTRL));
    phaseD(p, bid, nblk, smem);
    phaseR1(p, bid, nblk, smem); grid_barrier(gb, WSP(unsigned, WS_CTRL));
    {
        const int lb = split ? bid - NCHAIN : bid, ln = split ? nblk - NCHAIN : nblk;
        const bool lru_member = !split || bid >= NCHAIN;
        if (!split || bid < NCHAIN) phaseR2(p, bid, split ? NCHAIN : nblk, smem);
        if (lru_member) phaseE(p, lb, ln, smem);
        if (split) { if (lru_member) grid_barrier(gs, WSP(unsigned, WS_CTRL)); } else grid_barrier(gb, WSP(unsigned, WS_CTRL));
        if (lru_member) phaseF(p, lb, ln, smem);
        grid_barrier(gb, WSP(unsigned, WS_CTRL));
    }
    phaseR3(p, bid, nblk, smem); grid_barrier(gb, WSP(unsigned, WS_CTRL));
    phaseJ(p, bid, nblk, smem); grid_barrier(gb, WSP(unsigned, WS_CTRL));
    phaseK(p, bid, nblk, smem); grid_barrier(gb, WSP(unsigned, WS_CTRL));
    phaseL(p, bid, nblk, smem); grid_barrier(gb, WSP(unsigned, WS_CTRL));
    phaseM(p, bid, nblk, smem); grid_barrier(gb, WSP(unsigned, WS_CTRL));
    phaseN(p, bid, nblk, smem); grid_barrier(gb, WSP(unsigned, WS_CTRL));
    phaseO(p, bid, nblk, smem);
}

#ifdef MULTI_LAUNCH
#define PHASE_KERNEL(NAME) \
    __global__ void __launch_bounds__(256) k_##NAME(Params p) { __shared__ __attribute__((aligned(16))) char smem[SMEM_BYTES]; NAME(p, blockIdx.x, gridDim.x, smem); }
PHASE_KERNEL(phaseA) PHASE_KERNEL(phaseB) PHASE_KERNEL(phaseC) PHASE_KERNEL(phaseD) PHASE_KERNEL(phaseE) PHASE_KERNEL(phaseF) PHASE_KERNEL(phaseR1) PHASE_KERNEL(phaseR2) PHASE_KERNEL(phaseR3)
PHASE_KERNEL(phaseJ) PHASE_KERNEL(phaseK) PHASE_KERNEL(phaseL) PHASE_KERNEL(phaseM) PHASE_KERNEL(phaseN) PHASE_KERNEL(phaseO)
#ifdef HOST_EMU
void emu_hook(const char* name, const Params& p);
#define LAUNCH(NAME, grid) do { EMU_LAUNCH(k_##NAME, grid, 256, p); emu_hook(#NAME, p); } while (0)
#else
#define LAUNCH(NAME, grid) hipLaunchKernelGGL(k_##NAME, dim3(grid), dim3(256), 0, stream, p)
#endif
#endif

extern "C" void kernel_launch(void* const* d_in, const int* in_sizes, int n_in, void* d_out, int out_size, void* d_ws, size_t ws_size, hipStream_t stream) {
    if (n_in != 38 || out_size != MLAT * D_MODEL || ws_size < WS_END) { fprintf(stderr, "kernel_launch: unexpected shapes (n_in %d out %d ws %zu need %zu)\n", n_in, out_size, ws_size, (size_t)WS_END); return; }
    Params p{};
    const float** f = (const float**)&p;
    for (int i = 0; i < 38; ++i) f[i] = (const float*)d_in[i];
    p.out = (float*)d_out; p.ws = (unsigned char*)d_ws;
#ifdef MULTI_LAUNCH
    const int G = 512;
    LAUNCH(phaseA, 6 * D_MODEL / 16);
    LAUNCH(phaseB, G);
    LAUNCH(phaseC, G);
    LAUNCH(phaseD, G);
    LAUNCH(phaseE, 16);
    LAUNCH(phaseF, G);
    LAUNCH(phaseR1, G);
    LAUNCH(phaseR2, NCHAIN);
    LAUNCH(phaseR3, G);
    LAUNCH(phaseJ, G);
    LAUNCH(phaseK, G);
    LAUNCH(phaseL, BATCH * N_EXPERTS);
    LAUNCH(phaseM, G);
    LAUNCH(phaseN, G);
    LAUNCH(phaseO, G);
#elif defined(HOST_EMU)
    EMU_LAUNCH(fused_forward, 1, 256, p);
#else
    static int grid_blocks = 0;
    if (!grid_blocks) {
        int dev = 0, cus = 0, per_cu = 0;
        (void)hipGetDevice(&dev);
        (void)hipDeviceGetAttribute(&cus, hipDeviceAttributeMultiprocessorCount, dev);
        (void)hipOccupancyMaxActiveBlocksPerMultiprocessor(&per_cu, fused_forward, 256, 0);
        if (per_cu > 2) per_cu = 2;
        if (per_cu < 1) { fprintf(stderr, "kernel_launch: occupancy query returned %d blocks per CU\n", per_cu); per_cu = 1; }
        grid_blocks = cus * per_cu;
    }
    (void)hipMemsetAsync((char*)d_ws + WS_CTRL, 0, 2 * XCD_BAR_WORDS * 4, stream);
    void* args[] = {&p};
    hipError_t e = hipLaunchCooperativeKernel((void*)fused_forward, dim3(grid_blocks), dim3(256), args, 0, stream);
    if (e != hipSuccess) fprintf(stderr, "cooperative launch failed: %s (grid %d)\n", hipGetErrorString(e), grid_blocks);
#endif
}
```

```cpp
#ifndef HOST_EMU
#include <hip/hip_runtime.h>
#include <cstdio>
#endif
#include <cstdint>
#include <cstddef>

#ifdef CFG_SMALL
constexpr int D_MODEL = 256, BATCH = 2, SEQ = 256, GRID_W = 16, CTX_LEN = 64, LRU_BLOCKS = 2, N_EXPERTS = 4, D_EXPERT = 256;
#else
constexpr int D_MODEL = 1024, BATCH = 4, SEQ = 4096, GRID_W = 64, CTX_LEN = 256, LRU_BLOCKS = 8, N_EXPERTS = 16, D_EXPERT = 1408;
#endif
constexpr int ROWS = SEQ / GRID_W;
constexpr int D_LRU = D_MODEL / 2, LRU_BLOCK = 64;
constexpr int D_RWKV = D_MODEL / 2, HEADS = D_RWKV / 64;
constexpr int D_RWKV_IN = 3 * D_RWKV + 128 + 128 + 128;
constexpr int D_IN = 2 * D_LRU + D_RWKV_IN;
constexpr int D_MIX = D_LRU + D_RWKV;
constexpr int CAP = 2 * SEQ / N_EXPERTS;
constexpr int MLAT = BATCH * SEQ, MCTX = BATCH * CTX_LEN, MTOT = MLAT + MCTX;
constexpr int NMOD = BATCH + 1;
constexpr int RW0 = 2 * D_LRU;
constexpr float ALPHA_F = 1.189207115002721f;
constexpr float LN_EPS = 1e-5f, GN_EPS = 64e-5f, RMS_EPS = 1e-6f;
static_assert(LRU_BLOCKS * LRU_BLOCK == D_LRU, "lru blocks");
static_assert(CAP % 128 == 0 && D_IN % 128 == 0 && D_EXPERT % 64 == 0 && D_MODEL % 128 == 0 && MTOT % 128 == 0 && D_MIX % 64 == 0, "tile divisibility");

typedef unsigned short bf16_t;
typedef short bf16x8 __attribute__((ext_vector_type(8)));
typedef float f32x4 __attribute__((ext_vector_type(4)));
typedef unsigned u32x4 __attribute__((ext_vector_type(4)));
typedef float f32x2_e __attribute__((ext_vector_type(2)));
struct alignas(16) F4 { float x, y, z, w; };
typedef unsigned U2 __attribute__((ext_vector_type(2)));
struct alignas(16) U4 { unsigned x, y, z, w; };

#ifdef HOST_EMU
#define MFMA16(a, b, c) emu_mfma_16x16x32_bf16(a, b, c)
#define MFMAF32(a, b, c) emu_mfma_16x16x4_f32(a, b, c)
#else
#define MFMA16(a, b, c) __builtin_amdgcn_mfma_f32_16x16x32_bf16(a, b, c, 0, 0, 0)
#define MFMAF32(a, b, c) __builtin_amdgcn_mfma_f32_16x16x4f32(a, b, c, 0, 0, 0)
#endif

__device__ __forceinline__ unsigned fbits(float f) { return __builtin_bit_cast(unsigned, f); }
__device__ __forceinline__ float bitsf(unsigned u) { return __builtin_bit_cast(float, u); }
__device__ __forceinline__ bf16_t f2bf(float f) { unsigned u = fbits(f); u += 0x7FFFu + ((u >> 16) & 1u); return (bf16_t)(u >> 16); }
__device__ __forceinline__ float bf2f(bf16_t h) { return bitsf(((unsigned)h) << 16); }
#ifdef HOST_EMU
__device__ __forceinline__ unsigned pk2(float lo, float hi) { return (unsigned)f2bf(lo) | ((unsigned)f2bf(hi) << 16); }
#else
typedef float f32x2_t __attribute__((ext_vector_type(2)));
typedef __bf16 bf16x2_t __attribute__((ext_vector_type(2)));
__device__ __forceinline__ unsigned pk2(float lo, float hi) { return __builtin_bit_cast(unsigned, __builtin_convertvector(f32x2_t{lo, hi}, bf16x2_t)); }
#endif
__device__ __forceinline__ float sigmoidf_(float x) { return 1.0f / (1.0f + expf(-x)); }
__device__ __forceinline__ float softplusf_(float x) { return fmaxf(x, 0.0f) + log1pf(expf(-fabsf(x))); }
#ifdef HOST_EMU
#define FEXP(x) expf(x)
#else
#define FEXP(x) __expf(x)
#endif
#ifdef HOST_EMU
__device__ __forceinline__ float frcp(float x) { return 1.0f / x; }
__device__ __forceinline__ float frsq(float x) { return 1.0f / sqrtf(x); }
__device__ __forceinline__ float fsqrt(float x) { return sqrtf(x); }
#else
__device__ __forceinline__ float frcp(float x) { return __builtin_amdgcn_rcpf(x); }
__device__ __forceinline__ float frsq(float x) { return __builtin_amdgcn_rsqf(x); }
__device__ __forceinline__ float fsqrt(float x) { return __builtin_amdgcn_sqrtf(x); }
#endif
__device__ __forceinline__ float fsigm(float x) { return frcp(1.0f + FEXP(-x)); }
__device__ __forceinline__ float siluf_(float x) { return x * fsigm(x); }
__device__ __forceinline__ float geluf_(float x) { return x * fsigm(1.5957691216057308f * (x + 0.044715f * x * x * x)); }
__device__ __forceinline__ float wave_sum(float v) {
#pragma unroll
    for (int o = 1; o < 64; o <<= 1) v += __shfl_xor(v, o);
    return v;
}

constexpr size_t al256(size_t x) { return (x + 255) & ~(size_t)255; }
constexpr int NLCH = BATCH * (SEQ / 64), NCCH = BATCH * (CTX_LEN / 64), NCH = NLCH + NCCH;
constexpr size_t WS_CTRL = 0;
constexpr size_t WS_MOD = 65536;
constexpr size_t WS_STATS = al256(WS_MOD + (size_t)NMOD * 6 * D_MODEL * 4);
constexpr size_t WS_SUMA = al256(WS_STATS + (size_t)MTOT * 2 * 4);
constexpr size_t WS_SUMH = al256(WS_SUMA + (size_t)2 * NCH * D_LRU * 4);
constexpr size_t WS_CARRY = al256(WS_SUMH + (size_t)2 * NCH * D_LRU * 4);
constexpr size_t WS_SSQP = al256(WS_CARRY + (size_t)2 * NLCH * D_LRU * 4);
constexpr size_t WS_RINV = al256(WS_SSQP + (size_t)MLAT * LRU_BLOCKS * 4);
constexpr size_t WS_BON = al256(WS_RINV + (size_t)MLAT * 4);
constexpr size_t WS_AFF = al256(WS_BON + (size_t)2 * MLAT * HEADS * 4 + 4096 * 64);
constexpr size_t WS_IDX = al256(WS_AFF + (size_t)MLAT * N_EXPERTS * 4);
constexpr size_t WS_GATE = al256(WS_IDX + (size_t)BATCH * N_EXPERTS * CAP * 4);
constexpr size_t WS_SLOT = al256(WS_GATE + (size_t)BATCH * N_EXPERTS * CAP * 4);
constexpr size_t WS_WBIN = al256(WS_SLOT + (size_t)MLAT * N_EXPERTS * 4);
constexpr size_t WS_WBOUT = al256(WS_WBIN + (size_t)D_IN * D_MODEL * 2);
constexpr size_t WS_R1 = al256(WS_WBOUT + (size_t)D_MODEL * D_MIX * 2);
constexpr size_t R1_BYTES = (size_t)MTOT * D_IN * 2 > (size_t)MLAT * D_MODEL * 4 ? ((size_t)MTOT * D_IN * 2 > (size_t)BATCH * N_EXPERTS * CAP * D_EXPERT * 2 ? (size_t)MTOT * D_IN * 2 : (size_t)BATCH * N_EXPERTS * CAP * D_EXPERT * 2)
                                                                                  : ((size_t)MLAT * D_MODEL * 4 > (size_t)BATCH * N_EXPERTS * CAP * D_EXPERT * 2 ? (size_t)MLAT * D_MODEL * 4 : (size_t)BATCH * N_EXPERTS * CAP * D_EXPERT * 2);
constexpr size_t WS_R3 = al256(WS_R1 + R1_BYTES);
constexpr int RC = 32;
constexpr int NCC = CTX_LEN / RC, NLC = SEQ / RC, NCK = NCC + NLC, NCHAIN = BATCH * HEADS * 2;
constexpr size_t CH_PM = 0, CH_SA = 8192, CH_QT = 16384, CH_Y0 = 20480, CH_BYTES = 24576;
constexpr size_t WS_CH = al256(WS_R3 + (size_t)MTOT * D_MODEL * 2);
constexpr size_t CH_TOTAL = (size_t)NCHAIN * NCK * CH_BYTES;
constexpr size_t WS_R5 = WS_CH;
constexpr size_t WS_LA = al256(WS_R5 + (size_t)MLAT * D_MODEL * 4);
constexpr size_t WS_R6 = WS_LA, WS_R2 = WS_LA;
constexpr size_t WEXP_BYTES = (size_t)D_MODEL * D_EXPERT * 2;
constexpr size_t WS_WG = al256(WS_LA + (size_t)MLAT * D_MODEL * 2);
constexpr size_t WS_WU = WS_WG + (size_t)N_EXPERTS * WEXP_BYTES;
constexpr int NE_R3 = ((size_t)MTOT * D_MODEL * 2 / WEXP_BYTES) < (size_t)N_EXPERTS ? (int)((size_t)MTOT * D_MODEL * 2 / WEXP_BYTES) : N_EXPERTS;
constexpr size_t WS_WD2 = WS_WU + (size_t)N_EXPERTS * WEXP_BYTES;
constexpr size_t WS_LATE_END = al256(WS_WD2 + (size_t)(N_EXPERTS - NE_R3) * WEXP_BYTES);
static_assert(WS_LA + (size_t)BATCH * N_EXPERTS * CAP * D_MODEL * 2 <= WS_WD2, "YS must not reach the w_down copies");
constexpr size_t WS_END = (WS_CH + CH_TOTAL > WS_LATE_END) ? al256(WS_CH + CH_TOTAL) : WS_LATE_END;
constexpr size_t WS_RBON = WS_BON;
static_assert((size_t)NCHAIN * NCK * RC * 4 <= (size_t)2 * MLAT * HEADS * 4 + 4096 * 64, "bonus buffer");

struct Params {
    const float *x, *c, *ctx, *c_ctx, *ln_in_g, *ln_in_b, *w_mod, *b_mod, *w_in, *lru_conv_w, *lru_conv_b, *lru_wa, *lru_ba, *lru_wx, *lru_bx, *lru_lam, *lru_norm_g,
        *mu_prev, *mu_next, *w0, *w2, *a0, *a2, *g2, *k_k, *k_a, *r_k, *gn_g, *gn_b, *w_out, *ln1_g, *ln1_b, *w_router, *w_gate, *w_up, *w_down, *ln2_g, *ln2_b;
    float* out;
    unsigned char* ws;
};
#define WSP(T, off) ((T*)(p.ws + (off)))
__device__ __forceinline__ size_t wdown_off(int e) { return e < NE_R3 ? WS_R3 + (size_t)e * WEXP_BYTES : WS_WD2 + (size_t)(e - NE_R3) * WEXP_BYTES; }

constexpr int SMEM_BYTES = 76 * 1024;

__device__ __forceinline__ f32x4 ld4(const float* p) { return *(const f32x4*)p; }
__device__ __forceinline__ f32x4 ldb4(const bf16_t* p) { const U2 u = *(const U2*)p; return f32x4{bitsf(u.x << 16), bitsf(u.x & 0xFFFF0000u), bitsf(u.y << 16), bitsf(u.y & 0xFFFF0000u)}; }
__device__ __forceinline__ float hsum4(f32x4 v) { return (v[0] + v[1]) + (v[2] + v[3]); }
__device__ __forceinline__ U2 pack4(f32x4 v) { U2 o; o.x = pk2(v[0], v[1]); o.y = pk2(v[2], v[3]); return o; }
__device__ __forceinline__ void convert_transpose(const float* src, bf16_t* dst, int K, int N, int t0, int t1, int tstride, char* smem) {
    float* T = (float*)smem;
    const int tid = threadIdx.x, r = tid >> 4, c4 = (tid & 15) * 4, ntn = N / 64;
    f32x4 v[4];
    if (t0 < t1) { const int kt = t0 / ntn, nt = t0 % ntn;
#pragma unroll
        for (int j = 0; j < 4; ++j) v[j] = ld4(src + (size_t)(kt * 64 + r + 16 * j) * N + nt * 64 + c4); }
    for (int t = t0; t < t1; t += tstride) {
        const int kt = t / ntn, nt = t % ntn;
        __syncthreads();
#pragma unroll
        for (int j = 0; j < 4; ++j) { float* d = T + (r + 16 * j) * 65 + c4; d[0] = v[j][0]; d[1] = v[j][1]; d[2] = v[j][2]; d[3] = v[j][3]; }
        __syncthreads();
        if (t + tstride < t1) { const int kt2 = (t + tstride) / ntn, nt2 = (t + tstride) % ntn;
#pragma unroll
            for (int j = 0; j < 4; ++j) v[j] = ld4(src + (size_t)(kt2 * 64 + r + 16 * j) * N + nt2 * 64 + c4); }
        const int n = tid >> 2, kc = (tid & 3) * 16;
        u32x4 o0, o1;
#pragma unroll
        for (int i = 0; i < 4; ++i) { o0[i] = pk2(T[(kc + 2 * i) * 65 + n], T[(kc + 2 * i + 1) * 65 + n]); o1[i] = pk2(T[(kc + 8 + 2 * i) * 65 + n], T[(kc + 9 + 2 * i) * 65 + n]); }
        bf16_t* d = dst + (size_t)(nt * 64 + n) * K + kt * 64 + kc;
        *(u32x4*)d = o0; *(u32x4*)(d + 8) = o1;
    }
    __syncthreads();
}
__device__ void convert_experts(const Params& p, int vb, int nvb, char* smem, int first, int last) {
    constexpr int TPM = (D_MODEL / 64) * (D_EXPERT / 64);
    int m = 0;
    for (int e = 0; e < N_EXPERTS; ++e)
        for (int which = first; which < last; ++which, ++m) {
            const float* src = (which == 0 ? p.w_gate : which == 1 ? p.w_up : p.w_down) + (size_t)e * D_MODEL * D_EXPERT;
            bf16_t* dst = which == 0 ? WSP(bf16_t, WS_WG + (size_t)e * WEXP_BYTES) : which == 1 ? WSP(bf16_t, WS_WU + (size_t)e * WEXP_BYTES) : WSP(bf16_t, wdown_off(e));
            const int K = which == 2 ? D_EXPERT : D_MODEL, N = which == 2 ? D_MODEL : D_EXPERT;
            const int start = ((vb - (m * TPM) % nvb) % nvb + nvb) % nvb;
            convert_transpose(src, dst, K, N, start, TPM, nvb, smem);
        }
}

__device__ void phaseA(const Params& p, int bid, int nblk, char* smem) {
    float* sc = (float*)smem;
    float* red = sc + NMOD * D_MODEL;
    const int tid = threadIdx.x;
    constexpr int NA = 6 * D_MODEL / 16;
    {
        const bool spare = nblk > NA + 32;
        const int vb = spare ? bid - NA : bid, nvb = spare ? nblk - NA : nblk;
        if (!spare || bid >= NA) {
            constexpr int T1 = (D_MODEL / 64) * (D_IN / 64), T2 = (D_MIX / 64) * (D_MODEL / 64);
            convert_transpose(p.w_in, WSP(bf16_t, WS_WBIN), D_MODEL, D_IN, vb, T1, nvb, smem);
            convert_transpose(p.w_out, WSP(bf16_t, WS_WBOUT), D_MIX, D_MODEL, ((vb - T1 % nvb) % nvb + nvb) % nvb, T2, nvb, smem);
        }
        if (spare && bid >= NA) return;
    }
    if (bid >= NA) return;
    __syncthreads();
    for (int i = tid; i < NMOD * D_MODEL; i += 256) {
        const int r = i / D_MODEL, k = i % D_MODEL;
        const float v = (r < BATCH) ? p.c[r * D_MODEL + k] : p.c_ctx[k];
        sc[i] = siluf_(v);
    }
    __syncthreads();
    float* MOD = WSP(float, WS_MOD);
    const int col = tid & 15, kg = tid >> 4;
    constexpr int KPT = D_MODEL / 16;
    for (int cb = bid; cb < 6 * D_MODEL / 16; cb += nblk) {
        const int n = cb * 16 + col;
        float acc[NMOD];
#pragma unroll
        for (int r = 0; r < NMOD; ++r) acc[r] = 0.f;
        const float* wp = p.w_mod + (size_t)(kg * KPT) * (6 * D_MODEL) + n;
#pragma unroll 16
        for (int kk = 0; kk < KPT; ++kk) {
            const float w = wp[(size_t)kk * (6 * D_MODEL)];
#pragma unroll
            for (int r = 0; r < NMOD; ++r) acc[r] += sc[r * D_MODEL + kg * KPT + kk] * w;
        }
#pragma unroll
        for (int r = 0; r < NMOD; ++r) red[(kg * NMOD + r) * 16 + col] = acc[r];
        __syncthreads();
        if (tid < NMOD * 16) {
            const int r = tid >> 4, c2 = tid & 15;
            float s2 = p.b_mod[cb * 16 + c2];
#pragma unroll
            for (int g = 0; g < 16; ++g) s2 += red[(g * NMOD + r) * 16 + c2];
            MOD[(size_t)r * 6 * D_MODEL + cb * 16 + c2] = s2;
        }
        __syncthreads();
    }
}

constexpr int NV = D_MODEL / 256;
__device__ void phaseB(const Params& p, int bid, int nblk, char* smem) {
    const int lane = threadIdx.x & 63, wave = threadIdx.x >> 6;
    const float* MOD = WSP(float, WS_MOD);
    float* STATS = WSP(float, WS_STATS);
    bf16_t* U = WSP(bf16_t, WS_R3);
    for (int row = bid * 4 + wave; row < MTOT; row += nblk * 4) {
        const float* xr = (row < MLAT) ? p.x + (size_t)row * D_MODEL : p.ctx + (size_t)(row - MLAT) * D_MODEL;
        const int mr = (row < MLAT) ? row / SEQ : BATCH;
        const float* md = MOD + (size_t)mr * 6 * D_MODEL;
        f32x4 v0, v1, v2, v3; float s = 0.f;
        v0 = ld4(xr + lane * 4); s += hsum4(v0);
        if (NV > 1) { v1 = ld4(xr + 256 + lane * 4); s += hsum4(v1); } else v1 = f32x4{0.f, 0.f, 0.f, 0.f};
        if (NV > 2) { v2 = ld4(xr + 512 + lane * 4); v3 = ld4(xr + 768 + lane * 4); s += hsum4(v2) + hsum4(v3); } else { v2 = v1; v3 = v1; }
        const float mu = wave_sum(s) * (1.0f / D_MODEL);
        v0 -= mu; float s2 = hsum4(v0 * v0);
        if (NV > 1) { v1 -= mu; s2 += hsum4(v1 * v1); }
        if (NV > 2) { v2 -= mu; v3 -= mu; s2 += hsum4(v2 * v2) + hsum4(v3 * v3); }
        const float rstd = frsq(wave_sum(s2) * (1.0f / D_MODEL) + LN_EPS);
        if (lane == 0) { STATS[row * 2] = mu; STATS[row * 2 + 1] = rstd; }
#pragma unroll
        for (int j = 0; j < NV; ++j) {
            const int k = j * 256 + lane * 4;
            const f32x4 vv = (j == 0) ? v0 : (j == 1) ? v1 : (j == 2) ? v2 : v3;
            const f32x4 h = vv * rstd * ld4(p.ln_in_g + k) + ld4(p.ln_in_b + k);
            *(U2*)(U + (size_t)row * D_MODEL + k) = pack4(h * (1.0f + ld4(md + D_MODEL + k)) + ld4(md + k));
        }
    }
}

constexpr int LDK = 64;
template <int MI, bool DUAL, class Epi>
__device__ __forceinline__ void gemm_tile(char* smem, const bf16_t* A, int lda, const int* rowidx, int m0, const bf16_t* Bt0, const bf16_t* Bt1, int ldb, int n0, int K, Epi epi, const float* rowscale = nullptr, int kscale = 0) {
    constexpr int BM = 32 * MI;
    bf16_t* As = (bf16_t*)smem;
    bf16_t* Bs = As + BM * LDK;
    int tid = threadIdx.x;
#ifndef HOST_EMU
    asm volatile("" : "+v"(tid));
#endif
    const int lane = tid & 63, wave = tid >> 6, wr = wave >> 1, wc = wave & 1, l15 = lane & 15, q = lane >> 4;
    const int ch = tid & 7, r0 = tid >> 3;
    unsigned aoff[MI], boff[4];
#pragma unroll
    for (int j = 0; j < MI; ++j) { const int r = m0 + r0 + 32 * j; aoff[j] = (unsigned)(rowidx ? rowidx[r] : r) * (unsigned)lda + ch * 8; }
#pragma unroll
    for (int j = 0; j < 4; ++j) boff[j] = (unsigned)(n0 + (DUAL ? (j >> 1) * 32 + r0 : r0 + 32 * j)) * (unsigned)ldb + ch * 8;
    const int wofs = r0 * LDK + ((ch ^ (r0 & 7)) * 8);
    u32x4 ar[MI], br[4];
    f32x4 acc[MI][4];
#pragma unroll
    for (int i = 0; i < MI; ++i)
#pragma unroll
        for (int j = 0; j < 4; ++j) acc[i][j] = f32x4{0.f, 0.f, 0.f, 0.f};
    const int nk = K / 64;
#pragma unroll
    for (int j = 0; j < MI; ++j) ar[j] = *(const u32x4*)(A + aoff[j]);
#pragma unroll
    for (int j = 0; j < 4; ++j) br[j] = *(const u32x4*)(((DUAL && (j & 1)) ? Bt1 : Bt0) + boff[j]);
    for (int kt = 0; kt < nk; ++kt) {
        __syncthreads();
#pragma unroll
        for (int j = 0; j < MI; ++j) *(u32x4*)(As + wofs + 32 * j * LDK) = ar[j];
#pragma unroll
        for (int j = 0; j < 4; ++j) *(u32x4*)(Bs + wofs + 32 * j * LDK) = br[j];
        __syncthreads();
        if (kt + 1 < nk) {
            const int ko = (kt + 1) * 64;
#pragma unroll
            for (int j = 0; j < MI; ++j) ar[j] = *(const u32x4*)(A + aoff[j] + ko);
#pragma unroll
            for (int j = 0; j < 4; ++j) br[j] = *(const u32x4*)(((DUAL && (j & 1)) ? Bt1 : Bt0) + boff[j] + ko);
        }
#pragma unroll
        for (int ks = 0; ks < 2; ++ks) {
            const int cofs = ((ks * 4 + q) ^ (l15 & 7)) * 8;
            bf16x8 bfr[4];
#pragma unroll
            for (int ni = 0; ni < 4; ++ni) bfr[ni] = *(const bf16x8*)(Bs + (wc * 64 + ni * 16 + l15) * LDK + cofs);
#pragma unroll
            for (int mi = 0; mi < MI; ++mi) {
                const bf16x8 af = *(const bf16x8*)(As + (wr * (16 * MI) + mi * 16 + l15) * LDK + cofs);
#pragma unroll
                for (int ni = 0; ni < 4; ++ni) acc[mi][ni] = MFMA16(bfr[ni], af, acc[mi][ni]);
            }
        }
        if (rowscale && kt + 1 == kscale) {
#pragma unroll
            for (int mi = 0; mi < MI; ++mi) {
                const float rs = rowscale[m0 + wr * (16 * MI) + mi * 16 + l15];
#pragma unroll
                for (int ni = 0; ni < 4; ++ni) acc[mi][ni] *= rs;
            }
        }
    }
#pragma unroll
    for (int mi = 0; mi < MI; ++mi) {
        const int ml = wr * (16 * MI) + mi * 16 + l15;
        if (DUAL) {
#pragma unroll
            for (int ni = 0; ni < 2; ++ni) epi(ml, wc * 32 + ni * 16 + q * 4, acc[mi][ni], acc[mi][ni + 2]);
        } else {
#pragma unroll
            for (int ni = 0; ni < 4; ++ni) epi(ml, wc * 64 + ni * 16 + q * 4, acc[mi][ni], acc[mi][ni]);
        }
    }
    __syncthreads();
}

__device__ __forceinline__ int xcd_vbid(int bid, int nblk) { return (nblk % 8 == 0) ? (bid % 8) * (nblk / 8) + bid / 8 : bid; }
constexpr int MI_C = (MTOT % 256 == 0) ? 8 : 4, MI_J = (MLAT % 256 == 0) ? 8 : 4, MI_E = (CAP % 256 == 0) ? 8 : 4;
__device__ void phaseC(const Params& p, int bid, int nblk, char* smem) {
    const bf16_t* U = WSP(bf16_t, WS_R3); const bf16_t* WB = WSP(bf16_t, WS_WBIN);
    bf16_t* P = WSP(bf16_t, WS_R1);
    constexpr int BM = 32 * MI_C, NTN = D_IN / 128, NTM = MTOT / BM;
    constexpr int GM = (NTM % 8 == 0) ? 8 : (NTM % 4 == 0) ? 4 : 1;
    for (int it = xcd_vbid(bid, nblk); it < NTN * NTM; it += nblk) {
        const int mg = it / (GM * NTN), r = it % (GM * NTN), nt = r / GM, mt = mg * GM + (r % GM);
        gemm_tile<MI_C, false>(smem, U, D_MODEL, nullptr, mt * BM, WB, nullptr, D_MODEL, nt * 128, D_MODEL, [&](int ml, int nl, f32x4 v, f32x4) {
            *(U2*)(P + (size_t)(mt * BM + ml) * D_IN + nt * 128 + nl) = pack4(v);
        });
    }
}


template <int NYT, int KS>
__device__ __forceinline__ void mmT(f32x4* acc, const bf16_t* X, int ldx, int xs, const bf16_t* Y, int ldy, int lane) {
#pragma unroll
    for (int ks = 0; ks < KS; ++ks) {
        const bf16x8 xf = *(const bf16x8*)(X + (xs * 16 + (lane & 15)) * ldx + ks * 32 + 8 * (lane >> 4));
#pragma unroll
        for (int nb = 0; nb < NYT; ++nb) {
            const bf16x8 yf = *(const bf16x8*)(Y + (nb * 16 + (lane & 15)) * ldy + ks * 32 + 8 * (lane >> 4));
            acc[nb] = MFMA16(xf, yf, acc[nb]);
        }
    }
}

struct SeqChunk { int base_row; int t0; int len; };
__device__ __forceinline__ SeqChunk lru_chunk(int cg) {
    SeqChunk s;
    if (cg < NLCH) { const int b = cg / (SEQ / 64), ck = cg % (SEQ / 64); s.base_row = b * SEQ; s.t0 = ck * 64; s.len = SEQ; }
    else { const int c2 = cg - NLCH; const int b = c2 / (CTX_LEN / 64), ck = c2 % (CTX_LEN / 64); s.base_row = MLAT + b * CTX_LEN; s.t0 = ck * 64; s.len = CTX_LEN; }
    return s;
}
constexpr int L_XIN = 0;
constexpr int L_GT = 8704;
constexpr int L_XB = L_GT + 9216;
constexpr int L_WT = L_XB + 9216;
constexpr int L_CP = L_WT + 36864;
constexpr int L_END = L_CP + 4096;
static_assert(L_END <= SMEM_BYTES, "lru lds");
__device__ __forceinline__ void lru_load_w(const Params& p, char* smem, int cb) {
    bf16_t* WT = (bf16_t*)(smem + L_WT);
    const int tid = threadIdx.x;
    for (int idx = tid; idx < 4 * 64 * 16; idx += 256) {
        const int m = idx >> 10, i = (idx >> 4) & 63, j4 = (idx & 15) * 4, d = m >> 1;
        const f32x4 w = ld4(((m & 1) ? p.lru_wx : p.lru_wa) + ((size_t)(d * LRU_BLOCKS + cb) * 64 + i) * 64 + j4);
        bf16_t* dst = WT + (m * 64 + j4) * 72 + i;
        dst[0] = f2bf(w[0]); dst[72] = f2bf(w[1]); dst[144] = f2bf(w[2]); dst[216] = f2bf(w[3]);
    }
}
struct LruOut { float a[2][4][4], b[2][4][4]; };
struct LruConst { float ba[2][4], bx[2][4], sp8[2][4], gn[4], cw[4], cb0; };
__device__ __forceinline__ void lru_consts(const Params& p, int cb, LruConst& K) {
    const int l15 = threadIdx.x & 15, c = threadIdx.x & 63, ch = cb * 64 + c;
#pragma unroll
    for (int d = 0; d < 2; ++d)
#pragma unroll
        for (int nb = 0; nb < 4; ++nb) { const int cc = d * D_LRU + cb * 64 + nb * 16 + l15; K.ba[d][nb] = p.lru_ba[cc]; K.bx[d][nb] = p.lru_bx[cc]; K.sp8[d][nb] = -8.0f * softplusf_(-p.lru_lam[cc]); }
#pragma unroll
    for (int nb = 0; nb < 4; ++nb) K.gn[nb] = p.lru_norm_g[cb * 64 + nb * 16 + l15];
#pragma unroll
    for (int j = 0; j < 4; ++j) K.cw[j] = p.lru_conv_w[j * D_LRU + ch];
    K.cb0 = p.lru_conv_b[ch];
}
struct LruStage { u32x4 x[3]; u32x4 g[2]; };
template <bool FINAL>
__device__ __forceinline__ void lru_stage_load(const Params& p, int cg, int cb, LruStage& S) {
    const bf16_t* P = WSP(bf16_t, WS_R1);
    const SeqChunk sc = lru_chunk(cg);
    const int tid = threadIdx.x;
#pragma unroll
    for (int k = 0; k < 3; ++k) {
        const int idx = tid + 256 * k, tt = idx >> 3, c8 = (idx & 7) * 8, t = sc.t0 - 1 + tt;
        S.x[k] = u32x4{0u, 0u, 0u, 0u};
        if (idx < 67 * 8 && t >= 0 && t < sc.len) S.x[k] = *(const u32x4*)(P + (size_t)(sc.base_row + t) * D_IN + cb * 64 + c8);
    }
    if (FINAL) {
#pragma unroll
        for (int k = 0; k < 2; ++k) { const int idx = tid + 256 * k, tt = idx >> 3, c8 = (idx & 7) * 8; S.g[k] = *(const u32x4*)(P + (size_t)(sc.base_row + sc.t0 + tt) * D_IN + D_LRU + cb * 64 + c8); }
    }
}
template <bool FINAL>
__device__ __forceinline__ void lru_item(const Params& p, char* smem, int cg, int cb, const LruConst& K, LruStage& S, int cg_next) {
    const bf16_t* P = WSP(bf16_t, WS_R1);
    bf16_t* XIN = (bf16_t*)(smem + L_XIN); bf16_t* GT = (bf16_t*)(smem + L_GT); bf16_t* XB = (bf16_t*)(smem + L_XB); const bf16_t* WT = (const bf16_t*)(smem + L_WT);
    float* CP = (float*)(smem + L_CP);
    const int tid = threadIdx.x, lane = tid & 63, wave = tid >> 6, q = lane >> 4, l15 = lane & 15;
    const SeqChunk sc = lru_chunk(cg);
    __syncthreads();
#pragma unroll
    for (int k = 0; k < 3; ++k) { const int idx = tid + 256 * k, tt = idx >> 3, c8 = (idx & 7) * 8; if (idx < 67 * 8) *(u32x4*)(XIN + tt * 64 + c8) = S.x[k]; }
    if (FINAL) {
#pragma unroll
        for (int k = 0; k < 2; ++k) { const int idx = tid + 256 * k, tt = idx >> 3, c8 = (idx & 7) * 8; *(u32x4*)(GT + tt * 72 + c8) = S.g[k]; }
    }
    if (cg_next >= 0) lru_stage_load<FINAL>(p, cg_next, cb, S);
    __syncthreads();
    {
        const int c = tid & 63;
#pragma unroll 4
        for (int tt = tid >> 6; tt < 64; tt += 4)
            XB[tt * 72 + c] = f2bf(K.cb0 + bf2f(XIN[tt * 64 + c]) * K.cw[0] + bf2f(XIN[(tt + 1) * 64 + c]) * K.cw[1] + bf2f(XIN[(tt + 2) * 64 + c]) * K.cw[2] + bf2f(XIN[(tt + 3) * 64 + c]) * K.cw[3]);
    }
    __syncthreads();
    float hs[4][4];
    float av[4][4], bv[4][4];
#pragma unroll
    for (int d = 0; d < 2; ++d) {
        f32x4 ga[4], gx[4];
#pragma unroll
        for (int nb = 0; nb < 4; ++nb) { ga[nb] = f32x4{0.f, 0.f, 0.f, 0.f}; gx[nb] = f32x4{0.f, 0.f, 0.f, 0.f}; }
        mmT<4, 2>(ga, XB, 72, wave, WT + (2 * d) * 64 * 72, 72, lane);
        mmT<4, 2>(gx, XB, 72, wave, WT + (2 * d + 1) * 64 * 72, 72, lane);
        float cA[4], cH[4];
#pragma unroll
        for (int nb = 0; nb < 4; ++nb) {
            const float ba = K.ba[d][nb], bx = K.bx[d][nb], sp8 = K.sp8[d][nb];
#pragma unroll
            for (int r = 0; r < 4; ++r) {
                const float rg = fsigm(ga[nb][r] + ba), ig = fsigm(gx[nb][r] + bx);
                const float a = FEXP(sp8 * rg);
                const float xv = bf2f(XB[(wave * 16 + q * 4 + r) * 72 + nb * 16 + l15]);
                av[nb][r] = a; bv[nb][r] = fsqrt(fmaxf(1.0f - a * a, 0.f)) * ig * xv;
            }
            float A, H;
            if (d == 0) { A = av[nb][0]; H = bv[nb][0];
#pragma unroll
                for (int r = 1; r < 4; ++r) { H = H * av[nb][r] + bv[nb][r]; A *= av[nb][r]; } }
            else { A = av[nb][3]; H = bv[nb][3];
#pragma unroll
                for (int r = 2; r >= 0; --r) { H = H * av[nb][r] + bv[nb][r]; A *= av[nb][r]; } }
#pragma unroll
            for (int st = 1; st <= 2; st <<= 1) {
                const float pA = d == 0 ? __shfl_up(A, 16 * st) : __shfl_down(A, 16 * st), pH = d == 0 ? __shfl_up(H, 16 * st) : __shfl_down(H, 16 * st);
                const bool has = d == 0 ? (q >= st) : (q + st <= 3);
                if (has) { H = pH * A + H; A = pA * A; }
            }
            cA[nb] = A; cH[nb] = H;
            const bool last = d == 0 ? (q == 3) : (q == 0);
            if (last) { CP[((d * 4 + wave) * 64 + nb * 16 + l15) * 2] = A; CP[((d * 4 + wave) * 64 + nb * 16 + l15) * 2 + 1] = H; }
        }
        __syncthreads();
        if (!FINAL) {
            if (wave == 0 && q == 0) {
#pragma unroll
                for (int nb = 0; nb < 4; ++nb) {
                    const int c = nb * 16 + l15;
                    float A = 1.f, H = 0.f;
#pragma unroll
                    for (int w = 0; w < 4; ++w) { const int ww = d == 0 ? w : 3 - w; const float wa = CP[((d * 4 + ww) * 64 + c) * 2], wh = CP[((d * 4 + ww) * 64 + c) * 2 + 1]; H = H * wa + wh; A *= wa; }
                    WSP(float, WS_SUMA)[((size_t)d * NCH + cg) * D_LRU + cb * 64 + c] = A;
                    WSP(float, WS_SUMH)[((size_t)d * NCH + cg) * D_LRU + cb * 64 + c] = H;
                }
            }
        } else {
#pragma unroll
            for (int nb = 0; nb < 4; ++nb) {
                const int c = nb * 16 + l15;
                float h = WSP(float, WS_CARRY)[((size_t)d * NLCH + cg) * D_LRU + cb * 64 + c];
#pragma unroll
                for (int w = 0; w < 3; ++w) { const int ww = d == 0 ? w : 3 - w; const bool use = d == 0 ? (ww < wave) : (ww > wave);
                    if (use) h = h * CP[((d * 4 + ww) * 64 + c) * 2] + CP[((d * 4 + ww) * 64 + c) * 2 + 1]; }
                const float eA = d == 0 ? __shfl_up(cA[nb], 16) : __shfl_down(cA[nb], 16), eH = d == 0 ? __shfl_up(cH[nb], 16) : __shfl_down(cH[nb], 16);
                const bool first = d == 0 ? (q == 0) : (q == 3);
                if (!first) h = h * eA + eH;
                if (d == 0) {
#pragma unroll
                    for (int r = 0; r < 4; ++r) { h = h * av[nb][r] + bv[nb][r]; hs[nb][r] = h; }
                } else {
#pragma unroll
                    for (int r = 3; r >= 0; --r) { h = h * av[nb][r] + bv[nb][r]; hs[nb][r] += h; }
                }
            }
        }
        __syncthreads();
    }
    if (FINAL) {
        float ss[4] = {0.f, 0.f, 0.f, 0.f};
#pragma unroll
        for (int nb = 0; nb < 4; ++nb) {
            const float gn = K.gn[nb];
#pragma unroll
            for (int r = 0; r < 4; ++r) {
                const int tt = wave * 16 + q * 4 + r;
                const float v = hs[nb][r] * geluf_(bf2f(GT[tt * 72 + nb * 16 + l15]));
                ss[r] += v * v;
                XB[tt * 72 + nb * 16 + l15] = f2bf(v * gn);
            }
        }
#pragma unroll
        for (int r = 0; r < 4; ++r) {
#pragma unroll
            for (int o = 1; o < 16; o <<= 1) ss[r] += __shfl_xor(ss[r], o);
            if (l15 == 0) WSP(float, WS_SSQP)[(size_t)(sc.base_row + sc.t0 + wave * 16 + q * 4 + r) * LRU_BLOCKS + cb] = ss[r];
        }
        __syncthreads();
        bf16_t* MIX = WSP(bf16_t, WS_R3);
        for (int idx = tid; idx < 64 * 8; idx += 256) {
            const int tt = idx >> 3, c8 = (idx & 7) * 8;
            *(u32x4*)(MIX + (size_t)(sc.base_row + sc.t0 + tt) * D_MIX + cb * 64 + c8) = *(const u32x4*)(XB + tt * 72 + c8);
        }
    }
}
__device__ void phaseD(const Params& p, int bid, int nblk, char* smem) {
    int cur = -1; LruConst K; LruStage S;
    for (int it = bid; it < NCH * LRU_BLOCKS; it += nblk) {
        const int cb = it % LRU_BLOCKS, cg = it / LRU_BLOCKS;
        if (cb != cur) { __syncthreads(); lru_load_w(p, smem, cb); lru_consts(p, cb, K); lru_stage_load<false>(p, cg, cb, S); cur = cb; }
        const int itn = it + nblk;
        lru_item<false>(p, smem, cg, cb, K, S, (itn < NCH * LRU_BLOCKS && itn % LRU_BLOCKS == cb) ? itn / LRU_BLOCKS : -1);
        if (itn < NCH * LRU_BLOCKS && itn % LRU_BLOCKS != cb) cur = -1;
    }
}
__device__ void phaseE(const Params& p, int bid, int nblk, char* smem) {
    const float* SUMA = WSP(float, WS_SUMA); const float* SUMH = WSP(float, WS_SUMH); float* CARRY = WSP(float, WS_CARRY);
    constexpr int NLB = SEQ / 64, NCB = CTX_LEN / 64;
    for (int g = bid * 256 + threadIdx.x; g < BATCH * 2 * D_LRU; g += nblk * 256) {
        const int c = g % D_LRU, d = (g / D_LRU) & 1, b = g / (2 * D_LRU);
        const float* sa = SUMA + (size_t)d * NCH * D_LRU + c; const float* sh = SUMH + (size_t)d * NCH * D_LRU + c;
        float* cr = CARRY + (size_t)d * NLCH * D_LRU + c;
        float h = 0.f;
        if (d == 0) {
            for (int q2 = 0; q2 < NCB; ++q2) { const int gi = NLCH + b * NCB + q2; h = sa[(size_t)gi * D_LRU] * h + sh[(size_t)gi * D_LRU]; }
            for (int q2 = 0; q2 < NLB; ++q2) { const int gi = b * NLB + q2; cr[(size_t)gi * D_LRU] = h; h = sa[(size_t)gi * D_LRU] * h + sh[(size_t)gi * D_LRU]; }
        } else {
            for (int q2 = NCB - 1; q2 >= 0; --q2) { const int gi = NLCH + b * NCB + q2; h = sa[(size_t)gi * D_LRU] * h + sh[(size_t)gi * D_LRU]; }
            for (int q2 = NLB - 1; q2 >= 0; --q2) { const int gi = b * NLB + q2; cr[(size_t)gi * D_LRU] = h; h = sa[(size_t)gi * D_LRU] * h + sh[(size_t)gi * D_LRU]; }
        }
    }
}
__device__ void phaseF(const Params& p, int bid, int nblk, char* smem) {
    int cur = -1; LruConst K; LruStage S;
    for (int it = bid; it < NLCH * LRU_BLOCKS; it += nblk) {
        const int cb = it % LRU_BLOCKS, cg = it / LRU_BLOCKS;
        if (cb != cur) { __syncthreads(); lru_load_w(p, smem, cb); lru_consts(p, cb, K); lru_stage_load<true>(p, cg, cb, S); cur = cb; }
        const int itn = it + nblk;
        lru_item<true>(p, smem, cg, cb, K, S, (itn < NLCH * LRU_BLOCKS && itn % LRU_BLOCKS == cb) ? itn / LRU_BLOCKS : -1);
        if (itn < NLCH * LRU_BLOCKS && itn % LRU_BLOCKS != cb) cur = -1;
    }
}

__device__ __forceinline__ size_t rwkv_row(int seg, int b, int s) {
    if (seg == 0) return (size_t)(MLAT + b * CTX_LEN + s);
    const int r = s % ROWS, c = s / ROWS;
    return (size_t)(b * SEQ + r * GRID_W + c);
}
__device__ __forceinline__ void chunk_info(int d, int c, int& seg, int& p0, int& len) {
    if (c < NCC) { seg = 0; len = CTX_LEN; p0 = (d == 0 ? c : NCC - 1 - c) * RC; }
    else { const int cc = c - NCC; seg = 1; len = SEQ; p0 = (d == 0 ? cc : NLC - 1 - cc) * RC; }
}
__device__ __forceinline__ void unpack8(const u32x4 v, float* o) {
    o[0] = bitsf(v[0] << 16); o[1] = bitsf(v[0] & 0xFFFF0000u); o[2] = bitsf(v[1] << 16); o[3] = bitsf(v[1] & 0xFFFF0000u);
    o[4] = bitsf(v[2] << 16); o[5] = bitsf(v[2] & 0xFFFF0000u); o[6] = bitsf(v[3] << 16); o[7] = bitsf(v[3] & 0xFFFF0000u);
}
__device__ __forceinline__ void shifted8(const Params& p, const bf16_t* P, int seg, int b, int pos, int len, int ch0, float* o) {
    float z[8], zp[8], zn[8];
    unpack8(*(const u32x4*)(P + rwkv_row(seg, b, pos) * D_IN + RW0 + ch0), z);
    if (pos > 0) unpack8(*(const u32x4*)(P + rwkv_row(seg, b, pos - 1) * D_IN + RW0 + ch0), zp); else { for (int i = 0; i < 8; ++i) zp[i] = 0.f; }
    if (pos < len - 1) unpack8(*(const u32x4*)(P + rwkv_row(seg, b, pos + 1) * D_IN + RW0 + ch0), zn); else { for (int i = 0; i < 8; ++i) zn[i] = 0.f; }
    const f32x4 mp0 = ld4(p.mu_prev + ch0), mp1 = ld4(p.mu_prev + ch0 + 4), mn0 = ld4(p.mu_next + ch0), mn1 = ld4(p.mu_next + ch0 + 4);
#pragma unroll
    for (int i = 0; i < 4; ++i) { o[i] = z[i] + mp0[i] * (zp[i] - z[i]) + mn0[i] * (zn[i] - z[i]); o[4 + i] = z[4 + i] + mp1[i] * (zp[4 + i] - z[4 + i]) + mn1[i] * (zn[4 + i] - z[4 + i]); }
}
constexpr int LT = 72, LJ = 40;
constexpr int R_RF = 0, R_KF = 8192, R_VF = 16384, R_LW = 24576, R_IC = 32768;
constexpr int R_NKA = 0, R_MBR = 2560, R_MKR = 5120;
constexpr int R_XU = 7680;
constexpr int R_IA = R_XU + 8448, R_IB = R_IA + 4608, R_PA = R_IB + 4608, R_PB = R_PA + 4608;
constexpr int R_WA = R_IB, R_U0 = R_WA + 5120;
static_assert(R_U0 + 5120 <= R_PB + 4608 && R_PB + 4608 <= 40960, "rwkv scratch");
constexpr int R_O = 40960;
constexpr int R_AH = R_O, R_BH = R_AH + 4608, R_KH = R_BH + 4608, R_RH = R_KH + 4608;
constexpr int R_VT = R_RH + 4608, R_BHT = R_VT + 5120, R_KHT = R_BHT + 5120;
constexpr int R_GC = R_KHT + 5120, R_TOT = R_GC + 256, R_END = R_TOT + 1024;
constexpr int R_TW = R_O, R_TA = R_TW + 4608, R_W2T = R_TA + 4608, R_A2T = R_W2T + 9216;
static_assert(R_A2T + 9216 <= R_END && R_END <= SMEM_BYTES, "rwkv lds");

__device__ void phaseR1(const Params& p, int bid, int nblk, char* smem) {
    const bf16_t* P = WSP(bf16_t, WS_R1);
    unsigned char* CH = p.ws + WS_CH;
    float* RBON = WSP(float, WS_RBON);
    float* Rf = (float*)(smem + R_RF); float* Kf = (float*)(smem + R_KF); float* Vf = (float*)(smem + R_VF); float* LW = (float*)(smem + R_LW); float* IC = (float*)(smem + R_IC);
    float* IA = (float*)(smem + R_IA); float* IB = (float*)(smem + R_IB); float* PA = (float*)(smem + R_PA); float* PB = (float*)(smem + R_PB); bf16_t* NkaT = (bf16_t*)(smem + R_NKA); bf16_t* MbrT = (bf16_t*)(smem + R_MBR); bf16_t* MkrT = (bf16_t*)(smem + R_MKR);
    float* Xu = (float*)(smem + R_XU); bf16_t* Wa = (bf16_t*)(smem + R_WA); bf16_t* U0 = (bf16_t*)(smem + R_U0);
    bf16_t* Ah = (bf16_t*)(smem + R_AH); bf16_t* Bh = (bf16_t*)(smem + R_BH); bf16_t* Kh = (bf16_t*)(smem + R_KH); bf16_t* Rh = (bf16_t*)(smem + R_RH);
    bf16_t* VT = (bf16_t*)(smem + R_VT); bf16_t* BhT = (bf16_t*)(smem + R_BHT); bf16_t* KhT = (bf16_t*)(smem + R_KHT);
    float* GC = (float*)(smem + R_GC); float* TOT = (float*)(smem + R_TOT);
    bf16_t* TW = (bf16_t*)(smem + R_TW); bf16_t* TA = (bf16_t*)(smem + R_TA); bf16_t* W2T = (bf16_t*)(smem + R_W2T); bf16_t* A2T = (bf16_t*)(smem + R_A2T);
    const int tid = threadIdx.x, lane = tid & 63, wave = tid >> 6, q = lane >> 4, l15 = lane & 15;
    constexpr int NITEM = NCHAIN * NCK;
    const int per = (NITEM + nblk - 1) / nblk;
    const int it0 = bid * per, it1 = (it0 + per < NITEM) ? it0 + per : NITEM;
    for (int it = it0; it < it1; ++it) {
        const int chain = it / NCK, c = it % NCK;
        const int d = chain & 1, h = (chain >> 1) % HEADS, b = chain / (2 * HEADS);
        int seg, p0, len; chunk_info(d, c, seg, p0, len);
        unsigned char* chp = CH + (size_t)it * CH_BYTES;
        const float kkc = p.k_k[h * 64 + lane], kac = p.k_a[h * 64 + lane], rkc = p.r_k[h * 64 + lane];
        __syncthreads();
        {
            f32x4 wv[8];
#pragma unroll
            for (int k = 0; k < 8; ++k) {
                const int idx = tid + 256 * k, which = idx >> 10, i = (idx >> 4) & 63, j4 = (idx & 15) * 4;
                wv[k] = ld4((which ? p.a2 : p.w2) + ((size_t)d * 64 + i) * D_RWKV + h * 64 + j4);
            }
#pragma unroll
            for (int kb = 0; kb < 5; kb += 2) {
            u32x4 zc[2], zp[2], zn[2];
#pragma unroll
            for (int k = 0; k < 2; ++k) if (kb + k < 5) {
                const int idx = tid + 256 * (kb + k), tau = idx / 40, g = idx % 40, grp = g >> 3, j0 = (g & 7) * 8;
                const int pos = p0 + (d ? RC - 1 - tau : tau);
                const int ch0 = (grp < 3) ? grp * D_RWKV + h * 64 + j0 : (grp == 3 ? 3 * D_RWKV + d * 64 + j0 : 3 * D_RWKV + 128 + d * 64 + j0);
                const u32x4 zero = u32x4{0u, 0u, 0u, 0u};
                zc[k] = *(const u32x4*)(P + rwkv_row(seg, b, pos) * D_IN + RW0 + ch0);
                zp[k] = (pos > 0) ? *(const u32x4*)(P + rwkv_row(seg, b, pos - 1) * D_IN + RW0 + ch0) : zero;
                zn[k] = (pos < len - 1) ? *(const u32x4*)(P + rwkv_row(seg, b, pos + 1) * D_IN + RW0 + ch0) : zero;
            }
#pragma unroll
            for (int k = 0; k < 2; ++k) if (kb + k < 5) {
                const int idx = tid + 256 * (kb + k), tau = idx / 40, g = idx % 40, grp = g >> 3, j0 = (g & 7) * 8;
                const int ch0 = (grp < 3) ? grp * D_RWKV + h * 64 + j0 : (grp == 3 ? 3 * D_RWKV + d * 64 + j0 : 3 * D_RWKV + 128 + d * 64 + j0);
                float z[8], zpv[8], znv[8], o[8];
                unpack8(zc[k], z); unpack8(zp[k], zpv); unpack8(zn[k], znv);
                const f32x4 mp0 = ld4(p.mu_prev + ch0), mp1 = ld4(p.mu_prev + ch0 + 4), mn0 = ld4(p.mu_next + ch0), mn1 = ld4(p.mu_next + ch0 + 4);
#pragma unroll
                for (int e = 0; e < 4; ++e) { o[e] = z[e] + mp0[e] * (zpv[e] - z[e]) + mn0[e] * (znv[e] - z[e]); o[4 + e] = z[4 + e] + mp1[e] * (zpv[4 + e] - z[4 + e]) + mn1[e] * (znv[4 + e] - z[4 + e]); }
                if (grp < 3) {
                    float* dst = (grp == 0 ? Rf : grp == 1 ? Kf : Vf) + tau * 64 + j0;
                    *(f32x4*)dst = f32x4{o[0], o[1], o[2], o[3]}; *(f32x4*)(dst + 4) = f32x4{o[4], o[5], o[6], o[7]};
                } else if (grp == 3) {
                    u32x4 w;
#pragma unroll
                    for (int e = 0; e < 4; ++e) { const float t0 = 2.0f * frcp(1.0f + FEXP(-2.0f * o[2 * e])) - 1.0f, t1 = 2.0f * frcp(1.0f + FEXP(-2.0f * o[2 * e + 1])) - 1.0f; w[e] = pk2(t0, t1); }
                    *(u32x4*)(TW + tau * LT + j0) = w;
                } else {
                    u32x4 w; w[0] = pk2(o[0], o[1]); w[1] = pk2(o[2], o[3]); w[2] = pk2(o[4], o[5]); w[3] = pk2(o[6], o[7]);
                    *(u32x4*)(TA + tau * LT + j0) = w;
                }
            }
            }
#pragma unroll
            for (int k = 0; k < 8; ++k) {
                const int idx = tid + 256 * k, which = idx >> 10, i = (idx >> 4) & 63, j4 = (idx & 15) * 4;
                bf16_t* dst = (which ? A2T : W2T) + j4 * LT + i;
                dst[0] = f2bf(wv[k][0]); dst[LT] = f2bf(wv[k][1]); dst[2 * LT] = f2bf(wv[k][2]); dst[3 * LT] = f2bf(wv[k][3]);
            }
        }
        __syncthreads();
        {
            f32x4 aw[2] = {f32x4{0.f, 0.f, 0.f, 0.f}, f32x4{0.f, 0.f, 0.f, 0.f}}, ai[2] = {f32x4{0.f, 0.f, 0.f, 0.f}, f32x4{0.f, 0.f, 0.f, 0.f}};
            mmT<2, 2>(aw, W2T, LT, wave, TW, LT, lane);
            mmT<2, 2>(ai, A2T, LT, wave, TA, LT, lane);
            const int j = wave * 16 + q * 4;
            const f32x4 w0v = ld4(p.w0 + d * D_RWKV + h * 64 + j), a0v = ld4(p.a0 + d * D_RWKV + h * 64 + j);
#pragma unroll
            for (int nb = 0; nb < 2; ++nb) {
                const int tau = nb * 16 + l15;
                f32x4 lw, ic;
#pragma unroll
                for (int r = 0; r < 4; ++r) { lw[r] = -0.6065306597126334f * fsigm(w0v[r] + aw[nb][r]); ic[r] = fsigm(a0v[r] + ai[nb][r]); }
                *(f32x4*)(LW + tau * 64 + j) = lw; *(f32x4*)(IC + tau * 64 + j) = ic;
            }
        }
        __syncthreads();
        {
            const int j = lane, t0 = wave * 8;
            float cum[8], kd[8], kkn[8], icv[8], rr[8], vv[8], run = 0.f;
#pragma unroll
            for (int i = 0; i < 8; ++i) {
                const int t = t0 + i;
                run += LW[t * 64 + j]; cum[i] = run;
                const float kr = Kf[t * 64 + j]; icv[i] = IC[t * 64 + j]; rr[i] = Rf[t * 64 + j]; vv[i] = Vf[t * 64 + j];
                kd[i] = kr * (1.0f + (icv[i] - 1.0f) * kac);
                const float kk = kr * kkc;
                const float n2 = wave_sum(kk * kk);
                kkn[i] = kk * frsq(fmaxf(n2, 1e-24f));
                const float bon = wave_sum(rr[i] * kd[i] * rkc);
                if (lane == 0) RBON[(size_t)it * RC + t] = bon;
            }
            TOT[wave * 64 + j] = run;
            __syncthreads();
            float off = 0.f;
            for (int w = 0; w < wave; ++w) off += TOT[w * 64 + j];
            u32x4 vt, bt, kt;
            float e_prev = 0.f;
#pragma unroll
            for (int i = 0; i < 8; ++i) {
                const int t = t0 + i;
                const float cu = off + cum[i], cprev = (i == 0) ? off : off + cum[i - 1];
                const float g = FEXP(cu), gi = FEXP(-cu), gm = FEXP(cprev);
                const float ah = -kkn[i] * gm, bh = kkn[i] * icv[i] * gi, kh = kd[i] * gi, rh = rr[i] * g;
                Ah[t * LT + j] = f2bf(ah); Bh[t * LT + j] = f2bf(bh); Kh[t * LT + j] = f2bf(kh); Rh[t * LT + j] = f2bf(rh);
                if (i & 1) { vt[i >> 1] = pk2(e_prev, vv[i]); bt[i >> 1] = (bt[i >> 1] & 0xFFFFu) | ((unsigned)f2bf(bh) << 16); kt[i >> 1] = (kt[i >> 1] & 0xFFFFu) | ((unsigned)f2bf(kh) << 16); }
                else { e_prev = vv[i]; bt[i >> 1] = f2bf(bh); kt[i >> 1] = f2bf(kh); }
                if (t == RC - 1) GC[j] = g;
            }
            *(u32x4*)(VT + j * LJ + t0) = vt; *(u32x4*)(BhT + j * LJ + t0) = bt; *(u32x4*)(KhT + j * LJ + t0) = kt;
        }
        __syncthreads();
        {
            const bf16_t* X = (wave == 0) ? Ah : (wave & 1) ? Kh : Bh;
            const bf16_t* Y = (wave == 0) ? Bh : (wave == 1) ? Ah : Rh;
#pragma unroll
            for (int xs = 0; xs < 2; ++xs) {
                f32x4 acc[2] = {f32x4{0.f, 0.f, 0.f, 0.f}, f32x4{0.f, 0.f, 0.f, 0.f}};
                mmT<2, 2>(acc, X, LT, xs, Y, LT, lane);
#pragma unroll
                for (int nb = 0; nb < 2; ++nb) {
                    const int yy = nb * 16 + l15, x0 = xs * 16 + q * 4;
                    f32x4 v = acc[nb];
#pragma unroll
                    for (int r = 0; r < 4; ++r) { const int xx = x0 + r; const bool keep = (wave == 0) ? (yy < xx) : (wave == 1) ? (xx < yy) : (xx <= yy); v[r] = keep ? v[r] : 0.f; }
                    if (wave == 0) { *(f32x4*)(PA + yy * 36 + x0) = v; f32x4 t0 = v; for (int r = 0; r < 4; ++r) t0[r] += (x0 + r == yy) ? 1.0f : 0.0f; *(f32x4*)(IA + yy * 36 + x0) = t0; }
                    else { bf16_t* dst = (wave == 1 ? NkaT : wave == 2 ? MbrT : MkrT) + yy * LJ + x0; *(U2*)dst = pack4(v); }
                }
            }
        }
        __syncthreads();
        {
#pragma unroll
            for (int xs = 0; xs < 2; ++xs) {
                f32x4 acc[1] = {f32x4{0.f, 0.f, 0.f, 0.f}};
                mmT<1, 1>(acc, NkaT, LJ, xs, VT + wave * 16 * LJ, LJ, lane);
                const int i = wave * 16 + l15, tb = xs * 16 + q * 4;
                Xu[i * 33 + tb] = acc[0][0]; Xu[i * 33 + tb + 1] = acc[0][1]; Xu[i * 33 + tb + 2] = acc[0][2]; Xu[i * 33 + tb + 3] = acc[0][3];
            }
        }
        __syncthreads();
        {
            auto mm32 = [&](float* Z, const float* init, const float* L, const float* R, int ti, int tj) {
                f32x4 acc = f32x4{0.f, 0.f, 0.f, 0.f};
                if (init) { for (int r = 0; r < 4; ++r) acc[r] = init[(ti * 16 + q * 4 + r) * 36 + tj * 16 + l15]; }
#pragma unroll
                for (int k0 = 0; k0 < 32; k0 += 4) acc = MFMAF32(L[(ti * 16 + l15) * 36 + k0 + q], R[(k0 + q) * 36 + tj * 16 + l15], acc);
#pragma unroll
                for (int r = 0; r < 4; ++r) Z[(ti * 16 + q * 4 + r) * 36 + tj * 16 + l15] = acc[r];
            };
            const int ti = wave >> 1, tj = wave & 1;
            mm32(PB, nullptr, PA, PA, ti, tj);
            __syncthreads();
            mm32(IB, IA, IA, PB, ti, tj); mm32(PA, nullptr, PB, PB, ti, tj);
            __syncthreads();
            mm32(IA, IB, IB, PA, ti, tj); mm32(PB, nullptr, PA, PA, ti, tj);
            __syncthreads();
            mm32(IB, IA, IA, PB, ti, tj); mm32(PA, nullptr, PB, PB, ti, tj);
            __syncthreads();
            f32x4 accw[2], accu[2];
            mm32(IA, IB, IB, PA, ti, tj);
            __syncthreads();
#pragma unroll
            for (int tc = 0; tc < 2; ++tc) { accw[tc] = f32x4{0.f, 0.f, 0.f, 0.f}; accu[tc] = f32x4{0.f, 0.f, 0.f, 0.f}; }
#pragma unroll
            for (int k0 = 0; k0 < 32; k0 += 4) {
                const float la = bf2f(Ah[(k0 + q) * LT + wave * 16 + l15]), lu = Xu[(wave * 16 + l15) * 33 + k0 + q];
#pragma unroll
                for (int tc = 0; tc < 2; ++tc) { const float rv = IA[(k0 + q) * 36 + tc * 16 + l15]; accw[tc] = MFMAF32(la, rv, accw[tc]); accu[tc] = MFMAF32(lu, rv, accu[tc]); }
            }
            __syncthreads();
#pragma unroll
            for (int tc = 0; tc < 2; ++tc)
#pragma unroll
                for (int r = 0; r < 4; ++r) { const int row = wave * 16 + q * 4 + r, col = tc * 16 + l15; Wa[row * LJ + col] = f2bf(accw[tc][r]); U0[row * LJ + col] = f2bf(accu[tc][r]); }
        }
        __syncthreads();
        {
            bf16_t* gPm = (bf16_t*)(chp + CH_PM); bf16_t* gSA = (bf16_t*)(chp + CH_SA); bf16_t* gQT = (bf16_t*)(chp + CH_QT); bf16_t* gY0 = (bf16_t*)(chp + CH_Y0);
            const int x0 = wave * 16 + q * 4;
            {
                f32x4 acc[4] = {f32x4{0.f, 0.f, 0.f, 0.f}, f32x4{0.f, 0.f, 0.f, 0.f}, f32x4{0.f, 0.f, 0.f, 0.f}, f32x4{0.f, 0.f, 0.f, 0.f}};
                mmT<4, 1>(acc, Wa, LJ, wave, BhT, LJ, lane);
#pragma unroll
                for (int nb = 0; nb < 4; ++nb) {
                    const int jp = nb * 16 + l15; const float g = GC[jp];
                    f32x4 v = acc[nb];
#pragma unroll
                    for (int r = 0; r < 4; ++r) v[r] = (v[r] + ((x0 + r == jp) ? 1.0f : 0.0f)) * g;
                    *(U2*)(gPm + jp * 64 + x0) = pack4(v);
                }
            }
            {
                f32x4 acc[4] = {f32x4{0.f, 0.f, 0.f, 0.f}, f32x4{0.f, 0.f, 0.f, 0.f}, f32x4{0.f, 0.f, 0.f, 0.f}, f32x4{0.f, 0.f, 0.f, 0.f}};
                mmT<4, 1>(acc, BhT, LJ, wave, U0, LJ, lane);
                mmT<4, 1>(acc, KhT, LJ, wave, VT, LJ, lane);
                const f32x4 g = *(const f32x4*)(GC + x0);
#pragma unroll
                for (int nb = 0; nb < 4; ++nb) *(U2*)(gSA + (nb * 16 + l15) * 64 + x0) = pack4(acc[nb] * g);
            }
            if (seg == 1) {
                {
                    f32x4 acc[2] = {f32x4{0.f, 0.f, 0.f, 0.f}, f32x4{0.f, 0.f, 0.f, 0.f}};
                    mmT<2, 1>(acc, Wa, LJ, wave, MbrT, LJ, lane);
#pragma unroll
                    for (int nb = 0; nb < 2; ++nb) {
                        const int t = nb * 16 + l15;
                        f32x4 v = acc[nb];
#pragma unroll
                        for (int r = 0; r < 4; ++r) v[r] += bf2f(Rh[t * LT + x0 + r]);
                        *(U2*)(gQT + t * 64 + x0) = pack4(v);
                    }
                }
                {
                    f32x4 acc[2] = {f32x4{0.f, 0.f, 0.f, 0.f}, f32x4{0.f, 0.f, 0.f, 0.f}};
                    mmT<2, 1>(acc, U0, LJ, wave, MbrT, LJ, lane);
                    mmT<2, 1>(acc, VT, LJ, wave, MkrT, LJ, lane);
#pragma unroll
                    for (int nb = 0; nb < 2; ++nb) *(U2*)(gY0 + (nb * 16 + l15) * 64 + x0) = pack4(acc[nb]);
                }
            }
        }
    }
}

__device__ __forceinline__ U2 ldu2(const bf16_t* p) { return *(const U2*)p; }
constexpr int R2D = 6, R2LD = 72;
__device__ void phaseR2(const Params& p, int bid, int nblk, char* smem) {
    unsigned char* CH = p.ws + WS_CH;
    bf16_t* PL = (bf16_t*)smem;
    const int tid = threadIdx.x, lane = tid & 63, wave = tid >> 6, q = lane >> 4, l15 = lane & 15;
    const int lrow = wave * 16 + (lane >> 2), lcol = (lane & 3) * 16;
    for (int chain = bid; chain < NCHAIN; chain += nblk) {
        const int i = wave * 16 + l15;
        unsigned char* chbase = CH + (size_t)chain * NCK * CH_BYTES;
        f32x4 st[4];
#pragma unroll
        for (int nt = 0; nt < 4; ++nt) st[nt] = f32x4{0.f, 0.f, 0.f, 0.f};
        u32x4 pq[R2D][2]; U2 sa[R2D][4];
#pragma unroll
        for (int k = 0; k < R2D; ++k) {
            const unsigned char* chp = chbase + (size_t)(k < NCK ? k : NCK - 1) * CH_BYTES;
            const bf16_t* gp = (const bf16_t*)(chp + CH_PM) + lrow * 64 + lcol;
            pq[k][0] = *(const u32x4*)gp; pq[k][1] = *(const u32x4*)(gp + 8);
#pragma unroll
            for (int nt = 0; nt < 4; ++nt) sa[k][nt] = ldu2((const bf16_t*)(chp + CH_SA) + i * 64 + nt * 16 + 4 * q);
        }
#pragma unroll 1
        for (int c0 = 0; c0 < NCK; c0 += R2D) {
#pragma unroll
            for (int k = 0; k < R2D; ++k) {
                const int c = c0 + k;
                if (c < NCK) {
                bf16_t* pl = PL + (k & 1) * 64 * R2LD;
                *(u32x4*)(pl + lrow * R2LD + lcol) = pq[k][0]; *(u32x4*)(pl + lrow * R2LD + lcol + 8) = pq[k][1];
                const U2 s0 = sa[k][0], s1 = sa[k][1], s2 = sa[k][2], s3 = sa[k][3];
                {
                    const int cn = (c + R2D < NCK) ? c + R2D : NCK - 1;
                    const unsigned char* chp = chbase + (size_t)cn * CH_BYTES;
                    const bf16_t* gp = (const bf16_t*)(chp + CH_PM) + lrow * 64 + lcol;
                    pq[k][0] = *(const u32x4*)gp; pq[k][1] = *(const u32x4*)(gp + 8);
#pragma unroll
                    for (int nt = 0; nt < 4; ++nt) sa[k][nt] = ldu2((const bf16_t*)(chp + CH_SA) + i * 64 + nt * 16 + 4 * q);
                }
                __syncthreads();
                bf16_t* gSA = (bf16_t*)(chbase + (size_t)c * CH_BYTES + CH_SA) + i * 64 + 4 * q;
                bf16x8 bfr[2];
#pragma unroll
                for (int ks = 0; ks < 2; ++ks) {
                    const U2 lo = pack4(st[2 * ks]), hi = pack4(st[2 * ks + 1]);
                    bfr[ks] = __builtin_bit_cast(bf16x8, u32x4{lo.x, lo.y, hi.x, hi.y});
                    *(U2*)(gSA + (2 * ks) * 16) = lo; *(U2*)(gSA + (2 * ks + 1) * 16) = hi;
                }
#pragma unroll
                for (int nt = 0; nt < 4; ++nt) {
                    const U2 sv = nt == 0 ? s0 : nt == 1 ? s1 : nt == 2 ? s2 : s3;
                    f32x4 acc = f32x4{bitsf(sv.x << 16), bitsf(sv.x & 0xFFFF0000u), bitsf(sv.y << 16), bitsf(sv.y & 0xFFFF0000u)};
#pragma unroll
                    for (int ks = 0; ks < 2; ++ks) {
                        const U2 lo = *(const U2*)(pl + (nt * 16 + l15) * R2LD + 32 * ks + 4 * q), hi = *(const U2*)(pl + (nt * 16 + l15) * R2LD + 32 * ks + 16 + 4 * q);
                        acc = MFMA16(__builtin_bit_cast(bf16x8, u32x4{lo.x, lo.y, hi.x, hi.y}), bfr[ks], acc);
                    }
                    st[nt] = acc;
                }
                }
            }
        }
        __syncthreads();
    }
}

__device__ void phaseR3(const Params& p, int bid, int nblk, char* smem) {
    const bf16_t* P = WSP(bf16_t, WS_R1);
    const unsigned char* CH = p.ws + WS_CH;
    const float* RBON = WSP(float, WS_RBON);
    bf16_t* MIX = WSP(bf16_t, WS_R3);
    float* red = (float*)smem;
    const int tid = threadIdx.x, lane = tid & 63, wave = tid >> 6, q = lane >> 4, l15 = lane & 15;
    for (int m = bid * 256 + tid; m < MLAT; m += nblk * 256) {
        const float* sp = WSP(float, WS_SSQP) + (size_t)m * LRU_BLOCKS;
        float sq = 0.f;
#pragma unroll
        for (int c = 0; c < LRU_BLOCKS; ++c) sq += sp[c];
        WSP(float, WS_RINV)[m] = frsq(sq * (1.0f / D_LRU) + RMS_EPS);
    }
    bf16_t* G2T = (bf16_t*)(smem + 1024);
    const int nbh = nblk / HEADS;
    int hcur = -1;
    const bool uniform = (nbh > 0) && (nblk % HEADS == 0);
    const int nrest = BATCH * NLC;
    for (int itx = uniform ? (bid % nbh) : bid; itx < (uniform ? nrest : nrest * HEADS); itx += uniform ? nbh : nblk) {
        int h, rest;
        if (uniform) { h = bid / nbh; rest = itx; } else { h = itx % HEADS; rest = itx / HEADS; }
        const int pc = rest % NLC, b = rest / NLC;
        if (h != hcur) {
            __syncthreads();
            for (int idx = tid; idx < 128 * 16; idx += 256) {
                const int c = idx >> 4, i4 = (idx & 15) * 4;
                const f32x4 w = ld4(p.g2 + (size_t)c * D_RWKV + h * 64 + i4);
                bf16_t* dst = G2T + i4 * 136 + c;
                dst[0] = f2bf(w[0]); dst[136] = f2bf(w[1]); dst[272] = f2bf(w[2]); dst[408] = f2bf(w[3]);
            }
            hcur = h;
            __syncthreads();
        }
        const int i0 = wave * 16 + q * 4;
        f32x4 y[2] = {f32x4{0.f, 0.f, 0.f, 0.f}, f32x4{0.f, 0.f, 0.f, 0.f}};
        float bon[2] = {0.f, 0.f};
#pragma unroll
        for (int d = 0; d < 2; ++d) {
            const int chain = (b * HEADS + h) * 2 + d, c = NCC + (d ? NLC - 1 - pc : pc);
            const size_t item = (size_t)chain * NCK + c;
            const unsigned char* chp = CH + item * CH_BYTES;
            const bf16_t* gS = (const bf16_t*)(chp + CH_SA); const bf16_t* gQT = (const bf16_t*)(chp + CH_QT); const bf16_t* gY0 = (const bf16_t*)(chp + CH_Y0);
#pragma unroll
            for (int nb = 0; nb < 2; ++nb) {
                const int pl = nb * 16 + l15, tau = d ? RC - 1 - pl : pl;
                const U2 y0 = ldu2(gY0 + tau * 64 + i0);
                f32x4 acc = f32x4{bitsf(y0.x << 16), bitsf(y0.x & 0xFFFF0000u), bitsf(y0.y << 16), bitsf(y0.y & 0xFFFF0000u)};
#pragma unroll
                for (int ks = 0; ks < 2; ++ks) {
                    const bf16x8 xf = *(const bf16x8*)(gS + (wave * 16 + l15) * 64 + ks * 32 + 8 * q);
                    const bf16x8 yf = *(const bf16x8*)(gQT + tau * 64 + ks * 32 + 8 * q);
                    acc = MFMA16(xf, yf, acc);
                }
                y[nb] += acc;
                bon[nb] += RBON[item * RC + tau];
            }
        }
        f32x4 g[2] = {f32x4{0.f, 0.f, 0.f, 0.f}, f32x4{0.f, 0.f, 0.f, 0.f}};
#pragma unroll
        for (int ks = 0; ks < 4; ++ks) {
            const bf16x8 xf = *(const bf16x8*)(G2T + (wave * 16 + l15) * 136 + ks * 32 + 8 * q);
#pragma unroll
            for (int nb = 0; nb < 2; ++nb) {
                const int pos = pc * RC + nb * 16 + l15;
                float o[8]; shifted8(p, P, 1, b, pos, SEQ, 3 * D_RWKV + 256 + ks * 32 + 8 * q, o);
                u32x4 t; t[0] = pk2(fsigm(o[0]), fsigm(o[1])); t[1] = pk2(fsigm(o[2]), fsigm(o[3])); t[2] = pk2(fsigm(o[4]), fsigm(o[5])); t[3] = pk2(fsigm(o[6]), fsigm(o[7]));
                g[nb] = MFMA16(xf, __builtin_bit_cast(bf16x8, t), g[nb]);
            }
        }
        float s1[2], s2[2];
#pragma unroll
        for (int nb = 0; nb < 2; ++nb) {
            float a = hsum4(y[nb]), bq = hsum4(y[nb] * y[nb]);
            a += __shfl_xor(a, 16); a += __shfl_xor(a, 32); bq += __shfl_xor(bq, 16); bq += __shfl_xor(bq, 32);
            s1[nb] = a; s2[nb] = bq;
        }
        __syncthreads();
        if (q == 0) { red[(0 * 4 + wave) * 32 + l15] = s1[0]; red[(0 * 4 + wave) * 32 + 16 + l15] = s1[1]; red[(1 * 4 + wave) * 32 + l15] = s2[0]; red[(1 * 4 + wave) * 32 + 16 + l15] = s2[1]; }
        __syncthreads();
        const f32x4 gng = ld4(p.gn_g + h * 64 + i0), gnb = ld4(p.gn_b + h * 64 + i0);
#pragma unroll
        for (int nb = 0; nb < 2; ++nb) {
            const int pl = nb * 16 + l15, pos = pc * RC + pl;
            float t1 = 0.f, t2 = 0.f;
#pragma unroll
            for (int w = 0; w < 4; ++w) { t1 += red[(0 * 4 + w) * 32 + pl]; t2 += red[(1 * 4 + w) * 32 + pl]; }
            const float mu = t1 * (1.0f / 64.0f), var = fmaxf(t2 * (1.0f / 64.0f) - mu * mu, 0.f), rstd = frsq(var + GN_EPS);
            const int chv = 2 * D_RWKV + h * 64 + i0;
            const size_t mrow = rwkv_row(1, b, pos);
            const U2 zc = ldu2(P + mrow * D_IN + RW0 + chv);
            U2 zp; zp.x = 0u; zp.y = 0u; U2 zn = zp;
            if (pos > 0) zp = ldu2(P + rwkv_row(1, b, pos - 1) * D_IN + RW0 + chv);
            if (pos < SEQ - 1) zn = ldu2(P + rwkv_row(1, b, pos + 1) * D_IN + RW0 + chv);
            const f32x4 z = f32x4{bitsf(zc.x << 16), bitsf(zc.x & 0xFFFF0000u), bitsf(zc.y << 16), bitsf(zc.y & 0xFFFF0000u)};
            const f32x4 zpv = f32x4{bitsf(zp.x << 16), bitsf(zp.x & 0xFFFF0000u), bitsf(zp.y << 16), bitsf(zp.y & 0xFFFF0000u)};
            const f32x4 znv = f32x4{bitsf(zn.x << 16), bitsf(zn.x & 0xFFFF0000u), bitsf(zn.y << 16), bitsf(zn.y & 0xFFFF0000u)};
            const f32x4 v = z + ld4(p.mu_prev + chv) * (zpv - z) + ld4(p.mu_next + chv) * (znv - z);
            const f32x4 yn = (y[nb] - mu) * rstd * gng + gnb;
            *(U2*)(MIX + mrow * D_MIX + D_LRU + h * 64 + i0) = pack4((yn + bon[nb] * v) * g[nb]);
        }
    }
}

__device__ void phaseJ(const Params& p, int bid, int nblk, char* smem) {
    const bf16_t* MIX = WSP(bf16_t, WS_R3); const bf16_t* WB = WSP(bf16_t, WS_WBOUT);
    bf16_t* YOUT = WSP(bf16_t, WS_R1);
    const float* RINV = WSP(float, WS_RINV);
    constexpr int BM = 32 * MI_J, NTN = D_MODEL / 128, NTM = MLAT / BM;
    constexpr int GM = (NTM % 8 == 0) ? 8 : 1;
    for (int it = xcd_vbid(bid, nblk); it < NTN * NTM; it += nblk) {
        const int mg = it / (GM * NTN), r = it % (GM * NTN), nt = r / GM, mt = mg * GM + (r % GM);
        gemm_tile<MI_J, false>(smem, MIX, D_MIX, nullptr, mt * BM, WB, nullptr, D_MIX, nt * 128, D_MIX, [&](int ml, int nl, f32x4 v, f32x4) {
            *(U2*)(YOUT + (size_t)(mt * BM + ml) * D_MODEL + nt * 128 + nl) = pack4(v);
        }, RINV, D_LRU / 64);
    }
}

constexpr int KUL = D_MODEL + 2;
static_assert((16 * KUL + 4 * 256) * 4 <= SMEM_BYTES && N_EXPERTS <= 16 && MLAT % 16 == 0, "phase K lds");
__device__ void phaseK(const Params& p, int bid, int nblk, char* smem) {
    const int tid = threadIdx.x, lane = tid & 63, wave = tid >> 6, q = lane >> 4, l15 = lane & 15;
    const float* MOD = WSP(float, WS_MOD); const float* STATS = WSP(float, WS_STATS);
    const bf16_t* YOUT = WSP(bf16_t, WS_R1);
    float* H1 = WSP(float, WS_R5); bf16_t* U2b = WSP(bf16_t, WS_R6); float* AFF = WSP(float, WS_AFF);
    float* UL = (float*)smem;
    float* PL = UL + 16 * KUL;
    for (int rb = bid; rb < MLAT / 16; rb += nblk) {
        __syncthreads();
#pragma unroll 1
        for (int rr = 0; rr < 4; ++rr) {
            const int lr = wave * 4 + rr, row = rb * 16 + lr;
            const float* xr = p.x + (size_t)row * D_MODEL;
            const float* md = MOD + (size_t)(row / SEQ) * 6 * D_MODEL;
            const float mu0 = STATS[row * 2], rs0 = STATS[row * 2 + 1];
            f32x4 v0, v1, v2, v3; float s = 0.f;
#define PK_LOAD(V, J) { const int k = (J) * 256 + lane * 4; \
            V = ALPHA_F * ((ld4(xr + k) - mu0) * rs0 * ld4(p.ln_in_g + k) + ld4(p.ln_in_b + k)) + ld4(md + 2 * D_MODEL + k) * ldb4(YOUT + (size_t)row * D_MODEL + k); s += hsum4(V); }
            PK_LOAD(v0, 0)
            if (NV > 1) PK_LOAD(v1, 1) else v1 = f32x4{0.f, 0.f, 0.f, 0.f};
            if (NV > 2) { PK_LOAD(v2, 2) PK_LOAD(v3, 3) } else { v2 = v1; v3 = v1; }
#undef PK_LOAD
            const float mu = wave_sum(s) * (1.0f / D_MODEL);
            v0 -= mu; float s2 = hsum4(v0 * v0);
            if (NV > 1) { v1 -= mu; s2 += hsum4(v1 * v1); }
            if (NV > 2) { v2 -= mu; v3 -= mu; s2 += hsum4(v2 * v2) + hsum4(v3 * v3); }
            const float rstd = frsq(wave_sum(s2) * (1.0f / D_MODEL) + LN_EPS);
#pragma unroll
            for (int j = 0; j < NV; ++j) {
                const int k = j * 256 + lane * 4;
                const f32x4 vv = (j == 0) ? v0 : (j == 1) ? v1 : (j == 2) ? v2 : v3;
                const f32x4 h = vv * rstd * ld4(p.ln1_g + k) + ld4(p.ln1_b + k);
                *(f32x4*)(H1 + (size_t)row * D_MODEL + k) = h;
                const f32x4 u = h * (1.0f + ld4(md + 4 * D_MODEL + k)) + ld4(md + 3 * D_MODEL + k);
                *(U2*)(U2b + (size_t)row * D_MODEL + k) = pack4(u);
                float* ul = UL + lr * KUL + k;
                *(f32x2_e*)ul = f32x2_e{u[0], u[1]}; *(f32x2_e*)(ul + 2) = f32x2_e{u[2], u[3]};
            }
        }
        __syncthreads();
        {
            f32x4 acc = f32x4{0.f, 0.f, 0.f, 0.f};
            const int kq0 = wave * (D_MODEL / 4);
#pragma unroll 8
            for (int s4 = 0; s4 < D_MODEL / 16; ++s4) {
                const int k = kq0 + s4 * 4 + q;
                const float av = UL[l15 * KUL + k];
                const float bv = (l15 < N_EXPERTS) ? p.w_router[(size_t)k * N_EXPERTS + l15] : 0.f;
                acc = MFMAF32(av, bv, acc);
            }
#pragma unroll
            for (int r = 0; r < 4; ++r) PL[wave * 256 + (q * 4 + r) * 16 + l15] = acc[r];
        }
        __syncthreads();
        {
            const int lr = tid >> 4, e = tid & 15;
            const bool valid = e < N_EXPERTS;
            float lg = PL[tid] + PL[256 + tid] + PL[512 + tid] + PL[768 + tid];
            float mx = valid ? lg : -3.0e38f;
#pragma unroll
            for (int o = 1; o < 16; o <<= 1) mx = fmaxf(mx, __shfl_xor(mx, o));
            const float ex = valid ? expf(lg - mx) : 0.f;
            float den = ex;
#pragma unroll
            for (int o = 1; o < 16; o <<= 1) den += __shfl_xor(den, o);
            if (valid) AFF[(size_t)(rb * 16 + lr) * N_EXPERTS + e] = ex / den;
        }
    }
}

__device__ __forceinline__ int block_sum_int(int v, int* red) {
    const int lane = threadIdx.x & 63, wave = threadIdx.x >> 6;
#pragma unroll
    for (int o = 1; o < 64; o <<= 1) v += __shfl_xor(v, o);
    __syncthreads();
    if (lane == 0) red[wave] = v;
    __syncthreads();
    return red[0] + red[1] + red[2] + red[3];
}
__device__ void phaseL(const Params& p, int bid, int nblk, char* smem) {
    const float* AFF = WSP(float, WS_AFF);
    int* IDX = WSP(int, WS_IDX); float* GATE = WSP(float, WS_GATE); int* SLOTOF = WSP(int, WS_SLOT);
    unsigned* vals = (unsigned*)smem;
    int* red = (int*)(vals + SEQ);
    int* wsum = red + 8;
    const int tid = threadIdx.x, lane = tid & 63, wave = tid >> 6;
    constexpr int PER = SEQ / 256;
    {
        constexpr int NL = BATCH * N_EXPERTS;
        const bool spare = nblk > NL + 32;
        if (spare ? (bid >= NL) : true) convert_experts(p, spare ? bid - NL : bid, spare ? nblk - NL : nblk, smem, 0, 2);
        if (spare && bid >= NL) return;
        __syncthreads();
    }
    for (int be = bid; be < BATCH * N_EXPERTS; be += nblk) {
        const int b = be / N_EXPERTS, e = be % N_EXPERTS;
        __syncthreads();
        for (int t = tid; t < SEQ; t += 256) vals[t] = fbits(AFF[((size_t)b * SEQ + t) * N_EXPERTS + e]);
        __syncthreads();
        unsigned lo = 0u, hi = 0x7F800000u;
        while (lo < hi) {
            const unsigned mid = lo + (hi - lo + 1u) / 2u;
            int c = 0;
            for (int t = tid; t < SEQ; t += 256) c += (vals[t] >= mid) ? 1 : 0;
            c = block_sum_int(c, red);
            if (c >= CAP) lo = mid; else hi = mid - 1u;
        }
        const unsigned T = lo;
        int cg = 0, ce = 0;
        for (int q = 0; q < PER; ++q) { const unsigned v = vals[tid * PER + q]; cg += (v > T) ? 1 : 0; ce += (v == T) ? 1 : 0; }
        int pg = cg, pe = ce;
#pragma unroll
        for (int o = 1; o < 64; o <<= 1) { const int a = __shfl_up(pg, o), bb = __shfl_up(pe, o); if (lane >= o) { pg += a; pe += bb; } }
        __syncthreads();
        if (lane == 63) { wsum[wave] = pg; wsum[4 + wave] = pe; }
        __syncthreads();
        int og = 0, oe = 0, totg = 0;
        for (int w = 0; w < 4; ++w) { if (w < wave) { og += wsum[w]; oe += wsum[4 + w]; } totg += wsum[w]; }
        int posg = og + pg - cg, pose = oe + pe - ce;
        const int need_eq = CAP - totg;
        for (int q = 0; q < PER; ++q) {
            const int t = tid * PER + q; const unsigned v = vals[t];
            int slot = -1;
            if (v > T) { slot = posg++; }
            else if (v == T) { if (pose < need_eq) slot = totg + pose; pose++; }
            if (slot >= 0) { IDX[(size_t)be * CAP + slot] = b * SEQ + t; GATE[(size_t)be * CAP + slot] = bitsf(v); }
            SLOTOF[((size_t)b * SEQ + t) * N_EXPERTS + e] = slot;
        }
    }
}

__device__ void phaseM(const Params& p, int bid, int nblk, char* smem) {
    const bf16_t* U2b = WSP(bf16_t, WS_R6); const int* IDX = WSP(int, WS_IDX);
    bf16_t* HID = WSP(bf16_t, WS_R1);
    constexpr int BM = 32 * MI_E, NTN = D_EXPERT / 64, NTM = CAP / BM;
    for (int it = xcd_vbid(bid, nblk); it < BATCH * N_EXPERTS * NTM * NTN; it += nblk) {
        const int mt = it % NTM, b = (it / NTM) % BATCH, nt = (it / (NTM * BATCH)) % NTN, e = it / (NTM * BATCH * NTN), be = b * N_EXPERTS + e;
        const bf16_t* wg = WSP(bf16_t, WS_WG + (size_t)e * WEXP_BYTES); const bf16_t* wu = WSP(bf16_t, WS_WU + (size_t)e * WEXP_BYTES);
        gemm_tile<MI_E, true>(smem, U2b, D_MODEL, IDX + (size_t)be * CAP, mt * BM, wg, wu, D_MODEL, nt * 64, D_MODEL, [&](int ml, int nl, f32x4 g, f32x4 u) {
            U2 o; o.x = pk2(siluf_(g[0]) * u[0], siluf_(g[1]) * u[1]); o.y = pk2(siluf_(g[2]) * u[2], siluf_(g[3]) * u[3]);
            *(U2*)(HID + ((size_t)be * CAP + mt * BM + ml) * D_EXPERT + nt * 64 + nl) = o;
        });
    }
    {
        constexpr int NT = BATCH * N_EXPERTS * NTM * NTN;
        const int rem = NT % nblk, vb = xcd_vbid(bid, nblk);
        if (rem == 0 || nblk - rem < 32) convert_experts(p, vb, nblk, smem, 2, 3);
        else if (vb >= rem) convert_experts(p, vb - rem, nblk - rem, smem, 2, 3);
    }
}
__device__ void phaseN(const Params& p, int bid, int nblk, char* smem) {
    const bf16_t* HID = WSP(bf16_t, WS_R1); const float* GATE = WSP(float, WS_GATE);
    bf16_t* YS = WSP(bf16_t, WS_R2);
    constexpr int BM = 32 * MI_E, NTN = D_MODEL / 128, NTM = CAP / BM;
    for (int it = xcd_vbid(bid, nblk); it < BATCH * N_EXPERTS * NTM * NTN; it += nblk) {
        const int mt = it % NTM, b = (it / NTM) % BATCH, nt = (it / (NTM * BATCH)) % NTN, e = it / (NTM * BATCH * NTN), be = b * N_EXPERTS + e;
        const bf16_t* wd = WSP(bf16_t, wdown_off(e));
        gemm_tile<MI_E, false>(smem, HID + (size_t)be * CAP * D_EXPERT, D_EXPERT, nullptr, mt * BM, wd, nullptr, D_EXPERT, nt * 128, D_EXPERT, [&](int ml, int nl, f32x4 v, f32x4) {
            const int slot = mt * BM + ml;
            const float gt = GATE[(size_t)be * CAP + slot];
            *(U2*)(YS + ((size_t)be * CAP + slot) * D_MODEL + nt * 128 + nl) = pack4(v * gt);
        });
    }
}
__device__ void phaseO(const Params& p, int bid, int nblk, char* smem) {
    const int lane = threadIdx.x & 63, wave = threadIdx.x >> 6;
    const float* MOD = WSP(float, WS_MOD); const float* H1 = WSP(float, WS_R5); const bf16_t* YS = WSP(bf16_t, WS_R2); const int* SLOTOF = WSP(int, WS_SLOT);
    for (int row = bid * 4 + wave; row < MLAT; row += nblk * 4) {
        const float* md = MOD + (size_t)(row / SEQ) * 6 * D_MODEL;
        f32x4 v0, v1, v2, v3; float s = 0.f;
        f32x4 y0 = f32x4{0.f, 0.f, 0.f, 0.f}, y1 = y0, y2 = y0, y3 = y0;
        const int myslot = (lane < N_EXPERTS) ? SLOTOF[(size_t)row * N_EXPERTS + lane] : -1;
        const int bbase = (row / SEQ) * N_EXPERTS;
        for (int e = 0; e < N_EXPERTS; ++e) {
            const int sl = __shfl(myslot, e);
            if (sl >= 0) {
                const bf16_t* yr = YS + ((size_t)(bbase + e) * CAP + sl) * D_MODEL + lane * 4;
                { const U2 u = *(const U2*)yr; y0 += f32x4{bitsf(u.x << 16), bitsf(u.x & 0xFFFF0000u), bitsf(u.y << 16), bitsf(u.y & 0xFFFF0000u)}; }
                if (NV > 1) { const U2 u = *(const U2*)(yr + 256); y1 += f32x4{bitsf(u.x << 16), bitsf(u.x & 0xFFFF0000u), bitsf(u.y << 16), bitsf(u.y & 0xFFFF0000u)}; }
                if (NV > 2) { const U2 u = *(const U2*)(yr + 512); y2 += f32x4{bitsf(u.x << 16), bitsf(u.x & 0xFFFF0000u), bitsf(u.y << 16), bitsf(u.y & 0xFFFF0000u)};
                              const U2 w = *(const U2*)(yr + 768); y3 += f32x4{bitsf(w.x << 16), bitsf(w.x & 0xFFFF0000u), bitsf(w.y << 16), bitsf(w.y & 0xFFFF0000u)}; }
            }
        }
#define PO_LOAD(V, J) { const int k = (J) * 256 + lane * 4; const f32x4 yy = ((J) == 0) ? y0 : ((J) == 1) ? y1 : ((J) == 2) ? y2 : y3; V = ALPHA_F * ld4(H1 + (size_t)row * D_MODEL + k) + ld4(md + 5 * D_MODEL + k) * yy; s += hsum4(V); }
        PO_LOAD(v0, 0)
        if (NV > 1) PO_LOAD(v1, 1) else v1 = f32x4{0.f, 0.f, 0.f, 0.f};
        if (NV > 2) { PO_LOAD(v2, 2) PO_LOAD(v3, 3) } else { v2 = v1; v3 = v1; }
#undef PO_LOAD
        const float mu = wave_sum(s) * (1.0f / D_MODEL);
        v0 -= mu; float s2 = hsum4(v0 * v0);
        if (NV > 1) { v1 -= mu; s2 += hsum4(v1 * v1); }
        if (NV > 2) { v2 -= mu; v3 -= mu; s2 += hsum4(v2 * v2) + hsum4(v3 * v3); }
        const float rstd = frsq(wave_sum(s2) * (1.0f / D_MODEL) + LN_EPS);
#pragma unroll
        for (int j = 0; j < NV; ++j) {
            const int k = j * 256 + lane * 4;
            const f32x4 vv = (j == 0) ? v0 : (j == 1) ? v1 : (j == 2) ? v2 : v3;
            *(f32x4*)(p.out + (size_t)row * D_MODEL + k) = vv * rstd * ld4(p.ln2_g + k) + ld4(p.ln2_b + k);
        }
    }
}

#define XB_TMO      128
#define XB_XCNT(j)  (256  + 64 * (j))
#define XB_XSUB(j)  (1280 + 64 * (j))
#define XB_XGEN(j)  (2304 + 64 * (j))
#define XB_TOP      3328
#define XB_TOPGEN   3392
#define XCD_BAR_WORDS 3456
#define XB_SPIN_CAP (1u << 22)
#ifndef HOST_EMU
__device__ __forceinline__ unsigned xb_ld(unsigned* p) { return __hip_atomic_load(p, __ATOMIC_RELAXED, __HIP_MEMORY_SCOPE_AGENT); }
__device__ __forceinline__ unsigned xb_add(unsigned* p, unsigned v) { return __hip_atomic_fetch_add(p, v, __ATOMIC_RELAXED, __HIP_MEMORY_SCOPE_AGENT); }
__device__ __forceinline__ unsigned xb_xcc_id() { return (unsigned)__builtin_amdgcn_s_getreg((3 << 11) | 20) & 0xFu; }
#define XB_SPIN(cond, bar) do { unsigned _sp = 0; while (cond) { __builtin_amdgcn_s_sleep(1); \
    if ((++_sp & 255u) == 0u) { if (xb_ld(&(bar)[XB_TMO])) break; if (_sp > XB_SPIN_CAP) { atomicAdd(&(bar)[XB_TMO], 1u); break; } } } } while (0)
#define XB_LAS __attribute__((address_space(3)))
struct XcdBarrier { unsigned off; unsigned x; volatile XB_LAS unsigned* st; unsigned G; };
__device__ __forceinline__ XcdBarrier xcd_barrier_post(unsigned* ctrl, unsigned off, volatile XB_LAS unsigned* st, unsigned G, bool member = true) {
    XcdBarrier b; b.off = off; b.x = xb_xcc_id(); b.st = st; b.G = G; unsigned* bar = ctrl + off;
    if (!member) return b;
    if (threadIdx.x == 0) (void)xb_add(&bar[XB_XCNT(b.x)], 1u);
    return b;
}
__device__ __forceinline__ void xcd_barrier_complete(unsigned* bar, unsigned x, unsigned& nloc, unsigned& nx, unsigned G) {
    unsigned sum, cnt, mine, sp = 0u;
    for (;;) {
        sum = 0u; cnt = 0u; mine = 0u;
#pragma unroll
        for (unsigned j = 0; j < 16; ++j) { const unsigned c = xb_ld(&bar[XB_XCNT(j)]); sum += c; cnt += (c > 0u) ? 1u : 0u; mine = (j == x) ? c : mine; }
        if (sum == G) break;
        __builtin_amdgcn_s_sleep(1);
        if ((++sp & 255u) == 0u) { if (xb_ld(&bar[XB_TMO])) break; if (sp > XB_SPIN_CAP) { atomicAdd(&bar[XB_TMO], 1u); break; } }
    }
    nloc = mine > 0u ? mine : 1u; nx = cnt > 0u ? cnt : 1u;
}
__device__ __forceinline__ void grid_barrier(const XcdBarrier& b, unsigned* ctrl) {
    asm volatile("s_waitcnt vmcnt(0)" ::: "memory");
    __syncthreads();
    if (threadIdx.x == 0) {
        unsigned* bar = ctrl + b.off;
        __builtin_amdgcn_s_waitcnt(0);
        volatile XB_LAS unsigned* st = b.st;
        unsigned nloc = st[0], nx = st[1];
        if (nloc == 0u) { xcd_barrier_complete(bar, b.x, nloc, nx, b.G); st[0] = nloc; st[1] = nx; }
        const unsigned old = xb_add(&bar[XB_XSUB(b.x)], 1u);
        const unsigned gen = old / nloc;
        if (old + 1u == (gen + 1u) * nloc) {
            __builtin_amdgcn_fence(__ATOMIC_RELEASE, "agent");
            asm volatile("s_waitcnt vmcnt(0)" ::: "memory");
            const unsigned og = xb_add(&bar[XB_TOP], 1u);
            const unsigned tg = og / nx;
            if (og + 1u == (tg + 1u) * nx) xb_add(&bar[XB_TOPGEN], 1u);
            else XB_SPIN(xb_ld(&bar[XB_TOPGEN]) == tg, bar);
            __builtin_amdgcn_fence(__ATOMIC_ACQUIRE, "agent");
            xb_add(&bar[XB_XGEN(b.x)], 1u);
            asm volatile("s_waitcnt vmcnt(0)" ::: "memory");
        } else {
            XB_SPIN(xb_ld(&bar[XB_XGEN(b.x)]) == gen, bar);
            __builtin_amdgcn_fence(__ATOMIC_ACQUIRE, "agent");
            asm volatile("s_waitcnt vmcnt(0)" ::: "memory");
        }
    }
    __syncthreads();
}
#else
struct XcdBarrier { int dummy; };
__device__ __forceinline__ void grid_barrier(const XcdBarrier&, unsigned*) { __syncthreads(); }
#endif

__global__ void __launch_bounds__(256, 2) fused_forward(Params p) {
    __shared__ __attribute__((aligned(16))) char smem[SMEM_BYTES];
    __shared__ __attribute__((aligned(16))) unsigned xb_words[4];
    if (threadIdx.x == 0) { xb_words[0] = 0u; xb_words[1] = 0u; xb_words[2] = 0u; xb_words[3] = 0u; }
    __syncthreads();
    const int bid = blockIdx.x, nblk = gridDim.x;
    const bool split = nblk >= 2 * NCHAIN;
#ifdef HOST_EMU
    const XcdBarrier gb{0}; const XcdBarrier gs{0};
#else
    const XcdBarrier gb = xcd_barrier_post(WSP(unsigned, WS_CTRL), 0u, (volatile XB_LAS unsigned*)xb_words, (unsigned)nblk);
    const XcdBarrier gs = xcd_barrier_post(WSP(unsigned, WS_CTRL), (unsigned)XCD_BAR_WORDS, (volatile XB_LAS unsigned*)xb_words + 2, (unsigned)(nblk - NCHAIN), split && bid >= NCHAIN);
#endif
    phaseA(p, bid, nblk, smem); grid_barrier(gb, WSP(unsigned, WS_CTRL));
    phaseB(p, bid, nblk, smem); grid_barrier(gb, WSP(unsigned, WS_CTRL));
    phaseC(p, bid, nblk, smem); grid_barrier(gb, WSP(unsigned, WS_CTRL));
    phaseD(p, bid, nblk, smem);
    phaseR1(p, bid, nblk, smem); grid_barrier(gb, WSP(unsigned, WS_CTRL));
    {
        const int lb = split ? bid - NCHAIN : bid, ln = split ? nblk - NCHAIN : nblk;
        const bool lru_member = !split || bid >= NCHAIN;
        if (!split || bid < NCHAIN) phaseR2(p, bid, split ? NCHAIN : nblk, smem);
        if (lru_member) phaseE(p, lb, ln, smem);
        if (split) { if (lru_member) grid_barrier(gs, WSP(unsigned, WS_CTRL)); } else grid_barrier(gb, WSP(unsigned, WS_CTRL));
        if (lru_member) phaseF(p, lb, ln, smem);
        grid_barrier(gb, WSP(unsigned, WS_CTRL));
    }
    phaseR3(p, bid, nblk, smem); grid_barrier(gb, WSP(unsigned, WS_CTRL));
    phaseJ(p, bid, nblk, smem); grid_barrier(gb, WSP(unsigned, WS_CTRL));
    phaseK(p, bid, nblk, smem); grid_barrier(gb, WSP(unsigned, WS_CTRL));
    phaseL(p, bid, nblk, smem); grid_barrier(gb, WSP(unsigned, WS_CTRL));
    phaseM(p, bid, nblk, smem); grid_barrier(gb, WSP(unsigned, WS_CTRL));
    phaseN(p, bid, nblk, smem); grid_barrier(gb, WSP(unsigned, WS_CTRL));
    phaseO(p, bid, nblk, smem);
}

#ifdef MULTI_LAUNCH
#define PHASE_KERNEL(NAME) \
    __global__ void __launch_bounds__(256) k_##NAME(Params p) { __shared__ __attribute__((aligned(16))) char smem[SMEM_BYTES]; NAME(p, blockIdx.x, gridDim.x, smem); }
PHASE_KERNEL(phaseA) PHASE_KERNEL(phaseB) PHASE_KERNEL(phaseC) PHASE_KERNEL(phaseD) PHASE_KERNEL(phaseE) PHASE_KERNEL(phaseF) PHASE_KERNEL(phaseR1) PHASE_KERNEL(phaseR2) PHASE_KERNEL(phaseR3)
PHASE_KERNEL(phaseJ) PHASE_KERNEL(phaseK) PHASE_KERNEL(phaseL) PHASE_KERNEL(phaseM) PHASE_KERNEL(phaseN) PHASE_KERNEL(phaseO)
#ifdef HOST_EMU
void emu_hook(const char* name, const Params& p);
#define LAUNCH(NAME, grid) do { EMU_LAUNCH(k_##NAME, grid, 256, p); emu_hook(#NAME, p); } while (0)
#else
#define LAUNCH(NAME, grid) hipLaunchKernelGGL(k_##NAME, dim3(grid), dim3(256), 0, stream, p)
#endif
#endif

extern "C" void kernel_launch(void* const* d_in, const int* in_sizes, int n_in, void* d_out, int out_size, void* d_ws, size_t ws_size, hipStream_t stream) {
    if (n_in != 38 || out_size != MLAT * D_MODEL || ws_size < WS_END) { fprintf(stderr, "kernel_launch: unexpected shapes (n_in %d out %d ws %zu need %zu)\n", n_in, out_size, ws_size, (size_t)WS_END); return; }
    Params p{};
    const float** f = (const float**)&p;
    for (int i = 0; i < 38; ++i) f[i] = (const float*)d_in[i];
    p.out = (float*)d_out; p.ws = (unsigned char*)d_ws;
#ifdef MULTI_LAUNCH
    const int G = 512;
    LAUNCH(phaseA, 6 * D_MODEL / 16);
    LAUNCH(phaseB, G);
    LAUNCH(phaseC, G);
    LAUNCH(phaseD, G);
    LAUNCH(phaseE, 16);
    LAUNCH(phaseF, G);
    LAUNCH(phaseR1, G);
    LAUNCH(phaseR2, NCHAIN);
    LAUNCH(phaseR3, G);
    LAUNCH(phaseJ, G);
    LAUNCH(phaseK, G);
    LAUNCH(phaseL, BATCH * N_EXPERTS);
    LAUNCH(phaseM, G);
    LAUNCH(phaseN, G);
    LAUNCH(phaseO, G);
#elif defined(HOST_EMU)
    EMU_LAUNCH(fused_forward, 1, 256, p);
#else
    static int grid_blocks = 0;
    if (!grid_blocks) {
        int dev = 0, cus = 0, per_cu = 0;
        (void)hipGetDevice(&dev);
        (void)hipDeviceGetAttribute(&cus, hipDeviceAttributeMultiprocessorCount, dev);
        (void)hipOccupancyMaxActiveBlocksPerMultiprocessor(&per_cu, fused_forward, 256, 0);
        if (per_cu > 2) per_cu = 2;
        if (per_cu < 1) { fprintf(stderr, "kernel_launch: occupancy query returned %d blocks per CU\n", per_cu); per_cu = 1; }
        grid_blocks = cus * per_cu;
    }
    (void)hipMemsetAsync((char*)d_ws + WS_CTRL, 0, 2 * XCD_BAR_WORDS * 4, stream);
    void* args[] = {&p};
    hipError_t e = hipLaunchCooperativeKernel((void*)fused_forward, dim3(grid_blocks), dim3(256), args, 0, stream);
    if (e != hipSuccess) fprintf(stderr, "cooperative launch failed: %s (grid %d)\n", hipGetErrorString(e), grid_blocks);
#endif
}
```

```cpp
#ifndef HOST_EMU
#include <hip/hip_runtime.h>
#include <cstdio>
#endif
#include <cstdint>
#include <cstddef>

#ifdef CFG_SMALL
constexpr int D_MODEL = 256, BATCH = 2, SEQ = 256, GRID_W = 16, CTX_LEN = 64, LRU_BLOCKS = 2, N_EXPERTS = 4, D_EXPERT = 256;
#else
constexpr int D_MODEL = 1024, BATCH = 4, SEQ = 4096, GRID_W = 64, CTX_LEN = 256, LRU_BLOCKS = 8, N_EXPERTS = 16, D_EXPERT = 1408;
#endif
constexpr int ROWS = SEQ / GRID_W;
constexpr int D_LRU = D_MODEL / 2, LRU_BLOCK = 64;
constexpr int D_RWKV = D_MODEL / 2, HEADS = D_RWKV / 64;
constexpr int D_RWKV_IN = 3 * D_RWKV + 128 + 128 + 128;
constexpr int D_IN = 2 * D_LRU + D_RWKV_IN;
constexpr int D_MIX = D_LRU + D_RWKV;
constexpr int CAP = 2 * SEQ / N_EXPERTS;
constexpr int MLAT = BATCH * SEQ, MCTX = BATCH * CTX_LEN, MTOT = MLAT + MCTX;
constexpr int NMOD = BATCH + 1;
constexpr int RW0 = 2 * D_LRU;
constexpr float ALPHA_F = 1.189207115002721f;
constexpr float LN_EPS = 1e-5f, GN_EPS = 64e-5f, RMS_EPS = 1e-6f;
static_assert(LRU_BLOCKS * LRU_BLOCK == D_LRU, "lru blocks");
static_assert(CAP % 128 == 0 && D_IN % 128 == 0 && D_EXPERT % 64 == 0 && D_MODEL % 128 == 0 && MTOT % 128 == 0 && D_MIX % 64 == 0, "tile divisibility");

typedef unsigned short bf16_t;
typedef short bf16x8 __attribute__((ext_vector_type(8)));
typedef float f32x4 __attribute__((ext_vector_type(4)));
typedef unsigned u32x4 __attribute__((ext_vector_type(4)));
typedef float f32x2_e __attribute__((ext_vector_type(2)));
struct alignas(16) F4 { float x, y, z, w; };
typedef unsigned U2 __attribute__((ext_vector_type(2)));
struct alignas(16) U4 { unsigned x, y, z, w; };

#ifdef HOST_EMU
#define MFMA16(a, b, c) emu_mfma_16x16x32_bf16(a, b, c)
#define MFMAF32(a, b, c) emu_mfma_16x16x4_f32(a, b, c)
#else
#define MFMA16(a, b, c) __builtin_amdgcn_mfma_f32_16x16x32_bf16(a, b, c, 0, 0, 0)
#define MFMAF32(a, b, c) __builtin_amdgcn_mfma_f32_16x16x4f32(a, b, c, 0, 0, 0)
#endif

__device__ __forceinline__ unsigned fbits(float f) { return __builtin_bit_cast(unsigned, f); }
__device__ __forceinline__ float bitsf(unsigned u) { return __builtin_bit_cast(float, u); }
__device__ __forceinline__ bf16_t f2bf(float f) { unsigned u = fbits(f); u += 0x7FFFu + ((u >> 16) & 1u); return (bf16_t)(u >> 16); }
__device__ __forceinline__ float bf2f(bf16_t h) { return bitsf(((unsigned)h) << 16); }
#ifdef HOST_EMU
__device__ __forceinline__ unsigned pk2(float lo, float hi) { return (unsigned)f2bf(lo) | ((unsigned)f2bf(hi) << 16); }
#else
typedef float f32x2_t __attribute__((ext_vector_type(2)));
typedef __bf16 bf16x2_t __attribute__((ext_vector_type(2)));
__device__ __forceinline__ unsigned pk2(float lo, float hi) { return __builtin_bit_cast(unsigned, __builtin_convertvector(f32x2_t{lo, hi}, bf16x2_t)); }
#endif
__device__ __forceinline__ float sigmoidf_(float x) { return 1.0f / (1.0f + expf(-x)); }
__device__ __forceinline__ float softplusf_(float x) { return fmaxf(x, 0.0f) + log1pf(expf(-fabsf(x))); }
#ifdef HOST_EMU
#define FEXP(x) expf(x)
#else
#define FEXP(x) __expf(x)
#endif
#ifdef HOST_EMU
__device__ __forceinline__ float frcp(float x) { return 1.0f / x; }
__device__ __forceinline__ float frsq(float x) { return 1.0f / sqrtf(x); }
__device__ __forceinline__ float fsqrt(float x) { return sqrtf(x); }
#else
__device__ __forceinline__ float frcp(float x) { return __builtin_amdgcn_rcpf(x); }
__device__ __forceinline__ float frsq(float x) { return __builtin_amdgcn_rsqf(x); }
__device__ __forceinline__ float fsqrt(float x) { return __builtin_amdgcn_sqrtf(x); }
#endif
__device__ __forceinline__ float fsigm(float x) { return frcp(1.0f + FEXP(-x)); }
__device__ __forceinline__ float siluf_(float x) { return x * fsigm(x); }
__device__ __forceinline__ float geluf_(float x) { return x * fsigm(1.5957691216057308f * (x + 0.044715f * x * x * x)); }
__device__ __forceinline__ int opaque_tid() {
    int t = threadIdx.x;
#ifndef HOST_EMU
    asm volatile("" : "+v"(t));
#endif
    return t;
}
__device__ __forceinline__ float wave_sum(float v) {
#pragma unroll
    for (int o = 1; o < 64; o <<= 1) v += __shfl_xor(v, o);
    return v;
}

constexpr size_t al256(size_t x) { return (x + 255) & ~(size_t)255; }
constexpr int NLCH = BATCH * (SEQ / 64), NCCH = BATCH * (CTX_LEN / 64), NCH = NLCH + NCCH;
constexpr size_t WS_CTRL = 0;
constexpr size_t WS_MOD = 65536;
constexpr size_t WS_STATS = al256(WS_MOD + (size_t)NMOD * 6 * D_MODEL * 4);
constexpr size_t WS_SUMA = al256(WS_STATS + (size_t)MTOT * 2 * 4);
constexpr size_t WS_SUMH = al256(WS_SUMA + (size_t)2 * NCH * D_LRU * 4);
constexpr size_t WS_CARRY = al256(WS_SUMH + (size_t)2 * NCH * D_LRU * 4);
constexpr size_t WS_SSQP = al256(WS_CARRY + (size_t)2 * NLCH * D_LRU * 4);
constexpr size_t WS_RINV = al256(WS_SSQP + (size_t)MLAT * LRU_BLOCKS * 4);
constexpr size_t WS_BON = al256(WS_RINV + (size_t)MLAT * 4);
constexpr size_t WS_AFF = al256(WS_BON + (size_t)2 * MLAT * HEADS * 4 + 4096 * 64);
constexpr size_t WS_IDX = al256(WS_AFF + (size_t)MLAT * N_EXPERTS * 4);
constexpr size_t WS_GATE = al256(WS_IDX + (size_t)BATCH * N_EXPERTS * CAP * 4);
constexpr size_t WS_SLOT = al256(WS_GATE + (size_t)BATCH * N_EXPERTS * CAP * 4);
constexpr size_t WS_WBIN = al256(WS_SLOT + (size_t)MLAT * N_EXPERTS * 4);
constexpr size_t WS_WBOUT = al256(WS_WBIN + (size_t)D_IN * D_MODEL * 2);
constexpr size_t WS_R1 = al256(WS_WBOUT + (size_t)D_MODEL * D_MIX * 2);
constexpr size_t R1_BYTES = (size_t)MTOT * D_IN * 2 > (size_t)MLAT * D_MODEL * 4 ? ((size_t)MTOT * D_IN * 2 > (size_t)BATCH * N_EXPERTS * CAP * D_EXPERT * 2 ? (size_t)MTOT * D_IN * 2 : (size_t)BATCH * N_EXPERTS * CAP * D_EXPERT * 2)
                                                                                  : ((size_t)MLAT * D_MODEL * 4 > (size_t)BATCH * N_EXPERTS * CAP * D_EXPERT * 2 ? (size_t)MLAT * D_MODEL * 4 : (size_t)BATCH * N_EXPERTS * CAP * D_EXPERT * 2);
constexpr size_t WS_R3 = al256(WS_R1 + R1_BYTES);
constexpr int RC = 32;
constexpr int NCC = CTX_LEN / RC, NLC = SEQ / RC, NCK = NCC + NLC, NCHAIN = BATCH * HEADS * 2;
constexpr size_t CH_PM = 0, CH_SA = 8192, CH_QT = 16384, CH_Y0 = 20480, CH_BYTES = 24576;
constexpr size_t WS_CH = al256(WS_R3 + (size_t)MTOT * D_MODEL * 2);
constexpr size_t CH_TOTAL = (size_t)NCHAIN * NCK * CH_BYTES;
constexpr size_t WS_R5 = WS_CH;
constexpr size_t WS_LA = al256(WS_R5 + (size_t)MLAT * D_MODEL * 4);
constexpr size_t WS_R6 = WS_LA, WS_R2 = WS_LA;
constexpr size_t WEXP_BYTES = (size_t)D_MODEL * D_EXPERT * 2;
constexpr size_t WS_WG = al256(WS_LA + (size_t)MLAT * D_MODEL * 2);
constexpr size_t WS_WU = WS_WG + (size_t)N_EXPERTS * WEXP_BYTES;
constexpr int NE_R3 = ((size_t)MTOT * D_MODEL * 2 / WEXP_BYTES) < (size_t)N_EXPERTS ? (int)((size_t)MTOT * D_MODEL * 2 / WEXP_BYTES) : N_EXPERTS;
constexpr size_t WS_WD2 = WS_WU + (size_t)N_EXPERTS * WEXP_BYTES;
constexpr size_t WS_LATE_END = al256(WS_WD2 + (size_t)(N_EXPERTS - NE_R3) * WEXP_BYTES);
static_assert(WS_LA + (size_t)BATCH * N_EXPERTS * CAP * D_MODEL * 2 <= WS_WD2, "YS must not reach the w_down copies");
constexpr size_t WS_END = (WS_CH + CH_TOTAL > WS_LATE_END) ? al256(WS_CH + CH_TOTAL) : WS_LATE_END;
constexpr size_t WS_RBON = WS_BON;
static_assert((size_t)NCHAIN * NCK * RC * 4 <= (size_t)2 * MLAT * HEADS * 4 + 4096 * 64, "bonus buffer");

struct Params {
    const float *x, *c, *ctx, *c_ctx, *ln_in_g, *ln_in_b, *w_mod, *b_mod, *w_in, *lru_conv_w, *lru_conv_b, *lru_wa, *lru_ba, *lru_wx, *lru_bx, *lru_lam, *lru_norm_g,
        *mu_prev, *mu_next, *w0, *w2, *a0, *a2, *g2, *k_k, *k_a, *r_k, *gn_g, *gn_b, *w_out, *ln1_g, *ln1_b, *w_router, *w_gate, *w_up, *w_down, *ln2_g, *ln2_b;
    float* out;
    unsigned char* ws;
};
#define WSP(T, off) ((T*)(p.ws + (off)))
__device__ __forceinline__ size_t wdown_off(int e) { return e < NE_R3 ? WS_R3 + (size_t)e * WEXP_BYTES : WS_WD2 + (size_t)(e - NE_R3) * WEXP_BYTES; }

constexpr int SMEM_BYTES = 76 * 1024;

__device__ __forceinline__ f32x4 ld4(const float* p) { return *(const f32x4*)p; }
__device__ __forceinline__ f32x4 ldb4(const bf16_t* p) { const U2 u = *(const U2*)p; return f32x4{bitsf(u.x << 16), bitsf(u.x & 0xFFFF0000u), bitsf(u.y << 16), bitsf(u.y & 0xFFFF0000u)}; }
__device__ __forceinline__ float hsum4(f32x4 v) { return (v[0] + v[1]) + (v[2] + v[3]); }
__device__ __forceinline__ U2 pack4(f32x4 v) { U2 o; o.x = pk2(v[0], v[1]); o.y = pk2(v[2], v[3]); return o; }
__device__ __forceinline__ void convert_transpose(const float* src, bf16_t* dst, int K, int N, int t0, int t1, int tstride, char* smem) {
    float* T = (float*)smem;
    const int tid = opaque_tid(), r = tid >> 4, c4 = (tid & 15) * 4, ntn = N / 64;
    f32x4 v[4];
    if (t0 < t1) { const int kt = t0 / ntn, nt = t0 % ntn;
#pragma unroll
        for (int j = 0; j < 4; ++j) v[j] = ld4(src + (size_t)(kt * 64 + r + 16 * j) * N + nt * 64 + c4); }
    for (int t = t0; t < t1; t += tstride) {
        const int kt = t / ntn, nt = t % ntn;
        __syncthreads();
#pragma unroll
        for (int j = 0; j < 4; ++j) { float* d = T + (r + 16 * j) * 65 + c4; d[0] = v[j][0]; d[1] = v[j][1]; d[2] = v[j][2]; d[3] = v[j][3]; }
        __syncthreads();
        if (t + tstride < t1) { const int kt2 = (t + tstride) / ntn, nt2 = (t + tstride) % ntn;
#pragma unroll
            for (int j = 0; j < 4; ++j) v[j] = ld4(src + (size_t)(kt2 * 64 + r + 16 * j) * N + nt2 * 64 + c4); }
        const int n = tid >> 2, kc = (tid & 3) * 16;
        u32x4 o0, o1;
#pragma unroll
        for (int i = 0; i < 4; ++i) { o0[i] = pk2(T[(kc + 2 * i) * 65 + n], T[(kc + 2 * i + 1) * 65 + n]); o1[i] = pk2(T[(kc + 8 + 2 * i) * 65 + n], T[(kc + 9 + 2 * i) * 65 + n]); }
        bf16_t* d = dst + (size_t)(nt * 64 + n) * K + kt * 64 + kc;
        *(u32x4*)d = o0; *(u32x4*)(d + 8) = o1;
    }
    __syncthreads();
}
__device__ void convert_experts(const Params& p, int vb, int nvb, char* smem, int first, int last) {
    constexpr int TPM = (D_MODEL / 64) * (D_EXPERT / 64);
    int m = 0;
    for (int e = 0; e < N_EXPERTS; ++e)
        for (int which = first; which < last; ++which, ++m) {
            const float* src = (which == 0 ? p.w_gate : which == 1 ? p.w_up : p.w_down) + (size_t)e * D_MODEL * D_EXPERT;
            bf16_t* dst = which == 0 ? WSP(bf16_t, WS_WG + (size_t)e * WEXP_BYTES) : which == 1 ? WSP(bf16_t, WS_WU + (size_t)e * WEXP_BYTES) : WSP(bf16_t, wdown_off(e));
            const int K = which == 2 ? D_EXPERT : D_MODEL, N = which == 2 ? D_MODEL : D_EXPERT;
            const int start = ((vb - (m * TPM) % nvb) % nvb + nvb) % nvb;
            convert_transpose(src, dst, K, N, start, TPM, nvb, smem);
        }
}

__device__ __forceinline__ void phaseA(const Params& p, int bid, int nblk, char* smem) {
    float* sc = (float*)smem;
    float* red = sc + NMOD * D_MODEL;
    const int tid = opaque_tid();
    constexpr int NA = 6 * D_MODEL / 16;
    {
        const bool spare = nblk > NA + 32;
        const int vb = spare ? bid - NA : bid, nvb = spare ? nblk - NA : nblk;
        if (!spare || bid >= NA) {
            constexpr int T1 = (D_MODEL / 64) * (D_IN / 64), T2 = (D_MIX / 64) * (D_MODEL / 64);
            convert_transpose(p.w_in, WSP(bf16_t, WS_WBIN), D_MODEL, D_IN, vb, T1, nvb, smem);
            convert_transpose(p.w_out, WSP(bf16_t, WS_WBOUT), D_MIX, D_MODEL, ((vb - T1 % nvb) % nvb + nvb) % nvb, T2, nvb, smem);
        }
        if (spare && bid >= NA) return;
    }
    if (bid >= NA) return;
    __syncthreads();
    for (int i = tid; i < NMOD * D_MODEL; i += 256) {
        const int r = i / D_MODEL, k = i % D_MODEL;
        const float v = (r < BATCH) ? p.c[r * D_MODEL + k] : p.c_ctx[k];
        sc[i] = siluf_(v);
    }
    __syncthreads();
    float* MOD = WSP(float, WS_MOD);
    const int col = tid & 15, kg = tid >> 4;
    constexpr int KPT = D_MODEL / 16;
    for (int cb = bid; cb < 6 * D_MODEL / 16; cb += nblk) {
        const int n = cb * 16 + col;
        float acc[NMOD];
#pragma unroll
        for (int r = 0; r < NMOD; ++r) acc[r] = 0.f;
        const float* wp = p.w_mod + (size_t)(kg * KPT) * (6 * D_MODEL) + n;
#pragma unroll 16
        for (int kk = 0; kk < KPT; ++kk) {
            const float w = wp[(size_t)kk * (6 * D_MODEL)];
#pragma unroll
            for (int r = 0; r < NMOD; ++r) acc[r] += sc[r * D_MODEL + kg * KPT + kk] * w;
        }
#pragma unroll
        for (int r = 0; r < NMOD; ++r) red[(kg * NMOD + r) * 16 + col] = acc[r];
        __syncthreads();
        if (tid < NMOD * 16) {
            const int r = tid >> 4, c2 = tid & 15;
            float s2 = p.b_mod[cb * 16 + c2];
#pragma unroll
            for (int g = 0; g < 16; ++g) s2 += red[(g * NMOD + r) * 16 + c2];
            MOD[(size_t)r * 6 * D_MODEL + cb * 16 + c2] = s2;
        }
        __syncthreads();
    }
}

constexpr int NV = D_MODEL / 256;
__device__ __forceinline__ void phaseB(const Params& p, int bid, int nblk, char* smem) {
    const int tid_ = opaque_tid(), lane = tid_ & 63, wave = tid_ >> 6;
    const float* MOD = WSP(float, WS_MOD);
    float* STATS = WSP(float, WS_STATS);
    bf16_t* U = WSP(bf16_t, WS_R3);
    for (int row = bid * 4 + wave; row < MTOT; row += nblk * 4) {
        const float* xr = (row < MLAT) ? p.x + (size_t)row * D_MODEL : p.ctx + (size_t)(row - MLAT) * D_MODEL;
        const int mr = (row < MLAT) ? row / SEQ : BATCH;
        const float* md = MOD + (size_t)mr * 6 * D_MODEL;
        f32x4 v0, v1, v2, v3; float s = 0.f;
        v0 = ld4(xr + lane * 4); s += hsum4(v0);
        if (NV > 1) { v1 = ld4(xr + 256 + lane * 4); s += hsum4(v1); } else v1 = f32x4{0.f, 0.f, 0.f, 0.f};
        if (NV > 2) { v2 = ld4(xr + 512 + lane * 4); v3 = ld4(xr + 768 + lane * 4); s += hsum4(v2) + hsum4(v3); } else { v2 = v1; v3 = v1; }
        const float mu = wave_sum(s) * (1.0f / D_MODEL);
        v0 -= mu; float s2 = hsum4(v0 * v0);
        if (NV > 1) { v1 -= mu; s2 += hsum4(v1 * v1); }
        if (NV > 2) { v2 -= mu; v3 -= mu; s2 += hsum4(v2 * v2) + hsum4(v3 * v3); }
        const float rstd = frsq(wave_sum(s2) * (1.0f / D_MODEL) + LN_EPS);
        if (lane == 0) { STATS[row * 2] = mu; STATS[row * 2 + 1] = rstd; }
#pragma unroll
        for (int j = 0; j < NV; ++j) {
            const int k = j * 256 + lane * 4;
            const f32x4 vv = (j == 0) ? v0 : (j == 1) ? v1 : (j == 2) ? v2 : v3;
            const f32x4 h = vv * rstd * ld4(p.ln_in_g + k) + ld4(p.ln_in_b + k);
            *(U2*)(U + (size_t)row * D_MODEL + k) = pack4(h * (1.0f + ld4(md + D_MODEL + k)) + ld4(md + k));
        }
    }
}

constexpr int LDK = 64;
template <int MI, bool DUAL, class Epi>
__device__ __forceinline__ void gemm_tile(char* smem, const bf16_t* A, int lda, const int* rowidx, int m0, const bf16_t* Bt0, const bf16_t* Bt1, int ldb, int n0, int K, Epi epi, const float* rowscale = nullptr, int kscale = 0) {
    constexpr int BM = 32 * MI;
    bf16_t* As = (bf16_t*)smem;
    bf16_t* Bs = As + BM * LDK;
    int tid = threadIdx.x;
#ifndef HOST_EMU
    asm volatile("" : "+v"(tid));
#endif
    const int lane = tid & 63, wave = tid >> 6, wr = wave >> 1, wc = wave & 1, l15 = lane & 15, q = lane >> 4;
    const int ch = tid & 7, r0 = tid >> 3;
    unsigned aoff[MI], boff[4];
#pragma unroll
    for (int j = 0; j < MI; ++j) { const int r = m0 + r0 + 32 * j; aoff[j] = (unsigned)(rowidx ? rowidx[r] : r) * (unsigned)lda + ch * 8; }
#pragma unroll
    for (int j = 0; j < 4; ++j) boff[j] = (unsigned)(n0 + (DUAL ? (j >> 1) * 32 + r0 : r0 + 32 * j)) * (unsigned)ldb + ch * 8;
    const int wofs = r0 * LDK + ((ch ^ (r0 & 7)) * 8);
    u32x4 ar[MI], br[4];
    f32x4 acc[MI][4];
#pragma unroll
    for (int i = 0; i < MI; ++i)
#pragma unroll
        for (int j = 0; j < 4; ++j) acc[i][j] = f32x4{0.f, 0.f, 0.f, 0.f};
    const int nk = K / 64;
#pragma unroll
    for (int j = 0; j < MI; ++j) ar[j] = *(const u32x4*)(A + aoff[j]);
#pragma unroll
    for (int j = 0; j < 4; ++j) br[j] = *(const u32x4*)(((DUAL && (j & 1)) ? Bt1 : Bt0) + boff[j]);
    for (int kt = 0; kt < nk; ++kt) {
        __syncthreads();
#pragma unroll
        for (int j = 0; j < MI; ++j) *(u32x4*)(As + wofs + 32 * j * LDK) = ar[j];
#pragma unroll
        for (int j = 0; j < 4; ++j) *(u32x4*)(Bs + wofs + 32 * j * LDK) = br[j];
        __syncthreads();
        if (kt + 1 < nk) {
            const int ko = (kt + 1) * 64;
#pragma unroll
            for (int j = 0; j < MI; ++j) ar[j] = *(const u32x4*)(A + aoff[j] + ko);
#pragma unroll
            for (int j = 0; j < 4; ++j) br[j] = *(const u32x4*)(((DUAL && (j & 1)) ? Bt1 : Bt0) + boff[j] + ko);
        }
#pragma unroll
        for (int ks = 0; ks < 2; ++ks) {
            const int cofs = ((ks * 4 + q) ^ (l15 & 7)) * 8;
            bf16x8 bfr[4];
#pragma unroll
            for (int ni = 0; ni < 4; ++ni) bfr[ni] = *(const bf16x8*)(Bs + (wc * 64 + ni * 16 + l15) * LDK + cofs);
#pragma unroll
            for (int mi = 0; mi < MI; ++mi) {
                const bf16x8 af = *(const bf16x8*)(As + (wr * (16 * MI) + mi * 16 + l15) * LDK + cofs);
#pragma unroll
                for (int ni = 0; ni < 4; ++ni) acc[mi][ni] = MFMA16(bfr[ni], af, acc[mi][ni]);
            }
        }
        if (rowscale && kt + 1 == kscale) {
#pragma unroll
            for (int mi = 0; mi < MI; ++mi) {
                const float rs = rowscale[m0 + wr * (16 * MI) + mi * 16 + l15];
#pragma unroll
                for (int ni = 0; ni < 4; ++ni) acc[mi][ni] *= rs;
            }
        }
    }
#pragma unroll
    for (int mi = 0; mi < MI; ++mi) {
        const int ml = wr * (16 * MI) + mi * 16 + l15;
        if (DUAL) {
#pragma unroll
            for (int ni = 0; ni < 2; ++ni) epi(ml, wc * 32 + ni * 16 + q * 4, acc[mi][ni], acc[mi][ni + 2]);
        } else {
#pragma unroll
            for (int ni = 0; ni < 4; ++ni) epi(ml, wc * 64 + ni * 16 + q * 4, acc[mi][ni], acc[mi][ni]);
        }
    }
    __syncthreads();
}

__device__ __forceinline__ int xcd_vbid(int bid, int nblk) { return (nblk % 8 == 0) ? (bid % 8) * (nblk / 8) + bid / 8 : bid; }
constexpr int MI_C = (MTOT % 256 == 0) ? 8 : 4, MI_J = (MLAT % 256 == 0) ? 8 : 4, MI_E = (CAP % 256 == 0) ? 8 : 4;
__device__ __forceinline__ void phaseC(const Params& p, int bid, int nblk, char* smem) {
    const bf16_t* U = WSP(bf16_t, WS_R3); const bf16_t* WB = WSP(bf16_t, WS_WBIN);
    bf16_t* P = WSP(bf16_t, WS_R1);
    constexpr int BM = 32 * MI_C, NTN = D_IN / 128, NTM = MTOT / BM;
    constexpr int GM = (NTM % 8 == 0) ? 8 : (NTM % 4 == 0) ? 4 : 1;
    for (int it = xcd_vbid(bid, nblk); it < NTN * NTM; it += nblk) {
        const int mg = it / (GM * NTN), r = it % (GM * NTN), nt = r / GM, mt = mg * GM + (r % GM);
        gemm_tile<MI_C, false>(smem, U, D_MODEL, nullptr, mt * BM, WB, nullptr, D_MODEL, nt * 128, D_MODEL, [&](int ml, int nl, f32x4 v, f32x4) {
            *(U2*)(P + (size_t)(mt * BM + ml) * D_IN + nt * 128 + nl) = pack4(v);
        });
    }
}


template <int NYT, int KS>
__device__ __forceinline__ void mmT(f32x4* acc, const bf16_t* X, int ldx, int xs, const bf16_t* Y, int ldy, int lane) {
#pragma unroll
    for (int ks = 0; ks < KS; ++ks) {
        const bf16x8 xf = *(const bf16x8*)(X + (xs * 16 + (lane & 15)) * ldx + ks * 32 + 8 * (lane >> 4));
#pragma unroll
        for (int nb = 0; nb < NYT; ++nb) {
            const bf16x8 yf = *(const bf16x8*)(Y + (nb * 16 + (lane & 15)) * ldy + ks * 32 + 8 * (lane >> 4));
            acc[nb] = MFMA16(xf, yf, acc[nb]);
        }
    }
}

struct SeqChunk { int base_row; int t0; int len; };
__device__ __forceinline__ SeqChunk lru_chunk(int cg) {
    SeqChunk s;
    if (cg < NLCH) { const int b = cg / (SEQ / 64), ck = cg % (SEQ / 64); s.base_row = b * SEQ; s.t0 = ck * 64; s.len = SEQ; }
    else { const int c2 = cg - NLCH; const int b = c2 / (CTX_LEN / 64), ck = c2 % (CTX_LEN / 64); s.base_row = MLAT + b * CTX_LEN; s.t0 = ck * 64; s.len = CTX_LEN; }
    return s;
}
constexpr int L_XIN = 0;
constexpr int L_GT = 8704;
constexpr int L_XB = L_GT + 9216;
constexpr int L_WT = L_XB + 9216;
constexpr int L_CP = L_WT + 36864;
constexpr int L_END = L_CP + 4096;
static_assert(L_END <= SMEM_BYTES, "lru lds");
__device__ __forceinline__ void lru_load_w(const Params& p, char* smem, int cb) {
    bf16_t* WT = (bf16_t*)(smem + L_WT);
    const int tid = opaque_tid();
    for (int idx = tid; idx < 4 * 64 * 16; idx += 256) {
        const int m = idx >> 10, i = (idx >> 4) & 63, j4 = (idx & 15) * 4, d = m >> 1;
        const f32x4 w = ld4(((m & 1) ? p.lru_wx : p.lru_wa) + ((size_t)(d * LRU_BLOCKS + cb) * 64 + i) * 64 + j4);
        bf16_t* dst = WT + (m * 64 + j4) * 72 + i;
        dst[0] = f2bf(w[0]); dst[72] = f2bf(w[1]); dst[144] = f2bf(w[2]); dst[216] = f2bf(w[3]);
    }
}
struct LruOut { float a[2][4][4], b[2][4][4]; };
struct LruConst { float ba[2][4], bx[2][4], sp8[2][4], gn[4], cw[4], cb0; };
__device__ __forceinline__ void lru_consts(const Params& p, int cb, LruConst& K) {
    const int l15 = threadIdx.x & 15, c = threadIdx.x & 63, ch = cb * 64 + c;
#pragma unroll
    for (int d = 0; d < 2; ++d)
#pragma unroll
        for (int nb = 0; nb < 4; ++nb) { const int cc = d * D_LRU + cb * 64 + nb * 16 + l15; K.ba[d][nb] = p.lru_ba[cc]; K.bx[d][nb] = p.lru_bx[cc]; K.sp8[d][nb] = -8.0f * softplusf_(-p.lru_lam[cc]); }
#pragma unroll
    for (int nb = 0; nb < 4; ++nb) K.gn[nb] = p.lru_norm_g[cb * 64 + nb * 16 + l15];
#pragma unroll
    for (int j = 0; j < 4; ++j) K.cw[j] = p.lru_conv_w[j * D_LRU + ch];
    K.cb0 = p.lru_conv_b[ch];
}
struct LruStage { u32x4 x[3]; u32x4 g[2]; };
template <bool FINAL>
__device__ __forceinline__ void lru_stage_load(const Params& p, int cg, int cb, LruStage& S) {
    const bf16_t* P = WSP(bf16_t, WS_R1);
    const SeqChunk sc = lru_chunk(cg);
    const int tid = opaque_tid();
#pragma unroll
    for (int k = 0; k < 3; ++k) {
        const int idx = tid + 256 * k, tt = idx >> 3, c8 = (idx & 7) * 8, t = sc.t0 - 1 + tt;
        S.x[k] = u32x4{0u, 0u, 0u, 0u};
        if (idx < 67 * 8 && t >= 0 && t < sc.len) S.x[k] = *(const u32x4*)(P + (size_t)(sc.base_row + t) * D_IN + cb * 64 + c8);
    }
    if (FINAL) {
#pragma unroll
        for (int k = 0; k < 2; ++k) { const int idx = tid + 256 * k, tt = idx >> 3, c8 = (idx & 7) * 8; S.g[k] = *(const u32x4*)(P + (size_t)(sc.base_row + sc.t0 + tt) * D_IN + D_LRU + cb * 64 + c8); }
    }
}
template <bool FINAL>
__device__ __forceinline__ void lru_item(const Params& p, char* smem, int cg, int cb, const LruConst& K, LruStage& S, int cg_next) {
    const bf16_t* P = WSP(bf16_t, WS_R1);
    bf16_t* XIN = (bf16_t*)(smem + L_XIN); bf16_t* GT = (bf16_t*)(smem + L_GT); bf16_t* XB = (bf16_t*)(smem + L_XB); const bf16_t* WT = (const bf16_t*)(smem + L_WT);
    float* CP = (float*)(smem + L_CP);
    const int tid = opaque_tid(), lane = tid & 63, wave = tid >> 6, q = lane >> 4, l15 = lane & 15;
    const SeqChunk sc = lru_chunk(cg);
    __syncthreads();
#pragma unroll
    for (int k = 0; k < 3; ++k) { const int idx = tid + 256 * k, tt = idx >> 3, c8 = (idx & 7) * 8; if (idx < 67 * 8) *(u32x4*)(XIN + tt * 64 + c8) = S.x[k]; }
    if (FINAL) {
#pragma unroll
        for (int k = 0; k < 2; ++k) { const int idx = tid + 256 * k, tt = idx >> 3, c8 = (idx & 7) * 8; *(u32x4*)(GT + tt * 72 + c8) = S.g[k]; }
    }
    if (cg_next >= 0) lru_stage_load<FINAL>(p, cg_next, cb, S);
    __syncthreads();
    {
        const int c = tid & 63;
#pragma unroll 4
        for (int tt = tid >> 6; tt < 64; tt += 4)
            XB[tt * 72 + c] = f2bf(K.cb0 + bf2f(XIN[tt * 64 + c]) * K.cw[0] + bf2f(XIN[(tt + 1) * 64 + c]) * K.cw[1] + bf2f(XIN[(tt + 2) * 64 + c]) * K.cw[2] + bf2f(XIN[(tt + 3) * 64 + c]) * K.cw[3]);
    }
    __syncthreads();
    float hs[4][4];
    float av[4][4], bv[4][4];
#pragma unroll
    for (int d = 0; d < 2; ++d) {
        f32x4 ga[4], gx[4];
#pragma unroll
        for (int nb = 0; nb < 4; ++nb) { ga[nb] = f32x4{0.f, 0.f, 0.f, 0.f}; gx[nb] = f32x4{0.f, 0.f, 0.f, 0.f}; }
        mmT<4, 2>(ga, XB, 72, wave, WT + (2 * d) * 64 * 72, 72, lane);
        mmT<4, 2>(gx, XB, 72, wave, WT + (2 * d + 1) * 64 * 72, 72, lane);
        float cA[4], cH[4];
#pragma unroll
        for (int nb = 0; nb < 4; ++nb) {
            const float ba = K.ba[d][nb], bx = K.bx[d][nb], sp8 = K.sp8[d][nb];
#pragma unroll
            for (int r = 0; r < 4; ++r) {
                const float rg = fsigm(ga[nb][r] + ba), ig = fsigm(gx[nb][r] + bx);
                const float a = FEXP(sp8 * rg);
                const float xv = bf2f(XB[(wave * 16 + q * 4 + r) * 72 + nb * 16 + l15]);
                av[nb][r] = a; bv[nb][r] = fsqrt(fmaxf(1.0f - a * a, 0.f)) * ig * xv;
            }
            float A, H;
            if (d == 0) { A = av[nb][0]; H = bv[nb][0];
#pragma unroll
                for (int r = 1; r < 4; ++r) { H = H * av[nb][r] + bv[nb][r]; A *= av[nb][r]; } }
            else { A = av[nb][3]; H = bv[nb][3];
#pragma unroll
                for (int r = 2; r >= 0; --r) { H = H * av[nb][r] + bv[nb][r]; A *= av[nb][r]; } }
#pragma unroll
            for (int st = 1; st <= 2; st <<= 1) {
                const float pA = d == 0 ? __shfl_up(A, 16 * st) : __shfl_down(A, 16 * st), pH = d == 0 ? __shfl_up(H, 16 * st) : __shfl_down(H, 16 * st);
                const bool has = d == 0 ? (q >= st) : (q + st <= 3);
                if (has) { H = pH * A + H; A = pA * A; }
            }
            cA[nb] = A; cH[nb] = H;
            const bool last = d == 0 ? (q == 3) : (q == 0);
            if (last) { CP[((d * 4 + wave) * 64 + nb * 16 + l15) * 2] = A; CP[((d * 4 + wave) * 64 + nb * 16 + l15) * 2 + 1] = H; }
        }
        __syncthreads();
        if (!FINAL) {
            if (wave == 0 && q == 0) {
#pragma unroll
                for (int nb = 0; nb < 4; ++nb) {
                    const int c = nb * 16 + l15;
                    float A = 1.f, H = 0.f;
#pragma unroll
                    for (int w = 0; w < 4; ++w) { const int ww = d == 0 ? w : 3 - w; const float wa = CP[((d * 4 + ww) * 64 + c) * 2], wh = CP[((d * 4 + ww) * 64 + c) * 2 + 1]; H = H * wa + wh; A *= wa; }
                    WSP(float, WS_SUMA)[((size_t)d * NCH + cg) * D_LRU + cb * 64 + c] = A;
                    WSP(float, WS_SUMH)[((size_t)d * NCH + cg) * D_LRU + cb * 64 + c] = H;
                }
            }
        } else {
#pragma unroll
            for (int nb = 0; nb < 4; ++nb) {
                const int c = nb * 16 + l15;
                float h = WSP(float, WS_CARRY)[((size_t)d * NLCH + cg) * D_LRU + cb * 64 + c];
#pragma unroll
                for (int w = 0; w < 3; ++w) { const int ww = d == 0 ? w : 3 - w; const bool use = d == 0 ? (ww < wave) : (ww > wave);
                    if (use) h = h * CP[((d * 4 + ww) * 64 + c) * 2] + CP[((d * 4 + ww) * 64 + c) * 2 + 1]; }
                const float eA = d == 0 ? __shfl_up(cA[nb], 16) : __shfl_down(cA[nb], 16), eH = d == 0 ? __shfl_up(cH[nb], 16) : __shfl_down(cH[nb], 16);
                const bool first = d == 0 ? (q == 0) : (q == 3);
                if (!first) h = h * eA + eH;
                if (d == 0) {
#pragma unroll
                    for (int r = 0; r < 4; ++r) { h = h * av[nb][r] + bv[nb][r]; hs[nb][r] = h; }
                } else {
#pragma unroll
                    for (int r = 3; r >= 0; --r) { h = h * av[nb][r] + bv[nb][r]; hs[nb][r] += h; }
                }
            }
        }
        __syncthreads();
    }
    if (FINAL) {
        float ss[4] = {0.f, 0.f, 0.f, 0.f};
#pragma unroll
        for (int nb = 0; nb < 4; ++nb) {
            const float gn = K.gn[nb];
#pragma unroll
            for (int r = 0; r < 4; ++r) {
                const int tt = wave * 16 + q * 4 + r;
                const float v = hs[nb][r] * geluf_(bf2f(GT[tt * 72 + nb * 16 + l15]));
                ss[r] += v * v;
                XB[tt * 72 + nb * 16 + l15] = f2bf(v * gn);
            }
        }
#pragma unroll
        for (int r = 0; r < 4; ++r) {
#pragma unroll
            for (int o = 1; o < 16; o <<= 1) ss[r] += __shfl_xor(ss[r], o);
            if (l15 == 0) WSP(float, WS_SSQP)[(size_t)(sc.base_row + sc.t0 + wave * 16 + q * 4 + r) * LRU_BLOCKS + cb] = ss[r];
        }
        __syncthreads();
        bf16_t* MIX = WSP(bf16_t, WS_R3);
        for (int idx = tid; idx < 64 * 8; idx += 256) {
            const int tt = idx >> 3, c8 = (idx & 7) * 8;
            *(u32x4*)(MIX + (size_t)(sc.base_row + sc.t0 + tt) * D_MIX + cb * 64 + c8) = *(const u32x4*)(XB + tt * 72 + c8);
        }
    }
}
__device__ __forceinline__ void phaseD(const Params& p, int bid, int nblk, char* smem) {
    int cur = -1; LruConst K; LruStage S;
    for (int it = bid; it < NCH * LRU_BLOCKS; it += nblk) {
        const int cb = it % LRU_BLOCKS, cg = it / LRU_BLOCKS;
        if (cb != cur) { __syncthreads(); lru_load_w(p, smem, cb); lru_consts(p, cb, K); lru_stage_load<false>(p, cg, cb, S); cur = cb; }
        const int itn = it + nblk;
        lru_item<false>(p, smem, cg, cb, K, S, (itn < NCH * LRU_BLOCKS && itn % LRU_BLOCKS == cb) ? itn / LRU_BLOCKS : -1);
        if (itn < NCH * LRU_BLOCKS && itn % LRU_BLOCKS != cb) cur = -1;
    }
}
__device__ __forceinline__ void phaseE(const Params& p, int bid, int nblk, char* smem) {
    const float* SUMA = WSP(float, WS_SUMA); const float* SUMH = WSP(float, WS_SUMH); float* CARRY = WSP(float, WS_CARRY);
    constexpr int NLB = SEQ / 64, NCB = CTX_LEN / 64;
    for (int g = bid * 256 + threadIdx.x; g < BATCH * 2 * D_LRU; g += nblk * 256) {
        const int c = g % D_LRU, d = (g / D_LRU) & 1, b = g / (2 * D_LRU);
        const float* sa = SUMA + (size_t)d * NCH * D_LRU + c; const float* sh = SUMH + (size_t)d * NCH * D_LRU + c;
        float* cr = CARRY + (size_t)d * NLCH * D_LRU + c;
        float h = 0.f;
        if (d == 0) {
            for (int q2 = 0; q2 < NCB; ++q2) { const int gi = NLCH + b * NCB + q2; h = sa[(size_t)gi * D_LRU] * h + sh[(size_t)gi * D_LRU]; }
            for (int q2 = 0; q2 < NLB; ++q2) { const int gi = b * NLB + q2; cr[(size_t)gi * D_LRU] = h; h = sa[(size_t)gi * D_LRU] * h + sh[(size_t)gi * D_LRU]; }
        } else {
            for (int q2 = NCB - 1; q2 >= 0; --q2) { const int gi = NLCH + b * NCB + q2; h = sa[(size_t)gi * D_LRU] * h + sh[(size_t)gi * D_LRU]; }
            for (int q2 = NLB - 1; q2 >= 0; --q2) { const int gi = b * NLB + q2; cr[(size_t)gi * D_LRU] = h; h = sa[(size_t)gi * D_LRU] * h + sh[(size_t)gi * D_LRU]; }
        }
    }
}
__device__ __forceinline__ void phaseF(const Params& p, int bid, int nblk, char* smem) {
    int cur = -1; LruConst K; LruStage S;
    for (int it = bid; it < NLCH * LRU_BLOCKS; it += nblk) {
        const int cb = it % LRU_BLOCKS, cg = it / LRU_BLOCKS;
        if (cb != cur) { __syncthreads(); lru_load_w(p, smem, cb); lru_consts(p, cb, K); lru_stage_load<true>(p, cg, cb, S); cur = cb; }
        const int itn = it + nblk;
        lru_item<true>(p, smem, cg, cb, K, S, (itn < NLCH * LRU_BLOCKS && itn % LRU_BLOCKS == cb) ? itn / LRU_BLOCKS : -1);
        if (itn < NLCH * LRU_BLOCKS && itn % LRU_BLOCKS != cb) cur = -1;
    }
}

__device__ __forceinline__ size_t rwkv_row(int seg, int b, int s) {
    if (seg == 0) return (size_t)(MLAT + b * CTX_LEN + s);
    const int r = s % ROWS, c = s / ROWS;
    return (size_t)(b * SEQ + r * GRID_W + c);
}
__device__ __forceinline__ void chunk_info(int d, int c, int& seg, int& p0, int& len) {
    if (c < NCC) { seg = 0; len = CTX_LEN; p0 = (d == 0 ? c : NCC - 1 - c) * RC; }
    else { const int cc = c - NCC; seg = 1; len = SEQ; p0 = (d == 0 ? cc : NLC - 1 - cc) * RC; }
}
__device__ __forceinline__ void unpack8(const u32x4 v, float* o) {
    o[0] = bitsf(v[0] << 16); o[1] = bitsf(v[0] & 0xFFFF0000u); o[2] = bitsf(v[1] << 16); o[3] = bitsf(v[1] & 0xFFFF0000u);
    o[4] = bitsf(v[2] << 16); o[5] = bitsf(v[2] & 0xFFFF0000u); o[6] = bitsf(v[3] << 16); o[7] = bitsf(v[3] & 0xFFFF0000u);
}
__device__ __forceinline__ void shifted8(const Params& p, const bf16_t* P, int seg, int b, int pos, int len, int ch0, float* o) {
    float z[8], zp[8], zn[8];
    unpack8(*(const u32x4*)(P + rwkv_row(seg, b, pos) * D_IN + RW0 + ch0), z);
    if (pos > 0) unpack8(*(const u32x4*)(P + rwkv_row(seg, b, pos - 1) * D_IN + RW0 + ch0), zp); else { for (int i = 0; i < 8; ++i) zp[i] = 0.f; }
    if (pos < len - 1) unpack8(*(const u32x4*)(P + rwkv_row(seg, b, pos + 1) * D_IN + RW0 + ch0), zn); else { for (int i = 0; i < 8; ++i) zn[i] = 0.f; }
    const f32x4 mp0 = ld4(p.mu_prev + ch0), mp1 = ld4(p.mu_prev + ch0 + 4), mn0 = ld4(p.mu_next + ch0), mn1 = ld4(p.mu_next + ch0 + 4);
#pragma unroll
    for (int i = 0; i < 4; ++i) { o[i] = z[i] + mp0[i] * (zp[i] - z[i]) + mn0[i] * (zn[i] - z[i]); o[4 + i] = z[4 + i] + mp1[i] * (zp[4 + i] - z[4 + i]) + mn1[i] * (zn[4 + i] - z[4 + i]); }
}
constexpr int LT = 72, LJ = 40;
constexpr int R_RF = 0, R_KF = 8192, R_VF = 16384, R_LW = 24576, R_IC = 32768;
constexpr int R_NKA = 0, R_MBR = 2560, R_MKR = 5120;
constexpr int R_XU = 7680;
constexpr int R_IA = R_XU + 8448, R_IB = R_IA + 4608, R_PA = R_IB + 4608, R_PB = R_PA + 4608;
constexpr int R_WA = R_IB, R_U0 = R_WA + 5120;
static_assert(R_U0 + 5120 <= R_PB + 4608 && R_PB + 4608 <= 40960, "rwkv scratch");
constexpr int R_O = 40960;
constexpr int R_AH = R_O, R_BH = R_AH + 4608, R_KH = R_BH + 4608, R_RH = R_KH + 4608;
constexpr int R_VT = R_RH + 4608, R_BHT = R_VT + 5120, R_KHT = R_BHT + 5120;
constexpr int R_GC = R_KHT + 5120, R_TOT = R_GC + 256, R_END = R_TOT + 1024;
constexpr int R_TW = R_O, R_TA = R_TW + 4608, R_W2T = R_TA + 4608, R_A2T = R_W2T + 9216;
static_assert(R_A2T + 9216 <= R_END && R_END <= SMEM_BYTES, "rwkv lds");

__device__ __forceinline__ void phaseR1(const Params& p, int bid, int nblk, char* smem) {
    const bf16_t* P = WSP(bf16_t, WS_R1);
    unsigned char* CH = p.ws + WS_CH;
    float* RBON = WSP(float, WS_RBON);
    float* Rf = (float*)(smem + R_RF); float* Kf = (float*)(smem + R_KF); float* Vf = (float*)(smem + R_VF); float* LW = (float*)(smem + R_LW); float* IC = (float*)(smem + R_IC);
    float* IA = (float*)(smem + R_IA); float* IB = (float*)(smem + R_IB); float* PA = (float*)(smem + R_PA); float* PB = (float*)(smem + R_PB); bf16_t* NkaT = (bf16_t*)(smem + R_NKA); bf16_t* MbrT = (bf16_t*)(smem + R_MBR); bf16_t* MkrT = (bf16_t*)(smem + R_MKR);
    float* Xu = (float*)(smem + R_XU); bf16_t* Wa = (bf16_t*)(smem + R_WA); bf16_t* U0 = (bf16_t*)(smem + R_U0);
    bf16_t* Ah = (bf16_t*)(smem + R_AH); bf16_t* Bh = (bf16_t*)(smem + R_BH); bf16_t* Kh = (bf16_t*)(smem + R_KH); bf16_t* Rh = (bf16_t*)(smem + R_RH);
    bf16_t* VT = (bf16_t*)(smem + R_VT); bf16_t* BhT = (bf16_t*)(smem + R_BHT); bf16_t* KhT = (bf16_t*)(smem + R_KHT);
    float* GC = (float*)(smem + R_GC); float* TOT = (float*)(smem + R_TOT);
    bf16_t* TW = (bf16_t*)(smem + R_TW); bf16_t* TA = (bf16_t*)(smem + R_TA); bf16_t* W2T = (bf16_t*)(smem + R_W2T); bf16_t* A2T = (bf16_t*)(smem + R_A2T);
    const int tid = opaque_tid(), lane = tid & 63, wave = tid >> 6, q = lane >> 4, l15 = lane & 15;
    constexpr int NITEM = NCHAIN * NCK;
    const int per = (NITEM + nblk - 1) / nblk;
    const int it0 = bid * per, it1 = (it0 + per < NITEM) ? it0 + per : NITEM;
    for (int it = it0; it < it1; ++it) {
        const int chain = it / NCK, c = it % NCK;
        const int d = chain & 1, h = (chain >> 1) % HEADS, b = chain / (2 * HEADS);
        int seg, p0, len; chunk_info(d, c, seg, p0, len);
        unsigned char* chp = CH + (size_t)it * CH_BYTES;
        const float kkc = p.k_k[h * 64 + lane], kac = p.k_a[h * 64 + lane], rkc = p.r_k[h * 64 + lane];
        __syncthreads();
        {
            f32x4 wv[8];
#pragma unroll
            for (int k = 0; k < 8; ++k) {
                const int idx = tid + 256 * k, which = idx >> 10, i = (idx >> 4) & 63, j4 = (idx & 15) * 4;
                wv[k] = ld4((which ? p.a2 : p.w2) + ((size_t)d * 64 + i) * D_RWKV + h * 64 + j4);
            }
#pragma unroll
            for (int kb = 0; kb < 5; kb += 2) {
            u32x4 zc[2], zp[2], zn[2];
#pragma unroll
            for (int k = 0; k < 2; ++k) if (kb + k < 5) {
                const int idx = tid + 256 * (kb + k), tau = idx / 40, g = idx % 40, grp = g >> 3, j0 = (g & 7) * 8;
                const int pos = p0 + (d ? RC - 1 - tau : tau);
                const int ch0 = (grp < 3) ? grp * D_RWKV + h * 64 + j0 : (grp == 3 ? 3 * D_RWKV + d * 64 + j0 : 3 * D_RWKV + 128 + d * 64 + j0);
                const u32x4 zero = u32x4{0u, 0u, 0u, 0u};
                zc[k] = *(const u32x4*)(P + rwkv_row(seg, b, pos) * D_IN + RW0 + ch0);
                zp[k] = (pos > 0) ? *(const u32x4*)(P + rwkv_row(seg, b, pos - 1) * D_IN + RW0 + ch0) : zero;
                zn[k] = (pos < len - 1) ? *(const u32x4*)(P + rwkv_row(seg, b, pos + 1) * D_IN + RW0 + ch0) : zero;
            }
#pragma unroll
            for (int k = 0; k < 2; ++k) if (kb + k < 5) {
                const int idx = tid + 256 * (kb + k), tau = idx / 40, g = idx % 40, grp = g >> 3, j0 = (g & 7) * 8;
                const int ch0 = (grp < 3) ? grp * D_RWKV + h * 64 + j0 : (grp == 3 ? 3 * D_RWKV + d * 64 + j0 : 3 * D_RWKV + 128 + d * 64 + j0);
                float z[8], zpv[8], znv[8], o[8];
                unpack8(zc[k], z); unpack8(zp[k], zpv); unpack8(zn[k], znv);
                const f32x4 mp0 = ld4(p.mu_prev + ch0), mp1 = ld4(p.mu_prev + ch0 + 4), mn0 = ld4(p.mu_next + ch0), mn1 = ld4(p.mu_next + ch0 + 4);
#pragma unroll
                for (int e = 0; e < 4; ++e) { o[e] = z[e] + mp0[e] * (zpv[e] - z[e]) + mn0[e] * (znv[e] - z[e]); o[4 + e] = z[4 + e] + mp1[e] * (zpv[4 + e] - z[4 + e]) + mn1[e] * (znv[4 + e] - z[4 + e]); }
                if (grp < 3) {
                    float* dst = (grp == 0 ? Rf : grp == 1 ? Kf : Vf) + tau * 64 + j0;
                    *(f32x4*)dst = f32x4{o[0], o[1], o[2], o[3]}; *(f32x4*)(dst + 4) = f32x4{o[4], o[5], o[6], o[7]};
                } else if (grp == 3) {
                    u32x4 w;
#pragma unroll
                    for (int e = 0; e < 4; ++e) { const float t0 = 2.0f * frcp(1.0f + FEXP(-2.0f * o[2 * e])) - 1.0f, t1 = 2.0f * frcp(1.0f + FEXP(-2.0f * o[2 * e + 1])) - 1.0f; w[e] = pk2(t0, t1); }
                    *(u32x4*)(TW + tau * LT + j0) = w;
                } else {
                    u32x4 w; w[0] = pk2(o[0], o[1]); w[1] = pk2(o[2], o[3]); w[2] = pk2(o[4], o[5]); w[3] = pk2(o[6], o[7]);
                    *(u32x4*)(TA + tau * LT + j0) = w;
                }
            }
            }
#pragma unroll
            for (int k = 0; k < 8; ++k) {
                const int idx = tid + 256 * k, which = idx >> 10, i = (idx >> 4) & 63, j4 = (idx & 15) * 4;
                bf16_t* dst = (which ? A2T : W2T) + j4 * LT + i;
                dst[0] = f2bf(wv[k][0]); dst[LT] = f2bf(wv[k][1]); dst[2 * LT] = f2bf(wv[k][2]); dst[3 * LT] = f2bf(wv[k][3]);
            }
        }
        __syncthreads();
        {
            f32x4 aw[2] = {f32x4{0.f, 0.f, 0.f, 0.f}, f32x4{0.f, 0.f, 0.f, 0.f}}, ai[2] = {f32x4{0.f, 0.f, 0.f, 0.f}, f32x4{0.f, 0.f, 0.f, 0.f}};
            mmT<2, 2>(aw, W2T, LT, wave, TW, LT, lane);
            mmT<2, 2>(ai, A2T, LT, wave, TA, LT, lane);
            const int j = wave * 16 + q * 4;
            const f32x4 w0v = ld4(p.w0 + d * D_RWKV + h * 64 + j), a0v = ld4(p.a0 + d * D_RWKV + h * 64 + j);
#pragma unroll
            for (int nb = 0; nb < 2; ++nb) {
                const int tau = nb * 16 + l15;
                f32x4 lw, ic;
#pragma unroll
                for (int r = 0; r < 4; ++r) { lw[r] = -0.6065306597126334f * fsigm(w0v[r] + aw[nb][r]); ic[r] = fsigm(a0v[r] + ai[nb][r]); }
                *(f32x4*)(LW + tau * 64 + j) = lw; *(f32x4*)(IC + tau * 64 + j) = ic;
            }
        }
        __syncthreads();
        {
            const int j = lane, t0 = wave * 8;
            float cum[8], kd[8], kkn[8], icv[8], rr[8], vv[8], run = 0.f;
#pragma unroll
            for (int i = 0; i < 8; ++i) {
                const int t = t0 + i;
                run += LW[t * 64 + j]; cum[i] = run;
                const float kr = Kf[t * 64 + j]; icv[i] = IC[t * 64 + j]; rr[i] = Rf[t * 64 + j]; vv[i] = Vf[t * 64 + j];
                kd[i] = kr * (1.0f + (icv[i] - 1.0f) * kac);
                const float kk = kr * kkc;
                const float n2 = wave_sum(kk * kk);
                kkn[i] = kk * frsq(fmaxf(n2, 1e-24f));
                const float bon = wave_sum(rr[i] * kd[i] * rkc);
                if (lane == 0) RBON[(size_t)it * RC + t] = bon;
            }
            TOT[wave * 64 + j] = run;
            __syncthreads();
            float off = 0.f;
            for (int w = 0; w < wave; ++w) off += TOT[w * 64 + j];
            u32x4 vt, bt, kt;
            float e_prev = 0.f;
#pragma unroll
            for (int i = 0; i < 8; ++i) {
                const int t = t0 + i;
                const float cu = off + cum[i], cprev = (i == 0) ? off : off + cum[i - 1];
                const float g = FEXP(cu), gi = FEXP(-cu), gm = FEXP(cprev);
                const float ah = -kkn[i] * gm, bh = kkn[i] * icv[i] * gi, kh = kd[i] * gi, rh = rr[i] * g;
                Ah[t * LT + j] = f2bf(ah); Bh[t * LT + j] = f2bf(bh); Kh[t * LT + j] = f2bf(kh); Rh[t * LT + j] = f2bf(rh);
                if (i & 1) { vt[i >> 1] = pk2(e_prev, vv[i]); bt[i >> 1] = (bt[i >> 1] & 0xFFFFu) | ((unsigned)f2bf(bh) << 16); kt[i >> 1] = (kt[i >> 1] & 0xFFFFu) | ((unsigned)f2bf(kh) << 16); }
                else { e_prev = vv[i]; bt[i >> 1] = f2bf(bh); kt[i >> 1] = f2bf(kh); }
                if (t == RC - 1) GC[j] = g;
            }
            *(u32x4*)(VT + j * LJ + t0) = vt; *(u32x4*)(BhT + j * LJ + t0) = bt; *(u32x4*)(KhT + j * LJ + t0) = kt;
        }
        __syncthreads();
        {
            const bf16_t* X = (wave == 0) ? Ah : (wave & 1) ? Kh : Bh;
            const bf16_t* Y = (wave == 0) ? Bh : (wave == 1) ? Ah : Rh;
#pragma unroll
            for (int xs = 0; xs < 2; ++xs) {
                f32x4 acc[2] = {f32x4{0.f, 0.f, 0.f, 0.f}, f32x4{0.f, 0.f, 0.f, 0.f}};
                mmT<2, 2>(acc, X, LT, xs, Y, LT, lane);
#pragma unroll
                for (int nb = 0; nb < 2; ++nb) {
                    const int yy = nb * 16 + l15, x0 = xs * 16 + q * 4;
                    f32x4 v = acc[nb];
#pragma unroll
                    for (int r = 0; r < 4; ++r) { const int xx = x0 + r; const bool keep = (wave == 0) ? (yy < xx) : (wave == 1) ? (xx < yy) : (xx <= yy); v[r] = keep ? v[r] : 0.f; }
                    if (wave == 0) { *(f32x4*)(PA + yy * 36 + x0) = v; f32x4 t0 = v; for (int r = 0; r < 4; ++r) t0[r] += (x0 + r == yy) ? 1.0f : 0.0f; *(f32x4*)(IA + yy * 36 + x0) = t0; }
                    else { bf16_t* dst = (wave == 1 ? NkaT : wave == 2 ? MbrT : MkrT) + yy * LJ + x0; *(U2*)dst = pack4(v); }
                }
            }
        }
        __syncthreads();
        {
#pragma unroll
            for (int xs = 0; xs < 2; ++xs) {
                f32x4 acc[1] = {f32x4{0.f, 0.f, 0.f, 0.f}};
                mmT<1, 1>(acc, NkaT, LJ, xs, VT + wave * 16 * LJ, LJ, lane);
                const int i = wave * 16 + l15, tb = xs * 16 + q * 4;
                Xu[i * 33 + tb] = acc[0][0]; Xu[i * 33 + tb + 1] = acc[0][1]; Xu[i * 33 + tb + 2] = acc[0][2]; Xu[i * 33 + tb + 3] = acc[0][3];
            }
        }
        __syncthreads();
        {
            auto mm32 = [&](float* Z, const float* init, const float* L, const float* R, int ti, int tj) {
                f32x4 acc = f32x4{0.f, 0.f, 0.f, 0.f};
                if (init) { for (int r = 0; r < 4; ++r) acc[r] = init[(ti * 16 + q * 4 + r) * 36 + tj * 16 + l15]; }
#pragma unroll
                for (int k0 = 0; k0 < 32; k0 += 4) acc = MFMAF32(L[(ti * 16 + l15) * 36 + k0 + q], R[(k0 + q) * 36 + tj * 16 + l15], acc);
#pragma unroll
                for (int r = 0; r < 4; ++r) Z[(ti * 16 + q * 4 + r) * 36 + tj * 16 + l15] = acc[r];
            };
            const int ti = wave >> 1, tj = wave & 1;
            mm32(PB, nullptr, PA, PA, ti, tj);
            __syncthreads();
            mm32(IB, IA, IA, PB, ti, tj); mm32(PA, nullptr, PB, PB, ti, tj);
            __syncthreads();
            mm32(IA, IB, IB, PA, ti, tj); mm32(PB, nullptr, PA, PA, ti, tj);
            __syncthreads();
            mm32(IB, IA, IA, PB, ti, tj); mm32(PA, nullptr, PB, PB, ti, tj);
            __syncthreads();
            f32x4 accw[2], accu[2];
            mm32(IA, IB, IB, PA, ti, tj);
            __syncthreads();
#pragma unroll
            for (int tc = 0; tc < 2; ++tc) { accw[tc] = f32x4{0.f, 0.f, 0.f, 0.f}; accu[tc] = f32x4{0.f, 0.f, 0.f, 0.f}; }
#pragma unroll
            for (int k0 = 0; k0 < 32; k0 += 4) {
                const float la = bf2f(Ah[(k0 + q) * LT + wave * 16 + l15]), lu = Xu[(wave * 16 + l15) * 33 + k0 + q];
#pragma unroll
                for (int tc = 0; tc < 2; ++tc) { const float rv = IA[(k0 + q) * 36 + tc * 16 + l15]; accw[tc] = MFMAF32(la, rv, accw[tc]); accu[tc] = MFMAF32(lu, rv, accu[tc]); }
            }
            __syncthreads();
#pragma unroll
            for (int tc = 0; tc < 2; ++tc)
#pragma unroll
                for (int r = 0; r < 4; ++r) { const int row = wave * 16 + q * 4 + r, col = tc * 16 + l15; Wa[row * LJ + col] = f2bf(accw[tc][r]); U0[row * LJ + col] = f2bf(accu[tc][r]); }
        }
        __syncthreads();
        {
            bf16_t* gPm = (bf16_t*)(chp + CH_PM); bf16_t* gSA = (bf16_t*)(chp + CH_SA); bf16_t* gQT = (bf16_t*)(chp + CH_QT); bf16_t* gY0 = (bf16_t*)(chp + CH_Y0);
            const int x0 = wave * 16 + q * 4;
            {
                f32x4 acc[4] = {f32x4{0.f, 0.f, 0.f, 0.f}, f32x4{0.f, 0.f, 0.f, 0.f}, f32x4{0.f, 0.f, 0.f, 0.f}, f32x4{0.f, 0.f, 0.f, 0.f}};
                mmT<4, 1>(acc, Wa, LJ, wave, BhT, LJ, lane);
#pragma unroll
                for (int nb = 0; nb < 4; ++nb) {
                    const int jp = nb * 16 + l15; const float g = GC[jp];
                    f32x4 v = acc[nb];
#pragma unroll
                    for (int r = 0; r < 4; ++r) v[r] = (v[r] + ((x0 + r == jp) ? 1.0f : 0.0f)) * g;
                    *(U2*)(gPm + jp * 64 + x0) = pack4(v);
                }
            }
            {
                f32x4 acc[4] = {f32x4{0.f, 0.f, 0.f, 0.f}, f32x4{0.f, 0.f, 0.f, 0.f}, f32x4{0.f, 0.f, 0.f, 0.f}, f32x4{0.f, 0.f, 0.f, 0.f}};
                mmT<4, 1>(acc, BhT, LJ, wave, U0, LJ, lane);
                mmT<4, 1>(acc, KhT, LJ, wave, VT, LJ, lane);
                const f32x4 g = *(const f32x4*)(GC + x0);
#pragma unroll
                for (int nb = 0; nb < 4; ++nb) *(U2*)(gSA + (nb * 16 + l15) * 64 + x0) = pack4(acc[nb] * g);
            }
            if (seg == 1) {
                {
                    f32x4 acc[2] = {f32x4{0.f, 0.f, 0.f, 0.f}, f32x4{0.f, 0.f, 0.f, 0.f}};
                    mmT<2, 1>(acc, Wa, LJ, wave, MbrT, LJ, lane);
#pragma unroll
                    for (int nb = 0; nb < 2; ++nb) {
                        const int t = nb * 16 + l15;
                        f32x4 v = acc[nb];
#pragma unroll
                        for (int r = 0; r < 4; ++r) v[r] += bf2f(Rh[t * LT + x0 + r]);
                        *(U2*)(gQT + t * 64 + x0) = pack4(v);
                    }
                }
                {
                    f32x4 acc[2] = {f32x4{0.f, 0.f, 0.f, 0.f}, f32x4{0.f, 0.f, 0.f, 0.f}};
                    mmT<2, 1>(acc, U0, LJ, wave, MbrT, LJ, lane);
                    mmT<2, 1>(acc, VT, LJ, wave, MkrT, LJ, lane);
#pragma unroll
                    for (int nb = 0; nb < 2; ++nb) *(U2*)(gY0 + (nb * 16 + l15) * 64 + x0) = pack4(acc[nb]);
                }
            }
        }
    }
}

__device__ __forceinline__ U2 ldu2(const bf16_t* p) { return *(const U2*)p; }
constexpr int R2D = 6, R2LD = 72;
__device__ __forceinline__ void phaseR2(const Params& p, int bid, int nblk, char* smem) {
    unsigned char* CH = p.ws + WS_CH;
    bf16_t* PL = (bf16_t*)smem;
    const int tid = opaque_tid(), lane = tid & 63, wave = tid >> 6, q = lane >> 4, l15 = lane & 15;
    const int lrow = wave * 16 + (lane >> 2), lcol = (lane & 3) * 16;
    for (int chain = bid; chain < NCHAIN; chain += nblk) {
        const int i = wave * 16 + l15;
        unsigned char* chbase = CH + (size_t)chain * NCK * CH_BYTES;
        f32x4 st[4];
#pragma unroll
        for (int nt = 0; nt < 4; ++nt) st[nt] = f32x4{0.f, 0.f, 0.f, 0.f};
        u32x4 pq[R2D][2]; U2 sa[R2D][4];
#pragma unroll
        for (int k = 0; k < R2D; ++k) {
            const unsigned char* chp = chbase + (size_t)(k < NCK ? k : NCK - 1) * CH_BYTES;
            const bf16_t* gp = (const bf16_t*)(chp + CH_PM) + lrow * 64 + lcol;
            pq[k][0] = *(const u32x4*)gp; pq[k][1] = *(const u32x4*)(gp + 8);
#pragma unroll
            for (int nt = 0; nt < 4; ++nt) sa[k][nt] = ldu2((const bf16_t*)(chp + CH_SA) + i * 64 + nt * 16 + 4 * q);
        }
#pragma unroll 1
        for (int c0 = 0; c0 < NCK; c0 += R2D) {
#pragma unroll
            for (int k = 0; k < R2D; ++k) {
                const int c = c0 + k;
                if (c < NCK) {
                bf16_t* pl = PL + (k & 1) * 64 * R2LD;
                *(u32x4*)(pl + lrow * R2LD + lcol) = pq[k][0]; *(u32x4*)(pl + lrow * R2LD + lcol + 8) = pq[k][1];
                f32x4 ini[4];
#pragma unroll
                for (int nt = 0; nt < 4; ++nt) ini[nt] = f32x4{bitsf(sa[k][nt].x << 16), bitsf(sa[k][nt].x & 0xFFFF0000u), bitsf(sa[k][nt].y << 16), bitsf(sa[k][nt].y & 0xFFFF0000u)};
                {
                    const int cn = (c + R2D < NCK) ? c + R2D : NCK - 1;
                    const unsigned char* chp = chbase + (size_t)cn * CH_BYTES;
                    const bf16_t* gp = (const bf16_t*)(chp + CH_PM) + lrow * 64 + lcol;
                    pq[k][0] = *(const u32x4*)gp; pq[k][1] = *(const u32x4*)(gp + 8);
#pragma unroll
                    for (int nt = 0; nt < 4; ++nt) sa[k][nt] = ldu2((const bf16_t*)(chp + CH_SA) + i * 64 + nt * 16 + 4 * q);
                }
                __syncthreads();
                bf16_t* gSA = (bf16_t*)(chbase + (size_t)c * CH_BYTES + CH_SA) + i * 64 + 4 * q;
                bf16x8 bfr[2];
#pragma unroll
                for (int ks = 0; ks < 2; ++ks) {
                    const U2 lo = pack4(st[2 * ks]), hi = pack4(st[2 * ks + 1]);
                    bfr[ks] = __builtin_bit_cast(bf16x8, u32x4{lo.x, lo.y, hi.x, hi.y});
                    *(U2*)(gSA + (2 * ks) * 16) = lo; *(U2*)(gSA + (2 * ks + 1) * 16) = hi;
                }
#pragma unroll
                for (int nt = 0; nt < 4; ++nt) {
                    f32x4 acc = ini[nt];
#pragma unroll
                    for (int ks = 0; ks < 2; ++ks) {
                        const U2 lo = *(const U2*)(pl + (nt * 16 + l15) * R2LD + 32 * ks + 4 * q), hi = *(const U2*)(pl + (nt * 16 + l15) * R2LD + 32 * ks + 16 + 4 * q);
                        acc = MFMA16(__builtin_bit_cast(bf16x8, u32x4{lo.x, lo.y, hi.x, hi.y}), bfr[ks], acc);
                    }
                    st[nt] = acc;
                }
                }
            }
        }
        __syncthreads();
    }
}

__device__ __forceinline__ void phaseR3(const Params& p, int bid, int nblk, char* smem) {
    const bf16_t* P = WSP(bf16_t, WS_R1);
    const unsigned char* CH = p.ws + WS_CH;
    const float* RBON = WSP(float, WS_RBON);
    bf16_t* MIX = WSP(bf16_t, WS_R3);
    float* red = (float*)smem;
    const int tid = opaque_tid(), lane = tid & 63, wave = tid >> 6, q = lane >> 4, l15 = lane & 15;
    for (int m = bid * 256 + tid; m < MLAT; m += nblk * 256) {
        const float* sp = WSP(float, WS_SSQP) + (size_t)m * LRU_BLOCKS;
        float sq = 0.f;
#pragma unroll
        for (int c = 0; c < LRU_BLOCKS; ++c) sq += sp[c];
        WSP(float, WS_RINV)[m] = frsq(sq * (1.0f / D_LRU) + RMS_EPS);
    }
    bf16_t* G2T = (bf16_t*)(smem + 1024);
    const int nbh = nblk / HEADS;
    const bool uniform = (nbh > 0) && (nblk % HEADS == 0);
    constexpr int NP16 = SEQ / 16, NW = BATCH * NP16;
    const int nwv = uniform ? nbh * 4 : nblk * 4;
    int hcur = -1;
    for (int wi0 = (uniform ? (bid % nbh) : bid) * 4; wi0 < (uniform ? NW : NW * HEADS); wi0 += nwv) {
        int h; if (uniform) h = bid / nbh; else h = (wi0 / 4) % HEADS;
        if (h != hcur) {
            __syncthreads();
            for (int idx = tid; idx < 128 * 16; idx += 256) {
                const int c = idx >> 4, i4 = (idx & 15) * 4;
                const f32x4 w = ld4(p.g2 + (size_t)c * D_RWKV + h * 64 + i4);
                bf16_t* dst = G2T + i4 * 136 + c;
                dst[0] = f2bf(w[0]); dst[136] = f2bf(w[1]); dst[272] = f2bf(w[2]); dst[408] = f2bf(w[3]);
            }
            hcur = h;
            __syncthreads();
        }
        const int wi = uniform ? wi0 + wave : (wi0 / 4 / HEADS) * 4 + wave;
        if (wi >= NW) continue;
        const int b = wi / NP16, p16 = wi % NP16, pc = p16 >> 1, pl = (p16 & 1) * 16 + l15, pos = pc * RC + pl;
        f32x4 y[4], g[4];
#pragma unroll
        for (int xs = 0; xs < 4; ++xs) { y[xs] = f32x4{0.f, 0.f, 0.f, 0.f}; g[xs] = f32x4{0.f, 0.f, 0.f, 0.f}; }
        float bon = 0.f;
#pragma unroll
        for (int d = 0; d < 2; ++d) {
            const int chain = (b * HEADS + h) * 2 + d, c = NCC + (d ? NLC - 1 - pc : pc), tau = d ? RC - 1 - pl : pl;
            const size_t item = (size_t)chain * NCK + c;
            const unsigned char* chp = CH + item * CH_BYTES;
            const bf16_t* gS = (const bf16_t*)(chp + CH_SA); const bf16_t* gQT = (const bf16_t*)(chp + CH_QT); const bf16_t* gY0 = (const bf16_t*)(chp + CH_Y0);
            bf16x8 yf[2];
#pragma unroll
            for (int ks = 0; ks < 2; ++ks) yf[ks] = *(const bf16x8*)(gQT + tau * 64 + ks * 32 + 8 * q);
#pragma unroll
            for (int xs = 0; xs < 4; ++xs) {
                f32x4 acc = ldb4(gY0 + tau * 64 + xs * 16 + 4 * q);
#pragma unroll
                for (int ks = 0; ks < 2; ++ks) acc = MFMA16(*(const bf16x8*)(gS + (xs * 16 + l15) * 64 + ks * 32 + 8 * q), yf[ks], acc);
                y[xs] += acc;
            }
            bon += RBON[item * RC + tau];
        }
#pragma unroll
        for (int ks = 0; ks < 4; ++ks) {
            float o[8]; shifted8(p, P, 1, b, pos, SEQ, 3 * D_RWKV + 256 + ks * 32 + 8 * q, o);
            u32x4 t; t[0] = pk2(fsigm(o[0]), fsigm(o[1])); t[1] = pk2(fsigm(o[2]), fsigm(o[3])); t[2] = pk2(fsigm(o[4]), fsigm(o[5])); t[3] = pk2(fsigm(o[6]), fsigm(o[7]));
            const bf16x8 sg = __builtin_bit_cast(bf16x8, t);
#pragma unroll
            for (int xs = 0; xs < 4; ++xs) g[xs] = MFMA16(*(const bf16x8*)(G2T + (xs * 16 + l15) * 136 + ks * 32 + 8 * q), sg, g[xs]);
        }
        float s1 = 0.f, s2 = 0.f;
#pragma unroll
        for (int xs = 0; xs < 4; ++xs) { s1 += hsum4(y[xs]); s2 += hsum4(y[xs] * y[xs]); }
        s1 += __shfl_xor(s1, 16); s1 += __shfl_xor(s1, 32); s2 += __shfl_xor(s2, 16); s2 += __shfl_xor(s2, 32);
        const float mu = s1 * (1.0f / 64.0f), var = fmaxf(s2 * (1.0f / 64.0f) - mu * mu, 0.f), rstd = frsq(var + GN_EPS);
        const size_t mrow = rwkv_row(1, b, pos);
        const size_t mprev = pos > 0 ? rwkv_row(1, b, pos - 1) : mrow, mnext = pos < SEQ - 1 ? rwkv_row(1, b, pos + 1) : mrow;
#pragma unroll
        for (int xs = 0; xs < 4; ++xs) {
            const int i0 = xs * 16 + q * 4, chv = 2 * D_RWKV + h * 64 + i0;
            const f32x4 z = ldb4(P + mrow * D_IN + RW0 + chv);
            f32x4 zp = ldb4(P + mprev * D_IN + RW0 + chv), zn = ldb4(P + mnext * D_IN + RW0 + chv);
            if (pos == 0) zp = f32x4{0.f, 0.f, 0.f, 0.f};
            if (pos == SEQ - 1) zn = f32x4{0.f, 0.f, 0.f, 0.f};
            const f32x4 v = z + ld4(p.mu_prev + chv) * (zp - z) + ld4(p.mu_next + chv) * (zn - z);
            const f32x4 yn = (y[xs] - mu) * rstd * ld4(p.gn_g + h * 64 + i0) + ld4(p.gn_b + h * 64 + i0);
            *(U2*)(MIX + mrow * D_MIX + D_LRU + h * 64 + i0) = pack4((yn + bon * v) * g[xs]);
        }
    }
}

__device__ __forceinline__ void phaseJ(const Params& p, int bid, int nblk, char* smem) {
    const bf16_t* MIX = WSP(bf16_t, WS_R3); const bf16_t* WB = WSP(bf16_t, WS_WBOUT);
    bf16_t* YOUT = WSP(bf16_t, WS_R1);
    const float* RINV = WSP(float, WS_RINV);
    constexpr int BM = 32 * MI_J, NTN = D_MODEL / 128, NTM = MLAT / BM;
    constexpr int GM = (NTM % 8 == 0) ? 8 : 1;
    for (int it = xcd_vbid(bid, nblk); it < NTN * NTM; it += nblk) {
        const int mg = it / (GM * NTN), r = it % (GM * NTN), nt = r / GM, mt = mg * GM + (r % GM);
        gemm_tile<MI_J, false>(smem, MIX, D_MIX, nullptr, mt * BM, WB, nullptr, D_MIX, nt * 128, D_MIX, [&](int ml, int nl, f32x4 v, f32x4) {
            *(U2*)(YOUT + (size_t)(mt * BM + ml) * D_MODEL + nt * 128 + nl) = pack4(v);
        }, RINV, D_LRU / 64);
    }
}

constexpr int KUL = D_MODEL + 2;
static_assert((16 * KUL + 4 * 256) * 4 <= SMEM_BYTES && N_EXPERTS <= 16 && MLAT % 16 == 0, "phase K lds");
__device__ __forceinline__ void phaseK(const Params& p, int bid, int nblk, char* smem) {
    const int tid = opaque_tid(), lane = tid & 63, wave = tid >> 6, q = lane >> 4, l15 = lane & 15;
    const float* MOD = WSP(float, WS_MOD); const float* STATS = WSP(float, WS_STATS);
    const bf16_t* YOUT = WSP(bf16_t, WS_R1);
    float* H1 = WSP(float, WS_R5); bf16_t* U2b = WSP(bf16_t, WS_R6); float* AFF = WSP(float, WS_AFF);
    float* UL = (float*)smem;
    float* PL = UL + 16 * KUL;
    for (int rb = bid; rb < MLAT / 16; rb += nblk) {
        __syncthreads();
#pragma unroll 1
        for (int rr = 0; rr < 4; ++rr) {
            const int lr = wave * 4 + rr, row = rb * 16 + lr;
            const float* xr = p.x + (size_t)row * D_MODEL;
            const float* md = MOD + (size_t)(row / SEQ) * 6 * D_MODEL;
            const float mu0 = STATS[row * 2], rs0 = STATS[row * 2 + 1];
            f32x4 v0, v1, v2, v3; float s = 0.f;
#define PK_LOAD(V, J) { const int k = (J) * 256 + lane * 4; \
            V = ALPHA_F * ((ld4(xr + k) - mu0) * rs0 * ld4(p.ln_in_g + k) + ld4(p.ln_in_b + k)) + ld4(md + 2 * D_MODEL + k) * ldb4(YOUT + (size_t)row * D_MODEL + k); s += hsum4(V); }
            PK_LOAD(v0, 0)
            if (NV > 1) PK_LOAD(v1, 1) else v1 = f32x4{0.f, 0.f, 0.f, 0.f};
            if (NV > 2) { PK_LOAD(v2, 2) PK_LOAD(v3, 3) } else { v2 = v1; v3 = v1; }
#undef PK_LOAD
            const float mu = wave_sum(s) * (1.0f / D_MODEL);
            v0 -= mu; float s2 = hsum4(v0 * v0);
            if (NV > 1) { v1 -= mu; s2 += hsum4(v1 * v1); }
            if (NV > 2) { v2 -= mu; v3 -= mu; s2 += hsum4(v2 * v2) + hsum4(v3 * v3); }
            const float rstd = frsq(wave_sum(s2) * (1.0f / D_MODEL) + LN_EPS);
#pragma unroll
            for (int j = 0; j < NV; ++j) {
                const int k = j * 256 + lane * 4;
                const f32x4 vv = (j == 0) ? v0 : (j == 1) ? v1 : (j == 2) ? v2 : v3;
                const f32x4 h = vv * rstd * ld4(p.ln1_g + k) + ld4(p.ln1_b + k);
                *(f32x4*)(H1 + (size_t)row * D_MODEL + k) = h;
                const f32x4 u = h * (1.0f + ld4(md + 4 * D_MODEL + k)) + ld4(md + 3 * D_MODEL + k);
                *(U2*)(U2b + (size_t)row * D_MODEL + k) = pack4(u);
                float* ul = UL + lr * KUL + k;
                *(f32x2_e*)ul = f32x2_e{u[0], u[1]}; *(f32x2_e*)(ul + 2) = f32x2_e{u[2], u[3]};
            }
        }
        __syncthreads();
        {
            f32x4 acc = f32x4{0.f, 0.f, 0.f, 0.f};
            const int kq0 = wave * (D_MODEL / 4);
#pragma unroll 8
            for (int s4 = 0; s4 < D_MODEL / 16; ++s4) {
                const int k = kq0 + s4 * 4 + q;
                const float av = UL[l15 * KUL + k];
                const float bv = (l15 < N_EXPERTS) ? p.w_router[(size_t)k * N_EXPERTS + l15] : 0.f;
                acc = MFMAF32(av, bv, acc);
            }
#pragma unroll
            for (int r = 0; r < 4; ++r) PL[wave * 256 + (q * 4 + r) * 16 + l15] = acc[r];
        }
        __syncthreads();
        {
            const int lr = tid >> 4, e = tid & 15;
            const bool valid = e < N_EXPERTS;
            float lg = PL[tid] + PL[256 + tid] + PL[512 + tid] + PL[768 + tid];
            float mx = valid ? lg : -3.0e38f;
#pragma unroll
            for (int o = 1; o < 16; o <<= 1) mx = fmaxf(mx, __shfl_xor(mx, o));
            const float ex = valid ? expf(lg - mx) : 0.f;
            float den = ex;
#pragma unroll
            for (int o = 1; o < 16; o <<= 1) den += __shfl_xor(den, o);
            if (valid) AFF[(size_t)(rb * 16 + lr) * N_EXPERTS + e] = ex / den;
        }
    }
}

__device__ __forceinline__ int block_sum_int(int v, int* red) {
    const int tid_ = opaque_tid(), lane = tid_ & 63, wave = tid_ >> 6;
#pragma unroll
    for (int o = 1; o < 64; o <<= 1) v += __shfl_xor(v, o);
    __syncthreads();
    if (lane == 0) red[wave] = v;
    __syncthreads();
    return red[0] + red[1] + red[2] + red[3];
}
__device__ __forceinline__ void phaseL(const Params& p, int bid, int nblk, char* smem) {
    const float* AFF = WSP(float, WS_AFF);
    int* IDX = WSP(int, WS_IDX); float* GATE = WSP(float, WS_GATE); int* SLOTOF = WSP(int, WS_SLOT);
    unsigned* vals = (unsigned*)smem;
    int* red = (int*)(vals + SEQ);
    int* wsum = red + 8;
    const int tid = opaque_tid(), lane = tid & 63, wave = tid >> 6;
    constexpr int PER = SEQ / 256;
    {
        constexpr int NL = BATCH * N_EXPERTS;
        const bool spare = nblk > NL + 32;
        if (spare ? (bid >= NL) : true) convert_experts(p, spare ? bid - NL : bid, spare ? nblk - NL : nblk, smem, 0, 2);
        if (spare && bid >= NL) return;
        __syncthreads();
    }
    for (int be = bid; be < BATCH * N_EXPERTS; be += nblk) {
        const int b = be / N_EXPERTS, e = be % N_EXPERTS;
        __syncthreads();
        for (int t = tid; t < SEQ; t += 256) vals[t] = fbits(AFF[((size_t)b * SEQ + t) * N_EXPERTS + e]);
        __syncthreads();
        unsigned lo = 0u, hi = 0x7F800000u;
        while (lo < hi) {
            const unsigned mid = lo + (hi - lo + 1u) / 2u;
            int c = 0;
            for (int t = tid; t < SEQ; t += 256) c += (vals[t] >= mid) ? 1 : 0;
            c = block_sum_int(c, red);
            if (c >= CAP) lo = mid; else hi = mid - 1u;
        }
        const unsigned T = lo;
        int cg = 0, ce = 0;
        for (int q = 0; q < PER; ++q) { const unsigned v = vals[tid * PER + q]; cg += (v > T) ? 1 : 0; ce += (v == T) ? 1 : 0; }
        int pg = cg, pe = ce;
#pragma unroll
        for (int o = 1; o < 64; o <<= 1) { const int a = __shfl_up(pg, o), bb = __shfl_up(pe, o); if (lane >= o) { pg += a; pe += bb; } }
        __syncthreads();
        if (lane == 63) { wsum[wave] = pg; wsum[4 + wave] = pe; }
        __syncthreads();
        int og = 0, oe = 0, totg = 0;
        for (int w = 0; w < 4; ++w) { if (w < wave) { og += wsum[w]; oe += wsum[4 + w]; } totg += wsum[w]; }
        int posg = og + pg - cg, pose = oe + pe - ce;
        const int need_eq = CAP - totg;
        for (int q = 0; q < PER; ++q) {
            const int t = tid * PER + q; const unsigned v = vals[t];
            int slot = -1;
            if (v > T) { slot = posg++; }
            else if (v == T) { if (pose < need_eq) slot = totg + pose; pose++; }
            if (slot >= 0) { IDX[(size_t)be * CAP + slot] = b * SEQ + t; GATE[(size_t)be * CAP + slot] = bitsf(v); }
            SLOTOF[((size_t)b * SEQ + t) * N_EXPERTS + e] = slot;
        }
    }
}

__device__ __forceinline__ void phaseM(const Params& p, int bid, int nblk, char* smem) {
    const bf16_t* U2b = WSP(bf16_t, WS_R6); const int* IDX = WSP(int, WS_IDX);
    bf16_t* HID = WSP(bf16_t, WS_R1);
    constexpr int BM = 32 * MI_E, NTN = D_EXPERT / 64, NTM = CAP / BM;
    for (int it = xcd_vbid(bid, nblk); it < BATCH * N_EXPERTS * NTM * NTN; it += nblk) {
        const int mt = it % NTM, b = (it / NTM) % BATCH, nt = (it / (NTM * BATCH)) % NTN, e = it / (NTM * BATCH * NTN), be = b * N_EXPERTS + e;
        const bf16_t* wg = WSP(bf16_t, WS_WG + (size_t)e * WEXP_BYTES); const bf16_t* wu = WSP(bf16_t, WS_WU + (size_t)e * WEXP_BYTES);
        gemm_tile<MI_E, true>(smem, U2b, D_MODEL, IDX + (size_t)be * CAP, mt * BM, wg, wu, D_MODEL, nt * 64, D_MODEL, [&](int ml, int nl, f32x4 g, f32x4 u) {
            U2 o; o.x = pk2(siluf_(g[0]) * u[0], siluf_(g[1]) * u[1]); o.y = pk2(siluf_(g[2]) * u[2], siluf_(g[3]) * u[3]);
            *(U2*)(HID + ((size_t)be * CAP + mt * BM + ml) * D_EXPERT + nt * 64 + nl) = o;
        });
    }
    {
        constexpr int NT = BATCH * N_EXPERTS * NTM * NTN;
        const int rem = NT % nblk, vb = xcd_vbid(bid, nblk);
        if (rem == 0 || nblk - rem < 32) convert_experts(p, vb, nblk, smem, 2, 3);
        else if (vb >= rem) convert_experts(p, vb - rem, nblk - rem, smem, 2, 3);
    }
}
__device__ __forceinline__ void phaseN(const Params& p, int bid, int nblk, char* smem) {
    const bf16_t* HID = WSP(bf16_t, WS_R1); const float* GATE = WSP(float, WS_GATE);
    bf16_t* YS = WSP(bf16_t, WS_R2);
    constexpr int BM = 32 * MI_E, NTN = D_MODEL / 128, NTM = CAP / BM;
    for (int it = xcd_vbid(bid, nblk); it < BATCH * N_EXPERTS * NTM * NTN; it += nblk) {
        const int mt = it % NTM, b = (it / NTM) % BATCH, nt = (it / (NTM * BATCH)) % NTN, e = it / (NTM * BATCH * NTN), be = b * N_EXPERTS + e;
        const bf16_t* wd = WSP(bf16_t, wdown_off(e));
        gemm_tile<MI_E, false>(smem, HID + (size_t)be * CAP * D_EXPERT, D_EXPERT, nullptr, mt * BM, wd, nullptr, D_EXPERT, nt * 128, D_EXPERT, [&](int ml, int nl, f32x4 v, f32x4) {
            const int slot = mt * BM + ml;
            const float gt = GATE[(size_t)be * CAP + slot];
            *(U2*)(YS + ((size_t)be * CAP + slot) * D_MODEL + nt * 128 + nl) = pack4(v * gt);
        });
    }
}
__device__ __forceinline__ void phaseO(const Params& p, int bid, int nblk, char* smem) {
    const int tid_ = opaque_tid(), lane = tid_ & 63, wave = tid_ >> 6;
    const float* MOD = WSP(float, WS_MOD); const float* H1 = WSP(float, WS_R5); const bf16_t* YS = WSP(bf16_t, WS_R2); const int* SLOTOF = WSP(int, WS_SLOT);
    for (int row = bid * 4 + wave; row < MLAT; row += nblk * 4) {
        const float* md = MOD + (size_t)(row / SEQ) * 6 * D_MODEL;
        f32x4 v0, v1, v2, v3; float s = 0.f;
        f32x4 y0 = f32x4{0.f, 0.f, 0.f, 0.f}, y1 = y0, y2 = y0, y3 = y0;
        const int myslot = (lane < N_EXPERTS) ? SLOTOF[(size_t)row * N_EXPERTS + lane] : -1;
        const int bbase = (row / SEQ) * N_EXPERTS;
        for (int e = 0; e < N_EXPERTS; ++e) {
            const int sl = __shfl(myslot, e);
            if (sl >= 0) {
                const bf16_t* yr = YS + ((size_t)(bbase + e) * CAP + sl) * D_MODEL + lane * 4;
                { const U2 u = *(const U2*)yr; y0 += f32x4{bitsf(u.x << 16), bitsf(u.x & 0xFFFF0000u), bitsf(u.y << 16), bitsf(u.y & 0xFFFF0000u)}; }
                if (NV > 1) { const U2 u = *(const U2*)(yr + 256); y1 += f32x4{bitsf(u.x << 16), bitsf(u.x & 0xFFFF0000u), bitsf(u.y << 16), bitsf(u.y & 0xFFFF0000u)}; }
                if (NV > 2) { const U2 u = *(const U2*)(yr + 512); y2 += f32x4{bitsf(u.x << 16), bitsf(u.x & 0xFFFF0000u), bitsf(u.y << 16), bitsf(u.y & 0xFFFF0000u)};
                              const U2 w = *(const U2*)(yr + 768); y3 += f32x4{bitsf(w.x << 16), bitsf(w.x & 0xFFFF0000u), bitsf(w.y << 16), bitsf(w.y & 0xFFFF0000u)}; }
            }
        }
#define PO_LOAD(V, J) { const int k = (J) * 256 + lane * 4; const f32x4 yy = ((J) == 0) ? y0 : ((J) == 1) ? y1 : ((J) == 2) ? y2 : y3; V = ALPHA_F * ld4(H1 + (size_t)row * D_MODEL + k) + ld4(md + 5 * D_MODEL + k) * yy; s += hsum4(V); }
        PO_LOAD(v0, 0)
        if (NV > 1) PO_LOAD(v1, 1) else v1 = f32x4{0.f, 0.f, 0.f, 0.f};
        if (NV > 2) { PO_LOAD(v2, 2) PO_LOAD(v3, 3) } else { v2 = v1; v3 = v1; }
#undef PO_LOAD
        const float mu = wave_sum(s) * (1.0f / D_MODEL);
        v0 -= mu; float s2 = hsum4(v0 * v0);
        if (NV > 1) { v1 -= mu; s2 += hsum4(v1 * v1); }
        if (NV > 2) { v2 -= mu; v3 -= mu; s2 += hsum4(v2 * v2) + hsum4(v3 * v3); }
        const float rstd = frsq(wave_sum(s2) * (1.0f / D_MODEL) + LN_EPS);
#pragma unroll
        for (int j = 0; j < NV; ++j) {
            const int k = j * 256 + lane * 4;
            const f32x4 vv = (j == 0) ? v0 : (j == 1) ? v1 : (j == 2) ? v2 : v3;
            *(f32x4*)(p.out + (size_t)row * D_MODEL + k) = vv * rstd * ld4(p.ln2_g + k) + ld4(p.ln2_b + k);
        }
    }
}

#define XB_TMO      128
#define XB_XCNT(j)  (256  + 64 * (j))
#define XB_XSUB(j)  (1280 + 64 * (j))
#define XB_XGEN(j)  (2304 + 64 * (j))
#define XB_TOP      3328
#define XB_TOPGEN   3392
#define XCD_BAR_WORDS 3456
#define XB_SPIN_CAP (1u << 22)
#ifndef HOST_EMU
__device__ __forceinline__ unsigned xb_ld(unsigned* p) { return __hip_atomic_load(p, __ATOMIC_RELAXED, __HIP_MEMORY_SCOPE_AGENT); }
__device__ __forceinline__ unsigned xb_add(unsigned* p, unsigned v) { return __hip_atomic_fetch_add(p, v, __ATOMIC_RELAXED, __HIP_MEMORY_SCOPE_AGENT); }
__device__ __forceinline__ unsigned xb_xcc_id() { return (unsigned)__builtin_amdgcn_s_getreg((3 << 11) | 20) & 0xFu; }
#define XB_SPIN(cond, bar) do { unsigned _sp = 0; while (cond) { __builtin_amdgcn_s_sleep(1); \
    if ((++_sp & 255u) == 0u) { if (xb_ld(&(bar)[XB_TMO])) break; if (_sp > XB_SPIN_CAP) { atomicAdd(&(bar)[XB_TMO], 1u); break; } } } } while (0)
#define XB_LAS __attribute__((address_space(3)))
struct XcdBarrier { unsigned off; unsigned x; volatile XB_LAS unsigned* st; unsigned G; };
__device__ __forceinline__ XcdBarrier xcd_barrier_post(unsigned* ctrl, unsigned off, volatile XB_LAS unsigned* st, unsigned G, bool member = true) {
    XcdBarrier b; b.off = off; b.x = xb_xcc_id(); b.st = st; b.G = G; unsigned* bar = ctrl + off;
    if (!member) return b;
    if (threadIdx.x == 0) (void)xb_add(&bar[XB_XCNT(b.x)], 1u);
    return b;
}
__device__ __forceinline__ void xcd_barrier_complete(unsigned* bar, unsigned x, unsigned& nloc, unsigned& nx, unsigned G) {
    unsigned sum, cnt, mine, sp = 0u;
    for (;;) {
        sum = 0u; cnt = 0u; mine = 0u;
#pragma unroll
        for (unsigned j = 0; j < 16; ++j) { const unsigned c = xb_ld(&bar[XB_XCNT(j)]); sum += c; cnt += (c > 0u) ? 1u : 0u; mine = (j == x) ? c : mine; }
        if (sum == G) break;
        __builtin_amdgcn_s_sleep(1);
        if ((++sp & 255u) == 0u) { if (xb_ld(&bar[XB_TMO])) break; if (sp > XB_SPIN_CAP) { atomicAdd(&bar[XB_TMO], 1u); break; } }
    }
    nloc = mine > 0u ? mine : 1u; nx = cnt > 0u ? cnt : 1u;
}
__device__ __forceinline__ void grid_barrier(const XcdBarrier& b, unsigned* ctrl) {
    asm volatile("s_waitcnt vmcnt(0)" ::: "memory");
    __syncthreads();
    if (threadIdx.x == 0) {
        unsigned* bar = ctrl + b.off;
        __builtin_amdgcn_s_waitcnt(0);
        volatile XB_LAS unsigned* st = b.st;
        unsigned nloc = st[0], nx = st[1];
        if (nloc == 0u) { xcd_barrier_complete(bar, b.x, nloc, nx, b.G); st[0] = nloc; st[1] = nx; }
        const unsigned old = xb_add(&bar[XB_XSUB(b.x)], 1u);
        const unsigned gen = old / nloc;
        if (old + 1u == (gen + 1u) * nloc) {
            __builtin_amdgcn_fence(__ATOMIC_RELEASE, "agent");
            asm volatile("s_waitcnt vmcnt(0)" ::: "memory");
            const unsigned og = xb_add(&bar[XB_TOP], 1u);
            const unsigned tg = og / nx;
            if (og + 1u == (tg + 1u) * nx) xb_add(&bar[XB_TOPGEN], 1u);
            else XB_SPIN(xb_ld(&bar[XB_TOPGEN]) == tg, bar);
            __builtin_amdgcn_fence(__ATOMIC_ACQUIRE, "agent");
            xb_add(&bar[XB_XGEN(b.x)], 1u);
            asm volatile("s_waitcnt vmcnt(0)" ::: "memory");
        } else {
            XB_SPIN(xb_ld(&bar[XB_XGEN(b.x)]) == gen, bar);
            __builtin_amdgcn_fence(__ATOMIC_ACQUIRE, "agent");
            asm volatile("s_waitcnt vmcnt(0)" ::: "memory");
        }
    }
    __syncthreads();
}
#else
struct XcdBarrier { int dummy; };
__device__ __forceinline__ void grid_barrier(const XcdBarrier&, unsigned*) { __syncthreads(); }
#endif

__global__ void __launch_bounds__(256, 2) fused_forward(Params p) {
    __shared__ __attribute__((aligned(16))) char smem[SMEM_BYTES];
    __shared__ __attribute__((aligned(16))) unsigned xb_words[4];
    if (threadIdx.x == 0) { xb_words[0] = 0u; xb_words[1] = 0u; xb_words[2] = 0u; xb_words[3] = 0u; }
    __syncthreads();
    const int bid = blockIdx.x, nblk = gridDim.x;
    const bool split = nblk >= 2 * NCHAIN;
#ifdef HOST_EMU
    const XcdBarrier gb{0}; const XcdBarrier gs{0};
#else
    const XcdBarrier gb = xcd_barrier_post(WSP(unsigned, WS_CTRL), 0u, (volatile XB_LAS unsigned*)xb_words, (unsigned)nblk);
    const XcdBarrier gs = xcd_barrier_post(WSP(unsigned, WS_CTRL), (unsigned)XCD_BAR_WORDS, (volatile XB_LAS unsigned*)xb_words + 2, (unsigned)(nblk - NCHAIN), split && bid >= NCHAIN);
#endif
    phaseA(p, bid, nblk, smem); grid_barrier(gb, WSP(unsigned, WS_CTRL));
    phaseB(p, bid, nblk, smem); grid_barrier(gb, WSP(unsigned, WS_CTRL));
    phaseC(p, bid, nblk, smem); grid_barrier(gb, WSP(unsigned, WS_CTRL));
    phaseD(p, bid, nblk, smem);
    phaseR1(p, bid, nblk, smem); grid_barrier(gb, WSP(unsigned, WS_CTRL));
    {
        const int lb = split ? bid - NCHAIN : bid, ln = split ? nblk - NCHAIN : nblk;
        const bool lru_member = !split || bid >= NCHAIN;
        if (!split || bid < NCHAIN) phaseR2(p, bid, split ? NCHAIN : nblk, smem);
        if (lru_member) phaseE(p, lb, ln, smem);
        if (split) { if (lru_member) grid_barrier(gs, WSP(unsigned, WS_CTRL)); } else grid_barrier(gb, WSP(unsigned, WS_CTRL));
        if (lru_member) phaseF(p, lb, ln, smem);
        grid_barrier(gb, WSP(unsigned, WS_CTRL));
    }
    phaseR3(p, bid, nblk, smem); grid_barrier(gb, WSP(unsigned, WS_CTRL));
    phaseJ(p, bid, nblk, smem); grid_barrier(gb, WSP(unsigned, WS_CTRL));
    phaseK(p, bid, nblk, smem); grid_barrier(gb, WSP(unsigned, WS_CTRL));
    phaseL(p, bid, nblk, smem); grid_barrier(gb, WSP(unsigned, WS_CTRL));
    phaseM(p, bid, nblk, smem); grid_barrier(gb, WSP(unsigned, WS_CTRL));
    phaseN(p, bid, nblk, smem); grid_barrier(gb, WSP(unsigned, WS_CTRL));
    phaseO(p, bid, nblk, smem);
}

#ifdef MULTI_LAUNCH
#define PHASE_KERNEL(NAME) \
    __global__ void __launch_bounds__(256) k_##NAME(Params p) { __shared__ __attribute__((aligned(16))) char smem[SMEM_BYTES]; NAME(p, blockIdx.x, gridDim.x, smem); }
PHASE_KERNEL(phaseA) PHASE_KERNEL(phaseB) PHASE_KERNEL(phaseC) PHASE_KERNEL(phaseD) PHASE_KERNEL(phaseE) PHASE_KERNEL(phaseF) PHASE_KERNEL(phaseR1) PHASE_KERNEL(phaseR2) PHASE_KERNEL(phaseR3)
PHASE_KERNEL(phaseJ) PHASE_KERNEL(phaseK) PHASE_KERNEL(phaseL) PHASE_KERNEL(phaseM) PHASE_KERNEL(phaseN) PHASE_KERNEL(phaseO)
#ifdef HOST_EMU
void emu_hook(const char* name, const Params& p);
#define LAUNCH(NAME, grid) do { EMU_LAUNCH(k_##NAME, grid, 256, p); emu_hook(#NAME, p); } while (0)
#else
#define LAUNCH(NAME, grid) hipLaunchKernelGGL(k_##NAME, dim3(grid), dim3(256), 0, stream, p)
#endif
#endif

extern "C" void kernel_launch(void* const* d_in, const int* in_sizes, int n_in, void* d_out, int out_size, void* d_ws, size_t ws_size, hipStream_t stream) {
    if (n_in != 38 || out_size != MLAT * D_MODEL || ws_size < WS_END) { fprintf(stderr, "kernel_launch: unexpected shapes (n_in %d out %d ws %zu need %zu)\n", n_in, out_size, ws_size, (size_t)WS_END); return; }
    Params p{};
    const float** f = (const float**)&p;
    for (int i = 0; i < 38; ++i) f[i] = (const float*)d_in[i];
    p.out = (float*)d_out; p.ws = (unsigned char*)d_ws;
#ifdef MULTI_LAUNCH
    const int G = 512;
    LAUNCH(phaseA, 6 * D_MODEL / 16);
    LAUNCH(phaseB, G);
    LAUNCH(phaseC, G);
    LAUNCH(phaseD, G);
    LAUNCH(phaseE, 16);
    LAUNCH(phaseF, G);
    LAUNCH(phaseR1, G);
    LAUNCH(phaseR2, NCHAIN);
    LAUNCH(phaseR3, G);
    LAUNCH(phaseJ, G);
    LAUNCH(phaseK, G);
    LAUNCH(phaseL, BATCH * N_EXPERTS);
    LAUNCH(phaseM, G);
    LAUNCH(phaseN, G);
    LAUNCH(phaseO, G);
#elif defined(HOST_EMU)
    EMU_LAUNCH(fused_forward, 1, 256, p);
#else
    static int grid_blocks = 0;
    if (!grid_blocks) {
        int dev = 0, cus = 0, per_cu = 0;
        (void)hipGetDevice(&dev);
        (void)hipDeviceGetAttribute(&cus, hipDeviceAttributeMultiprocessorCount, dev);
        (void)hipOccupancyMaxActiveBlocksPerMultiprocessor(&per_cu, fused_forward, 256, 0);
        if (per_cu > 2) per_cu = 2;
        if (per_cu < 1) { fprintf(stderr, "kernel_launch: occupancy query returned %d blocks per CU\n", per_cu); per_cu = 1; }
        grid_blocks = cus * per_cu;
    }
    (void)hipMemsetAsync((char*)d_ws + WS_CTRL, 0, 2 * XCD_BAR_WORDS * 4, stream);
    void* args[] = {&p};
    hipError_t e = hipLaunchCooperativeKernel((void*)fused_forward, dim3(grid_blocks), dim3(256), args, 0, stream);
    if (e != hipSuccess) fprintf(stderr, "cooperative launch failed: %s (grid %d)\n", hipGetErrorString(e), grid_blocks);
#endif
}
```

```cpp
#ifndef HOST_EMU
#include <hip/hip_runtime.h>
#include <cstdio>
#endif
#include <cstdint>
#include <cstddef>

#ifdef CFG_SMALL
constexpr int D_MODEL = 256, BATCH = 2, SEQ = 256, GRID_W = 16, CTX_LEN = 64, LRU_BLOCKS = 2, N_EXPERTS = 4, D_EXPERT = 256;
#else
constexpr int D_MODEL = 1024, BATCH = 4, SEQ = 4096, GRID_W = 64, CTX_LEN = 256, LRU_BLOCKS = 8, N_EXPERTS = 16, D_EXPERT = 1408;
#endif
constexpr int ROWS = SEQ / GRID_W;
constexpr int D_LRU = D_MODEL / 2, LRU_BLOCK = 64;
constexpr int D_RWKV = D_MODEL / 2, HEADS = D_RWKV / 64;
constexpr int D_RWKV_IN = 3 * D_RWKV + 128 + 128 + 128;
constexpr int D_IN = 2 * D_LRU + D_RWKV_IN;
constexpr int D_MIX = D_LRU + D_RWKV;
constexpr int CAP = 2 * SEQ / N_EXPERTS;
constexpr int MLAT = BATCH * SEQ, MCTX = BATCH * CTX_LEN, MTOT = MLAT + MCTX;
constexpr int NMOD = BATCH + 1;
constexpr int RW0 = 2 * D_LRU;
constexpr float ALPHA_F = 1.189207115002721f;
constexpr float LN_EPS = 1e-5f, GN_EPS = 64e-5f, RMS_EPS = 1e-6f;
static_assert(LRU_BLOCKS * LRU_BLOCK == D_LRU, "lru blocks");
static_assert(CAP % 128 == 0 && D_IN % 128 == 0 && D_EXPERT % 64 == 0 && D_MODEL % 128 == 0 && MTOT % 128 == 0 && D_MIX % 64 == 0, "tile divisibility");

typedef unsigned short bf16_t;
typedef short bf16x8 __attribute__((ext_vector_type(8)));
typedef float f32x4 __attribute__((ext_vector_type(4)));
typedef unsigned u32x4 __attribute__((ext_vector_type(4)));
typedef float f32x2_e __attribute__((ext_vector_type(2)));
struct alignas(16) F4 { float x, y, z, w; };
typedef unsigned U2 __attribute__((ext_vector_type(2)));
struct alignas(16) U4 { unsigned x, y, z, w; };

#ifdef HOST_EMU
#define MFMA16(a, b, c) emu_mfma_16x16x32_bf16(a, b, c)
#define MFMAF32(a, b, c) emu_mfma_16x16x4_f32(a, b, c)
#else
#define MFMA16(a, b, c) __builtin_amdgcn_mfma_f32_16x16x32_bf16(a, b, c, 0, 0, 0)
#define MFMAF32(a, b, c) __builtin_amdgcn_mfma_f32_16x16x4f32(a, b, c, 0, 0, 0)
#endif

__device__ __forceinline__ unsigned fbits(float f) { return __builtin_bit_cast(unsigned, f); }
__device__ __forceinline__ float bitsf(unsigned u) { return __builtin_bit_cast(float, u); }
__device__ __forceinline__ bf16_t f2bf(float f) { unsigned u = fbits(f); u += 0x7FFFu + ((u >> 16) & 1u); return (bf16_t)(u >> 16); }
__device__ __forceinline__ float bf2f(bf16_t h) { return bitsf(((unsigned)h) << 16); }
#ifdef HOST_EMU
__device__ __forceinline__ unsigned pk2(float lo, float hi) { return (unsigned)f2bf(lo) | ((unsigned)f2bf(hi) << 16); }
#else
typedef float f32x2_t __attribute__((ext_vector_type(2)));
typedef __bf16 bf16x2_t __attribute__((ext_vector_type(2)));
__device__ __forceinline__ unsigned pk2(float lo, float hi) { return __builtin_bit_cast(unsigned, __builtin_convertvector(f32x2_t{lo, hi}, bf16x2_t)); }
#endif
__device__ __forceinline__ float sigmoidf_(float x) { return 1.0f / (1.0f + expf(-x)); }
__device__ __forceinline__ float softplusf_(float x) { return fmaxf(x, 0.0f) + log1pf(expf(-fabsf(x))); }
#ifdef HOST_EMU
#define FEXP(x) expf(x)
#else
#define FEXP(x) __expf(x)
#endif
#ifdef HOST_EMU
__device__ __forceinline__ float frcp(float x) { return 1.0f / x; }
__device__ __forceinline__ float frsq(float x) { return 1.0f / sqrtf(x); }
__device__ __forceinline__ float fsqrt(float x) { return sqrtf(x); }
#else
__device__ __forceinline__ float frcp(float x) { return __builtin_amdgcn_rcpf(x); }
__device__ __forceinline__ float frsq(float x) { return __builtin_amdgcn_rsqf(x); }
__device__ __forceinline__ float fsqrt(float x) { return __builtin_amdgcn_sqrtf(x); }
#endif
__device__ __forceinline__ float fsigm(float x) { return frcp(1.0f + FEXP(-x)); }
__device__ __forceinline__ float siluf_(float x) { return x * fsigm(x); }
__device__ __forceinline__ float geluf_(float x) { return x * fsigm(1.5957691216057308f * (x + 0.044715f * x * x * x)); }
__device__ __forceinline__ int opaque_tid() {
    int t = threadIdx.x;
#ifndef HOST_EMU
    asm volatile("" : "+v"(t));
#endif
    return t;
}
__device__ __forceinline__ float wave_sum(float v) {
#pragma unroll
    for (int o = 1; o < 64; o <<= 1) v += __shfl_xor(v, o);
    return v;
}

constexpr size_t al256(size_t x) { return (x + 255) & ~(size_t)255; }
constexpr int NLCH = BATCH * (SEQ / 64), NCCH = BATCH * (CTX_LEN / 64), NCH = NLCH + NCCH;
constexpr size_t WS_CTRL = 0;
constexpr size_t WS_MOD = 65536;
constexpr size_t WS_STATS = al256(WS_MOD + (size_t)NMOD * 6 * D_MODEL * 4);
constexpr size_t WS_SUMA = al256(WS_STATS + (size_t)MTOT * 2 * 4);
constexpr size_t WS_SUMH = al256(WS_SUMA + (size_t)2 * NCH * D_LRU * 4);
constexpr size_t WS_CARRY = al256(WS_SUMH + (size_t)2 * NCH * D_LRU * 4);
constexpr size_t WS_SSQP = al256(WS_CARRY + (size_t)2 * NLCH * D_LRU * 4);
constexpr size_t WS_RINV = al256(WS_SSQP + (size_t)MLAT * LRU_BLOCKS * 4);
constexpr size_t WS_BON = al256(WS_RINV + (size_t)MLAT * 4);
constexpr size_t WS_AFF = al256(WS_BON + (size_t)2 * MLAT * HEADS * 4 + 4096 * 64);
constexpr size_t WS_IDX = al256(WS_AFF + (size_t)MLAT * N_EXPERTS * 4);
constexpr size_t WS_GATE = al256(WS_IDX + (size_t)BATCH * N_EXPERTS * CAP * 4);
constexpr size_t WS_SLOT = al256(WS_GATE + (size_t)BATCH * N_EXPERTS * CAP * 4);
constexpr size_t WS_WBIN = al256(WS_SLOT + (size_t)MLAT * N_EXPERTS * 4);
constexpr size_t WS_WBOUT = al256(WS_WBIN + (size_t)D_IN * D_MODEL * 2);
constexpr size_t WS_LORA = al256(WS_WBOUT + (size_t)D_MODEL * D_MIX * 2);
constexpr size_t WS_R1 = al256(WS_LORA + (size_t)2 * 2 * HEADS * 64 * 64 * 2);
constexpr size_t R1_BYTES = (size_t)MTOT * D_IN * 2 > (size_t)MLAT * D_MODEL * 4 ? ((size_t)MTOT * D_IN * 2 > (size_t)BATCH * N_EXPERTS * CAP * D_EXPERT * 2 ? (size_t)MTOT * D_IN * 2 : (size_t)BATCH * N_EXPERTS * CAP * D_EXPERT * 2)
                                                                                  : ((size_t)MLAT * D_MODEL * 4 > (size_t)BATCH * N_EXPERTS * CAP * D_EXPERT * 2 ? (size_t)MLAT * D_MODEL * 4 : (size_t)BATCH * N_EXPERTS * CAP * D_EXPERT * 2);
constexpr size_t WS_R3 = al256(WS_R1 + R1_BYTES);
constexpr int RC = 32;
constexpr int NCC = CTX_LEN / RC, NLC = SEQ / RC, NCK = NCC + NLC, NCHAIN = BATCH * HEADS * 2;
constexpr size_t CH_PM = 0, CH_SA = 8192, CH_QT = 16384, CH_Y0 = 20480, CH_BYTES = 24576;
constexpr size_t WS_CH = al256(WS_R3 + (size_t)MTOT * D_MODEL * 2);
constexpr size_t CH_TOTAL = (size_t)NCHAIN * NCK * CH_BYTES;
constexpr size_t WS_R5 = WS_CH;
constexpr size_t WS_LA = al256(WS_R5 + (size_t)MLAT * D_MODEL * 4);
constexpr size_t WS_R6 = WS_LA, WS_R2 = WS_LA;
constexpr size_t WEXP_BYTES = (size_t)D_MODEL * D_EXPERT * 2;
constexpr size_t WS_WG = al256(WS_LA + (size_t)MLAT * D_MODEL * 2);
constexpr size_t WS_WU = WS_WG + (size_t)N_EXPERTS * WEXP_BYTES;
constexpr int NE_R3 = ((size_t)MTOT * D_MODEL * 2 / WEXP_BYTES) < (size_t)N_EXPERTS ? (int)((size_t)MTOT * D_MODEL * 2 / WEXP_BYTES) : N_EXPERTS;
constexpr size_t WS_WD2 = WS_WU + (size_t)N_EXPERTS * WEXP_BYTES;
constexpr size_t WS_LATE_END = al256(WS_WD2 + (size_t)(N_EXPERTS - NE_R3) * WEXP_BYTES);
static_assert(WS_LA + (size_t)BATCH * N_EXPERTS * CAP * D_MODEL * 2 <= WS_WD2, "YS must not reach the w_down copies");
constexpr size_t WS_END = (WS_CH + CH_TOTAL > WS_LATE_END) ? al256(WS_CH + CH_TOTAL) : WS_LATE_END;
constexpr size_t WS_RBON = WS_BON;
static_assert((size_t)NCHAIN * NCK * RC * 4 <= (size_t)2 * MLAT * HEADS * 4 + 4096 * 64, "bonus buffer");

struct Params {
    const float *x, *c, *ctx, *c_ctx, *ln_in_g, *ln_in_b, *w_mod, *b_mod, *w_in, *lru_conv_w, *lru_conv_b, *lru_wa, *lru_ba, *lru_wx, *lru_bx, *lru_lam, *lru_norm_g,
        *mu_prev, *mu_next, *w0, *w2, *a0, *a2, *g2, *k_k, *k_a, *r_k, *gn_g, *gn_b, *w_out, *ln1_g, *ln1_b, *w_router, *w_gate, *w_up, *w_down, *ln2_g, *ln2_b;
    float* out;
    unsigned char* ws;
};
#define WSP(T, off) ((T*)(p.ws + (off)))
__device__ __forceinline__ size_t wdown_off(int e) { return e < NE_R3 ? WS_R3 + (size_t)e * WEXP_BYTES : WS_WD2 + (size_t)(e - NE_R3) * WEXP_BYTES; }

constexpr int SMEM_BYTES = 76 * 1024;

__device__ __forceinline__ f32x4 ld4(const float* p) { return *(const f32x4*)p; }
__device__ __forceinline__ f32x4 ldb4(const bf16_t* p) { const U2 u = *(const U2*)p; return f32x4{bitsf(u.x << 16), bitsf(u.x & 0xFFFF0000u), bitsf(u.y << 16), bitsf(u.y & 0xFFFF0000u)}; }
__device__ __forceinline__ float hsum4(f32x4 v) { return (v[0] + v[1]) + (v[2] + v[3]); }
__device__ __forceinline__ U2 pack4(f32x4 v) { U2 o; o.x = pk2(v[0], v[1]); o.y = pk2(v[2], v[3]); return o; }
__device__ __forceinline__ void convert_transpose(const float* src, bf16_t* dst, int K, int N, int t0, int t1, int tstride, char* smem) {
    float* T = (float*)smem;
    const int tid = opaque_tid(), r = tid >> 4, c4 = (tid & 15) * 4, ntn = N / 64;
    f32x4 v[4];
    if (t0 < t1) { const int kt = t0 / ntn, nt = t0 % ntn;
#pragma unroll
        for (int j = 0; j < 4; ++j) v[j] = ld4(src + (size_t)(kt * 64 + r + 16 * j) * N + nt * 64 + c4); }
    for (int t = t0; t < t1; t += tstride) {
        const int kt = t / ntn, nt = t % ntn;
        __syncthreads();
#pragma unroll
        for (int j = 0; j < 4; ++j) { float* d = T + (r + 16 * j) * 65 + c4; d[0] = v[j][0]; d[1] = v[j][1]; d[2] = v[j][2]; d[3] = v[j][3]; }
        __syncthreads();
        if (t + tstride < t1) { const int kt2 = (t + tstride) / ntn, nt2 = (t + tstride) % ntn;
#pragma unroll
            for (int j = 0; j < 4; ++j) v[j] = ld4(src + (size_t)(kt2 * 64 + r + 16 * j) * N + nt2 * 64 + c4); }
        const int n = tid >> 2, kc = (tid & 3) * 16;
        u32x4 o0, o1;
#pragma unroll
        for (int i = 0; i < 4; ++i) { o0[i] = pk2(T[(kc + 2 * i) * 65 + n], T[(kc + 2 * i + 1) * 65 + n]); o1[i] = pk2(T[(kc + 8 + 2 * i) * 65 + n], T[(kc + 9 + 2 * i) * 65 + n]); }
        bf16_t* d = dst + (size_t)(nt * 64 + n) * K + kt * 64 + kc;
        *(u32x4*)d = o0; *(u32x4*)(d + 8) = o1;
    }
    __syncthreads();
}
__device__ void convert_experts(const Params& p, int vb, int nvb, char* smem, int first, int last) {
    constexpr int TPM = (D_MODEL / 64) * (D_EXPERT / 64);
    int m = 0;
    for (int e = 0; e < N_EXPERTS; ++e)
        for (int which = first; which < last; ++which, ++m) {
            const float* src = (which == 0 ? p.w_gate : which == 1 ? p.w_up : p.w_down) + (size_t)e * D_MODEL * D_EXPERT;
            bf16_t* dst = which == 0 ? WSP(bf16_t, WS_WG + (size_t)e * WEXP_BYTES) : which == 1 ? WSP(bf16_t, WS_WU + (size_t)e * WEXP_BYTES) : WSP(bf16_t, wdown_off(e));
            const int K = which == 2 ? D_EXPERT : D_MODEL, N = which == 2 ? D_MODEL : D_EXPERT;
            const int start = ((vb - (m * TPM) % nvb) % nvb + nvb) % nvb;
            convert_transpose(src, dst, K, N, start, TPM, nvb, smem);
        }
}

__device__ __forceinline__ void phaseA(const Params& p, int bid, int nblk, char* smem) {
    float* sc = (float*)smem;
    float* red = sc + NMOD * D_MODEL;
    const int tid = opaque_tid();
    constexpr int NA = 6 * D_MODEL / 16;
    {
        const bool spare = nblk > NA + 32;
        const int vb = spare ? bid - NA : bid, nvb = spare ? nblk - NA : nblk;
        if (!spare || bid >= NA) {
            constexpr int T1 = (D_MODEL / 64) * (D_IN / 64), T2 = (D_MIX / 64) * (D_MODEL / 64);
            convert_transpose(p.w_in, WSP(bf16_t, WS_WBIN), D_MODEL, D_IN, vb, T1, nvb, smem);
            convert_transpose(p.w_out, WSP(bf16_t, WS_WBOUT), D_MIX, D_MODEL, ((vb - T1 % nvb) % nvb + nvb) % nvb, T2, nvb, smem);
            for (int idx = vb * 256 + tid; idx < 2 * 2 * HEADS * 64 * 64; idx += nvb * 256) {
                const int i = idx & 63, j = (idx >> 6) & 63, hh = (idx >> 12) % HEADS, which = (idx >> 12) / HEADS % 2, dd = (idx >> 12) / HEADS / 2;
                WSP(bf16_t, WS_LORA)[idx] = f2bf((which ? p.a2 : p.w2)[((size_t)dd * 64 + i) * D_RWKV + hh * 64 + j]);
            }
        }
        if (spare && bid >= NA) return;
    }
    if (bid >= NA) return;
    __syncthreads();
    for (int i = tid; i < NMOD * D_MODEL; i += 256) {
        const int r = i / D_MODEL, k = i % D_MODEL;
        const float v = (r < BATCH) ? p.c[r * D_MODEL + k] : p.c_ctx[k];
        sc[i] = siluf_(v);
    }
    __syncthreads();
    float* MOD = WSP(float, WS_MOD);
    const int col = tid & 15, kg = tid >> 4;
    constexpr int KPT = D_MODEL / 16;
    for (int cb = bid; cb < 6 * D_MODEL / 16; cb += nblk) {
        const int n = cb * 16 + col;
        float acc[NMOD];
#pragma unroll
        for (int r = 0; r < NMOD; ++r) acc[r] = 0.f;
        const float* wp = p.w_mod + (size_t)(kg * KPT) * (6 * D_MODEL) + n;
#pragma unroll 16
        for (int kk = 0; kk < KPT; ++kk) {
            const float w = wp[(size_t)kk * (6 * D_MODEL)];
#pragma unroll
            for (int r = 0; r < NMOD; ++r) acc[r] += sc[r * D_MODEL + kg * KPT + kk] * w;
        }
#pragma unroll
        for (int r = 0; r < NMOD; ++r) red[(kg * NMOD + r) * 16 + col] = acc[r];
        __syncthreads();
        if (tid < NMOD * 16) {
            const int r = tid >> 4, c2 = tid & 15;
            float s2 = p.b_mod[cb * 16 + c2];
#pragma unroll
            for (int g = 0; g < 16; ++g) s2 += red[(g * NMOD + r) * 16 + c2];
            MOD[(size_t)r * 6 * D_MODEL + cb * 16 + c2] = s2;
        }
        __syncthreads();
    }
}

constexpr int NV = D_MODEL / 256;
__device__ __forceinline__ void phaseB(const Params& p, int bid, int nblk, char* smem) {
    const int tid_ = opaque_tid(), lane = tid_ & 63, wave = tid_ >> 6;
    const float* MOD = WSP(float, WS_MOD);
    float* STATS = WSP(float, WS_STATS);
    bf16_t* U = WSP(bf16_t, WS_R3);
    auto rowptr = [&](int row) { return (row < MLAT) ? p.x + (size_t)row * D_MODEL : p.ctx + (size_t)(row - MLAT) * D_MODEL; };
    int row = bid * 4 + wave;
    f32x4 n0 = f32x4{0.f, 0.f, 0.f, 0.f}, n1 = n0, n2 = n0, n3 = n0;
    if (row < MTOT) { const float* xr = rowptr(row); n0 = ld4(xr + lane * 4); if (NV > 1) n1 = ld4(xr + 256 + lane * 4); if (NV > 2) { n2 = ld4(xr + 512 + lane * 4); n3 = ld4(xr + 768 + lane * 4); } }
    for (; row < MTOT; row += nblk * 4) {
        const int mr = (row < MLAT) ? row / SEQ : BATCH;
        const float* md = MOD + (size_t)mr * 6 * D_MODEL;
        f32x4 v0 = n0, v1 = n1, v2 = n2, v3 = n3;
        const int nrow = row + nblk * 4;
        if (nrow < MTOT) { const float* xr = rowptr(nrow); n0 = ld4(xr + lane * 4); if (NV > 1) n1 = ld4(xr + 256 + lane * 4); if (NV > 2) { n2 = ld4(xr + 512 + lane * 4); n3 = ld4(xr + 768 + lane * 4); } }
        float s = hsum4(v0);
        if (NV > 1) s += hsum4(v1);
        if (NV > 2) s += hsum4(v2) + hsum4(v3);
        const float mu = wave_sum(s) * (1.0f / D_MODEL);
        v0 -= mu; float s2 = hsum4(v0 * v0);
        if (NV > 1) { v1 -= mu; s2 += hsum4(v1 * v1); }
        if (NV > 2) { v2 -= mu; v3 -= mu; s2 += hsum4(v2 * v2) + hsum4(v3 * v3); }
        const float rstd = frsq(wave_sum(s2) * (1.0f / D_MODEL) + LN_EPS);
        if (lane == 0) { STATS[row * 2] = mu; STATS[row * 2 + 1] = rstd; }
#pragma unroll
        for (int j = 0; j < NV; ++j) {
            const int k = j * 256 + lane * 4;
            const f32x4 vv = (j == 0) ? v0 : (j == 1) ? v1 : (j == 2) ? v2 : v3;
            const f32x4 h = vv * rstd * ld4(p.ln_in_g + k) + ld4(p.ln_in_b + k);
            *(U2*)(U + (size_t)row * D_MODEL + k) = pack4(h * (1.0f + ld4(md + D_MODEL + k)) + ld4(md + k));
        }
    }
}

constexpr int LDK = 64;
template <int MI, bool DUAL, class Epi>
__device__ __forceinline__ void gemm_tile(char* smem, const bf16_t* A, int lda, const int* rowidx, int m0, const bf16_t* Bt0, const bf16_t* Bt1, int ldb, int n0, int K, Epi epi, const float* rowscale = nullptr, int kscale = 0) {
    constexpr int BM = 32 * MI;
    bf16_t* As = (bf16_t*)smem;
    bf16_t* Bs = As + BM * LDK;
    int tid = threadIdx.x;
#ifndef HOST_EMU
    asm volatile("" : "+v"(tid));
#endif
    const int lane = tid & 63, wave = tid >> 6, wr = wave >> 1, wc = wave & 1, l15 = lane & 15, q = lane >> 4;
    const int ch = tid & 7, r0 = tid >> 3;
    unsigned aoff[MI], boff[4];
#pragma unroll
    for (int j = 0; j < MI; ++j) { const int r = m0 + r0 + 32 * j; aoff[j] = (unsigned)(rowidx ? rowidx[r] : r) * (unsigned)lda + ch * 8; }
#pragma unroll
    for (int j = 0; j < 4; ++j) boff[j] = (unsigned)(n0 + (DUAL ? (j >> 1) * 32 + r0 : r0 + 32 * j)) * (unsigned)ldb + ch * 8;
    const int wofs = r0 * LDK + ((ch ^ (r0 & 7)) * 8);
    u32x4 ar[MI], br[4];
    f32x4 acc[MI][4];
#pragma unroll
    for (int i = 0; i < MI; ++i)
#pragma unroll
        for (int j = 0; j < 4; ++j) acc[i][j] = f32x4{0.f, 0.f, 0.f, 0.f};
    const int nk = K / 64;
#pragma unroll
    for (int j = 0; j < MI; ++j) ar[j] = *(const u32x4*)(A + aoff[j]);
#pragma unroll
    for (int j = 0; j < 4; ++j) br[j] = *(const u32x4*)(((DUAL && (j & 1)) ? Bt1 : Bt0) + boff[j]);
    for (int kt = 0; kt < nk; ++kt) {
        __syncthreads();
#pragma unroll
        for (int j = 0; j < MI; ++j) *(u32x4*)(As + wofs + 32 * j * LDK) = ar[j];
#pragma unroll
        for (int j = 0; j < 4; ++j) *(u32x4*)(Bs + wofs + 32 * j * LDK) = br[j];
        __syncthreads();
        if (kt + 1 < nk) {
            const int ko = (kt + 1) * 64;
#pragma unroll
            for (int j = 0; j < MI; ++j) ar[j] = *(const u32x4*)(A + aoff[j] + ko);
#pragma unroll
            for (int j = 0; j < 4; ++j) br[j] = *(const u32x4*)(((DUAL && (j & 1)) ? Bt1 : Bt0) + boff[j] + ko);
        }
#pragma unroll
        for (int ks = 0; ks < 2; ++ks) {
            const int cofs = ((ks * 4 + q) ^ (l15 & 7)) * 8;
            bf16x8 bfr[4];
#pragma unroll
            for (int ni = 0; ni < 4; ++ni) bfr[ni] = *(const bf16x8*)(Bs + (wc * 64 + ni * 16 + l15) * LDK + cofs);
#pragma unroll
            for (int mi = 0; mi < MI; ++mi) {
                const bf16x8 af = *(const bf16x8*)(As + (wr * (16 * MI) + mi * 16 + l15) * LDK + cofs);
#pragma unroll
                for (int ni = 0; ni < 4; ++ni) acc[mi][ni] = MFMA16(bfr[ni], af, acc[mi][ni]);
            }
        }
        if (rowscale && kt + 1 == kscale) {
#pragma unroll
            for (int mi = 0; mi < MI; ++mi) {
                const float rs = rowscale[m0 + wr * (16 * MI) + mi * 16 + l15];
#pragma unroll
                for (int ni = 0; ni < 4; ++ni) acc[mi][ni] *= rs;
            }
        }
    }
#pragma unroll
    for (int mi = 0; mi < MI; ++mi) {
        const int ml = wr * (16 * MI) + mi * 16 + l15;
        if (DUAL) {
#pragma unroll
            for (int ni = 0; ni < 2; ++ni) epi(ml, wc * 32 + ni * 16 + q * 4, acc[mi][ni], acc[mi][ni + 2]);
        } else {
#pragma unroll
            for (int ni = 0; ni < 4; ++ni) epi(ml, wc * 64 + ni * 16 + q * 4, acc[mi][ni], acc[mi][ni]);
        }
    }
    __syncthreads();
}

__device__ __forceinline__ int xcd_vbid(int bid, int nblk) { return (nblk % 8 == 0) ? (bid % 8) * (nblk / 8) + bid / 8 : bid; }
constexpr int MI_C = (MTOT % 256 == 0) ? 8 : 4, MI_J = (MLAT % 256 == 0) ? 8 : 4, MI_E = (CAP % 256 == 0) ? 8 : 4;
__device__ __forceinline__ void phaseC(const Params& p, int bid, int nblk, char* smem) {
    const bf16_t* U = WSP(bf16_t, WS_R3); const bf16_t* WB = WSP(bf16_t, WS_WBIN);
    bf16_t* P = WSP(bf16_t, WS_R1);
    constexpr int BM = 32 * MI_C, NTN = D_IN / 128, NTM = MTOT / BM;
    constexpr int GM = (NTM % 8 == 0) ? 8 : (NTM % 4 == 0) ? 4 : 1;
    for (int it = xcd_vbid(bid, nblk); it < NTN * NTM; it += nblk) {
        const int mg = it / (GM * NTN), r = it % (GM * NTN), nt = r / GM, mt = mg * GM + (r % GM);
        gemm_tile<MI_C, false>(smem, U, D_MODEL, nullptr, mt * BM, WB, nullptr, D_MODEL, nt * 128, D_MODEL, [&](int ml, int nl, f32x4 v, f32x4) {
            *(U2*)(P + (size_t)(mt * BM + ml) * D_IN + nt * 128 + nl) = pack4(v);
        });
    }
}


template <int NYT, int KS>
__device__ __forceinline__ void mmT(f32x4* acc, const bf16_t* X, int ldx, int xs, const bf16_t* Y, int ldy, int lane) {
#pragma unroll
    for (int ks = 0; ks < KS; ++ks) {
        const bf16x8 xf = *(const bf16x8*)(X + (xs * 16 + (lane & 15)) * ldx + ks * 32 + 8 * (lane >> 4));
#pragma unroll
        for (int nb = 0; nb < NYT; ++nb) {
            const bf16x8 yf = *(const bf16x8*)(Y + (nb * 16 + (lane & 15)) * ldy + ks * 32 + 8 * (lane >> 4));
            acc[nb] = MFMA16(xf, yf, acc[nb]);
        }
    }
}

struct SeqChunk { int base_row; int t0; int len; };
__device__ __forceinline__ SeqChunk lru_chunk(int cg) {
    SeqChunk s;
    if (cg < NLCH) { const int b = cg / (SEQ / 64), ck = cg % (SEQ / 64); s.base_row = b * SEQ; s.t0 = ck * 64; s.len = SEQ; }
    else { const int c2 = cg - NLCH; const int b = c2 / (CTX_LEN / 64), ck = c2 % (CTX_LEN / 64); s.base_row = MLAT + b * CTX_LEN; s.t0 = ck * 64; s.len = CTX_LEN; }
    return s;
}
constexpr int L_XIN = 0;
constexpr int L_GT = 8704;
constexpr int L_XB = L_GT + 9216;
constexpr int L_WT = L_XB + 9216;
constexpr int L_CP = L_WT + 36864;
constexpr int L_END = L_CP + 4096;
static_assert(L_END <= SMEM_BYTES, "lru lds");
__device__ __forceinline__ void lru_load_w(const Params& p, char* smem, int cb) {
    bf16_t* WT = (bf16_t*)(smem + L_WT);
    const int tid = opaque_tid();
    for (int idx = tid; idx < 4 * 64 * 16; idx += 256) {
        const int m = idx >> 10, i = (idx >> 4) & 63, j4 = (idx & 15) * 4, d = m >> 1;
        const f32x4 w = ld4(((m & 1) ? p.lru_wx : p.lru_wa) + ((size_t)(d * LRU_BLOCKS + cb) * 64 + i) * 64 + j4);
        bf16_t* dst = WT + (m * 64 + j4) * 72 + i;
        dst[0] = f2bf(w[0]); dst[72] = f2bf(w[1]); dst[144] = f2bf(w[2]); dst[216] = f2bf(w[3]);
    }
}
struct LruOut { float a[2][4][4], b[2][4][4]; };
struct LruConst { float ba[2][4], bx[2][4], sp8[2][4], gn[4], cw[4], cb0; };
__device__ __forceinline__ void lru_consts(const Params& p, int cb, LruConst& K) {
    const int l15 = threadIdx.x & 15, c = threadIdx.x & 63, ch = cb * 64 + c;
#pragma unroll
    for (int d = 0; d < 2; ++d)
#pragma unroll
        for (int nb = 0; nb < 4; ++nb) { const int cc = d * D_LRU + cb * 64 + nb * 16 + l15; K.ba[d][nb] = p.lru_ba[cc]; K.bx[d][nb] = p.lru_bx[cc]; K.sp8[d][nb] = -8.0f * softplusf_(-p.lru_lam[cc]); }
#pragma unroll
    for (int nb = 0; nb < 4; ++nb) K.gn[nb] = p.lru_norm_g[cb * 64 + nb * 16 + l15];
#pragma unroll
    for (int j = 0; j < 4; ++j) K.cw[j] = p.lru_conv_w[j * D_LRU + ch];
    K.cb0 = p.lru_conv_b[ch];
}
struct LruStage { u32x4 x[3]; u32x4 g[2]; };
template <bool FINAL>
__device__ __forceinline__ void lru_stage_load(const Params& p, int cg, int cb, LruStage& S) {
    const bf16_t* P = WSP(bf16_t, WS_R1);
    const SeqChunk sc = lru_chunk(cg);
    const int tid = opaque_tid();
#pragma unroll
    for (int k = 0; k < 3; ++k) {
        const int idx = tid + 256 * k, tt = idx >> 3, c8 = (idx & 7) * 8, t = sc.t0 - 1 + tt;
        S.x[k] = u32x4{0u, 0u, 0u, 0u};
        if (idx < 67 * 8 && t >= 0 && t < sc.len) S.x[k] = *(const u32x4*)(P + (size_t)(sc.base_row + t) * D_IN + cb * 64 + c8);
    }
    if (FINAL) {
#pragma unroll
        for (int k = 0; k < 2; ++k) { const int idx = tid + 256 * k, tt = idx >> 3, c8 = (idx & 7) * 8; S.g[k] = *(const u32x4*)(P + (size_t)(sc.base_row + sc.t0 + tt) * D_IN + D_LRU + cb * 64 + c8); }
    }
}
template <bool FINAL>
__device__ __forceinline__ void lru_item(const Params& p, char* smem, int cg, int cb, const LruConst& K, LruStage& S, int cg_next) {
    const bf16_t* P = WSP(bf16_t, WS_R1);
    bf16_t* XIN = (bf16_t*)(smem + L_XIN); bf16_t* GT = (bf16_t*)(smem + L_GT); bf16_t* XB = (bf16_t*)(smem + L_XB); const bf16_t* WT = (const bf16_t*)(smem + L_WT);
    float* CP = (float*)(smem + L_CP);
    const int tid = opaque_tid(), lane = tid & 63, wave = tid >> 6, q = lane >> 4, l15 = lane & 15;
    const SeqChunk sc = lru_chunk(cg);
    __syncthreads();
#pragma unroll
    for (int k = 0; k < 3; ++k) { const int idx = tid + 256 * k, tt = idx >> 3, c8 = (idx & 7) * 8; if (idx < 67 * 8) *(u32x4*)(XIN + tt * 64 + c8) = S.x[k]; }
    if (FINAL) {
#pragma unroll
        for (int k = 0; k < 2; ++k) { const int idx = tid + 256 * k, tt = idx >> 3, c8 = (idx & 7) * 8; *(u32x4*)(GT + tt * 72 + c8) = S.g[k]; }
    }
    if (cg_next >= 0) lru_stage_load<FINAL>(p, cg_next, cb, S);
    __syncthreads();
    {
        const int c = tid & 63;
#pragma unroll 4
        for (int tt = tid >> 6; tt < 64; tt += 4)
            XB[tt * 72 + c] = f2bf(K.cb0 + bf2f(XIN[tt * 64 + c]) * K.cw[0] + bf2f(XIN[(tt + 1) * 64 + c]) * K.cw[1] + bf2f(XIN[(tt + 2) * 64 + c]) * K.cw[2] + bf2f(XIN[(tt + 3) * 64 + c]) * K.cw[3]);
    }
    __syncthreads();
    float hs[4][4];
    float av[4][4], bv[4][4];
#pragma unroll
    for (int d = 0; d < 2; ++d) {
        f32x4 ga[4], gx[4];
#pragma unroll
        for (int nb = 0; nb < 4; ++nb) { ga[nb] = f32x4{0.f, 0.f, 0.f, 0.f}; gx[nb] = f32x4{0.f, 0.f, 0.f, 0.f}; }
        mmT<4, 2>(ga, XB, 72, wave, WT + (2 * d) * 64 * 72, 72, lane);
        mmT<4, 2>(gx, XB, 72, wave, WT + (2 * d + 1) * 64 * 72, 72, lane);
        float cA[4], cH[4];
#pragma unroll
        for (int nb = 0; nb < 4; ++nb) {
            const float ba = K.ba[d][nb], bx = K.bx[d][nb], sp8 = K.sp8[d][nb];
#pragma unroll
            for (int r = 0; r < 4; ++r) {
                const float rg = fsigm(ga[nb][r] + ba), ig = fsigm(gx[nb][r] + bx);
                const float a = FEXP(sp8 * rg);
                const float xv = bf2f(XB[(wave * 16 + q * 4 + r) * 72 + nb * 16 + l15]);
                av[nb][r] = a; bv[nb][r] = fsqrt(fmaxf(1.0f - a * a, 0.f)) * ig * xv;
            }
            float A, H;
            if (d == 0) { A = av[nb][0]; H = bv[nb][0];
#pragma unroll
                for (int r = 1; r < 4; ++r) { H = H * av[nb][r] + bv[nb][r]; A *= av[nb][r]; } }
            else { A = av[nb][3]; H = bv[nb][3];
#pragma unroll
                for (int r = 2; r >= 0; --r) { H = H * av[nb][r] + bv[nb][r]; A *= av[nb][r]; } }
#pragma unroll
            for (int st = 1; st <= 2; st <<= 1) {
                const float pA = d == 0 ? __shfl_up(A, 16 * st) : __shfl_down(A, 16 * st), pH = d == 0 ? __shfl_up(H, 16 * st) : __shfl_down(H, 16 * st);
                const bool has = d == 0 ? (q >= st) : (q + st <= 3);
                if (has) { H = pH * A + H; A = pA * A; }
            }
            cA[nb] = A; cH[nb] = H;
            const bool last = d == 0 ? (q == 3) : (q == 0);
            if (last) { CP[((d * 4 + wave) * 64 + nb * 16 + l15) * 2] = A; CP[((d * 4 + wave) * 64 + nb * 16 + l15) * 2 + 1] = H; }
        }
        __syncthreads();
        if (!FINAL) {
            if (wave == 0 && q == 0) {
#pragma unroll
                for (int nb = 0; nb < 4; ++nb) {
                    const int c = nb * 16 + l15;
                    float A = 1.f, H = 0.f;
#pragma unroll
                    for (int w = 0; w < 4; ++w) { const int ww = d == 0 ? w : 3 - w; const float wa = CP[((d * 4 + ww) * 64 + c) * 2], wh = CP[((d * 4 + ww) * 64 + c) * 2 + 1]; H = H * wa + wh; A *= wa; }
                    WSP(float, WS_SUMA)[((size_t)d * NCH + cg) * D_LRU + cb * 64 + c] = A;
                    WSP(float, WS_SUMH)[((size_t)d * NCH + cg) * D_LRU + cb * 64 + c] = H;
                }
            }
        } else {
#pragma unroll
            for (int nb = 0; nb < 4; ++nb) {
                const int c = nb * 16 + l15;
                float h = WSP(float, WS_CARRY)[((size_t)d * NLCH + cg) * D_LRU + cb * 64 + c];
#pragma unroll
                for (int w = 0; w < 3; ++w) { const int ww = d == 0 ? w : 3 - w; const bool use = d == 0 ? (ww < wave) : (ww > wave);
                    if (use) h = h * CP[((d * 4 + ww) * 64 + c) * 2] + CP[((d * 4 + ww) * 64 + c) * 2 + 1]; }
                const float eA = d == 0 ? __shfl_up(cA[nb], 16) : __shfl_down(cA[nb], 16), eH = d == 0 ? __shfl_up(cH[nb], 16) : __shfl_down(cH[nb], 16);
                const bool first = d == 0 ? (q == 0) : (q == 3);
                if (!first) h = h * eA + eH;
                if (d == 0) {
#pragma unroll
                    for (int r = 0; r < 4; ++r) { h = h * av[nb][r] + bv[nb][r]; hs[nb][r] = h; }
                } else {
#pragma unroll
                    for (int r = 3; r >= 0; --r) { h = h * av[nb][r] + bv[nb][r]; hs[nb][r] += h; }
                }
            }
        }
        __syncthreads();
    }
    if (FINAL) {
        float ss[4] = {0.f, 0.f, 0.f, 0.f};
#pragma unroll
        for (int nb = 0; nb < 4; ++nb) {
            const float gn = K.gn[nb];
#pragma unroll
            for (int r = 0; r < 4; ++r) {
                const int tt = wave * 16 + q * 4 + r;
                const float v = hs[nb][r] * geluf_(bf2f(GT[tt * 72 + nb * 16 + l15]));
                ss[r] += v * v;
                XB[tt * 72 + nb * 16 + l15] = f2bf(v * gn);
            }
        }
#pragma unroll
        for (int r = 0; r < 4; ++r) {
#pragma unroll
            for (int o = 1; o < 16; o <<= 1) ss[r] += __shfl_xor(ss[r], o);
            if (l15 == 0) WSP(float, WS_SSQP)[(size_t)(sc.base_row + sc.t0 + wave * 16 + q * 4 + r) * LRU_BLOCKS + cb] = ss[r];
        }
        __syncthreads();
        bf16_t* MIX = WSP(bf16_t, WS_R3);
        for (int idx = tid; idx < 64 * 8; idx += 256) {
            const int tt = idx >> 3, c8 = (idx & 7) * 8;
            *(u32x4*)(MIX + (size_t)(sc.base_row + sc.t0 + tt) * D_MIX + cb * 64 + c8) = *(const u32x4*)(XB + tt * 72 + c8);
        }
    }
}
__device__ __forceinline__ void phaseD(const Params& p, int bid, int nblk, char* smem) {
    int cur = -1; LruConst K; LruStage S;
    for (int it = bid; it < NCH * LRU_BLOCKS; it += nblk) {
        const int cb = it % LRU_BLOCKS, cg = it / LRU_BLOCKS;
        if (cb != cur) { __syncthreads(); lru_load_w(p, smem, cb); lru_consts(p, cb, K); lru_stage_load<false>(p, cg, cb, S); cur = cb; }
        const int itn = it + nblk;
        lru_item<false>(p, smem, cg, cb, K, S, (itn < NCH * LRU_BLOCKS && itn % LRU_BLOCKS == cb) ? itn / LRU_BLOCKS : -1);
        if (itn < NCH * LRU_BLOCKS && itn % LRU_BLOCKS != cb) cur = -1;
    }
}
__device__ __forceinline__ void phaseE(const Params& p, int bid, int nblk, char* smem) {
    const float* SUMA = WSP(float, WS_SUMA); const float* SUMH = WSP(float, WS_SUMH); float* CARRY = WSP(float, WS_CARRY);
    constexpr int NLB = SEQ / 64, NCB = CTX_LEN / 64;
    for (int g = bid * 256 + threadIdx.x; g < BATCH * 2 * D_LRU; g += nblk * 256) {
        const int c = g % D_LRU, d = (g / D_LRU) & 1, b = g / (2 * D_LRU);
        const float* sa = SUMA + (size_t)d * NCH * D_LRU + c; const float* sh = SUMH + (size_t)d * NCH * D_LRU + c;
        float* cr = CARRY + (size_t)d * NLCH * D_LRU + c;
        float h = 0.f;
        if (d == 0) {
            for (int q2 = 0; q2 < NCB; ++q2) { const int gi = NLCH + b * NCB + q2; h = sa[(size_t)gi * D_LRU] * h + sh[(size_t)gi * D_LRU]; }
            for (int q2 = 0; q2 < NLB; ++q2) { const int gi = b * NLB + q2; cr[(size_t)gi * D_LRU] = h; h = sa[(size_t)gi * D_LRU] * h + sh[(size_t)gi * D_LRU]; }
        } else {
            for (int q2 = NCB - 1; q2 >= 0; --q2) { const int gi = NLCH + b * NCB + q2; h = sa[(size_t)gi * D_LRU] * h + sh[(size_t)gi * D_LRU]; }
            for (int q2 = NLB - 1; q2 >= 0; --q2) { const int gi = b * NLB + q2; cr[(size_t)gi * D_LRU] = h; h = sa[(size_t)gi * D_LRU] * h + sh[(size_t)gi * D_LRU]; }
        }
    }
}
__device__ __forceinline__ void phaseF(const Params& p, int bid, int nblk, char* smem) {
    int cur = -1; LruConst K; LruStage S;
    for (int it = bid; it < NLCH * LRU_BLOCKS; it += nblk) {
        const int cb = it % LRU_BLOCKS, cg = it / LRU_BLOCKS;
        if (cb != cur) { __syncthreads(); lru_load_w(p, smem, cb); lru_consts(p, cb, K); lru_stage_load<true>(p, cg, cb, S); cur = cb; }
        const int itn = it + nblk;
        lru_item<true>(p, smem, cg, cb, K, S, (itn < NLCH * LRU_BLOCKS && itn % LRU_BLOCKS == cb) ? itn / LRU_BLOCKS : -1);
        if (itn < NLCH * LRU_BLOCKS && itn % LRU_BLOCKS != cb) cur = -1;
    }
}

__device__ __forceinline__ size_t rwkv_row(int seg, int b, int s) {
    if (seg == 0) return (size_t)(MLAT + b * CTX_LEN + s);
    const int r = s % ROWS, c = s / ROWS;
    return (size_t)(b * SEQ + r * GRID_W + c);
}
__device__ __forceinline__ void chunk_info(int d, int c, int& seg, int& p0, int& len) {
    if (c < NCC) { seg = 0; len = CTX_LEN; p0 = (d == 0 ? c : NCC - 1 - c) * RC; }
    else { const int cc = c - NCC; seg = 1; len = SEQ; p0 = (d == 0 ? cc : NLC - 1 - cc) * RC; }
}
__device__ __forceinline__ void unpack8(const u32x4 v, float* o) {
    o[0] = bitsf(v[0] << 16); o[1] = bitsf(v[0] & 0xFFFF0000u); o[2] = bitsf(v[1] << 16); o[3] = bitsf(v[1] & 0xFFFF0000u);
    o[4] = bitsf(v[2] << 16); o[5] = bitsf(v[2] & 0xFFFF0000u); o[6] = bitsf(v[3] << 16); o[7] = bitsf(v[3] & 0xFFFF0000u);
}
__device__ __forceinline__ void shifted8(const Params& p, const bf16_t* P, int seg, int b, int pos, int len, int ch0, float* o) {
    float z[8], zp[8], zn[8];
    unpack8(*(const u32x4*)(P + rwkv_row(seg, b, pos) * D_IN + RW0 + ch0), z);
    if (pos > 0) unpack8(*(const u32x4*)(P + rwkv_row(seg, b, pos - 1) * D_IN + RW0 + ch0), zp); else { for (int i = 0; i < 8; ++i) zp[i] = 0.f; }
    if (pos < len - 1) unpack8(*(const u32x4*)(P + rwkv_row(seg, b, pos + 1) * D_IN + RW0 + ch0), zn); else { for (int i = 0; i < 8; ++i) zn[i] = 0.f; }
    const f32x4 mp0 = ld4(p.mu_prev + ch0), mp1 = ld4(p.mu_prev + ch0 + 4), mn0 = ld4(p.mu_next + ch0), mn1 = ld4(p.mu_next + ch0 + 4);
#pragma unroll
    for (int i = 0; i < 4; ++i) { o[i] = z[i] + mp0[i] * (zp[i] - z[i]) + mn0[i] * (zn[i] - z[i]); o[4 + i] = z[4 + i] + mp1[i] * (zp[4 + i] - z[4 + i]) + mn1[i] * (zn[4 + i] - z[4 + i]); }
}
constexpr int LT = 72, LJ = 40;
constexpr int R_RF = 0, R_KF = 8192, R_VF = 16384, R_LW = 24576, R_IC = 32768;
constexpr int R_NKA = 0, R_MBR = 2560, R_MKR = 5120;
constexpr int R_XU = 7680;
constexpr int R_IA = R_XU + 8448, R_IB = R_IA + 4608, R_PA = R_IB + 4608, R_PB = R_PA + 4608;
constexpr int R_WA = R_IB, R_U0 = R_WA + 5120;
static_assert(R_U0 + 5120 <= R_PB + 4608 && R_PB + 4608 <= 40960, "rwkv scratch");
constexpr int R_O = 40960;
constexpr int R_AH = R_O, R_BH = R_AH + 4608, R_KH = R_BH + 4608, R_RH = R_KH + 4608;
constexpr int R_VT = R_RH + 4608, R_BHT = R_VT + 5120, R_KHT = R_BHT + 5120;
constexpr int R_GC = R_KHT + 5120, R_TOT = R_GC + 256, R_PS = R_TOT + 1024, R_END = R_PS + 1024;
constexpr int R_TW = R_O, R_TA = R_TW + 4608, R_W2T = R_TA + 4608, R_A2T = R_W2T + 9216;
static_assert(R_A2T + 9216 <= R_END && R_END <= SMEM_BYTES, "rwkv lds");

__device__ __forceinline__ void phaseR1(const Params& p, int bid, int nblk, char* smem) {
    const bf16_t* P = WSP(bf16_t, WS_R1);
    unsigned char* CH = p.ws + WS_CH;
    float* RBON = WSP(float, WS_RBON);
    float* Rf = (float*)(smem + R_RF); float* Kf = (float*)(smem + R_KF); float* Vf = (float*)(smem + R_VF); float* LW = (float*)(smem + R_LW); float* IC = (float*)(smem + R_IC);
    float* IA = (float*)(smem + R_IA); float* IB = (float*)(smem + R_IB); float* PA = (float*)(smem + R_PA); float* PB = (float*)(smem + R_PB); bf16_t* NkaT = (bf16_t*)(smem + R_NKA); bf16_t* MbrT = (bf16_t*)(smem + R_MBR); bf16_t* MkrT = (bf16_t*)(smem + R_MKR);
    float* Xu = (float*)(smem + R_XU); bf16_t* Wa = (bf16_t*)(smem + R_WA); bf16_t* U0 = (bf16_t*)(smem + R_U0);
    bf16_t* Ah = (bf16_t*)(smem + R_AH); bf16_t* Bh = (bf16_t*)(smem + R_BH); bf16_t* Kh = (bf16_t*)(smem + R_KH); bf16_t* Rh = (bf16_t*)(smem + R_RH);
    bf16_t* VT = (bf16_t*)(smem + R_VT); bf16_t* BhT = (bf16_t*)(smem + R_BHT); bf16_t* KhT = (bf16_t*)(smem + R_KHT);
    float* GC = (float*)(smem + R_GC); float* TOT = (float*)(smem + R_TOT); float* PS = (float*)(smem + R_PS);
    bf16_t* TW = (bf16_t*)(smem + R_TW); bf16_t* TA = (bf16_t*)(smem + R_TA); bf16_t* W2T = (bf16_t*)(smem + R_W2T); bf16_t* A2T = (bf16_t*)(smem + R_A2T);
    constexpr int NITEM = NCHAIN * NCK;
    const int per = (NITEM + nblk - 1) / nblk;
    const int it0 = bid * per, it1 = (it0 + per < NITEM) ? it0 + per : NITEM;
    for (int it = it0; it < it1; ++it) {
        const int tid = opaque_tid(), lane = tid & 63, wave = tid >> 6, q = lane >> 4, l15 = lane & 15;
        const int chain = it / NCK, c = it % NCK;
        const int d = chain & 1, h = (chain >> 1) % HEADS, b = chain / (2 * HEADS);
        int seg, p0, len; chunk_info(d, c, seg, p0, len);
        unsigned char* chp = CH + (size_t)it * CH_BYTES;
        const float kkc = p.k_k[h * 64 + lane], kac = p.k_a[h * 64 + lane];
        __syncthreads();
        {
            u32x4 wv[4];
#pragma unroll
            for (int k = 0; k < 4; ++k) {
                const int idx = tid + 256 * k, which = idx >> 9, j = (idx >> 3) & 63, c8 = (idx & 7) * 8;
                wv[k] = *(const u32x4*)(WSP(bf16_t, WS_LORA) + ((size_t)((d * 2 + which) * HEADS + h) * 64 + j) * 64 + c8);
            }
#pragma unroll
            for (int kb = 0; kb < 5; kb += 5) {
            u32x4 zc[5], zp[5], zn[5];
#pragma unroll
            for (int k = 0; k < 5; ++k) if (kb + k < 5) {
                const int idx = tid + 256 * (kb + k), tau = idx / 40, g = idx % 40, grp = g >> 3, j0 = (g & 7) * 8;
                const int pos = p0 + (d ? RC - 1 - tau : tau);
                const int ch0 = (grp < 3) ? grp * D_RWKV + h * 64 + j0 : (grp == 3 ? 3 * D_RWKV + d * 64 + j0 : 3 * D_RWKV + 128 + d * 64 + j0);
                const u32x4 zero = u32x4{0u, 0u, 0u, 0u};
                zc[k] = *(const u32x4*)(P + rwkv_row(seg, b, pos) * D_IN + RW0 + ch0);
                zp[k] = (pos > 0) ? *(const u32x4*)(P + rwkv_row(seg, b, pos - 1) * D_IN + RW0 + ch0) : zero;
                zn[k] = (pos < len - 1) ? *(const u32x4*)(P + rwkv_row(seg, b, pos + 1) * D_IN + RW0 + ch0) : zero;
            }
#pragma unroll
            for (int k = 0; k < 5; ++k) if (kb + k < 5) {
                const int idx = tid + 256 * (kb + k), tau = idx / 40, g = idx % 40, grp = g >> 3, j0 = (g & 7) * 8;
                const int ch0 = (grp < 3) ? grp * D_RWKV + h * 64 + j0 : (grp == 3 ? 3 * D_RWKV + d * 64 + j0 : 3 * D_RWKV + 128 + d * 64 + j0);
                float z[8], zpv[8], znv[8], o[8];
                unpack8(zc[k], z); unpack8(zp[k], zpv); unpack8(zn[k], znv);
                const f32x4 mp0 = ld4(p.mu_prev + ch0), mp1 = ld4(p.mu_prev + ch0 + 4), mn0 = ld4(p.mu_next + ch0), mn1 = ld4(p.mu_next + ch0 + 4);
#pragma unroll
                for (int e = 0; e < 4; ++e) { o[e] = z[e] + mp0[e] * (zpv[e] - z[e]) + mn0[e] * (znv[e] - z[e]); o[4 + e] = z[4 + e] + mp1[e] * (zpv[4 + e] - z[4 + e]) + mn1[e] * (znv[4 + e] - z[4 + e]); }
                if (grp < 3) {
                    float* dst = (grp == 0 ? Rf : grp == 1 ? Kf : Vf) + tau * 64 + j0;
                    *(f32x4*)dst = f32x4{o[0], o[1], o[2], o[3]}; *(f32x4*)(dst + 4) = f32x4{o[4], o[5], o[6], o[7]};
                } else if (grp == 3) {
                    u32x4 w;
#pragma unroll
                    for (int e = 0; e < 4; ++e) { const float t0 = 2.0f * frcp(1.0f + FEXP(-2.0f * o[2 * e])) - 1.0f, t1 = 2.0f * frcp(1.0f + FEXP(-2.0f * o[2 * e + 1])) - 1.0f; w[e] = pk2(t0, t1); }
                    *(u32x4*)(TW + tau * LT + j0) = w;
                } else {
                    u32x4 w; w[0] = pk2(o[0], o[1]); w[1] = pk2(o[2], o[3]); w[2] = pk2(o[4], o[5]); w[3] = pk2(o[6], o[7]);
                    *(u32x4*)(TA + tau * LT + j0) = w;
                }
            }
            }
#pragma unroll
            for (int k = 0; k < 4; ++k) {
                const int idx = tid + 256 * k, which = idx >> 9, j = (idx >> 3) & 63, c8 = (idx & 7) * 8;
                *(u32x4*)((which ? A2T : W2T) + j * LT + c8) = wv[k];
            }
        }
        __syncthreads();
        {
            f32x4 aw[2] = {f32x4{0.f, 0.f, 0.f, 0.f}, f32x4{0.f, 0.f, 0.f, 0.f}}, ai[2] = {f32x4{0.f, 0.f, 0.f, 0.f}, f32x4{0.f, 0.f, 0.f, 0.f}};
            mmT<2, 2>(aw, W2T, LT, wave, TW, LT, lane);
            mmT<2, 2>(ai, A2T, LT, wave, TA, LT, lane);
            const int j = wave * 16 + q * 4;
            const f32x4 w0v = ld4(p.w0 + d * D_RWKV + h * 64 + j), a0v = ld4(p.a0 + d * D_RWKV + h * 64 + j);
            const f32x4 kk4 = ld4(p.k_k + h * 64 + j), ka4 = ld4(p.k_a + h * 64 + j), rk4 = ld4(p.r_k + h * 64 + j);
#pragma unroll
            for (int nb = 0; nb < 2; ++nb) {
                const int tau = nb * 16 + l15;
                f32x4 lw, ic;
#pragma unroll
                for (int r = 0; r < 4; ++r) { lw[r] = -0.6065306597126334f * fsigm(w0v[r] + aw[nb][r]); ic[r] = fsigm(a0v[r] + ai[nb][r]); }
                *(f32x4*)(LW + tau * 64 + j) = lw; *(f32x4*)(IC + tau * 64 + j) = ic;
                const f32x4 kr = *(const f32x4*)(Kf + tau * 64 + j), rr = *(const f32x4*)(Rf + tau * 64 + j);
                const f32x4 kd = kr * (1.0f + (ic - 1.0f) * ka4), kq = kr * kk4;
                float n2 = hsum4(kq * kq), bon = hsum4(rr * kd * rk4);
                n2 += __shfl_xor(n2, 16); n2 += __shfl_xor(n2, 32); bon += __shfl_xor(bon, 16); bon += __shfl_xor(bon, 32);
                if (q == 0) { PS[(tau * 4 + wave) * 2] = n2; PS[(tau * 4 + wave) * 2 + 1] = bon; }
            }
        }
        __syncthreads();
        {
            const int j = lane, t0 = wave * 8;
            float cum[8], kd[8], kkn[8], icv[8], rr[8], vv[8], run = 0.f;
#pragma unroll
            for (int i = 0; i < 8; ++i) {
                const int t = t0 + i;
                run += LW[t * 64 + j]; cum[i] = run;
                const float kr = Kf[t * 64 + j]; icv[i] = IC[t * 64 + j]; rr[i] = Rf[t * 64 + j]; vv[i] = Vf[t * 64 + j];
                kd[i] = kr * (1.0f + (icv[i] - 1.0f) * kac);
                const float kk = kr * kkc;
                const f32x4 pa = *(const f32x4*)(PS + t * 8), pb = *(const f32x4*)(PS + t * 8 + 4);
                const float n2 = (pa[0] + pa[2]) + (pb[0] + pb[2]);
                kkn[i] = kk * frsq(fmaxf(n2, 1e-24f));
                if (lane == 0) RBON[(size_t)it * RC + t] = (pa[1] + pa[3]) + (pb[1] + pb[3]);
            }
            TOT[wave * 64 + j] = run;
            __syncthreads();
            float off = 0.f;
            for (int w = 0; w < wave; ++w) off += TOT[w * 64 + j];
            u32x4 vt, bt, kt;
            float e_prev = 0.f;
#pragma unroll
            for (int i = 0; i < 8; ++i) {
                const int t = t0 + i;
                const float cu = off + cum[i], cprev = (i == 0) ? off : off + cum[i - 1];
                const float g = FEXP(cu), gi = FEXP(-cu), gm = FEXP(cprev);
                const float ah = -kkn[i] * gm, bh = kkn[i] * icv[i] * gi, kh = kd[i] * gi, rh = rr[i] * g;
                Ah[t * LT + j] = f2bf(ah); Bh[t * LT + j] = f2bf(bh); Kh[t * LT + j] = f2bf(kh); Rh[t * LT + j] = f2bf(rh);
                if (i & 1) { vt[i >> 1] = pk2(e_prev, vv[i]); bt[i >> 1] = (bt[i >> 1] & 0xFFFFu) | ((unsigned)f2bf(bh) << 16); kt[i >> 1] = (kt[i >> 1] & 0xFFFFu) | ((unsigned)f2bf(kh) << 16); }
                else { e_prev = vv[i]; bt[i >> 1] = f2bf(bh); kt[i >> 1] = f2bf(kh); }
                if (t == RC - 1) GC[j] = g;
            }
            *(u32x4*)(VT + j * LJ + t0) = vt; *(u32x4*)(BhT + j * LJ + t0) = bt; *(u32x4*)(KhT + j * LJ + t0) = kt;
        }
        __syncthreads();
        {
            const bf16_t* X = (wave == 0) ? Ah : (wave & 1) ? Kh : Bh;
            const bf16_t* Y = (wave == 0) ? Bh : (wave == 1) ? Ah : Rh;
#pragma unroll
            for (int xs = 0; xs < 2; ++xs) {
                f32x4 acc[2] = {f32x4{0.f, 0.f, 0.f, 0.f}, f32x4{0.f, 0.f, 0.f, 0.f}};
                mmT<2, 2>(acc, X, LT, xs, Y, LT, lane);
#pragma unroll
                for (int nb = 0; nb < 2; ++nb) {
                    const int yy = nb * 16 + l15, x0 = xs * 16 + q * 4;
                    f32x4 v = acc[nb];
#pragma unroll
                    for (int r = 0; r < 4; ++r) { const int xx = x0 + r; const bool keep = (wave == 0) ? (yy < xx) : (wave == 1) ? (xx < yy) : (xx <= yy); v[r] = keep ? v[r] : 0.f; }
                    if (wave == 0) { *(f32x4*)(PA + yy * 36 + x0) = v; f32x4 t0 = v; for (int r = 0; r < 4; ++r) t0[r] += (x0 + r == yy) ? 1.0f : 0.0f; *(f32x4*)(IA + yy * 36 + x0) = t0; }
                    else { bf16_t* dst = (wave == 1 ? NkaT : wave == 2 ? MbrT : MkrT) + yy * LJ + x0; *(U2*)dst = pack4(v); }
                }
            }
        }
        __syncthreads();
        {
#pragma unroll
            for (int xs = 0; xs < 2; ++xs) {
                f32x4 acc[1] = {f32x4{0.f, 0.f, 0.f, 0.f}};
                mmT<1, 1>(acc, NkaT, LJ, xs, VT + wave * 16 * LJ, LJ, lane);
                const int i = wave * 16 + l15, tb = xs * 16 + q * 4;
                Xu[i * 33 + tb] = acc[0][0]; Xu[i * 33 + tb + 1] = acc[0][1]; Xu[i * 33 + tb + 2] = acc[0][2]; Xu[i * 33 + tb + 3] = acc[0][3];
            }
        }
        __syncthreads();
        {
            auto mm32 = [&](float* Z, const float* init, const float* L, const float* R, int ti, int tj) {
                f32x4 acc = f32x4{0.f, 0.f, 0.f, 0.f};
                if (init) { for (int r = 0; r < 4; ++r) acc[r] = init[(ti * 16 + q * 4 + r) * 36 + tj * 16 + l15]; }
#pragma unroll
                for (int k0 = 0; k0 < 32; k0 += 4) acc = MFMAF32(L[(ti * 16 + l15) * 36 + k0 + q], R[(k0 + q) * 36 + tj * 16 + l15], acc);
#pragma unroll
                for (int r = 0; r < 4; ++r) Z[(ti * 16 + q * 4 + r) * 36 + tj * 16 + l15] = acc[r];
            };
            const int ti = wave >> 1, tj = wave & 1;
            mm32(PB, nullptr, PA, PA, ti, tj);
            __syncthreads();
            mm32(IB, IA, IA, PB, ti, tj); mm32(PA, nullptr, PB, PB, ti, tj);
            __syncthreads();
            mm32(IA, IB, IB, PA, ti, tj); mm32(PB, nullptr, PA, PA, ti, tj);
            __syncthreads();
            mm32(IB, IA, IA, PB, ti, tj); mm32(PA, nullptr, PB, PB, ti, tj);
            __syncthreads();
            f32x4 accw[2], accu[2];
            mm32(IA, IB, IB, PA, ti, tj);
            __syncthreads();
#pragma unroll
            for (int tc = 0; tc < 2; ++tc) { accw[tc] = f32x4{0.f, 0.f, 0.f, 0.f}; accu[tc] = f32x4{0.f, 0.f, 0.f, 0.f}; }
#pragma unroll
            for (int k0 = 0; k0 < 32; k0 += 4) {
                const float la = bf2f(Ah[(k0 + q) * LT + wave * 16 + l15]), lu = Xu[(wave * 16 + l15) * 33 + k0 + q];
#pragma unroll
                for (int tc = 0; tc < 2; ++tc) { const float rv = IA[(k0 + q) * 36 + tc * 16 + l15]; accw[tc] = MFMAF32(la, rv, accw[tc]); accu[tc] = MFMAF32(lu, rv, accu[tc]); }
            }
            __syncthreads();
#pragma unroll
            for (int tc = 0; tc < 2; ++tc)
#pragma unroll
                for (int r = 0; r < 4; ++r) { const int row = wave * 16 + q * 4 + r, col = tc * 16 + l15; Wa[row * LJ + col] = f2bf(accw[tc][r]); U0[row * LJ + col] = f2bf(accu[tc][r]); }
        }
        __syncthreads();
        {
            bf16_t* gPm = (bf16_t*)(chp + CH_PM); bf16_t* gSA = (bf16_t*)(chp + CH_SA); bf16_t* gQT = (bf16_t*)(chp + CH_QT); bf16_t* gY0 = (bf16_t*)(chp + CH_Y0);
            const int x0 = wave * 16 + q * 4;
            {
                f32x4 acc[4] = {f32x4{0.f, 0.f, 0.f, 0.f}, f32x4{0.f, 0.f, 0.f, 0.f}, f32x4{0.f, 0.f, 0.f, 0.f}, f32x4{0.f, 0.f, 0.f, 0.f}};
                mmT<4, 1>(acc, Wa, LJ, wave, BhT, LJ, lane);
#pragma unroll
                for (int nb = 0; nb < 4; ++nb) {
                    const int jp = nb * 16 + l15; const float g = GC[jp];
                    f32x4 v = acc[nb];
#pragma unroll
                    for (int r = 0; r < 4; ++r) v[r] = (v[r] + ((x0 + r == jp) ? 1.0f : 0.0f)) * g;
                    *(U2*)(gPm + jp * 64 + x0) = pack4(v);
                }
            }
            {
                f32x4 acc[4] = {f32x4{0.f, 0.f, 0.f, 0.f}, f32x4{0.f, 0.f, 0.f, 0.f}, f32x4{0.f, 0.f, 0.f, 0.f}, f32x4{0.f, 0.f, 0.f, 0.f}};
                mmT<4, 1>(acc, BhT, LJ, wave, U0, LJ, lane);
                mmT<4, 1>(acc, KhT, LJ, wave, VT, LJ, lane);
                const f32x4 g = *(const f32x4*)(GC + x0);
#pragma unroll
                for (int nb = 0; nb < 4; ++nb) *(U2*)(gSA + (nb * 16 + l15) * 64 + x0) = pack4(acc[nb] * g);
            }
            if (seg == 1) {
                {
                    f32x4 acc[2] = {f32x4{0.f, 0.f, 0.f, 0.f}, f32x4{0.f, 0.f, 0.f, 0.f}};
                    mmT<2, 1>(acc, Wa, LJ, wave, MbrT, LJ, lane);
#pragma unroll
                    for (int nb = 0; nb < 2; ++nb) {
                        const int t = nb * 16 + l15;
                        f32x4 v = acc[nb];
#pragma unroll
                        for (int r = 0; r < 4; ++r) v[r] += bf2f(Rh[t * LT + x0 + r]);
                        *(U2*)(gQT + t * 64 + x0) = pack4(v);
                    }
                }
                {
                    f32x4 acc[2] = {f32x4{0.f, 0.f, 0.f, 0.f}, f32x4{0.f, 0.f, 0.f, 0.f}};
                    mmT<2, 1>(acc, U0, LJ, wave, MbrT, LJ, lane);
                    mmT<2, 1>(acc, VT, LJ, wave, MkrT, LJ, lane);
#pragma unroll
                    for (int nb = 0; nb < 2; ++nb) *(U2*)(gY0 + (nb * 16 + l15) * 64 + x0) = pack4(acc[nb]);
                }
            }
        }
    }
}

__device__ __forceinline__ U2 ldu2(const bf16_t* p) { return *(const U2*)p; }
constexpr int R2D = 6, R2LD = 72;
__device__ __forceinline__ void phaseR2(const Params& p, int bid, int nblk, char* smem) {
    unsigned char* CH = p.ws + WS_CH;
    bf16_t* PL = (bf16_t*)smem;
    const int tid = opaque_tid(), lane = tid & 63, wave = tid >> 6, q = lane >> 4, l15 = lane & 15;
    const int lrow = wave * 16 + (lane >> 2), lcol = (lane & 3) * 16;
    for (int chain = bid; chain < NCHAIN; chain += nblk) {
        const int i = wave * 16 + l15;
        unsigned char* chbase = CH + (size_t)chain * NCK * CH_BYTES;
        f32x4 st[4];
#pragma unroll
        for (int nt = 0; nt < 4; ++nt) st[nt] = f32x4{0.f, 0.f, 0.f, 0.f};
        u32x4 pq[R2D][2]; U2 sa[R2D][4];
#pragma unroll
        for (int k = 0; k < R2D; ++k) {
            const unsigned char* chp = chbase + (size_t)(k < NCK ? k : NCK - 1) * CH_BYTES;
            const bf16_t* gp = (const bf16_t*)(chp + CH_PM) + lrow * 64 + lcol;
            pq[k][0] = *(const u32x4*)gp; pq[k][1] = *(const u32x4*)(gp + 8);
#pragma unroll
            for (int nt = 0; nt < 4; ++nt) sa[k][nt] = ldu2((const bf16_t*)(chp + CH_SA) + i * 64 + nt * 16 + 4 * q);
        }
#pragma unroll 1
        for (int c0 = 0; c0 < NCK; c0 += R2D) {
#pragma unroll
            for (int k = 0; k < R2D; ++k) {
                const int c = c0 + k;
                if (c < NCK) {
                bf16_t* pl = PL + (k & 1) * 64 * R2LD;
                *(u32x4*)(pl + lrow * R2LD + lcol) = pq[k][0]; *(u32x4*)(pl + lrow * R2LD + lcol + 8) = pq[k][1];
                f32x4 ini[4];
#pragma unroll
                for (int nt = 0; nt < 4; ++nt) ini[nt] = f32x4{bitsf(sa[k][nt].x << 16), bitsf(sa[k][nt].x & 0xFFFF0000u), bitsf(sa[k][nt].y << 16), bitsf(sa[k][nt].y & 0xFFFF0000u)};
                {
                    const int cn = (c + R2D < NCK) ? c + R2D : NCK - 1;
                    const unsigned char* chp = chbase + (size_t)cn * CH_BYTES;
                    const bf16_t* gp = (const bf16_t*)(chp + CH_PM) + lrow * 64 + lcol;
                    pq[k][0] = *(const u32x4*)gp; pq[k][1] = *(const u32x4*)(gp + 8);
#pragma unroll
                    for (int nt = 0; nt < 4; ++nt) sa[k][nt] = ldu2((const bf16_t*)(chp + CH_SA) + i * 64 + nt * 16 + 4 * q);
                }
                __syncthreads();
                bf16_t* gSA = (bf16_t*)(chbase + (size_t)c * CH_BYTES + CH_SA) + i * 64 + 4 * q;
                bf16x8 bfr[2];
#pragma unroll
                for (int ks = 0; ks < 2; ++ks) {
                    const U2 lo = pack4(st[2 * ks]), hi = pack4(st[2 * ks + 1]);
                    bfr[ks] = __builtin_bit_cast(bf16x8, u32x4{lo.x, lo.y, hi.x, hi.y});
                    *(U2*)(gSA + (2 * ks) * 16) = lo; *(U2*)(gSA + (2 * ks + 1) * 16) = hi;
                }
#pragma unroll
                for (int nt = 0; nt < 4; ++nt) {
                    f32x4 acc = ini[nt];
#pragma unroll
                    for (int ks = 0; ks < 2; ++ks) {
                        const U2 lo = *(const U2*)(pl + (nt * 16 + l15) * R2LD + 32 * ks + 4 * q), hi = *(const U2*)(pl + (nt * 16 + l15) * R2LD + 32 * ks + 16 + 4 * q);
                        acc = MFMA16(__builtin_bit_cast(bf16x8, u32x4{lo.x, lo.y, hi.x, hi.y}), bfr[ks], acc);
                    }
                    st[nt] = acc;
                }
                }
            }
        }
        __syncthreads();
    }
}

__device__ __forceinline__ void phaseR3(const Params& p, int bid, int nblk, char* smem) {
    const bf16_t* P = WSP(bf16_t, WS_R1);
    const unsigned char* CH = p.ws + WS_CH;
    const float* RBON = WSP(float, WS_RBON);
    bf16_t* MIX = WSP(bf16_t, WS_R3);
    float* red = (float*)smem;
    const int tid = opaque_tid(), lane = tid & 63, wave = tid >> 6, q = lane >> 4, l15 = lane & 15;
    for (int m = bid * 256 + tid; m < MLAT; m += nblk * 256) {
        const float* sp = WSP(float, WS_SSQP) + (size_t)m * LRU_BLOCKS;
        float sq = 0.f;
#pragma unroll
        for (int c = 0; c < LRU_BLOCKS; ++c) sq += sp[c];
        WSP(float, WS_RINV)[m] = frsq(sq * (1.0f / D_LRU) + RMS_EPS);
    }
    bf16_t* G2T = (bf16_t*)(smem + 1024);
    const int nbh = nblk / HEADS;
    const bool uniform = (nbh > 0) && (nblk % HEADS == 0);
    constexpr int NP16 = SEQ / 16, NW = BATCH * NP16;
    const int nwv = uniform ? nbh * 4 : nblk * 4;
    int hcur = -1;
    for (int wi0 = (uniform ? (bid % nbh) : bid) * 4; wi0 < (uniform ? NW : NW * HEADS); wi0 += nwv) {
        int h; if (uniform) h = bid / nbh; else h = (wi0 / 4) % HEADS;
        if (h != hcur) {
            __syncthreads();
            for (int idx = tid; idx < 128 * 16; idx += 256) {
                const int c = idx >> 4, i4 = (idx & 15) * 4;
                const f32x4 w = ld4(p.g2 + (size_t)c * D_RWKV + h * 64 + i4);
                bf16_t* dst = G2T + i4 * 136 + c;
                dst[0] = f2bf(w[0]); dst[136] = f2bf(w[1]); dst[272] = f2bf(w[2]); dst[408] = f2bf(w[3]);
            }
            hcur = h;
            __syncthreads();
        }
        const int wi = uniform ? wi0 + wave : (wi0 / 4 / HEADS) * 4 + wave;
        if (wi >= NW) continue;
        const int b = wi / NP16, p16 = wi % NP16, pc = p16 >> 1, pl = (p16 & 1) * 16 + l15, pos = pc * RC + pl;
        f32x4 y[4], g[4];
#pragma unroll
        for (int xs = 0; xs < 4; ++xs) { y[xs] = f32x4{0.f, 0.f, 0.f, 0.f}; g[xs] = f32x4{0.f, 0.f, 0.f, 0.f}; }
        float bon = 0.f;
#pragma unroll
        for (int d = 0; d < 2; ++d) {
            const int chain = (b * HEADS + h) * 2 + d, c = NCC + (d ? NLC - 1 - pc : pc), tau = d ? RC - 1 - pl : pl;
            const size_t item = (size_t)chain * NCK + c;
            const unsigned char* chp = CH + item * CH_BYTES;
            const bf16_t* gS = (const bf16_t*)(chp + CH_SA); const bf16_t* gQT = (const bf16_t*)(chp + CH_QT); const bf16_t* gY0 = (const bf16_t*)(chp + CH_Y0);
            bf16x8 yf[2];
#pragma unroll
            for (int ks = 0; ks < 2; ++ks) yf[ks] = *(const bf16x8*)(gQT + tau * 64 + ks * 32 + 8 * q);
#pragma unroll
            for (int xs = 0; xs < 4; ++xs) {
                f32x4 acc = ldb4(gY0 + tau * 64 + xs * 16 + 4 * q);
#pragma unroll
                for (int ks = 0; ks < 2; ++ks) acc = MFMA16(*(const bf16x8*)(gS + (xs * 16 + l15) * 64 + ks * 32 + 8 * q), yf[ks], acc);
                y[xs] += acc;
            }
            bon += RBON[item * RC + tau];
        }
#pragma unroll
        for (int ks = 0; ks < 4; ++ks) {
            float o[8]; shifted8(p, P, 1, b, pos, SEQ, 3 * D_RWKV + 256 + ks * 32 + 8 * q, o);
            u32x4 t; t[0] = pk2(fsigm(o[0]), fsigm(o[1])); t[1] = pk2(fsigm(o[2]), fsigm(o[3])); t[2] = pk2(fsigm(o[4]), fsigm(o[5])); t[3] = pk2(fsigm(o[6]), fsigm(o[7]));
            const bf16x8 sg = __builtin_bit_cast(bf16x8, t);
#pragma unroll
            for (int xs = 0; xs < 4; ++xs) g[xs] = MFMA16(*(const bf16x8*)(G2T + (xs * 16 + l15) * 136 + ks * 32 + 8 * q), sg, g[xs]);
        }
        float s1 = 0.f, s2 = 0.f;
#pragma unroll
        for (int xs = 0; xs < 4; ++xs) { s1 += hsum4(y[xs]); s2 += hsum4(y[xs] * y[xs]); }
        s1 += __shfl_xor(s1, 16); s1 += __shfl_xor(s1, 32); s2 += __shfl_xor(s2, 16); s2 += __shfl_xor(s2, 32);
        const float mu = s1 * (1.0f / 64.0f), var = fmaxf(s2 * (1.0f / 64.0f) - mu * mu, 0.f), rstd = frsq(var + GN_EPS);
        const size_t mrow = rwkv_row(1, b, pos);
        const size_t mprev = pos > 0 ? rwkv_row(1, b, pos - 1) : mrow, mnext = pos < SEQ - 1 ? rwkv_row(1, b, pos + 1) : mrow;
#pragma unroll
        for (int xs = 0; xs < 4; ++xs) {
            const int i0 = xs * 16 + q * 4, chv = 2 * D_RWKV + h * 64 + i0;
            const f32x4 z = ldb4(P + mrow * D_IN + RW0 + chv);
            f32x4 zp = ldb4(P + mprev * D_IN + RW0 + chv), zn = ldb4(P + mnext * D_IN + RW0 + chv);
            if (pos == 0) zp = f32x4{0.f, 0.f, 0.f, 0.f};
            if (pos == SEQ - 1) zn = f32x4{0.f, 0.f, 0.f, 0.f};
            const f32x4 v = z + ld4(p.mu_prev + chv) * (zp - z) + ld4(p.mu_next + chv) * (zn - z);
            const f32x4 yn = (y[xs] - mu) * rstd * ld4(p.gn_g + h * 64 + i0) + ld4(p.gn_b + h * 64 + i0);
            *(U2*)(MIX + mrow * D_MIX + D_LRU + h * 64 + i0) = pack4((yn + bon * v) * g[xs]);
        }
    }
}

__device__ __forceinline__ void phaseJ(const Params& p, int bid, int nblk, char* smem) {
    const bf16_t* MIX = WSP(bf16_t, WS_R3); const bf16_t* WB = WSP(bf16_t, WS_WBOUT);
    bf16_t* YOUT = WSP(bf16_t, WS_R1);
    const float* RINV = WSP(float, WS_RINV);
    constexpr int BM = 32 * MI_J, NTN = D_MODEL / 128, NTM = MLAT / BM;
    constexpr int GM = (NTM % 8 == 0) ? 8 : 1;
    for (int it = xcd_vbid(bid, nblk); it < NTN * NTM; it += nblk) {
        const int mg = it / (GM * NTN), r = it % (GM * NTN), nt = r / GM, mt = mg * GM + (r % GM);
        gemm_tile<MI_J, false>(smem, MIX, D_MIX, nullptr, mt * BM, WB, nullptr, D_MIX, nt * 128, D_MIX, [&](int ml, int nl, f32x4 v, f32x4) {
            *(U2*)(YOUT + (size_t)(mt * BM + ml) * D_MODEL + nt * 128 + nl) = pack4(v);
        }, RINV, D_LRU / 64);
    }
}

constexpr int KUL = D_MODEL + 2;
static_assert((16 * KUL + 4 * 256) * 4 <= SMEM_BYTES && N_EXPERTS <= 16 && MLAT % 16 == 0, "phase K lds");
__device__ __forceinline__ void phaseK(const Params& p, int bid, int nblk, char* smem) {
    const int tid = opaque_tid(), lane = tid & 63, wave = tid >> 6, q = lane >> 4, l15 = lane & 15;
    const float* MOD = WSP(float, WS_MOD); const float* STATS = WSP(float, WS_STATS);
    const bf16_t* YOUT = WSP(bf16_t, WS_R1);
    float* H1 = WSP(float, WS_R5); bf16_t* U2b = WSP(bf16_t, WS_R6); float* AFF = WSP(float, WS_AFF);
    float* UL = (float*)smem;
    float* PL = UL + 16 * KUL;
    for (int rb = bid; rb < MLAT / 16; rb += nblk) {
        __syncthreads();
#pragma unroll 1
        for (int rr = 0; rr < 4; ++rr) {
            const int lr = wave * 4 + rr, row = rb * 16 + lr;
            const float* xr = p.x + (size_t)row * D_MODEL;
            const float* md = MOD + (size_t)(row / SEQ) * 6 * D_MODEL;
            const float mu0 = STATS[row * 2], rs0 = STATS[row * 2 + 1];
            f32x4 v0, v1, v2, v3; float s = 0.f;
#define PK_LOAD(V, J) { const int k = (J) * 256 + lane * 4; \
            V = ALPHA_F * ((ld4(xr + k) - mu0) * rs0 * ld4(p.ln_in_g + k) + ld4(p.ln_in_b + k)) + ld4(md + 2 * D_MODEL + k) * ldb4(YOUT + (size_t)row * D_MODEL + k); s += hsum4(V); }
            PK_LOAD(v0, 0)
            if (NV > 1) PK_LOAD(v1, 1) else v1 = f32x4{0.f, 0.f, 0.f, 0.f};
            if (NV > 2) { PK_LOAD(v2, 2) PK_LOAD(v3, 3) } else { v2 = v1; v3 = v1; }
#undef PK_LOAD
            const float mu = wave_sum(s) * (1.0f / D_MODEL);
            v0 -= mu; float s2 = hsum4(v0 * v0);
            if (NV > 1) { v1 -= mu; s2 += hsum4(v1 * v1); }
            if (NV > 2) { v2 -= mu; v3 -= mu; s2 += hsum4(v2 * v2) + hsum4(v3 * v3); }
            const float rstd = frsq(wave_sum(s2) * (1.0f / D_MODEL) + LN_EPS);
#pragma unroll
            for (int j = 0; j < NV; ++j) {
                const int k = j * 256 + lane * 4;
                const f32x4 vv = (j == 0) ? v0 : (j == 1) ? v1 : (j == 2) ? v2 : v3;
                const f32x4 h = vv * rstd * ld4(p.ln1_g + k) + ld4(p.ln1_b + k);
                *(f32x4*)(H1 + (size_t)row * D_MODEL + k) = h;
                const f32x4 u = h * (1.0f + ld4(md + 4 * D_MODEL + k)) + ld4(md + 3 * D_MODEL + k);
                *(U2*)(U2b + (size_t)row * D_MODEL + k) = pack4(u);
                float* ul = UL + lr * KUL + k;
                *(f32x2_e*)ul = f32x2_e{u[0], u[1]}; *(f32x2_e*)(ul + 2) = f32x2_e{u[2], u[3]};
            }
        }
        __syncthreads();
        {
            f32x4 acc = f32x4{0.f, 0.f, 0.f, 0.f};
            const int kq0 = wave * (D_MODEL / 4);
#pragma unroll 8
            for (int s4 = 0; s4 < D_MODEL / 16; ++s4) {
                const int k = kq0 + s4 * 4 + q;
                const float av = UL[l15 * KUL + k];
                const float bv = (l15 < N_EXPERTS) ? p.w_router[(size_t)k * N_EXPERTS + l15] : 0.f;
                acc = MFMAF32(av, bv, acc);
            }
#pragma unroll
            for (int r = 0; r < 4; ++r) PL[wave * 256 + (q * 4 + r) * 16 + l15] = acc[r];
        }
        __syncthreads();
        {
            const int lr = tid >> 4, e = tid & 15;
            const bool valid = e < N_EXPERTS;
            float lg = PL[tid] + PL[256 + tid] + PL[512 + tid] + PL[768 + tid];
            float mx = valid ? lg : -3.0e38f;
#pragma unroll
            for (int o = 1; o < 16; o <<= 1) mx = fmaxf(mx, __shfl_xor(mx, o));
            const float ex = valid ? expf(lg - mx) : 0.f;
            float den = ex;
#pragma unroll
            for (int o = 1; o < 16; o <<= 1) den += __shfl_xor(den, o);
            if (valid) AFF[(size_t)(rb * 16 + lr) * N_EXPERTS + e] = ex / den;
        }
    }
}

__device__ __forceinline__ int block_sum_int(int v, int* red) {
    const int tid_ = opaque_tid(), lane = tid_ & 63, wave = tid_ >> 6;
#pragma unroll
    for (int o = 1; o < 64; o <<= 1) v += __shfl_xor(v, o);
    __syncthreads();
    if (lane == 0) red[wave] = v;
    __syncthreads();
    return red[0] + red[1] + red[2] + red[3];
}
__device__ __forceinline__ void phaseL(const Params& p, int bid, int nblk, char* smem) {
    const float* AFF = WSP(float, WS_AFF);
    int* IDX = WSP(int, WS_IDX); float* GATE = WSP(float, WS_GATE); int* SLOTOF = WSP(int, WS_SLOT);
    unsigned* vals = (unsigned*)smem;
    int* red = (int*)(vals + SEQ);
    int* wsum = red + 8;
    const int tid = opaque_tid(), lane = tid & 63, wave = tid >> 6;
    constexpr int PER = SEQ / 256;
    {
        constexpr int NL = BATCH * N_EXPERTS;
        const bool spare = nblk > NL + 32;
        if (spare ? (bid >= NL) : true) convert_experts(p, spare ? bid - NL : bid, spare ? nblk - NL : nblk, smem, 0, 2);
        if (spare && bid >= NL) return;
        __syncthreads();
    }
    for (int be = bid; be < BATCH * N_EXPERTS; be += nblk) {
        const int b = be / N_EXPERTS, e = be % N_EXPERTS;
        __syncthreads();
        for (int t = tid; t < SEQ; t += 256) vals[t] = fbits(AFF[((size_t)b * SEQ + t) * N_EXPERTS + e]);
        __syncthreads();
        unsigned lo = 0u, hi = 0x7F800000u;
        while (lo < hi) {
            const unsigned mid = lo + (hi - lo + 1u) / 2u;
            int c = 0;
            for (int t = tid; t < SEQ; t += 256) c += (vals[t] >= mid) ? 1 : 0;
            c = block_sum_int(c, red);
            if (c >= CAP) lo = mid; else hi = mid - 1u;
        }
        const unsigned T = lo;
        int cg = 0, ce = 0;
        for (int q = 0; q < PER; ++q) { const unsigned v = vals[tid * PER + q]; cg += (v > T) ? 1 : 0; ce += (v == T) ? 1 : 0; }
        int pg = cg, pe = ce;
#pragma unroll
        for (int o = 1; o < 64; o <<= 1) { const int a = __shfl_up(pg, o), bb = __shfl_up(pe, o); if (lane >= o) { pg += a; pe += bb; } }
        __syncthreads();
        if (lane == 63) { wsum[wave] = pg; wsum[4 + wave] = pe; }
        __syncthreads();
        int og = 0, oe = 0, totg = 0;
        for (int w = 0; w < 4; ++w) { if (w < wave) { og += wsum[w]; oe += wsum[4 + w]; } totg += wsum[w]; }
        int posg = og + pg - cg, pose = oe + pe - ce;
        const int need_eq = CAP - totg;
        for (int q = 0; q < PER; ++q) {
            const int t = tid * PER + q; const unsigned v = vals[t];
            int slot = -1;
            if (v > T) { slot = posg++; }
            else if (v == T) { if (pose < need_eq) slot = totg + pose; pose++; }
            if (slot >= 0) { IDX[(size_t)be * CAP + slot] = b * SEQ + t; GATE[(size_t)be * CAP + slot] = bitsf(v); }
            SLOTOF[((size_t)b * SEQ + t) * N_EXPERTS + e] = slot;
        }
    }
}

__device__ __forceinline__ void phaseM(const Params& p, int bid, int nblk, char* smem) {
    const bf16_t* U2b = WSP(bf16_t, WS_R6); const int* IDX = WSP(int, WS_IDX);
    bf16_t* HID = WSP(bf16_t, WS_R1);
    constexpr int BM = 32 * MI_E, NTN = D_EXPERT / 64, NTM = CAP / BM;
    for (int it = xcd_vbid(bid, nblk); it < BATCH * N_EXPERTS * NTM * NTN; it += nblk) {
        const int mt = it % NTM, b = (it / NTM) % BATCH, nt = (it / (NTM * BATCH)) % NTN, e = it / (NTM * BATCH * NTN), be = b * N_EXPERTS + e;
        const bf16_t* wg = WSP(bf16_t, WS_WG + (size_t)e * WEXP_BYTES); const bf16_t* wu = WSP(bf16_t, WS_WU + (size_t)e * WEXP_BYTES);
        gemm_tile<MI_E, true>(smem, U2b, D_MODEL, IDX + (size_t)be * CAP, mt * BM, wg, wu, D_MODEL, nt * 64, D_MODEL, [&](int ml, int nl, f32x4 g, f32x4 u) {
            U2 o; o.x = pk2(siluf_(g[0]) * u[0], siluf_(g[1]) * u[1]); o.y = pk2(siluf_(g[2]) * u[2], siluf_(g[3]) * u[3]);
            *(U2*)(HID + ((size_t)be * CAP + mt * BM + ml) * D_EXPERT + nt * 64 + nl) = o;
        });
    }
    {
        constexpr int NT = BATCH * N_EXPERTS * NTM * NTN;
        const int rem = NT % nblk, vb = xcd_vbid(bid, nblk);
        if (rem == 0 || nblk - rem < 32) convert_experts(p, vb, nblk, smem, 2, 3);
        else if (vb >= rem) convert_experts(p, vb - rem, nblk - rem, smem, 2, 3);
    }
}
__device__ __forceinline__ void phaseN(const Params& p, int bid, int nblk, char* smem) {
    const bf16_t* HID = WSP(bf16_t, WS_R1); const float* GATE = WSP(float, WS_GATE);
    bf16_t* YS = WSP(bf16_t, WS_R2);
    constexpr int BM = 32 * MI_E, NTN = D_MODEL / 128, NTM = CAP / BM;
    for (int it = xcd_vbid(bid, nblk); it < BATCH * N_EXPERTS * NTM * NTN; it += nblk) {
        const int mt = it % NTM, b = (it / NTM) % BATCH, nt = (it / (NTM * BATCH)) % NTN, e = it / (NTM * BATCH * NTN), be = b * N_EXPERTS + e;
        const bf16_t* wd = WSP(bf16_t, wdown_off(e));
        gemm_tile<MI_E, false>(smem, HID + (size_t)be * CAP * D_EXPERT, D_EXPERT, nullptr, mt * BM, wd, nullptr, D_EXPERT, nt * 128, D_EXPERT, [&](int ml, int nl, f32x4 v, f32x4) {
            const int slot = mt * BM + ml;
            const float gt = GATE[(size_t)be * CAP + slot];
            *(U2*)(YS + ((size_t)be * CAP + slot) * D_MODEL + nt * 128 + nl) = pack4(v * gt);
        });
    }
}
__device__ __forceinline__ void phaseO(const Params& p, int bid, int nblk, char* smem) {
    const int tid_ = opaque_tid(), lane = tid_ & 63, wave = tid_ >> 6;
    const float* MOD = WSP(float, WS_MOD); const float* H1 = WSP(float, WS_R5); const bf16_t* YS = WSP(bf16_t, WS_R2); const int* SLOTOF = WSP(int, WS_SLOT);
    int row = bid * 4 + wave;
    f32x4 n0 = f32x4{0.f, 0.f, 0.f, 0.f}, n1 = n0, n2 = n0, n3 = n0; int nslot = -1;
    if (row < MLAT) { const float* hr = H1 + (size_t)row * D_MODEL; n0 = ld4(hr + lane * 4); if (NV > 1) n1 = ld4(hr + 256 + lane * 4); if (NV > 2) { n2 = ld4(hr + 512 + lane * 4); n3 = ld4(hr + 768 + lane * 4); }
                      nslot = (lane < N_EXPERTS) ? SLOTOF[(size_t)row * N_EXPERTS + lane] : -1; }
    for (; row < MLAT; row += nblk * 4) {
        const float* md = MOD + (size_t)(row / SEQ) * 6 * D_MODEL;
        const f32x4 h0 = n0, h1 = n1, h2 = n2, h3 = n3; const int myslot = nslot;
        const int nrow = row + nblk * 4;
        if (nrow < MLAT) { const float* hr = H1 + (size_t)nrow * D_MODEL; n0 = ld4(hr + lane * 4); if (NV > 1) n1 = ld4(hr + 256 + lane * 4); if (NV > 2) { n2 = ld4(hr + 512 + lane * 4); n3 = ld4(hr + 768 + lane * 4); }
                           nslot = (lane < N_EXPERTS) ? SLOTOF[(size_t)nrow * N_EXPERTS + lane] : -1; }
        f32x4 y0 = f32x4{0.f, 0.f, 0.f, 0.f}, y1 = y0, y2 = y0, y3 = y0;
        const int bbase = (row / SEQ) * N_EXPERTS;
        for (int e = 0; e < N_EXPERTS; ++e) {
            const int sl = __shfl(myslot, e);
            if (sl >= 0) {
                const bf16_t* yr = YS + ((size_t)(bbase + e) * CAP + sl) * D_MODEL + lane * 4;
                y0 += ldb4(yr);
                if (NV > 1) y1 += ldb4(yr + 256);
                if (NV > 2) { y2 += ldb4(yr + 512); y3 += ldb4(yr + 768); }
            }
        }
        f32x4 v0, v1, v2, v3; float s = 0.f;
        v0 = ALPHA_F * h0 + ld4(md + 5 * D_MODEL + lane * 4) * y0; s += hsum4(v0);
        if (NV > 1) { v1 = ALPHA_F * h1 + ld4(md + 5 * D_MODEL + 256 + lane * 4) * y1; s += hsum4(v1); } else v1 = f32x4{0.f, 0.f, 0.f, 0.f};
        if (NV > 2) { v2 = ALPHA_F * h2 + ld4(md + 5 * D_MODEL + 512 + lane * 4) * y2; v3 = ALPHA_F * h3 + ld4(md + 5 * D_MODEL + 768 + lane * 4) * y3; s += hsum4(v2) + hsum4(v3); } else { v2 = v1; v3 = v1; }
        const float mu = wave_sum(s) * (1.0f / D_MODEL);
        v0 -= mu; float s2 = hsum4(v0 * v0);
        if (NV > 1) { v1 -= mu; s2 += hsum4(v1 * v1); }
        if (NV > 2) { v2 -= mu; v3 -= mu; s2 += hsum4(v2 * v2) + hsum4(v3 * v3); }
        const float rstd = frsq(wave_sum(s2) * (1.0f / D_MODEL) + LN_EPS);
#pragma unroll
        for (int j = 0; j < NV; ++j) {
            const int k = j * 256 + lane * 4;
            const f32x4 vv = (j == 0) ? v0 : (j == 1) ? v1 : (j == 2) ? v2 : v3;
            *(f32x4*)(p.out + (size_t)row * D_MODEL + k) = vv * rstd * ld4(p.ln2_g + k) + ld4(p.ln2_b + k);
        }
    }
}

#define XB_TMO      128
#define XB_XCNT(j)  (256  + 64 * (j))
#define XB_XSUB(j)  (1280 + 64 * (j))
#define XB_XGEN(j)  (2304 + 64 * (j))
#define XB_TOP      3328
#define XB_TOPGEN   3392
#define XCD_BAR_WORDS 3456
#define XB_SPIN_CAP (1u << 22)
#ifndef HOST_EMU
__device__ __forceinline__ unsigned xb_ld(unsigned* p) { return __hip_atomic_load(p, __ATOMIC_RELAXED, __HIP_MEMORY_SCOPE_AGENT); }
__device__ __forceinline__ unsigned xb_add(unsigned* p, unsigned v) { return __hip_atomic_fetch_add(p, v, __ATOMIC_RELAXED, __HIP_MEMORY_SCOPE_AGENT); }
__device__ __forceinline__ unsigned xb_xcc_id() { return (unsigned)__builtin_amdgcn_s_getreg((3 << 11) | 20) & 0xFu; }
#define XB_SPIN(cond, bar) do { unsigned _sp = 0; while (cond) { __builtin_amdgcn_s_sleep(1); \
    if ((++_sp & 255u) == 0u) { if (xb_ld(&(bar)[XB_TMO])) break; if (_sp > XB_SPIN_CAP) { atomicAdd(&(bar)[XB_TMO], 1u); break; } } } } while (0)
#define XB_LAS __attribute__((address_space(3)))
struct XcdBarrier { unsigned off; unsigned x; volatile XB_LAS unsigned* st; unsigned G; };
__device__ __forceinline__ XcdBarrier xcd_barrier_post(unsigned* ctrl, unsigned off, volatile XB_LAS unsigned* st, unsigned G, bool member = true) {
    XcdBarrier b; b.off = off; b.x = xb_xcc_id(); b.st = st; b.G = G; unsigned* bar = ctrl + off;
    if (!member) return b;
    if (threadIdx.x == 0) (void)xb_add(&bar[XB_XCNT(b.x)], 1u);
    return b;
}
__device__ __forceinline__ void xcd_barrier_complete(unsigned* bar, unsigned x, unsigned& nloc, unsigned& nx, unsigned G) {
    unsigned sum, cnt, mine, sp = 0u;
    for (;;) {
        sum = 0u; cnt = 0u; mine = 0u;
#pragma unroll
        for (unsigned j = 0; j < 16; ++j) { const unsigned c = xb_ld(&bar[XB_XCNT(j)]); sum += c; cnt += (c > 0u) ? 1u : 0u; mine = (j == x) ? c : mine; }
        if (sum == G) break;
        __builtin_amdgcn_s_sleep(1);
        if ((++sp & 255u) == 0u) { if (xb_ld(&bar[XB_TMO])) break; if (sp > XB_SPIN_CAP) { atomicAdd(&bar[XB_TMO], 1u); break; } }
    }
    nloc = mine > 0u ? mine : 1u; nx = cnt > 0u ? cnt : 1u;
}
__device__ __forceinline__ void grid_barrier(const XcdBarrier& b, unsigned* ctrl) {
    asm volatile("s_waitcnt vmcnt(0)" ::: "memory");
    __syncthreads();
    if (threadIdx.x == 0) {
        unsigned* bar = ctrl + b.off;
        __builtin_amdgcn_s_waitcnt(0);
        volatile XB_LAS unsigned* st = b.st;
        unsigned nloc = st[0], nx = st[1];
        if (nloc == 0u) { xcd_barrier_complete(bar, b.x, nloc, nx, b.G); st[0] = nloc; st[1] = nx; }
        const unsigned old = xb_add(&bar[XB_XSUB(b.x)], 1u);
        const unsigned gen = old / nloc;
        if (old + 1u == (gen + 1u) * nloc) {
            __builtin_amdgcn_fence(__ATOMIC_RELEASE, "agent");
            asm volatile("s_waitcnt vmcnt(0)" ::: "memory");
            const unsigned og = xb_add(&bar[XB_TOP], 1u);
            const unsigned tg = og / nx;
            if (og + 1u == (tg + 1u) * nx) xb_add(&bar[XB_TOPGEN], 1u);
            else XB_SPIN(xb_ld(&bar[XB_TOPGEN]) == tg, bar);
            __builtin_amdgcn_fence(__ATOMIC_ACQUIRE, "agent");
            xb_add(&bar[XB_XGEN(b.x)], 1u);
            asm volatile("s_waitcnt vmcnt(0)" ::: "memory");
        } else {
            XB_SPIN(xb_ld(&bar[XB_XGEN(b.x)]) == gen, bar);
            __builtin_amdgcn_fence(__ATOMIC_ACQUIRE, "agent");
            asm volatile("s_waitcnt vmcnt(0)" ::: "memory");
        }
    }
    __syncthreads();
}
#else
struct XcdBarrier { int dummy; };
__device__ __forceinline__ void grid_barrier(const XcdBarrier&, unsigned*) { __syncthreads(); }
#endif

__global__ void __launch_bounds__(256, 2) fused_forward(Params p) {
    __shared__ __attribute__((aligned(16))) char smem[SMEM_BYTES];
    __shared__ __attribute__((aligned(16))) unsigned xb_words[4];
    if (threadIdx.x == 0) { xb_words[0] = 0u; xb_words[1] = 0u; xb_words[2] = 0u; xb_words[3] = 0u; }
    __syncthreads();
    const int bid = blockIdx.x, nblk = gridDim.x;
    const bool split = nblk >= 2 * NCHAIN;
#ifdef HOST_EMU
    const XcdBarrier gb{0}; const XcdBarrier gs{0};
#else
    const XcdBarrier gb = xcd_barrier_post(WSP(unsigned, WS_CTRL), 0u, (volatile XB_LAS unsigned*)xb_words, (unsigned)nblk);
    const XcdBarrier gs = xcd_barrier_post(WSP(unsigned, WS_CTRL), (unsigned)XCD_BAR_WORDS, (volatile XB_LAS unsigned*)xb_words + 2, (unsigned)(nblk - NCHAIN), split && bid >= NCHAIN);
#endif
    phaseA(p, bid, nblk, smem); grid_barrier(gb, WSP(unsigned, WS_CTRL));
    phaseB(p, bid, nblk, smem); grid_barrier(gb, WSP(unsigned, WS_CTRL));
    phaseC(p, bid, nblk, smem); grid_barrier(gb, WSP(unsigned, WS_CTRL));
    phaseD(p, bid, nblk, smem);
    phaseR1(p, bid, nblk, smem); grid_barrier(gb, WSP(unsigned, WS_CTRL));
    {
        const int lb = split ? bid - NCHAIN : bid, ln = split ? nblk - NCHAIN : nblk;
        const bool lru_member = !split || bid >= NCHAIN;
        if (!split || bid < NCHAIN) phaseR2(p, bid, split ? NCHAIN : nblk, smem);
        if (lru_member) phaseE(p, lb, ln, smem);
        if (split) { if (lru_member) grid_barrier(gs, WSP(unsigned, WS_CTRL)); } else grid_barrier(gb, WSP(unsigned, WS_CTRL));
        if (lru_member) phaseF(p, lb, ln, smem);
        grid_barrier(gb, WSP(unsigned, WS_CTRL));
    }
    phaseR3(p, bid, nblk, smem); grid_barrier(gb, WSP(unsigned, WS_CTRL));
    phaseJ(p, bid, nblk, smem); grid_barrier(gb, WSP(unsigned, WS_CTRL));
    phaseK(p, bid, nblk, smem); grid_barrier(gb, WSP(unsigned, WS_CTRL));
    phaseL(p, bid, nblk, smem); grid_barrier(gb, WSP(unsigned, WS_CTRL));
    phaseM(p, bid, nblk, smem); grid_barrier(gb, WSP(unsigned, WS_CTRL));
    phaseN(p, bid, nblk, smem); grid_barrier(gb, WSP(unsigned, WS_CTRL));
    phaseO(p, bid, nblk, smem);
}

#ifdef MULTI_LAUNCH
#define PHASE_KERNEL(NAME) \
    __global__ void __launch_bounds__(256) k_##NAME(Params p) { __shared__ __attribute__((aligned(16))) char smem[SMEM_BYTES]; NAME(p, blockIdx.x, gridDim.x, smem); }
PHASE_KERNEL(phaseA) PHASE_KERNEL(phaseB) PHASE_KERNEL(phaseC) PHASE_KERNEL(phaseD) PHASE_KERNEL(phaseE) PHASE_KERNEL(phaseF) PHASE_KERNEL(phaseR1) PHASE_KERNEL(phaseR2) PHASE_KERNEL(phaseR3)
PHASE_KERNEL(phaseJ) PHASE_KERNEL(phaseK) PHASE_KERNEL(phaseL) PHASE_KERNEL(phaseM) PHASE_KERNEL(phaseN) PHASE_KERNEL(phaseO)
#ifdef HOST_EMU
void emu_hook(const char* name, const Params& p);
#define LAUNCH(NAME, grid) do { EMU_LAUNCH(k_##NAME, grid, 256, p); emu_hook(#NAME, p); } while (0)
#else
#define LAUNCH(NAME, grid) hipLaunchKernelGGL(k_##NAME, dim3(grid), dim3(256), 0, stream, p)
#endif
#endif

extern "C" void kernel_launch(void* const* d_in, const int* in_sizes, int n_in, void* d_out, int out_size, void* d_ws, size_t ws_size, hipStream_t stream) {
    if (n_in != 38 || out_size != MLAT * D_MODEL || ws_size < WS_END) { fprintf(stderr, "kernel_launch: unexpected shapes (n_in %d out %d ws %zu need %zu)\n", n_in, out_size, ws_size, (size_t)WS_END); return; }
    Params p{};
    const float** f = (const float**)&p;
    for (int i = 0; i < 38; ++i) f[i] = (const float*)d_in[i];
    p.out = (float*)d_out; p.ws = (unsigned char*)d_ws;
#ifdef MULTI_LAUNCH
    const int G = 512;
    LAUNCH(phaseA, 6 * D_MODEL / 16);
    LAUNCH(phaseB, G);
    LAUNCH(phaseC, G);
    LAUNCH(phaseD, G);
    LAUNCH(phaseE, 16);
    LAUNCH(phaseF, G);
    LAUNCH(phaseR1, G);
    LAUNCH(phaseR2, NCHAIN);
    LAUNCH(phaseR3, G);
    LAUNCH(phaseJ, G);
    LAUNCH(phaseK, G);
    LAUNCH(phaseL, BATCH * N_EXPERTS);
    LAUNCH(phaseM, G);
    LAUNCH(phaseN, G);
    LAUNCH(phaseO, G);
#elif defined(HOST_EMU)
    EMU_LAUNCH(fused_forward, 1, 256, p);
#else
    static int grid_blocks = 0;
    if (!grid_blocks) {
        int dev = 0, cus = 0, per_cu = 0;
        (void)hipGetDevice(&dev);
        (void)hipDeviceGetAttribute(&cus, hipDeviceAttributeMultiprocessorCount, dev);
        (void)hipOccupancyMaxActiveBlocksPerMultiprocessor(&per_cu, fused_forward, 256, 0);
        if (per_cu > 2) per_cu = 2;
        if (per_cu < 1) { fprintf(stderr, "kernel_launch: occupancy query returned %d blocks per CU\n", per_cu); per_cu = 1; }
        grid_blocks = cus * per_cu;
    }
    (void)hipMemsetAsync((char*)d_ws + WS_CTRL, 0, 2 * XCD_BAR_WORDS * 4, stream);
    void* args[] = {&p};
    hipError_t e = hipLaunchCooperativeKernel((void*)fused_forward, dim3(grid_blocks), dim3(256), args, 0, stream);
    if (e != hipSuccess) fprintf(stderr, "cooperative launch failed: %s (grid %d)\n", hipGetErrorString(e), grid_blocks);
#endif
}
```

```cpp
#ifndef HOST_EMU
#include <hip/hip_runtime.h>
#include <cstdio>
#endif
#include <cstdint>
#include <cstddef>

#ifdef CFG_SMALL
constexpr int D_MODEL = 256, BATCH = 2, SEQ = 256, GRID_W = 16, CTX_LEN = 64, LRU_BLOCKS = 2, N_EXPERTS = 4, D_EXPERT = 256;
#else
constexpr int D_MODEL = 1024, BATCH = 4, SEQ = 4096, GRID_W = 64, CTX_LEN = 256, LRU_BLOCKS = 8, N_EXPERTS = 16, D_EXPERT = 1408;
#endif
constexpr int ROWS = SEQ / GRID_W;
constexpr int D_LRU = D_MODEL / 2, LRU_BLOCK = 64;
constexpr int D_RWKV = D_MODEL / 2, HEADS = D_RWKV / 64;
constexpr int D_RWKV_IN = 3 * D_RWKV + 128 + 128 + 128;
constexpr int D_IN = 2 * D_LRU + D_RWKV_IN;
constexpr int D_MIX = D_LRU + D_RWKV;
constexpr int CAP = 2 * SEQ / N_EXPERTS;
constexpr int MLAT = BATCH * SEQ, MCTX = BATCH * CTX_LEN, MTOT = MLAT + MCTX;
constexpr int NMOD = BATCH + 1;
constexpr int RW0 = 2 * D_LRU;
constexpr float ALPHA_F = 1.189207115002721f;
constexpr float LN_EPS = 1e-5f, GN_EPS = 64e-5f, RMS_EPS = 1e-6f;
static_assert(LRU_BLOCKS * LRU_BLOCK == D_LRU, "lru blocks");
static_assert(CAP % 128 == 0 && D_IN % 128 == 0 && D_EXPERT % 64 == 0 && D_MODEL % 128 == 0 && MTOT % 128 == 0 && D_MIX % 64 == 0, "tile divisibility");

typedef unsigned short bf16_t;
typedef short bf16x8 __attribute__((ext_vector_type(8)));
typedef float f32x4 __attribute__((ext_vector_type(4)));
typedef unsigned u32x4 __attribute__((ext_vector_type(4)));
typedef float f32x2_e __attribute__((ext_vector_type(2)));
typedef unsigned U2 __attribute__((ext_vector_type(2)));

#ifdef HOST_EMU
#define MFMA16(a, b, c) emu_mfma_16x16x32_bf16(a, b, c)
#define MFMAF32(a, b, c) emu_mfma_16x16x4_f32(a, b, c)
#else
#define MFMA16(a, b, c) __builtin_amdgcn_mfma_f32_16x16x32_bf16(a, b, c, 0, 0, 0)
#define MFMAF32(a, b, c) __builtin_amdgcn_mfma_f32_16x16x4f32(a, b, c, 0, 0, 0)
#endif

__device__ __forceinline__ unsigned fbits(float f) { return __builtin_bit_cast(unsigned, f); }
__device__ __forceinline__ float bitsf(unsigned u) { return __builtin_bit_cast(float, u); }
__device__ __forceinline__ bf16_t f2bf(float f) { unsigned u = fbits(f); u += 0x7FFFu + ((u >> 16) & 1u); return (bf16_t)(u >> 16); }
__device__ __forceinline__ float bf2f(bf16_t h) { return bitsf(((unsigned)h) << 16); }
#ifdef HOST_EMU
__device__ __forceinline__ unsigned pk2(float lo, float hi) { return (unsigned)f2bf(lo) | ((unsigned)f2bf(hi) << 16); }
#else
typedef float f32x2_t __attribute__((ext_vector_type(2)));
typedef __bf16 bf16x2_t __attribute__((ext_vector_type(2)));
__device__ __forceinline__ unsigned pk2(float lo, float hi) { return __builtin_bit_cast(unsigned, __builtin_convertvector(f32x2_t{lo, hi}, bf16x2_t)); }
#endif
__device__ __forceinline__ float softplusf_(float x) { return fmaxf(x, 0.0f) + log1pf(expf(-fabsf(x))); }
#ifdef HOST_EMU
#define FEXP(x) expf(x)
#else
#define FEXP(x) __expf(x)
#endif
#ifdef HOST_EMU
__device__ __forceinline__ float frcp(float x) { return 1.0f / x; }
__device__ __forceinline__ float frsq(float x) { return 1.0f / sqrtf(x); }
__device__ __forceinline__ float fsqrt(float x) { return sqrtf(x); }
#else
__device__ __forceinline__ float frcp(float x) { return __builtin_amdgcn_rcpf(x); }
__device__ __forceinline__ float frsq(float x) { return __builtin_amdgcn_rsqf(x); }
__device__ __forceinline__ float fsqrt(float x) { return __builtin_amdgcn_sqrtf(x); }
#endif
__device__ __forceinline__ float fsigm(float x) { return frcp(1.0f + FEXP(-x)); }
__device__ __forceinline__ float siluf_(float x) { return x * fsigm(x); }
__device__ __forceinline__ float geluf_(float x) { return x * fsigm(1.5957691216057308f * (x + 0.044715f * x * x * x)); }
__device__ __forceinline__ int opaque_tid() {
    int t = threadIdx.x;
#ifndef HOST_EMU
    asm volatile("" : "+v"(t));
#endif
    return t;
}
__device__ __forceinline__ float wave_sum(float v) {
#pragma unroll
    for (int o = 1; o < 64; o <<= 1) v += __shfl_xor(v, o);
    return v;
}

constexpr size_t al256(size_t x) { return (x + 255) & ~(size_t)255; }
constexpr int NLCH = BATCH * (SEQ / 64), NCCH = BATCH * (CTX_LEN / 64), NCH = NLCH + NCCH;
constexpr size_t WS_CTRL = 0;
constexpr size_t WS_MOD = 65536;
constexpr size_t WS_STATS = al256(WS_MOD + (size_t)NMOD * 6 * D_MODEL * 4);
constexpr size_t WS_SUMA = al256(WS_STATS + (size_t)MTOT * 2 * 4);
constexpr size_t WS_SUMH = al256(WS_SUMA + (size_t)2 * NCH * D_LRU * 4);
constexpr size_t WS_CARRY = al256(WS_SUMH + (size_t)2 * NCH * D_LRU * 4);
constexpr size_t WS_SSQP = al256(WS_CARRY + (size_t)2 * NLCH * D_LRU * 4);
constexpr size_t WS_RINV = al256(WS_SSQP + (size_t)MLAT * LRU_BLOCKS * 4);
constexpr size_t WS_BON = al256(WS_RINV + (size_t)MLAT * 4);
constexpr size_t WS_AFF = al256(WS_BON + (size_t)2 * MLAT * HEADS * 4 + 4096 * 64);
constexpr size_t WS_IDX = al256(WS_AFF + (size_t)MLAT * N_EXPERTS * 4);
constexpr size_t WS_GATE = al256(WS_IDX + (size_t)BATCH * N_EXPERTS * CAP * 4);
constexpr size_t WS_SLOT = al256(WS_GATE + (size_t)BATCH * N_EXPERTS * CAP * 4);
constexpr size_t WS_WBIN = al256(WS_SLOT + (size_t)MLAT * N_EXPERTS * 4);
constexpr size_t WS_WBOUT = al256(WS_WBIN + (size_t)D_IN * D_MODEL * 2);
constexpr size_t WS_LORA = al256(WS_WBOUT + (size_t)D_MODEL * D_MIX * 2);
constexpr size_t WS_R1 = al256(WS_LORA + (size_t)2 * 2 * HEADS * 64 * 64 * 2);
constexpr size_t R1_BYTES = (size_t)MTOT * D_IN * 2 > (size_t)MLAT * D_MODEL * 4 ? ((size_t)MTOT * D_IN * 2 > (size_t)BATCH * N_EXPERTS * CAP * D_EXPERT * 2 ? (size_t)MTOT * D_IN * 2 : (size_t)BATCH * N_EXPERTS * CAP * D_EXPERT * 2)
                                                                                  : ((size_t)MLAT * D_MODEL * 4 > (size_t)BATCH * N_EXPERTS * CAP * D_EXPERT * 2 ? (size_t)MLAT * D_MODEL * 4 : (size_t)BATCH * N_EXPERTS * CAP * D_EXPERT * 2);
constexpr size_t WS_R3 = al256(WS_R1 + R1_BYTES);
constexpr int RC = 32;
constexpr int NCC = CTX_LEN / RC, NLC = SEQ / RC, NCK = NCC + NLC, NCHAIN = BATCH * HEADS * 2;
constexpr size_t CH_PM = 0, CH_SA = 8192, CH_QT = 16384, CH_Y0 = 20480, CH_BYTES = 24576;
constexpr size_t WS_CH = al256(WS_R3 + (size_t)MTOT * D_MODEL * 2);
constexpr size_t CH_TOTAL = (size_t)NCHAIN * NCK * CH_BYTES;
constexpr size_t WS_R5 = WS_CH;
constexpr size_t WS_LA = al256(WS_R5 + (size_t)MLAT * D_MODEL * 4);
constexpr size_t WS_R6 = WS_LA, WS_R2 = WS_LA;
constexpr size_t WEXP_BYTES = (size_t)D_MODEL * D_EXPERT * 2;
constexpr size_t WS_WG = al256(WS_LA + (size_t)MLAT * D_MODEL * 2);
constexpr size_t WS_WU = WS_WG + (size_t)N_EXPERTS * WEXP_BYTES;
constexpr int NE_R3 = ((size_t)MTOT * D_MODEL * 2 / WEXP_BYTES) < (size_t)N_EXPERTS ? (int)((size_t)MTOT * D_MODEL * 2 / WEXP_BYTES) : N_EXPERTS;
constexpr size_t WS_WD2 = WS_WU + (size_t)N_EXPERTS * WEXP_BYTES;
constexpr size_t WS_LATE_END = al256(WS_WD2 + (size_t)(N_EXPERTS - NE_R3) * WEXP_BYTES);
static_assert(WS_LA + (size_t)BATCH * N_EXPERTS * CAP * D_MODEL * 2 <= WS_WD2, "YS must not reach the w_down copies");
constexpr size_t WS_END = (WS_CH + CH_TOTAL > WS_LATE_END) ? al256(WS_CH + CH_TOTAL) : WS_LATE_END;
constexpr size_t WS_RBON = WS_BON;
static_assert((size_t)NCHAIN * NCK * RC * 4 <= (size_t)2 * MLAT * HEADS * 4 + 4096 * 64, "bonus buffer");

struct Params {
    const float *x, *c, *ctx, *c_ctx, *ln_in_g, *ln_in_b, *w_mod, *b_mod, *w_in, *lru_conv_w, *lru_conv_b, *lru_wa, *lru_ba, *lru_wx, *lru_bx, *lru_lam, *lru_norm_g,
        *mu_prev, *mu_next, *w0, *w2, *a0, *a2, *g2, *k_k, *k_a, *r_k, *gn_g, *gn_b, *w_out, *ln1_g, *ln1_b, *w_router, *w_gate, *w_up, *w_down, *ln2_g, *ln2_b;
    float* out;
    unsigned char* ws;
};
#define WSP(T, off) ((T*)(p.ws + (off)))
__device__ __forceinline__ size_t wdown_off(int e) { return e < NE_R3 ? WS_R3 + (size_t)e * WEXP_BYTES : WS_WD2 + (size_t)(e - NE_R3) * WEXP_BYTES; }

constexpr int SMEM_BYTES = 76 * 1024;

__device__ __forceinline__ f32x4 ld4(const float* p) { return *(const f32x4*)p; }
__device__ __forceinline__ f32x4 ldb4(const bf16_t* p) { const U2 u = *(const U2*)p; return f32x4{bitsf(u.x << 16), bitsf(u.x & 0xFFFF0000u), bitsf(u.y << 16), bitsf(u.y & 0xFFFF0000u)}; }
__device__ __forceinline__ float hsum4(f32x4 v) { return (v[0] + v[1]) + (v[2] + v[3]); }
__device__ __forceinline__ U2 pack4(f32x4 v) { U2 o; o.x = pk2(v[0], v[1]); o.y = pk2(v[2], v[3]); return o; }
__device__ __forceinline__ void convert_transpose(const float* src, bf16_t* dst, int K, int N, int t0, int t1, int tstride, char* smem) {
    float* T = (float*)smem;
    const int tid = opaque_tid(), r = tid >> 4, c4 = (tid & 15) * 4, ntn = N / 64;
    f32x4 v[4];
    if (t0 < t1) { const int kt = t0 / ntn, nt = t0 % ntn;
#pragma unroll
        for (int j = 0; j < 4; ++j) v[j] = ld4(src + (size_t)(kt * 64 + r + 16 * j) * N + nt * 64 + c4); }
    for (int t = t0; t < t1; t += tstride) {
        const int kt = t / ntn, nt = t % ntn;
        __syncthreads();
#pragma unroll
        for (int j = 0; j < 4; ++j) { float* d = T + (r + 16 * j) * 65 + c4; d[0] = v[j][0]; d[1] = v[j][1]; d[2] = v[j][2]; d[3] = v[j][3]; }
        __syncthreads();
        if (t + tstride < t1) { const int kt2 = (t + tstride) / ntn, nt2 = (t + tstride) % ntn;
#pragma unroll
            for (int j = 0; j < 4; ++j) v[j] = ld4(src + (size_t)(kt2 * 64 + r + 16 * j) * N + nt2 * 64 + c4); }
        const int n = tid >> 2, kc = (tid & 3) * 16;
        u32x4 o0, o1;
#pragma unroll
        for (int i = 0; i < 4; ++i) { o0[i] = pk2(T[(kc + 2 * i) * 65 + n], T[(kc + 2 * i + 1) * 65 + n]); o1[i] = pk2(T[(kc + 8 + 2 * i) * 65 + n], T[(kc + 9 + 2 * i) * 65 + n]); }
        bf16_t* d = dst + (size_t)(nt * 64 + n) * K + kt * 64 + kc;
        *(u32x4*)d = o0; *(u32x4*)(d + 8) = o1;
    }
    __syncthreads();
}
__device__ void convert_experts(const Params& p, int vb, int nvb, char* smem, int first, int last) {
    constexpr int TPM = (D_MODEL / 64) * (D_EXPERT / 64);
    int m = 0;
    for (int e = 0; e < N_EXPERTS; ++e)
        for (int which = first; which < last; ++which, ++m) {
            const float* src = (which == 0 ? p.w_gate : which == 1 ? p.w_up : p.w_down) + (size_t)e * D_MODEL * D_EXPERT;
            bf16_t* dst = which == 0 ? WSP(bf16_t, WS_WG + (size_t)e * WEXP_BYTES) : which == 1 ? WSP(bf16_t, WS_WU + (size_t)e * WEXP_BYTES) : WSP(bf16_t, wdown_off(e));
            const int K = which == 2 ? D_EXPERT : D_MODEL, N = which == 2 ? D_MODEL : D_EXPERT;
            const int start = ((vb - (m * TPM) % nvb) % nvb + nvb) % nvb;
            convert_transpose(src, dst, K, N, start, TPM, nvb, smem);
        }
}

__device__ __forceinline__ void phaseA(const Params& p, int bid, int nblk, char* smem) {
    float* sc = (float*)smem;
    float* red = sc + NMOD * D_MODEL;
    const int tid = opaque_tid();
    constexpr int NA = 6 * D_MODEL / 16;
    {
        const bool spare = nblk > NA + 32;
        const int vb = spare ? bid - NA : bid, nvb = spare ? nblk - NA : nblk;
        if (!spare || bid >= NA) {
            constexpr int T1 = (D_MODEL / 64) * (D_IN / 64), T2 = (D_MIX / 64) * (D_MODEL / 64);
            convert_transpose(p.w_in, WSP(bf16_t, WS_WBIN), D_MODEL, D_IN, vb, T1, nvb, smem);
            convert_transpose(p.w_out, WSP(bf16_t, WS_WBOUT), D_MIX, D_MODEL, ((vb - T1 % nvb) % nvb + nvb) % nvb, T2, nvb, smem);
            for (int idx = vb * 256 + tid; idx < 2 * 2 * HEADS * 64 * 64; idx += nvb * 256) {
                const int i = idx & 63, j = (idx >> 6) & 63, hh = (idx >> 12) % HEADS, which = (idx >> 12) / HEADS % 2, dd = (idx >> 12) / HEADS / 2;
                WSP(bf16_t, WS_LORA)[idx] = f2bf((which ? p.a2 : p.w2)[((size_t)dd * 64 + i) * D_RWKV + hh * 64 + j]);
            }
        }
        if (spare && bid >= NA) return;
    }
    if (bid >= NA) return;
    __syncthreads();
    for (int i = tid; i < NMOD * D_MODEL; i += 256) {
        const int r = i / D_MODEL, k = i % D_MODEL;
        const float v = (r < BATCH) ? p.c[r * D_MODEL + k] : p.c_ctx[k];
        sc[i] = siluf_(v);
    }
    __syncthreads();
    float* MOD = WSP(float, WS_MOD);
    const int col = tid & 15, kg = tid >> 4;
    constexpr int KPT = D_MODEL / 16;
    for (int cb = bid; cb < 6 * D_MODEL / 16; cb += nblk) {
        const int n = cb * 16 + col;
        float acc[NMOD];
#pragma unroll
        for (int r = 0; r < NMOD; ++r) acc[r] = 0.f;
        const float* wp = p.w_mod + (size_t)(kg * KPT) * (6 * D_MODEL) + n;
#pragma unroll 16
        for (int kk = 0; kk < KPT; ++kk) {
            const float w = wp[(size_t)kk * (6 * D_MODEL)];
#pragma unroll
            for (int r = 0; r < NMOD; ++r) acc[r] += sc[r * D_MODEL + kg * KPT + kk] * w;
        }
#pragma unroll
        for (int r = 0; r < NMOD; ++r) red[(kg * NMOD + r) * 16 + col] = acc[r];
        __syncthreads();
        if (tid < NMOD * 16) {
            const int r = tid >> 4, c2 = tid & 15;
            float s2 = p.b_mod[cb * 16 + c2];
#pragma unroll
            for (int g = 0; g < 16; ++g) s2 += red[(g * NMOD + r) * 16 + c2];
            MOD[(size_t)r * 6 * D_MODEL + cb * 16 + c2] = s2;
        }
        __syncthreads();
    }
}

constexpr int NV = D_MODEL / 256;
__device__ __forceinline__ void phaseB(const Params& p, int bid, int nblk, char* smem) {
    const int tid_ = opaque_tid(), lane = tid_ & 63, wave = tid_ >> 6;
    const float* MOD = WSP(float, WS_MOD);
    float* STATS = WSP(float, WS_STATS);
    bf16_t* U = WSP(bf16_t, WS_R3);
    auto rowptr = [&](int row) { return (row < MLAT) ? p.x + (size_t)row * D_MODEL : p.ctx + (size_t)(row - MLAT) * D_MODEL; };
    int row = bid * 4 + wave;
    f32x4 n0 = f32x4{0.f, 0.f, 0.f, 0.f}, n1 = n0, n2 = n0, n3 = n0;
    if (row < MTOT) { const float* xr = rowptr(row); n0 = ld4(xr + lane * 4); if (NV > 1) n1 = ld4(xr + 256 + lane * 4); if (NV > 2) { n2 = ld4(xr + 512 + lane * 4); n3 = ld4(xr + 768 + lane * 4); } }
    for (; row < MTOT; row += nblk * 4) {
        const int mr = (row < MLAT) ? row / SEQ : BATCH;
        const float* md = MOD + (size_t)mr * 6 * D_MODEL;
        f32x4 v0 = n0, v1 = n1, v2 = n2, v3 = n3;
        const int nrow = row + nblk * 4;
        if (nrow < MTOT) { const float* xr = rowptr(nrow); n0 = ld4(xr + lane * 4); if (NV > 1) n1 = ld4(xr + 256 + lane * 4); if (NV > 2) { n2 = ld4(xr + 512 + lane * 4); n3 = ld4(xr + 768 + lane * 4); } }
        float s = hsum4(v0);
        if (NV > 1) s += hsum4(v1);
        if (NV > 2) s += hsum4(v2) + hsum4(v3);
        const float mu = wave_sum(s) * (1.0f / D_MODEL);
        v0 -= mu; float s2 = hsum4(v0 * v0);
        if (NV > 1) { v1 -= mu; s2 += hsum4(v1 * v1); }
        if (NV > 2) { v2 -= mu; v3 -= mu; s2 += hsum4(v2 * v2) + hsum4(v3 * v3); }
        const float rstd = frsq(wave_sum(s2) * (1.0f / D_MODEL) + LN_EPS);
        if (lane == 0) { STATS[row * 2] = mu; STATS[row * 2 + 1] = rstd; }
#pragma unroll
        for (int j = 0; j < NV; ++j) {
            const int k = j * 256 + lane * 4;
            const f32x4 vv = (j == 0) ? v0 : (j == 1) ? v1 : (j == 2) ? v2 : v3;
            const f32x4 h = vv * rstd * ld4(p.ln_in_g + k) + ld4(p.ln_in_b + k);
            *(U2*)(U + (size_t)row * D_MODEL + k) = pack4(h * (1.0f + ld4(md + D_MODEL + k)) + ld4(md + k));
        }
    }
}

constexpr int LDK = 64;
template <int MI, bool DUAL, class Epi>
__device__ __forceinline__ void gemm_tile(char* smem, const bf16_t* A, int lda, const int* rowidx, int m0, const bf16_t* Bt0, const bf16_t* Bt1, int ldb, int n0, int K, Epi epi, const float* rowscale = nullptr, int kscale = 0) {
    constexpr int BM = 32 * MI;
    bf16_t* As = (bf16_t*)smem;
    bf16_t* Bs = As + BM * LDK;
    int tid = threadIdx.x;
#ifndef HOST_EMU
    asm volatile("" : "+v"(tid));
#endif
    const int lane = tid & 63, wave = tid >> 6, wr = wave >> 1, wc = wave & 1, l15 = lane & 15, q = lane >> 4;
    const int ch = tid & 7, r0 = tid >> 3;
    unsigned aoff[MI], boff[4];
#pragma unroll
    for (int j = 0; j < MI; ++j) { const int r = m0 + r0 + 32 * j; aoff[j] = (unsigned)(rowidx ? rowidx[r] : r) * (unsigned)lda + ch * 8; }
#pragma unroll
    for (int j = 0; j < 4; ++j) boff[j] = (unsigned)(n0 + (DUAL ? (j >> 1) * 32 + r0 : r0 + 32 * j)) * (unsigned)ldb + ch * 8;
    const int wofs = r0 * LDK + ((ch ^ (r0 & 7)) * 8);
    u32x4 ar[MI], br[4];
    f32x4 acc[MI][4];
#pragma unroll
    for (int i = 0; i < MI; ++i)
#pragma unroll
        for (int j = 0; j < 4; ++j) acc[i][j] = f32x4{0.f, 0.f, 0.f, 0.f};
    const int nk = K / 64;
#pragma unroll
    for (int j = 0; j < MI; ++j) ar[j] = *(const u32x4*)(A + aoff[j]);
#pragma unroll
    for (int j = 0; j < 4; ++j) br[j] = *(const u32x4*)(((DUAL && (j & 1)) ? Bt1 : Bt0) + boff[j]);
    for (int kt = 0; kt < nk; ++kt) {
        __syncthreads();
#pragma unroll
        for (int j = 0; j < MI; ++j) *(u32x4*)(As + wofs + 32 * j * LDK) = ar[j];
#pragma unroll
        for (int j = 0; j < 4; ++j) *(u32x4*)(Bs + wofs + 32 * j * LDK) = br[j];
        __syncthreads();
        if (kt + 1 < nk) {
            const int ko = (kt + 1) * 64;
#pragma unroll
            for (int j = 0; j < MI; ++j) ar[j] = *(const u32x4*)(A + aoff[j] + ko);
#pragma unroll
            for (int j = 0; j < 4; ++j) br[j] = *(const u32x4*)(((DUAL && (j & 1)) ? Bt1 : Bt0) + boff[j] + ko);
        }
#pragma unroll
        for (int ks = 0; ks < 2; ++ks) {
            const int cofs = ((ks * 4 + q) ^ (l15 & 7)) * 8;
            bf16x8 bfr[4];
#pragma unroll
            for (int ni = 0; ni < 4; ++ni) bfr[ni] = *(const bf16x8*)(Bs + (wc * 64 + ni * 16 + l15) * LDK + cofs);
#pragma unroll
            for (int mi = 0; mi < MI; ++mi) {
                const bf16x8 af = *(const bf16x8*)(As + (wr * (16 * MI) + mi * 16 + l15) * LDK + cofs);
#pragma unroll
                for (int ni = 0; ni < 4; ++ni) acc[mi][ni] = MFMA16(bfr[ni], af, acc[mi][ni]);
            }
        }
        if (rowscale && kt + 1 == kscale) {
#pragma unroll
            for (int mi = 0; mi < MI; ++mi) {
                const float rs = rowscale[m0 + wr * (16 * MI) + mi * 16 + l15];
#pragma unroll
                for (int ni = 0; ni < 4; ++ni) acc[mi][ni] *= rs;
            }
        }
    }
#pragma unroll
    for (int mi = 0; mi < MI; ++mi) {
        const int ml = wr * (16 * MI) + mi * 16 + l15;
        if (DUAL) {
#pragma unroll
            for (int ni = 0; ni < 2; ++ni) epi(ml, wc * 32 + ni * 16 + q * 4, acc[mi][ni], acc[mi][ni + 2]);
        } else {
#pragma unroll
            for (int ni = 0; ni < 4; ++ni) epi(ml, wc * 64 + ni * 16 + q * 4, acc[mi][ni], acc[mi][ni]);
        }
    }
    __syncthreads();
}

__device__ __forceinline__ int xcd_vbid(int bid, int nblk) { return (nblk % 8 == 0) ? (bid % 8) * (nblk / 8) + bid / 8 : bid; }
constexpr int MI_C = (MTOT % 256 == 0) ? 8 : 4, MI_J = (MLAT % 256 == 0) ? 8 : 4, MI_E = (CAP % 256 == 0) ? 8 : 4;
__device__ __forceinline__ void phaseC(const Params& p, int bid, int nblk, char* smem) {
    const bf16_t* U = WSP(bf16_t, WS_R3); const bf16_t* WB = WSP(bf16_t, WS_WBIN);
    bf16_t* P = WSP(bf16_t, WS_R1);
    constexpr int BM = 32 * MI_C, NTN = D_IN / 128, NTM = MTOT / BM;
    constexpr int GM = (NTM % 8 == 0) ? 8 : (NTM % 4 == 0) ? 4 : 1;
    for (int it = xcd_vbid(bid, nblk); it < NTN * NTM; it += nblk) {
        const int mg = it / (GM * NTN), r = it % (GM * NTN), nt = r / GM, mt = mg * GM + (r % GM);
        gemm_tile<MI_C, false>(smem, U, D_MODEL, nullptr, mt * BM, WB, nullptr, D_MODEL, nt * 128, D_MODEL, [&](int ml, int nl, f32x4 v, f32x4) {
            *(U2*)(P + (size_t)(mt * BM + ml) * D_IN + nt * 128 + nl) = pack4(v);
        });
    }
}


template <int NYT, int KS>
__device__ __forceinline__ void mmT(f32x4* acc, const bf16_t* X, int ldx, int xs, const bf16_t* Y, int ldy, int lane) {
#pragma unroll
    for (int ks = 0; ks < KS; ++ks) {
        const bf16x8 xf = *(const bf16x8*)(X + (xs * 16 + (lane & 15)) * ldx + ks * 32 + 8 * (lane >> 4));
#pragma unroll
        for (int nb = 0; nb < NYT; ++nb) {
            const bf16x8 yf = *(const bf16x8*)(Y + (nb * 16 + (lane & 15)) * ldy + ks * 32 + 8 * (lane >> 4));
            acc[nb] = MFMA16(xf, yf, acc[nb]);
        }
    }
}

struct SeqChunk { int base_row; int t0; int len; };
__device__ __forceinline__ SeqChunk lru_chunk(int cg) {
    SeqChunk s;
    if (cg < NLCH) { const int b = cg / (SEQ / 64), ck = cg % (SEQ / 64); s.base_row = b * SEQ; s.t0 = ck * 64; s.len = SEQ; }
    else { const int c2 = cg - NLCH; const int b = c2 / (CTX_LEN / 64), ck = c2 % (CTX_LEN / 64); s.base_row = MLAT + b * CTX_LEN; s.t0 = ck * 64; s.len = CTX_LEN; }
    return s;
}
constexpr int L_XIN = 0;
constexpr int L_GT = 8704;
constexpr int L_XB = L_GT + 9216;
constexpr int L_WT = L_XB + 9216;
constexpr int L_CP = L_WT + 36864;
constexpr int L_END = L_CP + 4096;
static_assert(L_END <= SMEM_BYTES, "lru lds");
__device__ __forceinline__ void lru_load_w(const Params& p, char* smem, int cb) {
    bf16_t* WT = (bf16_t*)(smem + L_WT);
    const int tid = opaque_tid();
    for (int idx = tid; idx < 4 * 64 * 16; idx += 256) {
        const int m = idx >> 10, i = (idx >> 4) & 63, j4 = (idx & 15) * 4, d = m >> 1;
        const f32x4 w = ld4(((m & 1) ? p.lru_wx : p.lru_wa) + ((size_t)(d * LRU_BLOCKS + cb) * 64 + i) * 64 + j4);
        bf16_t* dst = WT + (m * 64 + j4) * 72 + i;
        dst[0] = f2bf(w[0]); dst[72] = f2bf(w[1]); dst[144] = f2bf(w[2]); dst[216] = f2bf(w[3]);
    }
}
struct LruConst { float ba[2][4], bx[2][4], sp8[2][4], gn[4], cw[4], cb0; };
__device__ __forceinline__ void lru_consts(const Params& p, int cb, LruConst& K) {
    const int l15 = threadIdx.x & 15, c = threadIdx.x & 63, ch = cb * 64 + c;
#pragma unroll
    for (int d = 0; d < 2; ++d)
#pragma unroll
        for (int nb = 0; nb < 4; ++nb) { const int cc = d * D_LRU + cb * 64 + nb * 16 + l15; K.ba[d][nb] = p.lru_ba[cc]; K.bx[d][nb] = p.lru_bx[cc]; K.sp8[d][nb] = -8.0f * softplusf_(-p.lru_lam[cc]); }
#pragma unroll
    for (int nb = 0; nb < 4; ++nb) K.gn[nb] = p.lru_norm_g[cb * 64 + nb * 16 + l15];
#pragma unroll
    for (int j = 0; j < 4; ++j) K.cw[j] = p.lru_conv_w[j * D_LRU + ch];
    K.cb0 = p.lru_conv_b[ch];
}
struct LruStage { u32x4 x[3]; u32x4 g[2]; };
template <bool FINAL>
__device__ __forceinline__ void lru_stage_load(const Params& p, int cg, int cb, LruStage& S) {
    const bf16_t* P = WSP(bf16_t, WS_R1);
    const SeqChunk sc = lru_chunk(cg);
    const int tid = opaque_tid();
#pragma unroll
    for (int k = 0; k < 3; ++k) {
        const int idx = tid + 256 * k, tt = idx >> 3, c8 = (idx & 7) * 8, t = sc.t0 - 1 + tt;
        S.x[k] = u32x4{0u, 0u, 0u, 0u};
        if (idx < 67 * 8 && t >= 0 && t < sc.len) S.x[k] = *(const u32x4*)(P + (size_t)(sc.base_row + t) * D_IN + cb * 64 + c8);
    }
    if (FINAL) {
#pragma unroll
        for (int k = 0; k < 2; ++k) { const int idx = tid + 256 * k, tt = idx >> 3, c8 = (idx & 7) * 8; S.g[k] = *(const u32x4*)(P + (size_t)(sc.base_row + sc.t0 + tt) * D_IN + D_LRU + cb * 64 + c8); }
    }
}
template <bool FINAL>
__device__ __forceinline__ void lru_item(const Params& p, char* smem, int cg, int cb, const LruConst& K, LruStage& S, int cg_next) {
    const bf16_t* P = WSP(bf16_t, WS_R1);
    bf16_t* XIN = (bf16_t*)(smem + L_XIN); bf16_t* GT = (bf16_t*)(smem + L_GT); bf16_t* XB = (bf16_t*)(smem + L_XB); const bf16_t* WT = (const bf16_t*)(smem + L_WT);
    float* CP = (float*)(smem + L_CP);
    const int tid = opaque_tid(), lane = tid & 63, wave = tid >> 6, q = lane >> 4, l15 = lane & 15;
    const SeqChunk sc = lru_chunk(cg);
    __syncthreads();
#pragma unroll
    for (int k = 0; k < 3; ++k) { const int idx = tid + 256 * k, tt = idx >> 3, c8 = (idx & 7) * 8; if (idx < 67 * 8) *(u32x4*)(XIN + tt * 64 + c8) = S.x[k]; }
    if (FINAL) {
#pragma unroll
        for (int k = 0; k < 2; ++k) { const int idx = tid + 256 * k, tt = idx >> 3, c8 = (idx & 7) * 8; *(u32x4*)(GT + tt * 72 + c8) = S.g[k]; }
    }
    if (cg_next >= 0) lru_stage_load<FINAL>(p, cg_next, cb, S);
    __syncthreads();
    {
        const int c = tid & 63;
#pragma unroll 4
        for (int tt = tid >> 6; tt < 64; tt += 4)
            XB[tt * 72 + c] = f2bf(K.cb0 + bf2f(XIN[tt * 64 + c]) * K.cw[0] + bf2f(XIN[(tt + 1) * 64 + c]) * K.cw[1] + bf2f(XIN[(tt + 2) * 64 + c]) * K.cw[2] + bf2f(XIN[(tt + 3) * 64 + c]) * K.cw[3]);
    }
    __syncthreads();
    float hs[4][4];
    float av[4][4], bv[4][4];
#pragma unroll
    for (int d = 0; d < 2; ++d) {
        f32x4 ga[4], gx[4];
#pragma unroll
        for (int nb = 0; nb < 4; ++nb) { ga[nb] = f32x4{0.f, 0.f, 0.f, 0.f}; gx[nb] = f32x4{0.f, 0.f, 0.f, 0.f}; }
        mmT<4, 2>(ga, XB, 72, wave, WT + (2 * d) * 64 * 72, 72, lane);
        mmT<4, 2>(gx, XB, 72, wave, WT + (2 * d + 1) * 64 * 72, 72, lane);
        float cA[4], cH[4];
#pragma unroll
        for (int nb = 0; nb < 4; ++nb) {
            const float ba = K.ba[d][nb], bx = K.bx[d][nb], sp8 = K.sp8[d][nb];
#pragma unroll
            for (int r = 0; r < 4; ++r) {
                const float rg = fsigm(ga[nb][r] + ba), ig = fsigm(gx[nb][r] + bx);
                const float a = FEXP(sp8 * rg);
                const float xv = bf2f(XB[(wave * 16 + q * 4 + r) * 72 + nb * 16 + l15]);
                av[nb][r] = a; bv[nb][r] = fsqrt(fmaxf(1.0f - a * a, 0.f)) * ig * xv;
            }
            float A, H;
            if (d == 0) { A = av[nb][0]; H = bv[nb][0];
#pragma unroll
                for (int r = 1; r < 4; ++r) { H = H * av[nb][r] + bv[nb][r]; A *= av[nb][r]; } }
            else { A = av[nb][3]; H = bv[nb][3];
#pragma unroll
                for (int r = 2; r >= 0; --r) { H = H * av[nb][r] + bv[nb][r]; A *= av[nb][r]; } }
#pragma unroll
            for (int st = 1; st <= 2; st <<= 1) {
                const float pA = d == 0 ? __shfl_up(A, 16 * st) : __shfl_down(A, 16 * st), pH = d == 0 ? __shfl_up(H, 16 * st) : __shfl_down(H, 16 * st);
                const bool has = d == 0 ? (q >= st) : (q + st <= 3);
                if (has) { H = pH * A + H; A = pA * A; }
            }
            cA[nb] = A; cH[nb] = H;
            const bool last = d == 0 ? (q == 3) : (q == 0);
            if (last) { CP[((d * 4 + wave) * 64 + nb * 16 + l15) * 2] = A; CP[((d * 4 + wave) * 64 + nb * 16 + l15) * 2 + 1] = H; }
        }
        __syncthreads();
        if (!FINAL) {
            if (wave == 0 && q == 0) {
#pragma unroll
                for (int nb = 0; nb < 4; ++nb) {
                    const int c = nb * 16 + l15;
                    float A = 1.f, H = 0.f;
#pragma unroll
                    for (int w = 0; w < 4; ++w) { const int ww = d == 0 ? w : 3 - w; const float wa = CP[((d * 4 + ww) * 64 + c) * 2], wh = CP[((d * 4 + ww) * 64 + c) * 2 + 1]; H = H * wa + wh; A *= wa; }
                    WSP(float, WS_SUMA)[((size_t)d * NCH + cg) * D_LRU + cb * 64 + c] = A;
                    WSP(float, WS_SUMH)[((size_t)d * NCH + cg) * D_LRU + cb * 64 + c] = H;
                }
            }
        } else {
#pragma unroll
            for (int nb = 0; nb < 4; ++nb) {
                const int c = nb * 16 + l15;
                float h = WSP(float, WS_CARRY)[((size_t)d * NLCH + cg) * D_LRU + cb * 64 + c];
#pragma unroll
                for (int w = 0; w < 3; ++w) { const int ww = d == 0 ? w : 3 - w; const bool use = d == 0 ? (ww < wave) : (ww > wave);
                    if (use) h = h * CP[((d * 4 + ww) * 64 + c) * 2] + CP[((d * 4 + ww) * 64 + c) * 2 + 1]; }
                const float eA = d == 0 ? __shfl_up(cA[nb], 16) : __shfl_down(cA[nb], 16), eH = d == 0 ? __shfl_up(cH[nb], 16) : __shfl_down(cH[nb], 16);
                const bool first = d == 0 ? (q == 0) : (q == 3);
                if (!first) h = h * eA + eH;
                if (d == 0) {
#pragma unroll
                    for (int r = 0; r < 4; ++r) { h = h * av[nb][r] + bv[nb][r]; hs[nb][r] = h; }
                } else {
#pragma unroll
                    for (int r = 3; r >= 0; --r) { h = h * av[nb][r] + bv[nb][r]; hs[nb][r] += h; }
                }
            }
        }
        __syncthreads();
    }
    if (FINAL) {
        float ss[4] = {0.f, 0.f, 0.f, 0.f};
#pragma unroll
        for (int nb = 0; nb < 4; ++nb) {
            const float gn = K.gn[nb];
#pragma unroll
            for (int r = 0; r < 4; ++r) {
                const int tt = wave * 16 + q * 4 + r;
                const float v = hs[nb][r] * geluf_(bf2f(GT[tt * 72 + nb * 16 + l15]));
                ss[r] += v * v;
                XB[tt * 72 + nb * 16 + l15] = f2bf(v * gn);
            }
        }
#pragma unroll
        for (int r = 0; r < 4; ++r) {
#pragma unroll
            for (int o = 1; o < 16; o <<= 1) ss[r] += __shfl_xor(ss[r], o);
            if (l15 == 0) WSP(float, WS_SSQP)[(size_t)(sc.base_row + sc.t0 + wave * 16 + q * 4 + r) * LRU_BLOCKS + cb] = ss[r];
        }
        __syncthreads();
        bf16_t* MIX = WSP(bf16_t, WS_R3);
        for (int idx = tid; idx < 64 * 8; idx += 256) {
            const int tt = idx >> 3, c8 = (idx & 7) * 8;
            *(u32x4*)(MIX + (size_t)(sc.base_row + sc.t0 + tt) * D_MIX + cb * 64 + c8) = *(const u32x4*)(XB + tt * 72 + c8);
        }
    }
}
__device__ __forceinline__ void phaseD(const Params& p, int bid, int nblk, char* smem) {
    int cur = -1; LruConst K; LruStage S;
    for (int it = bid; it < NCH * LRU_BLOCKS; it += nblk) {
        const int cb = it % LRU_BLOCKS, cg = it / LRU_BLOCKS;
        if (cb != cur) { __syncthreads(); lru_load_w(p, smem, cb); lru_consts(p, cb, K); lru_stage_load<false>(p, cg, cb, S); cur = cb; }
        const int itn = it + nblk;
        lru_item<false>(p, smem, cg, cb, K, S, (itn < NCH * LRU_BLOCKS && itn % LRU_BLOCKS == cb) ? itn / LRU_BLOCKS : -1);
        if (itn < NCH * LRU_BLOCKS && itn % LRU_BLOCKS != cb) cur = -1;
    }
}
__device__ __forceinline__ void phaseE(const Params& p, int bid, int nblk, char* smem) {
    const float* SUMA = WSP(float, WS_SUMA); const float* SUMH = WSP(float, WS_SUMH); float* CARRY = WSP(float, WS_CARRY);
    constexpr int NLB = SEQ / 64, NCB = CTX_LEN / 64;
    for (int g = bid * 256 + threadIdx.x; g < BATCH * 2 * D_LRU; g += nblk * 256) {
        const int c = g % D_LRU, d = (g / D_LRU) & 1, b = g / (2 * D_LRU);
        const float* sa = SUMA + (size_t)d * NCH * D_LRU + c; const float* sh = SUMH + (size_t)d * NCH * D_LRU + c;
        float* cr = CARRY + (size_t)d * NLCH * D_LRU + c;
        float h = 0.f;
        if (d == 0) {
            for (int q2 = 0; q2 < NCB; ++q2) { const int gi = NLCH + b * NCB + q2; h = sa[(size_t)gi * D_LRU] * h + sh[(size_t)gi * D_LRU]; }
            for (int q2 = 0; q2 < NLB; ++q2) { const int gi = b * NLB + q2; cr[(size_t)gi * D_LRU] = h; h = sa[(size_t)gi * D_LRU] * h + sh[(size_t)gi * D_LRU]; }
        } else {
            for (int q2 = NCB - 1; q2 >= 0; --q2) { const int gi = NLCH + b * NCB + q2; h = sa[(size_t)gi * D_LRU] * h + sh[(size_t)gi * D_LRU]; }
            for (int q2 = NLB - 1; q2 >= 0; --q2) { const int gi = b * NLB + q2; cr[(size_t)gi * D_LRU] = h; h = sa[(size_t)gi * D_LRU] * h + sh[(size_t)gi * D_LRU]; }
        }
    }
}
__device__ __forceinline__ void phaseF(const Params& p, int bid, int nblk, char* smem) {
    int cur = -1; LruConst K; LruStage S;
    for (int it = bid; it < NLCH * LRU_BLOCKS; it += nblk) {
        const int cb = it % LRU_BLOCKS, cg = it / LRU_BLOCKS;
        if (cb != cur) { __syncthreads(); lru_load_w(p, smem, cb); lru_consts(p, cb, K); lru_stage_load<true>(p, cg, cb, S); cur = cb; }
        const int itn = it + nblk;
        lru_item<true>(p, smem, cg, cb, K, S, (itn < NLCH * LRU_BLOCKS && itn % LRU_BLOCKS == cb) ? itn / LRU_BLOCKS : -1);
        if (itn < NLCH * LRU_BLOCKS && itn % LRU_BLOCKS != cb) cur = -1;
    }
}

__device__ __forceinline__ size_t rwkv_row(int seg, int b, int s) {
    if (seg == 0) return (size_t)(MLAT + b * CTX_LEN + s);
    const int r = s % ROWS, c = s / ROWS;
    return (size_t)(b * SEQ + r * GRID_W + c);
}
__device__ __forceinline__ void chunk_info(int d, int c, int& seg, int& p0, int& len) {
    if (c < NCC) { seg = 0; len = CTX_LEN; p0 = (d == 0 ? c : NCC - 1 - c) * RC; }
    else { const int cc = c - NCC; seg = 1; len = SEQ; p0 = (d == 0 ? cc : NLC - 1 - cc) * RC; }
}
__device__ __forceinline__ void unpack8(const u32x4 v, float* o) {
    o[0] = bitsf(v[0] << 16); o[1] = bitsf(v[0] & 0xFFFF0000u); o[2] = bitsf(v[1] << 16); o[3] = bitsf(v[1] & 0xFFFF0000u);
    o[4] = bitsf(v[2] << 16); o[5] = bitsf(v[2] & 0xFFFF0000u); o[6] = bitsf(v[3] << 16); o[7] = bitsf(v[3] & 0xFFFF0000u);
}
__device__ __forceinline__ void shifted8(const Params& p, const bf16_t* P, int seg, int b, int pos, int len, int ch0, float* o) {
    float z[8], zp[8], zn[8];
    unpack8(*(const u32x4*)(P + rwkv_row(seg, b, pos) * D_IN + RW0 + ch0), z);
    if (pos > 0) unpack8(*(const u32x4*)(P + rwkv_row(seg, b, pos - 1) * D_IN + RW0 + ch0), zp); else { for (int i = 0; i < 8; ++i) zp[i] = 0.f; }
    if (pos < len - 1) unpack8(*(const u32x4*)(P + rwkv_row(seg, b, pos + 1) * D_IN + RW0 + ch0), zn); else { for (int i = 0; i < 8; ++i) zn[i] = 0.f; }
    const f32x4 mp0 = ld4(p.mu_prev + ch0), mp1 = ld4(p.mu_prev + ch0 + 4), mn0 = ld4(p.mu_next + ch0), mn1 = ld4(p.mu_next + ch0 + 4);
#pragma unroll
    for (int i = 0; i < 4; ++i) { o[i] = z[i] + mp0[i] * (zp[i] - z[i]) + mn0[i] * (zn[i] - z[i]); o[4 + i] = z[4 + i] + mp1[i] * (zp[4 + i] - z[4 + i]) + mn1[i] * (zn[4 + i] - z[4 + i]); }
}
constexpr int LT = 72, LJ = 40;
constexpr int R_RF = 0, R_KF = 8192, R_VF = 16384, R_LW = 24576, R_IC = 32768;
constexpr int R_NKA = 0, R_MBR = 2560, R_MKR = 5120;
constexpr int R_XU = 7680;
constexpr int R_IA = R_XU + 8448, R_IB = R_IA + 4608, R_PA = R_IB + 4608, R_PB = R_PA + 4608;
constexpr int R_WA = R_IB, R_U0 = R_WA + 5120;
static_assert(R_U0 + 5120 <= R_PB + 4608 && R_PB + 4608 <= 40960, "rwkv scratch");
constexpr int R_O = 40960;
constexpr int R_AH = R_O, R_BH = R_AH + 4608, R_KH = R_BH + 4608, R_RH = R_KH + 4608;
constexpr int R_VT = R_RH + 4608, R_BHT = R_VT + 5120, R_KHT = R_BHT + 5120;
constexpr int R_GC = R_KHT + 5120, R_TOT = R_GC + 256, R_PS = R_TOT + 1024, R_END = R_PS + 1024;
constexpr int R_TW = R_O, R_TA = R_TW + 4608, R_W2T = R_TA + 4608, R_A2T = R_W2T + 9216;
static_assert(R_A2T + 9216 <= R_END && R_END <= SMEM_BYTES, "rwkv lds");

__device__ __forceinline__ void phaseR1(const Params& p, int bid, int nblk, char* smem) {
    const bf16_t* P = WSP(bf16_t, WS_R1);
    unsigned char* CH = p.ws + WS_CH;
    float* RBON = WSP(float, WS_RBON);
    float* Rf = (float*)(smem + R_RF); float* Kf = (float*)(smem + R_KF); float* Vf = (float*)(smem + R_VF); float* LW = (float*)(smem + R_LW); float* IC = (float*)(smem + R_IC);
    float* IA = (float*)(smem + R_IA); float* IB = (float*)(smem + R_IB); float* PA = (float*)(smem + R_PA); float* PB = (float*)(smem + R_PB); bf16_t* NkaT = (bf16_t*)(smem + R_NKA); bf16_t* MbrT = (bf16_t*)(smem + R_MBR); bf16_t* MkrT = (bf16_t*)(smem + R_MKR);
    float* Xu = (float*)(smem + R_XU); bf16_t* Wa = (bf16_t*)(smem + R_WA); bf16_t* U0 = (bf16_t*)(smem + R_U0);
    bf16_t* Ah = (bf16_t*)(smem + R_AH); bf16_t* Bh = (bf16_t*)(smem + R_BH); bf16_t* Kh = (bf16_t*)(smem + R_KH); bf16_t* Rh = (bf16_t*)(smem + R_RH);
    bf16_t* VT = (bf16_t*)(smem + R_VT); bf16_t* BhT = (bf16_t*)(smem + R_BHT); bf16_t* KhT = (bf16_t*)(smem + R_KHT);
    float* GC = (float*)(smem + R_GC); float* TOT = (float*)(smem + R_TOT); float* PS = (float*)(smem + R_PS);
    bf16_t* TW = (bf16_t*)(smem + R_TW); bf16_t* TA = (bf16_t*)(smem + R_TA); bf16_t* W2T = (bf16_t*)(smem + R_W2T); bf16_t* A2T = (bf16_t*)(smem + R_A2T);
    constexpr int NITEM = NCHAIN * NCK;
    const int per = (NITEM + nblk - 1) / nblk;
    const int it0 = bid * per, it1 = (it0 + per < NITEM) ? it0 + per : NITEM;
    for (int it = it0; it < it1; ++it) {
        const int tid = opaque_tid(), lane = tid & 63, wave = tid >> 6, q = lane >> 4, l15 = lane & 15;
        const int chain = it / NCK, c = it % NCK;
        const int d = chain & 1, h = (chain >> 1) % HEADS, b = chain / (2 * HEADS);
        int seg, p0, len; chunk_info(d, c, seg, p0, len);
        unsigned char* chp = CH + (size_t)it * CH_BYTES;
        const float kkc = p.k_k[h * 64 + lane], kac = p.k_a[h * 64 + lane];
        __syncthreads();
        {
            u32x4 wv[4];
#pragma unroll
            for (int k = 0; k < 4; ++k) {
                const int idx = tid + 256 * k, which = idx >> 9, j = (idx >> 3) & 63, c8 = (idx & 7) * 8;
                wv[k] = *(const u32x4*)(WSP(bf16_t, WS_LORA) + ((size_t)((d * 2 + which) * HEADS + h) * 64 + j) * 64 + c8);
            }
#pragma unroll
            for (int kb = 0; kb < 5; kb += 5) {
            u32x4 zc[5], zp[5], zn[5];
#pragma unroll
            for (int k = 0; k < 5; ++k) if (kb + k < 5) {
                const int idx = tid + 256 * (kb + k), tau = idx / 40, g = idx % 40, grp = g >> 3, j0 = (g & 7) * 8;
                const int pos = p0 + (d ? RC - 1 - tau : tau);
                const int ch0 = (grp < 3) ? grp * D_RWKV + h * 64 + j0 : (grp == 3 ? 3 * D_RWKV + d * 64 + j0 : 3 * D_RWKV + 128 + d * 64 + j0);
                const u32x4 zero = u32x4{0u, 0u, 0u, 0u};
                zc[k] = *(const u32x4*)(P + rwkv_row(seg, b, pos) * D_IN + RW0 + ch0);
                zp[k] = (pos > 0) ? *(const u32x4*)(P + rwkv_row(seg, b, pos - 1) * D_IN + RW0 + ch0) : zero;
                zn[k] = (pos < len - 1) ? *(const u32x4*)(P + rwkv_row(seg, b, pos + 1) * D_IN + RW0 + ch0) : zero;
            }
#pragma unroll
            for (int k = 0; k < 5; ++k) if (kb + k < 5) {
                const int idx = tid + 256 * (kb + k), tau = idx / 40, g = idx % 40, grp = g >> 3, j0 = (g & 7) * 8;
                const int ch0 = (grp < 3) ? grp * D_RWKV + h * 64 + j0 : (grp == 3 ? 3 * D_RWKV + d * 64 + j0 : 3 * D_RWKV + 128 + d * 64 + j0);
                float z[8], zpv[8], znv[8], o[8];
                unpack8(zc[k], z); unpack8(zp[k], zpv); unpack8(zn[k], znv);
                const f32x4 mp0 = ld4(p.mu_prev + ch0), mp1 = ld4(p.mu_prev + ch0 + 4), mn0 = ld4(p.mu_next + ch0), mn1 = ld4(p.mu_next + ch0 + 4);
#pragma unroll
                for (int e = 0; e < 4; ++e) { o[e] = z[e] + mp0[e] * (zpv[e] - z[e]) + mn0[e] * (znv[e] - z[e]); o[4 + e] = z[4 + e] + mp1[e] * (zpv[4 + e] - z[4 + e]) + mn1[e] * (znv[4 + e] - z[4 + e]); }
                if (grp < 3) {
                    float* dst = (grp == 0 ? Rf : grp == 1 ? Kf : Vf) + tau * 64 + j0;
                    *(f32x4*)dst = f32x4{o[0], o[1], o[2], o[3]}; *(f32x4*)(dst + 4) = f32x4{o[4], o[5], o[6], o[7]};
                } else if (grp == 3) {
                    u32x4 w;
#pragma unroll
                    for (int e = 0; e < 4; ++e) { const float t0 = 2.0f * frcp(1.0f + FEXP(-2.0f * o[2 * e])) - 1.0f, t1 = 2.0f * frcp(1.0f + FEXP(-2.0f * o[2 * e + 1])) - 1.0f; w[e] = pk2(t0, t1); }
                    *(u32x4*)(TW + tau * LT + j0) = w;
                } else {
                    u32x4 w; w[0] = pk2(o[0], o[1]); w[1] = pk2(o[2], o[3]); w[2] = pk2(o[4], o[5]); w[3] = pk2(o[6], o[7]);
                    *(u32x4*)(TA + tau * LT + j0) = w;
                }
            }
            }
#pragma unroll
            for (int k = 0; k < 4; ++k) {
                const int idx = tid + 256 * k, which = idx >> 9, j = (idx >> 3) & 63, c8 = (idx & 7) * 8;
                *(u32x4*)((which ? A2T : W2T) + j * LT + c8) = wv[k];
            }
        }
        __syncthreads();
        {
            f32x4 aw[2] = {f32x4{0.f, 0.f, 0.f, 0.f}, f32x4{0.f, 0.f, 0.f, 0.f}}, ai[2] = {f32x4{0.f, 0.f, 0.f, 0.f}, f32x4{0.f, 0.f, 0.f, 0.f}};
            mmT<2, 2>(aw, W2T, LT, wave, TW, LT, lane);
            mmT<2, 2>(ai, A2T, LT, wave, TA, LT, lane);
            const int j = wave * 16 + q * 4;
            const f32x4 w0v = ld4(p.w0 + d * D_RWKV + h * 64 + j), a0v = ld4(p.a0 + d * D_RWKV + h * 64 + j);
            const f32x4 kk4 = ld4(p.k_k + h * 64 + j), ka4 = ld4(p.k_a + h * 64 + j), rk4 = ld4(p.r_k + h * 64 + j);
#pragma unroll
            for (int nb = 0; nb < 2; ++nb) {
                const int tau = nb * 16 + l15;
                f32x4 lw, ic;
#pragma unroll
                for (int r = 0; r < 4; ++r) { lw[r] = -0.6065306597126334f * fsigm(w0v[r] + aw[nb][r]); ic[r] = fsigm(a0v[r] + ai[nb][r]); }
                *(f32x4*)(LW + tau * 64 + j) = lw; *(f32x4*)(IC + tau * 64 + j) = ic;
                const f32x4 kr = *(const f32x4*)(Kf + tau * 64 + j), rr = *(const f32x4*)(Rf + tau * 64 + j);
                const f32x4 kd = kr * (1.0f + (ic - 1.0f) * ka4), kq = kr * kk4;
                float n2 = hsum4(kq * kq), bon = hsum4(rr * kd * rk4);
                n2 += __shfl_xor(n2, 16); n2 += __shfl_xor(n2, 32); bon += __shfl_xor(bon, 16); bon += __shfl_xor(bon, 32);
                if (q == 0) { PS[(tau * 4 + wave) * 2] = n2; PS[(tau * 4 + wave) * 2 + 1] = bon; }
            }
        }
        __syncthreads();
        {
            const int j = lane, t0 = wave * 8;
            float cum[8], kd[8], kkn[8], icv[8], rr[8], vv[8], run = 0.f;
#pragma unroll
            for (int i = 0; i < 8; ++i) {
                const int t = t0 + i;
                run += LW[t * 64 + j]; cum[i] = run;
                const float kr = Kf[t * 64 + j]; icv[i] = IC[t * 64 + j]; rr[i] = Rf[t * 64 + j]; vv[i] = Vf[t * 64 + j];
                kd[i] = kr * (1.0f + (icv[i] - 1.0f) * kac);
                const float kk = kr * kkc;
                const f32x4 pa = *(const f32x4*)(PS + t * 8), pb = *(const f32x4*)(PS + t * 8 + 4);
                const float n2 = (pa[0] + pa[2]) + (pb[0] + pb[2]);
                kkn[i] = kk * frsq(fmaxf(n2, 1e-24f));
                if (lane == 0) RBON[(size_t)it * RC + t] = (pa[1] + pa[3]) + (pb[1] + pb[3]);
            }
            TOT[wave * 64 + j] = run;
            __syncthreads();
            float off = 0.f;
            for (int w = 0; w < wave; ++w) off += TOT[w * 64 + j];
            u32x4 vt, bt, kt;
            float e_prev = 0.f;
#pragma unroll
            for (int i = 0; i < 8; ++i) {
                const int t = t0 + i;
                const float cu = off + cum[i], cprev = (i == 0) ? off : off + cum[i - 1];
                const float g = FEXP(cu), gi = FEXP(-cu), gm = FEXP(cprev);
                const float ah = -kkn[i] * gm, bh = kkn[i] * icv[i] * gi, kh = kd[i] * gi, rh = rr[i] * g;
                Ah[t * LT + j] = f2bf(ah); Bh[t * LT + j] = f2bf(bh); Kh[t * LT + j] = f2bf(kh); Rh[t * LT + j] = f2bf(rh);
                if (i & 1) { vt[i >> 1] = pk2(e_prev, vv[i]); bt[i >> 1] = (bt[i >> 1] & 0xFFFFu) | ((unsigned)f2bf(bh) << 16); kt[i >> 1] = (kt[i >> 1] & 0xFFFFu) | ((unsigned)f2bf(kh) << 16); }
                else { e_prev = vv[i]; bt[i >> 1] = f2bf(bh); kt[i >> 1] = f2bf(kh); }
                if (t == RC - 1) GC[j] = g;
            }
            *(u32x4*)(VT + j * LJ + t0) = vt; *(u32x4*)(BhT + j * LJ + t0) = bt; *(u32x4*)(KhT + j * LJ + t0) = kt;
        }
        __syncthreads();
        {
            const bf16_t* X = (wave == 0) ? Ah : (wave & 1) ? Kh : Bh;
            const bf16_t* Y = (wave == 0) ? Bh : (wave == 1) ? Ah : Rh;
#pragma unroll
            for (int xs = 0; xs < 2; ++xs) {
                f32x4 acc[2] = {f32x4{0.f, 0.f, 0.f, 0.f}, f32x4{0.f, 0.f, 0.f, 0.f}};
                mmT<2, 2>(acc, X, LT, xs, Y, LT, lane);
#pragma unroll
                for (int nb = 0; nb < 2; ++nb) {
                    const int yy = nb * 16 + l15, x0 = xs * 16 + q * 4;
                    f32x4 v = acc[nb];
#pragma unroll
                    for (int r = 0; r < 4; ++r) { const int xx = x0 + r; const bool keep = (wave == 0) ? (yy < xx) : (wave == 1) ? (xx < yy) : (xx <= yy); v[r] = keep ? v[r] : 0.f; }
                    if (wave == 0) { *(f32x4*)(PA + yy * 36 + x0) = v; f32x4 t0 = v; for (int r = 0; r < 4; ++r) t0[r] += (x0 + r == yy) ? 1.0f : 0.0f; *(f32x4*)(IA + yy * 36 + x0) = t0; }
                    else { bf16_t* dst = (wave == 1 ? NkaT : wave == 2 ? MbrT : MkrT) + yy * LJ + x0; *(U2*)dst = pack4(v); }
                }
            }
        }
        __syncthreads();
        {
#pragma unroll
            for (int xs = 0; xs < 2; ++xs) {
                f32x4 acc[1] = {f32x4{0.f, 0.f, 0.f, 0.f}};
                mmT<1, 1>(acc, NkaT, LJ, xs, VT + wave * 16 * LJ, LJ, lane);
                const int i = wave * 16 + l15, tb = xs * 16 + q * 4;
                Xu[i * 33 + tb] = acc[0][0]; Xu[i * 33 + tb + 1] = acc[0][1]; Xu[i * 33 + tb + 2] = acc[0][2]; Xu[i * 33 + tb + 3] = acc[0][3];
            }
        }
        __syncthreads();
        {
            auto mm32 = [&](float* Z, const float* init, const float* L, const float* R, int ti, int tj) {
                f32x4 acc = f32x4{0.f, 0.f, 0.f, 0.f};
                if (init) { for (int r = 0; r < 4; ++r) acc[r] = init[(ti * 16 + q * 4 + r) * 36 + tj * 16 + l15]; }
#pragma unroll
                for (int k0 = 0; k0 < 32; k0 += 4) acc = MFMAF32(L[(ti * 16 + l15) * 36 + k0 + q], R[(k0 + q) * 36 + tj * 16 + l15], acc);
#pragma unroll
                for (int r = 0; r < 4; ++r) Z[(ti * 16 + q * 4 + r) * 36 + tj * 16 + l15] = acc[r];
            };
            const int ti = wave >> 1, tj = wave & 1;
            mm32(PB, nullptr, PA, PA, ti, tj);
            __syncthreads();
            mm32(IB, IA, IA, PB, ti, tj); mm32(PA, nullptr, PB, PB, ti, tj);
            __syncthreads();
            mm32(IA, IB, IB, PA, ti, tj); mm32(PB, nullptr, PA, PA, ti, tj);
            __syncthreads();
            mm32(IB, IA, IA, PB, ti, tj); mm32(PA, nullptr, PB, PB, ti, tj);
            __syncthreads();
            f32x4 accw[2], accu[2];
            mm32(IA, IB, IB, PA, ti, tj);
            __syncthreads();
#pragma unroll
            for (int tc = 0; tc < 2; ++tc) { accw[tc] = f32x4{0.f, 0.f, 0.f, 0.f}; accu[tc] = f32x4{0.f, 0.f, 0.f, 0.f}; }
#pragma unroll
            for (int k0 = 0; k0 < 32; k0 += 4) {
                const float la = bf2f(Ah[(k0 + q) * LT + wave * 16 + l15]), lu = Xu[(wave * 16 + l15) * 33 + k0 + q];
#pragma unroll
                for (int tc = 0; tc < 2; ++tc) { const float rv = IA[(k0 + q) * 36 + tc * 16 + l15]; accw[tc] = MFMAF32(la, rv, accw[tc]); accu[tc] = MFMAF32(lu, rv, accu[tc]); }
            }
            __syncthreads();
#pragma unroll
            for (int tc = 0; tc < 2; ++tc)
#pragma unroll
                for (int r = 0; r < 4; ++r) { const int row = wave * 16 + q * 4 + r, col = tc * 16 + l15; Wa[row * LJ + col] = f2bf(accw[tc][r]); U0[row * LJ + col] = f2bf(accu[tc][r]); }
        }
        __syncthreads();
        {
            bf16_t* gPm = (bf16_t*)(chp + CH_PM); bf16_t* gSA = (bf16_t*)(chp + CH_SA); bf16_t* gQT = (bf16_t*)(chp + CH_QT); bf16_t* gY0 = (bf16_t*)(chp + CH_Y0);
            const int x0 = wave * 16 + q * 4;
            {
                f32x4 acc[4] = {f32x4{0.f, 0.f, 0.f, 0.f}, f32x4{0.f, 0.f, 0.f, 0.f}, f32x4{0.f, 0.f, 0.f, 0.f}, f32x4{0.f, 0.f, 0.f, 0.f}};
                mmT<4, 1>(acc, Wa, LJ, wave, BhT, LJ, lane);
#pragma unroll
                for (int nb = 0; nb < 4; ++nb) {
                    const int jp = nb * 16 + l15; const float g = GC[jp];
                    f32x4 v = acc[nb];
#pragma unroll
                    for (int r = 0; r < 4; ++r) v[r] = (v[r] + ((x0 + r == jp) ? 1.0f : 0.0f)) * g;
                    *(U2*)(gPm + jp * 64 + x0) = pack4(v);
                }
            }
            {
                f32x4 acc[4] = {f32x4{0.f, 0.f, 0.f, 0.f}, f32x4{0.f, 0.f, 0.f, 0.f}, f32x4{0.f, 0.f, 0.f, 0.f}, f32x4{0.f, 0.f, 0.f, 0.f}};
                mmT<4, 1>(acc, BhT, LJ, wave, U0, LJ, lane);
                mmT<4, 1>(acc, KhT, LJ, wave, VT, LJ, lane);
                const f32x4 g = *(const f32x4*)(GC + x0);
#pragma unroll
                for (int nb = 0; nb < 4; ++nb) *(U2*)(gSA + (nb * 16 + l15) * 64 + x0) = pack4(acc[nb] * g);
            }
            if (seg == 1) {
                {
                    f32x4 acc[2] = {f32x4{0.f, 0.f, 0.f, 0.f}, f32x4{0.f, 0.f, 0.f, 0.f}};
                    mmT<2, 1>(acc, Wa, LJ, wave, MbrT, LJ, lane);
#pragma unroll
                    for (int nb = 0; nb < 2; ++nb) {
                        const int t = nb * 16 + l15;
                        f32x4 v = acc[nb];
#pragma unroll
                        for (int r = 0; r < 4; ++r) v[r] += bf2f(Rh[t * LT + x0 + r]);
                        *(U2*)(gQT + t * 64 + x0) = pack4(v);
                    }
                }
                {
                    f32x4 acc[2] = {f32x4{0.f, 0.f, 0.f, 0.f}, f32x4{0.f, 0.f, 0.f, 0.f}};
                    mmT<2, 1>(acc, U0, LJ, wave, MbrT, LJ, lane);
                    mmT<2, 1>(acc, VT, LJ, wave, MkrT, LJ, lane);
#pragma unroll
                    for (int nb = 0; nb < 2; ++nb) *(U2*)(gY0 + (nb * 16 + l15) * 64 + x0) = pack4(acc[nb]);
                }
            }
        }
    }
}

__device__ __forceinline__ U2 ldu2(const bf16_t* p) { return *(const U2*)p; }
constexpr int R2D = 6, R2LD = 72;
__device__ __forceinline__ void phaseR2(const Params& p, int bid, int nblk, char* smem) {
    unsigned char* CH = p.ws + WS_CH;
    bf16_t* PL = (bf16_t*)smem;
    const int tid = opaque_tid(), lane = tid & 63, wave = tid >> 6, q = lane >> 4, l15 = lane & 15;
    const int lrow = wave * 16 + (lane >> 2), lcol = (lane & 3) * 16;
    for (int chain = bid; chain < NCHAIN; chain += nblk) {
        const int i = wave * 16 + l15;
        unsigned char* chbase = CH + (size_t)chain * NCK * CH_BYTES;
        f32x4 st[4];
#pragma unroll
        for (int nt = 0; nt < 4; ++nt) st[nt] = f32x4{0.f, 0.f, 0.f, 0.f};
        u32x4 pq[R2D][2]; U2 sa[R2D][4];
#pragma unroll
        for (int k = 0; k < R2D; ++k) {
            const unsigned char* chp = chbase + (size_t)(k < NCK ? k : NCK - 1) * CH_BYTES;
            const bf16_t* gp = (const bf16_t*)(chp + CH_PM) + lrow * 64 + lcol;
            pq[k][0] = *(const u32x4*)gp; pq[k][1] = *(const u32x4*)(gp + 8);
#pragma unroll
            for (int nt = 0; nt < 4; ++nt) sa[k][nt] = ldu2((const bf16_t*)(chp + CH_SA) + i * 64 + nt * 16 + 4 * q);
        }
#pragma unroll 1
        for (int c0 = 0; c0 < NCK; c0 += R2D) {
#pragma unroll
            for (int k = 0; k < R2D; ++k) {
                const int c = c0 + k;
                if (c < NCK) {
                bf16_t* pl = PL + (k & 1) * 64 * R2LD;
                *(u32x4*)(pl + lrow * R2LD + lcol) = pq[k][0]; *(u32x4*)(pl + lrow * R2LD + lcol + 8) = pq[k][1];
                f32x4 ini[4];
#pragma unroll
                for (int nt = 0; nt < 4; ++nt) ini[nt] = f32x4{bitsf(sa[k][nt].x << 16), bitsf(sa[k][nt].x & 0xFFFF0000u), bitsf(sa[k][nt].y << 16), bitsf(sa[k][nt].y & 0xFFFF0000u)};
                {
                    const int cn = (c + R2D < NCK) ? c + R2D : NCK - 1;
                    const unsigned char* chp = chbase + (size_t)cn * CH_BYTES;
                    const bf16_t* gp = (const bf16_t*)(chp + CH_PM) + lrow * 64 + lcol;
                    pq[k][0] = *(const u32x4*)gp; pq[k][1] = *(const u32x4*)(gp + 8);
#pragma unroll
                    for (int nt = 0; nt < 4; ++nt) sa[k][nt] = ldu2((const bf16_t*)(chp + CH_SA) + i * 64 + nt * 16 + 4 * q);
                }
                __syncthreads();
                bf16_t* gSA = (bf16_t*)(chbase + (size_t)c * CH_BYTES + CH_SA) + i * 64 + 4 * q;
                bf16x8 bfr[2];
#pragma unroll
                for (int ks = 0; ks < 2; ++ks) {
                    const U2 lo = pack4(st[2 * ks]), hi = pack4(st[2 * ks + 1]);
                    bfr[ks] = __builtin_bit_cast(bf16x8, u32x4{lo.x, lo.y, hi.x, hi.y});
                    *(U2*)(gSA + (2 * ks) * 16) = lo; *(U2*)(gSA + (2 * ks + 1) * 16) = hi;
                }
#pragma unroll
                for (int nt = 0; nt < 4; ++nt) {
                    f32x4 acc = ini[nt];
#pragma unroll
                    for (int ks = 0; ks < 2; ++ks) {
                        const U2 lo = *(const U2*)(pl + (nt * 16 + l15) * R2LD + 32 * ks + 4 * q), hi = *(const U2*)(pl + (nt * 16 + l15) * R2LD + 32 * ks + 16 + 4 * q);
                        acc = MFMA16(__builtin_bit_cast(bf16x8, u32x4{lo.x, lo.y, hi.x, hi.y}), bfr[ks], acc);
                    }
                    st[nt] = acc;
                }
                }
            }
        }
        __syncthreads();
    }
}

__device__ __forceinline__ void phaseR3(const Params& p, int bid, int nblk, char* smem) {
    const bf16_t* P = WSP(bf16_t, WS_R1);
    const unsigned char* CH = p.ws + WS_CH;
    const float* RBON = WSP(float, WS_RBON);
    bf16_t* MIX = WSP(bf16_t, WS_R3);
    float* red = (float*)smem;
    const int tid = opaque_tid(), lane = tid & 63, wave = tid >> 6, q = lane >> 4, l15 = lane & 15;
    for (int m = bid * 256 + tid; m < MLAT; m += nblk * 256) {
        const float* sp = WSP(float, WS_SSQP) + (size_t)m * LRU_BLOCKS;
        float sq = 0.f;
#pragma unroll
        for (int c = 0; c < LRU_BLOCKS; ++c) sq += sp[c];
        WSP(float, WS_RINV)[m] = frsq(sq * (1.0f / D_LRU) + RMS_EPS);
    }
    bf16_t* G2T = (bf16_t*)(smem + 1024);
    const int nbh = nblk / HEADS;
    const bool uniform = (nbh > 0) && (nblk % HEADS == 0);
    constexpr int NP16 = SEQ / 16, NW = BATCH * NP16;
    const int nwv = uniform ? nbh * 4 : nblk * 4;
    int hcur = -1;
    for (int wi0 = (uniform ? (bid % nbh) : bid) * 4; wi0 < (uniform ? NW : NW * HEADS); wi0 += nwv) {
        int h; if (uniform) h = bid / nbh; else h = (wi0 / 4) % HEADS;
        if (h != hcur) {
            __syncthreads();
            for (int idx = tid; idx < 128 * 16; idx += 256) {
                const int c = idx >> 4, i4 = (idx & 15) * 4;
                const f32x4 w = ld4(p.g2 + (size_t)c * D_RWKV + h * 64 + i4);
                bf16_t* dst = G2T + i4 * 136 + c;
                dst[0] = f2bf(w[0]); dst[136] = f2bf(w[1]); dst[272] = f2bf(w[2]); dst[408] = f2bf(w[3]);
            }
            hcur = h;
            __syncthreads();
        }
        const int wi = uniform ? wi0 + wave : (wi0 / 4 / HEADS) * 4 + wave;
        if (wi >= NW) continue;
        const int b = wi / NP16, p16 = wi % NP16, pc = p16 >> 1, pl = (p16 & 1) * 16 + l15, pos = pc * RC + pl;
        f32x4 y[4], g[4];
#pragma unroll
        for (int xs = 0; xs < 4; ++xs) { y[xs] = f32x4{0.f, 0.f, 0.f, 0.f}; g[xs] = f32x4{0.f, 0.f, 0.f, 0.f}; }
        float bon = 0.f;
#pragma unroll
        for (int d = 0; d < 2; ++d) {
            const int chain = (b * HEADS + h) * 2 + d, c = NCC + (d ? NLC - 1 - pc : pc), tau = d ? RC - 1 - pl : pl;
            const size_t item = (size_t)chain * NCK + c;
            const unsigned char* chp = CH + item * CH_BYTES;
            const bf16_t* gS = (const bf16_t*)(chp + CH_SA); const bf16_t* gQT = (const bf16_t*)(chp + CH_QT); const bf16_t* gY0 = (const bf16_t*)(chp + CH_Y0);
            bf16x8 yf[2];
#pragma unroll
            for (int ks = 0; ks < 2; ++ks) yf[ks] = *(const bf16x8*)(gQT + tau * 64 + ks * 32 + 8 * q);
#pragma unroll
            for (int xs = 0; xs < 4; ++xs) {
                f32x4 acc = ldb4(gY0 + tau * 64 + xs * 16 + 4 * q);
#pragma unroll
                for (int ks = 0; ks < 2; ++ks) acc = MFMA16(*(const bf16x8*)(gS + (xs * 16 + l15) * 64 + ks * 32 + 8 * q), yf[ks], acc);
                y[xs] += acc;
            }
            bon += RBON[item * RC + tau];
        }
#pragma unroll
        for (int ks = 0; ks < 4; ++ks) {
            float o[8]; shifted8(p, P, 1, b, pos, SEQ, 3 * D_RWKV + 256 + ks * 32 + 8 * q, o);
            u32x4 t; t[0] = pk2(fsigm(o[0]), fsigm(o[1])); t[1] = pk2(fsigm(o[2]), fsigm(o[3])); t[2] = pk2(fsigm(o[4]), fsigm(o[5])); t[3] = pk2(fsigm(o[6]), fsigm(o[7]));
            const bf16x8 sg = __builtin_bit_cast(bf16x8, t);
#pragma unroll
            for (int xs = 0; xs < 4; ++xs) g[xs] = MFMA16(*(const bf16x8*)(G2T + (xs * 16 + l15) * 136 + ks * 32 + 8 * q), sg, g[xs]);
        }
        float s1 = 0.f, s2 = 0.f;
#pragma unroll
        for (int xs = 0; xs < 4; ++xs) { s1 += hsum4(y[xs]); s2 += hsum4(y[xs] * y[xs]); }
        s1 += __shfl_xor(s1, 16); s1 += __shfl_xor(s1, 32); s2 += __shfl_xor(s2, 16); s2 += __shfl_xor(s2, 32);
        const float mu = s1 * (1.0f / 64.0f), var = fmaxf(s2 * (1.0f / 64.0f) - mu * mu, 0.f), rstd = frsq(var + GN_EPS);
        const size_t mrow = rwkv_row(1, b, pos);
        const size_t mprev = pos > 0 ? rwkv_row(1, b, pos - 1) : mrow, mnext = pos < SEQ - 1 ? rwkv_row(1, b, pos + 1) : mrow;
#pragma unroll
        for (int xs = 0; xs < 4; ++xs) {
            const int i0 = xs * 16 + q * 4, chv = 2 * D_RWKV + h * 64 + i0;
            const f32x4 z = ldb4(P + mrow * D_IN + RW0 + chv);
            f32x4 zp = ldb4(P + mprev * D_IN + RW0 + chv), zn = ldb4(P + mnext * D_IN + RW0 + chv);
            if (pos == 0) zp = f32x4{0.f, 0.f, 0.f, 0.f};
            if (pos == SEQ - 1) zn = f32x4{0.f, 0.f, 0.f, 0.f};
            const f32x4 v = z + ld4(p.mu_prev + chv) * (zp - z) + ld4(p.mu_next + chv) * (zn - z);
            const f32x4 yn = (y[xs] - mu) * rstd * ld4(p.gn_g + h * 64 + i0) + ld4(p.gn_b + h * 64 + i0);
            *(U2*)(MIX + mrow * D_MIX + D_LRU + h * 64 + i0) = pack4((yn + bon * v) * g[xs]);
        }
    }
}

__device__ __forceinline__ void phaseJ(const Params& p, int bid, int nblk, char* smem) {
    const bf16_t* MIX = WSP(bf16_t, WS_R3); const bf16_t* WB = WSP(bf16_t, WS_WBOUT);
    bf16_t* YOUT = WSP(bf16_t, WS_R1);
    const float* RINV = WSP(float, WS_RINV);
    constexpr int BM = 32 * MI_J, NTN = D_MODEL / 128, NTM = MLAT / BM;
    constexpr int GM = (NTM % 8 == 0) ? 8 : 1;
    for (int it = xcd_vbid(bid, nblk); it < NTN * NTM; it += nblk) {
        const int mg = it / (GM * NTN), r = it % (GM * NTN), nt = r / GM, mt = mg * GM + (r % GM);
        gemm_tile<MI_J, false>(smem, MIX, D_MIX, nullptr, mt * BM, WB, nullptr, D_MIX, nt * 128, D_MIX, [&](int ml, int nl, f32x4 v, f32x4) {
            *(U2*)(YOUT + (size_t)(mt * BM + ml) * D_MODEL + nt * 128 + nl) = pack4(v);
        }, RINV, D_LRU / 64);
    }
}

constexpr int KUL = D_MODEL + 2;
static_assert((16 * KUL + 4 * 256) * 4 <= SMEM_BYTES && N_EXPERTS <= 16 && MLAT % 16 == 0, "phase K lds");
__device__ __forceinline__ void phaseK(const Params& p, int bid, int nblk, char* smem) {
    const int tid = opaque_tid(), lane = tid & 63, wave = tid >> 6, q = lane >> 4, l15 = lane & 15;
    const float* MOD = WSP(float, WS_MOD); const float* STATS = WSP(float, WS_STATS);
    const bf16_t* YOUT = WSP(bf16_t, WS_R1);
    float* H1 = WSP(float, WS_R5); bf16_t* U2b = WSP(bf16_t, WS_R6); float* AFF = WSP(float, WS_AFF);
    float* UL = (float*)smem;
    float* PL = UL + 16 * KUL;
    for (int rb = bid; rb < MLAT / 16; rb += nblk) {
        __syncthreads();
#pragma unroll 1
        for (int rr = 0; rr < 4; ++rr) {
            const int lr = wave * 4 + rr, row = rb * 16 + lr;
            const float* xr = p.x + (size_t)row * D_MODEL;
            const float* md = MOD + (size_t)(row / SEQ) * 6 * D_MODEL;
            const float mu0 = STATS[row * 2], rs0 = STATS[row * 2 + 1];
            f32x4 v0, v1, v2, v3; float s = 0.f;
#define PK_LOAD(V, J) { const int k = (J) * 256 + lane * 4; \
            V = ALPHA_F * ((ld4(xr + k) - mu0) * rs0 * ld4(p.ln_in_g + k) + ld4(p.ln_in_b + k)) + ld4(md + 2 * D_MODEL + k) * ldb4(YOUT + (size_t)row * D_MODEL + k); s += hsum4(V); }
            PK_LOAD(v0, 0)
            if (NV > 1) PK_LOAD(v1, 1) else v1 = f32x4{0.f, 0.f, 0.f, 0.f};
            if (NV > 2) { PK_LOAD(v2, 2) PK_LOAD(v3, 3) } else { v2 = v1; v3 = v1; }
#undef PK_LOAD
            const float mu = wave_sum(s) * (1.0f / D_MODEL);
            v0 -= mu; float s2 = hsum4(v0 * v0);
            if (NV > 1) { v1 -= mu; s2 += hsum4(v1 * v1); }
            if (NV > 2) { v2 -= mu; v3 -= mu; s2 += hsum4(v2 * v2) + hsum4(v3 * v3); }
            const float rstd = frsq(wave_sum(s2) * (1.0f / D_MODEL) + LN_EPS);
#pragma unroll
            for (int j = 0; j < NV; ++j) {
                const int k = j * 256 + lane * 4;
                const f32x4 vv = (j == 0) ? v0 : (j == 1) ? v1 : (j == 2) ? v2 : v3;
                const f32x4 h = vv * rstd * ld4(p.ln1_g + k) + ld4(p.ln1_b + k);
                *(f32x4*)(H1 + (size_t)row * D_MODEL + k) = h;
                const f32x4 u = h * (1.0f + ld4(md + 4 * D_MODEL + k)) + ld4(md + 3 * D_MODEL + k);
                *(U2*)(U2b + (size_t)row * D_MODEL + k) = pack4(u);
                float* ul = UL + lr * KUL + k;
                *(f32x2_e*)ul = f32x2_e{u[0], u[1]}; *(f32x2_e*)(ul + 2) = f32x2_e{u[2], u[3]};
            }
        }
        __syncthreads();
        {
            f32x4 acc = f32x4{0.f, 0.f, 0.f, 0.f};
            const int kq0 = wave * (D_MODEL / 4);
#pragma unroll 8
            for (int s4 = 0; s4 < D_MODEL / 16; ++s4) {
                const int k = kq0 + s4 * 4 + q;
                const float av = UL[l15 * KUL + k];
                const float bv = (l15 < N_EXPERTS) ? p.w_router[(size_t)k * N_EXPERTS + l15] : 0.f;
                acc = MFMAF32(av, bv, acc);
            }
#pragma unroll
            for (int r = 0; r < 4; ++r) PL[wave * 256 + (q * 4 + r) * 16 + l15] = acc[r];
        }
        __syncthreads();
        {
            const int lr = tid >> 4, e = tid & 15;
            const bool valid = e < N_EXPERTS;
            float lg = PL[tid] + PL[256 + tid] + PL[512 + tid] + PL[768 + tid];
            float mx = valid ? lg : -3.0e38f;
#pragma unroll
            for (int o = 1; o < 16; o <<= 1) mx = fmaxf(mx, __shfl_xor(mx, o));
            const float ex = valid ? expf(lg - mx) : 0.f;
            float den = ex;
#pragma unroll
            for (int o = 1; o < 16; o <<= 1) den += __shfl_xor(den, o);
            if (valid) AFF[(size_t)(rb * 16 + lr) * N_EXPERTS + e] = ex / den;
        }
    }
}

__device__ __forceinline__ int block_sum_int(int v, int* red) {
    const int tid_ = opaque_tid(), lane = tid_ & 63, wave = tid_ >> 6;
#pragma unroll
    for (int o = 1; o < 64; o <<= 1) v += __shfl_xor(v, o);
    __syncthreads();
    if (lane == 0) red[wave] = v;
    __syncthreads();
    return red[0] + red[1] + red[2] + red[3];
}
__device__ __forceinline__ void phaseL(const Params& p, int bid, int nblk, char* smem) {
    const float* AFF = WSP(float, WS_AFF);
    int* IDX = WSP(int, WS_IDX); float* GATE = WSP(float, WS_GATE); int* SLOTOF = WSP(int, WS_SLOT);
    unsigned* vals = (unsigned*)smem;
    int* red = (int*)(vals + SEQ);
    int* wsum = red + 8;
    const int tid = opaque_tid(), lane = tid & 63, wave = tid >> 6;
    constexpr int PER = SEQ / 256;
    {
        constexpr int NL = BATCH * N_EXPERTS;
        const bool spare = nblk > NL + 32;
        if (spare ? (bid >= NL) : true) convert_experts(p, spare ? bid - NL : bid, spare ? nblk - NL : nblk, smem, 0, 2);
        if (spare && bid >= NL) return;
        __syncthreads();
    }
    for (int be = bid; be < BATCH * N_EXPERTS; be += nblk) {
        const int b = be / N_EXPERTS, e = be % N_EXPERTS;
        __syncthreads();
        for (int t = tid; t < SEQ; t += 256) vals[t] = fbits(AFF[((size_t)b * SEQ + t) * N_EXPERTS + e]);
        __syncthreads();
        unsigned lo = 0u, hi = 0x7F800000u;
        while (lo < hi) {
            const unsigned mid = lo + (hi - lo + 1u) / 2u;
            int c = 0;
            for (int t = tid; t < SEQ; t += 256) c += (vals[t] >= mid) ? 1 : 0;
            c = block_sum_int(c, red);
            if (c >= CAP) lo = mid; else hi = mid - 1u;
        }
        const unsigned T = lo;
        int cg = 0, ce = 0;
        for (int q = 0; q < PER; ++q) { const unsigned v = vals[tid * PER + q]; cg += (v > T) ? 1 : 0; ce += (v == T) ? 1 : 0; }
        int pg = cg, pe = ce;
#pragma unroll
        for (int o = 1; o < 64; o <<= 1) { const int a = __shfl_up(pg, o), bb = __shfl_up(pe, o); if (lane >= o) { pg += a; pe += bb; } }
        __syncthreads();
        if (lane == 63) { wsum[wave] = pg; wsum[4 + wave] = pe; }
        __syncthreads();
        int og = 0, oe = 0, totg = 0;
        for (int w = 0; w < 4; ++w) { if (w < wave) { og += wsum[w]; oe += wsum[4 + w]; } totg += wsum[w]; }
        int posg = og + pg - cg, pose = oe + pe - ce;
        const int need_eq = CAP - totg;
        for (int q = 0; q < PER; ++q) {
            const int t = tid * PER + q; const unsigned v = vals[t];
            int slot = -1;
            if (v > T) { slot = posg++; }
            else if (v == T) { if (pose < need_eq) slot = totg + pose; pose++; }
            if (slot >= 0) { IDX[(size_t)be * CAP + slot] = b * SEQ + t; GATE[(size_t)be * CAP + slot] = bitsf(v); }
            SLOTOF[((size_t)b * SEQ + t) * N_EXPERTS + e] = slot;
        }
    }
}

__device__ __forceinline__ void phaseM(const Params& p, int bid, int nblk, char* smem) {
    const bf16_t* U2b = WSP(bf16_t, WS_R6); const int* IDX = WSP(int, WS_IDX);
    bf16_t* HID = WSP(bf16_t, WS_R1);
    constexpr int BM = 32 * MI_E, NTN = D_EXPERT / 64, NTM = CAP / BM;
    for (int it = xcd_vbid(bid, nblk); it < BATCH * N_EXPERTS * NTM * NTN; it += nblk) {
        const int mt = it % NTM, b = (it / NTM) % BATCH, nt = (it / (NTM * BATCH)) % NTN, e = it / (NTM * BATCH * NTN), be = b * N_EXPERTS + e;
        const bf16_t* wg = WSP(bf16_t, WS_WG + (size_t)e * WEXP_BYTES); const bf16_t* wu = WSP(bf16_t, WS_WU + (size_t)e * WEXP_BYTES);
        gemm_tile<MI_E, true>(smem, U2b, D_MODEL, IDX + (size_t)be * CAP, mt * BM, wg, wu, D_MODEL, nt * 64, D_MODEL, [&](int ml, int nl, f32x4 g, f32x4 u) {
            U2 o; o.x = pk2(siluf_(g[0]) * u[0], siluf_(g[1]) * u[1]); o.y = pk2(siluf_(g[2]) * u[2], siluf_(g[3]) * u[3]);
            *(U2*)(HID + ((size_t)be * CAP + mt * BM + ml) * D_EXPERT + nt * 64 + nl) = o;
        });
    }
    {
        constexpr int NT = BATCH * N_EXPERTS * NTM * NTN;
        const int rem = NT % nblk, vb = xcd_vbid(bid, nblk);
        if (rem == 0 || nblk - rem < 32) convert_experts(p, vb, nblk, smem, 2, 3);
        else if (vb >= rem) convert_experts(p, vb - rem, nblk - rem, smem, 2, 3);
    }
}
__device__ __forceinline__ void phaseN(const Params& p, int bid, int nblk, char* smem) {
    const bf16_t* HID = WSP(bf16_t, WS_R1); const float* GATE = WSP(float, WS_GATE);
    bf16_t* YS = WSP(bf16_t, WS_R2);
    constexpr int BM = 32 * MI_E, NTN = D_MODEL / 128, NTM = CAP / BM;
    for (int it = xcd_vbid(bid, nblk); it < BATCH * N_EXPERTS * NTM * NTN; it += nblk) {
        const int mt = it % NTM, b = (it / NTM) % BATCH, nt = (it / (NTM * BATCH)) % NTN, e = it / (NTM * BATCH * NTN), be = b * N_EXPERTS + e;
        const bf16_t* wd = WSP(bf16_t, wdown_off(e));
        gemm_tile<MI_E, false>(smem, HID + (size_t)be * CAP * D_EXPERT, D_EXPERT, nullptr, mt * BM, wd, nullptr, D_EXPERT, nt * 128, D_EXPERT, [&](int ml, int nl, f32x4 v, f32x4) {
            const int slot = mt * BM + ml;
            const float gt = GATE[(size_t)be * CAP + slot];
            *(U2*)(YS + ((size_t)be * CAP + slot) * D_MODEL + nt * 128 + nl) = pack4(v * gt);
        });
    }
}
__device__ __forceinline__ void phaseO(const Params& p, int bid, int nblk, char* smem) {
    const int tid_ = opaque_tid(), lane = tid_ & 63, wave = tid_ >> 6;
    const float* MOD = WSP(float, WS_MOD); const float* H1 = WSP(float, WS_R5); const bf16_t* YS = WSP(bf16_t, WS_R2); const int* SLOTOF = WSP(int, WS_SLOT);
    int row = bid * 4 + wave;
    f32x4 n0 = f32x4{0.f, 0.f, 0.f, 0.f}, n1 = n0, n2 = n0, n3 = n0; int nslot = -1;
    if (row < MLAT) { const float* hr = H1 + (size_t)row * D_MODEL; n0 = ld4(hr + lane * 4); if (NV > 1) n1 = ld4(hr + 256 + lane * 4); if (NV > 2) { n2 = ld4(hr + 512 + lane * 4); n3 = ld4(hr + 768 + lane * 4); }
                      nslot = (lane < N_EXPERTS) ? SLOTOF[(size_t)row * N_EXPERTS + lane] : -1; }
    for (; row < MLAT; row += nblk * 4) {
        const float* md = MOD + (size_t)(row / SEQ) * 6 * D_MODEL;
        const f32x4 h0 = n0, h1 = n1, h2 = n2, h3 = n3; const int myslot = nslot;
        const int nrow = row + nblk * 4;
        if (nrow < MLAT) { const float* hr = H1 + (size_t)nrow * D_MODEL; n0 = ld4(hr + lane * 4); if (NV > 1) n1 = ld4(hr + 256 + lane * 4); if (NV > 2) { n2 = ld4(hr + 512 + lane * 4); n3 = ld4(hr + 768 + lane * 4); }
                           nslot = (lane < N_EXPERTS) ? SLOTOF[(size_t)nrow * N_EXPERTS + lane] : -1; }
        f32x4 y0 = f32x4{0.f, 0.f, 0.f, 0.f}, y1 = y0, y2 = y0, y3 = y0;
        const int bbase = (row / SEQ) * N_EXPERTS;
        for (int e = 0; e < N_EXPERTS; ++e) {
            const int sl = __shfl(myslot, e);
            if (sl >= 0) {
                const bf16_t* yr = YS + ((size_t)(bbase + e) * CAP + sl) * D_MODEL + lane * 4;
                y0 += ldb4(yr);
                if (NV > 1) y1 += ldb4(yr + 256);
                if (NV > 2) { y2 += ldb4(yr + 512); y3 += ldb4(yr + 768); }
            }
        }
        f32x4 v0, v1, v2, v3; float s = 0.f;
        v0 = ALPHA_F * h0 + ld4(md + 5 * D_MODEL + lane * 4) * y0; s += hsum4(v0);
        if (NV > 1) { v1 = ALPHA_F * h1 + ld4(md + 5 * D_MODEL + 256 + lane * 4) * y1; s += hsum4(v1); } else v1 = f32x4{0.f, 0.f, 0.f, 0.f};
        if (NV > 2) { v2 = ALPHA_F * h2 + ld4(md + 5 * D_MODEL + 512 + lane * 4) * y2; v3 = ALPHA_F * h3 + ld4(md + 5 * D_MODEL + 768 + lane * 4) * y3; s += hsum4(v2) + hsum4(v3); } else { v2 = v1; v3 = v1; }
        const float mu = wave_sum(s) * (1.0f / D_MODEL);
        v0 -= mu; float s2 = hsum4(v0 * v0);
        if (NV > 1) { v1 -= mu; s2 += hsum4(v1 * v1); }
        if (NV > 2) { v2 -= mu; v3 -= mu; s2 += hsum4(v2 * v2) + hsum4(v3 * v3); }
        const float rstd = frsq(wave_sum(s2) * (1.0f / D_MODEL) + LN_EPS);
#pragma unroll
        for (int j = 0; j < NV; ++j) {
            const int k = j * 256 + lane * 4;
            const f32x4 vv = (j == 0) ? v0 : (j == 1) ? v1 : (j == 2) ? v2 : v3;
            *(f32x4*)(p.out + (size_t)row * D_MODEL + k) = vv * rstd * ld4(p.ln2_g + k) + ld4(p.ln2_b + k);
        }
    }
}

#define XB_TMO      128
#define XB_XCNT(j)  (256  + 64 * (j))
#define XB_XSUB(j)  (1280 + 64 * (j))
#define XB_XGEN(j)  (2304 + 64 * (j))
#define XB_TOP      3328
#define XB_TOPGEN   3392
#define XCD_BAR_WORDS 3456
#define XB_SPIN_CAP (1u << 22)
#ifndef HOST_EMU
__device__ __forceinline__ unsigned xb_ld(unsigned* p) { return __hip_atomic_load(p, __ATOMIC_RELAXED, __HIP_MEMORY_SCOPE_AGENT); }
__device__ __forceinline__ unsigned xb_add(unsigned* p, unsigned v) { return __hip_atomic_fetch_add(p, v, __ATOMIC_RELAXED, __HIP_MEMORY_SCOPE_AGENT); }
__device__ __forceinline__ unsigned xb_xcc_id() { return (unsigned)__builtin_amdgcn_s_getreg((3 << 11) | 20) & 0xFu; }
#define XB_SPIN(cond, bar) do { unsigned _sp = 0; while (cond) { __builtin_amdgcn_s_sleep(1); \
    if ((++_sp & 255u) == 0u) { if (xb_ld(&(bar)[XB_TMO])) break; if (_sp > XB_SPIN_CAP) { atomicAdd(&(bar)[XB_TMO], 1u); break; } } } } while (0)
#define XB_LAS __attribute__((address_space(3)))
struct XcdBarrier { unsigned off; unsigned x; volatile XB_LAS unsigned* st; unsigned G; };
__device__ __forceinline__ XcdBarrier xcd_barrier_post(unsigned* ctrl, unsigned off, volatile XB_LAS unsigned* st, unsigned G, bool member = true) {
    XcdBarrier b; b.off = off; b.x = xb_xcc_id(); b.st = st; b.G = G; unsigned* bar = ctrl + off;
    if (!member) return b;
    if (threadIdx.x == 0) (void)xb_add(&bar[XB_XCNT(b.x)], 1u);
    return b;
}
__device__ __forceinline__ void xcd_barrier_complete(unsigned* bar, unsigned x, unsigned& nloc, unsigned& nx, unsigned G) {
    unsigned sum, cnt, mine, sp = 0u;
    for (;;) {
        sum = 0u; cnt = 0u; mine = 0u;
#pragma unroll
        for (unsigned j = 0; j < 16; ++j) { const unsigned c = xb_ld(&bar[XB_XCNT(j)]); sum += c; cnt += (c > 0u) ? 1u : 0u; mine = (j == x) ? c : mine; }
        if (sum == G) break;
        __builtin_amdgcn_s_sleep(1);
        if ((++sp & 255u) == 0u) { if (xb_ld(&bar[XB_TMO])) break; if (sp > XB_SPIN_CAP) { atomicAdd(&bar[XB_TMO], 1u); break; } }
    }
    nloc = mine > 0u ? mine : 1u; nx = cnt > 0u ? cnt : 1u;
}
__device__ __forceinline__ void grid_barrier(const XcdBarrier& b, unsigned* ctrl) {
    asm volatile("s_waitcnt vmcnt(0)" ::: "memory");
    __syncthreads();
    if (threadIdx.x == 0) {
        unsigned* bar = ctrl + b.off;
        __builtin_amdgcn_s_waitcnt(0);
        volatile XB_LAS unsigned* st = b.st;
        unsigned nloc = st[0], nx = st[1];
        if (nloc == 0u) { xcd_barrier_complete(bar, b.x, nloc, nx, b.G); st[0] = nloc; st[1] = nx; }
        const unsigned old = xb_add(&bar[XB_XSUB(b.x)], 1u);
        const unsigned gen = old / nloc;
        if (old + 1u == (gen + 1u) * nloc) {
            __builtin_amdgcn_fence(__ATOMIC_RELEASE, "agent");
            asm volatile("s_waitcnt vmcnt(0)" ::: "memory");
            const unsigned og = xb_add(&bar[XB_TOP], 1u);
            const unsigned tg = og / nx;
            if (og + 1u == (tg + 1u) * nx) xb_add(&bar[XB_TOPGEN], 1u);
            else XB_SPIN(xb_ld(&bar[XB_TOPGEN]) == tg, bar);
            __builtin_amdgcn_fence(__ATOMIC_ACQUIRE, "agent");
            xb_add(&bar[XB_XGEN(b.x)], 1u);
            asm volatile("s_waitcnt vmcnt(0)" ::: "memory");
        } else {
            XB_SPIN(xb_ld(&bar[XB_XGEN(b.x)]) == gen, bar);
            __builtin_amdgcn_fence(__ATOMIC_ACQUIRE, "agent");
            asm volatile("s_waitcnt vmcnt(0)" ::: "memory");
        }
    }
    __syncthreads();
}
#else
struct XcdBarrier { int dummy; };
__device__ __forceinline__ void grid_barrier(const XcdBarrier&, unsigned*) { __syncthreads(); }
#endif

__global__ void __launch_bounds__(256, 2) fused_forward(Params p) {
    __shared__ __attribute__((aligned(16))) char smem[SMEM_BYTES];
    __shared__ __attribute__((aligned(16))) unsigned xb_words[4];
    if (threadIdx.x == 0) { xb_words[0] = 0u; xb_words[1] = 0u; xb_words[2] = 0u; xb_words[3] = 0u; }
    __syncthreads();
    const int bid = blockIdx.x, nblk = gridDim.x;
    const bool split = nblk >= 2 * NCHAIN;
#ifdef HOST_EMU
    const XcdBarrier gb{0}; const XcdBarrier gs{0};
#else
    const XcdBarrier gb = xcd_barrier_post(WSP(unsigned, WS_CTRL), 0u, (volatile XB_LAS unsigned*)xb_words, (unsigned)nblk);
    const XcdBarrier gs = xcd_barrier_post(WSP(unsigned, WS_CTRL), (unsigned)XCD_BAR_WORDS, (volatile XB_LAS unsigned*)xb_words + 2, (unsigned)(nblk - NCHAIN), split && bid >= NCHAIN);
#endif
    phaseA(p, bid, nblk, smem); grid_barrier(gb, WSP(unsigned, WS_CTRL));
    phaseB(p, bid, nblk, smem); grid_barrier(gb, WSP(unsigned, WS_CTRL));
    phaseC(p, bid, nblk, smem); grid_barrier(gb, WSP(unsigned, WS_CTRL));
    phaseD(p, bid, nblk, smem);
    phaseR1(p, bid, nblk, smem); grid_barrier(gb, WSP(unsigned, WS_CTRL));
    {
        const int lb = split ? bid - NCHAIN : bid, ln = split ? nblk - NCHAIN : nblk;
        const bool lru_member = !split || bid >= NCHAIN;
        if (!split || bid < NCHAIN) phaseR2(p, bid, split ? NCHAIN : nblk, smem);
        if (lru_member) phaseE(p, lb, ln, smem);
        if (split) { if (lru_member) grid_barrier(gs, WSP(unsigned, WS_CTRL)); } else grid_barrier(gb, WSP(unsigned, WS_CTRL));
        if (lru_member) phaseF(p, lb, ln, smem);
        grid_barrier(gb, WSP(unsigned, WS_CTRL));
    }
    phaseR3(p, bid, nblk, smem); grid_barrier(gb, WSP(unsigned, WS_CTRL));
    phaseJ(p, bid, nblk, smem); grid_barrier(gb, WSP(unsigned, WS_CTRL));
    phaseK(p, bid, nblk, smem); grid_barrier(gb, WSP(unsigned, WS_CTRL));
    phaseL(p, bid, nblk, smem); grid_barrier(gb, WSP(unsigned, WS_CTRL));
    phaseM(p, bid, nblk, smem); grid_barrier(gb, WSP(unsigned, WS_CTRL));
    phaseN(p, bid, nblk, smem); grid_barrier(gb, WSP(unsigned, WS_CTRL));
    phaseO(p, bid, nblk, smem);
}

#ifdef MULTI_LAUNCH
#define PHASE_KERNEL(NAME) \
    __global__ void __launch_bounds__(256) k_##NAME(Params p) { __shared__ __attribute__((aligned(16))) char smem[SMEM_BYTES]; NAME(p, blockIdx.x, gridDim.x, smem); }
PHASE_KERNEL(phaseA) PHASE_KERNEL(phaseB) PHASE_KERNEL(phaseC) PHASE_KERNEL(phaseD) PHASE_KERNEL(phaseE) PHASE_KERNEL(phaseF) PHASE_KERNEL(phaseR1) PHASE_KERNEL(phaseR2) PHASE_KERNEL(phaseR3)
PHASE_KERNEL(phaseJ) PHASE_KERNEL(phaseK) PHASE_KERNEL(phaseL) PHASE_KERNEL(phaseM) PHASE_KERNEL(phaseN) PHASE_KERNEL(phaseO)
#ifdef HOST_EMU
void emu_hook(const char* name, const Params& p);
#define LAUNCH(NAME, grid) do { EMU_LAUNCH(k_##NAME, grid, 256, p); emu_hook(#NAME, p); } while (0)
#else
#define LAUNCH(NAME, grid) hipLaunchKernelGGL(k_##NAME, dim3(grid), dim3(256), 0, stream, p)
#endif
#endif

extern "C" void kernel_launch(void* const* d_in, const int* in_sizes, int n_in, void* d_out, int out_size, void* d_ws, size_t ws_size, hipStream_t stream) {
    if (n_in != 38 || out_size != MLAT * D_MODEL || ws_size < WS_END) { fprintf(stderr, "kernel_launch: unexpected shapes (n_in %d out %d ws %zu need %zu)\n", n_in, out_size, ws_size, (size_t)WS_END); return; }
    Params p{};
    const float** f = (const float**)&p;
    for (int i = 0; i < 38; ++i) f[i] = (const float*)d_in[i];
    p.out = (float*)d_out; p.ws = (unsigned char*)d_ws;
#ifdef MULTI_LAUNCH
    const int G = 512;
    LAUNCH(phaseA, 6 * D_MODEL / 16);
    LAUNCH(phaseB, G);
    LAUNCH(phaseC, G);
    LAUNCH(phaseD, G);
    LAUNCH(phaseE, 16);
    LAUNCH(phaseF, G);
    LAUNCH(phaseR1, G);
    LAUNCH(phaseR2, NCHAIN);
    LAUNCH(phaseR3, G);
    LAUNCH(phaseJ, G);
    LAUNCH(phaseK, G);
    LAUNCH(phaseL, BATCH * N_EXPERTS);
    LAUNCH(phaseM, G);
    LAUNCH(phaseN, G);
    LAUNCH(phaseO, G);
#elif defined(HOST_EMU)
    EMU_LAUNCH(fused_forward, 1, 256, p);
#else
    static int grid_blocks = 0;
    if (!grid_blocks) {
        int dev = 0, cus = 0, per_cu = 0;
        (void)hipGetDevice(&dev);
        (void)hipDeviceGetAttribute(&cus, hipDeviceAttributeMultiprocessorCount, dev);
        (void)hipOccupancyMaxActiveBlocksPerMultiprocessor(&per_cu, fused_forward, 256, 0);
        if (per_cu > 2) per_cu = 2;
        if (per_cu < 1) { fprintf(stderr, "kernel_launch: occupancy query returned %d blocks per CU\n", per_cu); per_cu = 1; }
        grid_blocks = cus * per_cu;
    }
    (void)hipMemsetAsync((char*)d_ws + WS_CTRL, 0, 2 * XCD_BAR_WORDS * 4, stream);
    void* args[] = {&p};
    hipError_t e = hipLaunchCooperativeKernel((void*)fused_forward, dim3(grid_blocks), dim3(256), args, 0, stream);
    if (e != hipSuccess) fprintf(stderr, "cooperative launch failed: %s (grid %d)\n", hipGetErrorString(e), grid_blocks);
#endif
}
```

```cpp
#ifndef HOST_EMU
#include <hip/hip_runtime.h>
#include <cstdio>
#endif
#include <cstdint>
#include <cstddef>

#ifdef CFG_SMALL
constexpr int D_MODEL = 256, BATCH = 2, SEQ = 256, GRID_W = 16, CTX_LEN = 64, LRU_BLOCKS = 2, N_EXPERTS = 4, D_EXPERT = 256;
#else
constexpr int D_MODEL = 1024, BATCH = 4, SEQ = 4096, GRID_W = 64, CTX_LEN = 256, LRU_BLOCKS = 8, N_EXPERTS = 16, D_EXPERT = 1408;
#endif
constexpr int ROWS = SEQ / GRID_W;
constexpr int D_LRU = D_MODEL / 2, LRU_BLOCK = 64;
constexpr int D_RWKV = D_MODEL / 2, HEADS = D_RWKV / 64;
constexpr int D_RWKV_IN = 3 * D_RWKV + 128 + 128 + 128;
constexpr int D_IN = 2 * D_LRU + D_RWKV_IN;
constexpr int D_MIX = D_LRU + D_RWKV;
constexpr int CAP = 2 * SEQ / N_EXPERTS;
constexpr int MLAT = BATCH * SEQ, MCTX = BATCH * CTX_LEN, MTOT = MLAT + MCTX;
constexpr int NMOD = BATCH + 1;
constexpr int RW0 = 2 * D_LRU;
constexpr float ALPHA_F = 1.189207115002721f;
constexpr float LN_EPS = 1e-5f, GN_EPS = 64e-5f, RMS_EPS = 1e-6f;
static_assert(LRU_BLOCKS * LRU_BLOCK == D_LRU, "lru blocks");
static_assert(CAP % 128 == 0 && D_IN % 128 == 0 && D_EXPERT % 64 == 0 && D_MODEL % 128 == 0 && MTOT % 128 == 0 && D_MIX % 64 == 0, "tile divisibility");

typedef unsigned short bf16_t;
typedef short bf16x8 __attribute__((ext_vector_type(8)));
typedef float f32x4 __attribute__((ext_vector_type(4)));
typedef unsigned u32x4 __attribute__((ext_vector_type(4)));
typedef float f32x2_e __attribute__((ext_vector_type(2)));
typedef unsigned U2 __attribute__((ext_vector_type(2)));

#ifdef HOST_EMU
#define MFMA16(a, b, c) emu_mfma_16x16x32_bf16(a, b, c)
#define MFMAF32(a, b, c) emu_mfma_16x16x4_f32(a, b, c)
#else
#define MFMA16(a, b, c) __builtin_amdgcn_mfma_f32_16x16x32_bf16(a, b, c, 0, 0, 0)
#define MFMAF32(a, b, c) __builtin_amdgcn_mfma_f32_16x16x4f32(a, b, c, 0, 0, 0)
#endif

__device__ __forceinline__ unsigned fbits(float f) { return __builtin_bit_cast(unsigned, f); }
__device__ __forceinline__ float bitsf(unsigned u) { return __builtin_bit_cast(float, u); }
__device__ __forceinline__ bf16_t f2bf(float f) { unsigned u = fbits(f); u += 0x7FFFu + ((u >> 16) & 1u); return (bf16_t)(u >> 16); }
__device__ __forceinline__ float bf2f(bf16_t h) { return bitsf(((unsigned)h) << 16); }
#ifdef HOST_EMU
__device__ __forceinline__ unsigned pk2(float lo, float hi) { return (unsigned)f2bf(lo) | ((unsigned)f2bf(hi) << 16); }
#else
typedef float f32x2_t __attribute__((ext_vector_type(2)));
typedef __bf16 bf16x2_t __attribute__((ext_vector_type(2)));
__device__ __forceinline__ unsigned pk2(float lo, float hi) { return __builtin_bit_cast(unsigned, __builtin_convertvector(f32x2_t{lo, hi}, bf16x2_t)); }
#endif
__device__ __forceinline__ float softplusf_(float x) { return fmaxf(x, 0.0f) + log1pf(expf(-fabsf(x))); }
#ifdef HOST_EMU
#define FEXP(x) expf(x)
#else
#define FEXP(x) __expf(x)
#endif
#ifdef HOST_EMU
__device__ __forceinline__ float frcp(float x) { return 1.0f / x; }
__device__ __forceinline__ float frsq(float x) { return 1.0f / sqrtf(x); }
__device__ __forceinline__ float fsqrt(float x) { return sqrtf(x); }
#else
__device__ __forceinline__ float frcp(float x) { return __builtin_amdgcn_rcpf(x); }
__device__ __forceinline__ float frsq(float x) { return __builtin_amdgcn_rsqf(x); }
__device__ __forceinline__ float fsqrt(float x) { return __builtin_amdgcn_sqrtf(x); }
#endif
__device__ __forceinline__ float fsigm(float x) { return frcp(1.0f + FEXP(-x)); }
__device__ __forceinline__ float siluf_(float x) { return x * fsigm(x); }
__device__ __forceinline__ float geluf_(float x) { return x * fsigm(1.5957691216057308f * (x + 0.044715f * x * x * x)); }
__device__ __forceinline__ int opaque_tid() {
    int t = threadIdx.x;
#ifndef HOST_EMU
    asm volatile("" : "+v"(t));
#endif
    return t;
}
__device__ __forceinline__ float wave_sum(float v) {
#pragma unroll
    for (int o = 1; o < 64; o <<= 1) v += __shfl_xor(v, o);
    return v;
}

constexpr size_t al256(size_t x) { return (x + 255) & ~(size_t)255; }
constexpr int NLCH = BATCH * (SEQ / 64), NCCH = BATCH * (CTX_LEN / 64), NCH = NLCH + NCCH;
constexpr size_t WS_CTRL = 0;
constexpr size_t WS_MOD = 65536;
constexpr size_t WS_STATS = al256(WS_MOD + (size_t)NMOD * 6 * D_MODEL * 4);
constexpr size_t WS_SUMA = al256(WS_STATS + (size_t)MTOT * 2 * 4);
constexpr size_t WS_SUMH = al256(WS_SUMA + (size_t)2 * NCH * D_LRU * 4);
constexpr size_t WS_CARRY = al256(WS_SUMH + (size_t)2 * NCH * D_LRU * 4);
constexpr size_t WS_SSQP = al256(WS_CARRY + (size_t)2 * NLCH * D_LRU * 4);
constexpr size_t WS_RINV = al256(WS_SSQP + (size_t)MLAT * LRU_BLOCKS * 4);
constexpr size_t WS_BON = al256(WS_RINV + (size_t)MLAT * 4);
constexpr size_t WS_AFF = al256(WS_BON + (size_t)2 * MLAT * HEADS * 4 + 4096 * 64);
constexpr size_t WS_IDX = al256(WS_AFF + (size_t)MLAT * N_EXPERTS * 4);
constexpr size_t WS_GATE = al256(WS_IDX + (size_t)BATCH * N_EXPERTS * CAP * 4);
constexpr size_t WS_SLOT = al256(WS_GATE + (size_t)BATCH * N_EXPERTS * CAP * 4);
constexpr size_t WS_WBIN = al256(WS_SLOT + (size_t)MLAT * N_EXPERTS * 4);
constexpr size_t WS_WBOUT = al256(WS_WBIN + (size_t)D_IN * D_MODEL * 2);
constexpr size_t WS_LORA = al256(WS_WBOUT + (size_t)D_MODEL * D_MIX * 2);
constexpr size_t WS_R1 = al256(WS_LORA + (size_t)2 * 2 * HEADS * 64 * 64 * 2);
constexpr size_t R1_BYTES = (size_t)MTOT * D_IN * 2 > (size_t)MLAT * D_MODEL * 4 ? ((size_t)MTOT * D_IN * 2 > (size_t)BATCH * N_EXPERTS * CAP * D_EXPERT * 2 ? (size_t)MTOT * D_IN * 2 : (size_t)BATCH * N_EXPERTS * CAP * D_EXPERT * 2)
                                                                                  : ((size_t)MLAT * D_MODEL * 4 > (size_t)BATCH * N_EXPERTS * CAP * D_EXPERT * 2 ? (size_t)MLAT * D_MODEL * 4 : (size_t)BATCH * N_EXPERTS * CAP * D_EXPERT * 2);
constexpr size_t WS_R3 = al256(WS_R1 + R1_BYTES);
constexpr int RC = 32;
constexpr int NCC = CTX_LEN / RC, NLC = SEQ / RC, NCK = NCC + NLC, NCHAIN = BATCH * HEADS * 2;
constexpr size_t CH_PM = 0, CH_SA = 8192, CH_QT = 16384, CH_Y0 = 20480, CH_BYTES = 24576;
constexpr size_t WS_CH = al256(WS_R3 + (size_t)MTOT * D_MODEL * 2);
constexpr size_t CH_TOTAL = (size_t)NCHAIN * NCK * CH_BYTES;
constexpr size_t WS_R5 = WS_CH;
constexpr size_t WS_LA = al256(WS_R5 + (size_t)MLAT * D_MODEL * 4);
constexpr size_t WS_R6 = WS_LA, WS_R2 = WS_LA;
constexpr size_t WEXP_BYTES = (size_t)D_MODEL * D_EXPERT * 2;
constexpr size_t WS_WG = al256(WS_LA + (size_t)MLAT * D_MODEL * 2);
constexpr size_t WS_WU = WS_WG + (size_t)N_EXPERTS * WEXP_BYTES;
constexpr int NE_R3 = ((size_t)MTOT * D_MODEL * 2 / WEXP_BYTES) < (size_t)N_EXPERTS ? (int)((size_t)MTOT * D_MODEL * 2 / WEXP_BYTES) : N_EXPERTS;
constexpr size_t WS_WD2 = WS_WU + (size_t)N_EXPERTS * WEXP_BYTES;
constexpr size_t WS_LATE_END = al256(WS_WD2 + (size_t)(N_EXPERTS - NE_R3) * WEXP_BYTES);
static_assert(WS_LA + (size_t)BATCH * N_EXPERTS * CAP * D_MODEL * 2 <= WS_WD2, "YS must not reach the w_down copies");
constexpr size_t WS_END = (WS_CH + CH_TOTAL > WS_LATE_END) ? al256(WS_CH + CH_TOTAL) : WS_LATE_END;
constexpr size_t WS_RBON = WS_BON;
static_assert((size_t)NCHAIN * NCK * RC * 4 <= (size_t)2 * MLAT * HEADS * 4 + 4096 * 64, "bonus buffer");

struct Params {
    const float *x, *c, *ctx, *c_ctx, *ln_in_g, *ln_in_b, *w_mod, *b_mod, *w_in, *lru_conv_w, *lru_conv_b, *lru_wa, *lru_ba, *lru_wx, *lru_bx, *lru_lam, *lru_norm_g,
        *mu_prev, *mu_next, *w0, *w2, *a0, *a2, *g2, *k_k, *k_a, *r_k, *gn_g, *gn_b, *w_out, *ln1_g, *ln1_b, *w_router, *w_gate, *w_up, *w_down, *ln2_g, *ln2_b;
    float* out;
    unsigned char* ws;
};
#define WSP(T, off) ((T*)(p.ws + (off)))
__device__ __forceinline__ size_t wdown_off(int e) { return e < NE_R3 ? WS_R3 + (size_t)e * WEXP_BYTES : WS_WD2 + (size_t)(e - NE_R3) * WEXP_BYTES; }

constexpr int SMEM_BYTES = 76 * 1024;

__device__ __forceinline__ f32x4 ld4(const float* p) { return *(const f32x4*)p; }
__device__ __forceinline__ f32x4 ldb4(const bf16_t* p) { const U2 u = *(const U2*)p; return f32x4{bitsf(u.x << 16), bitsf(u.x & 0xFFFF0000u), bitsf(u.y << 16), bitsf(u.y & 0xFFFF0000u)}; }
__device__ __forceinline__ float hsum4(f32x4 v) { return (v[0] + v[1]) + (v[2] + v[3]); }
__device__ __forceinline__ U2 pack4(f32x4 v) { U2 o; o.x = pk2(v[0], v[1]); o.y = pk2(v[2], v[3]); return o; }
__device__ __forceinline__ void convert_transpose(const float* src, bf16_t* dst, int K, int N, int t0, int t1, int tstride, char* smem) {
    float* T = (float*)smem;
    const int tid = opaque_tid(), r = tid >> 4, c4 = (tid & 15) * 4, ntn = N / 64;
    f32x4 v[4];
    if (t0 < t1) { const int kt = t0 / ntn, nt = t0 % ntn;
#pragma unroll
        for (int j = 0; j < 4; ++j) v[j] = ld4(src + (size_t)(kt * 64 + r + 16 * j) * N + nt * 64 + c4); }
    for (int t = t0; t < t1; t += tstride) {
        const int kt = t / ntn, nt = t % ntn;
        __syncthreads();
#pragma unroll
        for (int j = 0; j < 4; ++j) { float* d = T + (r + 16 * j) * 65 + c4; d[0] = v[j][0]; d[1] = v[j][1]; d[2] = v[j][2]; d[3] = v[j][3]; }
        __syncthreads();
        if (t + tstride < t1) { const int kt2 = (t + tstride) / ntn, nt2 = (t + tstride) % ntn;
#pragma unroll
            for (int j = 0; j < 4; ++j) v[j] = ld4(src + (size_t)(kt2 * 64 + r + 16 * j) * N + nt2 * 64 + c4); }
        const int n = tid >> 2, kc = (tid & 3) * 16;
        u32x4 o0, o1;
#pragma unroll
        for (int i = 0; i < 4; ++i) { o0[i] = pk2(T[(kc + 2 * i) * 65 + n], T[(kc + 2 * i + 1) * 65 + n]); o1[i] = pk2(T[(kc + 8 + 2 * i) * 65 + n], T[(kc + 9 + 2 * i) * 65 + n]); }
        bf16_t* d = dst + (size_t)(nt * 64 + n) * K + kt * 64 + kc;
        *(u32x4*)d = o0; *(u32x4*)(d + 8) = o1;
    }
    __syncthreads();
}
__device__ void convert_experts(const Params& p, int vb, int nvb, char* smem, int first, int last) {
    constexpr int TPM = (D_MODEL / 64) * (D_EXPERT / 64);
    int m = 0;
    for (int e = 0; e < N_EXPERTS; ++e)
        for (int which = first; which < last; ++which, ++m) {
            const float* src = (which == 0 ? p.w_gate : which == 1 ? p.w_up : p.w_down) + (size_t)e * D_MODEL * D_EXPERT;
            bf16_t* dst = which == 0 ? WSP(bf16_t, WS_WG + (size_t)e * WEXP_BYTES) : which == 1 ? WSP(bf16_t, WS_WU + (size_t)e * WEXP_BYTES) : WSP(bf16_t, wdown_off(e));
            const int K = which == 2 ? D_EXPERT : D_MODEL, N = which == 2 ? D_MODEL : D_EXPERT;
            const int start = ((vb - (m * TPM) % nvb) % nvb + nvb) % nvb;
            convert_transpose(src, dst, K, N, start, TPM, nvb, smem);
        }
}

__device__ __forceinline__ void phaseA(const Params& p, int bid, int nblk, char* smem) {
    float* sc = (float*)smem;
    float* red = sc + NMOD * D_MODEL;
    const int tid = opaque_tid();
    constexpr int NA = 6 * D_MODEL / 16;
    {
        const bool spare = nblk > NA + 32;
        const int vb = spare ? bid - NA : bid, nvb = spare ? nblk - NA : nblk;
        if (!spare || bid >= NA) {
            constexpr int T1 = (D_MODEL / 64) * (D_IN / 64), T2 = (D_MIX / 64) * (D_MODEL / 64);
            convert_transpose(p.w_in, WSP(bf16_t, WS_WBIN), D_MODEL, D_IN, vb, T1, nvb, smem);
            convert_transpose(p.w_out, WSP(bf16_t, WS_WBOUT), D_MIX, D_MODEL, ((vb - T1 % nvb) % nvb + nvb) % nvb, T2, nvb, smem);
            for (int idx = vb * 256 + tid; idx < 2 * 2 * HEADS * 64 * 64; idx += nvb * 256) {
                const int i = idx & 63, j = (idx >> 6) & 63, hh = (idx >> 12) % HEADS, which = (idx >> 12) / HEADS % 2, dd = (idx >> 12) / HEADS / 2;
                WSP(bf16_t, WS_LORA)[idx] = f2bf((which ? p.a2 : p.w2)[((size_t)dd * 64 + i) * D_RWKV + hh * 64 + j]);
            }
        }
        if (spare && bid >= NA) return;
    }
    if (bid >= NA) return;
    __syncthreads();
    for (int i = tid; i < NMOD * D_MODEL; i += 256) {
        const int r = i / D_MODEL, k = i % D_MODEL;
        const float v = (r < BATCH) ? p.c[r * D_MODEL + k] : p.c_ctx[k];
        sc[i] = siluf_(v);
    }
    __syncthreads();
    float* MOD = WSP(float, WS_MOD);
    const int col = tid & 15, kg = tid >> 4;
    constexpr int KPT = D_MODEL / 16;
    for (int cb = bid; cb < 6 * D_MODEL / 16; cb += nblk) {
        const int n = cb * 16 + col;
        float acc[NMOD];
#pragma unroll
        for (int r = 0; r < NMOD; ++r) acc[r] = 0.f;
        const float* wp = p.w_mod + (size_t)(kg * KPT) * (6 * D_MODEL) + n;
#pragma unroll 16
        for (int kk = 0; kk < KPT; ++kk) {
            const float w = wp[(size_t)kk * (6 * D_MODEL)];
#pragma unroll
            for (int r = 0; r < NMOD; ++r) acc[r] += sc[r * D_MODEL + kg * KPT + kk] * w;
        }
#pragma unroll
        for (int r = 0; r < NMOD; ++r) red[(kg * NMOD + r) * 16 + col] = acc[r];
        __syncthreads();
        if (tid < NMOD * 16) {
            const int r = tid >> 4, c2 = tid & 15;
            float s2 = p.b_mod[cb * 16 + c2];
#pragma unroll
            for (int g = 0; g < 16; ++g) s2 += red[(g * NMOD + r) * 16 + c2];
            MOD[(size_t)r * 6 * D_MODEL + cb * 16 + c2] = s2;
        }
        __syncthreads();
    }
}

constexpr int NV = D_MODEL / 256;
__device__ __forceinline__ void phaseB(const Params& p, int bid, int nblk, char* smem) {
    const int tid_ = opaque_tid(), lane = tid_ & 63, wave = tid_ >> 6;
    const float* MOD = WSP(float, WS_MOD);
    float* STATS = WSP(float, WS_STATS);
    bf16_t* U = WSP(bf16_t, WS_R3);
    auto rowptr = [&](int row) { return (row < MLAT) ? p.x + (size_t)row * D_MODEL : p.ctx + (size_t)(row - MLAT) * D_MODEL; };
    int row = bid * 4 + wave;
    f32x4 n0 = f32x4{0.f, 0.f, 0.f, 0.f}, n1 = n0, n2 = n0, n3 = n0;
    if (row < MTOT) { const float* xr = rowptr(row); n0 = ld4(xr + lane * 4); if (NV > 1) n1 = ld4(xr + 256 + lane * 4); if (NV > 2) { n2 = ld4(xr + 512 + lane * 4); n3 = ld4(xr + 768 + lane * 4); } }
    for (; row < MTOT; row += nblk * 4) {
        const int mr = (row < MLAT) ? row / SEQ : BATCH;
        const float* md = MOD + (size_t)mr * 6 * D_MODEL;
        f32x4 v0 = n0, v1 = n1, v2 = n2, v3 = n3;
        const int nrow = row + nblk * 4;
        if (nrow < MTOT) { const float* xr = rowptr(nrow); n0 = ld4(xr + lane * 4); if (NV > 1) n1 = ld4(xr + 256 + lane * 4); if (NV > 2) { n2 = ld4(xr + 512 + lane * 4); n3 = ld4(xr + 768 + lane * 4); } }
        float s = hsum4(v0);
        if (NV > 1) s += hsum4(v1);
        if (NV > 2) s += hsum4(v2) + hsum4(v3);
        const float mu = wave_sum(s) * (1.0f / D_MODEL);
        v0 -= mu; float s2 = hsum4(v0 * v0);
        if (NV > 1) { v1 -= mu; s2 += hsum4(v1 * v1); }
        if (NV > 2) { v2 -= mu; v3 -= mu; s2 += hsum4(v2 * v2) + hsum4(v3 * v3); }
        const float rstd = frsq(wave_sum(s2) * (1.0f / D_MODEL) + LN_EPS);
        if (lane == 0) { STATS[row * 2] = mu; STATS[row * 2 + 1] = rstd; }
#pragma unroll
        for (int j = 0; j < NV; ++j) {
            const int k = j * 256 + lane * 4;
            const f32x4 vv = (j == 0) ? v0 : (j == 1) ? v1 : (j == 2) ? v2 : v3;
            const f32x4 h = vv * rstd * ld4(p.ln_in_g + k) + ld4(p.ln_in_b + k);
            *(U2*)(U + (size_t)row * D_MODEL + k) = pack4(h * (1.0f + ld4(md + D_MODEL + k)) + ld4(md + k));
        }
    }
}

constexpr int LDK = 64;
template <int MI, bool DUAL, class Epi>
__device__ __forceinline__ void gemm_tile(char* smem, const bf16_t* A, int lda, const int* rowidx, int m0, const bf16_t* Bt0, const bf16_t* Bt1, int ldb, int n0, int K, Epi epi, const float* rowscale = nullptr, int kscale = 0) {
    constexpr int BM = 32 * MI;
    bf16_t* As = (bf16_t*)smem;
    bf16_t* Bs = As + BM * LDK;
    int tid = threadIdx.x;
#ifndef HOST_EMU
    asm volatile("" : "+v"(tid));
#endif
    const int lane = tid & 63, wave = tid >> 6, wr = wave >> 1, wc = wave & 1, l15 = lane & 15, q = lane >> 4;
    const int ch = tid & 7, r0 = tid >> 3;
    unsigned aoff[MI], boff[4];
#pragma unroll
    for (int j = 0; j < MI; ++j) { const int r = m0 + r0 + 32 * j; aoff[j] = (unsigned)(rowidx ? rowidx[r] : r) * (unsigned)lda + ch * 8; }
#pragma unroll
    for (int j = 0; j < 4; ++j) boff[j] = (unsigned)(n0 + (DUAL ? (j >> 1) * 32 + r0 : r0 + 32 * j)) * (unsigned)ldb + ch * 8;
    const int wofs = r0 * LDK + ((ch ^ (r0 & 7)) * 8);
    u32x4 ar[MI], br[4];
    f32x4 acc[MI][4];
#pragma unroll
    for (int i = 0; i < MI; ++i)
#pragma unroll
        for (int j = 0; j < 4; ++j) acc[i][j] = f32x4{0.f, 0.f, 0.f, 0.f};
    const int nk = K / 64;
#pragma unroll
    for (int j = 0; j < MI; ++j) ar[j] = *(const u32x4*)(A + aoff[j]);
#pragma unroll
    for (int j = 0; j < 4; ++j) br[j] = *(const u32x4*)(((DUAL && (j & 1)) ? Bt1 : Bt0) + boff[j]);
    for (int kt = 0; kt < nk; ++kt) {
        __syncthreads();
#pragma unroll
        for (int j = 0; j < MI; ++j) *(u32x4*)(As + wofs + 32 * j * LDK) = ar[j];
#pragma unroll
        for (int j = 0; j < 4; ++j) *(u32x4*)(Bs + wofs + 32 * j * LDK) = br[j];
        __syncthreads();
        if (kt + 1 < nk) {
            const int ko = (kt + 1) * 64;
#pragma unroll
            for (int j = 0; j < MI; ++j) ar[j] = *(const u32x4*)(A + aoff[j] + ko);
#pragma unroll
            for (int j = 0; j < 4; ++j) br[j] = *(const u32x4*)(((DUAL && (j & 1)) ? Bt1 : Bt0) + boff[j] + ko);
        }
#pragma unroll
        for (int ks = 0; ks < 2; ++ks) {
            const int cofs = ((ks * 4 + q) ^ (l15 & 7)) * 8;
            bf16x8 bfr[4];
#pragma unroll
            for (int ni = 0; ni < 4; ++ni) bfr[ni] = *(const bf16x8*)(Bs + (wc * 64 + ni * 16 + l15) * LDK + cofs);
#pragma unroll
            for (int mi = 0; mi < MI; ++mi) {
                const bf16x8 af = *(const bf16x8*)(As + (wr * (16 * MI) + mi * 16 + l15) * LDK + cofs);
#pragma unroll
                for (int ni = 0; ni < 4; ++ni) acc[mi][ni] = MFMA16(bfr[ni], af, acc[mi][ni]);
            }
        }
        if (rowscale && kt + 1 == kscale) {
#pragma unroll
            for (int mi = 0; mi < MI; ++mi) {
                const float rs = rowscale[m0 + wr * (16 * MI) + mi * 16 + l15];
#pragma unroll
                for (int ni = 0; ni < 4; ++ni) acc[mi][ni] *= rs;
            }
        }
    }
#pragma unroll
    for (int mi = 0; mi < MI; ++mi) {
        const int ml = wr * (16 * MI) + mi * 16 + l15;
        if (DUAL) {
#pragma unroll
            for (int ni = 0; ni < 2; ++ni) epi(ml, wc * 32 + ni * 16 + q * 4, acc[mi][ni], acc[mi][ni + 2]);
        } else {
#pragma unroll
            for (int ni = 0; ni < 4; ++ni) epi(ml, wc * 64 + ni * 16 + q * 4, acc[mi][ni], acc[mi][ni]);
        }
    }
    __syncthreads();
}

__device__ __forceinline__ int xcd_vbid(int bid, int nblk) { return (nblk % 8 == 0) ? (bid % 8) * (nblk / 8) + bid / 8 : bid; }
constexpr int MI_C = (MTOT % 256 == 0) ? 8 : 4, MI_J = (MLAT % 256 == 0) ? 8 : 4, MI_E = (CAP % 256 == 0) ? 8 : 4;
__device__ __forceinline__ void phaseC(const Params& p, int bid, int nblk, char* smem) {
    const bf16_t* U = WSP(bf16_t, WS_R3); const bf16_t* WB = WSP(bf16_t, WS_WBIN);
    bf16_t* P = WSP(bf16_t, WS_R1);
    constexpr int BM = 32 * MI_C, NTN = D_IN / 128, NTM = MTOT / BM;
    constexpr int GM = (NTM % 8 == 0) ? 8 : (NTM % 4 == 0) ? 4 : 1;
    for (int it = xcd_vbid(bid, nblk); it < NTN * NTM; it += nblk) {
        const int mg = it / (GM * NTN), r = it % (GM * NTN), nt = r / GM, mt = mg * GM + (r % GM);
        gemm_tile<MI_C, false>(smem, U, D_MODEL, nullptr, mt * BM, WB, nullptr, D_MODEL, nt * 128, D_MODEL, [&](int ml, int nl, f32x4 v, f32x4) {
            *(U2*)(P + (size_t)(mt * BM + ml) * D_IN + nt * 128 + nl) = pack4(v);
        });
    }
}


template <int NYT, int KS>
__device__ __forceinline__ void mmT(f32x4* acc, const bf16_t* X, int ldx, int xs, const bf16_t* Y, int ldy, int lane) {
#pragma unroll
    for (int ks = 0; ks < KS; ++ks) {
        const bf16x8 xf = *(const bf16x8*)(X + (xs * 16 + (lane & 15)) * ldx + ks * 32 + 8 * (lane >> 4));
#pragma unroll
        for (int nb = 0; nb < NYT; ++nb) {
            const bf16x8 yf = *(const bf16x8*)(Y + (nb * 16 + (lane & 15)) * ldy + ks * 32 + 8 * (lane >> 4));
            acc[nb] = MFMA16(xf, yf, acc[nb]);
        }
    }
}

struct SeqChunk { int base_row; int t0; int len; };
__device__ __forceinline__ SeqChunk lru_chunk(int cg) {
    SeqChunk s;
    if (cg < NLCH) { const int b = cg / (SEQ / 64), ck = cg % (SEQ / 64); s.base_row = b * SEQ; s.t0 = ck * 64; s.len = SEQ; }
    else { const int c2 = cg - NLCH; const int b = c2 / (CTX_LEN / 64), ck = c2 % (CTX_LEN / 64); s.base_row = MLAT + b * CTX_LEN; s.t0 = ck * 64; s.len = CTX_LEN; }
    return s;
}
constexpr int L_XIN = 0;
constexpr int L_GT = 8704;
constexpr int L_XB = L_GT + 9216;
constexpr int L_WT = L_XB + 9216;
constexpr int L_CP = L_WT + 36864;
constexpr int L_END = L_CP + 4096;
static_assert(L_END <= SMEM_BYTES, "lru lds");
__device__ __forceinline__ void lru_load_w(const Params& p, char* smem, int cb) {
    bf16_t* WT = (bf16_t*)(smem + L_WT);
    const int tid = opaque_tid();
    for (int idx = tid; idx < 4 * 64 * 16; idx += 256) {
        const int m = idx >> 10, i = (idx >> 4) & 63, j4 = (idx & 15) * 4, d = m >> 1;
        const f32x4 w = ld4(((m & 1) ? p.lru_wx : p.lru_wa) + ((size_t)(d * LRU_BLOCKS + cb) * 64 + i) * 64 + j4);
        bf16_t* dst = WT + (m * 64 + j4) * 72 + i;
        dst[0] = f2bf(w[0]); dst[72] = f2bf(w[1]); dst[144] = f2bf(w[2]); dst[216] = f2bf(w[3]);
    }
}
struct LruConst { float ba[2][4], bx[2][4], sp8[2][4], gn[4], cw[4], cb0; };
__device__ __forceinline__ void lru_consts(const Params& p, int cb, LruConst& K) {
    const int l15 = threadIdx.x & 15, c = threadIdx.x & 63, ch = cb * 64 + c;
#pragma unroll
    for (int d = 0; d < 2; ++d)
#pragma unroll
        for (int nb = 0; nb < 4; ++nb) { const int cc = d * D_LRU + cb * 64 + nb * 16 + l15; K.ba[d][nb] = p.lru_ba[cc]; K.bx[d][nb] = p.lru_bx[cc]; K.sp8[d][nb] = -8.0f * softplusf_(-p.lru_lam[cc]); }
#pragma unroll
    for (int nb = 0; nb < 4; ++nb) K.gn[nb] = p.lru_norm_g[cb * 64 + nb * 16 + l15];
#pragma unroll
    for (int j = 0; j < 4; ++j) K.cw[j] = p.lru_conv_w[j * D_LRU + ch];
    K.cb0 = p.lru_conv_b[ch];
}
struct LruStage { u32x4 x[3]; u32x4 g[2]; };
template <bool FINAL>
__device__ __forceinline__ void lru_stage_load(const Params& p, int cg, int cb, LruStage& S) {
    const bf16_t* P = WSP(bf16_t, WS_R1);
    const SeqChunk sc = lru_chunk(cg);
    const int tid = opaque_tid();
#pragma unroll
    for (int k = 0; k < 3; ++k) {
        const int idx = tid + 256 * k, tt = idx >> 3, c8 = (idx & 7) * 8, t = sc.t0 - 1 + tt;
        S.x[k] = u32x4{0u, 0u, 0u, 0u};
        if (idx < 67 * 8 && t >= 0 && t < sc.len) S.x[k] = *(const u32x4*)(P + (size_t)(sc.base_row + t) * D_IN + cb * 64 + c8);
    }
    if (FINAL) {
#pragma unroll
        for (int k = 0; k < 2; ++k) { const int idx = tid + 256 * k, tt = idx >> 3, c8 = (idx & 7) * 8; S.g[k] = *(const u32x4*)(P + (size_t)(sc.base_row + sc.t0 + tt) * D_IN + D_LRU + cb * 64 + c8); }
    }
}
template <bool FINAL>
__device__ __forceinline__ void lru_item(const Params& p, char* smem, int cg, int cb, const LruConst& K, LruStage& S, int cg_next) {
    const bf16_t* P = WSP(bf16_t, WS_R1);
    bf16_t* XIN = (bf16_t*)(smem + L_XIN); bf16_t* GT = (bf16_t*)(smem + L_GT); bf16_t* XB = (bf16_t*)(smem + L_XB); const bf16_t* WT = (const bf16_t*)(smem + L_WT);
    float* CP = (float*)(smem + L_CP);
    const int tid = opaque_tid(), lane = tid & 63, wave = tid >> 6, q = lane >> 4, l15 = lane & 15;
    const SeqChunk sc = lru_chunk(cg);
    __syncthreads();
#pragma unroll
    for (int k = 0; k < 3; ++k) { const int idx = tid + 256 * k, tt = idx >> 3, c8 = (idx & 7) * 8; if (idx < 67 * 8) *(u32x4*)(XIN + tt * 64 + c8) = S.x[k]; }
    if (FINAL) {
#pragma unroll
        for (int k = 0; k < 2; ++k) { const int idx = tid + 256 * k, tt = idx >> 3, c8 = (idx & 7) * 8; *(u32x4*)(GT + tt * 72 + c8) = S.g[k]; }
    }
    if (cg_next >= 0) lru_stage_load<FINAL>(p, cg_next, cb, S);
    __syncthreads();
    {
        const int c = tid & 63;
#pragma unroll 4
        for (int tt = tid >> 6; tt < 64; tt += 4)
            XB[tt * 72 + c] = f2bf(K.cb0 + bf2f(XIN[tt * 64 + c]) * K.cw[0] + bf2f(XIN[(tt + 1) * 64 + c]) * K.cw[1] + bf2f(XIN[(tt + 2) * 64 + c]) * K.cw[2] + bf2f(XIN[(tt + 3) * 64 + c]) * K.cw[3]);
    }
    __syncthreads();
    float hs[4][4];
    float av[4][4], bv[4][4];
#pragma unroll
    for (int d = 0; d < 2; ++d) {
        f32x4 ga[4], gx[4];
#pragma unroll
        for (int nb = 0; nb < 4; ++nb) { ga[nb] = f32x4{0.f, 0.f, 0.f, 0.f}; gx[nb] = f32x4{0.f, 0.f, 0.f, 0.f}; }
        mmT<4, 2>(ga, XB, 72, wave, WT + (2 * d) * 64 * 72, 72, lane);
        mmT<4, 2>(gx, XB, 72, wave, WT + (2 * d + 1) * 64 * 72, 72, lane);
        float cA[4], cH[4];
#pragma unroll
        for (int nb = 0; nb < 4; ++nb) {
            const float ba = K.ba[d][nb], bx = K.bx[d][nb], sp8 = K.sp8[d][nb];
#pragma unroll
            for (int r = 0; r < 4; ++r) {
                const float rg = fsigm(ga[nb][r] + ba), ig = fsigm(gx[nb][r] + bx);
                const float a = FEXP(sp8 * rg);
                const float xv = bf2f(XB[(wave * 16 + q * 4 + r) * 72 + nb * 16 + l15]);
                av[nb][r] = a; bv[nb][r] = fsqrt(fmaxf(1.0f - a * a, 0.f)) * ig * xv;
            }
            float A, H;
            if (d == 0) { A = av[nb][0]; H = bv[nb][0];
#pragma unroll
                for (int r = 1; r < 4; ++r) { H = H * av[nb][r] + bv[nb][r]; A *= av[nb][r]; } }
            else { A = av[nb][3]; H = bv[nb][3];
#pragma unroll
                for (int r = 2; r >= 0; --r) { H = H * av[nb][r] + bv[nb][r]; A *= av[nb][r]; } }
#pragma unroll
            for (int st = 1; st <= 2; st <<= 1) {
                const float pA = d == 0 ? __shfl_up(A, 16 * st) : __shfl_down(A, 16 * st), pH = d == 0 ? __shfl_up(H, 16 * st) : __shfl_down(H, 16 * st);
                const bool has = d == 0 ? (q >= st) : (q + st <= 3);
                if (has) { H = pH * A + H; A = pA * A; }
            }
            cA[nb] = A; cH[nb] = H;
            const bool last = d == 0 ? (q == 3) : (q == 0);
            if (last) { CP[((d * 4 + wave) * 64 + nb * 16 + l15) * 2] = A; CP[((d * 4 + wave) * 64 + nb * 16 + l15) * 2 + 1] = H; }
        }
        __syncthreads();
        if (!FINAL) {
            if (wave == 0 && q == 0) {
#pragma unroll
                for (int nb = 0; nb < 4; ++nb) {
                    const int c = nb * 16 + l15;
                    float A = 1.f, H = 0.f;
#pragma unroll
                    for (int w = 0; w < 4; ++w) { const int ww = d == 0 ? w : 3 - w; const float wa = CP[((d * 4 + ww) * 64 + c) * 2], wh = CP[((d * 4 + ww) * 64 + c) * 2 + 1]; H = H * wa + wh; A *= wa; }
                    WSP(float, WS_SUMA)[((size_t)d * NCH + cg) * D_LRU + cb * 64 + c] = A;
                    WSP(float, WS_SUMH)[((size_t)d * NCH + cg) * D_LRU + cb * 64 + c] = H;
                }
            }
        } else {
#pragma unroll
            for (int nb = 0; nb < 4; ++nb) {
                const int c = nb * 16 + l15;
                float h = WSP(float, WS_CARRY)[((size_t)d * NLCH + cg) * D_LRU + cb * 64 + c];
#pragma unroll
                for (int w = 0; w < 3; ++w) { const int ww = d == 0 ? w : 3 - w; const bool use = d == 0 ? (ww < wave) : (ww > wave);
                    if (use) h = h * CP[((d * 4 + ww) * 64 + c) * 2] + CP[((d * 4 + ww) * 64 + c) * 2 + 1]; }
                const float eA = d == 0 ? __shfl_up(cA[nb], 16) : __shfl_down(cA[nb], 16), eH = d == 0 ? __shfl_up(cH[nb], 16) : __shfl_down(cH[nb], 16);
                const bool first = d == 0 ? (q == 0) : (q == 3);
                if (!first) h = h * eA + eH;
                if (d == 0) {
#pragma unroll
                    for (int r = 0; r < 4; ++r) { h = h * av[nb][r] + bv[nb][r]; hs[nb][r] = h; }
                } else {
#pragma unroll
                    for (int r = 3; r >= 0; --r) { h = h * av[nb][r] + bv[nb][r]; hs[nb][r] += h; }
                }
            }
        }
        __syncthreads();
    }
    if (FINAL) {
        float ss[4] = {0.f, 0.f, 0.f, 0.f};
#pragma unroll
        for (int nb = 0; nb < 4; ++nb) {
            const float gn = K.gn[nb];
#pragma unroll
            for (int r = 0; r < 4; ++r) {
                const int tt = wave * 16 + q * 4 + r;
                const float v = hs[nb][r] * geluf_(bf2f(GT[tt * 72 + nb * 16 + l15]));
                ss[r] += v * v;
                XB[tt * 72 + nb * 16 + l15] = f2bf(v * gn);
            }
        }
#pragma unroll
        for (int r = 0; r < 4; ++r) {
#pragma unroll
            for (int o = 1; o < 16; o <<= 1) ss[r] += __shfl_xor(ss[r], o);
            if (l15 == 0) WSP(float, WS_SSQP)[(size_t)(sc.base_row + sc.t0 + wave * 16 + q * 4 + r) * LRU_BLOCKS + cb] = ss[r];
        }
        __syncthreads();
        bf16_t* MIX = WSP(bf16_t, WS_R3);
        for (int idx = tid; idx < 64 * 8; idx += 256) {
            const int tt = idx >> 3, c8 = (idx & 7) * 8;
            *(u32x4*)(MIX + (size_t)(sc.base_row + sc.t0 + tt) * D_MIX + cb * 64 + c8) = *(const u32x4*)(XB + tt * 72 + c8);
        }
    }
}
__device__ __forceinline__ void phaseD(const Params& p, int bid, int nblk, char* smem) {
    int cur = -1; LruConst K; LruStage S;
    for (int it = bid; it < NCH * LRU_BLOCKS; it += nblk) {
        const int cb = it % LRU_BLOCKS, cg = it / LRU_BLOCKS;
        if (cb != cur) { __syncthreads(); lru_load_w(p, smem, cb); lru_consts(p, cb, K); lru_stage_load<false>(p, cg, cb, S); cur = cb; }
        const int itn = it + nblk;
        lru_item<false>(p, smem, cg, cb, K, S, (itn < NCH * LRU_BLOCKS && itn % LRU_BLOCKS == cb) ? itn / LRU_BLOCKS : -1);
        if (itn < NCH * LRU_BLOCKS && itn % LRU_BLOCKS != cb) cur = -1;
    }
}
__device__ __forceinline__ void phaseE(const Params& p, int bid, int nblk, char* smem) {
    const float* SUMA = WSP(float, WS_SUMA); const float* SUMH = WSP(float, WS_SUMH); float* CARRY = WSP(float, WS_CARRY);
    constexpr int NLB = SEQ / 64, NCB = CTX_LEN / 64;
    for (int g = bid * 256 + threadIdx.x; g < BATCH * 2 * D_LRU; g += nblk * 256) {
        const int c = g % D_LRU, d = (g / D_LRU) & 1, b = g / (2 * D_LRU);
        const float* sa = SUMA + (size_t)d * NCH * D_LRU + c; const float* sh = SUMH + (size_t)d * NCH * D_LRU + c;
        float* cr = CARRY + (size_t)d * NLCH * D_LRU + c;
        float h = 0.f;
        if (d == 0) {
            for (int q2 = 0; q2 < NCB; ++q2) { const int gi = NLCH + b * NCB + q2; h = sa[(size_t)gi * D_LRU] * h + sh[(size_t)gi * D_LRU]; }
            for (int q2 = 0; q2 < NLB; ++q2) { const int gi = b * NLB + q2; cr[(size_t)gi * D_LRU] = h; h = sa[(size_t)gi * D_LRU] * h + sh[(size_t)gi * D_LRU]; }
        } else {
            for (int q2 = NCB - 1; q2 >= 0; --q2) { const int gi = NLCH + b * NCB + q2; h = sa[(size_t)gi * D_LRU] * h + sh[(size_t)gi * D_LRU]; }
            for (int q2 = NLB - 1; q2 >= 0; --q2) { const int gi = b * NLB + q2; cr[(size_t)gi * D_LRU] = h; h = sa[(size_t)gi * D_LRU] * h + sh[(size_t)gi * D_LRU]; }
        }
    }
}
__device__ __forceinline__ void phaseF(const Params& p, int bid, int nblk, char* smem) {
    int cur = -1; LruConst K; LruStage S;
    for (int it = bid; it < NLCH * LRU_BLOCKS; it += nblk) {
        const int cb = it % LRU_BLOCKS, cg = it / LRU_BLOCKS;
        if (cb != cur) { __syncthreads(); lru_load_w(p, smem, cb); lru_consts(p, cb, K); lru_stage_load<true>(p, cg, cb, S); cur = cb; }
        const int itn = it + nblk;
        lru_item<true>(p, smem, cg, cb, K, S, (itn < NLCH * LRU_BLOCKS && itn % LRU_BLOCKS == cb) ? itn / LRU_BLOCKS : -1);
        if (itn < NLCH * LRU_BLOCKS && itn % LRU_BLOCKS != cb) cur = -1;
    }
}

__device__ __forceinline__ size_t rwkv_row(int seg, int b, int s) {
    if (seg == 0) return (size_t)(MLAT + b * CTX_LEN + s);
    const int r = s % ROWS, c = s / ROWS;
    return (size_t)(b * SEQ + r * GRID_W + c);
}
__device__ __forceinline__ void chunk_info(int d, int c, int& seg, int& p0, int& len) {
    if (c < NCC) { seg = 0; len = CTX_LEN; p0 = (d == 0 ? c : NCC - 1 - c) * RC; }
    else { const int cc = c - NCC; seg = 1; len = SEQ; p0 = (d == 0 ? cc : NLC - 1 - cc) * RC; }
}
__device__ __forceinline__ void unpack8(const u32x4 v, float* o) {
    o[0] = bitsf(v[0] << 16); o[1] = bitsf(v[0] & 0xFFFF0000u); o[2] = bitsf(v[1] << 16); o[3] = bitsf(v[1] & 0xFFFF0000u);
    o[4] = bitsf(v[2] << 16); o[5] = bitsf(v[2] & 0xFFFF0000u); o[6] = bitsf(v[3] << 16); o[7] = bitsf(v[3] & 0xFFFF0000u);
}
__device__ __forceinline__ void shifted8(const Params& p, const bf16_t* P, int seg, int b, int pos, int len, int ch0, float* o) {
    float z[8], zp[8], zn[8];
    unpack8(*(const u32x4*)(P + rwkv_row(seg, b, pos) * D_IN + RW0 + ch0), z);
    if (pos > 0) unpack8(*(const u32x4*)(P + rwkv_row(seg, b, pos - 1) * D_IN + RW0 + ch0), zp); else { for (int i = 0; i < 8; ++i) zp[i] = 0.f; }
    if (pos < len - 1) unpack8(*(const u32x4*)(P + rwkv_row(seg, b, pos + 1) * D_IN + RW0 + ch0), zn); else { for (int i = 0; i < 8; ++i) zn[i] = 0.f; }
    const f32x4 mp0 = ld4(p.mu_prev + ch0), mp1 = ld4(p.mu_prev + ch0 + 4), mn0 = ld4(p.mu_next + ch0), mn1 = ld4(p.mu_next + ch0 + 4);
#pragma unroll
    for (int i = 0; i < 4; ++i) { o[i] = z[i] + mp0[i] * (zp[i] - z[i]) + mn0[i] * (zn[i] - z[i]); o[4 + i] = z[4 + i] + mp1[i] * (zp[4 + i] - z[4 + i]) + mn1[i] * (zn[4 + i] - z[4 + i]); }
}
constexpr int LT = 72, LJ = 40;
constexpr int R_RF = 0, R_KF = 8192, R_VF = 16384, R_LW = 24576, R_IC = 32768;
constexpr int R_NKA = 0, R_MBR = 2560, R_MKR = 5120;
constexpr int R_XU = 7680;
constexpr int R_IA = R_XU + 8448, R_IB = R_IA + 4608, R_PA = R_IB + 4608, R_PB = R_PA + 4608;
constexpr int R_WA = R_IB, R_U0 = R_WA + 5120;
constexpr int R_TB0 = R_IB, R_TB1 = R_IB + 2560, R_PB0 = R_IB + 5120, R_PB1 = R_IB + 7680, R_PT0 = R_IB + 10240, R_PT1 = R_IB + 12800;
static_assert(R_PT1 + 2560 <= 40960, "rwkv doubling buffers");
static_assert(R_U0 + 5120 <= R_PB + 4608 && R_PB + 4608 <= 40960, "rwkv scratch");
constexpr int R_O = 40960;
constexpr int R_AH = R_O, R_BH = R_AH + 4608, R_KH = R_BH + 4608, R_RH = R_KH + 4608;
constexpr int R_VT = R_RH + 4608, R_BHT = R_VT + 5120, R_KHT = R_BHT + 5120;
constexpr int R_GC = R_KHT + 5120, R_TOT = R_GC + 256, R_PS = R_TOT + 1024, R_END = R_PS + 1024;
constexpr int R_TW = R_O, R_TA = R_TW + 4608, R_W2T = R_TA + 4608, R_A2T = R_W2T + 9216;
static_assert(R_A2T + 9216 <= R_END && R_END <= SMEM_BYTES, "rwkv lds");

__device__ __forceinline__ void phaseR1(const Params& p, int bid, int nblk, char* smem) {
    const bf16_t* P = WSP(bf16_t, WS_R1);
    unsigned char* CH = p.ws + WS_CH;
    float* RBON = WSP(float, WS_RBON);
    float* Rf = (float*)(smem + R_RF); float* Kf = (float*)(smem + R_KF); float* Vf = (float*)(smem + R_VF); float* LW = (float*)(smem + R_LW); float* IC = (float*)(smem + R_IC);
    float* IA = (float*)(smem + R_IA); float* IB = (float*)(smem + R_IB); float* PA = (float*)(smem + R_PA); float* PB = (float*)(smem + R_PB); bf16_t* NkaT = (bf16_t*)(smem + R_NKA); bf16_t* MbrT = (bf16_t*)(smem + R_MBR); bf16_t* MkrT = (bf16_t*)(smem + R_MKR);
    float* Xu = (float*)(smem + R_XU); bf16_t* Wa = (bf16_t*)(smem + R_WA); bf16_t* U0 = (bf16_t*)(smem + R_U0);
    bf16_t* Ah = (bf16_t*)(smem + R_AH); bf16_t* Bh = (bf16_t*)(smem + R_BH); bf16_t* Kh = (bf16_t*)(smem + R_KH); bf16_t* Rh = (bf16_t*)(smem + R_RH);
    bf16_t* VT = (bf16_t*)(smem + R_VT); bf16_t* BhT = (bf16_t*)(smem + R_BHT); bf16_t* KhT = (bf16_t*)(smem + R_KHT);
    float* GC = (float*)(smem + R_GC); float* TOT = (float*)(smem + R_TOT); float* PS = (float*)(smem + R_PS);
    bf16_t* TW = (bf16_t*)(smem + R_TW); bf16_t* TA = (bf16_t*)(smem + R_TA); bf16_t* W2T = (bf16_t*)(smem + R_W2T); bf16_t* A2T = (bf16_t*)(smem + R_A2T);
    constexpr int NITEM = NCHAIN * NCK;
    const int per = (NITEM + nblk - 1) / nblk;
    const int it0 = bid * per, it1 = (it0 + per < NITEM) ? it0 + per : NITEM;
    for (int it = it0; it < it1; ++it) {
        const int tid = opaque_tid(), lane = tid & 63, wave = tid >> 6, q = lane >> 4, l15 = lane & 15;
        const int chain = it / NCK, c = it % NCK;
        const int d = chain & 1, h = (chain >> 1) % HEADS, b = chain / (2 * HEADS);
        int seg, p0, len; chunk_info(d, c, seg, p0, len);
        unsigned char* chp = CH + (size_t)it * CH_BYTES;
        const float kkc = p.k_k[h * 64 + lane], kac = p.k_a[h * 64 + lane];
        __syncthreads();
        {
            u32x4 wv[4];
#pragma unroll
            for (int k = 0; k < 4; ++k) {
                const int idx = tid + 256 * k, which = idx >> 9, j = (idx >> 3) & 63, c8 = (idx & 7) * 8;
                wv[k] = *(const u32x4*)(WSP(bf16_t, WS_LORA) + ((size_t)((d * 2 + which) * HEADS + h) * 64 + j) * 64 + c8);
            }
#pragma unroll
            for (int kb = 0; kb < 5; kb += 5) {
            u32x4 zc[5], zp[5], zn[5];
#pragma unroll
            for (int k = 0; k < 5; ++k) if (kb + k < 5) {
                const int idx = tid + 256 * (kb + k), tau = idx / 40, g = idx % 40, grp = g >> 3, j0 = (g & 7) * 8;
                const int pos = p0 + (d ? RC - 1 - tau : tau);
                const int ch0 = (grp < 3) ? grp * D_RWKV + h * 64 + j0 : (grp == 3 ? 3 * D_RWKV + d * 64 + j0 : 3 * D_RWKV + 128 + d * 64 + j0);
                const u32x4 zero = u32x4{0u, 0u, 0u, 0u};
                zc[k] = *(const u32x4*)(P + rwkv_row(seg, b, pos) * D_IN + RW0 + ch0);
                zp[k] = (pos > 0) ? *(const u32x4*)(P + rwkv_row(seg, b, pos - 1) * D_IN + RW0 + ch0) : zero;
                zn[k] = (pos < len - 1) ? *(const u32x4*)(P + rwkv_row(seg, b, pos + 1) * D_IN + RW0 + ch0) : zero;
            }
#pragma unroll
            for (int k = 0; k < 5; ++k) if (kb + k < 5) {
                const int idx = tid + 256 * (kb + k), tau = idx / 40, g = idx % 40, grp = g >> 3, j0 = (g & 7) * 8;
                const int ch0 = (grp < 3) ? grp * D_RWKV + h * 64 + j0 : (grp == 3 ? 3 * D_RWKV + d * 64 + j0 : 3 * D_RWKV + 128 + d * 64 + j0);
                float z[8], zpv[8], znv[8], o[8];
                unpack8(zc[k], z); unpack8(zp[k], zpv); unpack8(zn[k], znv);
                const f32x4 mp0 = ld4(p.mu_prev + ch0), mp1 = ld4(p.mu_prev + ch0 + 4), mn0 = ld4(p.mu_next + ch0), mn1 = ld4(p.mu_next + ch0 + 4);
#pragma unroll
                for (int e = 0; e < 4; ++e) { o[e] = z[e] + mp0[e] * (zpv[e] - z[e]) + mn0[e] * (znv[e] - z[e]); o[4 + e] = z[4 + e] + mp1[e] * (zpv[4 + e] - z[4 + e]) + mn1[e] * (znv[4 + e] - z[4 + e]); }
                if (grp < 3) {
                    float* dst = (grp == 0 ? Rf : grp == 1 ? Kf : Vf) + tau * 64 + j0;
                    *(f32x4*)dst = f32x4{o[0], o[1], o[2], o[3]}; *(f32x4*)(dst + 4) = f32x4{o[4], o[5], o[6], o[7]};
                } else if (grp == 3) {
                    u32x4 w;
#pragma unroll
                    for (int e = 0; e < 4; ++e) { const float t0 = 2.0f * frcp(1.0f + FEXP(-2.0f * o[2 * e])) - 1.0f, t1 = 2.0f * frcp(1.0f + FEXP(-2.0f * o[2 * e + 1])) - 1.0f; w[e] = pk2(t0, t1); }
                    *(u32x4*)(TW + tau * LT + j0) = w;
                } else {
                    u32x4 w; w[0] = pk2(o[0], o[1]); w[1] = pk2(o[2], o[3]); w[2] = pk2(o[4], o[5]); w[3] = pk2(o[6], o[7]);
                    *(u32x4*)(TA + tau * LT + j0) = w;
                }
            }
            }
#pragma unroll
            for (int k = 0; k < 4; ++k) {
                const int idx = tid + 256 * k, which = idx >> 9, j = (idx >> 3) & 63, c8 = (idx & 7) * 8;
                *(u32x4*)((which ? A2T : W2T) + j * LT + c8) = wv[k];
            }
        }
        __syncthreads();
        {
            f32x4 aw[2] = {f32x4{0.f, 0.f, 0.f, 0.f}, f32x4{0.f, 0.f, 0.f, 0.f}}, ai[2] = {f32x4{0.f, 0.f, 0.f, 0.f}, f32x4{0.f, 0.f, 0.f, 0.f}};
            mmT<2, 2>(aw, W2T, LT, wave, TW, LT, lane);
            mmT<2, 2>(ai, A2T, LT, wave, TA, LT, lane);
            const int j = wave * 16 + q * 4;
            const f32x4 w0v = ld4(p.w0 + d * D_RWKV + h * 64 + j), a0v = ld4(p.a0 + d * D_RWKV + h * 64 + j);
            const f32x4 kk4 = ld4(p.k_k + h * 64 + j), ka4 = ld4(p.k_a + h * 64 + j), rk4 = ld4(p.r_k + h * 64 + j);
#pragma unroll
            for (int nb = 0; nb < 2; ++nb) {
                const int tau = nb * 16 + l15;
                f32x4 lw, ic;
#pragma unroll
                for (int r = 0; r < 4; ++r) { lw[r] = -0.6065306597126334f * fsigm(w0v[r] + aw[nb][r]); ic[r] = fsigm(a0v[r] + ai[nb][r]); }
                *(f32x4*)(LW + tau * 64 + j) = lw; *(f32x4*)(IC + tau * 64 + j) = ic;
                const f32x4 kr = *(const f32x4*)(Kf + tau * 64 + j), rr = *(const f32x4*)(Rf + tau * 64 + j);
                const f32x4 kd = kr * (1.0f + (ic - 1.0f) * ka4), kq = kr * kk4;
                float n2 = hsum4(kq * kq), bon = hsum4(rr * kd * rk4);
                n2 += __shfl_xor(n2, 16); n2 += __shfl_xor(n2, 32); bon += __shfl_xor(bon, 16); bon += __shfl_xor(bon, 32);
                if (q == 0) { PS[(tau * 4 + wave) * 2] = n2; PS[(tau * 4 + wave) * 2 + 1] = bon; }
            }
        }
        __syncthreads();
        {
            const int j = lane, t0 = wave * 8;
            float cum[8], kd[8], kkn[8], icv[8], rr[8], vv[8], run = 0.f;
#pragma unroll
            for (int i = 0; i < 8; ++i) {
                const int t = t0 + i;
                run += LW[t * 64 + j]; cum[i] = run;
                const float kr = Kf[t * 64 + j]; icv[i] = IC[t * 64 + j]; rr[i] = Rf[t * 64 + j]; vv[i] = Vf[t * 64 + j];
                kd[i] = kr * (1.0f + (icv[i] - 1.0f) * kac);
                const float kk = kr * kkc;
                const f32x4 pa = *(const f32x4*)(PS + t * 8), pb = *(const f32x4*)(PS + t * 8 + 4);
                const float n2 = (pa[0] + pa[2]) + (pb[0] + pb[2]);
                kkn[i] = kk * frsq(fmaxf(n2, 1e-24f));
                if (lane == 0) RBON[(size_t)it * RC + t] = (pa[1] + pa[3]) + (pb[1] + pb[3]);
            }
            TOT[wave * 64 + j] = run;
            __syncthreads();
            float off = 0.f;
            for (int w = 0; w < wave; ++w) off += TOT[w * 64 + j];
            u32x4 vt, bt, kt;
            float e_prev = 0.f;
#pragma unroll
            for (int i = 0; i < 8; ++i) {
                const int t = t0 + i;
                const float cu = off + cum[i], cprev = (i == 0) ? off : off + cum[i - 1];
                const float g = FEXP(cu), gi = FEXP(-cu), gm = FEXP(cprev);
                const float ah = -kkn[i] * gm, bh = kkn[i] * icv[i] * gi, kh = kd[i] * gi, rh = rr[i] * g;
                Ah[t * LT + j] = f2bf(ah); Bh[t * LT + j] = f2bf(bh); Kh[t * LT + j] = f2bf(kh); Rh[t * LT + j] = f2bf(rh);
                if (i & 1) { vt[i >> 1] = pk2(e_prev, vv[i]); bt[i >> 1] = (bt[i >> 1] & 0xFFFFu) | ((unsigned)f2bf(bh) << 16); kt[i >> 1] = (kt[i >> 1] & 0xFFFFu) | ((unsigned)f2bf(kh) << 16); }
                else { e_prev = vv[i]; bt[i >> 1] = f2bf(bh); kt[i >> 1] = f2bf(kh); }
                if (t == RC - 1) GC[j] = g;
            }
            *(u32x4*)(VT + j * LJ + t0) = vt; *(u32x4*)(BhT + j * LJ + t0) = bt; *(u32x4*)(KhT + j * LJ + t0) = kt;
        }
        __syncthreads();
        {
            const bf16_t* X = (wave == 0) ? Ah : (wave & 1) ? Kh : Bh;
            const bf16_t* Y = (wave == 0) ? Bh : (wave == 1) ? Ah : Rh;
#pragma unroll
            for (int xs = 0; xs < 2; ++xs) {
                f32x4 acc[2] = {f32x4{0.f, 0.f, 0.f, 0.f}, f32x4{0.f, 0.f, 0.f, 0.f}};
                mmT<2, 2>(acc, X, LT, xs, Y, LT, lane);
#pragma unroll
                for (int nb = 0; nb < 2; ++nb) {
                    const int yy = nb * 16 + l15, x0 = xs * 16 + q * 4;
                    f32x4 v = acc[nb];
#pragma unroll
                    for (int r = 0; r < 4; ++r) { const int xx = x0 + r; const bool keep = (wave == 0) ? (yy < xx) : (wave == 1) ? (xx < yy) : (xx <= yy); v[r] = keep ? v[r] : 0.f; }
                    if (wave == 0) {
                        bf16_t* Pb0 = (bf16_t*)(smem + R_PB0); bf16_t* Pt0 = (bf16_t*)(smem + R_PT0); bf16_t* Tb0 = (bf16_t*)(smem + R_TB0);
                        *(U2*)(Pb0 + yy * LJ + x0) = pack4(v);
#pragma unroll
                        for (int r = 0; r < 4; ++r) Pt0[(x0 + r) * LJ + yy] = f2bf(v[r]);
                        f32x4 t0 = v;
#pragma unroll
                        for (int r = 0; r < 4; ++r) t0[r] += (x0 + r == yy) ? 1.0f : 0.0f;
                        *(f32x4*)(IA + yy * 36 + x0) = t0; *(U2*)(Tb0 + yy * LJ + x0) = pack4(t0);
                    }
                    else { bf16_t* dst = (wave == 1 ? NkaT : wave == 2 ? MbrT : MkrT) + yy * LJ + x0; *(U2*)dst = pack4(v); }
                }
            }
        }
        __syncthreads();
        {
#pragma unroll
            for (int xs = 0; xs < 2; ++xs) {
                f32x4 acc[1] = {f32x4{0.f, 0.f, 0.f, 0.f}};
                mmT<1, 1>(acc, NkaT, LJ, xs, VT + wave * 16 * LJ, LJ, lane);
                const int i = wave * 16 + l15, tb = xs * 16 + q * 4;
                Xu[i * 33 + tb] = acc[0][0]; Xu[i * 33 + tb + 1] = acc[0][1]; Xu[i * 33 + tb + 2] = acc[0][2]; Xu[i * 33 + tb + 3] = acc[0][3];
            }
        }
        __syncthreads();
        {
            bf16_t* Tb[2] = {(bf16_t*)(smem + R_TB0), (bf16_t*)(smem + R_TB1)};
            bf16_t* Pb[2] = {(bf16_t*)(smem + R_PB0), (bf16_t*)(smem + R_PB1)};
            bf16_t* Pt[2] = {(bf16_t*)(smem + R_PT0), (bf16_t*)(smem + R_PT1)};
            const int nb = wave >> 1, xs = wave & 1;
            const int yy = nb * 16 + l15, x0 = xs * 16 + q * 4;
            auto prod = [&](const bf16_t* L, const bf16_t* Rt, f32x4 init) {
                const bf16x8 xf = *(const bf16x8*)(Rt + (xs * 16 + l15) * LJ + 8 * q), yf = *(const bf16x8*)(L + (nb * 16 + l15) * LJ + 8 * q);
                return MFMA16(xf, yf, init);
            };
            const f32x4 zero = f32x4{0.f, 0.f, 0.f, 0.f};
#pragma unroll
            for (int k = 0; k < 5; ++k) {
                const int pc = k & 1, pn = pc ^ 1;
                f32x4 tnew = zero, pnew = zero;
                if (k >= 1) tnew = prod(Tb[pn], Pt[pc], *(const f32x4*)(IA + yy * 36 + x0));
                if (k <= 3) pnew = prod(Pb[pc], Pt[pc], zero);
                if (k >= 1) { *(f32x4*)(IA + yy * 36 + x0) = tnew; if (k <= 3) *(U2*)(Tb[pc] + yy * LJ + x0) = pack4(tnew); }
                if (k <= 3) {
                    *(U2*)(Pb[pn] + yy * LJ + x0) = pack4(pnew);
#pragma unroll
                    for (int r = 0; r < 4; ++r) Pt[pn][(x0 + r) * LJ + yy] = f2bf(pnew[r]);
                }
                __syncthreads();
            }
            f32x4 accw[2], accu[2];
#pragma unroll
            for (int tc = 0; tc < 2; ++tc) { accw[tc] = f32x4{0.f, 0.f, 0.f, 0.f}; accu[tc] = f32x4{0.f, 0.f, 0.f, 0.f}; }
#pragma unroll
            for (int k0 = 0; k0 < 32; k0 += 4) {
                const float la = bf2f(Ah[(k0 + q) * LT + wave * 16 + l15]), lu = Xu[(wave * 16 + l15) * 33 + k0 + q];
#pragma unroll
                for (int tc = 0; tc < 2; ++tc) { const float rv = IA[(k0 + q) * 36 + tc * 16 + l15]; accw[tc] = MFMAF32(la, rv, accw[tc]); accu[tc] = MFMAF32(lu, rv, accu[tc]); }
            }
            __syncthreads();
#pragma unroll
            for (int tc = 0; tc < 2; ++tc)
#pragma unroll
                for (int r = 0; r < 4; ++r) { const int row = wave * 16 + q * 4 + r, col = tc * 16 + l15; Wa[row * LJ + col] = f2bf(accw[tc][r]); U0[row * LJ + col] = f2bf(accu[tc][r]); }
        }
        __syncthreads();
        {
            bf16_t* gPm = (bf16_t*)(chp + CH_PM); bf16_t* gSA = (bf16_t*)(chp + CH_SA); bf16_t* gQT = (bf16_t*)(chp + CH_QT); bf16_t* gY0 = (bf16_t*)(chp + CH_Y0);
            const int x0 = wave * 16 + q * 4;
            {
                f32x4 acc[4] = {f32x4{0.f, 0.f, 0.f, 0.f}, f32x4{0.f, 0.f, 0.f, 0.f}, f32x4{0.f, 0.f, 0.f, 0.f}, f32x4{0.f, 0.f, 0.f, 0.f}};
                mmT<4, 1>(acc, Wa, LJ, wave, BhT, LJ, lane);
#pragma unroll
                for (int nb = 0; nb < 4; ++nb) {
                    const int jp = nb * 16 + l15; const float g = GC[jp];
                    f32x4 v = acc[nb];
#pragma unroll
                    for (int r = 0; r < 4; ++r) v[r] = (v[r] + ((x0 + r == jp) ? 1.0f : 0.0f)) * g;
                    *(U2*)(gPm + jp * 64 + x0) = pack4(v);
                }
            }
            {
                f32x4 acc[4] = {f32x4{0.f, 0.f, 0.f, 0.f}, f32x4{0.f, 0.f, 0.f, 0.f}, f32x4{0.f, 0.f, 0.f, 0.f}, f32x4{0.f, 0.f, 0.f, 0.f}};
                mmT<4, 1>(acc, BhT, LJ, wave, U0, LJ, lane);
                mmT<4, 1>(acc, KhT, LJ, wave, VT, LJ, lane);
                const f32x4 g = *(const f32x4*)(GC + x0);
#pragma unroll
                for (int nb = 0; nb < 4; ++nb) *(U2*)(gSA + (nb * 16 + l15) * 64 + x0) = pack4(acc[nb] * g);
            }
            if (seg == 1) {
                {
                    f32x4 acc[2] = {f32x4{0.f, 0.f, 0.f, 0.f}, f32x4{0.f, 0.f, 0.f, 0.f}};
                    mmT<2, 1>(acc, Wa, LJ, wave, MbrT, LJ, lane);
#pragma unroll
                    for (int nb = 0; nb < 2; ++nb) {
                        const int t = nb * 16 + l15;
                        f32x4 v = acc[nb];
#pragma unroll
                        for (int r = 0; r < 4; ++r) v[r] += bf2f(Rh[t * LT + x0 + r]);
                        *(U2*)(gQT + t * 64 + x0) = pack4(v);
                    }
                }
                {
                    f32x4 acc[2] = {f32x4{0.f, 0.f, 0.f, 0.f}, f32x4{0.f, 0.f, 0.f, 0.f}};
                    mmT<2, 1>(acc, U0, LJ, wave, MbrT, LJ, lane);
                    mmT<2, 1>(acc, VT, LJ, wave, MkrT, LJ, lane);
#pragma unroll
                    for (int nb = 0; nb < 2; ++nb) *(U2*)(gY0 + (nb * 16 + l15) * 64 + x0) = pack4(acc[nb]);
                }
            }
        }
    }
}

__device__ __forceinline__ U2 ldu2(const bf16_t* p) { return *(const U2*)p; }
constexpr int R2D = 6, R2LD = 72;
__device__ __forceinline__ void phaseR2(const Params& p, int bid, int nblk, char* smem) {
    unsigned char* CH = p.ws + WS_CH;
    bf16_t* PL = (bf16_t*)smem;
    const int tid = opaque_tid(), lane = tid & 63, wave = tid >> 6, q = lane >> 4, l15 = lane & 15;
    const int lrow = wave * 16 + (lane >> 2), lcol = (lane & 3) * 16;
    for (int chain = bid; chain < NCHAIN; chain += nblk) {
        const int i = wave * 16 + l15;
        unsigned char* chbase = CH + (size_t)chain * NCK * CH_BYTES;
        f32x4 st[4];
#pragma unroll
        for (int nt = 0; nt < 4; ++nt) st[nt] = f32x4{0.f, 0.f, 0.f, 0.f};
        u32x4 pq[R2D][2]; U2 sa[R2D][4];
#pragma unroll
        for (int k = 0; k < R2D; ++k) {
            const unsigned char* chp = chbase + (size_t)(k < NCK ? k : NCK - 1) * CH_BYTES;
            const bf16_t* gp = (const bf16_t*)(chp + CH_PM) + lrow * 64 + lcol;
            pq[k][0] = *(const u32x4*)gp; pq[k][1] = *(const u32x4*)(gp + 8);
#pragma unroll
            for (int nt = 0; nt < 4; ++nt) sa[k][nt] = ldu2((const bf16_t*)(chp + CH_SA) + i * 64 + nt * 16 + 4 * q);
        }
#pragma unroll 1
        for (int c0 = 0; c0 < NCK; c0 += R2D) {
#pragma unroll
            for (int k = 0; k < R2D; ++k) {
                const int c = c0 + k;
                if (c < NCK) {
                bf16_t* pl = PL + (k & 1) * 64 * R2LD;
                *(u32x4*)(pl + lrow * R2LD + lcol) = pq[k][0]; *(u32x4*)(pl + lrow * R2LD + lcol + 8) = pq[k][1];
                f32x4 ini[4];
#pragma unroll
                for (int nt = 0; nt < 4; ++nt) ini[nt] = f32x4{bitsf(sa[k][nt].x << 16), bitsf(sa[k][nt].x & 0xFFFF0000u), bitsf(sa[k][nt].y << 16), bitsf(sa[k][nt].y & 0xFFFF0000u)};
                {
                    const int cn = (c + R2D < NCK) ? c + R2D : NCK - 1;
                    const unsigned char* chp = chbase + (size_t)cn * CH_BYTES;
                    const bf16_t* gp = (const bf16_t*)(chp + CH_PM) + lrow * 64 + lcol;
                    pq[k][0] = *(const u32x4*)gp; pq[k][1] = *(const u32x4*)(gp + 8);
#pragma unroll
                    for (int nt = 0; nt < 4; ++nt) sa[k][nt] = ldu2((const bf16_t*)(chp + CH_SA) + i * 64 + nt * 16 + 4 * q);
                }
                __syncthreads();
                bf16_t* gSA = (bf16_t*)(chbase + (size_t)c * CH_BYTES + CH_SA) + i * 64 + 4 * q;
                bf16x8 bfr[2];
#pragma unroll
                for (int ks = 0; ks < 2; ++ks) {
                    const U2 lo = pack4(st[2 * ks]), hi = pack4(st[2 * ks + 1]);
                    bfr[ks] = __builtin_bit_cast(bf16x8, u32x4{lo.x, lo.y, hi.x, hi.y});
                    *(U2*)(gSA + (2 * ks) * 16) = lo; *(U2*)(gSA + (2 * ks + 1) * 16) = hi;
                }
#pragma unroll
                for (int nt = 0; nt < 4; ++nt) {
                    f32x4 acc = ini[nt];
#pragma unroll
                    for (int ks = 0; ks < 2; ++ks) {
                        const U2 lo = *(const U2*)(pl + (nt * 16 + l15) * R2LD + 32 * ks + 4 * q), hi = *(const U2*)(pl + (nt * 16 + l15) * R2LD + 32 * ks + 16 + 4 * q);
                        acc = MFMA16(__builtin_bit_cast(bf16x8, u32x4{lo.x, lo.y, hi.x, hi.y}), bfr[ks], acc);
                    }
                    st[nt] = acc;
                }
                }
            }
        }
        __syncthreads();
    }
}

__device__ __forceinline__ void phaseR3(const Params& p, int bid, int nblk, char* smem) {
    const bf16_t* P = WSP(bf16_t, WS_R1);
    const unsigned char* CH = p.ws + WS_CH;
    const float* RBON = WSP(float, WS_RBON);
    bf16_t* MIX = WSP(bf16_t, WS_R3);
    float* red = (float*)smem;
    const int tid = opaque_tid(), lane = tid & 63, wave = tid >> 6, q = lane >> 4, l15 = lane & 15;
    for (int m = bid * 256 + tid; m < MLAT; m += nblk * 256) {
        const float* sp = WSP(float, WS_SSQP) + (size_t)m * LRU_BLOCKS;
        float sq = 0.f;
#pragma unroll
        for (int c = 0; c < LRU_BLOCKS; ++c) sq += sp[c];
        WSP(float, WS_RINV)[m] = frsq(sq * (1.0f / D_LRU) + RMS_EPS);
    }
    bf16_t* G2T = (bf16_t*)(smem + 1024);
    const int nbh = nblk / HEADS;
    const bool uniform = (nbh > 0) && (nblk % HEADS == 0);
    constexpr int NP16 = SEQ / 16, NW = BATCH * NP16;
    const int nwv = uniform ? nbh * 4 : nblk * 4;
    int hcur = -1;
    for (int wi0 = (uniform ? (bid % nbh) : bid) * 4; wi0 < (uniform ? NW : NW * HEADS); wi0 += nwv) {
        int h; if (uniform) h = bid / nbh; else h = (wi0 / 4) % HEADS;
        if (h != hcur) {
            __syncthreads();
            for (int idx = tid; idx < 128 * 16; idx += 256) {
                const int c = idx >> 4, i4 = (idx & 15) * 4;
                const f32x4 w = ld4(p.g2 + (size_t)c * D_RWKV + h * 64 + i4);
                bf16_t* dst = G2T + i4 * 136 + c;
                dst[0] = f2bf(w[0]); dst[136] = f2bf(w[1]); dst[272] = f2bf(w[2]); dst[408] = f2bf(w[3]);
            }
            hcur = h;
            __syncthreads();
        }
        const int wi = uniform ? wi0 + wave : (wi0 / 4 / HEADS) * 4 + wave;
        if (wi >= NW) continue;
        const int b = wi / NP16, p16 = wi % NP16, pc = p16 >> 1, pl = (p16 & 1) * 16 + l15, pos = pc * RC + pl;
        f32x4 y[4], g[4];
#pragma unroll
        for (int xs = 0; xs < 4; ++xs) { y[xs] = f32x4{0.f, 0.f, 0.f, 0.f}; g[xs] = f32x4{0.f, 0.f, 0.f, 0.f}; }
        float bon = 0.f;
#pragma unroll
        for (int d = 0; d < 2; ++d) {
            const int chain = (b * HEADS + h) * 2 + d, c = NCC + (d ? NLC - 1 - pc : pc), tau = d ? RC - 1 - pl : pl;
            const size_t item = (size_t)chain * NCK + c;
            const unsigned char* chp = CH + item * CH_BYTES;
            const bf16_t* gS = (const bf16_t*)(chp + CH_SA); const bf16_t* gQT = (const bf16_t*)(chp + CH_QT); const bf16_t* gY0 = (const bf16_t*)(chp + CH_Y0);
            bf16x8 yf[2];
#pragma unroll
            for (int ks = 0; ks < 2; ++ks) yf[ks] = *(const bf16x8*)(gQT + tau * 64 + ks * 32 + 8 * q);
#pragma unroll
            for (int xs = 0; xs < 4; ++xs) {
                f32x4 acc = ldb4(gY0 + tau * 64 + xs * 16 + 4 * q);
#pragma unroll
                for (int ks = 0; ks < 2; ++ks) acc = MFMA16(*(const bf16x8*)(gS + (xs * 16 + l15) * 64 + ks * 32 + 8 * q), yf[ks], acc);
                y[xs] += acc;
            }
            bon += RBON[item * RC + tau];
        }
#pragma unroll
        for (int ks = 0; ks < 4; ++ks) {
            float o[8]; shifted8(p, P, 1, b, pos, SEQ, 3 * D_RWKV + 256 + ks * 32 + 8 * q, o);
            u32x4 t; t[0] = pk2(fsigm(o[0]), fsigm(o[1])); t[1] = pk2(fsigm(o[2]), fsigm(o[3])); t[2] = pk2(fsigm(o[4]), fsigm(o[5])); t[3] = pk2(fsigm(o[6]), fsigm(o[7]));
            const bf16x8 sg = __builtin_bit_cast(bf16x8, t);
#pragma unroll
            for (int xs = 0; xs < 4; ++xs) g[xs] = MFMA16(*(const bf16x8*)(G2T + (xs * 16 + l15) * 136 + ks * 32 + 8 * q), sg, g[xs]);
        }
        float s1 = 0.f, s2 = 0.f;
#pragma unroll
        for (int xs = 0; xs < 4; ++xs) { s1 += hsum4(y[xs]); s2 += hsum4(y[xs] * y[xs]); }
        s1 += __shfl_xor(s1, 16); s1 += __shfl_xor(s1, 32); s2 += __shfl_xor(s2, 16); s2 += __shfl_xor(s2, 32);
        const float mu = s1 * (1.0f / 64.0f), var = fmaxf(s2 * (1.0f / 64.0f) - mu * mu, 0.f), rstd = frsq(var + GN_EPS);
        const size_t mrow = rwkv_row(1, b, pos);
        const size_t mprev = pos > 0 ? rwkv_row(1, b, pos - 1) : mrow, mnext = pos < SEQ - 1 ? rwkv_row(1, b, pos + 1) : mrow;
#pragma unroll
        for (int xs = 0; xs < 4; ++xs) {
            const int i0 = xs * 16 + q * 4, chv = 2 * D_RWKV + h * 64 + i0;
            const f32x4 z = ldb4(P + mrow * D_IN + RW0 + chv);
            f32x4 zp = ldb4(P + mprev * D_IN + RW0 + chv), zn = ldb4(P + mnext * D_IN + RW0 + chv);
            if (pos == 0) zp = f32x4{0.f, 0.f, 0.f, 0.f};
            if (pos == SEQ - 1) zn = f32x4{0.f, 0.f, 0.f, 0.f};
            const f32x4 v = z + ld4(p.mu_prev + chv) * (zp - z) + ld4(p.mu_next + chv) * (zn - z);
            const f32x4 yn = (y[xs] - mu) * rstd * ld4(p.gn_g + h * 64 + i0) + ld4(p.gn_b + h * 64 + i0);
            *(U2*)(MIX + mrow * D_MIX + D_LRU + h * 64 + i0) = pack4((yn + bon * v) * g[xs]);
        }
    }
}

__device__ __forceinline__ void phaseJ(const Params& p, int bid, int nblk, char* smem) {
    const bf16_t* MIX = WSP(bf16_t, WS_R3); const bf16_t* WB = WSP(bf16_t, WS_WBOUT);
    bf16_t* YOUT = WSP(bf16_t, WS_R1);
    const float* RINV = WSP(float, WS_RINV);
    constexpr int BM = 32 * MI_J, NTN = D_MODEL / 128, NTM = MLAT / BM;
    constexpr int GM = (NTM % 8 == 0) ? 8 : 1;
    for (int it = xcd_vbid(bid, nblk); it < NTN * NTM; it += nblk) {
        const int mg = it / (GM * NTN), r = it % (GM * NTN), nt = r / GM, mt = mg * GM + (r % GM);
        gemm_tile<MI_J, false>(smem, MIX, D_MIX, nullptr, mt * BM, WB, nullptr, D_MIX, nt * 128, D_MIX, [&](int ml, int nl, f32x4 v, f32x4) {
            *(U2*)(YOUT + (size_t)(mt * BM + ml) * D_MODEL + nt * 128 + nl) = pack4(v);
        }, RINV, D_LRU / 64);
    }
}

constexpr int KUL = D_MODEL + 2;
static_assert((16 * KUL + 4 * 256) * 4 <= SMEM_BYTES && N_EXPERTS <= 16 && MLAT % 16 == 0, "phase K lds");
__device__ __forceinline__ void phaseK(const Params& p, int bid, int nblk, char* smem) {
    const int tid = opaque_tid(), lane = tid & 63, wave = tid >> 6, q = lane >> 4, l15 = lane & 15;
    const float* MOD = WSP(float, WS_MOD); const float* STATS = WSP(float, WS_STATS);
    const bf16_t* YOUT = WSP(bf16_t, WS_R1);
    float* H1 = WSP(float, WS_R5); bf16_t* U2b = WSP(bf16_t, WS_R6); float* AFF = WSP(float, WS_AFF);
    float* UL = (float*)smem;
    float* PL = UL + 16 * KUL;
    for (int rb = bid; rb < MLAT / 16; rb += nblk) {
        __syncthreads();
#pragma unroll 1
        for (int rr = 0; rr < 4; ++rr) {
            const int lr = wave * 4 + rr, row = rb * 16 + lr;
            const float* xr = p.x + (size_t)row * D_MODEL;
            const float* md = MOD + (size_t)(row / SEQ) * 6 * D_MODEL;
            const float mu0 = STATS[row * 2], rs0 = STATS[row * 2 + 1];
            f32x4 v0, v1, v2, v3; float s = 0.f;
#define PK_LOAD(V, J) { const int k = (J) * 256 + lane * 4; \
            V = ALPHA_F * ((ld4(xr + k) - mu0) * rs0 * ld4(p.ln_in_g + k) + ld4(p.ln_in_b + k)) + ld4(md + 2 * D_MODEL + k) * ldb4(YOUT + (size_t)row * D_MODEL + k); s += hsum4(V); }
            PK_LOAD(v0, 0)
            if (NV > 1) PK_LOAD(v1, 1) else v1 = f32x4{0.f, 0.f, 0.f, 0.f};
            if (NV > 2) { PK_LOAD(v2, 2) PK_LOAD(v3, 3) } else { v2 = v1; v3 = v1; }
#undef PK_LOAD
            const float mu = wave_sum(s) * (1.0f / D_MODEL);
            v0 -= mu; float s2 = hsum4(v0 * v0);
            if (NV > 1) { v1 -= mu; s2 += hsum4(v1 * v1); }
            if (NV > 2) { v2 -= mu; v3 -= mu; s2 += hsum4(v2 * v2) + hsum4(v3 * v3); }
            const float rstd = frsq(wave_sum(s2) * (1.0f / D_MODEL) + LN_EPS);
#pragma unroll
            for (int j = 0; j < NV; ++j) {
                const int k = j * 256 + lane * 4;
                const f32x4 vv = (j == 0) ? v0 : (j == 1) ? v1 : (j == 2) ? v2 : v3;
                const f32x4 h = vv * rstd * ld4(p.ln1_g + k) + ld4(p.ln1_b + k);
                *(f32x4*)(H1 + (size_t)row * D_MODEL + k) = h;
                const f32x4 u = h * (1.0f + ld4(md + 4 * D_MODEL + k)) + ld4(md + 3 * D_MODEL + k);
                *(U2*)(U2b + (size_t)row * D_MODEL + k) = pack4(u);
                float* ul = UL + lr * KUL + k;
                *(f32x2_e*)ul = f32x2_e{u[0], u[1]}; *(f32x2_e*)(ul + 2) = f32x2_e{u[2], u[3]};
            }
        }
        __syncthreads();
        {
            f32x4 acc = f32x4{0.f, 0.f, 0.f, 0.f};
            const int kq0 = wave * (D_MODEL / 4);
#pragma unroll 8
            for (int s4 = 0; s4 < D_MODEL / 16; ++s4) {
                const int k = kq0 + s4 * 4 + q;
                const float av = UL[l15 * KUL + k];
                const float bv = (l15 < N_EXPERTS) ? p.w_router[(size_t)k * N_EXPERTS + l15] : 0.f;
                acc = MFMAF32(av, bv, acc);
            }
#pragma unroll
            for (int r = 0; r < 4; ++r) PL[wave * 256 + (q * 4 + r) * 16 + l15] = acc[r];
        }
        __syncthreads();
        {
            const int lr = tid >> 4, e = tid & 15;
            const bool valid = e < N_EXPERTS;
            float lg = PL[tid] + PL[256 + tid] + PL[512 + tid] + PL[768 + tid];
            float mx = valid ? lg : -3.0e38f;
#pragma unroll
            for (int o = 1; o < 16; o <<= 1) mx = fmaxf(mx, __shfl_xor(mx, o));
            const float ex = valid ? expf(lg - mx) : 0.f;
            float den = ex;
#pragma unroll
            for (int o = 1; o < 16; o <<= 1) den += __shfl_xor(den, o);
            if (valid) AFF[(size_t)(rb * 16 + lr) * N_EXPERTS + e] = ex / den;
        }
    }
}

__device__ __forceinline__ int block_sum_int(int v, int* red) {
    const int tid_ = opaque_tid(), lane = tid_ & 63, wave = tid_ >> 6;
#pragma unroll
    for (int o = 1; o < 64; o <<= 1) v += __shfl_xor(v, o);
    __syncthreads();
    if (lane == 0) red[wave] = v;
    __syncthreads();
    return red[0] + red[1] + red[2] + red[3];
}
__device__ __forceinline__ void phaseL(const Params& p, int bid, int nblk, char* smem) {
    const float* AFF = WSP(float, WS_AFF);
    int* IDX = WSP(int, WS_IDX); float* GATE = WSP(float, WS_GATE); int* SLOTOF = WSP(int, WS_SLOT);
    unsigned* vals = (unsigned*)smem;
    int* red = (int*)(vals + SEQ);
    int* wsum = red + 8;
    const int tid = opaque_tid(), lane = tid & 63, wave = tid >> 6;
    constexpr int PER = SEQ / 256;
    {
        constexpr int NL = BATCH * N_EXPERTS;
        const bool spare = nblk > NL + 32;
        if (spare ? (bid >= NL) : true) convert_experts(p, spare ? bid - NL : bid, spare ? nblk - NL : nblk, smem, 0, 2);
        if (spare && bid >= NL) return;
        __syncthreads();
    }
    for (int be = bid; be < BATCH * N_EXPERTS; be += nblk) {
        const int b = be / N_EXPERTS, e = be % N_EXPERTS;
        __syncthreads();
        for (int t = tid; t < SEQ; t += 256) vals[t] = fbits(AFF[((size_t)b * SEQ + t) * N_EXPERTS + e]);
        __syncthreads();
        unsigned lo = 0u, hi = 0x7F800000u;
        while (lo < hi) {
            const unsigned mid = lo + (hi - lo + 1u) / 2u;
            int c = 0;
            for (int t = tid; t < SEQ; t += 256) c += (vals[t] >= mid) ? 1 : 0;
            c = block_sum_int(c, red);
            if (c >= CAP) lo = mid; else hi = mid - 1u;
        }
        const unsigned T = lo;
        int cg = 0, ce = 0;
        for (int q = 0; q < PER; ++q) { const unsigned v = vals[tid * PER + q]; cg += (v > T) ? 1 : 0; ce += (v == T) ? 1 : 0; }
        int pg = cg, pe = ce;
#pragma unroll
        for (int o = 1; o < 64; o <<= 1) { const int a = __shfl_up(pg, o), bb = __shfl_up(pe, o); if (lane >= o) { pg += a; pe += bb; } }
        __syncthreads();
        if (lane == 63) { wsum[wave] = pg; wsum[4 + wave] = pe; }
        __syncthreads();
        int og = 0, oe = 0, totg = 0;
        for (int w = 0; w < 4; ++w) { if (w < wave) { og += wsum[w]; oe += wsum[4 + w]; } totg += wsum[w]; }
        int posg = og + pg - cg, pose = oe + pe - ce;
        const int need_eq = CAP - totg;
        for (int q = 0; q < PER; ++q) {
            const int t = tid * PER + q; const unsigned v = vals[t];
            int slot = -1;
            if (v > T) { slot = posg++; }
            else if (v == T) { if (pose < need_eq) slot = totg + pose; pose++; }
            if (slot >= 0) { IDX[(size_t)be * CAP + slot] = b * SEQ + t; GATE[(size_t)be * CAP + slot] = bitsf(v); }
            SLOTOF[((size_t)b * SEQ + t) * N_EXPERTS + e] = slot;
        }
    }
}

__device__ __forceinline__ void phaseM(const Params& p, int bid, int nblk, char* smem) {
    const bf16_t* U2b = WSP(bf16_t, WS_R6); const int* IDX = WSP(int, WS_IDX);
    bf16_t* HID = WSP(bf16_t, WS_R1);
    constexpr int BM = 32 * MI_E, NTN = D_EXPERT / 64, NTM = CAP / BM;
    for (int it = xcd_vbid(bid, nblk); it < BATCH * N_EXPERTS * NTM * NTN; it += nblk) {
        const int mt = it % NTM, b = (it / NTM) % BATCH, nt = (it / (NTM * BATCH)) % NTN, e = it / (NTM * BATCH * NTN), be = b * N_EXPERTS + e;
        const bf16_t* wg = WSP(bf16_t, WS_WG + (size_t)e * WEXP_BYTES); const bf16_t* wu = WSP(bf16_t, WS_WU + (size_t)e * WEXP_BYTES);
        gemm_tile<MI_E, true>(smem, U2b, D_MODEL, IDX + (size_t)be * CAP, mt * BM, wg, wu, D_MODEL, nt * 64, D_MODEL, [&](int ml, int nl, f32x4 g, f32x4 u) {
            U2 o; o.x = pk2(siluf_(g[0]) * u[0], siluf_(g[1]) * u[1]); o.y = pk2(siluf_(g[2]) * u[2], siluf_(g[3]) * u[3]);
            *(U2*)(HID + ((size_t)be * CAP + mt * BM + ml) * D_EXPERT + nt * 64 + nl) = o;
        });
    }
    {
        constexpr int NT = BATCH * N_EXPERTS * NTM * NTN;
        const int rem = NT % nblk, vb = xcd_vbid(bid, nblk);
        if (rem == 0 || nblk - rem < 32) convert_experts(p, vb, nblk, smem, 2, 3);
        else if (vb >= rem) convert_experts(p, vb - rem, nblk - rem, smem, 2, 3);
    }
}
__device__ __forceinline__ void phaseN(const Params& p, int bid, int nblk, char* smem) {
    const bf16_t* HID = WSP(bf16_t, WS_R1); const float* GATE = WSP(float, WS_GATE);
    bf16_t* YS = WSP(bf16_t, WS_R2);
    constexpr int BM = 32 * MI_E, NTN = D_MODEL / 128, NTM = CAP / BM;
    for (int it = xcd_vbid(bid, nblk); it < BATCH * N_EXPERTS * NTM * NTN; it += nblk) {
        const int mt = it % NTM, b = (it / NTM) % BATCH, nt = (it / (NTM * BATCH)) % NTN, e = it / (NTM * BATCH * NTN), be = b * N_EXPERTS + e;
        const bf16_t* wd = WSP(bf16_t, wdown_off(e));
        gemm_tile<MI_E, false>(smem, HID + (size_t)be * CAP * D_EXPERT, D_EXPERT, nullptr, mt * BM, wd, nullptr, D_EXPERT, nt * 128, D_EXPERT, [&](int ml, int nl, f32x4 v, f32x4) {
            const int slot = mt * BM + ml;
            const float gt = GATE[(size_t)be * CAP + slot];
            *(U2*)(YS + ((size_t)be * CAP + slot) * D_MODEL + nt * 128 + nl) = pack4(v * gt);
        });
    }
}
__device__ __forceinline__ void phaseO(const Params& p, int bid, int nblk, char* smem) {
    const int tid_ = opaque_tid(), lane = tid_ & 63, wave = tid_ >> 6;
    const float* MOD = WSP(float, WS_MOD); const float* H1 = WSP(float, WS_R5); const bf16_t* YS = WSP(bf16_t, WS_R2); const int* SLOTOF = WSP(int, WS_SLOT);
    int row = bid * 4 + wave;
    f32x4 n0 = f32x4{0.f, 0.f, 0.f, 0.f}, n1 = n0, n2 = n0, n3 = n0; int nslot = -1;
    if (row < MLAT) { const float* hr = H1 + (size_t)row * D_MODEL; n0 = ld4(hr + lane * 4); if (NV > 1) n1 = ld4(hr + 256 + lane * 4); if (NV > 2) { n2 = ld4(hr + 512 + lane * 4); n3 = ld4(hr + 768 + lane * 4); }
                      nslot = (lane < N_EXPERTS) ? SLOTOF[(size_t)row * N_EXPERTS + lane] : -1; }
    for (; row < MLAT; row += nblk * 4) {
        const float* md = MOD + (size_t)(row / SEQ) * 6 * D_MODEL;
        const f32x4 h0 = n0, h1 = n1, h2 = n2, h3 = n3; const int myslot = nslot;
        const int nrow = row + nblk * 4;
        if (nrow < MLAT) { const float* hr = H1 + (size_t)nrow * D_MODEL; n0 = ld4(hr + lane * 4); if (NV > 1) n1 = ld4(hr + 256 + lane * 4); if (NV > 2) { n2 = ld4(hr + 512 + lane * 4); n3 = ld4(hr + 768 + lane * 4); }
                           nslot = (lane < N_EXPERTS) ? SLOTOF[(size_t)nrow * N_EXPERTS + lane] : -1; }
        f32x4 y0 = f32x4{0.f, 0.f, 0.f, 0.f}, y1 = y0, y2 = y0, y3 = y0;
        const int bbase = (row / SEQ) * N_EXPERTS;
        for (int e = 0; e < N_EXPERTS; ++e) {
            const int sl = __shfl(myslot, e);
            if (sl >= 0) {
                const bf16_t* yr = YS + ((size_t)(bbase + e) * CAP + sl) * D_MODEL + lane * 4;
                y0 += ldb4(yr);
                if (NV > 1) y1 += ldb4(yr + 256);
                if (NV > 2) { y2 += ldb4(yr + 512); y3 += ldb4(yr + 768); }
            }
        }
        f32x4 v0, v1, v2, v3; float s = 0.f;
        v0 = ALPHA_F * h0 + ld4(md + 5 * D_MODEL + lane * 4) * y0; s += hsum4(v0);
        if (NV > 1) { v1 = ALPHA_F * h1 + ld4(md + 5 * D_MODEL + 256 + lane * 4) * y1; s += hsum4(v1); } else v1 = f32x4{0.f, 0.f, 0.f, 0.f};
        if (NV > 2) { v2 = ALPHA_F * h2 + ld4(md + 5 * D_MODEL + 512 + lane * 4) * y2; v3 = ALPHA_F * h3 + ld4(md + 5 * D_MODEL + 768 + lane * 4) * y3; s += hsum4(v2) + hsum4(v3); } else { v2 = v1; v3 = v1; }
        const float mu = wave_sum(s) * (1.0f / D_MODEL);
        v0 -= mu; float s2 = hsum4(v0 * v0);
        if (NV > 1) { v1 -= mu; s2 += hsum4(v1 * v1); }
        if (NV > 2) { v2 -= mu; v3 -= mu; s2 += hsum4(v2 * v2) + hsum4(v3 * v3); }
        const float rstd = frsq(wave_sum(s2) * (1.0f / D_MODEL) + LN_EPS);
#pragma unroll
        for (int j = 0; j < NV; ++j) {
            const int k = j * 256 + lane * 4;
            const f32x4 vv = (j == 0) ? v0 : (j == 1) ? v1 : (j == 2) ? v2 : v3;
            *(f32x4*)(p.out + (size_t)row * D_MODEL + k) = vv * rstd * ld4(p.ln2_g + k) + ld4(p.ln2_b + k);
        }
    }
}

#define XB_TMO      128
#define XB_XCNT(j)  (256  + 64 * (j))
#define XB_XSUB(j)  (1280 + 64 * (j))
#define XB_XGEN(j)  (2304 + 64 * (j))
#define XB_TOP      3328
#define XB_TOPGEN   3392
#define XCD_BAR_WORDS 3456
#define XB_SPIN_CAP (1u << 22)
#ifndef HOST_EMU
__device__ __forceinline__ unsigned xb_ld(unsigned* p) { return __hip_atomic_load(p, __ATOMIC_RELAXED, __HIP_MEMORY_SCOPE_AGENT); }
__device__ __forceinline__ unsigned xb_add(unsigned* p, unsigned v) { return __hip_atomic_fetch_add(p, v, __ATOMIC_RELAXED, __HIP_MEMORY_SCOPE_AGENT); }
__device__ __forceinline__ unsigned xb_xcc_id() { return (unsigned)__builtin_amdgcn_s_getreg((3 << 11) | 20) & 0xFu; }
#define XB_SPIN(cond, bar) do { unsigned _sp = 0; while (cond) { __builtin_amdgcn_s_sleep(1); \
    if ((++_sp & 255u) == 0u) { if (xb_ld(&(bar)[XB_TMO])) break; if (_sp > XB_SPIN_CAP) { atomicAdd(&(bar)[XB_TMO], 1u); break; } } } } while (0)
#define XB_LAS __attribute__((address_space(3)))
struct XcdBarrier { unsigned off; unsigned x; volatile XB_LAS unsigned* st; unsigned G; };
__device__ __forceinline__ XcdBarrier xcd_barrier_post(unsigned* ctrl, unsigned off, volatile XB_LAS unsigned* st, unsigned G, bool member = true) {
    XcdBarrier b; b.off = off; b.x = xb_xcc_id(); b.st = st; b.G = G; unsigned* bar = ctrl + off;
    if (!member) return b;
    if (threadIdx.x == 0) (void)xb_add(&bar[XB_XCNT(b.x)], 1u);
    return b;
}
__device__ __forceinline__ void xcd_barrier_complete(unsigned* bar, unsigned x, unsigned& nloc, unsigned& nx, unsigned G) {
    unsigned sum, cnt, mine, sp = 0u;
    for (;;) {
        sum = 0u; cnt = 0u; mine = 0u;
#pragma unroll
        for (unsigned j = 0; j < 16; ++j) { const unsigned c = xb_ld(&bar[XB_XCNT(j)]); sum += c; cnt += (c > 0u) ? 1u : 0u; mine = (j == x) ? c : mine; }
        if (sum == G) break;
        __builtin_amdgcn_s_sleep(1);
        if ((++sp & 255u) == 0u) { if (xb_ld(&bar[XB_TMO])) break; if (sp > XB_SPIN_CAP) { atomicAdd(&bar[XB_TMO], 1u); break; } }
    }
    nloc = mine > 0u ? mine : 1u; nx = cnt > 0u ? cnt : 1u;
}
__device__ __forceinline__ void grid_barrier(const XcdBarrier& b, unsigned* ctrl) {
    asm volatile("s_waitcnt vmcnt(0)" ::: "memory");
    __syncthreads();
    if (threadIdx.x == 0) {
        unsigned* bar = ctrl + b.off;
        __builtin_amdgcn_s_waitcnt(0);
        volatile XB_LAS unsigned* st = b.st;
        unsigned nloc = st[0], nx = st[1];
        if (nloc == 0u) { xcd_barrier_complete(bar, b.x, nloc, nx, b.G); st[0] = nloc; st[1] = nx; }
        const unsigned old = xb_add(&bar[XB_XSUB(b.x)], 1u);
        const unsigned gen = old / nloc;
        if (old + 1u == (gen + 1u) * nloc) {
            __builtin_amdgcn_fence(__ATOMIC_RELEASE, "agent");
            asm volatile("s_waitcnt vmcnt(0)" ::: "memory");
            const unsigned og = xb_add(&bar[XB_TOP], 1u);
            const unsigned tg = og / nx;
            if (og + 1u == (tg + 1u) * nx) xb_add(&bar[XB_TOPGEN], 1u);
            else XB_SPIN(xb_ld(&bar[XB_TOPGEN]) == tg, bar);
            __builtin_amdgcn_fence(__ATOMIC_ACQUIRE, "agent");
            xb_add(&bar[XB_XGEN(b.x)], 1u);
            asm volatile("s_waitcnt vmcnt(0)" ::: "memory");
        } else {
            XB_SPIN(xb_ld(&bar[XB_XGEN(b.x)]) == gen, bar);
            __builtin_amdgcn_fence(__ATOMIC_ACQUIRE, "agent");
            asm volatile("s_waitcnt vmcnt(0)" ::: "memory");
        }
    }
    __syncthreads();
}
#else
struct XcdBarrier { int dummy; };
__device__ __forceinline__ void grid_barrier(const XcdBarrier&, unsigned*) { __syncthreads(); }
#endif

__global__ void __launch_bounds__(256, 2) fused_forward(Params p) {
    __shared__ __attribute__((aligned(16))) char smem[SMEM_BYTES];
    __shared__ __attribute__((aligned(16))) unsigned xb_words[4];
    if (threadIdx.x == 0) { xb_words[0] = 0u; xb_words[1] = 0u; xb_words[2] = 0u; xb_words[3] = 0u; }
    __syncthreads();
    const int bid = blockIdx.x, nblk = gridDim.x;
    const bool split = nblk >= 2 * NCHAIN;
#ifdef HOST_EMU
    const XcdBarrier gb{0}; const XcdBarrier gs{0};
#else
    const XcdBarrier gb = xcd_barrier_post(WSP(unsigned, WS_CTRL), 0u, (volatile XB_LAS unsigned*)xb_words, (unsigned)nblk);
    const XcdBarrier gs = xcd_barrier_post(WSP(unsigned, WS_CTRL), (unsigned)XCD_BAR_WORDS, (volatile XB_LAS unsigned*)xb_words + 2, (unsigned)(nblk - NCHAIN), split && bid >= NCHAIN);
#endif
    phaseA(p, bid, nblk, smem); grid_barrier(gb, WSP(unsigned, WS_CTRL));
    phaseB(p, bid, nblk, smem); grid_barrier(gb, WSP(unsigned, WS_CTRL));
    phaseC(p, bid, nblk, smem); grid_barrier(gb, WSP(unsigned, WS_CTRL));
    phaseR1(p, bid, nblk, smem); grid_barrier(gb, WSP(unsigned, WS_CTRL));
    {
        const int lb = split ? bid - NCHAIN : bid, ln = split ? nblk - NCHAIN : nblk;
        const bool lru_member = !split || bid >= NCHAIN;
        if (!split || bid < NCHAIN) phaseR2(p, bid, split ? NCHAIN : nblk, smem);
        if (lru_member) phaseD(p, lb, ln, smem);
        if (split) { if (lru_member) grid_barrier(gs, WSP(unsigned, WS_CTRL)); } else grid_barrier(gb, WSP(unsigned, WS_CTRL));
        if (lru_member) phaseE(p, lb, ln, smem);
        if (split) { if (lru_member) grid_barrier(gs, WSP(unsigned, WS_CTRL)); } else grid_barrier(gb, WSP(unsigned, WS_CTRL));
        if (lru_member) phaseF(p, lb, ln, smem);
        grid_barrier(gb, WSP(unsigned, WS_CTRL));
    }
    phaseR3(p, bid, nblk, smem); grid_barrier(gb, WSP(unsigned, WS_CTRL));
    phaseJ(p, bid, nblk, smem); grid_barrier(gb, WSP(unsigned, WS_CTRL));
    phaseK(p, bid, nblk, smem); grid_barrier(gb, WSP(unsigned, WS_CTRL));
    phaseL(p, bid, nblk, smem); grid_barrier(gb, WSP(unsigned, WS_CTRL));
    phaseM(p, bid, nblk, smem); grid_barrier(gb, WSP(unsigned, WS_CTRL));
    phaseN(p, bid, nblk, smem); grid_barrier(gb, WSP(unsigned, WS_CTRL));
    phaseO(p, bid, nblk, smem);
}

#ifdef MULTI_LAUNCH
#define PHASE_KERNEL(NAME) \
    __global__ void __launch_bounds__(256) k_##NAME(Params p) { __shared__ __attribute__((aligned(16))) char smem[SMEM_BYTES]; NAME(p, blockIdx.x, gridDim.x, smem); }
PHASE_KERNEL(phaseA) PHASE_KERNEL(phaseB) PHASE_KERNEL(phaseC) PHASE_KERNEL(phaseD) PHASE_KERNEL(phaseE) PHASE_KERNEL(phaseF) PHASE_KERNEL(phaseR1) PHASE_KERNEL(phaseR2) PHASE_KERNEL(phaseR3)
PHASE_KERNEL(phaseJ) PHASE_KERNEL(phaseK) PHASE_KERNEL(phaseL) PHASE_KERNEL(phaseM) PHASE_KERNEL(phaseN) PHASE_KERNEL(phaseO)
#ifdef HOST_EMU
void emu_hook(const char* name, const Params& p);
#define LAUNCH(NAME, grid) do { EMU_LAUNCH(k_##NAME, grid, 256, p); emu_hook(#NAME, p); } while (0)
#else
#define LAUNCH(NAME, grid) hipLaunchKernelGGL(k_##NAME, dim3(grid), dim3(256), 0, stream, p)
#endif
#endif

extern "C" void kernel_launch(void* const* d_in, const int* in_sizes, int n_in, void* d_out, int out_size, void* d_ws, size_t ws_size, hipStream_t stream) {
    if (n_in != 38 || out_size != MLAT * D_MODEL || ws_size < WS_END) { fprintf(stderr, "kernel_launch: unexpected shapes (n_in %d out %d ws %zu need %zu)\n", n_in, out_size, ws_size, (size_t)WS_END); return; }
    Params p{};
    const float** f = (const float**)&p;
    for (int i = 0; i < 38; ++i) f[i] = (const float*)d_in[i];
    p.out = (float*)d_out; p.ws = (unsigned char*)d_ws;
#ifdef MULTI_LAUNCH
    const int G = 512;
    LAUNCH(phaseA, 6 * D_MODEL / 16);
    LAUNCH(phaseB, G);
    LAUNCH(phaseC, G);
    LAUNCH(phaseD, G);
    LAUNCH(phaseE, 16);
    LAUNCH(phaseF, G);
    LAUNCH(phaseR1, G);
    LAUNCH(phaseR2, NCHAIN);
    LAUNCH(phaseR3, G);
    LAUNCH(phaseJ, G);
    LAUNCH(phaseK, G);
    LAUNCH(phaseL, BATCH * N_EXPERTS);
    LAUNCH(phaseM, G);
    LAUNCH(phaseN, G);
    LAUNCH(phaseO, G);
#elif defined(HOST_EMU)
    EMU_LAUNCH(fused_forward, 1, 256, p);
#else
    static int grid_blocks = 0;
    if (!grid_blocks) {
        int dev = 0, cus = 0, per_cu = 0;
        (void)hipGetDevice(&dev);
        (void)hipDeviceGetAttribute(&cus, hipDeviceAttributeMultiprocessorCount, dev);
        (void)hipOccupancyMaxActiveBlocksPerMultiprocessor(&per_cu, fused_forward, 256, 0);
        if (per_cu > 2) per_cu = 2;
        if (per_cu < 1) { fprintf(stderr, "kernel_launch: occupancy query returned %d blocks per CU\n", per_cu); per_cu = 1; }
        grid_blocks = cus * per_cu;
    }
    (void)hipMemsetAsync((char*)d_ws + WS_CTRL, 0, 2 * XCD_BAR_WORDS * 4, stream);
    void* args[] = {&p};
    hipError_t e = hipLaunchCooperativeKernel((void*)fused_forward, dim3(grid_blocks), dim3(256), args, 0, stream);
    if (e != hipSuccess) fprintf(stderr, "cooperative launch failed: %s (grid %d)\n", hipGetErrorString(e), grid_blocks);
#endif
}
```

```cpp
#ifndef HOST_EMU
#include <hip/hip_runtime.h>
#include <cstdio>
#endif
#include <cstdint>
#include <cstddef>

#ifdef CFG_SMALL
constexpr int D_MODEL = 256, BATCH = 2, SEQ = 256, GRID_W = 16, CTX_LEN = 64, LRU_BLOCKS = 2, N_EXPERTS = 4, D_EXPERT = 256;
#else
constexpr int D_MODEL = 1024, BATCH = 4, SEQ = 4096, GRID_W = 64, CTX_LEN = 256, LRU_BLOCKS = 8, N_EXPERTS = 16, D_EXPERT = 1408;
#endif
constexpr int ROWS = SEQ / GRID_W;
constexpr int D_LRU = D_MODEL / 2, LRU_BLOCK = 64;
constexpr int D_RWKV = D_MODEL / 2, HEADS = D_RWKV / 64;
constexpr int D_RWKV_IN = 3 * D_RWKV + 128 + 128 + 128;
constexpr int D_IN = 2 * D_LRU + D_RWKV_IN;
constexpr int D_MIX = D_LRU + D_RWKV;
constexpr int CAP = 2 * SEQ / N_EXPERTS;
constexpr int MLAT = BATCH * SEQ, MCTX = BATCH * CTX_LEN, MTOT = MLAT + MCTX;
constexpr int NMOD = BATCH + 1;
constexpr int RW0 = 2 * D_LRU;
constexpr float ALPHA_F = 1.189207115002721f;
constexpr float LN_EPS = 1e-5f, GN_EPS = 64e-5f, RMS_EPS = 1e-6f;
static_assert(LRU_BLOCKS * LRU_BLOCK == D_LRU, "lru blocks");
static_assert(CAP % 128 == 0 && D_IN % 128 == 0 && D_EXPERT % 64 == 0 && D_MODEL % 128 == 0 && MTOT % 128 == 0 && D_MIX % 64 == 0, "tile divisibility");

typedef unsigned short bf16_t;
typedef short bf16x8 __attribute__((ext_vector_type(8)));
typedef float f32x4 __attribute__((ext_vector_type(4)));
typedef unsigned u32x4 __attribute__((ext_vector_type(4)));
typedef float f32x2_e __attribute__((ext_vector_type(2)));
typedef unsigned U2 __attribute__((ext_vector_type(2)));

#ifdef HOST_EMU
#define MFMA16(a, b, c) emu_mfma_16x16x32_bf16(a, b, c)
#define MFMAF32(a, b, c) emu_mfma_16x16x4_f32(a, b, c)
#else
#define MFMA16(a, b, c) __builtin_amdgcn_mfma_f32_16x16x32_bf16(a, b, c, 0, 0, 0)
#define MFMAF32(a, b, c) __builtin_amdgcn_mfma_f32_16x16x4f32(a, b, c, 0, 0, 0)
#endif

__device__ __forceinline__ unsigned fbits(float f) { return __builtin_bit_cast(unsigned, f); }
__device__ __forceinline__ float bitsf(unsigned u) { return __builtin_bit_cast(float, u); }
__device__ __forceinline__ bf16_t f2bf(float f) { unsigned u = fbits(f); u += 0x7FFFu + ((u >> 16) & 1u); return (bf16_t)(u >> 16); }
__device__ __forceinline__ float bf2f(bf16_t h) { return bitsf(((unsigned)h) << 16); }
#ifdef HOST_EMU
__device__ __forceinline__ unsigned pk2(float lo, float hi) { return (unsigned)f2bf(lo) | ((unsigned)f2bf(hi) << 16); }
#else
typedef float f32x2_t __attribute__((ext_vector_type(2)));
typedef __bf16 bf16x2_t __attribute__((ext_vector_type(2)));
__device__ __forceinline__ unsigned pk2(float lo, float hi) { return __builtin_bit_cast(unsigned, __builtin_convertvector(f32x2_t{lo, hi}, bf16x2_t)); }
#endif
__device__ __forceinline__ float softplusf_(float x) { return fmaxf(x, 0.0f) + log1pf(expf(-fabsf(x))); }
#ifdef HOST_EMU
#define FEXP(x) expf(x)
#else
#define FEXP(x) __expf(x)
#endif
#ifdef HOST_EMU
__device__ __forceinline__ float frcp(float x) { return 1.0f / x; }
__device__ __forceinline__ float frsq(float x) { return 1.0f / sqrtf(x); }
__device__ __forceinline__ float fsqrt(float x) { return sqrtf(x); }
#else
__device__ __forceinline__ float frcp(float x) { return __builtin_amdgcn_rcpf(x); }
__device__ __forceinline__ float frsq(float x) { return __builtin_amdgcn_rsqf(x); }
__device__ __forceinline__ float fsqrt(float x) { return __builtin_amdgcn_sqrtf(x); }
#endif
__device__ __forceinline__ float fsigm(float x) { return frcp(1.0f + FEXP(-x)); }
__device__ __forceinline__ float siluf_(float x) { return x * fsigm(x); }
__device__ __forceinline__ float geluf_(float x) { return x * fsigm(1.5957691216057308f * (x + 0.044715f * x * x * x)); }
__device__ __forceinline__ int opaque_tid() {
    int t = threadIdx.x;
#ifndef HOST_EMU
    asm volatile("" : "+v"(t));
#endif
    return t;
}
__device__ __forceinline__ float wave_sum(float v) {
#pragma unroll
    for (int o = 1; o < 64; o <<= 1) v += __shfl_xor(v, o);
    return v;
}

constexpr size_t al256(size_t x) { return (x + 255) & ~(size_t)255; }
constexpr int NLCH = BATCH * (SEQ / 64), NCCH = BATCH * (CTX_LEN / 64), NCH = NLCH + NCCH;
constexpr size_t WS_CTRL = 0;
constexpr size_t WS_MOD = 65536;
constexpr size_t WS_STATS = al256(WS_MOD + (size_t)NMOD * 6 * D_MODEL * 4);
constexpr size_t WS_SUMA = al256(WS_STATS + (size_t)MTOT * 2 * 4);
constexpr size_t WS_SUMH = al256(WS_SUMA + (size_t)2 * NCH * D_LRU * 4);
constexpr size_t WS_CARRY = al256(WS_SUMH + (size_t)2 * NCH * D_LRU * 4);
constexpr size_t WS_SSQP = al256(WS_CARRY + (size_t)2 * NLCH * D_LRU * 4);
constexpr size_t WS_RINV = al256(WS_SSQP + (size_t)MLAT * LRU_BLOCKS * 4);
constexpr size_t WS_BON = al256(WS_RINV + (size_t)MLAT * 4);
constexpr size_t WS_AFF = al256(WS_BON + (size_t)2 * MLAT * HEADS * 4 + 4096 * 64);
constexpr size_t WS_IDX = al256(WS_AFF + (size_t)MLAT * N_EXPERTS * 4);
constexpr size_t WS_GATE = al256(WS_IDX + (size_t)BATCH * N_EXPERTS * CAP * 4);
constexpr size_t WS_SLOT = al256(WS_GATE + (size_t)BATCH * N_EXPERTS * CAP * 4);
constexpr size_t WS_WBIN = al256(WS_SLOT + (size_t)MLAT * N_EXPERTS * 4);
constexpr size_t WS_WBOUT = al256(WS_WBIN + (size_t)D_IN * D_MODEL * 2);
constexpr size_t WS_LORA = al256(WS_WBOUT + (size_t)D_MODEL * D_MIX * 2);
constexpr size_t WS_R1 = al256(WS_LORA + (size_t)2 * 2 * HEADS * 64 * 64 * 2);
constexpr size_t R1_BYTES = (size_t)MTOT * D_IN * 2 > (size_t)MLAT * D_MODEL * 4 ? ((size_t)MTOT * D_IN * 2 > (size_t)BATCH * N_EXPERTS * CAP * D_EXPERT * 2 ? (size_t)MTOT * D_IN * 2 : (size_t)BATCH * N_EXPERTS * CAP * D_EXPERT * 2)
                                                                                  : ((size_t)MLAT * D_MODEL * 4 > (size_t)BATCH * N_EXPERTS * CAP * D_EXPERT * 2 ? (size_t)MLAT * D_MODEL * 4 : (size_t)BATCH * N_EXPERTS * CAP * D_EXPERT * 2);
constexpr size_t WS_R3 = al256(WS_R1 + R1_BYTES);
constexpr int RC = 32;
constexpr int NCC = CTX_LEN / RC, NLC = SEQ / RC, NCK = NCC + NLC, NCHAIN = BATCH * HEADS * 2;
constexpr size_t CH_PM = 0, CH_SA = 8192, CH_QT = 16384, CH_Y0 = 20480, CH_BYTES = 24576;
constexpr size_t WS_CH = al256(WS_R3 + (size_t)MTOT * D_MODEL * 2);
constexpr size_t CH_TOTAL = (size_t)NCHAIN * NCK * CH_BYTES;
constexpr size_t WS_R5 = WS_CH;
constexpr size_t WS_LA = al256(WS_R5 + (size_t)MLAT * D_MODEL * 4);
constexpr size_t WS_R6 = WS_LA, WS_R2 = WS_LA;
constexpr size_t WEXP_BYTES = (size_t)D_MODEL * D_EXPERT * 2;
constexpr size_t WS_WG = al256(WS_LA + (size_t)MLAT * D_MODEL * 2);
constexpr size_t WS_WU = WS_WG + (size_t)N_EXPERTS * WEXP_BYTES;
constexpr int NE_R3 = ((size_t)MTOT * D_MODEL * 2 / WEXP_BYTES) < (size_t)N_EXPERTS ? (int)((size_t)MTOT * D_MODEL * 2 / WEXP_BYTES) : N_EXPERTS;
constexpr size_t WS_WD2 = WS_WU + (size_t)N_EXPERTS * WEXP_BYTES;
constexpr size_t WS_LATE_END = al256(WS_WD2 + (size_t)(N_EXPERTS - NE_R3) * WEXP_BYTES);
static_assert(WS_LA + (size_t)BATCH * N_EXPERTS * CAP * D_MODEL * 2 <= WS_WD2, "YS must not reach the w_down copies");
constexpr size_t WS_END = (WS_CH + CH_TOTAL > WS_LATE_END) ? al256(WS_CH + CH_TOTAL) : WS_LATE_END;
constexpr size_t WS_RBON = WS_BON;
static_assert((size_t)NCHAIN * NCK * RC * 4 <= (size_t)2 * MLAT * HEADS * 4 + 4096 * 64, "bonus buffer");

struct Params {
    const float *x, *c, *ctx, *c_ctx, *ln_in_g, *ln_in_b, *w_mod, *b_mod, *w_in, *lru_conv_w, *lru_conv_b, *lru_wa, *lru_ba, *lru_wx, *lru_bx, *lru_lam, *lru_norm_g,
        *mu_prev, *mu_next, *w0, *w2, *a0, *a2, *g2, *k_k, *k_a, *r_k, *gn_g, *gn_b, *w_out, *ln1_g, *ln1_b, *w_router, *w_gate, *w_up, *w_down, *ln2_g, *ln2_b;
    float* out;
    unsigned char* ws;
};
#define WSP(T, off) ((T*)(p.ws + (off)))
__device__ __forceinline__ size_t wdown_off(int e) { return e < NE_R3 ? WS_R3 + (size_t)e * WEXP_BYTES : WS_WD2 + (size_t)(e - NE_R3) * WEXP_BYTES; }

constexpr int SMEM_BYTES = 76 * 1024;

__device__ __forceinline__ f32x4 ld4(const float* p) { return *(const f32x4*)p; }
__device__ __forceinline__ f32x4 ldb4(const bf16_t* p) { const U2 u = *(const U2*)p; return f32x4{bitsf(u.x << 16), bitsf(u.x & 0xFFFF0000u), bitsf(u.y << 16), bitsf(u.y & 0xFFFF0000u)}; }
__device__ __forceinline__ float hsum4(f32x4 v) { return (v[0] + v[1]) + (v[2] + v[3]); }
__device__ __forceinline__ U2 pack4(f32x4 v) { U2 o; o.x = pk2(v[0], v[1]); o.y = pk2(v[2], v[3]); return o; }
__device__ __forceinline__ void convert_transpose(const float* src, bf16_t* dst, int K, int N, int t0, int t1, int tstride, char* smem) {
    float* T = (float*)smem;
    const int tid = opaque_tid(), r = tid >> 4, c4 = (tid & 15) * 4, ntn = N / 64;
    f32x4 v[4];
    if (t0 < t1) { const int kt = t0 / ntn, nt = t0 % ntn;
#pragma unroll
        for (int j = 0; j < 4; ++j) v[j] = ld4(src + (size_t)(kt * 64 + r + 16 * j) * N + nt * 64 + c4); }
    for (int t = t0; t < t1; t += tstride) {
        const int kt = t / ntn, nt = t % ntn;
        __syncthreads();
#pragma unroll
        for (int j = 0; j < 4; ++j) { float* d = T + (r + 16 * j) * 65 + c4; d[0] = v[j][0]; d[1] = v[j][1]; d[2] = v[j][2]; d[3] = v[j][3]; }
        __syncthreads();
        if (t + tstride < t1) { const int kt2 = (t + tstride) / ntn, nt2 = (t + tstride) % ntn;
#pragma unroll
            for (int j = 0; j < 4; ++j) v[j] = ld4(src + (size_t)(kt2 * 64 + r + 16 * j) * N + nt2 * 64 + c4); }
        const int n = tid >> 2, kc = (tid & 3) * 16;
        u32x4 o0, o1;
#pragma unroll
        for (int i = 0; i < 4; ++i) { o0[i] = pk2(T[(kc + 2 * i) * 65 + n], T[(kc + 2 * i + 1) * 65 + n]); o1[i] = pk2(T[(kc + 8 + 2 * i) * 65 + n], T[(kc + 9 + 2 * i) * 65 + n]); }
        bf16_t* d = dst + (size_t)(nt * 64 + n) * K + kt * 64 + kc;
        *(u32x4*)d = o0; *(u32x4*)(d + 8) = o1;
    }
    __syncthreads();
}
__device__ void convert_experts(const Params& p, int vb, int nvb, char* smem, int first, int last) {
    constexpr int TPM = (D_MODEL / 64) * (D_EXPERT / 64);
    int m = 0;
    for (int e = 0; e < N_EXPERTS; ++e)
        for (int which = first; which < last; ++which, ++m) {
            const float* src = (which == 0 ? p.w_gate : which == 1 ? p.w_up : p.w_down) + (size_t)e * D_MODEL * D_EXPERT;
            bf16_t* dst = which == 0 ? WSP(bf16_t, WS_WG + (size_t)e * WEXP_BYTES) : which == 1 ? WSP(bf16_t, WS_WU + (size_t)e * WEXP_BYTES) : WSP(bf16_t, wdown_off(e));
            const int K = which == 2 ? D_EXPERT : D_MODEL, N = which == 2 ? D_MODEL : D_EXPERT;
            const int start = ((vb - (m * TPM) % nvb) % nvb + nvb) % nvb;
            convert_transpose(src, dst, K, N, start, TPM, nvb, smem);
        }
}

__device__ __forceinline__ void phaseA(const Params& p, int bid, int nblk, char* smem) {
    float* sc = (float*)smem;
    float* red = sc + NMOD * D_MODEL;
    const int tid = opaque_tid();
    constexpr int NA = 6 * D_MODEL / 16;
    {
        const bool spare = nblk > NA + 32;
        const int vb = spare ? bid - NA : bid, nvb = spare ? nblk - NA : nblk;
        if (!spare || bid >= NA) {
            constexpr int T1 = (D_MODEL / 64) * (D_IN / 64), T2 = (D_MIX / 64) * (D_MODEL / 64);
            convert_transpose(p.w_in, WSP(bf16_t, WS_WBIN), D_MODEL, D_IN, vb, T1, nvb, smem);
            convert_transpose(p.w_out, WSP(bf16_t, WS_WBOUT), D_MIX, D_MODEL, ((vb - T1 % nvb) % nvb + nvb) % nvb, T2, nvb, smem);
            for (int idx = vb * 256 + tid; idx < 2 * 2 * HEADS * 64 * 64; idx += nvb * 256) {
                const int i = idx & 63, j = (idx >> 6) & 63, hh = (idx >> 12) % HEADS, which = (idx >> 12) / HEADS % 2, dd = (idx >> 12) / HEADS / 2;
                WSP(bf16_t, WS_LORA)[idx] = f2bf((which ? p.a2 : p.w2)[((size_t)dd * 64 + i) * D_RWKV + hh * 64 + j]);
            }
        }
        if (spare && bid >= NA) return;
    }
    if (bid >= NA) return;
    __syncthreads();
    for (int i = tid; i < NMOD * D_MODEL; i += 256) {
        const int r = i / D_MODEL, k = i % D_MODEL;
        const float v = (r < BATCH) ? p.c[r * D_MODEL + k] : p.c_ctx[k];
        sc[i] = siluf_(v);
    }
    __syncthreads();
    float* MOD = WSP(float, WS_MOD);
    const int col = tid & 15, kg = tid >> 4;
    constexpr int KPT = D_MODEL / 16;
    for (int cb = bid; cb < 6 * D_MODEL / 16; cb += nblk) {
        const int n = cb * 16 + col;
        float acc[NMOD];
#pragma unroll
        for (int r = 0; r < NMOD; ++r) acc[r] = 0.f;
        const float* wp = p.w_mod + (size_t)(kg * KPT) * (6 * D_MODEL) + n;
#pragma unroll 16
        for (int kk = 0; kk < KPT; ++kk) {
            const float w = wp[(size_t)kk * (6 * D_MODEL)];
#pragma unroll
            for (int r = 0; r < NMOD; ++r) acc[r] += sc[r * D_MODEL + kg * KPT + kk] * w;
        }
#pragma unroll
        for (int r = 0; r < NMOD; ++r) red[(kg * NMOD + r) * 16 + col] = acc[r];
        __syncthreads();
        if (tid < NMOD * 16) {
            const int r = tid >> 4, c2 = tid & 15;
            float s2 = p.b_mod[cb * 16 + c2];
#pragma unroll
            for (int g = 0; g < 16; ++g) s2 += red[(g * NMOD + r) * 16 + c2];
            MOD[(size_t)r * 6 * D_MODEL + cb * 16 + c2] = s2;
        }
        __syncthreads();
    }
}

constexpr int NV = D_MODEL / 256;
__device__ __forceinline__ void phaseB(const Params& p, int bid, int nblk, char* smem) {
    const int tid_ = opaque_tid(), lane = tid_ & 63, wave = tid_ >> 6;
    const float* MOD = WSP(float, WS_MOD);
    float* STATS = WSP(float, WS_STATS);
    bf16_t* U = WSP(bf16_t, WS_R3);
    auto rowptr = [&](int row) { return (row < MLAT) ? p.x + (size_t)row * D_MODEL : p.ctx + (size_t)(row - MLAT) * D_MODEL; };
    int row = bid * 4 + wave;
    f32x4 n0 = f32x4{0.f, 0.f, 0.f, 0.f}, n1 = n0, n2 = n0, n3 = n0;
    if (row < MTOT) { const float* xr = rowptr(row); n0 = ld4(xr + lane * 4); if (NV > 1) n1 = ld4(xr + 256 + lane * 4); if (NV > 2) { n2 = ld4(xr + 512 + lane * 4); n3 = ld4(xr + 768 + lane * 4); } }
    for (; row < MTOT; row += nblk * 4) {
        const int mr = (row < MLAT) ? row / SEQ : BATCH;
        const float* md = MOD + (size_t)mr * 6 * D_MODEL;
        f32x4 v0 = n0, v1 = n1, v2 = n2, v3 = n3;
        const int nrow = row + nblk * 4;
        if (nrow < MTOT) { const float* xr = rowptr(nrow); n0 = ld4(xr + lane * 4); if (NV > 1) n1 = ld4(xr + 256 + lane * 4); if (NV > 2) { n2 = ld4(xr + 512 + lane * 4); n3 = ld4(xr + 768 + lane * 4); } }
        float s = hsum4(v0);
        if (NV > 1) s += hsum4(v1);
        if (NV > 2) s += hsum4(v2) + hsum4(v3);
        const float mu = wave_sum(s) * (1.0f / D_MODEL);
        v0 -= mu; float s2 = hsum4(v0 * v0);
        if (NV > 1) { v1 -= mu; s2 += hsum4(v1 * v1); }
        if (NV > 2) { v2 -= mu; v3 -= mu; s2 += hsum4(v2 * v2) + hsum4(v3 * v3); }
        const float rstd = frsq(wave_sum(s2) * (1.0f / D_MODEL) + LN_EPS);
        if (lane == 0) { STATS[row * 2] = mu; STATS[row * 2 + 1] = rstd; }
#pragma unroll
        for (int j = 0; j < NV; ++j) {
            const int k = j * 256 + lane * 4;
            const f32x4 vv = (j == 0) ? v0 : (j == 1) ? v1 : (j == 2) ? v2 : v3;
            const f32x4 h = vv * rstd * ld4(p.ln_in_g + k) + ld4(p.ln_in_b + k);
            *(U2*)(U + (size_t)row * D_MODEL + k) = pack4(h * (1.0f + ld4(md + D_MODEL + k)) + ld4(md + k));
        }
    }
}

constexpr int LDK = 64;
template <int MI, bool DUAL, class Epi>
__device__ __forceinline__ void gemm_tile(char* smem, const bf16_t* A, int lda, const int* rowidx, int m0, const bf16_t* Bt0, const bf16_t* Bt1, int ldb, int n0, int K, Epi epi, const float* rowscale = nullptr, int kscale = 0) {
    constexpr int BM = 32 * MI;
    bf16_t* As = (bf16_t*)smem;
    bf16_t* Bs = As + BM * LDK;
    int tid = threadIdx.x;
#ifndef HOST_EMU
    asm volatile("" : "+v"(tid));
#endif
    const int lane = tid & 63, wave = tid >> 6, wr = wave >> 1, wc = wave & 1, l15 = lane & 15, q = lane >> 4;
    const int ch = tid & 7, r0 = tid >> 3;
    unsigned aoff[MI], boff[4];
#pragma unroll
    for (int j = 0; j < MI; ++j) { const int r = m0 + r0 + 32 * j; aoff[j] = (unsigned)(rowidx ? rowidx[r] : r) * (unsigned)lda + ch * 8; }
#pragma unroll
    for (int j = 0; j < 4; ++j) boff[j] = (unsigned)(n0 + (DUAL ? (j >> 1) * 32 + r0 : r0 + 32 * j)) * (unsigned)ldb + ch * 8;
    const int wofs = r0 * LDK + ((ch ^ (r0 & 7)) * 8);
    u32x4 ar[MI], br[4];
    f32x4 acc[MI][4];
#pragma unroll
    for (int i = 0; i < MI; ++i)
#pragma unroll
        for (int j = 0; j < 4; ++j) acc[i][j] = f32x4{0.f, 0.f, 0.f, 0.f};
    const int nk = K / 64;
#pragma unroll
    for (int j = 0; j < MI; ++j) ar[j] = *(const u32x4*)(A + aoff[j]);
#pragma unroll
    for (int j = 0; j < 4; ++j) br[j] = *(const u32x4*)(((DUAL && (j & 1)) ? Bt1 : Bt0) + boff[j]);
    for (int kt = 0; kt < nk; ++kt) {
        __syncthreads();
#pragma unroll
        for (int j = 0; j < MI; ++j) *(u32x4*)(As + wofs + 32 * j * LDK) = ar[j];
#pragma unroll
        for (int j = 0; j < 4; ++j) *(u32x4*)(Bs + wofs + 32 * j * LDK) = br[j];
        __syncthreads();
        if (kt + 1 < nk) {
            const int ko = (kt + 1) * 64;
#pragma unroll
            for (int j = 0; j < MI; ++j) ar[j] = *(const u32x4*)(A + aoff[j] + ko);
#pragma unroll
            for (int j = 0; j < 4; ++j) br[j] = *(const u32x4*)(((DUAL && (j & 1)) ? Bt1 : Bt0) + boff[j] + ko);
        }
#pragma unroll
        for (int ks = 0; ks < 2; ++ks) {
            const int cofs = ((ks * 4 + q) ^ (l15 & 7)) * 8;
            bf16x8 bfr[4];
#pragma unroll
            for (int ni = 0; ni < 4; ++ni) bfr[ni] = *(const bf16x8*)(Bs + (wc * 64 + ni * 16 + l15) * LDK + cofs);
#pragma unroll
            for (int mi = 0; mi < MI; ++mi) {
                const bf16x8 af = *(const bf16x8*)(As + (wr * (16 * MI) + mi * 16 + l15) * LDK + cofs);
#pragma unroll
                for (int ni = 0; ni < 4; ++ni) acc[mi][ni] = MFMA16(bfr[ni], af, acc[mi][ni]);
            }
        }
        if (rowscale && kt + 1 == kscale) {
#pragma unroll
            for (int mi = 0; mi < MI; ++mi) {
                const float rs = rowscale[m0 + wr * (16 * MI) + mi * 16 + l15];
#pragma unroll
                for (int ni = 0; ni < 4; ++ni) acc[mi][ni] *= rs;
            }
        }
    }
#pragma unroll
    for (int mi = 0; mi < MI; ++mi) {
        const int ml = wr * (16 * MI) + mi * 16 + l15;
        if (DUAL) {
#pragma unroll
            for (int ni = 0; ni < 2; ++ni) epi(ml, wc * 32 + ni * 16 + q * 4, acc[mi][ni], acc[mi][ni + 2]);
        } else {
#pragma unroll
            for (int ni = 0; ni < 4; ++ni) epi(ml, wc * 64 + ni * 16 + q * 4, acc[mi][ni], acc[mi][ni]);
        }
    }
    __syncthreads();
}

__device__ __forceinline__ int xcd_vbid(int bid, int nblk) { return (nblk % 8 == 0) ? (bid % 8) * (nblk / 8) + bid / 8 : bid; }
constexpr int MI_C = (MTOT % 256 == 0) ? 8 : 4, MI_J = (MLAT % 256 == 0) ? 8 : 4, MI_E = (CAP % 256 == 0) ? 8 : 4;
__device__ __forceinline__ void phaseC(const Params& p, int bid, int nblk, char* smem) {
    const bf16_t* U = WSP(bf16_t, WS_R3); const bf16_t* WB = WSP(bf16_t, WS_WBIN);
    bf16_t* P = WSP(bf16_t, WS_R1);
    constexpr int BM = 32 * MI_C, NTN = D_IN / 128, NTM = MTOT / BM;
    constexpr int GM = (NTM % 8 == 0) ? 8 : (NTM % 4 == 0) ? 4 : 1;
    for (int it = xcd_vbid(bid, nblk); it < NTN * NTM; it += nblk) {
        const int mg = it / (GM * NTN), r = it % (GM * NTN), nt = r / GM, mt = mg * GM + (r % GM);
        gemm_tile<MI_C, false>(smem, U, D_MODEL, nullptr, mt * BM, WB, nullptr, D_MODEL, nt * 128, D_MODEL, [&](int ml, int nl, f32x4 v, f32x4) {
            *(U2*)(P + (size_t)(mt * BM + ml) * D_IN + nt * 128 + nl) = pack4(v);
        });
    }
}


template <int NYT, int KS>
__device__ __forceinline__ void mmT(f32x4* acc, const bf16_t* X, int ldx, int xs, const bf16_t* Y, int ldy, int lane) {
#pragma unroll
    for (int ks = 0; ks < KS; ++ks) {
        const bf16x8 xf = *(const bf16x8*)(X + (xs * 16 + (lane & 15)) * ldx + ks * 32 + 8 * (lane >> 4));
#pragma unroll
        for (int nb = 0; nb < NYT; ++nb) {
            const bf16x8 yf = *(const bf16x8*)(Y + (nb * 16 + (lane & 15)) * ldy + ks * 32 + 8 * (lane >> 4));
            acc[nb] = MFMA16(xf, yf, acc[nb]);
        }
    }
}

struct SeqChunk { int base_row; int t0; int len; };
__device__ __forceinline__ SeqChunk lru_chunk(int cg) {
    SeqChunk s;
    if (cg < NLCH) { const int b = cg / (SEQ / 64), ck = cg % (SEQ / 64); s.base_row = b * SEQ; s.t0 = ck * 64; s.len = SEQ; }
    else { const int c2 = cg - NLCH; const int b = c2 / (CTX_LEN / 64), ck = c2 % (CTX_LEN / 64); s.base_row = MLAT + b * CTX_LEN; s.t0 = ck * 64; s.len = CTX_LEN; }
    return s;
}
constexpr int L_XIN = 0;
constexpr int L_GT = 8704;
constexpr int L_XB = L_GT + 9216;
constexpr int L_WT = L_XB + 9216;
constexpr int L_CP = L_WT + 36864;
constexpr int L_END = L_CP + 4096;
static_assert(L_END <= SMEM_BYTES, "lru lds");
__device__ __forceinline__ void lru_load_w(const Params& p, char* smem, int cb) {
    bf16_t* WT = (bf16_t*)(smem + L_WT);
    const int tid = opaque_tid();
    for (int idx = tid; idx < 4 * 64 * 16; idx += 256) {
        const int m = idx >> 10, i = (idx >> 4) & 63, j4 = (idx & 15) * 4, d = m >> 1;
        const f32x4 w = ld4(((m & 1) ? p.lru_wx : p.lru_wa) + ((size_t)(d * LRU_BLOCKS + cb) * 64 + i) * 64 + j4);
        bf16_t* dst = WT + (m * 64 + j4) * 72 + i;
        dst[0] = f2bf(w[0]); dst[72] = f2bf(w[1]); dst[144] = f2bf(w[2]); dst[216] = f2bf(w[3]);
    }
}
struct LruConst { float ba[2][4], bx[2][4], sp8[2][4], gn[4], cw[4], cb0; };
__device__ __forceinline__ void lru_consts(const Params& p, int cb, LruConst& K) {
    const int l15 = threadIdx.x & 15, c = threadIdx.x & 63, ch = cb * 64 + c;
#pragma unroll
    for (int d = 0; d < 2; ++d)
#pragma unroll
        for (int nb = 0; nb < 4; ++nb) { const int cc = d * D_LRU + cb * 64 + nb * 16 + l15; K.ba[d][nb] = p.lru_ba[cc]; K.bx[d][nb] = p.lru_bx[cc]; K.sp8[d][nb] = -8.0f * softplusf_(-p.lru_lam[cc]); }
#pragma unroll
    for (int nb = 0; nb < 4; ++nb) K.gn[nb] = p.lru_norm_g[cb * 64 + nb * 16 + l15];
#pragma unroll
    for (int j = 0; j < 4; ++j) K.cw[j] = p.lru_conv_w[j * D_LRU + ch];
    K.cb0 = p.lru_conv_b[ch];
}
struct LruStage { u32x4 x[3]; u32x4 g[2]; };
template <bool FINAL>
__device__ __forceinline__ void lru_stage_load(const Params& p, int cg, int cb, LruStage& S) {
    const bf16_t* P = WSP(bf16_t, WS_R1);
    const SeqChunk sc = lru_chunk(cg);
    const int tid = opaque_tid();
#pragma unroll
    for (int k = 0; k < 3; ++k) {
        const int idx = tid + 256 * k, tt = idx >> 3, c8 = (idx & 7) * 8, t = sc.t0 - 1 + tt;
        S.x[k] = u32x4{0u, 0u, 0u, 0u};
        if (idx < 67 * 8 && t >= 0 && t < sc.len) S.x[k] = *(const u32x4*)(P + (size_t)(sc.base_row + t) * D_IN + cb * 64 + c8);
    }
    if (FINAL) {
#pragma unroll
        for (int k = 0; k < 2; ++k) { const int idx = tid + 256 * k, tt = idx >> 3, c8 = (idx & 7) * 8; S.g[k] = *(const u32x4*)(P + (size_t)(sc.base_row + sc.t0 + tt) * D_IN + D_LRU + cb * 64 + c8); }
    }
}
template <bool FINAL>
__device__ __forceinline__ void lru_item(const Params& p, char* smem, int cg, int cb, const LruConst& K, LruStage& S, int cg_next) {
    const bf16_t* P = WSP(bf16_t, WS_R1);
    bf16_t* XIN = (bf16_t*)(smem + L_XIN); bf16_t* GT = (bf16_t*)(smem + L_GT); bf16_t* XB = (bf16_t*)(smem + L_XB); const bf16_t* WT = (const bf16_t*)(smem + L_WT);
    float* CP = (float*)(smem + L_CP);
    const int tid = opaque_tid(), lane = tid & 63, wave = tid >> 6, q = lane >> 4, l15 = lane & 15;
    const SeqChunk sc = lru_chunk(cg);
    float cin[2][4];
    if (FINAL) {
#pragma unroll
        for (int d = 0; d < 2; ++d)
#pragma unroll
            for (int nb = 0; nb < 4; ++nb) cin[d][nb] = WSP(float, WS_CARRY)[((size_t)d * NLCH + cg) * D_LRU + cb * 64 + nb * 16 + l15];
    }
    __syncthreads();
#pragma unroll
    for (int k = 0; k < 3; ++k) { const int idx = tid + 256 * k, tt = idx >> 3, c8 = (idx & 7) * 8; if (idx < 67 * 8) *(u32x4*)(XIN + tt * 64 + c8) = S.x[k]; }
    if (FINAL) {
#pragma unroll
        for (int k = 0; k < 2; ++k) { const int idx = tid + 256 * k, tt = idx >> 3, c8 = (idx & 7) * 8; *(u32x4*)(GT + tt * 72 + c8) = S.g[k]; }
    }
    if (cg_next >= 0) lru_stage_load<FINAL>(p, cg_next, cb, S);
    __syncthreads();
    {
        const int c = tid & 63;
#pragma unroll 4
        for (int tt = tid >> 6; tt < 64; tt += 4)
            XB[tt * 72 + c] = f2bf(K.cb0 + bf2f(XIN[tt * 64 + c]) * K.cw[0] + bf2f(XIN[(tt + 1) * 64 + c]) * K.cw[1] + bf2f(XIN[(tt + 2) * 64 + c]) * K.cw[2] + bf2f(XIN[(tt + 3) * 64 + c]) * K.cw[3]);
    }
    __syncthreads();
    float hs[4][4];
    float av[4][4], bv[4][4];
#pragma unroll
    for (int d = 0; d < 2; ++d) {
        f32x4 ga[4], gx[4];
#pragma unroll
        for (int nb = 0; nb < 4; ++nb) { ga[nb] = f32x4{0.f, 0.f, 0.f, 0.f}; gx[nb] = f32x4{0.f, 0.f, 0.f, 0.f}; }
        mmT<4, 2>(ga, XB, 72, wave, WT + (2 * d) * 64 * 72, 72, lane);
        mmT<4, 2>(gx, XB, 72, wave, WT + (2 * d + 1) * 64 * 72, 72, lane);
        float cA[4], cH[4];
#pragma unroll
        for (int nb = 0; nb < 4; ++nb) {
            const float ba = K.ba[d][nb], bx = K.bx[d][nb], sp8 = K.sp8[d][nb];
#pragma unroll
            for (int r = 0; r < 4; ++r) {
                const float rg = fsigm(ga[nb][r] + ba), ig = fsigm(gx[nb][r] + bx);
                const float a = FEXP(sp8 * rg);
                const float xv = bf2f(XB[(wave * 16 + q * 4 + r) * 72 + nb * 16 + l15]);
                av[nb][r] = a; bv[nb][r] = fsqrt(fmaxf(1.0f - a * a, 0.f)) * ig * xv;
            }
            float A, H;
            if (d == 0) { A = av[nb][0]; H = bv[nb][0];
#pragma unroll
                for (int r = 1; r < 4; ++r) { H = H * av[nb][r] + bv[nb][r]; A *= av[nb][r]; } }
            else { A = av[nb][3]; H = bv[nb][3];
#pragma unroll
                for (int r = 2; r >= 0; --r) { H = H * av[nb][r] + bv[nb][r]; A *= av[nb][r]; } }
#pragma unroll
            for (int st = 1; st <= 2; st <<= 1) {
                const float pA = d == 0 ? __shfl_up(A, 16 * st) : __shfl_down(A, 16 * st), pH = d == 0 ? __shfl_up(H, 16 * st) : __shfl_down(H, 16 * st);
                const bool has = d == 0 ? (q >= st) : (q + st <= 3);
                if (has) { H = pH * A + H; A = pA * A; }
            }
            cA[nb] = A; cH[nb] = H;
            const bool last = d == 0 ? (q == 3) : (q == 0);
            if (last) { CP[((d * 4 + wave) * 64 + nb * 16 + l15) * 2] = A; CP[((d * 4 + wave) * 64 + nb * 16 + l15) * 2 + 1] = H; }
        }
        __syncthreads();
        if (!FINAL) {
            if (wave == 0 && q == 0) {
#pragma unroll
                for (int nb = 0; nb < 4; ++nb) {
                    const int c = nb * 16 + l15;
                    float A = 1.f, H = 0.f;
#pragma unroll
                    for (int w = 0; w < 4; ++w) { const int ww = d == 0 ? w : 3 - w; const float wa = CP[((d * 4 + ww) * 64 + c) * 2], wh = CP[((d * 4 + ww) * 64 + c) * 2 + 1]; H = H * wa + wh; A *= wa; }
                    WSP(float, WS_SUMA)[((size_t)d * NCH + cg) * D_LRU + cb * 64 + c] = A;
                    WSP(float, WS_SUMH)[((size_t)d * NCH + cg) * D_LRU + cb * 64 + c] = H;
                }
            }
        } else {
#pragma unroll
            for (int nb = 0; nb < 4; ++nb) {
                const int c = nb * 16 + l15;
                float h = cin[d][nb];
#pragma unroll
                for (int w = 0; w < 3; ++w) { const int ww = d == 0 ? w : 3 - w; const bool use = d == 0 ? (ww < wave) : (ww > wave);
                    if (use) h = h * CP[((d * 4 + ww) * 64 + c) * 2] + CP[((d * 4 + ww) * 64 + c) * 2 + 1]; }
                const float eA = d == 0 ? __shfl_up(cA[nb], 16) : __shfl_down(cA[nb], 16), eH = d == 0 ? __shfl_up(cH[nb], 16) : __shfl_down(cH[nb], 16);
                const bool first = d == 0 ? (q == 0) : (q == 3);
                if (!first) h = h * eA + eH;
                if (d == 0) {
#pragma unroll
                    for (int r = 0; r < 4; ++r) { h = h * av[nb][r] + bv[nb][r]; hs[nb][r] = h; }
                } else {
#pragma unroll
                    for (int r = 3; r >= 0; --r) { h = h * av[nb][r] + bv[nb][r]; hs[nb][r] += h; }
                }
            }
        }
        __syncthreads();
    }
    if (FINAL) {
        float ss[4] = {0.f, 0.f, 0.f, 0.f};
#pragma unroll
        for (int nb = 0; nb < 4; ++nb) {
            const float gn = K.gn[nb];
#pragma unroll
            for (int r = 0; r < 4; ++r) {
                const int tt = wave * 16 + q * 4 + r;
                const float v = hs[nb][r] * geluf_(bf2f(GT[tt * 72 + nb * 16 + l15]));
                ss[r] += v * v;
                XB[tt * 72 + nb * 16 + l15] = f2bf(v * gn);
            }
        }
#pragma unroll
        for (int r = 0; r < 4; ++r) {
#pragma unroll
            for (int o = 1; o < 16; o <<= 1) ss[r] += __shfl_xor(ss[r], o);
            if (l15 == 0) WSP(float, WS_SSQP)[(size_t)(sc.base_row + sc.t0 + wave * 16 + q * 4 + r) * LRU_BLOCKS + cb] = ss[r];
        }
        __syncthreads();
        bf16_t* MIX = WSP(bf16_t, WS_R3);
        for (int idx = tid; idx < 64 * 8; idx += 256) {
            const int tt = idx >> 3, c8 = (idx & 7) * 8;
            *(u32x4*)(MIX + (size_t)(sc.base_row + sc.t0 + tt) * D_MIX + cb * 64 + c8) = *(const u32x4*)(XB + tt * 72 + c8);
        }
    }
}
__device__ __forceinline__ void phaseD(const Params& p, int bid, int nblk, char* smem) {
    int cur = -1; LruConst K; LruStage S;
    for (int it = bid; it < NCH * LRU_BLOCKS; it += nblk) {
        const int cb = it % LRU_BLOCKS, cg = it / LRU_BLOCKS;
        if (cb != cur) { __syncthreads(); lru_load_w(p, smem, cb); lru_consts(p, cb, K); lru_stage_load<false>(p, cg, cb, S); cur = cb; }
        const int itn = it + nblk;
        lru_item<false>(p, smem, cg, cb, K, S, (itn < NCH * LRU_BLOCKS && itn % LRU_BLOCKS == cb) ? itn / LRU_BLOCKS : -1);
        if (itn < NCH * LRU_BLOCKS && itn % LRU_BLOCKS != cb) cur = -1;
    }
}
__device__ __forceinline__ void phaseE(const Params& p, int bid, int nblk, char* smem) {
    const float* SUMA = WSP(float, WS_SUMA); const float* SUMH = WSP(float, WS_SUMH); float* CARRY = WSP(float, WS_CARRY);
    constexpr int NLB = SEQ / 64, NCB = CTX_LEN / 64;
    for (int g = bid * 256 + threadIdx.x; g < BATCH * 2 * D_LRU; g += nblk * 256) {
        const int c = g % D_LRU, d = (g / D_LRU) & 1, b = g / (2 * D_LRU);
        const float* sa = SUMA + (size_t)d * NCH * D_LRU + c; const float* sh = SUMH + (size_t)d * NCH * D_LRU + c;
        float* cr = CARRY + (size_t)d * NLCH * D_LRU + c;
        float h = 0.f;
        if (d == 0) {
            for (int q2 = 0; q2 < NCB; ++q2) { const int gi = NLCH + b * NCB + q2; h = sa[(size_t)gi * D_LRU] * h + sh[(size_t)gi * D_LRU]; }
            for (int q2 = 0; q2 < NLB; ++q2) { const int gi = b * NLB + q2; cr[(size_t)gi * D_LRU] = h; h = sa[(size_t)gi * D_LRU] * h + sh[(size_t)gi * D_LRU]; }
        } else {
            for (int q2 = NCB - 1; q2 >= 0; --q2) { const int gi = NLCH + b * NCB + q2; h = sa[(size_t)gi * D_LRU] * h + sh[(size_t)gi * D_LRU]; }
            for (int q2 = NLB - 1; q2 >= 0; --q2) { const int gi = b * NLB + q2; cr[(size_t)gi * D_LRU] = h; h = sa[(size_t)gi * D_LRU] * h + sh[(size_t)gi * D_LRU]; }
        }
    }
}
__device__ __forceinline__ void phaseF(const Params& p, int bid, int nblk, char* smem) {
    int cur = -1; LruConst K; LruStage S;
    for (int it = bid; it < NLCH * LRU_BLOCKS; it += nblk) {
        const int cb = it % LRU_BLOCKS, cg = it / LRU_BLOCKS;
        if (cb != cur) { __syncthreads(); lru_load_w(p, smem, cb); lru_consts(p, cb, K); lru_stage_load<true>(p, cg, cb, S); cur = cb; }
        const int itn = it + nblk;
        lru_item<true>(p, smem, cg, cb, K, S, (itn < NLCH * LRU_BLOCKS && itn % LRU_BLOCKS == cb) ? itn / LRU_BLOCKS : -1);
        if (itn < NLCH * LRU_BLOCKS && itn % LRU_BLOCKS != cb) cur = -1;
    }
}

__device__ __forceinline__ size_t rwkv_row(int seg, int b, int s) {
    if (seg == 0) return (size_t)(MLAT + b * CTX_LEN + s);
    const int r = s % ROWS, c = s / ROWS;
    return (size_t)(b * SEQ + r * GRID_W + c);
}
__device__ __forceinline__ void chunk_info(int d, int c, int& seg, int& p0, int& len) {
    if (c < NCC) { seg = 0; len = CTX_LEN; p0 = (d == 0 ? c : NCC - 1 - c) * RC; }
    else { const int cc = c - NCC; seg = 1; len = SEQ; p0 = (d == 0 ? cc : NLC - 1 - cc) * RC; }
}
__device__ __forceinline__ void unpack8(const u32x4 v, float* o) {
    o[0] = bitsf(v[0] << 16); o[1] = bitsf(v[0] & 0xFFFF0000u); o[2] = bitsf(v[1] << 16); o[3] = bitsf(v[1] & 0xFFFF0000u);
    o[4] = bitsf(v[2] << 16); o[5] = bitsf(v[2] & 0xFFFF0000u); o[6] = bitsf(v[3] << 16); o[7] = bitsf(v[3] & 0xFFFF0000u);
}
__device__ __forceinline__ void shifted8(const Params& p, const bf16_t* P, int seg, int b, int pos, int len, int ch0, float* o) {
    float z[8], zp[8], zn[8];
    unpack8(*(const u32x4*)(P + rwkv_row(seg, b, pos) * D_IN + RW0 + ch0), z);
    if (pos > 0) unpack8(*(const u32x4*)(P + rwkv_row(seg, b, pos - 1) * D_IN + RW0 + ch0), zp); else { for (int i = 0; i < 8; ++i) zp[i] = 0.f; }
    if (pos < len - 1) unpack8(*(const u32x4*)(P + rwkv_row(seg, b, pos + 1) * D_IN + RW0 + ch0), zn); else { for (int i = 0; i < 8; ++i) zn[i] = 0.f; }
    const f32x4 mp0 = ld4(p.mu_prev + ch0), mp1 = ld4(p.mu_prev + ch0 + 4), mn0 = ld4(p.mu_next + ch0), mn1 = ld4(p.mu_next + ch0 + 4);
#pragma unroll
    for (int i = 0; i < 4; ++i) { o[i] = z[i] + mp0[i] * (zp[i] - z[i]) + mn0[i] * (zn[i] - z[i]); o[4 + i] = z[4 + i] + mp1[i] * (zp[4 + i] - z[4 + i]) + mn1[i] * (zn[4 + i] - z[4 + i]); }
}
constexpr int LT = 72, LJ = 40;
constexpr int R_RF = 0, R_KF = 8192, R_VF = 16384, R_LW = 24576, R_IC = 32768;
constexpr int R_NKA = 0, R_MBR = 2560, R_MKR = 5120;
constexpr int R_XU = 7680;
constexpr int R_IA = R_XU + 8448, R_IB = R_IA + 4608, R_PA = R_IB + 4608, R_PB = R_PA + 4608;
constexpr int R_WA = R_IB, R_U0 = R_WA + 5120;
constexpr int R_TB0 = R_IB, R_TB1 = R_IB + 2560, R_PB0 = R_IB + 5120, R_PB1 = R_IB + 7680, R_PT0 = R_IB + 10240, R_PT1 = R_IB + 12800;
static_assert(R_PT1 + 2560 <= 40960, "rwkv doubling buffers");
static_assert(R_U0 + 5120 <= R_PB + 4608 && R_PB + 4608 <= 40960, "rwkv scratch");
constexpr int R_O = 40960;
constexpr int R_AH = R_O, R_BH = R_AH + 4608, R_KH = R_BH + 4608, R_RH = R_KH + 4608;
constexpr int R_VT = R_RH + 4608, R_BHT = R_VT + 5120, R_KHT = R_BHT + 5120;
constexpr int R_GC = R_KHT + 5120, R_TOT = R_GC + 256, R_PS = R_TOT + 1024, R_END = R_PS + 1024;
constexpr int R_TW = R_O, R_TA = R_TW + 4608, R_W2T = R_TA + 4608, R_A2T = R_W2T + 9216;
static_assert(R_A2T + 9216 <= R_END && R_END <= SMEM_BYTES, "rwkv lds");

__device__ __forceinline__ void phaseR1(const Params& p, int bid, int nblk, char* smem) {
    const bf16_t* P = WSP(bf16_t, WS_R1);
    unsigned char* CH = p.ws + WS_CH;
    float* RBON = WSP(float, WS_RBON);
    float* Rf = (float*)(smem + R_RF); float* Kf = (float*)(smem + R_KF); float* Vf = (float*)(smem + R_VF); float* LW = (float*)(smem + R_LW); float* IC = (float*)(smem + R_IC);
    float* IA = (float*)(smem + R_IA); float* IB = (float*)(smem + R_IB); float* PA = (float*)(smem + R_PA); float* PB = (float*)(smem + R_PB); bf16_t* NkaT = (bf16_t*)(smem + R_NKA); bf16_t* MbrT = (bf16_t*)(smem + R_MBR); bf16_t* MkrT = (bf16_t*)(smem + R_MKR);
    float* Xu = (float*)(smem + R_XU); bf16_t* Wa = (bf16_t*)(smem + R_WA); bf16_t* U0 = (bf16_t*)(smem + R_U0);
    bf16_t* Ah = (bf16_t*)(smem + R_AH); bf16_t* Bh = (bf16_t*)(smem + R_BH); bf16_t* Kh = (bf16_t*)(smem + R_KH); bf16_t* Rh = (bf16_t*)(smem + R_RH);
    bf16_t* VT = (bf16_t*)(smem + R_VT); bf16_t* BhT = (bf16_t*)(smem + R_BHT); bf16_t* KhT = (bf16_t*)(smem + R_KHT);
    float* GC = (float*)(smem + R_GC); float* TOT = (float*)(smem + R_TOT); float* PS = (float*)(smem + R_PS);
    bf16_t* TW = (bf16_t*)(smem + R_TW); bf16_t* TA = (bf16_t*)(smem + R_TA); bf16_t* W2T = (bf16_t*)(smem + R_W2T); bf16_t* A2T = (bf16_t*)(smem + R_A2T);
    constexpr int NITEM = NCHAIN * NCK;
    const int per = (NITEM + nblk - 1) / nblk;
    const int it0 = bid * per, it1 = (it0 + per < NITEM) ? it0 + per : NITEM;
    for (int it = it0; it < it1; ++it) {
        const int tid = opaque_tid(), lane = tid & 63, wave = tid >> 6, q = lane >> 4, l15 = lane & 15;
        const int chain = it / NCK, c = it % NCK;
        const int d = chain & 1, h = (chain >> 1) % HEADS, b = chain / (2 * HEADS);
        int seg, p0, len; chunk_info(d, c, seg, p0, len);
        unsigned char* chp = CH + (size_t)it * CH_BYTES;
        const float kkc = p.k_k[h * 64 + lane], kac = p.k_a[h * 64 + lane];
        __syncthreads();
        {
            u32x4 wv[4];
#pragma unroll
            for (int k = 0; k < 4; ++k) {
                const int idx = tid + 256 * k, which = idx >> 9, j = (idx >> 3) & 63, c8 = (idx & 7) * 8;
                wv[k] = *(const u32x4*)(WSP(bf16_t, WS_LORA) + ((size_t)((d * 2 + which) * HEADS + h) * 64 + j) * 64 + c8);
            }
#pragma unroll
            for (int kb = 0; kb < 5; kb += 5) {
            u32x4 zc[5], zp[5], zn[5];
#pragma unroll
            for (int k = 0; k < 5; ++k) if (kb + k < 5) {
                const int idx = tid + 256 * (kb + k), tau = idx / 40, g = idx % 40, grp = g >> 3, j0 = (g & 7) * 8;
                const int pos = p0 + (d ? RC - 1 - tau : tau);
                const int ch0 = (grp < 3) ? grp * D_RWKV + h * 64 + j0 : (grp == 3 ? 3 * D_RWKV + d * 64 + j0 : 3 * D_RWKV + 128 + d * 64 + j0);
                const u32x4 zero = u32x4{0u, 0u, 0u, 0u};
                zc[k] = *(const u32x4*)(P + rwkv_row(seg, b, pos) * D_IN + RW0 + ch0);
                zp[k] = (pos > 0) ? *(const u32x4*)(P + rwkv_row(seg, b, pos - 1) * D_IN + RW0 + ch0) : zero;
                zn[k] = (pos < len - 1) ? *(const u32x4*)(P + rwkv_row(seg, b, pos + 1) * D_IN + RW0 + ch0) : zero;
            }
#pragma unroll
            for (int k = 0; k < 5; ++k) if (kb + k < 5) {
                const int idx = tid + 256 * (kb + k), tau = idx / 40, g = idx % 40, grp = g >> 3, j0 = (g & 7) * 8;
                const int ch0 = (grp < 3) ? grp * D_RWKV + h * 64 + j0 : (grp == 3 ? 3 * D_RWKV + d * 64 + j0 : 3 * D_RWKV + 128 + d * 64 + j0);
                float z[8], zpv[8], znv[8], o[8];
                unpack8(zc[k], z); unpack8(zp[k], zpv); unpack8(zn[k], znv);
                const f32x4 mp0 = ld4(p.mu_prev + ch0), mp1 = ld4(p.mu_prev + ch0 + 4), mn0 = ld4(p.mu_next + ch0), mn1 = ld4(p.mu_next + ch0 + 4);
#pragma unroll
                for (int e = 0; e < 4; ++e) { o[e] = z[e] + mp0[e] * (zpv[e] - z[e]) + mn0[e] * (znv[e] - z[e]); o[4 + e] = z[4 + e] + mp1[e] * (zpv[4 + e] - z[4 + e]) + mn1[e] * (znv[4 + e] - z[4 + e]); }
                if (grp < 3) {
                    float* dst = (grp == 0 ? Rf : grp == 1 ? Kf : Vf) + tau * 64 + j0;
                    *(f32x4*)dst = f32x4{o[0], o[1], o[2], o[3]}; *(f32x4*)(dst + 4) = f32x4{o[4], o[5], o[6], o[7]};
                } else if (grp == 3) {
                    u32x4 w;
#pragma unroll
                    for (int e = 0; e < 4; ++e) { const float t0 = 2.0f * frcp(1.0f + FEXP(-2.0f * o[2 * e])) - 1.0f, t1 = 2.0f * frcp(1.0f + FEXP(-2.0f * o[2 * e + 1])) - 1.0f; w[e] = pk2(t0, t1); }
                    *(u32x4*)(TW + tau * LT + j0) = w;
                } else {
                    u32x4 w; w[0] = pk2(o[0], o[1]); w[1] = pk2(o[2], o[3]); w[2] = pk2(o[4], o[5]); w[3] = pk2(o[6], o[7]);
                    *(u32x4*)(TA + tau * LT + j0) = w;
                }
            }
            }
#pragma unroll
            for (int k = 0; k < 4; ++k) {
                const int idx = tid + 256 * k, which = idx >> 9, j = (idx >> 3) & 63, c8 = (idx & 7) * 8;
                *(u32x4*)((which ? A2T : W2T) + j * LT + c8) = wv[k];
            }
        }
        __syncthreads();
        {
            f32x4 aw[2] = {f32x4{0.f, 0.f, 0.f, 0.f}, f32x4{0.f, 0.f, 0.f, 0.f}}, ai[2] = {f32x4{0.f, 0.f, 0.f, 0.f}, f32x4{0.f, 0.f, 0.f, 0.f}};
            mmT<2, 2>(aw, W2T, LT, wave, TW, LT, lane);
            mmT<2, 2>(ai, A2T, LT, wave, TA, LT, lane);
            const int j = wave * 16 + q * 4;
            const f32x4 w0v = ld4(p.w0 + d * D_RWKV + h * 64 + j), a0v = ld4(p.a0 + d * D_RWKV + h * 64 + j);
            const f32x4 kk4 = ld4(p.k_k + h * 64 + j), ka4 = ld4(p.k_a + h * 64 + j), rk4 = ld4(p.r_k + h * 64 + j);
#pragma unroll
            for (int nb = 0; nb < 2; ++nb) {
                const int tau = nb * 16 + l15;
                f32x4 lw, ic;
#pragma unroll
                for (int r = 0; r < 4; ++r) { lw[r] = -0.6065306597126334f * fsigm(w0v[r] + aw[nb][r]); ic[r] = fsigm(a0v[r] + ai[nb][r]); }
                *(f32x4*)(LW + tau * 64 + j) = lw; *(f32x4*)(IC + tau * 64 + j) = ic;
                const f32x4 kr = *(const f32x4*)(Kf + tau * 64 + j), rr = *(const f32x4*)(Rf + tau * 64 + j);
                const f32x4 kd = kr * (1.0f + (ic - 1.0f) * ka4), kq = kr * kk4;
                float n2 = hsum4(kq * kq), bon = hsum4(rr * kd * rk4);
                n2 += __shfl_xor(n2, 16); n2 += __shfl_xor(n2, 32); bon += __shfl_xor(bon, 16); bon += __shfl_xor(bon, 32);
                if (q == 0) { PS[(tau * 4 + wave) * 2] = n2; PS[(tau * 4 + wave) * 2 + 1] = bon; }
            }
        }
        __syncthreads();
        {
            const int j = lane, t0 = wave * 8;
            float cum[8], kd[8], kkn[8], icv[8], rr[8], vv[8], run = 0.f;
#pragma unroll
            for (int i = 0; i < 8; ++i) {
                const int t = t0 + i;
                run += LW[t * 64 + j]; cum[i] = run;
                const float kr = Kf[t * 64 + j]; icv[i] = IC[t * 64 + j]; rr[i] = Rf[t * 64 + j]; vv[i] = Vf[t * 64 + j];
                kd[i] = kr * (1.0f + (icv[i] - 1.0f) * kac);
                const float kk = kr * kkc;
                const f32x4 pa = *(const f32x4*)(PS + t * 8), pb = *(const f32x4*)(PS + t * 8 + 4);
                const float n2 = (pa[0] + pa[2]) + (pb[0] + pb[2]);
                kkn[i] = kk * frsq(fmaxf(n2, 1e-24f));
                if (lane == 0) RBON[(size_t)it * RC + t] = (pa[1] + pa[3]) + (pb[1] + pb[3]);
            }
            TOT[wave * 64 + j] = run;
            __syncthreads();
            float off = 0.f;
            for (int w = 0; w < wave; ++w) off += TOT[w * 64 + j];
            u32x4 vt, bt, kt;
            float e_prev = 0.f;
#pragma unroll
            for (int i = 0; i < 8; ++i) {
                const int t = t0 + i;
                const float cu = off + cum[i], cprev = (i == 0) ? off : off + cum[i - 1];
                const float g = FEXP(cu), gi = FEXP(-cu), gm = FEXP(cprev);
                const float ah = -kkn[i] * gm, bh = kkn[i] * icv[i] * gi, kh = kd[i] * gi, rh = rr[i] * g;
                Ah[t * LT + j] = f2bf(ah); Bh[t * LT + j] = f2bf(bh); Kh[t * LT + j] = f2bf(kh); Rh[t * LT + j] = f2bf(rh);
                if (i & 1) { vt[i >> 1] = pk2(e_prev, vv[i]); bt[i >> 1] = (bt[i >> 1] & 0xFFFFu) | ((unsigned)f2bf(bh) << 16); kt[i >> 1] = (kt[i >> 1] & 0xFFFFu) | ((unsigned)f2bf(kh) << 16); }
                else { e_prev = vv[i]; bt[i >> 1] = f2bf(bh); kt[i >> 1] = f2bf(kh); }
                if (t == RC - 1) GC[j] = g;
            }
            *(u32x4*)(VT + j * LJ + t0) = vt; *(u32x4*)(BhT + j * LJ + t0) = bt; *(u32x4*)(KhT + j * LJ + t0) = kt;
        }
        __syncthreads();
        {
            const bf16_t* X = (wave == 0) ? Ah : (wave & 1) ? Kh : Bh;
            const bf16_t* Y = (wave == 0) ? Bh : (wave == 1) ? Ah : Rh;
#pragma unroll
            for (int xs = 0; xs < 2; ++xs) {
                f32x4 acc[2] = {f32x4{0.f, 0.f, 0.f, 0.f}, f32x4{0.f, 0.f, 0.f, 0.f}};
                mmT<2, 2>(acc, X, LT, xs, Y, LT, lane);
#pragma unroll
                for (int nb = 0; nb < 2; ++nb) {
                    const int yy = nb * 16 + l15, x0 = xs * 16 + q * 4;
                    f32x4 v = acc[nb];
#pragma unroll
                    for (int r = 0; r < 4; ++r) { const int xx = x0 + r; const bool keep = (wave == 0) ? (yy < xx) : (wave == 1) ? (xx < yy) : (xx <= yy); v[r] = keep ? v[r] : 0.f; }
                    if (wave == 0) {
                        bf16_t* Pb0 = (bf16_t*)(smem + R_PB0); bf16_t* Pt0 = (bf16_t*)(smem + R_PT0); bf16_t* Tb0 = (bf16_t*)(smem + R_TB0);
                        *(U2*)(Pb0 + yy * LJ + x0) = pack4(v);
#pragma unroll
                        for (int r = 0; r < 4; ++r) Pt0[(x0 + r) * LJ + yy] = f2bf(v[r]);
                        f32x4 t0 = v;
#pragma unroll
                        for (int r = 0; r < 4; ++r) t0[r] += (x0 + r == yy) ? 1.0f : 0.0f;
                        *(f32x4*)(IA + yy * 36 + x0) = t0; *(U2*)(Tb0 + yy * LJ + x0) = pack4(t0);
                    }
                    else { bf16_t* dst = (wave == 1 ? NkaT : wave == 2 ? MbrT : MkrT) + yy * LJ + x0; *(U2*)dst = pack4(v); }
                }
            }
        }
        __syncthreads();
        {
#pragma unroll
            for (int xs = 0; xs < 2; ++xs) {
                f32x4 acc[1] = {f32x4{0.f, 0.f, 0.f, 0.f}};
                mmT<1, 1>(acc, NkaT, LJ, xs, VT + wave * 16 * LJ, LJ, lane);
                const int i = wave * 16 + l15, tb = xs * 16 + q * 4;
                Xu[i * 33 + tb] = acc[0][0]; Xu[i * 33 + tb + 1] = acc[0][1]; Xu[i * 33 + tb + 2] = acc[0][2]; Xu[i * 33 + tb + 3] = acc[0][3];
            }
        }
        __syncthreads();
        {
            bf16_t* Tb[2] = {(bf16_t*)(smem + R_TB0), (bf16_t*)(smem + R_TB1)};
            bf16_t* Pb[2] = {(bf16_t*)(smem + R_PB0), (bf16_t*)(smem + R_PB1)};
            bf16_t* Pt[2] = {(bf16_t*)(smem + R_PT0), (bf16_t*)(smem + R_PT1)};
            const int nb = wave >> 1, xs = wave & 1;
            const int yy = nb * 16 + l15, x0 = xs * 16 + q * 4;
            auto prod = [&](const bf16_t* L, const bf16_t* Rt, f32x4 init) {
                const bf16x8 xf = *(const bf16x8*)(Rt + (xs * 16 + l15) * LJ + 8 * q), yf = *(const bf16x8*)(L + (nb * 16 + l15) * LJ + 8 * q);
                return MFMA16(xf, yf, init);
            };
            const f32x4 zero = f32x4{0.f, 0.f, 0.f, 0.f};
#pragma unroll
            for (int k = 0; k < 5; ++k) {
                const int pc = k & 1, pn = pc ^ 1;
                f32x4 tnew = zero, pnew = zero;
                if (k >= 1) tnew = prod(Tb[pn], Pt[pc], *(const f32x4*)(IA + yy * 36 + x0));
                if (k <= 3) pnew = prod(Pb[pc], Pt[pc], zero);
                if (k >= 1) { *(f32x4*)(IA + yy * 36 + x0) = tnew; if (k <= 3) *(U2*)(Tb[pc] + yy * LJ + x0) = pack4(tnew); }
                if (k <= 3) {
                    *(U2*)(Pb[pn] + yy * LJ + x0) = pack4(pnew);
#pragma unroll
                    for (int r = 0; r < 4; ++r) Pt[pn][(x0 + r) * LJ + yy] = f2bf(pnew[r]);
                }
                __syncthreads();
            }
            f32x4 accw[2], accu[2];
#pragma unroll
            for (int tc = 0; tc < 2; ++tc) { accw[tc] = f32x4{0.f, 0.f, 0.f, 0.f}; accu[tc] = f32x4{0.f, 0.f, 0.f, 0.f}; }
#pragma unroll
            for (int k0 = 0; k0 < 32; k0 += 4) {
                const float la = bf2f(Ah[(k0 + q) * LT + wave * 16 + l15]), lu = Xu[(wave * 16 + l15) * 33 + k0 + q];
#pragma unroll
                for (int tc = 0; tc < 2; ++tc) { const float rv = IA[(k0 + q) * 36 + tc * 16 + l15]; accw[tc] = MFMAF32(la, rv, accw[tc]); accu[tc] = MFMAF32(lu, rv, accu[tc]); }
            }
            __syncthreads();
#pragma unroll
            for (int tc = 0; tc < 2; ++tc)
#pragma unroll
                for (int r = 0; r < 4; ++r) { const int row = wave * 16 + q * 4 + r, col = tc * 16 + l15; Wa[row * LJ + col] = f2bf(accw[tc][r]); U0[row * LJ + col] = f2bf(accu[tc][r]); }
        }
        __syncthreads();
        {
            bf16_t* gPm = (bf16_t*)(chp + CH_PM); bf16_t* gSA = (bf16_t*)(chp + CH_SA); bf16_t* gQT = (bf16_t*)(chp + CH_QT); bf16_t* gY0 = (bf16_t*)(chp + CH_Y0);
            const int x0 = wave * 16 + q * 4;
            {
                f32x4 acc[4] = {f32x4{0.f, 0.f, 0.f, 0.f}, f32x4{0.f, 0.f, 0.f, 0.f}, f32x4{0.f, 0.f, 0.f, 0.f}, f32x4{0.f, 0.f, 0.f, 0.f}};
                mmT<4, 1>(acc, Wa, LJ, wave, BhT, LJ, lane);
#pragma unroll
                for (int nb = 0; nb < 4; ++nb) {
                    const int jp = nb * 16 + l15; const float g = GC[jp];
                    f32x4 v = acc[nb];
#pragma unroll
                    for (int r = 0; r < 4; ++r) v[r] = (v[r] + ((x0 + r == jp) ? 1.0f : 0.0f)) * g;
                    *(U2*)(gPm + jp * 64 + x0) = pack4(v);
                }
            }
            {
                f32x4 acc[4] = {f32x4{0.f, 0.f, 0.f, 0.f}, f32x4{0.f, 0.f, 0.f, 0.f}, f32x4{0.f, 0.f, 0.f, 0.f}, f32x4{0.f, 0.f, 0.f, 0.f}};
                mmT<4, 1>(acc, BhT, LJ, wave, U0, LJ, lane);
                mmT<4, 1>(acc, KhT, LJ, wave, VT, LJ, lane);
                const f32x4 g = *(const f32x4*)(GC + x0);
#pragma unroll
                for (int nb = 0; nb < 4; ++nb) *(U2*)(gSA + (nb * 16 + l15) * 64 + x0) = pack4(acc[nb] * g);
            }
            if (seg == 1) {
                {
                    f32x4 acc[2] = {f32x4{0.f, 0.f, 0.f, 0.f}, f32x4{0.f, 0.f, 0.f, 0.f}};
                    mmT<2, 1>(acc, Wa, LJ, wave, MbrT, LJ, lane);
#pragma unroll
                    for (int nb = 0; nb < 2; ++nb) {
                        const int t = nb * 16 + l15;
                        f32x4 v = acc[nb];
#pragma unroll
                        for (int r = 0; r < 4; ++r) v[r] += bf2f(Rh[t * LT + x0 + r]);
                        *(U2*)(gQT + t * 64 + x0) = pack4(v);
                    }
                }
                {
                    f32x4 acc[2] = {f32x4{0.f, 0.f, 0.f, 0.f}, f32x4{0.f, 0.f, 0.f, 0.f}};
                    mmT<2, 1>(acc, U0, LJ, wave, MbrT, LJ, lane);
                    mmT<2, 1>(acc, VT, LJ, wave, MkrT, LJ, lane);
#pragma unroll
                    for (int nb = 0; nb < 2; ++nb) *(U2*)(gY0 + (nb * 16 + l15) * 64 + x0) = pack4(acc[nb]);
                }
            }
        }
    }
}

__device__ __forceinline__ U2 ldu2(const bf16_t* p) { return *(const U2*)p; }
constexpr int R2D = 6, R2LD = 72;
__device__ __forceinline__ void phaseR2(const Params& p, int bid, int nblk, char* smem) {
    unsigned char* CH = p.ws + WS_CH;
    bf16_t* PL = (bf16_t*)smem;
    const int tid = opaque_tid(), lane = tid & 63, wave = tid >> 6, q = lane >> 4, l15 = lane & 15;
    const int lrow = wave * 16 + (lane >> 2), lcol = (lane & 3) * 16;
    for (int chain = bid; chain < NCHAIN; chain += nblk) {
        const int i = wave * 16 + l15;
        unsigned char* chbase = CH + (size_t)chain * NCK * CH_BYTES;
        f32x4 st[4];
#pragma unroll
        for (int nt = 0; nt < 4; ++nt) st[nt] = f32x4{0.f, 0.f, 0.f, 0.f};
        u32x4 pq[R2D][2]; U2 sa[R2D][4];
#pragma unroll
        for (int k = 0; k < R2D; ++k) {
            const unsigned char* chp = chbase + (size_t)(k < NCK ? k : NCK - 1) * CH_BYTES;
            const bf16_t* gp = (const bf16_t*)(chp + CH_PM) + lrow * 64 + lcol;
            pq[k][0] = *(const u32x4*)gp; pq[k][1] = *(const u32x4*)(gp + 8);
#pragma unroll
            for (int nt = 0; nt < 4; ++nt) sa[k][nt] = ldu2((const bf16_t*)(chp + CH_SA) + i * 64 + nt * 16 + 4 * q);
        }
#pragma unroll 1
        for (int c0 = 0; c0 < NCK; c0 += R2D) {
#pragma unroll
            for (int k = 0; k < R2D; ++k) {
                const int c = c0 + k;
                if (c < NCK) {
                bf16_t* pl = PL + (k & 1) * 64 * R2LD;
                *(u32x4*)(pl + lrow * R2LD + lcol) = pq[k][0]; *(u32x4*)(pl + lrow * R2LD + lcol + 8) = pq[k][1];
                f32x4 ini[4];
#pragma unroll
                for (int nt = 0; nt < 4; ++nt) ini[nt] = f32x4{bitsf(sa[k][nt].x << 16), bitsf(sa[k][nt].x & 0xFFFF0000u), bitsf(sa[k][nt].y << 16), bitsf(sa[k][nt].y & 0xFFFF0000u)};
                {
                    const int cn = (c + R2D < NCK) ? c + R2D : NCK - 1;
                    const unsigned char* chp = chbase + (size_t)cn * CH_BYTES;
                    const bf16_t* gp = (const bf16_t*)(chp + CH_PM) + lrow * 64 + lcol;
                    pq[k][0] = *(const u32x4*)gp; pq[k][1] = *(const u32x4*)(gp + 8);
#pragma unroll
                    for (int nt = 0; nt < 4; ++nt) sa[k][nt] = ldu2((const bf16_t*)(chp + CH_SA) + i * 64 + nt * 16 + 4 * q);
                }
                __syncthreads();
                bf16_t* gSA = (bf16_t*)(chbase + (size_t)c * CH_BYTES + CH_SA) + i * 64 + 4 * q;
                bf16x8 bfr[2];
#pragma unroll
                for (int ks = 0; ks < 2; ++ks) {
                    const U2 lo = pack4(st[2 * ks]), hi = pack4(st[2 * ks + 1]);
                    bfr[ks] = __builtin_bit_cast(bf16x8, u32x4{lo.x, lo.y, hi.x, hi.y});
                    *(U2*)(gSA + (2 * ks) * 16) = lo; *(U2*)(gSA + (2 * ks + 1) * 16) = hi;
                }
#pragma unroll
                for (int nt = 0; nt < 4; ++nt) {
                    f32x4 acc = ini[nt];
#pragma unroll
                    for (int ks = 0; ks < 2; ++ks) {
                        const U2 lo = *(const U2*)(pl + (nt * 16 + l15) * R2LD + 32 * ks + 4 * q), hi = *(const U2*)(pl + (nt * 16 + l15) * R2LD + 32 * ks + 16 + 4 * q);
                        acc = MFMA16(__builtin_bit_cast(bf16x8, u32x4{lo.x, lo.y, hi.x, hi.y}), bfr[ks], acc);
                    }
                    st[nt] = acc;
                }
                }
            }
        }
        __syncthreads();
    }
}

__device__ __forceinline__ void phaseR3(const Params& p, int bid, int nblk, char* smem) {
    const bf16_t* P = WSP(bf16_t, WS_R1);
    const unsigned char* CH = p.ws + WS_CH;
    const float* RBON = WSP(float, WS_RBON);
    bf16_t* MIX = WSP(bf16_t, WS_R3);
    float* red = (float*)smem;
    const int tid = opaque_tid(), lane = tid & 63, wave = tid >> 6, q = lane >> 4, l15 = lane & 15;
    for (int m = bid * 256 + tid; m < MLAT; m += nblk * 256) {
        const float* sp = WSP(float, WS_SSQP) + (size_t)m * LRU_BLOCKS;
        float sq = 0.f;
#pragma unroll
        for (int c = 0; c < LRU_BLOCKS; ++c) sq += sp[c];
        WSP(float, WS_RINV)[m] = frsq(sq * (1.0f / D_LRU) + RMS_EPS);
    }
    bf16_t* G2T = (bf16_t*)(smem + 1024);
    const int nbh = nblk / HEADS;
    const bool uniform = (nbh > 0) && (nblk % HEADS == 0);
    constexpr int NP16 = SEQ / 16, NW = BATCH * NP16;
    const int nwv = uniform ? nbh * 4 : nblk * 4;
    int hcur = -1;
    for (int wi0 = (uniform ? (bid % nbh) : bid) * 4; wi0 < (uniform ? NW : NW * HEADS); wi0 += nwv) {
        int h; if (uniform) h = bid / nbh; else h = (wi0 / 4) % HEADS;
        if (h != hcur) {
            __syncthreads();
            for (int idx = tid; idx < 128 * 16; idx += 256) {
                const int c = idx >> 4, i4 = (idx & 15) * 4;
                const f32x4 w = ld4(p.g2 + (size_t)c * D_RWKV + h * 64 + i4);
                bf16_t* dst = G2T + i4 * 136 + c;
                dst[0] = f2bf(w[0]); dst[136] = f2bf(w[1]); dst[272] = f2bf(w[2]); dst[408] = f2bf(w[3]);
            }
            hcur = h;
            __syncthreads();
        }
        const int wi = uniform ? wi0 + wave : (wi0 / 4 / HEADS) * 4 + wave;
        if (wi >= NW) continue;
        const int b = wi / NP16, p16 = wi % NP16, pc = p16 >> 1, pl = (p16 & 1) * 16 + l15, pos = pc * RC + pl;
        f32x4 y[4], g[4];
#pragma unroll
        for (int xs = 0; xs < 4; ++xs) { y[xs] = f32x4{0.f, 0.f, 0.f, 0.f}; g[xs] = f32x4{0.f, 0.f, 0.f, 0.f}; }
        float bon = 0.f;
#pragma unroll
        for (int d = 0; d < 2; ++d) {
            const int chain = (b * HEADS + h) * 2 + d, c = NCC + (d ? NLC - 1 - pc : pc), tau = d ? RC - 1 - pl : pl;
            const size_t item = (size_t)chain * NCK + c;
            const unsigned char* chp = CH + item * CH_BYTES;
            const bf16_t* gS = (const bf16_t*)(chp + CH_SA); const bf16_t* gQT = (const bf16_t*)(chp + CH_QT); const bf16_t* gY0 = (const bf16_t*)(chp + CH_Y0);
            bf16x8 yf[2];
#pragma unroll
            for (int ks = 0; ks < 2; ++ks) yf[ks] = *(const bf16x8*)(gQT + tau * 64 + ks * 32 + 8 * q);
#pragma unroll
            for (int xs = 0; xs < 4; ++xs) {
                f32x4 acc = ldb4(gY0 + tau * 64 + xs * 16 + 4 * q);
#pragma unroll
                for (int ks = 0; ks < 2; ++ks) acc = MFMA16(*(const bf16x8*)(gS + (xs * 16 + l15) * 64 + ks * 32 + 8 * q), yf[ks], acc);
                y[xs] += acc;
            }
            bon += RBON[item * RC + tau];
        }
#pragma unroll
        for (int ks = 0; ks < 4; ++ks) {
            float o[8]; shifted8(p, P, 1, b, pos, SEQ, 3 * D_RWKV + 256 + ks * 32 + 8 * q, o);
            u32x4 t; t[0] = pk2(fsigm(o[0]), fsigm(o[1])); t[1] = pk2(fsigm(o[2]), fsigm(o[3])); t[2] = pk2(fsigm(o[4]), fsigm(o[5])); t[3] = pk2(fsigm(o[6]), fsigm(o[7]));
            const bf16x8 sg = __builtin_bit_cast(bf16x8, t);
#pragma unroll
            for (int xs = 0; xs < 4; ++xs) g[xs] = MFMA16(*(const bf16x8*)(G2T + (xs * 16 + l15) * 136 + ks * 32 + 8 * q), sg, g[xs]);
        }
        float s1 = 0.f, s2 = 0.f;
#pragma unroll
        for (int xs = 0; xs < 4; ++xs) { s1 += hsum4(y[xs]); s2 += hsum4(y[xs] * y[xs]); }
        s1 += __shfl_xor(s1, 16); s1 += __shfl_xor(s1, 32); s2 += __shfl_xor(s2, 16); s2 += __shfl_xor(s2, 32);
        const float mu = s1 * (1.0f / 64.0f), var = fmaxf(s2 * (1.0f / 64.0f) - mu * mu, 0.f), rstd = frsq(var + GN_EPS);
        const size_t mrow = rwkv_row(1, b, pos);
        const size_t mprev = pos > 0 ? rwkv_row(1, b, pos - 1) : mrow, mnext = pos < SEQ - 1 ? rwkv_row(1, b, pos + 1) : mrow;
#pragma unroll
        for (int xs = 0; xs < 4; ++xs) {
            const int i0 = xs * 16 + q * 4, chv = 2 * D_RWKV + h * 64 + i0;
            const f32x4 z = ldb4(P + mrow * D_IN + RW0 + chv);
            f32x4 zp = ldb4(P + mprev * D_IN + RW0 + chv), zn = ldb4(P + mnext * D_IN + RW0 + chv);
            if (pos == 0) zp = f32x4{0.f, 0.f, 0.f, 0.f};
            if (pos == SEQ - 1) zn = f32x4{0.f, 0.f, 0.f, 0.f};
            const f32x4 v = z + ld4(p.mu_prev + chv) * (zp - z) + ld4(p.mu_next + chv) * (zn - z);
            const f32x4 yn = (y[xs] - mu) * rstd * ld4(p.gn_g + h * 64 + i0) + ld4(p.gn_b + h * 64 + i0);
            *(U2*)(MIX + mrow * D_MIX + D_LRU + h * 64 + i0) = pack4((yn + bon * v) * g[xs]);
        }
    }
}

__device__ __forceinline__ void phaseJ(const Params& p, int bid, int nblk, char* smem) {
    const bf16_t* MIX = WSP(bf16_t, WS_R3); const bf16_t* WB = WSP(bf16_t, WS_WBOUT);
    bf16_t* YOUT = WSP(bf16_t, WS_R1);
    const float* RINV = WSP(float, WS_RINV);
    constexpr int BM = 32 * MI_J, NTN = D_MODEL / 128, NTM = MLAT / BM;
    constexpr int GM = (NTM % 8 == 0) ? 8 : 1;
    for (int it = xcd_vbid(bid, nblk); it < NTN * NTM; it += nblk) {
        const int mg = it / (GM * NTN), r = it % (GM * NTN), nt = r / GM, mt = mg * GM + (r % GM);
        gemm_tile<MI_J, false>(smem, MIX, D_MIX, nullptr, mt * BM, WB, nullptr, D_MIX, nt * 128, D_MIX, [&](int ml, int nl, f32x4 v, f32x4) {
            *(U2*)(YOUT + (size_t)(mt * BM + ml) * D_MODEL + nt * 128 + nl) = pack4(v);
        }, RINV, D_LRU / 64);
    }
}

constexpr int KUL = D_MODEL + 2;
static_assert((16 * KUL + 4 * 256) * 4 <= SMEM_BYTES && N_EXPERTS <= 16 && MLAT % 16 == 0, "phase K lds");
__device__ __forceinline__ void phaseK(const Params& p, int bid, int nblk, char* smem) {
    const int tid = opaque_tid(), lane = tid & 63, wave = tid >> 6, q = lane >> 4, l15 = lane & 15;
    const float* MOD = WSP(float, WS_MOD); const float* STATS = WSP(float, WS_STATS);
    const bf16_t* YOUT = WSP(bf16_t, WS_R1);
    float* H1 = WSP(float, WS_R5); bf16_t* U2b = WSP(bf16_t, WS_R6); float* AFF = WSP(float, WS_AFF);
    float* UL = (float*)smem;
    float* PL = UL + 16 * KUL;
    for (int rb = bid; rb < MLAT / 16; rb += nblk) {
        __syncthreads();
#pragma unroll 1
        for (int rr = 0; rr < 4; ++rr) {
            const int lr = wave * 4 + rr, row = rb * 16 + lr;
            const float* xr = p.x + (size_t)row * D_MODEL;
            const float* md = MOD + (size_t)(row / SEQ) * 6 * D_MODEL;
            const float mu0 = STATS[row * 2], rs0 = STATS[row * 2 + 1];
            f32x4 v0, v1, v2, v3; float s = 0.f;
#define PK_LOAD(V, J) { const int k = (J) * 256 + lane * 4; \
            V = ALPHA_F * ((ld4(xr + k) - mu0) * rs0 * ld4(p.ln_in_g + k) + ld4(p.ln_in_b + k)) + ld4(md + 2 * D_MODEL + k) * ldb4(YOUT + (size_t)row * D_MODEL + k); s += hsum4(V); }
            PK_LOAD(v0, 0)
            if (NV > 1) PK_LOAD(v1, 1) else v1 = f32x4{0.f, 0.f, 0.f, 0.f};
            if (NV > 2) { PK_LOAD(v2, 2) PK_LOAD(v3, 3) } else { v2 = v1; v3 = v1; }
#undef PK_LOAD
            const float mu = wave_sum(s) * (1.0f / D_MODEL);
            v0 -= mu; float s2 = hsum4(v0 * v0);
            if (NV > 1) { v1 -= mu; s2 += hsum4(v1 * v1); }
            if (NV > 2) { v2 -= mu; v3 -= mu; s2 += hsum4(v2 * v2) + hsum4(v3 * v3); }
            const float rstd = frsq(wave_sum(s2) * (1.0f / D_MODEL) + LN_EPS);
#pragma unroll
            for (int j = 0; j < NV; ++j) {
                const int k = j * 256 + lane * 4;
                const f32x4 vv = (j == 0) ? v0 : (j == 1) ? v1 : (j == 2) ? v2 : v3;
                const f32x4 h = vv * rstd * ld4(p.ln1_g + k) + ld4(p.ln1_b + k);
                *(f32x4*)(H1 + (size_t)row * D_MODEL + k) = h;
                const f32x4 u = h * (1.0f + ld4(md + 4 * D_MODEL + k)) + ld4(md + 3 * D_MODEL + k);
                *(U2*)(U2b + (size_t)row * D_MODEL + k) = pack4(u);
                float* ul = UL + lr * KUL + k;
                *(f32x2_e*)ul = f32x2_e{u[0], u[1]}; *(f32x2_e*)(ul + 2) = f32x2_e{u[2], u[3]};
            }
        }
        __syncthreads();
        {
            f32x4 acc = f32x4{0.f, 0.f, 0.f, 0.f};
            const int kq0 = wave * (D_MODEL / 4);
#pragma unroll 8
            for (int s4 = 0; s4 < D_MODEL / 16; ++s4) {
                const int k = kq0 + s4 * 4 + q;
                const float av = UL[l15 * KUL + k];
                const float bv = (l15 < N_EXPERTS) ? p.w_router[(size_t)k * N_EXPERTS + l15] : 0.f;
                acc = MFMAF32(av, bv, acc);
            }
#pragma unroll
            for (int r = 0; r < 4; ++r) PL[wave * 256 + (q * 4 + r) * 16 + l15] = acc[r];
        }
        __syncthreads();
        {
            const int lr = tid >> 4, e = tid & 15;
            const bool valid = e < N_EXPERTS;
            float lg = PL[tid] + PL[256 + tid] + PL[512 + tid] + PL[768 + tid];
            float mx = valid ? lg : -3.0e38f;
#pragma unroll
            for (int o = 1; o < 16; o <<= 1) mx = fmaxf(mx, __shfl_xor(mx, o));
            const float ex = valid ? expf(lg - mx) : 0.f;
            float den = ex;
#pragma unroll
            for (int o = 1; o < 16; o <<= 1) den += __shfl_xor(den, o);
            if (valid) AFF[(size_t)(rb * 16 + lr) * N_EXPERTS + e] = ex / den;
        }
    }
}

__device__ __forceinline__ int block_sum_int(int v, int* red) {
    const int tid_ = opaque_tid(), lane = tid_ & 63, wave = tid_ >> 6;
#pragma unroll
    for (int o = 1; o < 64; o <<= 1) v += __shfl_xor(v, o);
    __syncthreads();
    if (lane == 0) red[wave] = v;
    __syncthreads();
    return red[0] + red[1] + red[2] + red[3];
}
__device__ __forceinline__ void phaseL(const Params& p, int bid, int nblk, char* smem) {
    const float* AFF = WSP(float, WS_AFF);
    int* IDX = WSP(int, WS_IDX); float* GATE = WSP(float, WS_GATE); int* SLOTOF = WSP(int, WS_SLOT);
    unsigned* vals = (unsigned*)smem;
    int* red = (int*)(vals + SEQ);
    int* wsum = red + 8;
    const int tid = opaque_tid(), lane = tid & 63, wave = tid >> 6;
    constexpr int PER = SEQ / 256;
    {
        constexpr int NL = BATCH * N_EXPERTS;
        const bool spare = nblk > NL + 32;
        if (spare ? (bid >= NL) : true) convert_experts(p, spare ? bid - NL : bid, spare ? nblk - NL : nblk, smem, 0, 2);
        if (spare && bid >= NL) return;
        __syncthreads();
    }
    for (int be = bid; be < BATCH * N_EXPERTS; be += nblk) {
        const int b = be / N_EXPERTS, e = be % N_EXPERTS;
        __syncthreads();
        for (int t = tid; t < SEQ; t += 256) vals[t] = fbits(AFF[((size_t)b * SEQ + t) * N_EXPERTS + e]);
        __syncthreads();
        unsigned lo = 0u, hi = 0x7F800000u;
        while (lo < hi) {
            const unsigned mid = lo + (hi - lo + 1u) / 2u;
            int c = 0;
            for (int t = tid; t < SEQ; t += 256) c += (vals[t] >= mid) ? 1 : 0;
            c = block_sum_int(c, red);
            if (c >= CAP) lo = mid; else hi = mid - 1u;
        }
        const unsigned T = lo;
        int cg = 0, ce = 0;
        for (int q = 0; q < PER; ++q) { const unsigned v = vals[tid * PER + q]; cg += (v > T) ? 1 : 0; ce += (v == T) ? 1 : 0; }
        int pg = cg, pe = ce;
#pragma unroll
        for (int o = 1; o < 64; o <<= 1) { const int a = __shfl_up(pg, o), bb = __shfl_up(pe, o); if (lane >= o) { pg += a; pe += bb; } }
        __syncthreads();
        if (lane == 63) { wsum[wave] = pg; wsum[4 + wave] = pe; }
        __syncthreads();
        int og = 0, oe = 0, totg = 0;
        for (int w = 0; w < 4; ++w) { if (w < wave) { og += wsum[w]; oe += wsum[4 + w]; } totg += wsum[w]; }
        int posg = og + pg - cg, pose = oe + pe - ce;
        const int need_eq = CAP - totg;
        for (int q = 0; q < PER; ++q) {
            const int t = tid * PER + q; const unsigned v = vals[t];
            int slot = -1;
            if (v > T) { slot = posg++; }
            else if (v == T) { if (pose < need_eq) slot = totg + pose; pose++; }
            if (slot >= 0) { IDX[(size_t)be * CAP + slot] = b * SEQ + t; GATE[(size_t)be * CAP + slot] = bitsf(v); }
            SLOTOF[((size_t)b * SEQ + t) * N_EXPERTS + e] = slot;
        }
    }
}

__device__ __forceinline__ void phaseM(const Params& p, int bid, int nblk, char* smem) {
    const bf16_t* U2b = WSP(bf16_t, WS_R6); const int* IDX = WSP(int, WS_IDX);
    bf16_t* HID = WSP(bf16_t, WS_R1);
    constexpr int BM = 32 * MI_E, NTN = D_EXPERT / 64, NTM = CAP / BM;
    for (int it = xcd_vbid(bid, nblk); it < BATCH * N_EXPERTS * NTM * NTN; it += nblk) {
        const int mt = it % NTM, b = (it / NTM) % BATCH, nt = (it / (NTM * BATCH)) % NTN, e = it / (NTM * BATCH * NTN), be = b * N_EXPERTS + e;
        const bf16_t* wg = WSP(bf16_t, WS_WG + (size_t)e * WEXP_BYTES); const bf16_t* wu = WSP(bf16_t, WS_WU + (size_t)e * WEXP_BYTES);
        gemm_tile<MI_E, true>(smem, U2b, D_MODEL, IDX + (size_t)be * CAP, mt * BM, wg, wu, D_MODEL, nt * 64, D_MODEL, [&](int ml, int nl, f32x4 g, f32x4 u) {
            U2 o; o.x = pk2(siluf_(g[0]) * u[0], siluf_(g[1]) * u[1]); o.y = pk2(siluf_(g[2]) * u[2], siluf_(g[3]) * u[3]);
            *(U2*)(HID + ((size_t)be * CAP + mt * BM + ml) * D_EXPERT + nt * 64 + nl) = o;
        });
    }
    {
        constexpr int NT = BATCH * N_EXPERTS * NTM * NTN;
        const int rem = NT % nblk, vb = xcd_vbid(bid, nblk);
        if (rem == 0 || nblk - rem < 32) convert_experts(p, vb, nblk, smem, 2, 3);
        else if (vb >= rem) convert_experts(p, vb - rem, nblk - rem, smem, 2, 3);
    }
}
__device__ __forceinline__ void phaseN(const Params& p, int bid, int nblk, char* smem) {
    const bf16_t* HID = WSP(bf16_t, WS_R1); const float* GATE = WSP(float, WS_GATE);
    bf16_t* YS = WSP(bf16_t, WS_R2);
    constexpr int BM = 32 * MI_E, NTN = D_MODEL / 128, NTM = CAP / BM;
    for (int it = xcd_vbid(bid, nblk); it < BATCH * N_EXPERTS * NTM * NTN; it += nblk) {
        const int mt = it % NTM, b = (it / NTM) % BATCH, nt = (it / (NTM * BATCH)) % NTN, e = it / (NTM * BATCH * NTN), be = b * N_EXPERTS + e;
        const bf16_t* wd = WSP(bf16_t, wdown_off(e));
        gemm_tile<MI_E, false>(smem, HID + (size_t)be * CAP * D_EXPERT, D_EXPERT, nullptr, mt * BM, wd, nullptr, D_EXPERT, nt * 128, D_EXPERT, [&](int ml, int nl, f32x4 v, f32x4) {
            const int slot = mt * BM + ml;
            const float gt = GATE[(size_t)be * CAP + slot];
            *(U2*)(YS + ((size_t)be * CAP + slot) * D_MODEL + nt * 128 + nl) = pack4(v * gt);
        });
    }
}
__device__ __forceinline__ void phaseO(const Params& p, int bid, int nblk, char* smem) {
    const int tid_ = opaque_tid(), lane = tid_ & 63, wave = tid_ >> 6;
    const float* MOD = WSP(float, WS_MOD); const float* H1 = WSP(float, WS_R5); const bf16_t* YS = WSP(bf16_t, WS_R2); const int* SLOTOF = WSP(int, WS_SLOT);
    int row = bid * 4 + wave;
    f32x4 n0 = f32x4{0.f, 0.f, 0.f, 0.f}, n1 = n0, n2 = n0, n3 = n0; int nslot = -1;
    if (row < MLAT) { const float* hr = H1 + (size_t)row * D_MODEL; n0 = ld4(hr + lane * 4); if (NV > 1) n1 = ld4(hr + 256 + lane * 4); if (NV > 2) { n2 = ld4(hr + 512 + lane * 4); n3 = ld4(hr + 768 + lane * 4); }
                      nslot = (lane < N_EXPERTS) ? SLOTOF[(size_t)row * N_EXPERTS + lane] : -1; }
    for (; row < MLAT; row += nblk * 4) {
        const float* md = MOD + (size_t)(row / SEQ) * 6 * D_MODEL;
        const f32x4 h0 = n0, h1 = n1, h2 = n2, h3 = n3; const int myslot = nslot;
        const int nrow = row + nblk * 4;
        if (nrow < MLAT) { const float* hr = H1 + (size_t)nrow * D_MODEL; n0 = ld4(hr + lane * 4); if (NV > 1) n1 = ld4(hr + 256 + lane * 4); if (NV > 2) { n2 = ld4(hr + 512 + lane * 4); n3 = ld4(hr + 768 + lane * 4); }
                           nslot = (lane < N_EXPERTS) ? SLOTOF[(size_t)nrow * N_EXPERTS + lane] : -1; }
        f32x4 y0 = f32x4{0.f, 0.f, 0.f, 0.f}, y1 = y0, y2 = y0, y3 = y0;
        const int bbase = (row / SEQ) * N_EXPERTS;
        for (int e = 0; e < N_EXPERTS; ++e) {
            const int sl = __shfl(myslot, e);
            if (sl >= 0) {
                const bf16_t* yr = YS + ((size_t)(bbase + e) * CAP + sl) * D_MODEL + lane * 4;
                y0 += ldb4(yr);
                if (NV > 1) y1 += ldb4(yr + 256);
                if (NV > 2) { y2 += ldb4(yr + 512); y3 += ldb4(yr + 768); }
            }
        }
        f32x4 v0, v1, v2, v3; float s = 0.f;
        v0 = ALPHA_F * h0 + ld4(md + 5 * D_MODEL + lane * 4) * y0; s += hsum4(v0);
        if (NV > 1) { v1 = ALPHA_F * h1 + ld4(md + 5 * D_MODEL + 256 + lane * 4) * y1; s += hsum4(v1); } else v1 = f32x4{0.f, 0.f, 0.f, 0.f};
        if (NV > 2) { v2 = ALPHA_F * h2 + ld4(md + 5 * D_MODEL + 512 + lane * 4) * y2; v3 = ALPHA_F * h3 + ld4(md + 5 * D_MODEL + 768 + lane * 4) * y3; s += hsum4(v2) + hsum4(v3); } else { v2 = v1; v3 = v1; }
        const float mu = wave_sum(s) * (1.0f / D_MODEL);
        v0 -= mu; float s2 = hsum4(v0 * v0);
        if (NV > 1) { v1 -= mu; s2 += hsum4(v1 * v1); }
        if (NV > 2) { v2 -= mu; v3 -= mu; s2 += hsum4(v2 * v2) + hsum4(v3 * v3); }
        const float rstd = frsq(wave_sum(s2) * (1.0f / D_MODEL) + LN_EPS);
#pragma unroll
        for (int j = 0; j < NV; ++j) {
            const int k = j * 256 + lane * 4;
            const f32x4 vv = (j == 0) ? v0 : (j == 1) ? v1 : (j == 2) ? v2 : v3;
            *(f32x4*)(p.out + (size_t)row * D_MODEL + k) = vv * rstd * ld4(p.ln2_g + k) + ld4(p.ln2_b + k);
        }
    }
}

#define XB_TMO      128
#define XB_XCNT(j)  (256  + 64 * (j))
#define XB_XSUB(j)  (1280 + 64 * (j))
#define XB_XGEN(j)  (2304 + 64 * (j))
#define XB_TOP      3328
#define XB_TOPGEN   3392
#define XCD_BAR_WORDS 3456
#define XB_SPIN_CAP (1u << 22)
#ifndef HOST_EMU
__device__ __forceinline__ unsigned xb_ld(unsigned* p) { return __hip_atomic_load(p, __ATOMIC_RELAXED, __HIP_MEMORY_SCOPE_AGENT); }
__device__ __forceinline__ unsigned xb_add(unsigned* p, unsigned v) { return __hip_atomic_fetch_add(p, v, __ATOMIC_RELAXED, __HIP_MEMORY_SCOPE_AGENT); }
__device__ __forceinline__ unsigned xb_xcc_id() { return (unsigned)__builtin_amdgcn_s_getreg((3 << 11) | 20) & 0xFu; }
#define XB_SPIN(cond, bar) do { unsigned _sp = 0; while (cond) { __builtin_amdgcn_s_sleep(1); \
    if ((++_sp & 255u) == 0u) { if (xb_ld(&(bar)[XB_TMO])) break; if (_sp > XB_SPIN_CAP) { atomicAdd(&(bar)[XB_TMO], 1u); break; } } } } while (0)
#define XB_LAS __attribute__((address_space(3)))
struct XcdBarrier { unsigned off; unsigned x; volatile XB_LAS unsigned* st; unsigned G; };
__device__ __forceinline__ XcdBarrier xcd_barrier_post(unsigned* ctrl, unsigned off, volatile XB_LAS unsigned* st, unsigned G, bool member = true) {
    XcdBarrier b; b.off = off; b.x = xb_xcc_id(); b.st = st; b.G = G; unsigned* bar = ctrl + off;
    if (!member) return b;
    if (threadIdx.x == 0) (void)xb_add(&bar[XB_XCNT(b.x)], 1u);
    return b;
}
__device__ __forceinline__ void xcd_barrier_complete(unsigned* bar, unsigned x, unsigned& nloc, unsigned& nx, unsigned G) {
    unsigned sum, cnt, mine, sp = 0u;
    for (;;) {
        sum = 0u; cnt = 0u; mine = 0u;
#pragma unroll
        for (unsigned j = 0; j < 16; ++j) { const unsigned c = xb_ld(&bar[XB_XCNT(j)]); sum += c; cnt += (c > 0u) ? 1u : 0u; mine = (j == x) ? c : mine; }
        if (sum == G) break;
        __builtin_amdgcn_s_sleep(1);
        if ((++sp & 255u) == 0u) { if (xb_ld(&bar[XB_TMO])) break; if (sp > XB_SPIN_CAP) { atomicAdd(&bar[XB_TMO], 1u); break; } }
    }
    nloc = mine > 0u ? mine : 1u; nx = cnt > 0u ? cnt : 1u;
}
__device__ __forceinline__ void grid_barrier(const XcdBarrier& b, unsigned* ctrl) {
    asm volatile("s_waitcnt vmcnt(0)" ::: "memory");
    __syncthreads();
    if (threadIdx.x == 0) {
        unsigned* bar = ctrl + b.off;
        __builtin_amdgcn_s_waitcnt(0);
        volatile XB_LAS unsigned* st = b.st;
        unsigned nloc = st[0], nx = st[1];
        if (nloc == 0u) { xcd_barrier_complete(bar, b.x, nloc, nx, b.G); st[0] = nloc; st[1] = nx; }
        const unsigned old = xb_add(&bar[XB_XSUB(b.x)], 1u);
        const unsigned gen = old / nloc;
        if (old + 1u == (gen + 1u) * nloc) {
            __builtin_amdgcn_fence(__ATOMIC_RELEASE, "agent");
            asm volatile("s_waitcnt vmcnt(0)" ::: "memory");
            const unsigned og = xb_add(&bar[XB_TOP], 1u);
            const unsigned tg = og / nx;
            if (og + 1u == (tg + 1u) * nx) xb_add(&bar[XB_TOPGEN], 1u);
            else XB_SPIN(xb_ld(&bar[XB_TOPGEN]) == tg, bar);
            __builtin_amdgcn_fence(__ATOMIC_ACQUIRE, "agent");
            xb_add(&bar[XB_XGEN(b.x)], 1u);
            asm volatile("s_waitcnt vmcnt(0)" ::: "memory");
        } else {
            XB_SPIN(xb_ld(&bar[XB_XGEN(b.x)]) == gen, bar);
            __builtin_amdgcn_fence(__ATOMIC_ACQUIRE, "agent");
            asm volatile("s_waitcnt vmcnt(0)" ::: "memory");
        }
    }
    __syncthreads();
}
#else
struct XcdBarrier { int dummy; };
__device__ __forceinline__ void grid_barrier(const XcdBarrier&, unsigned*) { __syncthreads(); }
#endif

__global__ void __launch_bounds__(256, 2) fused_forward(Params p) {
    __shared__ __attribute__((aligned(16))) char smem[SMEM_BYTES];
    __shared__ __attribute__((aligned(16))) unsigned xb_words[4];
    if (threadIdx.x == 0) { xb_words[0] = 0u; xb_words[1] = 0u; xb_words[2] = 0u; xb_words[3] = 0u; }
    __syncthreads();
    const int bid = blockIdx.x, nblk = gridDim.x;
    const bool split = nblk >= 2 * NCHAIN;
#ifdef HOST_EMU
    const XcdBarrier gb{0}; const XcdBarrier gs{0};
#else
    const XcdBarrier gb = xcd_barrier_post(WSP(unsigned, WS_CTRL), 0u, (volatile XB_LAS unsigned*)xb_words, (unsigned)nblk);
    const XcdBarrier gs = xcd_barrier_post(WSP(unsigned, WS_CTRL), (unsigned)XCD_BAR_WORDS, (volatile XB_LAS unsigned*)xb_words + 2, (unsigned)(nblk - NCHAIN), split && bid >= NCHAIN);
#endif
    phaseA(p, bid, nblk, smem); grid_barrier(gb, WSP(unsigned, WS_CTRL));
    phaseB(p, bid, nblk, smem); grid_barrier(gb, WSP(unsigned, WS_CTRL));
    phaseC(p, bid, nblk, smem); grid_barrier(gb, WSP(unsigned, WS_CTRL));
    phaseR1(p, bid, nblk, smem); grid_barrier(gb, WSP(unsigned, WS_CTRL));
    {
        const int lb = split ? bid - NCHAIN : bid, ln = split ? nblk - NCHAIN : nblk;
        const bool lru_member = !split || bid >= NCHAIN;
        if (!split || bid < NCHAIN) phaseR2(p, bid, split ? NCHAIN : nblk, smem);
        if (lru_member) phaseD(p, lb, ln, smem);
        if (split) { if (lru_member) grid_barrier(gs, WSP(unsigned, WS_CTRL)); } else grid_barrier(gb, WSP(unsigned, WS_CTRL));
        if (lru_member) phaseE(p, lb, ln, smem);
        if (split) { if (lru_member) grid_barrier(gs, WSP(unsigned, WS_CTRL)); } else grid_barrier(gb, WSP(unsigned, WS_CTRL));
        if (lru_member) phaseF(p, lb, ln, smem);
        grid_barrier(gb, WSP(unsigned, WS_CTRL));
    }
    phaseR3(p, bid, nblk, smem); grid_barrier(gb, WSP(unsigned, WS_CTRL));
    phaseJ(p, bid, nblk, smem); grid_barrier(gb, WSP(unsigned, WS_CTRL));
    phaseK(p, bid, nblk, smem); grid_barrier(gb, WSP(unsigned, WS_CTRL));
    phaseL(p, bid, nblk, smem); grid_barrier(gb, WSP(unsigned, WS_CTRL));
    phaseM(p, bid, nblk, smem); grid_barrier(gb, WSP(unsigned, WS_CTRL));
    phaseN(p, bid, nblk, smem); grid_barrier(gb, WSP(unsigned, WS_CTRL));
    phaseO(p, bid, nblk, smem);
}

#ifdef MULTI_LAUNCH
#define PHASE_KERNEL(NAME) \
    __global__ void __launch_bounds__(256) k_##NAME(Params p) { __shared__ __attribute__((aligned(16))) char smem[SMEM_BYTES]; NAME(p, blockIdx.x, gridDim.x, smem); }
PHASE_KERNEL(phaseA) PHASE_KERNEL(phaseB) PHASE_KERNEL(phaseC) PHASE_KERNEL(phaseD) PHASE_KERNEL(phaseE) PHASE_KERNEL(phaseF) PHASE_KERNEL(phaseR1) PHASE_KERNEL(phaseR2) PHASE_KERNEL(phaseR3)
PHASE_KERNEL(phaseJ) PHASE_KERNEL(phaseK) PHASE_KERNEL(phaseL) PHASE_KERNEL(phaseM) PHASE_KERNEL(phaseN) PHASE_KERNEL(phaseO)
#ifdef HOST_EMU
void emu_hook(const char* name, const Params& p);
#define LAUNCH(NAME, grid) do { EMU_LAUNCH(k_##NAME, grid, 256, p); emu_hook(#NAME, p); } while (0)
#else
#define LAUNCH(NAME, grid) hipLaunchKernelGGL(k_##NAME, dim3(grid), dim3(256), 0, stream, p)
#endif
#endif

extern "C" void kernel_launch(void* const* d_in, const int* in_sizes, int n_in, void* d_out, int out_size, void* d_ws, size_t ws_size, hipStream_t stream) {
    if (n_in != 38 || out_size != MLAT * D_MODEL || ws_size < WS_END) { fprintf(stderr, "kernel_launch: unexpected shapes (n_in %d out %d ws %zu need %zu)\n", n_in, out_size, ws_size, (size_t)WS_END); return; }
    Params p{};
    const float** f = (const float**)&p;
    for (int i = 0; i < 38; ++i) f[i] = (const float*)d_in[i];
    p.out = (float*)d_out; p.ws = (unsigned char*)d_ws;
#ifdef MULTI_LAUNCH
    const int G = 512;
    LAUNCH(phaseA, 6 * D_MODEL / 16);
    LAUNCH(phaseB, G);
    LAUNCH(phaseC, G);
    LAUNCH(phaseD, G);
    LAUNCH(phaseE, 16);
    LAUNCH(phaseF, G);
    LAUNCH(phaseR1, G);
    LAUNCH(phaseR2, NCHAIN);
    LAUNCH(phaseR3, G);
    LAUNCH(phaseJ, G);
    LAUNCH(phaseK, G);
    LAUNCH(phaseL, BATCH * N_EXPERTS);
    LAUNCH(phaseM, G);
    LAUNCH(phaseN, G);
    LAUNCH(phaseO, G);
#elif defined(HOST_EMU)
    EMU_LAUNCH(fused_forward, 1, 256, p);
#else
    static int grid_blocks = 0;
    if (!grid_blocks) {
        int dev = 0, cus = 0, per_cu = 0;
        (void)hipGetDevice(&dev);
        (void)hipDeviceGetAttribute(&cus, hipDeviceAttributeMultiprocessorCount, dev);
        (void)hipOccupancyMaxActiveBlocksPerMultiprocessor(&per_cu, fused_forward, 256, 0);
        if (per_cu > 2) per_cu = 2;
        if (per_cu < 1) { fprintf(stderr, "kernel_launch: occupancy query returned %d blocks per CU\n", per_cu); per_cu = 1; }
        grid_blocks = cus * per_cu;
    }
    (void)hipMemsetAsync((char*)d_ws + WS_CTRL, 0, 2 * XCD_BAR_WORDS * 4, stream);
    void* args[] = {&p};
    hipError_t e = hipLaunchCooperativeKernel((void*)fused_forward, dim3(grid_blocks), dim3(256), args, 0, stream);
    if (e != hipSuccess) fprintf(stderr, "cooperative launch failed: %s (grid %d)\n", hipGetErrorString(e), grid_blocks);
#endif
}
```

```cpp
#ifndef HOST_EMU
#include <hip/hip_runtime.h>
#include <cstdio>
#endif
#include <cstdint>
#include <cstddef>

#ifdef CFG_SMALL
constexpr int D_MODEL = 256, BATCH = 2, SEQ = 256, GRID_W = 16, CTX_LEN = 64, LRU_BLOCKS = 2, N_EXPERTS = 4, D_EXPERT = 256;
#else
constexpr int D_MODEL = 1024, BATCH = 4, SEQ = 4096, GRID_W = 64, CTX_LEN = 256, LRU_BLOCKS = 8, N_EXPERTS = 16, D_EXPERT = 1408;
#endif
constexpr int ROWS = SEQ / GRID_W;
constexpr int D_LRU = D_MODEL / 2, LRU_BLOCK = 64;
constexpr int D_RWKV = D_MODEL / 2, HEADS = D_RWKV / 64;
constexpr int D_RWKV_IN = 3 * D_RWKV + 128 + 128 + 128;
constexpr int D_IN = 2 * D_LRU + D_RWKV_IN;
constexpr int D_MIX = D_LRU + D_RWKV;
constexpr int CAP = 2 * SEQ / N_EXPERTS;
constexpr int MLAT = BATCH * SEQ, MCTX = BATCH * CTX_LEN, MTOT = MLAT + MCTX;
constexpr int NMOD = BATCH + 1;
constexpr int RW0 = 2 * D_LRU;
constexpr float ALPHA_F = 1.189207115002721f;
constexpr float LN_EPS = 1e-5f, GN_EPS = 64e-5f, RMS_EPS = 1e-6f;
static_assert(LRU_BLOCKS * LRU_BLOCK == D_LRU, "lru blocks");
static_assert(CAP % 128 == 0 && D_IN % 128 == 0 && D_EXPERT % 64 == 0 && D_MODEL % 128 == 0 && MTOT % 128 == 0 && D_MIX % 64 == 0, "tile divisibility");

typedef unsigned short bf16_t;
typedef short bf16x8 __attribute__((ext_vector_type(8)));
typedef float f32x4 __attribute__((ext_vector_type(4)));
typedef unsigned u32x4 __attribute__((ext_vector_type(4)));
typedef float f32x2_e __attribute__((ext_vector_type(2)));
typedef unsigned U2 __attribute__((ext_vector_type(2)));

#ifdef HOST_EMU
#define MFMA16(a, b, c) emu_mfma_16x16x32_bf16(a, b, c)
#define MFMAF32(a, b, c) emu_mfma_16x16x4_f32(a, b, c)
#else
#define MFMA16(a, b, c) __builtin_amdgcn_mfma_f32_16x16x32_bf16(a, b, c, 0, 0, 0)
#define MFMAF32(a, b, c) __builtin_amdgcn_mfma_f32_16x16x4f32(a, b, c, 0, 0, 0)
#endif

__device__ __forceinline__ unsigned fbits(float f) { return __builtin_bit_cast(unsigned, f); }
__device__ __forceinline__ float bitsf(unsigned u) { return __builtin_bit_cast(float, u); }
__device__ __forceinline__ bf16_t f2bf(float f) { unsigned u = fbits(f); u += 0x7FFFu + ((u >> 16) & 1u); return (bf16_t)(u >> 16); }
__device__ __forceinline__ float bf2f(bf16_t h) { return bitsf(((unsigned)h) << 16); }
#ifdef HOST_EMU
__device__ __forceinline__ unsigned pk2(float lo, float hi) { return (unsigned)f2bf(lo) | ((unsigned)f2bf(hi) << 16); }
#else
typedef float f32x2_t __attribute__((ext_vector_type(2)));
typedef __bf16 bf16x2_t __attribute__((ext_vector_type(2)));
__device__ __forceinline__ unsigned pk2(float lo, float hi) { return __builtin_bit_cast(unsigned, __builtin_convertvector(f32x2_t{lo, hi}, bf16x2_t)); }
#endif
__device__ __forceinline__ float softplusf_(float x) { return fmaxf(x, 0.0f) + log1pf(expf(-fabsf(x))); }
#ifdef HOST_EMU
#define FEXP(x) expf(x)
#else
#define FEXP(x) __expf(x)
#endif
#ifdef HOST_EMU
__device__ __forceinline__ float frcp(float x) { return 1.0f / x; }
__device__ __forceinline__ float frsq(float x) { return 1.0f / sqrtf(x); }
__device__ __forceinline__ float fsqrt(float x) { return sqrtf(x); }
#else
__device__ __forceinline__ float frcp(float x) { return __builtin_amdgcn_rcpf(x); }
__device__ __forceinline__ float frsq(float x) { return __builtin_amdgcn_rsqf(x); }
__device__ __forceinline__ float fsqrt(float x) { return __builtin_amdgcn_sqrtf(x); }
#endif
__device__ __forceinline__ float fsigm(float x) { return frcp(1.0f + FEXP(-x)); }
__device__ __forceinline__ float siluf_(float x) { return x * fsigm(x); }
__device__ __forceinline__ float geluf_(float x) { return x * fsigm(1.5957691216057308f * (x + 0.044715f * x * x * x)); }
__device__ __forceinline__ int opaque_tid() {
    int t = threadIdx.x;
#ifndef HOST_EMU
    asm volatile("" : "+v"(t));
#endif
    return t;
}
__device__ __forceinline__ float wave_sum(float v) {
#pragma unroll
    for (int o = 1; o < 64; o <<= 1) v += __shfl_xor(v, o);
    return v;
}

constexpr size_t al256(size_t x) { return (x + 255) & ~(size_t)255; }
constexpr int NLCH = BATCH * (SEQ / 64), NCCH = BATCH * (CTX_LEN / 64), NCH = NLCH + NCCH;
constexpr size_t WS_CTRL = 0;
constexpr size_t WS_MOD = 65536;
constexpr size_t WS_STATS = al256(WS_MOD + (size_t)NMOD * 6 * D_MODEL * 4);
constexpr size_t WS_SUMA = al256(WS_STATS + (size_t)MTOT * 2 * 4);
constexpr size_t WS_SUMH = al256(WS_SUMA + (size_t)2 * NCH * D_LRU * 4);
constexpr size_t WS_CARRY = al256(WS_SUMH + (size_t)2 * NCH * D_LRU * 4);
constexpr size_t WS_SSQP = al256(WS_CARRY + (size_t)2 * NLCH * D_LRU * 4);
constexpr size_t WS_RINV = al256(WS_SSQP + (size_t)MLAT * LRU_BLOCKS * 4);
constexpr size_t WS_BON = al256(WS_RINV + (size_t)MLAT * 4);
constexpr size_t WS_AFF = al256(WS_BON + (size_t)2 * MLAT * HEADS * 4 + 4096 * 64);
constexpr size_t WS_IDX = al256(WS_AFF + (size_t)MLAT * N_EXPERTS * 4);
constexpr size_t WS_GATE = al256(WS_IDX + (size_t)BATCH * N_EXPERTS * CAP * 4);
constexpr size_t WS_SLOT = al256(WS_GATE + (size_t)BATCH * N_EXPERTS * CAP * 4);
constexpr size_t WS_WBIN = al256(WS_SLOT + (size_t)MLAT * N_EXPERTS * 4);
constexpr size_t WS_WBOUT = al256(WS_WBIN + (size_t)D_IN * D_MODEL * 2);
constexpr size_t WS_LORA = al256(WS_WBOUT + (size_t)D_MODEL * D_MIX * 2);
constexpr size_t WS_R1 = al256(WS_LORA + (size_t)2 * 2 * HEADS * 64 * 64 * 2);
constexpr size_t R1_BYTES = (size_t)MTOT * D_IN * 2 > (size_t)MLAT * D_MODEL * 4 ? ((size_t)MTOT * D_IN * 2 > (size_t)BATCH * N_EXPERTS * CAP * D_EXPERT * 2 ? (size_t)MTOT * D_IN * 2 : (size_t)BATCH * N_EXPERTS * CAP * D_EXPERT * 2)
                                                                                  : ((size_t)MLAT * D_MODEL * 4 > (size_t)BATCH * N_EXPERTS * CAP * D_EXPERT * 2 ? (size_t)MLAT * D_MODEL * 4 : (size_t)BATCH * N_EXPERTS * CAP * D_EXPERT * 2);
constexpr size_t WS_R3 = al256(WS_R1 + R1_BYTES);
constexpr int RC = 32;
constexpr int NCC = CTX_LEN / RC, NLC = SEQ / RC, NCK = NCC + NLC, NCHAIN = BATCH * HEADS * 2;
constexpr size_t CH_PM = 0, CH_SA = 8192, CH_QT = 16384, CH_Y0 = 20480, CH_BYTES = 24576;
constexpr size_t WS_CH = al256(WS_R3 + (size_t)MTOT * D_MODEL * 2);
constexpr size_t CH_TOTAL = (size_t)NCHAIN * NCK * CH_BYTES;
constexpr size_t WS_R5 = WS_CH;
constexpr size_t WS_LA = al256(WS_R5 + (size_t)MLAT * D_MODEL * 4);
constexpr size_t WS_R6 = WS_LA, WS_R2 = WS_LA;
constexpr size_t WEXP_BYTES = (size_t)D_MODEL * D_EXPERT * 2;
constexpr size_t WS_WG = al256(WS_LA + (size_t)MLAT * D_MODEL * 2);
constexpr size_t WS_WU = WS_WG + (size_t)N_EXPERTS * WEXP_BYTES;
constexpr int NE_R3 = ((size_t)MTOT * D_MODEL * 2 / WEXP_BYTES) < (size_t)N_EXPERTS ? (int)((size_t)MTOT * D_MODEL * 2 / WEXP_BYTES) : N_EXPERTS;
constexpr size_t WS_WD2 = WS_WU + (size_t)N_EXPERTS * WEXP_BYTES;
constexpr size_t WS_LATE_END = al256(WS_WD2 + (size_t)(N_EXPERTS - NE_R3) * WEXP_BYTES);
static_assert(WS_LA + (size_t)BATCH * N_EXPERTS * CAP * D_MODEL * 2 <= WS_WD2, "YS must not reach the w_down copies");
constexpr size_t WS_END = (WS_CH + CH_TOTAL > WS_LATE_END) ? al256(WS_CH + CH_TOTAL) : WS_LATE_END;
constexpr size_t WS_RBON = WS_BON;
static_assert((size_t)NCHAIN * NCK * RC * 4 <= (size_t)2 * MLAT * HEADS * 4 + 4096 * 64, "bonus buffer");

struct Params {
    const float *x, *c, *ctx, *c_ctx, *ln_in_g, *ln_in_b, *w_mod, *b_mod, *w_in, *lru_conv_w, *lru_conv_b, *lru_wa, *lru_ba, *lru_wx, *lru_bx, *lru_lam, *lru_norm_g,
        *mu_prev, *mu_next, *w0, *w2, *a0, *a2, *g2, *k_k, *k_a, *r_k, *gn_g, *gn_b, *w_out, *ln1_g, *ln1_b, *w_router, *w_gate, *w_up, *w_down, *ln2_g, *ln2_b;
    float* out;
    unsigned char* ws;
};
#define WSP(T, off) ((T*)(p.ws + (off)))
__device__ __forceinline__ size_t wdown_off(int e) { return e < NE_R3 ? WS_R3 + (size_t)e * WEXP_BYTES : WS_WD2 + (size_t)(e - NE_R3) * WEXP_BYTES; }

constexpr int SMEM_BYTES = 76 * 1024;

__device__ __forceinline__ f32x4 ld4(const float* p) { return *(const f32x4*)p; }
__device__ __forceinline__ f32x4 ldb4(const bf16_t* p) { const U2 u = *(const U2*)p; return f32x4{bitsf(u.x << 16), bitsf(u.x & 0xFFFF0000u), bitsf(u.y << 16), bitsf(u.y & 0xFFFF0000u)}; }
__device__ __forceinline__ float hsum4(f32x4 v) { return (v[0] + v[1]) + (v[2] + v[3]); }
__device__ __forceinline__ U2 pack4(f32x4 v) { U2 o; o.x = pk2(v[0], v[1]); o.y = pk2(v[2], v[3]); return o; }
__device__ __forceinline__ void convert_transpose(const float* src, bf16_t* dst, int K, int N, int t0, int t1, int tstride, char* smem) {
    float* T = (float*)smem;
    const int tid = opaque_tid(), r = tid >> 4, c4 = (tid & 15) * 4, ntn = N / 64;
    f32x4 v[4];
    if (t0 < t1) { const int kt = t0 / ntn, nt = t0 % ntn;
#pragma unroll
        for (int j = 0; j < 4; ++j) v[j] = ld4(src + (size_t)(kt * 64 + r + 16 * j) * N + nt * 64 + c4); }
    for (int t = t0; t < t1; t += tstride) {
        const int kt = t / ntn, nt = t % ntn;
        __syncthreads();
#pragma unroll
        for (int j = 0; j < 4; ++j) { float* d = T + (r + 16 * j) * 65 + c4; d[0] = v[j][0]; d[1] = v[j][1]; d[2] = v[j][2]; d[3] = v[j][3]; }
        __syncthreads();
        if (t + tstride < t1) { const int kt2 = (t + tstride) / ntn, nt2 = (t + tstride) % ntn;
#pragma unroll
            for (int j = 0; j < 4; ++j) v[j] = ld4(src + (size_t)(kt2 * 64 + r + 16 * j) * N + nt2 * 64 + c4); }
        const int n = tid >> 2, kc = (tid & 3) * 16;
        u32x4 o0, o1;
#pragma unroll
        for (int i = 0; i < 4; ++i) { o0[i] = pk2(T[(kc + 2 * i) * 65 + n], T[(kc + 2 * i + 1) * 65 + n]); o1[i] = pk2(T[(kc + 8 + 2 * i) * 65 + n], T[(kc + 9 + 2 * i) * 65 + n]); }
        bf16_t* d = dst + (size_t)(nt * 64 + n) * K + kt * 64 + kc;
        *(u32x4*)d = o0; *(u32x4*)(d + 8) = o1;
    }
    __syncthreads();
}
__device__ void convert_experts(const Params& p, int vb, int nvb, char* smem, int first, int last) {
    constexpr int TPM = (D_MODEL / 64) * (D_EXPERT / 64);
    int m = 0;
    for (int e = 0; e < N_EXPERTS; ++e)
        for (int which = first; which < last; ++which, ++m) {
            const float* src = (which == 0 ? p.w_gate : which == 1 ? p.w_up : p.w_down) + (size_t)e * D_MODEL * D_EXPERT;
            bf16_t* dst = which == 0 ? WSP(bf16_t, WS_WG + (size_t)e * WEXP_BYTES) : which == 1 ? WSP(bf16_t, WS_WU + (size_t)e * WEXP_BYTES) : WSP(bf16_t, wdown_off(e));
            const int K = which == 2 ? D_EXPERT : D_MODEL, N = which == 2 ? D_MODEL : D_EXPERT;
            const int start = ((vb - (m * TPM) % nvb) % nvb + nvb) % nvb;
            convert_transpose(src, dst, K, N, start, TPM, nvb, smem);
        }
}

__device__ __forceinline__ void phaseA(const Params& p, int bid, int nblk, char* smem) {
    float* sc = (float*)smem;
    float* red = sc + NMOD * D_MODEL;
    const int tid = opaque_tid();
    constexpr int NA = 6 * D_MODEL / 16;
    {
        const bool spare = nblk > NA + 32;
        const int vb = spare ? bid - NA : bid, nvb = spare ? nblk - NA : nblk;
        if (!spare || bid >= NA) {
            constexpr int T1 = (D_MODEL / 64) * (D_IN / 64), T2 = (D_MIX / 64) * (D_MODEL / 64);
            convert_transpose(p.w_in, WSP(bf16_t, WS_WBIN), D_MODEL, D_IN, vb, T1, nvb, smem);
            convert_transpose(p.w_out, WSP(bf16_t, WS_WBOUT), D_MIX, D_MODEL, ((vb - T1 % nvb) % nvb + nvb) % nvb, T2, nvb, smem);
            for (int idx = vb * 256 + tid; idx < 2 * 2 * HEADS * 64 * 64; idx += nvb * 256) {
                const int i = idx & 63, j = (idx >> 6) & 63, hh = (idx >> 12) % HEADS, which = (idx >> 12) / HEADS % 2, dd = (idx >> 12) / HEADS / 2;
                WSP(bf16_t, WS_LORA)[idx] = f2bf((which ? p.a2 : p.w2)[((size_t)dd * 64 + i) * D_RWKV + hh * 64 + j]);
            }
        }
        if (spare && bid >= NA) return;
    }
    if (bid >= NA) return;
    __syncthreads();
    for (int i = tid; i < NMOD * D_MODEL; i += 256) {
        const int r = i / D_MODEL, k = i % D_MODEL;
        const float v = (r < BATCH) ? p.c[r * D_MODEL + k] : p.c_ctx[k];
        sc[i] = siluf_(v);
    }
    __syncthreads();
    float* MOD = WSP(float, WS_MOD);
    const int col = tid & 15, kg = tid >> 4;
    constexpr int KPT = D_MODEL / 16;
    for (int cb = bid; cb < 6 * D_MODEL / 16; cb += nblk) {
        const int n = cb * 16 + col;
        float acc[NMOD];
#pragma unroll
        for (int r = 0; r < NMOD; ++r) acc[r] = 0.f;
        const float* wp = p.w_mod + (size_t)(kg * KPT) * (6 * D_MODEL) + n;
#pragma unroll 16
        for (int kk = 0; kk < KPT; ++kk) {
            const float w = wp[(size_t)kk * (6 * D_MODEL)];
#pragma unroll
            for (int r = 0; r < NMOD; ++r) acc[r] += sc[r * D_MODEL + kg * KPT + kk] * w;
        }
#pragma unroll
        for (int r = 0; r < NMOD; ++r) red[(kg * NMOD + r) * 16 + col] = acc[r];
        __syncthreads();
        if (tid < NMOD * 16) {
            const int r = tid >> 4, c2 = tid & 15;
            float s2 = p.b_mod[cb * 16 + c2];
#pragma unroll
            for (int g = 0; g < 16; ++g) s2 += red[(g * NMOD + r) * 16 + c2];
            MOD[(size_t)r * 6 * D_MODEL + cb * 16 + c2] = s2;
        }
        __syncthreads();
    }
}

constexpr int NV = D_MODEL / 256;
__device__ __forceinline__ void phaseB(const Params& p, int bid, int nblk, char* smem) {
    const int tid_ = opaque_tid(), lane = tid_ & 63, wave = tid_ >> 6;
    const float* MOD = WSP(float, WS_MOD);
    float* STATS = WSP(float, WS_STATS);
    bf16_t* U = WSP(bf16_t, WS_R3);
    auto rowptr = [&](int row) { return (row < MLAT) ? p.x + (size_t)row * D_MODEL : p.ctx + (size_t)(row - MLAT) * D_MODEL; };
    int row = bid * 4 + wave;
    f32x4 n0 = f32x4{0.f, 0.f, 0.f, 0.f}, n1 = n0, n2 = n0, n3 = n0;
    if (row < MTOT) { const float* xr = rowptr(row); n0 = ld4(xr + lane * 4); if (NV > 1) n1 = ld4(xr + 256 + lane * 4); if (NV > 2) { n2 = ld4(xr + 512 + lane * 4); n3 = ld4(xr + 768 + lane * 4); } }
    for (; row < MTOT; row += nblk * 4) {
        const int mr = (row < MLAT) ? row / SEQ : BATCH;
        const float* md = MOD + (size_t)mr * 6 * D_MODEL;
        f32x4 v0 = n0, v1 = n1, v2 = n2, v3 = n3;
        const int nrow = row + nblk * 4;
        if (nrow < MTOT) { const float* xr = rowptr(nrow); n0 = ld4(xr + lane * 4); if (NV > 1) n1 = ld4(xr + 256 + lane * 4); if (NV > 2) { n2 = ld4(xr + 512 + lane * 4); n3 = ld4(xr + 768 + lane * 4); } }
        float s = hsum4(v0);
        if (NV > 1) s += hsum4(v1);
        if (NV > 2) s += hsum4(v2) + hsum4(v3);
        const float mu = wave_sum(s) * (1.0f / D_MODEL);
        v0 -= mu; float s2 = hsum4(v0 * v0);
        if (NV > 1) { v1 -= mu; s2 += hsum4(v1 * v1); }
        if (NV > 2) { v2 -= mu; v3 -= mu; s2 += hsum4(v2 * v2) + hsum4(v3 * v3); }
        const float rstd = frsq(wave_sum(s2) * (1.0f / D_MODEL) + LN_EPS);
        if (lane == 0) { STATS[row * 2] = mu; STATS[row * 2 + 1] = rstd; }
#pragma unroll
        for (int j = 0; j < NV; ++j) {
            const int k = j * 256 + lane * 4;
            const f32x4 vv = (j == 0) ? v0 : (j == 1) ? v1 : (j == 2) ? v2 : v3;
            const f32x4 h = vv * rstd * ld4(p.ln_in_g + k) + ld4(p.ln_in_b + k);
            *(U2*)(U + (size_t)row * D_MODEL + k) = pack4(h * (1.0f + ld4(md + D_MODEL + k)) + ld4(md + k));
        }
    }
}

constexpr int LDK = 64;
template <int MI, bool DUAL, class Epi>
__device__ __forceinline__ void gemm_tile(char* smem, const bf16_t* A, int lda, const int* rowidx, int m0, const bf16_t* Bt0, const bf16_t* Bt1, int ldb, int n0, int K, Epi epi, const float* rowscale = nullptr, int kscale = 0) {
    constexpr int BM = 32 * MI;
    bf16_t* As = (bf16_t*)smem;
    bf16_t* Bs = As + BM * LDK;
    int tid = threadIdx.x;
#ifndef HOST_EMU
    asm volatile("" : "+v"(tid));
#endif
    const int lane = tid & 63, wave = tid >> 6, wr = wave >> 1, wc = wave & 1, l15 = lane & 15, q = lane >> 4;
    const int ch = tid & 7, r0 = tid >> 3;
    unsigned aoff[MI], boff[4];
#pragma unroll
    for (int j = 0; j < MI; ++j) { const int r = m0 + r0 + 32 * j; aoff[j] = (unsigned)(rowidx ? rowidx[r] : r) * (unsigned)lda + ch * 8; }
#pragma unroll
    for (int j = 0; j < 4; ++j) boff[j] = (unsigned)(n0 + (DUAL ? (j >> 1) * 32 + r0 : r0 + 32 * j)) * (unsigned)ldb + ch * 8;
    const int wofs = r0 * LDK + ((ch ^ (r0 & 7)) * 8);
    u32x4 ar[MI], br[4];
    f32x4 acc[MI][4];
#pragma unroll
    for (int i = 0; i < MI; ++i)
#pragma unroll
        for (int j = 0; j < 4; ++j) acc[i][j] = f32x4{0.f, 0.f, 0.f, 0.f};
    const int nk = K / 64;
#pragma unroll
    for (int j = 0; j < MI; ++j) ar[j] = *(const u32x4*)(A + aoff[j]);
#pragma unroll
    for (int j = 0; j < 4; ++j) br[j] = *(const u32x4*)(((DUAL && (j & 1)) ? Bt1 : Bt0) + boff[j]);
    for (int kt = 0; kt < nk; ++kt) {
        __syncthreads();
#pragma unroll
        for (int j = 0; j < MI; ++j) *(u32x4*)(As + wofs + 32 * j * LDK) = ar[j];
#pragma unroll
        for (int j = 0; j < 4; ++j) *(u32x4*)(Bs + wofs + 32 * j * LDK) = br[j];
        __syncthreads();
        if (kt + 1 < nk) {
            const int ko = (kt + 1) * 64;
#pragma unroll
            for (int j = 0; j < MI; ++j) ar[j] = *(const u32x4*)(A + aoff[j] + ko);
#pragma unroll
            for (int j = 0; j < 4; ++j) br[j] = *(const u32x4*)(((DUAL && (j & 1)) ? Bt1 : Bt0) + boff[j] + ko);
        }
#pragma unroll
        for (int ks = 0; ks < 2; ++ks) {
            const int cofs = ((ks * 4 + q) ^ (l15 & 7)) * 8;
            bf16x8 bfr[4];
#pragma unroll
            for (int ni = 0; ni < 4; ++ni) bfr[ni] = *(const bf16x8*)(Bs + (wc * 64 + ni * 16 + l15) * LDK + cofs);
#pragma unroll
            for (int mi = 0; mi < MI; ++mi) {
                const bf16x8 af = *(const bf16x8*)(As + (wr * (16 * MI) + mi * 16 + l15) * LDK + cofs);
#pragma unroll
                for (int ni = 0; ni < 4; ++ni) acc[mi][ni] = MFMA16(bfr[ni], af, acc[mi][ni]);
            }
        }
        if (rowscale && kt + 1 == kscale) {
#pragma unroll
            for (int mi = 0; mi < MI; ++mi) {
                const float rs = rowscale[m0 + wr * (16 * MI) + mi * 16 + l15];
#pragma unroll
                for (int ni = 0; ni < 4; ++ni) acc[mi][ni] *= rs;
            }
        }
    }
#pragma unroll
    for (int mi = 0; mi < MI; ++mi) {
        const int ml = wr * (16 * MI) + mi * 16 + l15;
        if (DUAL) {
#pragma unroll
            for (int ni = 0; ni < 2; ++ni) epi(ml, wc * 32 + ni * 16 + q * 4, acc[mi][ni], acc[mi][ni + 2]);
        } else {
#pragma unroll
            for (int ni = 0; ni < 4; ++ni) epi(ml, wc * 64 + ni * 16 + q * 4, acc[mi][ni], acc[mi][ni]);
        }
    }
    __syncthreads();
}

__device__ __forceinline__ int xcd_vbid(int bid, int nblk) { return (nblk % 8 == 0) ? (bid % 8) * (nblk / 8) + bid / 8 : bid; }
constexpr int MI_C = (MTOT % 256 == 0) ? 8 : 4, MI_J = (MLAT % 256 == 0) ? 8 : 4, MI_E = (CAP % 256 == 0) ? 8 : 4;
__device__ __forceinline__ void phaseC(const Params& p, int bid, int nblk, char* smem) {
    const bf16_t* U = WSP(bf16_t, WS_R3); const bf16_t* WB = WSP(bf16_t, WS_WBIN);
    bf16_t* P = WSP(bf16_t, WS_R1);
    constexpr int BM = 32 * MI_C, NTN = D_IN / 128, NTM = MTOT / BM;
    constexpr int GM = (NTM % 8 == 0) ? 8 : (NTM % 4 == 0) ? 4 : 1;
    for (int it = xcd_vbid(bid, nblk); it < NTN * NTM; it += nblk) {
        const int mg = it / (GM * NTN), r = it % (GM * NTN), nt = r / GM, mt = mg * GM + (r % GM);
        gemm_tile<MI_C, false>(smem, U, D_MODEL, nullptr, mt * BM, WB, nullptr, D_MODEL, nt * 128, D_MODEL, [&](int ml, int nl, f32x4 v, f32x4) {
            *(U2*)(P + (size_t)(mt * BM + ml) * D_IN + nt * 128 + nl) = pack4(v);
        });
    }
}


template <int NYT, int KS>
__device__ __forceinline__ void mmT(f32x4* acc, const bf16_t* X, int ldx, int xs, const bf16_t* Y, int ldy, int lane) {
#pragma unroll
    for (int ks = 0; ks < KS; ++ks) {
        const bf16x8 xf = *(const bf16x8*)(X + (xs * 16 + (lane & 15)) * ldx + ks * 32 + 8 * (lane >> 4));
#pragma unroll
        for (int nb = 0; nb < NYT; ++nb) {
            const bf16x8 yf = *(const bf16x8*)(Y + (nb * 16 + (lane & 15)) * ldy + ks * 32 + 8 * (lane >> 4));
            acc[nb] = MFMA16(xf, yf, acc[nb]);
        }
    }
}

struct SeqChunk { int base_row; int t0; int len; };
__device__ __forceinline__ SeqChunk lru_chunk(int cg) {
    SeqChunk s;
    if (cg < NLCH) { const int b = cg / (SEQ / 64), ck = cg % (SEQ / 64); s.base_row = b * SEQ; s.t0 = ck * 64; s.len = SEQ; }
    else { const int c2 = cg - NLCH; const int b = c2 / (CTX_LEN / 64), ck = c2 % (CTX_LEN / 64); s.base_row = MLAT + b * CTX_LEN; s.t0 = ck * 64; s.len = CTX_LEN; }
    return s;
}
constexpr int L_XIN = 0;
constexpr int L_GT = 8704;
constexpr int L_XB = L_GT + 9216;
constexpr int L_WT = L_XB + 9216;
constexpr int L_CP = L_WT + 36864;
constexpr int L_END = L_CP + 4096;
static_assert(L_END <= SMEM_BYTES, "lru lds");
__device__ __forceinline__ void lru_load_w(const Params& p, char* smem, int cb) {
    bf16_t* WT = (bf16_t*)(smem + L_WT);
    const int tid = opaque_tid();
    for (int idx = tid; idx < 4 * 64 * 16; idx += 256) {
        const int m = idx >> 10, i = (idx >> 4) & 63, j4 = (idx & 15) * 4, d = m >> 1;
        const f32x4 w = ld4(((m & 1) ? p.lru_wx : p.lru_wa) + ((size_t)(d * LRU_BLOCKS + cb) * 64 + i) * 64 + j4);
        bf16_t* dst = WT + (m * 64 + j4) * 72 + i;
        dst[0] = f2bf(w[0]); dst[72] = f2bf(w[1]); dst[144] = f2bf(w[2]); dst[216] = f2bf(w[3]);
    }
}
struct LruConst { float ba[2][4], bx[2][4], sp8[2][4], gn[4], cw[4], cb0; };
__device__ __forceinline__ void lru_consts(const Params& p, int cb, LruConst& K) {
    const int l15 = threadIdx.x & 15, c = threadIdx.x & 63, ch = cb * 64 + c;
#pragma unroll
    for (int d = 0; d < 2; ++d)
#pragma unroll
        for (int nb = 0; nb < 4; ++nb) { const int cc = d * D_LRU + cb * 64 + nb * 16 + l15; K.ba[d][nb] = p.lru_ba[cc]; K.bx[d][nb] = p.lru_bx[cc]; K.sp8[d][nb] = -8.0f * softplusf_(-p.lru_lam[cc]); }
#pragma unroll
    for (int nb = 0; nb < 4; ++nb) K.gn[nb] = p.lru_norm_g[cb * 64 + nb * 16 + l15];
#pragma unroll
    for (int j = 0; j < 4; ++j) K.cw[j] = p.lru_conv_w[j * D_LRU + ch];
    K.cb0 = p.lru_conv_b[ch];
}
struct LruStage { u32x4 x[3]; u32x4 g[2]; };
template <bool FINAL>
__device__ __forceinline__ void lru_stage_load(const Params& p, int cg, int cb, LruStage& S) {
    const bf16_t* P = WSP(bf16_t, WS_R1);
    const SeqChunk sc = lru_chunk(cg);
    const int tid = opaque_tid();
#pragma unroll
    for (int k = 0; k < 3; ++k) {
        const int idx = tid + 256 * k, tt = idx >> 3, c8 = (idx & 7) * 8, t = sc.t0 - 1 + tt;
        S.x[k] = u32x4{0u, 0u, 0u, 0u};
        if (idx < 67 * 8 && t >= 0 && t < sc.len) S.x[k] = *(const u32x4*)(P + (size_t)(sc.base_row + t) * D_IN + cb * 64 + c8);
    }
    if (FINAL) {
#pragma unroll
        for (int k = 0; k < 2; ++k) { const int idx = tid + 256 * k, tt = idx >> 3, c8 = (idx & 7) * 8; S.g[k] = *(const u32x4*)(P + (size_t)(sc.base_row + sc.t0 + tt) * D_IN + D_LRU + cb * 64 + c8); }
    }
}
template <bool FINAL>
__device__ __forceinline__ void lru_item(const Params& p, char* smem, int cg, int cb, const LruConst& K, LruStage& S, int cg_next) {
    const bf16_t* P = WSP(bf16_t, WS_R1);
    bf16_t* XIN = (bf16_t*)(smem + L_XIN); bf16_t* GT = (bf16_t*)(smem + L_GT); bf16_t* XB = (bf16_t*)(smem + L_XB); const bf16_t* WT = (const bf16_t*)(smem + L_WT);
    float* CP = (float*)(smem + L_CP);
    const int tid = opaque_tid(), lane = tid & 63, wave = tid >> 6, q = lane >> 4, l15 = lane & 15;
    const SeqChunk sc = lru_chunk(cg);
    float cin[2][4];
    if (FINAL) {
#pragma unroll
        for (int d = 0; d < 2; ++d)
#pragma unroll
            for (int nb = 0; nb < 4; ++nb) cin[d][nb] = WSP(float, WS_CARRY)[((size_t)d * NLCH + cg) * D_LRU + cb * 64 + nb * 16 + l15];
    }
    __syncthreads();
#pragma unroll
    for (int k = 0; k < 3; ++k) { const int idx = tid + 256 * k, tt = idx >> 3, c8 = (idx & 7) * 8; if (idx < 67 * 8) *(u32x4*)(XIN + tt * 64 + c8) = S.x[k]; }
    if (FINAL) {
#pragma unroll
        for (int k = 0; k < 2; ++k) { const int idx = tid + 256 * k, tt = idx >> 3, c8 = (idx & 7) * 8; *(u32x4*)(GT + tt * 72 + c8) = S.g[k]; }
    }
    if (cg_next >= 0) lru_stage_load<FINAL>(p, cg_next, cb, S);
    __syncthreads();
    {
        const int c = tid & 63;
#pragma unroll 4
        for (int tt = tid >> 6; tt < 64; tt += 4)
            XB[tt * 72 + c] = f2bf(K.cb0 + bf2f(XIN[tt * 64 + c]) * K.cw[0] + bf2f(XIN[(tt + 1) * 64 + c]) * K.cw[1] + bf2f(XIN[(tt + 2) * 64 + c]) * K.cw[2] + bf2f(XIN[(tt + 3) * 64 + c]) * K.cw[3]);
    }
    __syncthreads();
    float hs[4][4];
    float av[4][4], bv[4][4];
#pragma unroll
    for (int d = 0; d < 2; ++d) {
        f32x4 ga[4], gx[4];
#pragma unroll
        for (int nb = 0; nb < 4; ++nb) { ga[nb] = f32x4{0.f, 0.f, 0.f, 0.f}; gx[nb] = f32x4{0.f, 0.f, 0.f, 0.f}; }
        mmT<4, 2>(ga, XB, 72, wave, WT + (2 * d) * 64 * 72, 72, lane);
        mmT<4, 2>(gx, XB, 72, wave, WT + (2 * d + 1) * 64 * 72, 72, lane);
        float cA[4], cH[4];
#pragma unroll
        for (int nb = 0; nb < 4; ++nb) {
            const float ba = K.ba[d][nb], bx = K.bx[d][nb], sp8 = K.sp8[d][nb];
#pragma unroll
            for (int r = 0; r < 4; ++r) {
                const float rg = fsigm(ga[nb][r] + ba), ig = fsigm(gx[nb][r] + bx);
                const float a = FEXP(sp8 * rg);
                const float xv = bf2f(XB[(wave * 16 + q * 4 + r) * 72 + nb * 16 + l15]);
                av[nb][r] = a; bv[nb][r] = fsqrt(fmaxf(1.0f - a * a, 0.f)) * ig * xv;
            }
            float A, H;
            if (d == 0) { A = av[nb][0]; H = bv[nb][0];
#pragma unroll
                for (int r = 1; r < 4; ++r) { H = H * av[nb][r] + bv[nb][r]; A *= av[nb][r]; } }
            else { A = av[nb][3]; H = bv[nb][3];
#pragma unroll
                for (int r = 2; r >= 0; --r) { H = H * av[nb][r] + bv[nb][r]; A *= av[nb][r]; } }
#pragma unroll
            for (int st = 1; st <= 2; st <<= 1) {
                const float pA = d == 0 ? __shfl_up(A, 16 * st) : __shfl_down(A, 16 * st), pH = d == 0 ? __shfl_up(H, 16 * st) : __shfl_down(H, 16 * st);
                const bool has = d == 0 ? (q >= st) : (q + st <= 3);
                if (has) { H = pH * A + H; A = pA * A; }
            }
            cA[nb] = A; cH[nb] = H;
            const bool last = d == 0 ? (q == 3) : (q == 0);
            if (last) { CP[((d * 4 + wave) * 64 + nb * 16 + l15) * 2] = A; CP[((d * 4 + wave) * 64 + nb * 16 + l15) * 2 + 1] = H; }
        }
        __syncthreads();
        if (!FINAL) {
            if (wave == 0 && q == 0) {
#pragma unroll
                for (int nb = 0; nb < 4; ++nb) {
                    const int c = nb * 16 + l15;
                    float A = 1.f, H = 0.f;
#pragma unroll
                    for (int w = 0; w < 4; ++w) { const int ww = d == 0 ? w : 3 - w; const float wa = CP[((d * 4 + ww) * 64 + c) * 2], wh = CP[((d * 4 + ww) * 64 + c) * 2 + 1]; H = H * wa + wh; A *= wa; }
                    WSP(float, WS_SUMA)[((size_t)d * NCH + cg) * D_LRU + cb * 64 + c] = A;
                    WSP(float, WS_SUMH)[((size_t)d * NCH + cg) * D_LRU + cb * 64 + c] = H;
                }
            }
        } else {
#pragma unroll
            for (int nb = 0; nb < 4; ++nb) {
                const int c = nb * 16 + l15;
                float h = cin[d][nb];
#pragma unroll
                for (int w = 0; w < 3; ++w) { const int ww = d == 0 ? w : 3 - w; const bool use = d == 0 ? (ww < wave) : (ww > wave);
                    if (use) h = h * CP[((d * 4 + ww) * 64 + c) * 2] + CP[((d * 4 + ww) * 64 + c) * 2 + 1]; }
                const float eA = d == 0 ? __shfl_up(cA[nb], 16) : __shfl_down(cA[nb], 16), eH = d == 0 ? __shfl_up(cH[nb], 16) : __shfl_down(cH[nb], 16);
                const bool first = d == 0 ? (q == 0) : (q == 3);
                if (!first) h = h * eA + eH;
                if (d == 0) {
#pragma unroll
                    for (int r = 0; r < 4; ++r) { h = h * av[nb][r] + bv[nb][r]; hs[nb][r] = h; }
                } else {
#pragma unroll
                    for (int r = 3; r >= 0; --r) { h = h * av[nb][r] + bv[nb][r]; hs[nb][r] += h; }
                }
            }
        }
        __syncthreads();
    }
    if (FINAL) {
        float ss[4] = {0.f, 0.f, 0.f, 0.f};
#pragma unroll
        for (int nb = 0; nb < 4; ++nb) {
            const float gn = K.gn[nb];
#pragma unroll
            for (int r = 0; r < 4; ++r) {
                const int tt = wave * 16 + q * 4 + r;
                const float v = hs[nb][r] * geluf_(bf2f(GT[tt * 72 + nb * 16 + l15]));
                ss[r] += v * v;
                XB[tt * 72 + nb * 16 + l15] = f2bf(v * gn);
            }
        }
#pragma unroll
        for (int r = 0; r < 4; ++r) {
#pragma unroll
            for (int o = 1; o < 16; o <<= 1) ss[r] += __shfl_xor(ss[r], o);
            if (l15 == 0) WSP(float, WS_SSQP)[(size_t)(sc.base_row + sc.t0 + wave * 16 + q * 4 + r) * LRU_BLOCKS + cb] = ss[r];
        }
        __syncthreads();
        bf16_t* MIX = WSP(bf16_t, WS_R3);
        for (int idx = tid; idx < 64 * 8; idx += 256) {
            const int tt = idx >> 3, c8 = (idx & 7) * 8;
            *(u32x4*)(MIX + (size_t)(sc.base_row + sc.t0 + tt) * D_MIX + cb * 64 + c8) = *(const u32x4*)(XB + tt * 72 + c8);
        }
    }
}
__device__ __forceinline__ void phaseD(const Params& p, int bid, int nblk, char* smem) {
    int cur = -1; LruConst K; LruStage S;
    for (int it = bid; it < NCH * LRU_BLOCKS; it += nblk) {
        const int cb = it % LRU_BLOCKS, cg = it / LRU_BLOCKS;
        if (cb != cur) { __syncthreads(); lru_load_w(p, smem, cb); lru_consts(p, cb, K); lru_stage_load<false>(p, cg, cb, S); cur = cb; }
        const int itn = it + nblk;
        lru_item<false>(p, smem, cg, cb, K, S, (itn < NCH * LRU_BLOCKS && itn % LRU_BLOCKS == cb) ? itn / LRU_BLOCKS : -1);
        if (itn < NCH * LRU_BLOCKS && itn % LRU_BLOCKS != cb) cur = -1;
    }
}
__device__ __forceinline__ void phaseE(const Params& p, int bid, int nblk, char* smem) {
    const float* SUMA = WSP(float, WS_SUMA); const float* SUMH = WSP(float, WS_SUMH); float* CARRY = WSP(float, WS_CARRY);
    constexpr int NLB = SEQ / 64, NCB = CTX_LEN / 64;
    for (int g = bid * 256 + threadIdx.x; g < BATCH * 2 * D_LRU; g += nblk * 256) {
        const int c = g % D_LRU, d = (g / D_LRU) & 1, b = g / (2 * D_LRU);
        const float* sa = SUMA + (size_t)d * NCH * D_LRU + c; const float* sh = SUMH + (size_t)d * NCH * D_LRU + c;
        float* cr = CARRY + (size_t)d * NLCH * D_LRU + c;
        float h = 0.f;
        if (d == 0) {
            for (int q2 = 0; q2 < NCB; ++q2) { const int gi = NLCH + b * NCB + q2; h = sa[(size_t)gi * D_LRU] * h + sh[(size_t)gi * D_LRU]; }
            for (int q2 = 0; q2 < NLB; ++q2) { const int gi = b * NLB + q2; cr[(size_t)gi * D_LRU] = h; h = sa[(size_t)gi * D_LRU] * h + sh[(size_t)gi * D_LRU]; }
        } else {
            for (int q2 = NCB - 1; q2 >= 0; --q2) { const int gi = NLCH + b * NCB + q2; h = sa[(size_t)gi * D_LRU] * h + sh[(size_t)gi * D_LRU]; }
            for (int q2 = NLB - 1; q2 >= 0; --q2) { const int gi = b * NLB + q2; cr[(size_t)gi * D_LRU] = h; h = sa[(size_t)gi * D_LRU] * h + sh[(size_t)gi * D_LRU]; }
        }
    }
}
__device__ __forceinline__ void phaseF(const Params& p, int bid, int nblk, char* smem) {
    int cur = -1; LruConst K; LruStage S;
    for (int it = bid; it < NLCH * LRU_BLOCKS; it += nblk) {
        const int cb = it % LRU_BLOCKS, cg = it / LRU_BLOCKS;
        if (cb != cur) { __syncthreads(); lru_load_w(p, smem, cb); lru_consts(p, cb, K); lru_stage_load<true>(p, cg, cb, S); cur = cb; }
        const int itn = it + nblk;
        lru_item<true>(p, smem, cg, cb, K, S, (itn < NLCH * LRU_BLOCKS && itn % LRU_BLOCKS == cb) ? itn / LRU_BLOCKS : -1);
        if (itn < NLCH * LRU_BLOCKS && itn % LRU_BLOCKS != cb) cur = -1;
    }
}

__device__ __forceinline__ size_t rwkv_row(int seg, int b, int s) {
    if (seg == 0) return (size_t)(MLAT + b * CTX_LEN + s);
    const int r = s % ROWS, c = s / ROWS;
    return (size_t)(b * SEQ + r * GRID_W + c);
}
__device__ __forceinline__ void chunk_info(int d, int c, int& seg, int& p0, int& len) {
    if (c < NCC) { seg = 0; len = CTX_LEN; p0 = (d == 0 ? c : NCC - 1 - c) * RC; }
    else { const int cc = c - NCC; seg = 1; len = SEQ; p0 = (d == 0 ? cc : NLC - 1 - cc) * RC; }
}
__device__ __forceinline__ void unpack8(const u32x4 v, float* o) {
    o[0] = bitsf(v[0] << 16); o[1] = bitsf(v[0] & 0xFFFF0000u); o[2] = bitsf(v[1] << 16); o[3] = bitsf(v[1] & 0xFFFF0000u);
    o[4] = bitsf(v[2] << 16); o[5] = bitsf(v[2] & 0xFFFF0000u); o[6] = bitsf(v[3] << 16); o[7] = bitsf(v[3] & 0xFFFF0000u);
}
__device__ __forceinline__ void shifted8(const Params& p, const bf16_t* P, int seg, int b, int pos, int len, int ch0, float* o) {
    float z[8], zp[8], zn[8];
    unpack8(*(const u32x4*)(P + rwkv_row(seg, b, pos) * D_IN + RW0 + ch0), z);
    if (pos > 0) unpack8(*(const u32x4*)(P + rwkv_row(seg, b, pos - 1) * D_IN + RW0 + ch0), zp); else { for (int i = 0; i < 8; ++i) zp[i] = 0.f; }
    if (pos < len - 1) unpack8(*(const u32x4*)(P + rwkv_row(seg, b, pos + 1) * D_IN + RW0 + ch0), zn); else { for (int i = 0; i < 8; ++i) zn[i] = 0.f; }
    const f32x4 mp0 = ld4(p.mu_prev + ch0), mp1 = ld4(p.mu_prev + ch0 + 4), mn0 = ld4(p.mu_next + ch0), mn1 = ld4(p.mu_next + ch0 + 4);
#pragma unroll
    for (int i = 0; i < 4; ++i) { o[i] = z[i] + mp0[i] * (zp[i] - z[i]) + mn0[i] * (zn[i] - z[i]); o[4 + i] = z[4 + i] + mp1[i] * (zp[4 + i] - z[4 + i]) + mn1[i] * (zn[4 + i] - z[4 + i]); }
}
constexpr int LT = 72, LJ = 40;
constexpr int R_RF = 0, R_KF = 8192, R_VF = 16384, R_LW = 24576, R_IC = 32768;
constexpr int R_NKA = 0, R_MBR = 2560, R_MKR = 5120;
constexpr int R_XU = 7680;
constexpr int R_IA = R_XU + 8448, R_IB = R_IA + 4608, R_PA = R_IB + 4608, R_PB = R_PA + 4608;
constexpr int R_WA = R_IB, R_U0 = R_WA + 5120;
constexpr int R_TB0 = R_IB, R_TB1 = R_IB + 2560, R_PB0 = R_IB + 5120, R_PB1 = R_IB + 7680, R_PT0 = R_IB + 10240, R_PT1 = R_IB + 12800;
static_assert(R_PT1 + 2560 <= 40960, "rwkv doubling buffers");
static_assert(R_U0 + 5120 <= R_PB + 4608 && R_PB + 4608 <= 40960, "rwkv scratch");
constexpr int R_O = 40960;
constexpr int R_AH = R_O, R_BH = R_AH + 4608, R_KH = R_BH + 4608, R_RH = R_KH + 4608;
constexpr int R_VT = R_RH + 4608, R_BHT = R_VT + 5120, R_KHT = R_BHT + 5120;
constexpr int R_GC = R_KHT + 5120, R_TOT = R_GC + 256, R_PS = R_TOT + 1024, R_END = R_PS + 1024;
constexpr int R_TW = R_O, R_TA = R_TW + 4608, R_W2T = R_TA + 4608, R_A2T = R_W2T + 9216;
static_assert(R_A2T + 9216 <= R_END && R_END <= SMEM_BYTES, "rwkv lds");

__device__ __forceinline__ void phaseR1(const Params& p, int bid, int nblk, char* smem) {
    const bf16_t* P = WSP(bf16_t, WS_R1);
    unsigned char* CH = p.ws + WS_CH;
    float* RBON = WSP(float, WS_RBON);
    float* Rf = (float*)(smem + R_RF); float* Kf = (float*)(smem + R_KF); float* Vf = (float*)(smem + R_VF); float* LW = (float*)(smem + R_LW); float* IC = (float*)(smem + R_IC);
    float* IA = (float*)(smem + R_IA); float* IB = (float*)(smem + R_IB); float* PA = (float*)(smem + R_PA); float* PB = (float*)(smem + R_PB); bf16_t* NkaT = (bf16_t*)(smem + R_NKA); bf16_t* MbrT = (bf16_t*)(smem + R_MBR); bf16_t* MkrT = (bf16_t*)(smem + R_MKR);
    float* Xu = (float*)(smem + R_XU); bf16_t* Wa = (bf16_t*)(smem + R_WA); bf16_t* U0 = (bf16_t*)(smem + R_U0);
    bf16_t* Ah = (bf16_t*)(smem + R_AH); bf16_t* Bh = (bf16_t*)(smem + R_BH); bf16_t* Kh = (bf16_t*)(smem + R_KH); bf16_t* Rh = (bf16_t*)(smem + R_RH);
    bf16_t* VT = (bf16_t*)(smem + R_VT); bf16_t* BhT = (bf16_t*)(smem + R_BHT); bf16_t* KhT = (bf16_t*)(smem + R_KHT);
    float* GC = (float*)(smem + R_GC); float* TOT = (float*)(smem + R_TOT); float* PS = (float*)(smem + R_PS);
    bf16_t* TW = (bf16_t*)(smem + R_TW); bf16_t* TA = (bf16_t*)(smem + R_TA); bf16_t* W2T = (bf16_t*)(smem + R_W2T); bf16_t* A2T = (bf16_t*)(smem + R_A2T);
    constexpr int NITEM = NCHAIN * NCK;
    const int per = (NITEM + nblk - 1) / nblk;
    const int it0 = bid * per, it1 = (it0 + per < NITEM) ? it0 + per : NITEM;
    for (int it = it0; it < it1; ++it) {
        const int tid = opaque_tid(), lane = tid & 63, wave = tid >> 6, q = lane >> 4, l15 = lane & 15;
        const int chain = it / NCK, c = it % NCK;
        const int d = chain & 1, h = (chain >> 1) % HEADS, b = chain / (2 * HEADS);
        int seg, p0, len; chunk_info(d, c, seg, p0, len);
        unsigned char* chp = CH + (size_t)it * CH_BYTES;
        const float kkc = p.k_k[h * 64 + lane], kac = p.k_a[h * 64 + lane];
        __syncthreads();
        {
            u32x4 wv[4];
#pragma unroll
            for (int k = 0; k < 4; ++k) {
                const int idx = tid + 256 * k, which = idx >> 9, j = (idx >> 3) & 63, c8 = (idx & 7) * 8;
                wv[k] = *(const u32x4*)(WSP(bf16_t, WS_LORA) + ((size_t)((d * 2 + which) * HEADS + h) * 64 + j) * 64 + c8);
            }
            if (tid < 160) {
                const int g = tid % 40, tq = tid / 40, grp = g >> 3, j0 = (g & 7) * 8;
                const int ch0 = (grp < 3) ? grp * D_RWKV + h * 64 + j0 : (grp == 3 ? 3 * D_RWKV + d * 64 + j0 : 3 * D_RWKV + 128 + d * 64 + j0);
                const int pa = p0 + (d ? RC - 8 - 8 * tq : 8 * tq);
                u32x4 zr[10];
#pragma unroll
                for (int i = 0; i < 10; ++i) {
                    const int pos = pa - 1 + i;
                    zr[i] = (pos >= 0 && pos < len) ? *(const u32x4*)(P + rwkv_row(seg, b, pos) * D_IN + RW0 + ch0) : u32x4{0u, 0u, 0u, 0u};
                }
                const f32x4 mp0 = ld4(p.mu_prev + ch0), mp1 = ld4(p.mu_prev + ch0 + 4), mn0 = ld4(p.mu_next + ch0), mn1 = ld4(p.mu_next + ch0 + 4);
                float zz[3][8];
                unpack8(zr[0], zz[0]); unpack8(zr[1], zz[1]);
#pragma unroll
                for (int i = 0; i < 8; ++i) {
                    unpack8(zr[i + 2], zz[(i + 2) % 3]);
                    const float* zpv = zz[i % 3]; const float* z = zz[(i + 1) % 3]; const float* znv = zz[(i + 2) % 3];
                    const int tau = d ? 8 * tq + 7 - i : 8 * tq + i;
                    float o[8];
#pragma unroll
                    for (int e = 0; e < 4; ++e) { o[e] = z[e] + mp0[e] * (zpv[e] - z[e]) + mn0[e] * (znv[e] - z[e]); o[4 + e] = z[4 + e] + mp1[e] * (zpv[4 + e] - z[4 + e]) + mn1[e] * (znv[4 + e] - z[4 + e]); }
                    if (grp < 3) {
                        float* dst = (grp == 0 ? Rf : grp == 1 ? Kf : Vf) + tau * 64 + j0;
                        *(f32x4*)dst = f32x4{o[0], o[1], o[2], o[3]}; *(f32x4*)(dst + 4) = f32x4{o[4], o[5], o[6], o[7]};
                    } else if (grp == 3) {
                        u32x4 w;
#pragma unroll
                        for (int e = 0; e < 4; ++e) { const float t0 = 2.0f * frcp(1.0f + FEXP(-2.0f * o[2 * e])) - 1.0f, t1 = 2.0f * frcp(1.0f + FEXP(-2.0f * o[2 * e + 1])) - 1.0f; w[e] = pk2(t0, t1); }
                        *(u32x4*)(TW + tau * LT + j0) = w;
                    } else {
                        u32x4 w; w[0] = pk2(o[0], o[1]); w[1] = pk2(o[2], o[3]); w[2] = pk2(o[4], o[5]); w[3] = pk2(o[6], o[7]);
                        *(u32x4*)(TA + tau * LT + j0) = w;
                    }
                }
            }
#pragma unroll
            for (int k = 0; k < 4; ++k) {
                const int idx = tid + 256 * k, which = idx >> 9, j = (idx >> 3) & 63, c8 = (idx & 7) * 8;
                *(u32x4*)((which ? A2T : W2T) + j * LT + c8) = wv[k];
            }
        }
        __syncthreads();
        {
            f32x4 aw[2] = {f32x4{0.f, 0.f, 0.f, 0.f}, f32x4{0.f, 0.f, 0.f, 0.f}}, ai[2] = {f32x4{0.f, 0.f, 0.f, 0.f}, f32x4{0.f, 0.f, 0.f, 0.f}};
            mmT<2, 2>(aw, W2T, LT, wave, TW, LT, lane);
            mmT<2, 2>(ai, A2T, LT, wave, TA, LT, lane);
            const int j = wave * 16 + q * 4;
            const f32x4 w0v = ld4(p.w0 + d * D_RWKV + h * 64 + j), a0v = ld4(p.a0 + d * D_RWKV + h * 64 + j);
            const f32x4 kk4 = ld4(p.k_k + h * 64 + j), ka4 = ld4(p.k_a + h * 64 + j), rk4 = ld4(p.r_k + h * 64 + j);
#pragma unroll
            for (int nb = 0; nb < 2; ++nb) {
                const int tau = nb * 16 + l15;
                f32x4 lw, ic;
#pragma unroll
                for (int r = 0; r < 4; ++r) { lw[r] = -0.6065306597126334f * fsigm(w0v[r] + aw[nb][r]); ic[r] = fsigm(a0v[r] + ai[nb][r]); }
                *(f32x4*)(LW + tau * 64 + j) = lw; *(f32x4*)(IC + tau * 64 + j) = ic;
                const f32x4 kr = *(const f32x4*)(Kf + tau * 64 + j), rr = *(const f32x4*)(Rf + tau * 64 + j);
                const f32x4 kd = kr * (1.0f + (ic - 1.0f) * ka4), kq = kr * kk4;
                float n2 = hsum4(kq * kq), bon = hsum4(rr * kd * rk4);
                n2 += __shfl_xor(n2, 16); n2 += __shfl_xor(n2, 32); bon += __shfl_xor(bon, 16); bon += __shfl_xor(bon, 32);
                if (q == 0) { PS[(tau * 4 + wave) * 2] = n2; PS[(tau * 4 + wave) * 2 + 1] = bon; }
            }
        }
        __syncthreads();
        {
            const int j = lane, t0 = wave * 8;
            float cum[8], kd[8], kkn[8], icv[8], rr[8], vv[8], run = 0.f;
#pragma unroll
            for (int i = 0; i < 8; ++i) {
                const int t = t0 + i;
                run += LW[t * 64 + j]; cum[i] = run;
                const float kr = Kf[t * 64 + j]; icv[i] = IC[t * 64 + j]; rr[i] = Rf[t * 64 + j]; vv[i] = Vf[t * 64 + j];
                kd[i] = kr * (1.0f + (icv[i] - 1.0f) * kac);
                const float kk = kr * kkc;
                const f32x4 pa = *(const f32x4*)(PS + t * 8), pb = *(const f32x4*)(PS + t * 8 + 4);
                const float n2 = (pa[0] + pa[2]) + (pb[0] + pb[2]);
                kkn[i] = kk * frsq(fmaxf(n2, 1e-24f));
                if (lane == 0) RBON[(size_t)it * RC + t] = (pa[1] + pa[3]) + (pb[1] + pb[3]);
            }
            TOT[wave * 64 + j] = run;
            __syncthreads();
            float off = 0.f;
            for (int w = 0; w < wave; ++w) off += TOT[w * 64 + j];
            u32x4 vt, bt, kt;
            float e_prev = 0.f;
#pragma unroll
            for (int i = 0; i < 8; ++i) {
                const int t = t0 + i;
                const float cu = off + cum[i], cprev = (i == 0) ? off : off + cum[i - 1];
                const float g = FEXP(cu), gi = FEXP(-cu), gm = FEXP(cprev);
                const float ah = -kkn[i] * gm, bh = kkn[i] * icv[i] * gi, kh = kd[i] * gi, rh = rr[i] * g;
                Ah[t * LT + j] = f2bf(ah); Bh[t * LT + j] = f2bf(bh); Kh[t * LT + j] = f2bf(kh); Rh[t * LT + j] = f2bf(rh);
                if (i & 1) { vt[i >> 1] = pk2(e_prev, vv[i]); bt[i >> 1] = (bt[i >> 1] & 0xFFFFu) | ((unsigned)f2bf(bh) << 16); kt[i >> 1] = (kt[i >> 1] & 0xFFFFu) | ((unsigned)f2bf(kh) << 16); }
                else { e_prev = vv[i]; bt[i >> 1] = f2bf(bh); kt[i >> 1] = f2bf(kh); }
                if (t == RC - 1) GC[j] = g;
            }
            *(u32x4*)(VT + j * LJ + t0) = vt; *(u32x4*)(BhT + j * LJ + t0) = bt; *(u32x4*)(KhT + j * LJ + t0) = kt;
        }
        __syncthreads();
        {
            const bf16_t* X = (wave == 0) ? Ah : (wave & 1) ? Kh : Bh;
            const bf16_t* Y = (wave == 0) ? Bh : (wave == 1) ? Ah : Rh;
#pragma unroll
            for (int xs = 0; xs < 2; ++xs) {
                f32x4 acc[2] = {f32x4{0.f, 0.f, 0.f, 0.f}, f32x4{0.f, 0.f, 0.f, 0.f}};
                mmT<2, 2>(acc, X, LT, xs, Y, LT, lane);
#pragma unroll
                for (int nb = 0; nb < 2; ++nb) {
                    const int yy = nb * 16 + l15, x0 = xs * 16 + q * 4;
                    f32x4 v = acc[nb];
#pragma unroll
                    for (int r = 0; r < 4; ++r) { const int xx = x0 + r; const bool keep = (wave == 0) ? (yy < xx) : (wave == 1) ? (xx < yy) : (xx <= yy); v[r] = keep ? v[r] : 0.f; }
                    if (wave == 0) {
                        bf16_t* Pb0 = (bf16_t*)(smem + R_PB0); bf16_t* Pt0 = (bf16_t*)(smem + R_PT0); bf16_t* Tb0 = (bf16_t*)(smem + R_TB0);
                        *(U2*)(Pb0 + yy * LJ + x0) = pack4(v);
#pragma unroll
                        for (int r = 0; r < 4; ++r) Pt0[(x0 + r) * LJ + yy] = f2bf(v[r]);
                        f32x4 t0 = v;
#pragma unroll
                        for (int r = 0; r < 4; ++r) t0[r] += (x0 + r == yy) ? 1.0f : 0.0f;
                        *(f32x4*)(IA + yy * 36 + x0) = t0; *(U2*)(Tb0 + yy * LJ + x0) = pack4(t0);
                    }
                    else { bf16_t* dst = (wave == 1 ? NkaT : wave == 2 ? MbrT : MkrT) + yy * LJ + x0; *(U2*)dst = pack4(v); }
                }
            }
        }
        __syncthreads();
        {
#pragma unroll
            for (int xs = 0; xs < 2; ++xs) {
                f32x4 acc[1] = {f32x4{0.f, 0.f, 0.f, 0.f}};
                mmT<1, 1>(acc, NkaT, LJ, xs, VT + wave * 16 * LJ, LJ, lane);
                const int i = wave * 16 + l15, tb = xs * 16 + q * 4;
                Xu[i * 33 + tb] = acc[0][0]; Xu[i * 33 + tb + 1] = acc[0][1]; Xu[i * 33 + tb + 2] = acc[0][2]; Xu[i * 33 + tb + 3] = acc[0][3];
            }
        }
        __syncthreads();
        {
            bf16_t* Tb[2] = {(bf16_t*)(smem + R_TB0), (bf16_t*)(smem + R_TB1)};
            bf16_t* Pb[2] = {(bf16_t*)(smem + R_PB0), (bf16_t*)(smem + R_PB1)};
            bf16_t* Pt[2] = {(bf16_t*)(smem + R_PT0), (bf16_t*)(smem + R_PT1)};
            const int nb = wave >> 1, xs = wave & 1;
            const int yy = nb * 16 + l15, x0 = xs * 16 + q * 4;
            auto prod = [&](const bf16_t* L, const bf16_t* Rt, f32x4 init) {
                const bf16x8 xf = *(const bf16x8*)(Rt + (xs * 16 + l15) * LJ + 8 * q), yf = *(const bf16x8*)(L + (nb * 16 + l15) * LJ + 8 * q);
                return MFMA16(xf, yf, init);
            };
            const f32x4 zero = f32x4{0.f, 0.f, 0.f, 0.f};
#pragma unroll
            for (int k = 0; k < 5; ++k) {
                const int pc = k & 1, pn = pc ^ 1;
                f32x4 tnew = zero, pnew = zero;
                if (k >= 1) tnew = prod(Tb[pn], Pt[pc], *(const f32x4*)(IA + yy * 36 + x0));
                if (k <= 3) pnew = prod(Pb[pc], Pt[pc], zero);
                if (k >= 1) { *(f32x4*)(IA + yy * 36 + x0) = tnew; if (k <= 3) *(U2*)(Tb[pc] + yy * LJ + x0) = pack4(tnew); }
                if (k <= 3) {
                    *(U2*)(Pb[pn] + yy * LJ + x0) = pack4(pnew);
#pragma unroll
                    for (int r = 0; r < 4; ++r) Pt[pn][(x0 + r) * LJ + yy] = f2bf(pnew[r]);
                }
                __syncthreads();
            }
            f32x4 accw[2], accu[2];
#pragma unroll
            for (int tc = 0; tc < 2; ++tc) { accw[tc] = f32x4{0.f, 0.f, 0.f, 0.f}; accu[tc] = f32x4{0.f, 0.f, 0.f, 0.f}; }
#pragma unroll
            for (int k0 = 0; k0 < 32; k0 += 4) {
                const float la = bf2f(Ah[(k0 + q) * LT + wave * 16 + l15]), lu = Xu[(wave * 16 + l15) * 33 + k0 + q];
#pragma unroll
                for (int tc = 0; tc < 2; ++tc) { const float rv = IA[(k0 + q) * 36 + tc * 16 + l15]; accw[tc] = MFMAF32(la, rv, accw[tc]); accu[tc] = MFMAF32(lu, rv, accu[tc]); }
            }
            __syncthreads();
#pragma unroll
            for (int tc = 0; tc < 2; ++tc)
#pragma unroll
                for (int r = 0; r < 4; ++r) { const int row = wave * 16 + q * 4 + r, col = tc * 16 + l15; Wa[row * LJ + col] = f2bf(accw[tc][r]); U0[row * LJ + col] = f2bf(accu[tc][r]); }
        }
        __syncthreads();
        {
            bf16_t* gPm = (bf16_t*)(chp + CH_PM); bf16_t* gSA = (bf16_t*)(chp + CH_SA); bf16_t* gQT = (bf16_t*)(chp + CH_QT); bf16_t* gY0 = (bf16_t*)(chp + CH_Y0);
            const int x0 = wave * 16 + q * 4;
            {
                f32x4 acc[4] = {f32x4{0.f, 0.f, 0.f, 0.f}, f32x4{0.f, 0.f, 0.f, 0.f}, f32x4{0.f, 0.f, 0.f, 0.f}, f32x4{0.f, 0.f, 0.f, 0.f}};
                mmT<4, 1>(acc, Wa, LJ, wave, BhT, LJ, lane);
#pragma unroll
                for (int nb = 0; nb < 4; ++nb) {
                    const int jp = nb * 16 + l15; const float g = GC[jp];
                    f32x4 v = acc[nb];
#pragma unroll
                    for (int r = 0; r < 4; ++r) v[r] = (v[r] + ((x0 + r == jp) ? 1.0f : 0.0f)) * g;
                    *(U2*)(gPm + jp * 64 + x0) = pack4(v);
                }
            }
            {
                f32x4 acc[4] = {f32x4{0.f, 0.f, 0.f, 0.f}, f32x4{0.f, 0.f, 0.f, 0.f}, f32x4{0.f, 0.f, 0.f, 0.f}, f32x4{0.f, 0.f, 0.f, 0.f}};
                mmT<4, 1>(acc, BhT, LJ, wave, U0, LJ, lane);
                mmT<4, 1>(acc, KhT, LJ, wave, VT, LJ, lane);
                const f32x4 g = *(const f32x4*)(GC + x0);
#pragma unroll
                for (int nb = 0; nb < 4; ++nb) *(U2*)(gSA + (nb * 16 + l15) * 64 + x0) = pack4(acc[nb] * g);
            }
            if (seg == 1) {
                {
                    f32x4 acc[2] = {f32x4{0.f, 0.f, 0.f, 0.f}, f32x4{0.f, 0.f, 0.f, 0.f}};
                    mmT<2, 1>(acc, Wa, LJ, wave, MbrT, LJ, lane);
#pragma unroll
                    for (int nb = 0; nb < 2; ++nb) {
                        const int t = nb * 16 + l15;
                        f32x4 v = acc[nb];
#pragma unroll
                        for (int r = 0; r < 4; ++r) v[r] += bf2f(Rh[t * LT + x0 + r]);
                        *(U2*)(gQT + t * 64 + x0) = pack4(v);
                    }
                }
                {
                    f32x4 acc[2] = {f32x4{0.f, 0.f, 0.f, 0.f}, f32x4{0.f, 0.f, 0.f, 0.f}};
                    mmT<2, 1>(acc, U0, LJ, wave, MbrT, LJ, lane);
                    mmT<2, 1>(acc, VT, LJ, wave, MkrT, LJ, lane);
#pragma unroll
                    for (int nb = 0; nb < 2; ++nb) *(U2*)(gY0 + (nb * 16 + l15) * 64 + x0) = pack4(acc[nb]);
                }
            }
        }
    }
}

__device__ __forceinline__ U2 ldu2(const bf16_t* p) { return *(const U2*)p; }
constexpr int R2D = 6, R2LD = 72;
__device__ __forceinline__ void phaseR2(const Params& p, int bid, int nblk, char* smem) {
    unsigned char* CH = p.ws + WS_CH;
    bf16_t* PL = (bf16_t*)smem;
    const int tid = opaque_tid(), lane = tid & 63, wave = tid >> 6, q = lane >> 4, l15 = lane & 15;
    const int lrow = wave * 16 + (lane >> 2), lcol = (lane & 3) * 16;
    for (int chain = bid; chain < NCHAIN; chain += nblk) {
        const int i = wave * 16 + l15;
        unsigned char* chbase = CH + (size_t)chain * NCK * CH_BYTES;
        f32x4 st[4];
#pragma unroll
        for (int nt = 0; nt < 4; ++nt) st[nt] = f32x4{0.f, 0.f, 0.f, 0.f};
        u32x4 pq[R2D][2]; U2 sa[R2D][4];
#pragma unroll
        for (int k = 0; k < R2D; ++k) {
            const unsigned char* chp = chbase + (size_t)(k < NCK ? k : NCK - 1) * CH_BYTES;
            const bf16_t* gp = (const bf16_t*)(chp + CH_PM) + lrow * 64 + lcol;
            pq[k][0] = *(const u32x4*)gp; pq[k][1] = *(const u32x4*)(gp + 8);
#pragma unroll
            for (int nt = 0; nt < 4; ++nt) sa[k][nt] = ldu2((const bf16_t*)(chp + CH_SA) + i * 64 + nt * 16 + 4 * q);
        }
#pragma unroll 1
        for (int c0 = 0; c0 < NCK; c0 += R2D) {
#pragma unroll
            for (int k = 0; k < R2D; ++k) {
                const int c = c0 + k;
                if (c < NCK) {
                bf16_t* pl = PL + (k & 1) * 64 * R2LD;
                *(u32x4*)(pl + lrow * R2LD + lcol) = pq[k][0]; *(u32x4*)(pl + lrow * R2LD + lcol + 8) = pq[k][1];
                f32x4 ini[4];
#pragma unroll
                for (int nt = 0; nt < 4; ++nt) ini[nt] = f32x4{bitsf(sa[k][nt].x << 16), bitsf(sa[k][nt].x & 0xFFFF0000u), bitsf(sa[k][nt].y << 16), bitsf(sa[k][nt].y & 0xFFFF0000u)};
                {
                    const int cn = (c + R2D < NCK) ? c + R2D : NCK - 1;
                    const unsigned char* chp = chbase + (size_t)cn * CH_BYTES;
                    const bf16_t* gp = (const bf16_t*)(chp + CH_PM) + lrow * 64 + lcol;
                    pq[k][0] = *(const u32x4*)gp; pq[k][1] = *(const u32x4*)(gp + 8);
#pragma unroll
                    for (int nt = 0; nt < 4; ++nt) sa[k][nt] = ldu2((const bf16_t*)(chp + CH_SA) + i * 64 + nt * 16 + 4 * q);
                }
                __syncthreads();
                bf16_t* gSA = (bf16_t*)(chbase + (size_t)c * CH_BYTES + CH_SA) + i * 64 + 4 * q;
                bf16x8 bfr[2];
#pragma unroll
                for (int ks = 0; ks < 2; ++ks) {
                    const U2 lo = pack4(st[2 * ks]), hi = pack4(st[2 * ks + 1]);
                    bfr[ks] = __builtin_bit_cast(bf16x8, u32x4{lo.x, lo.y, hi.x, hi.y});
                    *(U2*)(gSA + (2 * ks) * 16) = lo; *(U2*)(gSA + (2 * ks + 1) * 16) = hi;
                }
#pragma unroll
                for (int nt = 0; nt < 4; ++nt) {
                    f32x4 acc = ini[nt];
#pragma unroll
                    for (int ks = 0; ks < 2; ++ks) {
                        const U2 lo = *(const U2*)(pl + (nt * 16 + l15) * R2LD + 32 * ks + 4 * q), hi = *(const U2*)(pl + (nt * 16 + l15) * R2LD + 32 * ks + 16 + 4 * q);
                        acc = MFMA16(__builtin_bit_cast(bf16x8, u32x4{lo.x, lo.y, hi.x, hi.y}), bfr[ks], acc);
                    }
                    st[nt] = acc;
                }
                }
            }
        }
        __syncthreads();
    }
}

__device__ __forceinline__ void phaseR3(const Params& p, int bid, int nblk, char* smem) {
    const bf16_t* P = WSP(bf16_t, WS_R1);
    const unsigned char* CH = p.ws + WS_CH;
    const float* RBON = WSP(float, WS_RBON);
    bf16_t* MIX = WSP(bf16_t, WS_R3);
    float* red = (float*)smem;
    const int tid = opaque_tid(), lane = tid & 63, wave = tid >> 6, q = lane >> 4, l15 = lane & 15;
    for (int m = bid * 256 + tid; m < MLAT; m += nblk * 256) {
        const float* sp = WSP(float, WS_SSQP) + (size_t)m * LRU_BLOCKS;
        float sq = 0.f;
#pragma unroll
        for (int c = 0; c < LRU_BLOCKS; ++c) sq += sp[c];
        WSP(float, WS_RINV)[m] = frsq(sq * (1.0f / D_LRU) + RMS_EPS);
    }
    bf16_t* G2T = (bf16_t*)(smem + 1024);
    const int nbh = nblk / HEADS;
    const bool uniform = (nbh > 0) && (nblk % HEADS == 0);
    constexpr int NP16 = SEQ / 16, NW = BATCH * NP16;
    const int nwv = uniform ? nbh * 4 : nblk * 4;
    int hcur = -1;
    for (int wi0 = (uniform ? (bid % nbh) : bid) * 4; wi0 < (uniform ? NW : NW * HEADS); wi0 += nwv) {
        int h; if (uniform) h = bid / nbh; else h = (wi0 / 4) % HEADS;
        if (h != hcur) {
            __syncthreads();
            for (int idx = tid; idx < 128 * 16; idx += 256) {
                const int c = idx >> 4, i4 = (idx & 15) * 4;
                const f32x4 w = ld4(p.g2 + (size_t)c * D_RWKV + h * 64 + i4);
                bf16_t* dst = G2T + i4 * 136 + c;
                dst[0] = f2bf(w[0]); dst[136] = f2bf(w[1]); dst[272] = f2bf(w[2]); dst[408] = f2bf(w[3]);
            }
            hcur = h;
            __syncthreads();
        }
        const int wi = uniform ? wi0 + wave : (wi0 / 4 / HEADS) * 4 + wave;
        if (wi >= NW) continue;
        const int b = wi / NP16, p16 = wi % NP16, pc = p16 >> 1, pl = (p16 & 1) * 16 + l15, pos = pc * RC + pl;
        f32x4 y[4], g[4];
#pragma unroll
        for (int xs = 0; xs < 4; ++xs) { y[xs] = f32x4{0.f, 0.f, 0.f, 0.f}; g[xs] = f32x4{0.f, 0.f, 0.f, 0.f}; }
        float bon = 0.f;
#pragma unroll
        for (int d = 0; d < 2; ++d) {
            const int chain = (b * HEADS + h) * 2 + d, c = NCC + (d ? NLC - 1 - pc : pc), tau = d ? RC - 1 - pl : pl;
            const size_t item = (size_t)chain * NCK + c;
            const unsigned char* chp = CH + item * CH_BYTES;
            const bf16_t* gS = (const bf16_t*)(chp + CH_SA); const bf16_t* gQT = (const bf16_t*)(chp + CH_QT); const bf16_t* gY0 = (const bf16_t*)(chp + CH_Y0);
            bf16x8 yf[2];
#pragma unroll
            for (int ks = 0; ks < 2; ++ks) yf[ks] = *(const bf16x8*)(gQT + tau * 64 + ks * 32 + 8 * q);
#pragma unroll
            for (int xs = 0; xs < 4; ++xs) {
                f32x4 acc = ldb4(gY0 + tau * 64 + xs * 16 + 4 * q);
#pragma unroll
                for (int ks = 0; ks < 2; ++ks) acc = MFMA16(*(const bf16x8*)(gS + (xs * 16 + l15) * 64 + ks * 32 + 8 * q), yf[ks], acc);
                y[xs] += acc;
            }
            bon += RBON[item * RC + tau];
        }
#pragma unroll
        for (int ks = 0; ks < 4; ++ks) {
            float o[8]; shifted8(p, P, 1, b, pos, SEQ, 3 * D_RWKV + 256 + ks * 32 + 8 * q, o);
            u32x4 t; t[0] = pk2(fsigm(o[0]), fsigm(o[1])); t[1] = pk2(fsigm(o[2]), fsigm(o[3])); t[2] = pk2(fsigm(o[4]), fsigm(o[5])); t[3] = pk2(fsigm(o[6]), fsigm(o[7]));
            const bf16x8 sg = __builtin_bit_cast(bf16x8, t);
#pragma unroll
            for (int xs = 0; xs < 4; ++xs) g[xs] = MFMA16(*(const bf16x8*)(G2T + (xs * 16 + l15) * 136 + ks * 32 + 8 * q), sg, g[xs]);
        }
        float s1 = 0.f, s2 = 0.f;
#pragma unroll
        for (int xs = 0; xs < 4; ++xs) { s1 += hsum4(y[xs]); s2 += hsum4(y[xs] * y[xs]); }
        s1 += __shfl_xor(s1, 16); s1 += __shfl_xor(s1, 32); s2 += __shfl_xor(s2, 16); s2 += __shfl_xor(s2, 32);
        const float mu = s1 * (1.0f / 64.0f), var = fmaxf(s2 * (1.0f / 64.0f) - mu * mu, 0.f), rstd = frsq(var + GN_EPS);
        const size_t mrow = rwkv_row(1, b, pos);
        const size_t mprev = pos > 0 ? rwkv_row(1, b, pos - 1) : mrow, mnext = pos < SEQ - 1 ? rwkv_row(1, b, pos + 1) : mrow;
#pragma unroll
        for (int xs = 0; xs < 4; ++xs) {
            const int i0 = xs * 16 + q * 4, chv = 2 * D_RWKV + h * 64 + i0;
            const f32x4 z = ldb4(P + mrow * D_IN + RW0 + chv);
            f32x4 zp = ldb4(P + mprev * D_IN + RW0 + chv), zn = ldb4(P + mnext * D_IN + RW0 + chv);
            if (pos == 0) zp = f32x4{0.f, 0.f, 0.f, 0.f};
            if (pos == SEQ - 1) zn = f32x4{0.f, 0.f, 0.f, 0.f};
            const f32x4 v = z + ld4(p.mu_prev + chv) * (zp - z) + ld4(p.mu_next + chv) * (zn - z);
            const f32x4 yn = (y[xs] - mu) * rstd * ld4(p.gn_g + h * 64 + i0) + ld4(p.gn_b + h * 64 + i0);
            *(U2*)(MIX + mrow * D_MIX + D_LRU + h * 64 + i0) = pack4((yn + bon * v) * g[xs]);
        }
    }
}

__device__ __forceinline__ void phaseJ(const Params& p, int bid, int nblk, char* smem) {
    const bf16_t* MIX = WSP(bf16_t, WS_R3); const bf16_t* WB = WSP(bf16_t, WS_WBOUT);
    bf16_t* YOUT = WSP(bf16_t, WS_R1);
    const float* RINV = WSP(float, WS_RINV);
    constexpr int BM = 32 * MI_J, NTN = D_MODEL / 128, NTM = MLAT / BM;
    constexpr int GM = (NTM % 8 == 0) ? 8 : 1;
    for (int it = xcd_vbid(bid, nblk); it < NTN * NTM; it += nblk) {
        const int mg = it / (GM * NTN), r = it % (GM * NTN), nt = r / GM, mt = mg * GM + (r % GM);
        gemm_tile<MI_J, false>(smem, MIX, D_MIX, nullptr, mt * BM, WB, nullptr, D_MIX, nt * 128, D_MIX, [&](int ml, int nl, f32x4 v, f32x4) {
            *(U2*)(YOUT + (size_t)(mt * BM + ml) * D_MODEL + nt * 128 + nl) = pack4(v);
        }, RINV, D_LRU / 64);
    }
}

constexpr int KUL = D_MODEL + 2;
static_assert((16 * KUL + 4 * 256) * 4 <= SMEM_BYTES && N_EXPERTS <= 16 && MLAT % 16 == 0, "phase K lds");
__device__ __forceinline__ void phaseK(const Params& p, int bid, int nblk, char* smem) {
    const int tid = opaque_tid(), lane = tid & 63, wave = tid >> 6, q = lane >> 4, l15 = lane & 15;
    const float* MOD = WSP(float, WS_MOD); const float* STATS = WSP(float, WS_STATS);
    const bf16_t* YOUT = WSP(bf16_t, WS_R1);
    float* H1 = WSP(float, WS_R5); bf16_t* U2b = WSP(bf16_t, WS_R6); float* AFF = WSP(float, WS_AFF);
    float* UL = (float*)smem;
    float* PL = UL + 16 * KUL;
    for (int rb = bid; rb < MLAT / 16; rb += nblk) {
        __syncthreads();
#pragma unroll 1
        for (int rr = 0; rr < 4; ++rr) {
            const int lr = wave * 4 + rr, row = rb * 16 + lr;
            const float* xr = p.x + (size_t)row * D_MODEL;
            const float* md = MOD + (size_t)(row / SEQ) * 6 * D_MODEL;
            const float mu0 = STATS[row * 2], rs0 = STATS[row * 2 + 1];
            f32x4 v0, v1, v2, v3; float s = 0.f;
#define PK_LOAD(V, J) { const int k = (J) * 256 + lane * 4; \
            V = ALPHA_F * ((ld4(xr + k) - mu0) * rs0 * ld4(p.ln_in_g + k) + ld4(p.ln_in_b + k)) + ld4(md + 2 * D_MODEL + k) * ldb4(YOUT + (size_t)row * D_MODEL + k); s += hsum4(V); }
            PK_LOAD(v0, 0)
            if (NV > 1) PK_LOAD(v1, 1) else v1 = f32x4{0.f, 0.f, 0.f, 0.f};
            if (NV > 2) { PK_LOAD(v2, 2) PK_LOAD(v3, 3) } else { v2 = v1; v3 = v1; }
#undef PK_LOAD
            const float mu = wave_sum(s) * (1.0f / D_MODEL);
            v0 -= mu; float s2 = hsum4(v0 * v0);
            if (NV > 1) { v1 -= mu; s2 += hsum4(v1 * v1); }
            if (NV > 2) { v2 -= mu; v3 -= mu; s2 += hsum4(v2 * v2) + hsum4(v3 * v3); }
            const float rstd = frsq(wave_sum(s2) * (1.0f / D_MODEL) + LN_EPS);
#pragma unroll
            for (int j = 0; j < NV; ++j) {
                const int k = j * 256 + lane * 4;
                const f32x4 vv = (j == 0) ? v0 : (j == 1) ? v1 : (j == 2) ? v2 : v3;
                const f32x4 h = vv * rstd * ld4(p.ln1_g + k) + ld4(p.ln1_b + k);
                *(f32x4*)(H1 + (size_t)row * D_MODEL + k) = h;
                const f32x4 u = h * (1.0f + ld4(md + 4 * D_MODEL + k)) + ld4(md + 3 * D_MODEL + k);
                *(U2*)(U2b + (size_t)row * D_MODEL + k) = pack4(u);
                float* ul = UL + lr * KUL + k;
                *(f32x2_e*)ul = f32x2_e{u[0], u[1]}; *(f32x2_e*)(ul + 2) = f32x2_e{u[2], u[3]};
            }
        }
        __syncthreads();
        {
            f32x4 acc = f32x4{0.f, 0.f, 0.f, 0.f};
            const int kq0 = wave * (D_MODEL / 4);
#pragma unroll 8
            for (int s4 = 0; s4 < D_MODEL / 16; ++s4) {
                const int k = kq0 + s4 * 4 + q;
                const float av = UL[l15 * KUL + k];
                const float bv = (l15 < N_EXPERTS) ? p.w_router[(size_t)k * N_EXPERTS + l15] : 0.f;
                acc = MFMAF32(av, bv, acc);
            }
#pragma unroll
            for (int r = 0; r < 4; ++r) PL[wave * 256 + (q * 4 + r) * 16 + l15] = acc[r];
        }
        __syncthreads();
        {
            const int lr = tid >> 4, e = tid & 15;
            const bool valid = e < N_EXPERTS;
            float lg = PL[tid] + PL[256 + tid] + PL[512 + tid] + PL[768 + tid];
            float mx = valid ? lg : -3.0e38f;
#pragma unroll
            for (int o = 1; o < 16; o <<= 1) mx = fmaxf(mx, __shfl_xor(mx, o));
            const float ex = valid ? expf(lg - mx) : 0.f;
            float den = ex;
#pragma unroll
            for (int o = 1; o < 16; o <<= 1) den += __shfl_xor(den, o);
            if (valid) AFF[(size_t)(rb * 16 + lr) * N_EXPERTS + e] = ex / den;
        }
    }
}

__device__ __forceinline__ int block_sum_int(int v, int* red) {
    const int tid_ = opaque_tid(), lane = tid_ & 63, wave = tid_ >> 6;
#pragma unroll
    for (int o = 1; o < 64; o <<= 1) v += __shfl_xor(v, o);
    __syncthreads();
    if (lane == 0) red[wave] = v;
    __syncthreads();
    return red[0] + red[1] + red[2] + red[3];
}
__device__ __forceinline__ void phaseL(const Params& p, int bid, int nblk, char* smem) {
    const float* AFF = WSP(float, WS_AFF);
    int* IDX = WSP(int, WS_IDX); float* GATE = WSP(float, WS_GATE); int* SLOTOF = WSP(int, WS_SLOT);
    unsigned* vals = (unsigned*)smem;
    int* red = (int*)(vals + SEQ);
    int* wsum = red + 8;
    const int tid = opaque_tid(), lane = tid & 63, wave = tid >> 6;
    constexpr int PER = SEQ / 256;
    {
        constexpr int NL = BATCH * N_EXPERTS;
        const bool spare = nblk > NL + 32;
        if (spare ? (bid >= NL) : true) convert_experts(p, spare ? bid - NL : bid, spare ? nblk - NL : nblk, smem, 0, 2);
        if (spare && bid >= NL) return;
        __syncthreads();
    }
    for (int be = bid; be < BATCH * N_EXPERTS; be += nblk) {
        const int b = be / N_EXPERTS, e = be % N_EXPERTS;
        __syncthreads();
        for (int t = tid; t < SEQ; t += 256) vals[t] = fbits(AFF[((size_t)b * SEQ + t) * N_EXPERTS + e]);
        __syncthreads();
        unsigned lo = 0u, hi = 0x7F800000u;
        while (lo < hi) {
            const unsigned mid = lo + (hi - lo + 1u) / 2u;
            int c = 0;
            for (int t = tid; t < SEQ; t += 256) c += (vals[t] >= mid) ? 1 : 0;
            c = block_sum_int(c, red);
            if (c >= CAP) lo = mid; else hi = mid - 1u;
        }
        const unsigned T = lo;
        int cg = 0, ce = 0;
        for (int q = 0; q < PER; ++q) { const unsigned v = vals[tid * PER + q]; cg += (v > T) ? 1 : 0; ce += (v == T) ? 1 : 0; }
        int pg = cg, pe = ce;
#pragma unroll
        for (int o = 1; o < 64; o <<= 1) { const int a = __shfl_up(pg, o), bb = __shfl_up(pe, o); if (lane >= o) { pg += a; pe += bb; } }
        __syncthreads();
        if (lane == 63) { wsum[wave] = pg; wsum[4 + wave] = pe; }
        __syncthreads();
        int og = 0, oe = 0, totg = 0;
        for (int w = 0; w < 4; ++w) { if (w < wave) { og += wsum[w]; oe += wsum[4 + w]; } totg += wsum[w]; }
        int posg = og + pg - cg, pose = oe + pe - ce;
        const int need_eq = CAP - totg;
        for (int q = 0; q < PER; ++q) {
            const int t = tid * PER + q; const unsigned v = vals[t];
            int slot = -1;
            if (v > T) { slot = posg++; }
            else if (v == T) { if (pose < need_eq) slot = totg + pose; pose++; }
            if (slot >= 0) { IDX[(size_t)be * CAP + slot] = b * SEQ + t; GATE[(size_t)be * CAP + slot] = bitsf(v); }
            SLOTOF[((size_t)b * SEQ + t) * N_EXPERTS + e] = slot;
        }
    }
}

__device__ __forceinline__ void phaseM(const Params& p, int bid, int nblk, char* smem) {
    const bf16_t* U2b = WSP(bf16_t, WS_R6); const int* IDX = WSP(int, WS_IDX);
    bf16_t* HID = WSP(bf16_t, WS_R1);
    constexpr int BM = 32 * MI_E, NTN = D_EXPERT / 64, NTM = CAP / BM;
    for (int it = xcd_vbid(bid, nblk); it < BATCH * N_EXPERTS * NTM * NTN; it += nblk) {
        const int mt = it % NTM, b = (it / NTM) % BATCH, nt = (it / (NTM * BATCH)) % NTN, e = it / (NTM * BATCH * NTN), be = b * N_EXPERTS + e;
        const bf16_t* wg = WSP(bf16_t, WS_WG + (size_t)e * WEXP_BYTES); const bf16_t* wu = WSP(bf16_t, WS_WU + (size_t)e * WEXP_BYTES);
        gemm_tile<MI_E, true>(smem, U2b, D_MODEL, IDX + (size_t)be * CAP, mt * BM, wg, wu, D_MODEL, nt * 64, D_MODEL, [&](int ml, int nl, f32x4 g, f32x4 u) {
            U2 o; o.x = pk2(siluf_(g[0]) * u[0], siluf_(g[1]) * u[1]); o.y = pk2(siluf_(g[2]) * u[2], siluf_(g[3]) * u[3]);
            *(U2*)(HID + ((size_t)be * CAP + mt * BM + ml) * D_EXPERT + nt * 64 + nl) = o;
        });
    }
    {
        constexpr int NT = BATCH * N_EXPERTS * NTM * NTN;
        const int rem = NT % nblk, vb = xcd_vbid(bid, nblk);
        if (rem == 0 || nblk - rem < 32) convert_experts(p, vb, nblk, smem, 2, 3);
        else if (vb >= rem) convert_experts(p, vb - rem, nblk - rem, smem, 2, 3);
    }
}
__device__ __forceinline__ void phaseN(const Params& p, int bid, int nblk, char* smem) {
    const bf16_t* HID = WSP(bf16_t, WS_R1); const float* GATE = WSP(float, WS_GATE);
    bf16_t* YS = WSP(bf16_t, WS_R2);
    constexpr int BM = 32 * MI_E, NTN = D_MODEL / 128, NTM = CAP / BM;
    for (int it = xcd_vbid(bid, nblk); it < BATCH * N_EXPERTS * NTM * NTN; it += nblk) {
        const int mt = it % NTM, b = (it / NTM) % BATCH, nt = (it / (NTM * BATCH)) % NTN, e = it / (NTM * BATCH * NTN), be = b * N_EXPERTS + e;
        const bf16_t* wd = WSP(bf16_t, wdown_off(e));
        gemm_tile<MI_E, false>(smem, HID + (size_t)be * CAP * D_EXPERT, D_EXPERT, nullptr, mt * BM, wd, nullptr, D_EXPERT, nt * 128, D_EXPERT, [&](int ml, int nl, f32x4 v, f32x4) {
            const int slot = mt * BM + ml;
            const float gt = GATE[(size_t)be * CAP + slot];
            *(U2*)(YS + ((size_t)be * CAP + slot) * D_MODEL + nt * 128 + nl) = pack4(v * gt);
        });
    }
}
__device__ __forceinline__ void phaseO(const Params& p, int bid, int nblk, char* smem) {
    const int tid_ = opaque_tid(), lane = tid_ & 63, wave = tid_ >> 6;
    const float* MOD = WSP(float, WS_MOD); const float* H1 = WSP(float, WS_R5); const bf16_t* YS = WSP(bf16_t, WS_R2); const int* SLOTOF = WSP(int, WS_SLOT);
    int row = bid * 4 + wave;
    f32x4 n0 = f32x4{0.f, 0.f, 0.f, 0.f}, n1 = n0, n2 = n0, n3 = n0; int nslot = -1;
    if (row < MLAT) { const float* hr = H1 + (size_t)row * D_MODEL; n0 = ld4(hr + lane * 4); if (NV > 1) n1 = ld4(hr + 256 + lane * 4); if (NV > 2) { n2 = ld4(hr + 512 + lane * 4); n3 = ld4(hr + 768 + lane * 4); }
                      nslot = (lane < N_EXPERTS) ? SLOTOF[(size_t)row * N_EXPERTS + lane] : -1; }
    for (; row < MLAT; row += nblk * 4) {
        const float* md = MOD + (size_t)(row / SEQ) * 6 * D_MODEL;
        const f32x4 h0 = n0, h1 = n1, h2 = n2, h3 = n3; const int myslot = nslot;
        const int nrow = row + nblk * 4;
        if (nrow < MLAT) { const float* hr = H1 + (size_t)nrow * D_MODEL; n0 = ld4(hr + lane * 4); if (NV > 1) n1 = ld4(hr + 256 + lane * 4); if (NV > 2) { n2 = ld4(hr + 512 + lane * 4); n3 = ld4(hr + 768 + lane * 4); }
                           nslot = (lane < N_EXPERTS) ? SLOTOF[(size_t)nrow * N_EXPERTS + lane] : -1; }
        f32x4 y0 = f32x4{0.f, 0.f, 0.f, 0.f}, y1 = y0, y2 = y0, y3 = y0;
        const int bbase = (row / SEQ) * N_EXPERTS;
        for (int e = 0; e < N_EXPERTS; ++e) {
            const int sl = __shfl(myslot, e);
            if (sl >= 0) {
                const bf16_t* yr = YS + ((size_t)(bbase + e) * CAP + sl) * D_MODEL + lane * 4;
                y0 += ldb4(yr);
                if (NV > 1) y1 += ldb4(yr + 256);
                if (NV > 2) { y2 += ldb4(yr + 512); y3 += ldb4(yr + 768); }
            }
        }
        f32x4 v0, v1, v2, v3; float s = 0.f;
        v0 = ALPHA_F * h0 + ld4(md + 5 * D_MODEL + lane * 4) * y0; s += hsum4(v0);
        if (NV > 1) { v1 = ALPHA_F * h1 + ld4(md + 5 * D_MODEL + 256 + lane * 4) * y1; s += hsum4(v1); } else v1 = f32x4{0.f, 0.f, 0.f, 0.f};
        if (NV > 2) { v2 = ALPHA_F * h2 + ld4(md + 5 * D_MODEL + 512 + lane * 4) * y2; v3 = ALPHA_F * h3 + ld4(md + 5 * D_MODEL + 768 + lane * 4) * y3; s += hsum4(v2) + hsum4(v3); } else { v2 = v1; v3 = v1; }
        const float mu = wave_sum(s) * (1.0f / D_MODEL);
        v0 -= mu; float s2 = hsum4(v0 * v0);
        if (NV > 1) { v1 -= mu; s2 += hsum4(v1 * v1); }
        if (NV > 2) { v2 -= mu; v3 -= mu; s2 += hsum4(v2 * v2) + hsum4(v3 * v3); }
        const float rstd = frsq(wave_sum(s2) * (1.0f / D_MODEL) + LN_EPS);
#pragma unroll
        for (int j = 0; j < NV; ++j) {
            const int k = j * 256 + lane * 4;
            const f32x4 vv = (j == 0) ? v0 : (j == 1) ? v1 : (j == 2) ? v2 : v3;
            *(f32x4*)(p.out + (size_t)row * D_MODEL + k) = vv * rstd * ld4(p.ln2_g + k) + ld4(p.ln2_b + k);
        }
    }
}

#define XB_TMO      128
#define XB_XCNT(j)  (256  + 64 * (j))
#define XB_XSUB(j)  (1280 + 64 * (j))
#define XB_XGEN(j)  (2304 + 64 * (j))
#define XB_TOP      3328
#define XB_TOPGEN   3392
#define XCD_BAR_WORDS 3456
#define XB_SPIN_CAP (1u << 22)
#ifndef HOST_EMU
__device__ __forceinline__ unsigned xb_ld(unsigned* p) { return __hip_atomic_load(p, __ATOMIC_RELAXED, __HIP_MEMORY_SCOPE_AGENT); }
__device__ __forceinline__ unsigned xb_add(unsigned* p, unsigned v) { return __hip_atomic_fetch_add(p, v, __ATOMIC_RELAXED, __HIP_MEMORY_SCOPE_AGENT); }
__device__ __forceinline__ unsigned xb_xcc_id() { return (unsigned)__builtin_amdgcn_s_getreg((3 << 11) | 20) & 0xFu; }
#define XB_SPIN(cond, bar) do { unsigned _sp = 0; while (cond) { __builtin_amdgcn_s_sleep(1); \
    if ((++_sp & 255u) == 0u) { if (xb_ld(&(bar)[XB_TMO])) break; if (_sp > XB_SPIN_CAP) { atomicAdd(&(bar)[XB_TMO], 1u); break; } } } } while (0)
#define XB_LAS __attribute__((address_space(3)))
struct XcdBarrier { unsigned off; unsigned x; volatile XB_LAS unsigned* st; unsigned G; };
__device__ __forceinline__ XcdBarrier xcd_barrier_post(unsigned* ctrl, unsigned off, volatile XB_LAS unsigned* st, unsigned G, bool member = true) {
    XcdBarrier b; b.off = off; b.x = xb_xcc_id(); b.st = st; b.G = G; unsigned* bar = ctrl + off;
    if (!member) return b;
    if (threadIdx.x == 0) (void)xb_add(&bar[XB_XCNT(b.x)], 1u);
    return b;
}
__device__ __forceinline__ void xcd_barrier_complete(unsigned* bar, unsigned x, unsigned& nloc, unsigned& nx, unsigned G) {
    unsigned sum, cnt, mine, sp = 0u;
    for (;;) {
        sum = 0u; cnt = 0u; mine = 0u;
#pragma unroll
        for (unsigned j = 0; j < 16; ++j) { const unsigned c = xb_ld(&bar[XB_XCNT(j)]); sum += c; cnt += (c > 0u) ? 1u : 0u; mine = (j == x) ? c : mine; }
        if (sum == G) break;
        __builtin_amdgcn_s_sleep(1);
        if ((++sp & 255u) == 0u) { if (xb_ld(&bar[XB_TMO])) break; if (sp > XB_SPIN_CAP) { atomicAdd(&bar[XB_TMO], 1u); break; } }
    }
    nloc = mine > 0u ? mine : 1u; nx = cnt > 0u ? cnt : 1u;
}
__device__ __forceinline__ void grid_barrier(const XcdBarrier& b, unsigned* ctrl) {
    asm volatile("s_waitcnt vmcnt(0)" ::: "memory");
    __syncthreads();
    if (threadIdx.x == 0) {
        unsigned* bar = ctrl + b.off;
        __builtin_amdgcn_s_waitcnt(0);
        volatile XB_LAS unsigned* st = b.st;
        unsigned nloc = st[0], nx = st[1];
        if (nloc == 0u) { xcd_barrier_complete(bar, b.x, nloc, nx, b.G); st[0] = nloc; st[1] = nx; }
        const unsigned old = xb_add(&bar[XB_XSUB(b.x)], 1u);
        const unsigned gen = old / nloc;
        if (old + 1u == (gen + 1u) * nloc) {
            __builtin_amdgcn_fence(__ATOMIC_RELEASE, "agent");
            asm volatile("s_waitcnt vmcnt(0)" ::: "memory");
            const unsigned og = xb_add(&bar[XB_TOP], 1u);
            const unsigned tg = og / nx;
            if (og + 1u == (tg + 1u) * nx) xb_add(&bar[XB_TOPGEN], 1u);
            else XB_SPIN(xb_ld(&bar[XB_TOPGEN]) == tg, bar);
            __builtin_amdgcn_fence(__ATOMIC_ACQUIRE, "agent");
            xb_add(&bar[XB_XGEN(b.x)], 1u);
            asm volatile("s_waitcnt vmcnt(0)" ::: "memory");
        } else {
            XB_SPIN(xb_ld(&bar[XB_XGEN(b.x)]) == gen, bar);
            __builtin_amdgcn_fence(__ATOMIC_ACQUIRE, "agent");
            asm volatile("s_waitcnt vmcnt(0)" ::: "memory");
        }
    }
    __syncthreads();
}
#else
struct XcdBarrier { int dummy; };
__device__ __forceinline__ void grid_barrier(const XcdBarrier&, unsigned*) { __syncthreads(); }
#endif

__global__ void __launch_bounds__(256, 2) fused_forward(Params p) {
    __shared__ __attribute__((aligned(16))) char smem[SMEM_BYTES];
    __shared__ __attribute__((aligned(16))) unsigned xb_words[4];
    if (threadIdx.x == 0) { xb_words[0] = 0u; xb_words[1] = 0u; xb_words[2] = 0u; xb_words[3] = 0u; }
    __syncthreads();
    const int bid = blockIdx.x, nblk = gridDim.x;
    const bool split = nblk >= 2 * NCHAIN;
#ifdef HOST_EMU
    const XcdBarrier gb{0}; const XcdBarrier gs{0};
#else
    const XcdBarrier gb = xcd_barrier_post(WSP(unsigned, WS_CTRL), 0u, (volatile XB_LAS unsigned*)xb_words, (unsigned)nblk);
    const XcdBarrier gs = xcd_barrier_post(WSP(unsigned, WS_CTRL), (unsigned)XCD_BAR_WORDS, (volatile XB_LAS unsigned*)xb_words + 2, (unsigned)(nblk - NCHAIN), split && bid >= NCHAIN);
#endif
    phaseA(p, bid, nblk, smem); grid_barrier(gb, WSP(unsigned, WS_CTRL));
    phaseB(p, bid, nblk, smem); grid_barrier(gb, WSP(unsigned, WS_CTRL));
    phaseC(p, bid, nblk, smem); grid_barrier(gb, WSP(unsigned, WS_CTRL));
    phaseR1(p, bid, nblk, smem); grid_barrier(gb, WSP(unsigned, WS_CTRL));
    {
        const int lb = split ? bid - NCHAIN : bid, ln = split ? nblk - NCHAIN : nblk;
        const bool lru_member = !split || bid >= NCHAIN;
        if (!split || bid < NCHAIN) phaseR2(p, bid, split ? NCHAIN : nblk, smem);
        if (lru_member) phaseD(p, lb, ln, smem);
        if (split) { if (lru_member) grid_barrier(gs, WSP(unsigned, WS_CTRL)); } else grid_barrier(gb, WSP(unsigned, WS_CTRL));
        if (lru_member) phaseE(p, lb, ln, smem);
        if (split) { if (lru_member) grid_barrier(gs, WSP(unsigned, WS_CTRL)); } else grid_barrier(gb, WSP(unsigned, WS_CTRL));
        if (lru_member) phaseF(p, lb, ln, smem);
        grid_barrier(gb, WSP(unsigned, WS_CTRL));
    }
    phaseR3(p, bid, nblk, smem); grid_barrier(gb, WSP(unsigned, WS_CTRL));
    phaseJ(p, bid, nblk, smem); grid_barrier(gb, WSP(unsigned, WS_CTRL));
    phaseK(p, bid, nblk, smem); grid_barrier(gb, WSP(unsigned, WS_CTRL));
    phaseL(p, bid, nblk, smem); grid_barrier(gb, WSP(unsigned, WS_CTRL));
    phaseM(p, bid, nblk, smem); grid_barrier(gb, WSP(unsigned, WS_CTRL));
    phaseN(p, bid, nblk, smem); grid_barrier(gb, WSP(unsigned, WS_CTRL));
    phaseO(p, bid, nblk, smem);
}

#ifdef MULTI_LAUNCH
#define PHASE_KERNEL(NAME) \
    __global__ void __launch_bounds__(256) k_##NAME(Params p) { __shared__ __attribute__((aligned(16))) char smem[SMEM_BYTES]; NAME(p, blockIdx.x, gridDim.x, smem); }
PHASE_KERNEL(phaseA) PHASE_KERNEL(phaseB) PHASE_KERNEL(phaseC) PHASE_KERNEL(phaseD) PHASE_KERNEL(phaseE) PHASE_KERNEL(phaseF) PHASE_KERNEL(phaseR1) PHASE_KERNEL(phaseR2) PHASE_KERNEL(phaseR3)
PHASE_KERNEL(phaseJ) PHASE_KERNEL(phaseK) PHASE_KERNEL(phaseL) PHASE_KERNEL(phaseM) PHASE_KERNEL(phaseN) PHASE_KERNEL(phaseO)
#ifdef HOST_EMU
void emu_hook(const char* name, const Params& p);
#define LAUNCH(NAME, grid) do { EMU_LAUNCH(k_##NAME, grid, 256, p); emu_hook(#NAME, p); } while (0)
#else
#define LAUNCH(NAME, grid) hipLaunchKernelGGL(k_##NAME, dim3(grid), dim3(256), 0, stream, p)
#endif
#endif

extern "C" void kernel_launch(void* const* d_in, const int* in_sizes, int n_in, void* d_out, int out_size, void* d_ws, size_t ws_size, hipStream_t stream) {
    if (n_in != 38 || out_size != MLAT * D_MODEL || ws_size < WS_END) { fprintf(stderr, "kernel_launch: unexpected shapes (n_in %d out %d ws %zu need %zu)\n", n_in, out_size, ws_size, (size_t)WS_END); return; }
    Params p{};
    const float** f = (const float**)&p;
    for (int i = 0; i < 38; ++i) f[i] = (const float*)d_in[i];
    p.out = (float*)d_out; p.ws = (unsigned char*)d_ws;
#ifdef MULTI_LAUNCH
    const int G = 512;
    LAUNCH(phaseA, 6 * D_MODEL / 16);
    LAUNCH(phaseB, G);
    LAUNCH(phaseC, G);
    LAUNCH(phaseD, G);
    LAUNCH(phaseE, 16);
    LAUNCH(phaseF, G);
    LAUNCH(phaseR1, G);
    LAUNCH(phaseR2, NCHAIN);
    LAUNCH(phaseR3, G);
    LAUNCH(phaseJ, G);
    LAUNCH(phaseK, G);
    LAUNCH(phaseL, BATCH * N_EXPERTS);
    LAUNCH(phaseM, G);
    LAUNCH(phaseN, G);
    LAUNCH(phaseO, G);
#elif defined(HOST_EMU)
    EMU_LAUNCH(fused_forward, 1, 256, p);
#else
    static int grid_blocks = 0;
    if (!grid_blocks) {
        int dev = 0, cus = 0, per_cu = 0;
        (void)hipGetDevice(&dev);
        (void)hipDeviceGetAttribute(&cus, hipDeviceAttributeMultiprocessorCount, dev);
        (void)hipOccupancyMaxActiveBlocksPerMultiprocessor(&per_cu, fused_forward, 256, 0);
        if (per_cu > 2) per_cu = 2;
        if (per_cu < 1) { fprintf(stderr, "kernel_launch: occupancy query returned %d blocks per CU\n", per_cu); per_cu = 1; }
        grid_blocks = cus * per_cu;
    }
    (void)hipMemsetAsync((char*)d_ws + WS_CTRL, 0, 2 * XCD_BAR_WORDS * 4, stream);
    void* args[] = {&p};
    hipError_t e = hipLaunchCooperativeKernel((void*)fused_forward, dim3(grid_blocks), dim3(256), args, 0, stream);
    if (e != hipSuccess) fprintf(stderr, "cooperative launch failed: %s (grid %d)\n", hipGetErrorString(e), grid_blocks);
#endif
}
```

```cpp
#ifndef HOST_EMU
#include <hip/hip_runtime.h>
#include <cstdio>
#endif
#include <cstdint>
#include <cstddef>

#ifdef CFG_SMALL
constexpr int D_MODEL = 256, BATCH = 2, SEQ = 256, GRID_W = 16, CTX_LEN = 64, LRU_BLOCKS = 2, N_EXPERTS = 4, D_EXPERT = 256;
#else
constexpr int D_MODEL = 1024, BATCH = 4, SEQ = 4096, GRID_W = 64, CTX_LEN = 256, LRU_BLOCKS = 8, N_EXPERTS = 16, D_EXPERT = 1408;
#endif
constexpr int ROWS = SEQ / GRID_W;
constexpr int D_LRU = D_MODEL / 2, LRU_BLOCK = 64;
constexpr int D_RWKV = D_MODEL / 2, HEADS = D_RWKV / 64;
constexpr int D_RWKV_IN = 3 * D_RWKV + 128 + 128 + 128;
constexpr int D_IN = 2 * D_LRU + D_RWKV_IN;
constexpr int D_MIX = D_LRU + D_RWKV;
constexpr int CAP = 2 * SEQ / N_EXPERTS;
constexpr int MLAT = BATCH * SEQ, MCTX = BATCH * CTX_LEN, MTOT = MLAT + MCTX;
constexpr int NMOD = BATCH + 1;
constexpr int RW0 = 2 * D_LRU;
constexpr float ALPHA_F = 1.189207115002721f;
constexpr float LN_EPS = 1e-5f, GN_EPS = 64e-5f, RMS_EPS = 1e-6f;
static_assert(LRU_BLOCKS * LRU_BLOCK == D_LRU, "lru blocks");
static_assert(CAP % 128 == 0 && D_IN % 128 == 0 && D_EXPERT % 64 == 0 && D_MODEL % 128 == 0 && MTOT % 128 == 0 && D_MIX % 64 == 0, "tile divisibility");

typedef unsigned short bf16_t;
typedef short bf16x8 __attribute__((ext_vector_type(8)));
typedef float f32x4 __attribute__((ext_vector_type(4)));
typedef unsigned u32x4 __attribute__((ext_vector_type(4)));
typedef float f32x2_e __attribute__((ext_vector_type(2)));
typedef unsigned U2 __attribute__((ext_vector_type(2)));

#ifdef HOST_EMU
#define MFMA16(a, b, c) emu_mfma_16x16x32_bf16(a, b, c)
#define MFMAF32(a, b, c) emu_mfma_16x16x4_f32(a, b, c)
#else
#define MFMA16(a, b, c) __builtin_amdgcn_mfma_f32_16x16x32_bf16(a, b, c, 0, 0, 0)
#define MFMAF32(a, b, c) __builtin_amdgcn_mfma_f32_16x16x4f32(a, b, c, 0, 0, 0)
#endif

__device__ __forceinline__ unsigned fbits(float f) { return __builtin_bit_cast(unsigned, f); }
__device__ __forceinline__ float bitsf(unsigned u) { return __builtin_bit_cast(float, u); }
__device__ __forceinline__ bf16_t f2bf(float f) { unsigned u = fbits(f); u += 0x7FFFu + ((u >> 16) & 1u); return (bf16_t)(u >> 16); }
__device__ __forceinline__ float bf2f(bf16_t h) { return bitsf(((unsigned)h) << 16); }
#ifdef HOST_EMU
__device__ __forceinline__ unsigned pk2(float lo, float hi) { return (unsigned)f2bf(lo) | ((unsigned)f2bf(hi) << 16); }
#else
typedef float f32x2_t __attribute__((ext_vector_type(2)));
typedef __bf16 bf16x2_t __attribute__((ext_vector_type(2)));
__device__ __forceinline__ unsigned pk2(float lo, float hi) { return __builtin_bit_cast(unsigned, __builtin_convertvector(f32x2_t{lo, hi}, bf16x2_t)); }
#endif
__device__ __forceinline__ float softplusf_(float x) { return fmaxf(x, 0.0f) + log1pf(expf(-fabsf(x))); }
#ifdef HOST_EMU
#define FEXP(x) expf(x)
#else
#define FEXP(x) __expf(x)
#endif
#ifdef HOST_EMU
__device__ __forceinline__ float frcp(float x) { return 1.0f / x; }
__device__ __forceinline__ float frsq(float x) { return 1.0f / sqrtf(x); }
__device__ __forceinline__ float fsqrt(float x) { return sqrtf(x); }
#else
__device__ __forceinline__ float frcp(float x) { return __builtin_amdgcn_rcpf(x); }
__device__ __forceinline__ float frsq(float x) { return __builtin_amdgcn_rsqf(x); }
__device__ __forceinline__ float fsqrt(float x) { return __builtin_amdgcn_sqrtf(x); }
#endif
__device__ __forceinline__ float fsigm(float x) { return frcp(1.0f + FEXP(-x)); }
__device__ __forceinline__ float siluf_(float x) { return x * fsigm(x); }
__device__ __forceinline__ float geluf_(float x) { return x * fsigm(1.5957691216057308f * (x + 0.044715f * x * x * x)); }
__device__ __forceinline__ int opaque_tid() {
    int t = threadIdx.x;
#ifndef HOST_EMU
    asm volatile("" : "+v"(t));
#endif
    return t;
}
__device__ __forceinline__ float wave_sum(float v) {
#pragma unroll
    for (int o = 1; o < 64; o <<= 1) v += __shfl_xor(v, o);
    return v;
}

constexpr size_t al256(size_t x) { return (x + 255) & ~(size_t)255; }
constexpr int NLCH = BATCH * (SEQ / 64), NCCH = BATCH * (CTX_LEN / 64), NCH = NLCH + NCCH;
constexpr int R1_POOL_WORD = 8192;
constexpr size_t CTRL_ZERO_BYTES = (R1_POOL_WORD + 64) * 4;
constexpr size_t WS_CTRL = 0;
constexpr size_t WS_MOD = 65536;
constexpr size_t WS_STATS = al256(WS_MOD + (size_t)NMOD * 6 * D_MODEL * 4);
constexpr size_t WS_SUMA = al256(WS_STATS + (size_t)MTOT * 2 * 4);
constexpr size_t WS_SUMH = al256(WS_SUMA + (size_t)2 * NCH * D_LRU * 4);
constexpr size_t WS_CARRY = al256(WS_SUMH + (size_t)2 * NCH * D_LRU * 4);
constexpr size_t WS_SSQP = al256(WS_CARRY + (size_t)2 * NLCH * D_LRU * 4);
constexpr size_t WS_RINV = al256(WS_SSQP + (size_t)MLAT * LRU_BLOCKS * 4);
constexpr size_t WS_BON = al256(WS_RINV + (size_t)MLAT * 4);
constexpr size_t WS_AFF = al256(WS_BON + (size_t)2 * MLAT * HEADS * 4 + 4096 * 64);
constexpr size_t WS_IDX = al256(WS_AFF + (size_t)MLAT * N_EXPERTS * 4);
constexpr size_t WS_GATE = al256(WS_IDX + (size_t)BATCH * N_EXPERTS * CAP * 4);
constexpr size_t WS_SLOT = al256(WS_GATE + (size_t)BATCH * N_EXPERTS * CAP * 4);
constexpr size_t WS_WBIN = al256(WS_SLOT + (size_t)MLAT * N_EXPERTS * 4);
constexpr size_t WS_WBOUT = al256(WS_WBIN + (size_t)D_IN * D_MODEL * 2);
constexpr size_t WS_LORA = al256(WS_WBOUT + (size_t)D_MODEL * D_MIX * 2);
constexpr size_t WS_R1 = al256(WS_LORA + (size_t)2 * 2 * HEADS * 64 * 64 * 2);
constexpr size_t R1_BYTES = (size_t)MTOT * D_IN * 2 > (size_t)MLAT * D_MODEL * 4 ? ((size_t)MTOT * D_IN * 2 > (size_t)BATCH * N_EXPERTS * CAP * D_EXPERT * 2 ? (size_t)MTOT * D_IN * 2 : (size_t)BATCH * N_EXPERTS * CAP * D_EXPERT * 2)
                                                                                  : ((size_t)MLAT * D_MODEL * 4 > (size_t)BATCH * N_EXPERTS * CAP * D_EXPERT * 2 ? (size_t)MLAT * D_MODEL * 4 : (size_t)BATCH * N_EXPERTS * CAP * D_EXPERT * 2);
constexpr size_t WS_R3 = al256(WS_R1 + R1_BYTES);
constexpr int RC = 32;
constexpr int NCC = CTX_LEN / RC, NLC = SEQ / RC, NCK = NCC + NLC, NCHAIN = BATCH * HEADS * 2;
constexpr size_t CH_PM = 0, CH_SA = 8192, CH_QT = 16384, CH_Y0 = 20480, CH_BYTES = 24576;
constexpr size_t WS_CH = al256(WS_R3 + (size_t)MTOT * D_MODEL * 2);
constexpr size_t CH_TOTAL = (size_t)NCHAIN * NCK * CH_BYTES;
constexpr size_t WS_R5 = WS_CH;
constexpr size_t WS_LA = al256(WS_R5 + (size_t)MLAT * D_MODEL * 4);
constexpr size_t WS_R6 = WS_LA, WS_R2 = WS_LA;
constexpr size_t WEXP_BYTES = (size_t)D_MODEL * D_EXPERT * 2;
constexpr size_t WS_WG = al256(WS_LA + (size_t)MLAT * D_MODEL * 2);
constexpr size_t WS_WU = WS_WG + (size_t)N_EXPERTS * WEXP_BYTES;
constexpr int NE_R3 = ((size_t)MTOT * D_MODEL * 2 / WEXP_BYTES) < (size_t)N_EXPERTS ? (int)((size_t)MTOT * D_MODEL * 2 / WEXP_BYTES) : N_EXPERTS;
constexpr size_t WS_WD2 = WS_WU + (size_t)N_EXPERTS * WEXP_BYTES;
constexpr size_t WS_LATE_END = al256(WS_WD2 + (size_t)(N_EXPERTS - NE_R3) * WEXP_BYTES);
static_assert(WS_LA + (size_t)BATCH * N_EXPERTS * CAP * D_MODEL * 2 <= WS_WD2, "YS must not reach the w_down copies");
constexpr size_t WS_END = (WS_CH + CH_TOTAL > WS_LATE_END) ? al256(WS_CH + CH_TOTAL) : WS_LATE_END;
constexpr size_t WS_RBON = WS_BON;
static_assert((size_t)NCHAIN * NCK * RC * 4 <= (size_t)2 * MLAT * HEADS * 4 + 4096 * 64, "bonus buffer");

struct Params {
    const float *x, *c, *ctx, *c_ctx, *ln_in_g, *ln_in_b, *w_mod, *b_mod, *w_in, *lru_conv_w, *lru_conv_b, *lru_wa, *lru_ba, *lru_wx, *lru_bx, *lru_lam, *lru_norm_g,
        *mu_prev, *mu_next, *w0, *w2, *a0, *a2, *g2, *k_k, *k_a, *r_k, *gn_g, *gn_b, *w_out, *ln1_g, *ln1_b, *w_router, *w_gate, *w_up, *w_down, *ln2_g, *ln2_b;
    float* out;
    unsigned char* ws;
};
#define WSP(T, off) ((T*)(p.ws + (off)))
__device__ __forceinline__ size_t wdown_off(int e) { return e < NE_R3 ? WS_R3 + (size_t)e * WEXP_BYTES : WS_WD2 + (size_t)(e - NE_R3) * WEXP_BYTES; }

constexpr int SMEM_BYTES = 76 * 1024;

__device__ __forceinline__ f32x4 ld4(const float* p) { return *(const f32x4*)p; }
__device__ __forceinline__ f32x4 ldb4(const bf16_t* p) { const U2 u = *(const U2*)p; return f32x4{bitsf(u.x << 16), bitsf(u.x & 0xFFFF0000u), bitsf(u.y << 16), bitsf(u.y & 0xFFFF0000u)}; }
__device__ __forceinline__ float hsum4(f32x4 v) { return (v[0] + v[1]) + (v[2] + v[3]); }
__device__ __forceinline__ U2 pack4(f32x4 v) { U2 o; o.x = pk2(v[0], v[1]); o.y = pk2(v[2], v[3]); return o; }
__device__ __forceinline__ void convert_transpose(const float* src, bf16_t* dst, int K, int N, int t0, int t1, int tstride, char* smem) {
    float* T = (float*)smem;
    const int tid = opaque_tid(), r = tid >> 4, c4 = (tid & 15) * 4, ntn = N / 64;
    f32x4 v[4];
    if (t0 < t1) { const int kt = t0 / ntn, nt = t0 % ntn;
#pragma unroll
        for (int j = 0; j < 4; ++j) v[j] = ld4(src + (size_t)(kt * 64 + r + 16 * j) * N + nt * 64 + c4); }
    for (int t = t0; t < t1; t += tstride) {
        const int kt = t / ntn, nt = t % ntn;
        __syncthreads();
#pragma unroll
        for (int j = 0; j < 4; ++j) { float* d = T + (r + 16 * j) * 65 + c4; d[0] = v[j][0]; d[1] = v[j][1]; d[2] = v[j][2]; d[3] = v[j][3]; }
        __syncthreads();
        if (t + tstride < t1) { const int kt2 = (t + tstride) / ntn, nt2 = (t + tstride) % ntn;
#pragma unroll
            for (int j = 0; j < 4; ++j) v[j] = ld4(src + (size_t)(kt2 * 64 + r + 16 * j) * N + nt2 * 64 + c4); }
        const int n = tid >> 2, kc = (tid & 3) * 16;
        u32x4 o0, o1;
#pragma unroll
        for (int i = 0; i < 4; ++i) { o0[i] = pk2(T[(kc + 2 * i) * 65 + n], T[(kc + 2 * i + 1) * 65 + n]); o1[i] = pk2(T[(kc + 8 + 2 * i) * 65 + n], T[(kc + 9 + 2 * i) * 65 + n]); }
        bf16_t* d = dst + (size_t)(nt * 64 + n) * K + kt * 64 + kc;
        *(u32x4*)d = o0; *(u32x4*)(d + 8) = o1;
    }
    __syncthreads();
}
__device__ void convert_experts(const Params& p, int vb, int nvb, char* smem, int first, int last) {
    constexpr int TPM = (D_MODEL / 64) * (D_EXPERT / 64);
    int m = 0;
    for (int e = 0; e < N_EXPERTS; ++e)
        for (int which = first; which < last; ++which, ++m) {
            const float* src = (which == 0 ? p.w_gate : which == 1 ? p.w_up : p.w_down) + (size_t)e * D_MODEL * D_EXPERT;
            bf16_t* dst = which == 0 ? WSP(bf16_t, WS_WG + (size_t)e * WEXP_BYTES) : which == 1 ? WSP(bf16_t, WS_WU + (size_t)e * WEXP_BYTES) : WSP(bf16_t, wdown_off(e));
            const int K = which == 2 ? D_EXPERT : D_MODEL, N = which == 2 ? D_MODEL : D_EXPERT;
            const int start = ((vb - (m * TPM) % nvb) % nvb + nvb) % nvb;
            convert_transpose(src, dst, K, N, start, TPM, nvb, smem);
        }
}

__device__ __forceinline__ void phaseA(const Params& p, int bid, int nblk, char* smem) {
    float* sc = (float*)smem;
    float* red = sc + NMOD * D_MODEL;
    const int tid = opaque_tid();
    constexpr int NA = 6 * D_MODEL / 16;
    {
        const bool spare = nblk > NA + 32;
        const int vb = spare ? bid - NA : bid, nvb = spare ? nblk - NA : nblk;
        if (!spare || bid >= NA) {
            constexpr int T1 = (D_MODEL / 64) * (D_IN / 64), T2 = (D_MIX / 64) * (D_MODEL / 64);
            convert_transpose(p.w_in, WSP(bf16_t, WS_WBIN), D_MODEL, D_IN, vb, T1, nvb, smem);
            convert_transpose(p.w_out, WSP(bf16_t, WS_WBOUT), D_MIX, D_MODEL, ((vb - T1 % nvb) % nvb + nvb) % nvb, T2, nvb, smem);
            for (int idx = vb * 256 + tid; idx < 2 * 2 * HEADS * 64 * 64; idx += nvb * 256) {
                const int i = idx & 63, j = (idx >> 6) & 63, hh = (idx >> 12) % HEADS, which = (idx >> 12) / HEADS % 2, dd = (idx >> 12) / HEADS / 2;
                WSP(bf16_t, WS_LORA)[idx] = f2bf((which ? p.a2 : p.w2)[((size_t)dd * 64 + i) * D_RWKV + hh * 64 + j]);
            }
        }
        if (spare && bid >= NA) return;
    }
    if (bid >= NA) return;
    __syncthreads();
    for (int i = tid; i < NMOD * D_MODEL; i += 256) {
        const int r = i / D_MODEL, k = i % D_MODEL;
        const float v = (r < BATCH) ? p.c[r * D_MODEL + k] : p.c_ctx[k];
        sc[i] = siluf_(v);
    }
    __syncthreads();
    float* MOD = WSP(float, WS_MOD);
    const int col = tid & 15, kg = tid >> 4;
    constexpr int KPT = D_MODEL / 16;
    for (int cb = bid; cb < 6 * D_MODEL / 16; cb += nblk) {
        const int n = cb * 16 + col;
        float acc[NMOD];
#pragma unroll
        for (int r = 0; r < NMOD; ++r) acc[r] = 0.f;
        const float* wp = p.w_mod + (size_t)(kg * KPT) * (6 * D_MODEL) + n;
#pragma unroll 16
        for (int kk = 0; kk < KPT; ++kk) {
            const float w = wp[(size_t)kk * (6 * D_MODEL)];
#pragma unroll
            for (int r = 0; r < NMOD; ++r) acc[r] += sc[r * D_MODEL + kg * KPT + kk] * w;
        }
#pragma unroll
        for (int r = 0; r < NMOD; ++r) red[(kg * NMOD + r) * 16 + col] = acc[r];
        __syncthreads();
        if (tid < NMOD * 16) {
            const int r = tid >> 4, c2 = tid & 15;
            float s2 = p.b_mod[cb * 16 + c2];
#pragma unroll
            for (int g = 0; g < 16; ++g) s2 += red[(g * NMOD + r) * 16 + c2];
            MOD[(size_t)r * 6 * D_MODEL + cb * 16 + c2] = s2;
        }
        __syncthreads();
    }
}

constexpr int NV = D_MODEL / 256;
__device__ __forceinline__ void phaseB(const Params& p, int bid, int nblk, char* smem) {
    const int tid_ = opaque_tid(), lane = tid_ & 63, wave = tid_ >> 6;
    const float* MOD = WSP(float, WS_MOD);
    float* STATS = WSP(float, WS_STATS);
    bf16_t* U = WSP(bf16_t, WS_R3);
    auto rowptr = [&](int row) { return (row < MLAT) ? p.x + (size_t)row * D_MODEL : p.ctx + (size_t)(row - MLAT) * D_MODEL; };
    int row = bid * 4 + wave;
    f32x4 n0 = f32x4{0.f, 0.f, 0.f, 0.f}, n1 = n0, n2 = n0, n3 = n0;
    if (row < MTOT) { const float* xr = rowptr(row); n0 = ld4(xr + lane * 4); if (NV > 1) n1 = ld4(xr + 256 + lane * 4); if (NV > 2) { n2 = ld4(xr + 512 + lane * 4); n3 = ld4(xr + 768 + lane * 4); } }
    for (; row < MTOT; row += nblk * 4) {
        const int mr = (row < MLAT) ? row / SEQ : BATCH;
        const float* md = MOD + (size_t)mr * 6 * D_MODEL;
        f32x4 v0 = n0, v1 = n1, v2 = n2, v3 = n3;
        const int nrow = row + nblk * 4;
        if (nrow < MTOT) { const float* xr = rowptr(nrow); n0 = ld4(xr + lane * 4); if (NV > 1) n1 = ld4(xr + 256 + lane * 4); if (NV > 2) { n2 = ld4(xr + 512 + lane * 4); n3 = ld4(xr + 768 + lane * 4); } }
        float s = hsum4(v0);
        if (NV > 1) s += hsum4(v1);
        if (NV > 2) s += hsum4(v2) + hsum4(v3);
        const float mu = wave_sum(s) * (1.0f / D_MODEL);
        v0 -= mu; float s2 = hsum4(v0 * v0);
        if (NV > 1) { v1 -= mu; s2 += hsum4(v1 * v1); }
        if (NV > 2) { v2 -= mu; v3 -= mu; s2 += hsum4(v2 * v2) + hsum4(v3 * v3); }
        const float rstd = frsq(wave_sum(s2) * (1.0f / D_MODEL) + LN_EPS);
        if (lane == 0) { STATS[row * 2] = mu; STATS[row * 2 + 1] = rstd; }
#pragma unroll
        for (int j = 0; j < NV; ++j) {
            const int k = j * 256 + lane * 4;
            const f32x4 vv = (j == 0) ? v0 : (j == 1) ? v1 : (j == 2) ? v2 : v3;
            const f32x4 h = vv * rstd * ld4(p.ln_in_g + k) + ld4(p.ln_in_b + k);
            *(U2*)(U + (size_t)row * D_MODEL + k) = pack4(h * (1.0f + ld4(md + D_MODEL + k)) + ld4(md + k));
        }
    }
}

constexpr int LDK = 64;
template <int MI, bool DUAL, class Epi>
__device__ __forceinline__ void gemm_tile(char* smem, const bf16_t* A, int lda, const int* rowidx, int m0, const bf16_t* Bt0, const bf16_t* Bt1, int ldb, int n0, int K, Epi epi, const float* rowscale = nullptr, int kscale = 0) {
    constexpr int BM = 32 * MI;
    bf16_t* As = (bf16_t*)smem;
    bf16_t* Bs = As + BM * LDK;
    int tid = threadIdx.x;
#ifndef HOST_EMU
    asm volatile("" : "+v"(tid));
#endif
    const int lane = tid & 63, wave = tid >> 6, wr = wave >> 1, wc = wave & 1, l15 = lane & 15, q = lane >> 4;
    const int ch = tid & 7, r0 = tid >> 3;
    unsigned aoff[MI], boff[4];
#pragma unroll
    for (int j = 0; j < MI; ++j) { const int r = m0 + r0 + 32 * j; aoff[j] = (unsigned)(rowidx ? rowidx[r] : r) * (unsigned)lda + ch * 8; }
#pragma unroll
    for (int j = 0; j < 4; ++j) boff[j] = (unsigned)(n0 + (DUAL ? (j >> 1) * 32 + r0 : r0 + 32 * j)) * (unsigned)ldb + ch * 8;
    const int wofs = r0 * LDK + ((ch ^ (r0 & 7)) * 8);
    u32x4 ar[MI], br[4];
    f32x4 acc[MI][4];
#pragma unroll
    for (int i = 0; i < MI; ++i)
#pragma unroll
        for (int j = 0; j < 4; ++j) acc[i][j] = f32x4{0.f, 0.f, 0.f, 0.f};
    const int nk = K / 64;
#pragma unroll
    for (int j = 0; j < MI; ++j) ar[j] = *(const u32x4*)(A + aoff[j]);
#pragma unroll
    for (int j = 0; j < 4; ++j) br[j] = *(const u32x4*)(((DUAL && (j & 1)) ? Bt1 : Bt0) + boff[j]);
    for (int kt = 0; kt < nk; ++kt) {
        __syncthreads();
#pragma unroll
        for (int j = 0; j < MI; ++j) *(u32x4*)(As + wofs + 32 * j * LDK) = ar[j];
#pragma unroll
        for (int j = 0; j < 4; ++j) *(u32x4*)(Bs + wofs + 32 * j * LDK) = br[j];
        __syncthreads();
        if (kt + 1 < nk) {
            const int ko = (kt + 1) * 64;
#pragma unroll
            for (int j = 0; j < MI; ++j) ar[j] = *(const u32x4*)(A + aoff[j] + ko);
#pragma unroll
            for (int j = 0; j < 4; ++j) br[j] = *(const u32x4*)(((DUAL && (j & 1)) ? Bt1 : Bt0) + boff[j] + ko);
        }
#pragma unroll
        for (int ks = 0; ks < 2; ++ks) {
            const int cofs = ((ks * 4 + q) ^ (l15 & 7)) * 8;
            bf16x8 bfr[4];
#pragma unroll
            for (int ni = 0; ni < 4; ++ni) bfr[ni] = *(const bf16x8*)(Bs + (wc * 64 + ni * 16 + l15) * LDK + cofs);
#pragma unroll
            for (int mi = 0; mi < MI; ++mi) {
                const bf16x8 af = *(const bf16x8*)(As + (wr * (16 * MI) + mi * 16 + l15) * LDK + cofs);
#pragma unroll
                for (int ni = 0; ni < 4; ++ni) acc[mi][ni] = MFMA16(bfr[ni], af, acc[mi][ni]);
            }
        }
        if (rowscale && kt + 1 == kscale) {
#pragma unroll
            for (int mi = 0; mi < MI; ++mi) {
                const float rs = rowscale[m0 + wr * (16 * MI) + mi * 16 + l15];
#pragma unroll
                for (int ni = 0; ni < 4; ++ni) acc[mi][ni] *= rs;
            }
        }
    }
#pragma unroll
    for (int mi = 0; mi < MI; ++mi) {
        const int ml = wr * (16 * MI) + mi * 16 + l15;
        if (DUAL) {
#pragma unroll
            for (int ni = 0; ni < 2; ++ni) epi(ml, wc * 32 + ni * 16 + q * 4, acc[mi][ni], acc[mi][ni + 2]);
        } else {
#pragma unroll
            for (int ni = 0; ni < 4; ++ni) epi(ml, wc * 64 + ni * 16 + q * 4, acc[mi][ni], acc[mi][ni]);
        }
    }
    __syncthreads();
}

__device__ __forceinline__ int xcd_vbid(int bid, int nblk) { return (nblk % 8 == 0) ? (bid % 8) * (nblk / 8) + bid / 8 : bid; }
constexpr int MI_C = (MTOT % 256 == 0) ? 8 : 4, MI_J = (MLAT % 256 == 0) ? 8 : 4, MI_E = (CAP % 256 == 0) ? 8 : 4;
__device__ __forceinline__ void phaseC(const Params& p, int bid, int nblk, char* smem) {
    const bf16_t* U = WSP(bf16_t, WS_R3); const bf16_t* WB = WSP(bf16_t, WS_WBIN);
    bf16_t* P = WSP(bf16_t, WS_R1);
    constexpr int BM = 32 * MI_C, NTN = D_IN / 128, NTM = MTOT / BM;
    constexpr int GM = (NTM % 8 == 0) ? 8 : (NTM % 4 == 0) ? 4 : 1;
    for (int it = xcd_vbid(bid, nblk); it < NTN * NTM; it += nblk) {
        const int mg = it / (GM * NTN), r = it % (GM * NTN), nt = r / GM, mt = mg * GM + (r % GM);
        gemm_tile<MI_C, false>(smem, U, D_MODEL, nullptr, mt * BM, WB, nullptr, D_MODEL, nt * 128, D_MODEL, [&](int ml, int nl, f32x4 v, f32x4) {
            *(U2*)(P + (size_t)(mt * BM + ml) * D_IN + nt * 128 + nl) = pack4(v);
        });
    }
}


template <int NYT, int KS>
__device__ __forceinline__ void mmT(f32x4* acc, const bf16_t* X, int ldx, int xs, const bf16_t* Y, int ldy, int lane) {
#pragma unroll
    for (int ks = 0; ks < KS; ++ks) {
        const bf16x8 xf = *(const bf16x8*)(X + (xs * 16 + (lane & 15)) * ldx + ks * 32 + 8 * (lane >> 4));
#pragma unroll
        for (int nb = 0; nb < NYT; ++nb) {
            const bf16x8 yf = *(const bf16x8*)(Y + (nb * 16 + (lane & 15)) * ldy + ks * 32 + 8 * (lane >> 4));
            acc[nb] = MFMA16(xf, yf, acc[nb]);
        }
    }
}

struct SeqChunk { int base_row; int t0; int len; };
__device__ __forceinline__ SeqChunk lru_chunk(int cg) {
    SeqChunk s;
    if (cg < NLCH) { const int b = cg / (SEQ / 64), ck = cg % (SEQ / 64); s.base_row = b * SEQ; s.t0 = ck * 64; s.len = SEQ; }
    else { const int c2 = cg - NLCH; const int b = c2 / (CTX_LEN / 64), ck = c2 % (CTX_LEN / 64); s.base_row = MLAT + b * CTX_LEN; s.t0 = ck * 64; s.len = CTX_LEN; }
    return s;
}
constexpr int L_XIN = 0;
constexpr int L_GT = 8704;
constexpr int L_XB = L_GT + 9216;
constexpr int L_WT = L_XB + 9216;
constexpr int L_CP = L_WT + 36864;
constexpr int L_END = L_CP + 4096;
static_assert(L_END <= SMEM_BYTES, "lru lds");
__device__ __forceinline__ void lru_load_w(const Params& p, char* smem, int cb) {
    bf16_t* WT = (bf16_t*)(smem + L_WT);
    const int tid = opaque_tid();
    for (int idx = tid; idx < 4 * 64 * 16; idx += 256) {
        const int m = idx >> 10, i = (idx >> 4) & 63, j4 = (idx & 15) * 4, d = m >> 1;
        const f32x4 w = ld4(((m & 1) ? p.lru_wx : p.lru_wa) + ((size_t)(d * LRU_BLOCKS + cb) * 64 + i) * 64 + j4);
        bf16_t* dst = WT + (m * 64 + j4) * 72 + i;
        dst[0] = f2bf(w[0]); dst[72] = f2bf(w[1]); dst[144] = f2bf(w[2]); dst[216] = f2bf(w[3]);
    }
}
struct LruConst { float ba[2][4], bx[2][4], sp8[2][4], gn[4], cw[4], cb0; };
__device__ __forceinline__ void lru_consts(const Params& p, int cb, LruConst& K) {
    const int l15 = threadIdx.x & 15, c = threadIdx.x & 63, ch = cb * 64 + c;
#pragma unroll
    for (int d = 0; d < 2; ++d)
#pragma unroll
        for (int nb = 0; nb < 4; ++nb) { const int cc = d * D_LRU + cb * 64 + nb * 16 + l15; K.ba[d][nb] = p.lru_ba[cc]; K.bx[d][nb] = p.lru_bx[cc]; K.sp8[d][nb] = -8.0f * softplusf_(-p.lru_lam[cc]); }
#pragma unroll
    for (int nb = 0; nb < 4; ++nb) K.gn[nb] = p.lru_norm_g[cb * 64 + nb * 16 + l15];
#pragma unroll
    for (int j = 0; j < 4; ++j) K.cw[j] = p.lru_conv_w[j * D_LRU + ch];
    K.cb0 = p.lru_conv_b[ch];
}
struct LruStage { u32x4 x[3]; u32x4 g[2]; };
template <bool FINAL>
__device__ __forceinline__ void lru_stage_load(const Params& p, int cg, int cb, LruStage& S) {
    const bf16_t* P = WSP(bf16_t, WS_R1);
    const SeqChunk sc = lru_chunk(cg);
    const int tid = opaque_tid();
#pragma unroll
    for (int k = 0; k < 3; ++k) {
        const int idx = tid + 256 * k, tt = idx >> 3, c8 = (idx & 7) * 8, t = sc.t0 - 1 + tt;
        S.x[k] = u32x4{0u, 0u, 0u, 0u};
        if (idx < 67 * 8 && t >= 0 && t < sc.len) S.x[k] = *(const u32x4*)(P + (size_t)(sc.base_row + t) * D_IN + cb * 64 + c8);
    }
    if (FINAL) {
#pragma unroll
        for (int k = 0; k < 2; ++k) { const int idx = tid + 256 * k, tt = idx >> 3, c8 = (idx & 7) * 8; S.g[k] = *(const u32x4*)(P + (size_t)(sc.base_row + sc.t0 + tt) * D_IN + D_LRU + cb * 64 + c8); }
    }
}
template <bool FINAL>
__device__ __forceinline__ void lru_item(const Params& p, char* smem, int cg, int cb, const LruConst& K, LruStage& S, int cg_next) {
    const bf16_t* P = WSP(bf16_t, WS_R1);
    bf16_t* XIN = (bf16_t*)(smem + L_XIN); bf16_t* GT = (bf16_t*)(smem + L_GT); bf16_t* XB = (bf16_t*)(smem + L_XB); const bf16_t* WT = (const bf16_t*)(smem + L_WT);
    float* CP = (float*)(smem + L_CP);
    const int tid = opaque_tid(), lane = tid & 63, wave = tid >> 6, q = lane >> 4, l15 = lane & 15;
    const SeqChunk sc = lru_chunk(cg);
    float cin[2][4];
    if (FINAL) {
#pragma unroll
        for (int d = 0; d < 2; ++d)
#pragma unroll
            for (int nb = 0; nb < 4; ++nb) cin[d][nb] = WSP(float, WS_CARRY)[((size_t)d * NLCH + cg) * D_LRU + cb * 64 + nb * 16 + l15];
    }
    __syncthreads();
#pragma unroll
    for (int k = 0; k < 3; ++k) { const int idx = tid + 256 * k, tt = idx >> 3, c8 = (idx & 7) * 8; if (idx < 67 * 8) *(u32x4*)(XIN + tt * 64 + c8) = S.x[k]; }
    if (FINAL) {
#pragma unroll
        for (int k = 0; k < 2; ++k) { const int idx = tid + 256 * k, tt = idx >> 3, c8 = (idx & 7) * 8; *(u32x4*)(GT + tt * 72 + c8) = S.g[k]; }
    }
    if (cg_next >= 0) lru_stage_load<FINAL>(p, cg_next, cb, S);
    __syncthreads();
    {
        const int c = tid & 63;
#pragma unroll 4
        for (int tt = tid >> 6; tt < 64; tt += 4)
            XB[tt * 72 + c] = f2bf(K.cb0 + bf2f(XIN[tt * 64 + c]) * K.cw[0] + bf2f(XIN[(tt + 1) * 64 + c]) * K.cw[1] + bf2f(XIN[(tt + 2) * 64 + c]) * K.cw[2] + bf2f(XIN[(tt + 3) * 64 + c]) * K.cw[3]);
    }
    __syncthreads();
    float hs[4][4];
    float av[4][4], bv[4][4];
#pragma unroll
    for (int d = 0; d < 2; ++d) {
        f32x4 ga[4], gx[4];
#pragma unroll
        for (int nb = 0; nb < 4; ++nb) { ga[nb] = f32x4{0.f, 0.f, 0.f, 0.f}; gx[nb] = f32x4{0.f, 0.f, 0.f, 0.f}; }
        mmT<4, 2>(ga, XB, 72, wave, WT + (2 * d) * 64 * 72, 72, lane);
        mmT<4, 2>(gx, XB, 72, wave, WT + (2 * d + 1) * 64 * 72, 72, lane);
        float cA[4], cH[4];
#pragma unroll
        for (int nb = 0; nb < 4; ++nb) {
            const float ba = K.ba[d][nb], bx = K.bx[d][nb], sp8 = K.sp8[d][nb];
#pragma unroll
            for (int r = 0; r < 4; ++r) {
                const float rg = fsigm(ga[nb][r] + ba), ig = fsigm(gx[nb][r] + bx);
                const float a = FEXP(sp8 * rg);
                const float xv = bf2f(XB[(wave * 16 + q * 4 + r) * 72 + nb * 16 + l15]);
                av[nb][r] = a; bv[nb][r] = fsqrt(fmaxf(1.0f - a * a, 0.f)) * ig * xv;
            }
            float A, H;
            if (d == 0) { A = av[nb][0]; H = bv[nb][0];
#pragma unroll
                for (int r = 1; r < 4; ++r) { H = H * av[nb][r] + bv[nb][r]; A *= av[nb][r]; } }
            else { A = av[nb][3]; H = bv[nb][3];
#pragma unroll
                for (int r = 2; r >= 0; --r) { H = H * av[nb][r] + bv[nb][r]; A *= av[nb][r]; } }
#pragma unroll
            for (int st = 1; st <= 2; st <<= 1) {
                const float pA = d == 0 ? __shfl_up(A, 16 * st) : __shfl_down(A, 16 * st), pH = d == 0 ? __shfl_up(H, 16 * st) : __shfl_down(H, 16 * st);
                const bool has = d == 0 ? (q >= st) : (q + st <= 3);
                if (has) { H = pH * A + H; A = pA * A; }
            }
            cA[nb] = A; cH[nb] = H;
            const bool last = d == 0 ? (q == 3) : (q == 0);
            if (last) { CP[((d * 4 + wave) * 64 + nb * 16 + l15) * 2] = A; CP[((d * 4 + wave) * 64 + nb * 16 + l15) * 2 + 1] = H; }
        }
        __syncthreads();
        if (!FINAL) {
            if (wave == 0 && q == 0) {
#pragma unroll
                for (int nb = 0; nb < 4; ++nb) {
                    const int c = nb * 16 + l15;
                    float A = 1.f, H = 0.f;
#pragma unroll
                    for (int w = 0; w < 4; ++w) { const int ww = d == 0 ? w : 3 - w; const float wa = CP[((d * 4 + ww) * 64 + c) * 2], wh = CP[((d * 4 + ww) * 64 + c) * 2 + 1]; H = H * wa + wh; A *= wa; }
                    WSP(float, WS_SUMA)[((size_t)d * NCH + cg) * D_LRU + cb * 64 + c] = A;
                    WSP(float, WS_SUMH)[((size_t)d * NCH + cg) * D_LRU + cb * 64 + c] = H;
                }
            }
        } else {
#pragma unroll
            for (int nb = 0; nb < 4; ++nb) {
                const int c = nb * 16 + l15;
                float h = cin[d][nb];
#pragma unroll
                for (int w = 0; w < 3; ++w) { const int ww = d == 0 ? w : 3 - w; const bool use = d == 0 ? (ww < wave) : (ww > wave);
                    if (use) h = h * CP[((d * 4 + ww) * 64 + c) * 2] + CP[((d * 4 + ww) * 64 + c) * 2 + 1]; }
                const float eA = d == 0 ? __shfl_up(cA[nb], 16) : __shfl_down(cA[nb], 16), eH = d == 0 ? __shfl_up(cH[nb], 16) : __shfl_down(cH[nb], 16);
                const bool first = d == 0 ? (q == 0) : (q == 3);
                if (!first) h = h * eA + eH;
                if (d == 0) {
#pragma unroll
                    for (int r = 0; r < 4; ++r) { h = h * av[nb][r] + bv[nb][r]; hs[nb][r] = h; }
                } else {
#pragma unroll
                    for (int r = 3; r >= 0; --r) { h = h * av[nb][r] + bv[nb][r]; hs[nb][r] += h; }
                }
            }
        }
        __syncthreads();
    }
    if (FINAL) {
        float ss[4] = {0.f, 0.f, 0.f, 0.f};
#pragma unroll
        for (int nb = 0; nb < 4; ++nb) {
            const float gn = K.gn[nb];
#pragma unroll
            for (int r = 0; r < 4; ++r) {
                const int tt = wave * 16 + q * 4 + r;
                const float v = hs[nb][r] * geluf_(bf2f(GT[tt * 72 + nb * 16 + l15]));
                ss[r] += v * v;
                XB[tt * 72 + nb * 16 + l15] = f2bf(v * gn);
            }
        }
#pragma unroll
        for (int r = 0; r < 4; ++r) {
#pragma unroll
            for (int o = 1; o < 16; o <<= 1) ss[r] += __shfl_xor(ss[r], o);
            if (l15 == 0) WSP(float, WS_SSQP)[(size_t)(sc.base_row + sc.t0 + wave * 16 + q * 4 + r) * LRU_BLOCKS + cb] = ss[r];
        }
        __syncthreads();
        bf16_t* MIX = WSP(bf16_t, WS_R3);
        for (int idx = tid; idx < 64 * 8; idx += 256) {
            const int tt = idx >> 3, c8 = (idx & 7) * 8;
            *(u32x4*)(MIX + (size_t)(sc.base_row + sc.t0 + tt) * D_MIX + cb * 64 + c8) = *(const u32x4*)(XB + tt * 72 + c8);
        }
    }
}
__device__ __forceinline__ void phaseD(const Params& p, int bid, int nblk, char* smem) {
    int cur = -1; LruConst K; LruStage S;
    for (int it = bid; it < NCH * LRU_BLOCKS; it += nblk) {
        const int cb = it % LRU_BLOCKS, cg = it / LRU_BLOCKS;
        if (cb != cur) { __syncthreads(); lru_load_w(p, smem, cb); lru_consts(p, cb, K); lru_stage_load<false>(p, cg, cb, S); cur = cb; }
        const int itn = it + nblk;
        lru_item<false>(p, smem, cg, cb, K, S, (itn < NCH * LRU_BLOCKS && itn % LRU_BLOCKS == cb) ? itn / LRU_BLOCKS : -1);
        if (itn < NCH * LRU_BLOCKS && itn % LRU_BLOCKS != cb) cur = -1;
    }
}
__device__ __forceinline__ void phaseE(const Params& p, int bid, int nblk, char* smem) {
    const float* SUMA = WSP(float, WS_SUMA); const float* SUMH = WSP(float, WS_SUMH); float* CARRY = WSP(float, WS_CARRY);
    constexpr int NLB = SEQ / 64, NCB = CTX_LEN / 64;
    for (int g = bid * 256 + threadIdx.x; g < BATCH * 2 * D_LRU; g += nblk * 256) {
        const int c = g % D_LRU, d = (g / D_LRU) & 1, b = g / (2 * D_LRU);
        const float* sa = SUMA + (size_t)d * NCH * D_LRU + c; const float* sh = SUMH + (size_t)d * NCH * D_LRU + c;
        float* cr = CARRY + (size_t)d * NLCH * D_LRU + c;
        float h = 0.f;
        if (d == 0) {
            for (int q2 = 0; q2 < NCB; ++q2) { const int gi = NLCH + b * NCB + q2; h = sa[(size_t)gi * D_LRU] * h + sh[(size_t)gi * D_LRU]; }
            for (int q2 = 0; q2 < NLB; ++q2) { const int gi = b * NLB + q2; cr[(size_t)gi * D_LRU] = h; h = sa[(size_t)gi * D_LRU] * h + sh[(size_t)gi * D_LRU]; }
        } else {
            for (int q2 = NCB - 1; q2 >= 0; --q2) { const int gi = NLCH + b * NCB + q2; h = sa[(size_t)gi * D_LRU] * h + sh[(size_t)gi * D_LRU]; }
            for (int q2 = NLB - 1; q2 >= 0; --q2) { const int gi = b * NLB + q2; cr[(size_t)gi * D_LRU] = h; h = sa[(size_t)gi * D_LRU] * h + sh[(size_t)gi * D_LRU]; }
        }
    }
}
__device__ __forceinline__ void phaseF(const Params& p, int bid, int nblk, char* smem) {
    int cur = -1; LruConst K; LruStage S;
    for (int it = bid; it < NLCH * LRU_BLOCKS; it += nblk) {
        const int cb = it % LRU_BLOCKS, cg = it / LRU_BLOCKS;
        if (cb != cur) { __syncthreads(); lru_load_w(p, smem, cb); lru_consts(p, cb, K); lru_stage_load<true>(p, cg, cb, S); cur = cb; }
        const int itn = it + nblk;
        lru_item<true>(p, smem, cg, cb, K, S, (itn < NLCH * LRU_BLOCKS && itn % LRU_BLOCKS == cb) ? itn / LRU_BLOCKS : -1);
        if (itn < NLCH * LRU_BLOCKS && itn % LRU_BLOCKS != cb) cur = -1;
    }
}

__device__ __forceinline__ size_t rwkv_row(int seg, int b, int s) {
    if (seg == 0) return (size_t)(MLAT + b * CTX_LEN + s);
    const int r = s % ROWS, c = s / ROWS;
    return (size_t)(b * SEQ + r * GRID_W + c);
}
__device__ __forceinline__ void chunk_info(int d, int c, int& seg, int& p0, int& len) {
    if (c < NCC) { seg = 0; len = CTX_LEN; p0 = (d == 0 ? c : NCC - 1 - c) * RC; }
    else { const int cc = c - NCC; seg = 1; len = SEQ; p0 = (d == 0 ? cc : NLC - 1 - cc) * RC; }
}
__device__ __forceinline__ void unpack8(const u32x4 v, float* o) {
    o[0] = bitsf(v[0] << 16); o[1] = bitsf(v[0] & 0xFFFF0000u); o[2] = bitsf(v[1] << 16); o[3] = bitsf(v[1] & 0xFFFF0000u);
    o[4] = bitsf(v[2] << 16); o[5] = bitsf(v[2] & 0xFFFF0000u); o[6] = bitsf(v[3] << 16); o[7] = bitsf(v[3] & 0xFFFF0000u);
}
__device__ __forceinline__ void shifted8(const Params& p, const bf16_t* P, int seg, int b, int pos, int len, int ch0, float* o) {
    float z[8], zp[8], zn[8];
    unpack8(*(const u32x4*)(P + rwkv_row(seg, b, pos) * D_IN + RW0 + ch0), z);
    if (pos > 0) unpack8(*(const u32x4*)(P + rwkv_row(seg, b, pos - 1) * D_IN + RW0 + ch0), zp); else { for (int i = 0; i < 8; ++i) zp[i] = 0.f; }
    if (pos < len - 1) unpack8(*(const u32x4*)(P + rwkv_row(seg, b, pos + 1) * D_IN + RW0 + ch0), zn); else { for (int i = 0; i < 8; ++i) zn[i] = 0.f; }
    const f32x4 mp0 = ld4(p.mu_prev + ch0), mp1 = ld4(p.mu_prev + ch0 + 4), mn0 = ld4(p.mu_next + ch0), mn1 = ld4(p.mu_next + ch0 + 4);
#pragma unroll
    for (int i = 0; i < 4; ++i) { o[i] = z[i] + mp0[i] * (zp[i] - z[i]) + mn0[i] * (zn[i] - z[i]); o[4 + i] = z[4 + i] + mp1[i] * (zp[4 + i] - z[4 + i]) + mn1[i] * (zn[4 + i] - z[4 + i]); }
}
constexpr int LT = 72, LJ = 40;
constexpr int R_RF = 0, R_KF = 8192, R_VF = 16384, R_LW = 24576, R_IC = 32768;
constexpr int R_NKA = 0, R_MBR = 2560, R_MKR = 5120;
constexpr int R_XU = 7680;
constexpr int R_IA = R_XU + 8448, R_IB = R_IA + 4608, R_PA = R_IB + 4608, R_PB = R_PA + 4608;
constexpr int R_WA = R_IB, R_U0 = R_WA + 5120;
constexpr int R_TB0 = R_IB, R_TB1 = R_IB + 2560, R_PB0 = R_IB + 5120, R_PB1 = R_IB + 7680, R_PT0 = R_IB + 10240, R_PT1 = R_IB + 12800;
static_assert(R_PT1 + 2560 <= 40960, "rwkv doubling buffers");
static_assert(R_U0 + 5120 <= R_PB + 4608 && R_PB + 4608 <= 40960, "rwkv scratch");
constexpr int R_O = 40960;
constexpr int R_AH = R_O, R_BH = R_AH + 4608, R_KH = R_BH + 4608, R_RH = R_KH + 4608;
constexpr int R_VT = R_RH + 4608, R_BHT = R_VT + 5120, R_KHT = R_BHT + 5120;
constexpr int R_GC = R_KHT + 5120, R_TOT = R_GC + 256, R_PS = R_TOT + 1024, R_END = R_PS + 1024;
constexpr int R_TW = R_O, R_TA = R_TW + 4608, R_W2T = R_TA + 4608, R_A2T = R_W2T + 9216;
static_assert(R_A2T + 9216 <= R_END && R_END <= SMEM_BYTES, "rwkv lds");

__device__ __forceinline__ void phaseR1(const Params& p, int bid, int nblk, char* smem) {
    const bf16_t* P = WSP(bf16_t, WS_R1);
    unsigned char* CH = p.ws + WS_CH;
    float* RBON = WSP(float, WS_RBON);
    float* Rf = (float*)(smem + R_RF); float* Kf = (float*)(smem + R_KF); float* Vf = (float*)(smem + R_VF); float* LW = (float*)(smem + R_LW); float* IC = (float*)(smem + R_IC);
    float* IA = (float*)(smem + R_IA); float* IB = (float*)(smem + R_IB); float* PA = (float*)(smem + R_PA); float* PB = (float*)(smem + R_PB); bf16_t* NkaT = (bf16_t*)(smem + R_NKA); bf16_t* MbrT = (bf16_t*)(smem + R_MBR); bf16_t* MkrT = (bf16_t*)(smem + R_MKR);
    float* Xu = (float*)(smem + R_XU); bf16_t* Wa = (bf16_t*)(smem + R_WA); bf16_t* U0 = (bf16_t*)(smem + R_U0);
    bf16_t* Ah = (bf16_t*)(smem + R_AH); bf16_t* Bh = (bf16_t*)(smem + R_BH); bf16_t* Kh = (bf16_t*)(smem + R_KH); bf16_t* Rh = (bf16_t*)(smem + R_RH);
    bf16_t* VT = (bf16_t*)(smem + R_VT); bf16_t* BhT = (bf16_t*)(smem + R_BHT); bf16_t* KhT = (bf16_t*)(smem + R_KHT);
    float* GC = (float*)(smem + R_GC); float* TOT = (float*)(smem + R_TOT); float* PS = (float*)(smem + R_PS);
    bf16_t* TW = (bf16_t*)(smem + R_TW); bf16_t* TA = (bf16_t*)(smem + R_TA); bf16_t* W2T = (bf16_t*)(smem + R_W2T); bf16_t* A2T = (bf16_t*)(smem + R_A2T);
    constexpr int NITEM = NCHAIN * NCK;
    const int per = NITEM / nblk, nst = per > 2 ? per - 2 : 0, pool0 = nst * nblk;
    unsigned* pctr = WSP(unsigned, WS_CTRL) + R1_POOL_WORD;
    volatile int* nextw = (volatile int*)(smem + R_END);
    int it, kdone = 0;
    if (nst > 0) it = bid * nst;
    else {
        __syncthreads();
        if (threadIdx.x == 0) { const int v = pool0 + (int)atomicAdd(pctr, 1u); *nextw = v < NITEM ? v : -1; }
        __syncthreads();
        it = *nextw;
    }
    __syncthreads();
    for (; it >= 0; ++kdone) {
        const bool dyn_next = kdone + 1 >= nst;
        unsigned pool_v = 0u;
        if (dyn_next && threadIdx.x == 0) pool_v = atomicAdd(pctr, 1u);
        const int tid = opaque_tid(), lane = tid & 63, wave = tid >> 6, q = lane >> 4, l15 = lane & 15;
        const int chain = it / NCK, c = it % NCK;
        const int d = chain & 1, h = (chain >> 1) % HEADS, b = chain / (2 * HEADS);
        int seg, p0, len; chunk_info(d, c, seg, p0, len);
        unsigned char* chp = CH + (size_t)it * CH_BYTES;
        const float kkc = p.k_k[h * 64 + lane], kac = p.k_a[h * 64 + lane];
        {
            u32x4 wv[4];
#pragma unroll
            for (int k = 0; k < 4; ++k) {
                const int idx = tid + 256 * k, which = idx >> 9, j = (idx >> 3) & 63, c8 = (idx & 7) * 8;
                wv[k] = *(const u32x4*)(WSP(bf16_t, WS_LORA) + ((size_t)((d * 2 + which) * HEADS + h) * 64 + j) * 64 + c8);
            }
            if (tid < 160) {
                const int g = tid % 40, tq = tid / 40, grp = g >> 3, j0 = (g & 7) * 8;
                const int ch0 = (grp < 3) ? grp * D_RWKV + h * 64 + j0 : (grp == 3 ? 3 * D_RWKV + d * 64 + j0 : 3 * D_RWKV + 128 + d * 64 + j0);
                const int pa = p0 + (d ? RC - 8 - 8 * tq : 8 * tq);
                u32x4 zr[10];
#pragma unroll
                for (int i = 0; i < 10; ++i) {
                    const int pos = pa - 1 + i;
                    zr[i] = (pos >= 0 && pos < len) ? *(const u32x4*)(P + rwkv_row(seg, b, pos) * D_IN + RW0 + ch0) : u32x4{0u, 0u, 0u, 0u};
                }
                const f32x4 mp0 = ld4(p.mu_prev + ch0), mp1 = ld4(p.mu_prev + ch0 + 4), mn0 = ld4(p.mu_next + ch0), mn1 = ld4(p.mu_next + ch0 + 4);
                float zz[3][8];
                unpack8(zr[0], zz[0]); unpack8(zr[1], zz[1]);
#pragma unroll
                for (int i = 0; i < 8; ++i) {
                    unpack8(zr[i + 2], zz[(i + 2) % 3]);
                    const float* zpv = zz[i % 3]; const float* z = zz[(i + 1) % 3]; const float* znv = zz[(i + 2) % 3];
                    const int tau = d ? 8 * tq + 7 - i : 8 * tq + i;
                    float o[8];
#pragma unroll
                    for (int e = 0; e < 4; ++e) { o[e] = z[e] + mp0[e] * (zpv[e] - z[e]) + mn0[e] * (znv[e] - z[e]); o[4 + e] = z[4 + e] + mp1[e] * (zpv[4 + e] - z[4 + e]) + mn1[e] * (znv[4 + e] - z[4 + e]); }
                    if (grp < 3) {
                        float* dst = (grp == 0 ? Rf : grp == 1 ? Kf : Vf) + tau * 64 + j0;
                        *(f32x4*)dst = f32x4{o[0], o[1], o[2], o[3]}; *(f32x4*)(dst + 4) = f32x4{o[4], o[5], o[6], o[7]};
                    } else if (grp == 3) {
                        u32x4 w;
#pragma unroll
                        for (int e = 0; e < 4; ++e) { const float t0 = 2.0f * frcp(1.0f + FEXP(-2.0f * o[2 * e])) - 1.0f, t1 = 2.0f * frcp(1.0f + FEXP(-2.0f * o[2 * e + 1])) - 1.0f; w[e] = pk2(t0, t1); }
                        *(u32x4*)(TW + tau * LT + j0) = w;
                    } else {
                        u32x4 w; w[0] = pk2(o[0], o[1]); w[1] = pk2(o[2], o[3]); w[2] = pk2(o[4], o[5]); w[3] = pk2(o[6], o[7]);
                        *(u32x4*)(TA + tau * LT + j0) = w;
                    }
                }
            }
#pragma unroll
            for (int k = 0; k < 4; ++k) {
                const int idx = tid + 256 * k, which = idx >> 9, j = (idx >> 3) & 63, c8 = (idx & 7) * 8;
                *(u32x4*)((which ? A2T : W2T) + j * LT + c8) = wv[k];
            }
        }
        __syncthreads();
        {
            f32x4 aw[2] = {f32x4{0.f, 0.f, 0.f, 0.f}, f32x4{0.f, 0.f, 0.f, 0.f}}, ai[2] = {f32x4{0.f, 0.f, 0.f, 0.f}, f32x4{0.f, 0.f, 0.f, 0.f}};
            mmT<2, 2>(aw, W2T, LT, wave, TW, LT, lane);
            mmT<2, 2>(ai, A2T, LT, wave, TA, LT, lane);
            const int j = wave * 16 + q * 4;
            const f32x4 w0v = ld4(p.w0 + d * D_RWKV + h * 64 + j), a0v = ld4(p.a0 + d * D_RWKV + h * 64 + j);
            const f32x4 kk4 = ld4(p.k_k + h * 64 + j), ka4 = ld4(p.k_a + h * 64 + j), rk4 = ld4(p.r_k + h * 64 + j);
#pragma unroll
            for (int nb = 0; nb < 2; ++nb) {
                const int tau = nb * 16 + l15;
                f32x4 lw, ic;
#pragma unroll
                for (int r = 0; r < 4; ++r) { lw[r] = -0.6065306597126334f * fsigm(w0v[r] + aw[nb][r]); ic[r] = fsigm(a0v[r] + ai[nb][r]); }
                *(f32x4*)(LW + tau * 64 + j) = lw; *(f32x4*)(IC + tau * 64 + j) = ic;
                const f32x4 kr = *(const f32x4*)(Kf + tau * 64 + j), rr = *(const f32x4*)(Rf + tau * 64 + j);
                const f32x4 kd = kr * (1.0f + (ic - 1.0f) * ka4), kq = kr * kk4;
                float n2 = hsum4(kq * kq), bon = hsum4(rr * kd * rk4);
                n2 += __shfl_xor(n2, 16); n2 += __shfl_xor(n2, 32); bon += __shfl_xor(bon, 16); bon += __shfl_xor(bon, 32);
                if (q == 0) { PS[(tau * 4 + wave) * 2] = n2; PS[(tau * 4 + wave) * 2 + 1] = bon; }
            }
        }
        __syncthreads();
        {
            const int j = lane, t0 = wave * 8;
            float cum[8], kd[8], kkn[8], icv[8], rr[8], vv[8], run = 0.f;
#pragma unroll
            for (int i = 0; i < 8; ++i) {
                const int t = t0 + i;
                run += LW[t * 64 + j]; cum[i] = run;
                const float kr = Kf[t * 64 + j]; icv[i] = IC[t * 64 + j]; rr[i] = Rf[t * 64 + j]; vv[i] = Vf[t * 64 + j];
                kd[i] = kr * (1.0f + (icv[i] - 1.0f) * kac);
                const float kk = kr * kkc;
                const f32x4 pa = *(const f32x4*)(PS + t * 8), pb = *(const f32x4*)(PS + t * 8 + 4);
                const float n2 = (pa[0] + pa[2]) + (pb[0] + pb[2]);
                kkn[i] = kk * frsq(fmaxf(n2, 1e-24f));
                if (lane == 0) RBON[(size_t)it * RC + t] = (pa[1] + pa[3]) + (pb[1] + pb[3]);
            }
            TOT[wave * 64 + j] = run;
            __syncthreads();
            float off = 0.f;
            for (int w = 0; w < wave; ++w) off += TOT[w * 64 + j];
            u32x4 vt, bt, kt;
            float e_prev = 0.f;
#pragma unroll
            for (int i = 0; i < 8; ++i) {
                const int t = t0 + i;
                const float cu = off + cum[i], cprev = (i == 0) ? off : off + cum[i - 1];
                const float g = FEXP(cu), gi = FEXP(-cu), gm = FEXP(cprev);
                const float ah = -kkn[i] * gm, bh = kkn[i] * icv[i] * gi, kh = kd[i] * gi, rh = rr[i] * g;
                Ah[t * LT + j] = f2bf(ah); Bh[t * LT + j] = f2bf(bh); Kh[t * LT + j] = f2bf(kh); Rh[t * LT + j] = f2bf(rh);
                if (i & 1) { vt[i >> 1] = pk2(e_prev, vv[i]); bt[i >> 1] = (bt[i >> 1] & 0xFFFFu) | ((unsigned)f2bf(bh) << 16); kt[i >> 1] = (kt[i >> 1] & 0xFFFFu) | ((unsigned)f2bf(kh) << 16); }
                else { e_prev = vv[i]; bt[i >> 1] = f2bf(bh); kt[i >> 1] = f2bf(kh); }
                if (t == RC - 1) GC[j] = g;
            }
            *(u32x4*)(VT + j * LJ + t0) = vt; *(u32x4*)(BhT + j * LJ + t0) = bt; *(u32x4*)(KhT + j * LJ + t0) = kt;
        }
        __syncthreads();
        {
            const bf16_t* X = (wave == 0) ? Ah : (wave & 1) ? Kh : Bh;
            const bf16_t* Y = (wave == 0) ? Bh : (wave == 1) ? Ah : Rh;
#pragma unroll
            for (int xs = 0; xs < 2; ++xs) {
                f32x4 acc[2] = {f32x4{0.f, 0.f, 0.f, 0.f}, f32x4{0.f, 0.f, 0.f, 0.f}};
                mmT<2, 2>(acc, X, LT, xs, Y, LT, lane);
#pragma unroll
                for (int nb = 0; nb < 2; ++nb) {
                    const int yy = nb * 16 + l15, x0 = xs * 16 + q * 4;
                    f32x4 v = acc[nb];
#pragma unroll
                    for (int r = 0; r < 4; ++r) { const int xx = x0 + r; const bool keep = (wave == 0) ? (yy < xx) : (wave == 1) ? (xx < yy) : (xx <= yy); v[r] = keep ? v[r] : 0.f; }
                    if (wave == 0) {
                        bf16_t* Pb0 = (bf16_t*)(smem + R_PB0); bf16_t* Pt0 = (bf16_t*)(smem + R_PT0); bf16_t* Tb0 = (bf16_t*)(smem + R_TB0);
                        *(U2*)(Pb0 + yy * LJ + x0) = pack4(v);
#pragma unroll
                        for (int r = 0; r < 4; ++r) Pt0[(x0 + r) * LJ + yy] = f2bf(v[r]);
                        f32x4 t0 = v;
#pragma unroll
                        for (int r = 0; r < 4; ++r) t0[r] += (x0 + r == yy) ? 1.0f : 0.0f;
                        *(f32x4*)(IA + yy * 36 + x0) = t0; *(U2*)(Tb0 + yy * LJ + x0) = pack4(t0);
                    }
                    else { bf16_t* dst = (wave == 1 ? NkaT : wave == 2 ? MbrT : MkrT) + yy * LJ + x0; *(U2*)dst = pack4(v); }
                }
            }
        }
        __syncthreads();
        {
#pragma unroll
            for (int xs = 0; xs < 2; ++xs) {
                f32x4 acc[1] = {f32x4{0.f, 0.f, 0.f, 0.f}};
                mmT<1, 1>(acc, NkaT, LJ, xs, VT + wave * 16 * LJ, LJ, lane);
                const int i = wave * 16 + l15, tb = xs * 16 + q * 4;
                Xu[i * 33 + tb] = acc[0][0]; Xu[i * 33 + tb + 1] = acc[0][1]; Xu[i * 33 + tb + 2] = acc[0][2]; Xu[i * 33 + tb + 3] = acc[0][3];
            }
        }
        __syncthreads();
        {
            bf16_t* Tb[2] = {(bf16_t*)(smem + R_TB0), (bf16_t*)(smem + R_TB1)};
            bf16_t* Pb[2] = {(bf16_t*)(smem + R_PB0), (bf16_t*)(smem + R_PB1)};
            bf16_t* Pt[2] = {(bf16_t*)(smem + R_PT0), (bf16_t*)(smem + R_PT1)};
            const int nb = wave >> 1, xs = wave & 1;
            const int yy = nb * 16 + l15, x0 = xs * 16 + q * 4;
            auto prod = [&](const bf16_t* L, const bf16_t* Rt, f32x4 init) {
                const bf16x8 xf = *(const bf16x8*)(Rt + (xs * 16 + l15) * LJ + 8 * q), yf = *(const bf16x8*)(L + (nb * 16 + l15) * LJ + 8 * q);
                return MFMA16(xf, yf, init);
            };
            const f32x4 zero = f32x4{0.f, 0.f, 0.f, 0.f};
#pragma unroll
            for (int k = 0; k < 5; ++k) {
                const int pc = k & 1, pn = pc ^ 1;
                f32x4 tnew = zero, pnew = zero;
                if (k >= 1) tnew = prod(Tb[pn], Pt[pc], *(const f32x4*)(IA + yy * 36 + x0));
                if (k <= 3) pnew = prod(Pb[pc], Pt[pc], zero);
                if (k >= 1) { *(f32x4*)(IA + yy * 36 + x0) = tnew; if (k <= 3) *(U2*)(Tb[pc] + yy * LJ + x0) = pack4(tnew); }
                if (k <= 3) {
                    *(U2*)(Pb[pn] + yy * LJ + x0) = pack4(pnew);
#pragma unroll
                    for (int r = 0; r < 4; ++r) Pt[pn][(x0 + r) * LJ + yy] = f2bf(pnew[r]);
                }
                __syncthreads();
            }
            f32x4 accw[2], accu[2];
#pragma unroll
            for (int tc = 0; tc < 2; ++tc) { accw[tc] = f32x4{0.f, 0.f, 0.f, 0.f}; accu[tc] = f32x4{0.f, 0.f, 0.f, 0.f}; }
#pragma unroll
            for (int k0 = 0; k0 < 32; k0 += 4) {
                const float la = bf2f(Ah[(k0 + q) * LT + wave * 16 + l15]), lu = Xu[(wave * 16 + l15) * 33 + k0 + q];
#pragma unroll
                for (int tc = 0; tc < 2; ++tc) { const float rv = IA[(k0 + q) * 36 + tc * 16 + l15]; accw[tc] = MFMAF32(la, rv, accw[tc]); accu[tc] = MFMAF32(lu, rv, accu[tc]); }
            }
            __syncthreads();
#pragma unroll
            for (int tc = 0; tc < 2; ++tc)
#pragma unroll
                for (int r = 0; r < 4; ++r) { const int row = wave * 16 + q * 4 + r, col = tc * 16 + l15; Wa[row * LJ + col] = f2bf(accw[tc][r]); U0[row * LJ + col] = f2bf(accu[tc][r]); }
        }
        __syncthreads();
        {
            bf16_t* gPm = (bf16_t*)(chp + CH_PM); bf16_t* gSA = (bf16_t*)(chp + CH_SA); bf16_t* gQT = (bf16_t*)(chp + CH_QT); bf16_t* gY0 = (bf16_t*)(chp + CH_Y0);
            const int x0 = wave * 16 + q * 4;
            {
                f32x4 acc[4] = {f32x4{0.f, 0.f, 0.f, 0.f}, f32x4{0.f, 0.f, 0.f, 0.f}, f32x4{0.f, 0.f, 0.f, 0.f}, f32x4{0.f, 0.f, 0.f, 0.f}};
                mmT<4, 1>(acc, Wa, LJ, wave, BhT, LJ, lane);
#pragma unroll
                for (int nb = 0; nb < 4; ++nb) {
                    const int jp = nb * 16 + l15; const float g = GC[jp];
                    f32x4 v = acc[nb];
#pragma unroll
                    for (int r = 0; r < 4; ++r) v[r] = (v[r] + ((x0 + r == jp) ? 1.0f : 0.0f)) * g;
                    *(U2*)(gPm + jp * 64 + x0) = pack4(v);
                }
            }
            {
                f32x4 acc[4] = {f32x4{0.f, 0.f, 0.f, 0.f}, f32x4{0.f, 0.f, 0.f, 0.f}, f32x4{0.f, 0.f, 0.f, 0.f}, f32x4{0.f, 0.f, 0.f, 0.f}};
                mmT<4, 1>(acc, BhT, LJ, wave, U0, LJ, lane);
                mmT<4, 1>(acc, KhT, LJ, wave, VT, LJ, lane);
                const f32x4 g = *(const f32x4*)(GC + x0);
#pragma unroll
                for (int nb = 0; nb < 4; ++nb) *(U2*)(gSA + (nb * 16 + l15) * 64 + x0) = pack4(acc[nb] * g);
            }
            if (seg == 1) {
                {
                    f32x4 acc[2] = {f32x4{0.f, 0.f, 0.f, 0.f}, f32x4{0.f, 0.f, 0.f, 0.f}};
                    mmT<2, 1>(acc, Wa, LJ, wave, MbrT, LJ, lane);
#pragma unroll
                    for (int nb = 0; nb < 2; ++nb) {
                        const int t = nb * 16 + l15;
                        f32x4 v = acc[nb];
#pragma unroll
                        for (int r = 0; r < 4; ++r) v[r] += bf2f(Rh[t * LT + x0 + r]);
                        *(U2*)(gQT + t * 64 + x0) = pack4(v);
                    }
                }
                {
                    f32x4 acc[2] = {f32x4{0.f, 0.f, 0.f, 0.f}, f32x4{0.f, 0.f, 0.f, 0.f}};
                    mmT<2, 1>(acc, U0, LJ, wave, MbrT, LJ, lane);
                    mmT<2, 1>(acc, VT, LJ, wave, MkrT, LJ, lane);
#pragma unroll
                    for (int nb = 0; nb < 2; ++nb) *(U2*)(gY0 + (nb * 16 + l15) * 64 + x0) = pack4(acc[nb]);
                }
            }
        }
        if (threadIdx.x == 0) { const int v = pool0 + (int)pool_v; *nextw = dyn_next ? (v < NITEM ? v : -1) : it + 1; }
        __syncthreads();
        it = *nextw;
    }
}

__device__ __forceinline__ U2 ldu2(const bf16_t* p) { return *(const U2*)p; }
constexpr int R2D = 6, R2LD = 72;
__device__ __forceinline__ void phaseR2(const Params& p, int bid, int nblk, char* smem) {
    unsigned char* CH = p.ws + WS_CH;
    bf16_t* PL = (bf16_t*)smem;
    const int tid = opaque_tid(), lane = tid & 63, wave = tid >> 6, q = lane >> 4, l15 = lane & 15;
    const int lrow = wave * 16 + (lane >> 2), lcol = (lane & 3) * 16;
    for (int chain = bid; chain < NCHAIN; chain += nblk) {
        const int i = wave * 16 + l15;
        unsigned char* chbase = CH + (size_t)chain * NCK * CH_BYTES;
        f32x4 st[4];
#pragma unroll
        for (int nt = 0; nt < 4; ++nt) st[nt] = f32x4{0.f, 0.f, 0.f, 0.f};
        u32x4 pq[R2D][2]; U2 sa[R2D][4];
#pragma unroll
        for (int k = 0; k < R2D; ++k) {
            const unsigned char* chp = chbase + (size_t)(k < NCK ? k : NCK - 1) * CH_BYTES;
            const bf16_t* gp = (const bf16_t*)(chp + CH_PM) + lrow * 64 + lcol;
            pq[k][0] = *(const u32x4*)gp; pq[k][1] = *(const u32x4*)(gp + 8);
#pragma unroll
            for (int nt = 0; nt < 4; ++nt) sa[k][nt] = ldu2((const bf16_t*)(chp + CH_SA) + i * 64 + nt * 16 + 4 * q);
        }
#pragma unroll 1
        for (int c0 = 0; c0 < NCK; c0 += R2D) {
#pragma unroll
            for (int k = 0; k < R2D; ++k) {
                const int c = c0 + k;
                if (c < NCK) {
                bf16_t* pl = PL + (k & 1) * 64 * R2LD;
                *(u32x4*)(pl + lrow * R2LD + lcol) = pq[k][0]; *(u32x4*)(pl + lrow * R2LD + lcol + 8) = pq[k][1];
                f32x4 ini[4];
#pragma unroll
                for (int nt = 0; nt < 4; ++nt) ini[nt] = f32x4{bitsf(sa[k][nt].x << 16), bitsf(sa[k][nt].x & 0xFFFF0000u), bitsf(sa[k][nt].y << 16), bitsf(sa[k][nt].y & 0xFFFF0000u)};
                {
                    const int cn = (c + R2D < NCK) ? c + R2D : NCK - 1;
                    const unsigned char* chp = chbase + (size_t)cn * CH_BYTES;
                    const bf16_t* gp = (const bf16_t*)(chp + CH_PM) + lrow * 64 + lcol;
                    pq[k][0] = *(const u32x4*)gp; pq[k][1] = *(const u32x4*)(gp + 8);
#pragma unroll
                    for (int nt = 0; nt < 4; ++nt) sa[k][nt] = ldu2((const bf16_t*)(chp + CH_SA) + i * 64 + nt * 16 + 4 * q);
                }
                __syncthreads();
                bf16_t* gSA = (bf16_t*)(chbase + (size_t)c * CH_BYTES + CH_SA) + i * 64 + 4 * q;
                bf16x8 bfr[2];
#pragma unroll
                for (int ks = 0; ks < 2; ++ks) {
                    const U2 lo = pack4(st[2 * ks]), hi = pack4(st[2 * ks + 1]);
                    bfr[ks] = __builtin_bit_cast(bf16x8, u32x4{lo.x, lo.y, hi.x, hi.y});
                    *(U2*)(gSA + (2 * ks) * 16) = lo; *(U2*)(gSA + (2 * ks + 1) * 16) = hi;
                }
#pragma unroll
                for (int nt = 0; nt < 4; ++nt) {
                    f32x4 acc = ini[nt];
#pragma unroll
                    for (int ks = 0; ks < 2; ++ks) {
                        const U2 lo = *(const U2*)(pl + (nt * 16 + l15) * R2LD + 32 * ks + 4 * q), hi = *(const U2*)(pl + (nt * 16 + l15) * R2LD + 32 * ks + 16 + 4 * q);
                        acc = MFMA16(__builtin_bit_cast(bf16x8, u32x4{lo.x, lo.y, hi.x, hi.y}), bfr[ks], acc);
                    }
                    st[nt] = acc;
                }
                }
            }
        }
        __syncthreads();
    }
}

__device__ __forceinline__ void phaseR3(const Params& p, int bid, int nblk, char* smem) {
    const bf16_t* P = WSP(bf16_t, WS_R1);
    const unsigned char* CH = p.ws + WS_CH;
    const float* RBON = WSP(float, WS_RBON);
    bf16_t* MIX = WSP(bf16_t, WS_R3);
    float* red = (float*)smem;
    const int tid = opaque_tid(), lane = tid & 63, wave = tid >> 6, q = lane >> 4, l15 = lane & 15;
    for (int m = bid * 256 + tid; m < MLAT; m += nblk * 256) {
        const float* sp = WSP(float, WS_SSQP) + (size_t)m * LRU_BLOCKS;
        float sq = 0.f;
#pragma unroll
        for (int c = 0; c < LRU_BLOCKS; ++c) sq += sp[c];
        WSP(float, WS_RINV)[m] = frsq(sq * (1.0f / D_LRU) + RMS_EPS);
    }
    bf16_t* G2T = (bf16_t*)(smem + 1024);
    const int nbh = nblk / HEADS;
    const bool uniform = (nbh > 0) && (nblk % HEADS == 0);
    constexpr int NP16 = SEQ / 16, NW = BATCH * NP16;
    const int nwv = uniform ? nbh * 4 : nblk * 4;
    int hcur = -1;
    for (int wi0 = (uniform ? (bid % nbh) : bid) * 4; wi0 < (uniform ? NW : NW * HEADS); wi0 += nwv) {
        int h; if (uniform) h = bid / nbh; else h = (wi0 / 4) % HEADS;
        if (h != hcur) {
            __syncthreads();
            for (int idx = tid; idx < 128 * 16; idx += 256) {
                const int c = idx >> 4, i4 = (idx & 15) * 4;
                const f32x4 w = ld4(p.g2 + (size_t)c * D_RWKV + h * 64 + i4);
                bf16_t* dst = G2T + i4 * 136 + c;
                dst[0] = f2bf(w[0]); dst[136] = f2bf(w[1]); dst[272] = f2bf(w[2]); dst[408] = f2bf(w[3]);
            }
            hcur = h;
            __syncthreads();
        }
        const int wi = uniform ? wi0 + wave : (wi0 / 4 / HEADS) * 4 + wave;
        if (wi >= NW) continue;
        const int b = wi / NP16, p16 = wi % NP16, pc = p16 >> 1, pl = (p16 & 1) * 16 + l15, pos = pc * RC + pl;
        f32x4 y[4], g[4];
#pragma unroll
        for (int xs = 0; xs < 4; ++xs) { y[xs] = f32x4{0.f, 0.f, 0.f, 0.f}; g[xs] = f32x4{0.f, 0.f, 0.f, 0.f}; }
        float bon = 0.f;
#pragma unroll
        for (int d = 0; d < 2; ++d) {
            const int chain = (b * HEADS + h) * 2 + d, c = NCC + (d ? NLC - 1 - pc : pc), tau = d ? RC - 1 - pl : pl;
            const size_t item = (size_t)chain * NCK + c;
            const unsigned char* chp = CH + item * CH_BYTES;
            const bf16_t* gS = (const bf16_t*)(chp + CH_SA); const bf16_t* gQT = (const bf16_t*)(chp + CH_QT); const bf16_t* gY0 = (const bf16_t*)(chp + CH_Y0);
            bf16x8 yf[2];
#pragma unroll
            for (int ks = 0; ks < 2; ++ks) yf[ks] = *(const bf16x8*)(gQT + tau * 64 + ks * 32 + 8 * q);
#pragma unroll
            for (int xs = 0; xs < 4; ++xs) {
                f32x4 acc = ldb4(gY0 + tau * 64 + xs * 16 + 4 * q);
#pragma unroll
                for (int ks = 0; ks < 2; ++ks) acc = MFMA16(*(const bf16x8*)(gS + (xs * 16 + l15) * 64 + ks * 32 + 8 * q), yf[ks], acc);
                y[xs] += acc;
            }
            bon += RBON[item * RC + tau];
        }
#pragma unroll
        for (int ks = 0; ks < 4; ++ks) {
            float o[8]; shifted8(p, P, 1, b, pos, SEQ, 3 * D_RWKV + 256 + ks * 32 + 8 * q, o);
            u32x4 t; t[0] = pk2(fsigm(o[0]), fsigm(o[1])); t[1] = pk2(fsigm(o[2]), fsigm(o[3])); t[2] = pk2(fsigm(o[4]), fsigm(o[5])); t[3] = pk2(fsigm(o[6]), fsigm(o[7]));
            const bf16x8 sg = __builtin_bit_cast(bf16x8, t);
#pragma unroll
            for (int xs = 0; xs < 4; ++xs) g[xs] = MFMA16(*(const bf16x8*)(G2T + (xs * 16 + l15) * 136 + ks * 32 + 8 * q), sg, g[xs]);
        }
        float s1 = 0.f, s2 = 0.f;
#pragma unroll
        for (int xs = 0; xs < 4; ++xs) { s1 += hsum4(y[xs]); s2 += hsum4(y[xs] * y[xs]); }
        s1 += __shfl_xor(s1, 16); s1 += __shfl_xor(s1, 32); s2 += __shfl_xor(s2, 16); s2 += __shfl_xor(s2, 32);
        const float mu = s1 * (1.0f / 64.0f), var = fmaxf(s2 * (1.0f / 64.0f) - mu * mu, 0.f), rstd = frsq(var + GN_EPS);
        const size_t mrow = rwkv_row(1, b, pos);
        const size_t mprev = pos > 0 ? rwkv_row(1, b, pos - 1) : mrow, mnext = pos < SEQ - 1 ? rwkv_row(1, b, pos + 1) : mrow;
#pragma unroll
        for (int xs = 0; xs < 4; ++xs) {
            const int i0 = xs * 16 + q * 4, chv = 2 * D_RWKV + h * 64 + i0;
            const f32x4 z = ldb4(P + mrow * D_IN + RW0 + chv);
            f32x4 zp = ldb4(P + mprev * D_IN + RW0 + chv), zn = ldb4(P + mnext * D_IN + RW0 + chv);
            if (pos == 0) zp = f32x4{0.f, 0.f, 0.f, 0.f};
            if (pos == SEQ - 1) zn = f32x4{0.f, 0.f, 0.f, 0.f};
            const f32x4 v = z + ld4(p.mu_prev + chv) * (zp - z) + ld4(p.mu_next + chv) * (zn - z);
            const f32x4 yn = (y[xs] - mu) * rstd * ld4(p.gn_g + h * 64 + i0) + ld4(p.gn_b + h * 64 + i0);
            *(U2*)(MIX + mrow * D_MIX + D_LRU + h * 64 + i0) = pack4((yn + bon * v) * g[xs]);
        }
    }
}

__device__ __forceinline__ void phaseJ(const Params& p, int bid, int nblk, char* smem) {
    const bf16_t* MIX = WSP(bf16_t, WS_R3); const bf16_t* WB = WSP(bf16_t, WS_WBOUT);
    bf16_t* YOUT = WSP(bf16_t, WS_R1);
    const float* RINV = WSP(float, WS_RINV);
    constexpr int BM = 32 * MI_J, NTN = D_MODEL / 128, NTM = MLAT / BM;
    constexpr int GM = (NTM % 8 == 0) ? 8 : 1;
    for (int it = xcd_vbid(bid, nblk); it < NTN * NTM; it += nblk) {
        const int mg = it / (GM * NTN), r = it % (GM * NTN), nt = r / GM, mt = mg * GM + (r % GM);
        gemm_tile<MI_J, false>(smem, MIX, D_MIX, nullptr, mt * BM, WB, nullptr, D_MIX, nt * 128, D_MIX, [&](int ml, int nl, f32x4 v, f32x4) {
            *(U2*)(YOUT + (size_t)(mt * BM + ml) * D_MODEL + nt * 128 + nl) = pack4(v);
        }, RINV, D_LRU / 64);
    }
}

constexpr int KUL = D_MODEL + 2;
static_assert((16 * KUL + 4 * 256) * 4 <= SMEM_BYTES && N_EXPERTS <= 16 && MLAT % 16 == 0, "phase K lds");
__device__ __forceinline__ void phaseK(const Params& p, int bid, int nblk, char* smem) {
    const int tid = opaque_tid(), lane = tid & 63, wave = tid >> 6, q = lane >> 4, l15 = lane & 15;
    const float* MOD = WSP(float, WS_MOD); const float* STATS = WSP(float, WS_STATS);
    const bf16_t* YOUT = WSP(bf16_t, WS_R1);
    float* H1 = WSP(float, WS_R5); bf16_t* U2b = WSP(bf16_t, WS_R6); float* AFF = WSP(float, WS_AFF);
    float* UL = (float*)smem;
    float* PL = UL + 16 * KUL;
    for (int rb = bid; rb < MLAT / 16; rb += nblk) {
        __syncthreads();
#pragma unroll 1
        for (int rr = 0; rr < 4; ++rr) {
            const int lr = wave * 4 + rr, row = rb * 16 + lr;
            const float* xr = p.x + (size_t)row * D_MODEL;
            const float* md = MOD + (size_t)(row / SEQ) * 6 * D_MODEL;
            const float mu0 = STATS[row * 2], rs0 = STATS[row * 2 + 1];
            f32x4 v0, v1, v2, v3; float s = 0.f;
#define PK_LOAD(V, J) { const int k = (J) * 256 + lane * 4; \
            V = ALPHA_F * ((ld4(xr + k) - mu0) * rs0 * ld4(p.ln_in_g + k) + ld4(p.ln_in_b + k)) + ld4(md + 2 * D_MODEL + k) * ldb4(YOUT + (size_t)row * D_MODEL + k); s += hsum4(V); }
            PK_LOAD(v0, 0)
            if (NV > 1) PK_LOAD(v1, 1) else v1 = f32x4{0.f, 0.f, 0.f, 0.f};
            if (NV > 2) { PK_LOAD(v2, 2) PK_LOAD(v3, 3) } else { v2 = v1; v3 = v1; }
#undef PK_LOAD
            const float mu = wave_sum(s) * (1.0f / D_MODEL);
            v0 -= mu; float s2 = hsum4(v0 * v0);
            if (NV > 1) { v1 -= mu; s2 += hsum4(v1 * v1); }
            if (NV > 2) { v2 -= mu; v3 -= mu; s2 += hsum4(v2 * v2) + hsum4(v3 * v3); }
            const float rstd = frsq(wave_sum(s2) * (1.0f / D_MODEL) + LN_EPS);
#pragma unroll
            for (int j = 0; j < NV; ++j) {
                const int k = j * 256 + lane * 4;
                const f32x4 vv = (j == 0) ? v0 : (j == 1) ? v1 : (j == 2) ? v2 : v3;
                const f32x4 h = vv * rstd * ld4(p.ln1_g + k) + ld4(p.ln1_b + k);
                *(f32x4*)(H1 + (size_t)row * D_MODEL + k) = h;
                const f32x4 u = h * (1.0f + ld4(md + 4 * D_MODEL + k)) + ld4(md + 3 * D_MODEL + k);
                *(U2*)(U2b + (size_t)row * D_MODEL + k) = pack4(u);
                float* ul = UL + lr * KUL + k;
                *(f32x2_e*)ul = f32x2_e{u[0], u[1]}; *(f32x2_e*)(ul + 2) = f32x2_e{u[2], u[3]};
            }
        }
        __syncthreads();
        {
            f32x4 acc = f32x4{0.f, 0.f, 0.f, 0.f};
            const int kq0 = wave * (D_MODEL / 4);
#pragma unroll 8
            for (int s4 = 0; s4 < D_MODEL / 16; ++s4) {
                const int k = kq0 + s4 * 4 + q;
                const float av = UL[l15 * KUL + k];
                const float bv = (l15 < N_EXPERTS) ? p.w_router[(size_t)k * N_EXPERTS + l15] : 0.f;
                acc = MFMAF32(av, bv, acc);
            }
#pragma unroll
            for (int r = 0; r < 4; ++r) PL[wave * 256 + (q * 4 + r) * 16 + l15] = acc[r];
        }
        __syncthreads();
        {
            const int lr = tid >> 4, e = tid & 15;
            const bool valid = e < N_EXPERTS;
            float lg = PL[tid] + PL[256 + tid] + PL[512 + tid] + PL[768 + tid];
            float mx = valid ? lg : -3.0e38f;
#pragma unroll
            for (int o = 1; o < 16; o <<= 1) mx = fmaxf(mx, __shfl_xor(mx, o));
            const float ex = valid ? expf(lg - mx) : 0.f;
            float den = ex;
#pragma unroll
            for (int o = 1; o < 16; o <<= 1) den += __shfl_xor(den, o);
            if (valid) AFF[(size_t)(rb * 16 + lr) * N_EXPERTS + e] = ex / den;
        }
    }
}

__device__ __forceinline__ int block_sum_int(int v, int* red) {
    const int tid_ = opaque_tid(), lane = tid_ & 63, wave = tid_ >> 6;
#pragma unroll
    for (int o = 1; o < 64; o <<= 1) v += __shfl_xor(v, o);
    __syncthreads();
    if (lane == 0) red[wave] = v;
    __syncthreads();
    return red[0] + red[1] + red[2] + red[3];
}
__device__ __forceinline__ void phaseL(const Params& p, int bid, int nblk, char* smem) {
    const float* AFF = WSP(float, WS_AFF);
    int* IDX = WSP(int, WS_IDX); float* GATE = WSP(float, WS_GATE); int* SLOTOF = WSP(int, WS_SLOT);
    unsigned* vals = (unsigned*)smem;
    int* red = (int*)(vals + SEQ);
    int* wsum = red + 8;
    const int tid = opaque_tid(), lane = tid & 63, wave = tid >> 6;
    constexpr int PER = SEQ / 256;
    {
        constexpr int NL = BATCH * N_EXPERTS;
        const bool spare = nblk > NL + 32;
        if (spare ? (bid >= NL) : true) convert_experts(p, spare ? bid - NL : bid, spare ? nblk - NL : nblk, smem, 0, 2);
        if (spare && bid >= NL) return;
        __syncthreads();
    }
    for (int be = bid; be < BATCH * N_EXPERTS; be += nblk) {
        const int b = be / N_EXPERTS, e = be % N_EXPERTS;
        __syncthreads();
        for (int t = tid; t < SEQ; t += 256) vals[t] = fbits(AFF[((size_t)b * SEQ + t) * N_EXPERTS + e]);
        __syncthreads();
        unsigned lo = 0u, hi = 0x7F800000u;
        while (lo < hi) {
            const unsigned mid = lo + (hi - lo + 1u) / 2u;
            int c = 0;
            for (int t = tid; t < SEQ; t += 256) c += (vals[t] >= mid) ? 1 : 0;
            c = block_sum_int(c, red);
            if (c >= CAP) lo = mid; else hi = mid - 1u;
        }
        const unsigned T = lo;
        int cg = 0, ce = 0;
        for (int q = 0; q < PER; ++q) { const unsigned v = vals[tid * PER + q]; cg += (v > T) ? 1 : 0; ce += (v == T) ? 1 : 0; }
        int pg = cg, pe = ce;
#pragma unroll
        for (int o = 1; o < 64; o <<= 1) { const int a = __shfl_up(pg, o), bb = __shfl_up(pe, o); if (lane >= o) { pg += a; pe += bb; } }
        __syncthreads();
        if (lane == 63) { wsum[wave] = pg; wsum[4 + wave] = pe; }
        __syncthreads();
        int og = 0, oe = 0, totg = 0;
        for (int w = 0; w < 4; ++w) { if (w < wave) { og += wsum[w]; oe += wsum[4 + w]; } totg += wsum[w]; }
        int posg = og + pg - cg, pose = oe + pe - ce;
        const int need_eq = CAP - totg;
        for (int q = 0; q < PER; ++q) {
            const int t = tid * PER + q; const unsigned v = vals[t];
            int slot = -1;
            if (v > T) { slot = posg++; }
            else if (v == T) { if (pose < need_eq) slot = totg + pose; pose++; }
            if (slot >= 0) { IDX[(size_t)be * CAP + slot] = b * SEQ + t; GATE[(size_t)be * CAP + slot] = bitsf(v); }
            SLOTOF[((size_t)b * SEQ + t) * N_EXPERTS + e] = slot;
        }
    }
}

__device__ __forceinline__ void phaseM(const Params& p, int bid, int nblk, char* smem) {
    const bf16_t* U2b = WSP(bf16_t, WS_R6); const int* IDX = WSP(int, WS_IDX);
    bf16_t* HID = WSP(bf16_t, WS_R1);
    constexpr int BM = 32 * MI_E, NTN = D_EXPERT / 64, NTM = CAP / BM;
    for (int it = xcd_vbid(bid, nblk); it < BATCH * N_EXPERTS * NTM * NTN; it += nblk) {
        const int mt = it % NTM, b = (it / NTM) % BATCH, nt = (it / (NTM * BATCH)) % NTN, e = it / (NTM * BATCH * NTN), be = b * N_EXPERTS + e;
        const bf16_t* wg = WSP(bf16_t, WS_WG + (size_t)e * WEXP_BYTES); const bf16_t* wu = WSP(bf16_t, WS_WU + (size_t)e * WEXP_BYTES);
        gemm_tile<MI_E, true>(smem, U2b, D_MODEL, IDX + (size_t)be * CAP, mt * BM, wg, wu, D_MODEL, nt * 64, D_MODEL, [&](int ml, int nl, f32x4 g, f32x4 u) {
            U2 o; o.x = pk2(siluf_(g[0]) * u[0], siluf_(g[1]) * u[1]); o.y = pk2(siluf_(g[2]) * u[2], siluf_(g[3]) * u[3]);
            *(U2*)(HID + ((size_t)be * CAP + mt * BM + ml) * D_EXPERT + nt * 64 + nl) = o;
        });
    }
    {
        constexpr int NT = BATCH * N_EXPERTS * NTM * NTN;
        const int rem = NT % nblk, vb = xcd_vbid(bid, nblk);
        if (rem == 0 || nblk - rem < 32) convert_experts(p, vb, nblk, smem, 2, 3);
        else if (vb >= rem) convert_experts(p, vb - rem, nblk - rem, smem, 2, 3);
    }
}
__device__ __forceinline__ void phaseN(const Params& p, int bid, int nblk, char* smem) {
    const bf16_t* HID = WSP(bf16_t, WS_R1); const float* GATE = WSP(float, WS_GATE);
    bf16_t* YS = WSP(bf16_t, WS_R2);
    constexpr int BM = 32 * MI_E, NTN = D_MODEL / 128, NTM = CAP / BM;
    for (int it = xcd_vbid(bid, nblk); it < BATCH * N_EXPERTS * NTM * NTN; it += nblk) {
        const int mt = it % NTM, b = (it / NTM) % BATCH, nt = (it / (NTM * BATCH)) % NTN, e = it / (NTM * BATCH * NTN), be = b * N_EXPERTS + e;
        const bf16_t* wd = WSP(bf16_t, wdown_off(e));
        gemm_tile<MI_E, false>(smem, HID + (size_t)be * CAP * D_EXPERT, D_EXPERT, nullptr, mt * BM, wd, nullptr, D_EXPERT, nt * 128, D_EXPERT, [&](int ml, int nl, f32x4 v, f32x4) {
            const int slot = mt * BM + ml;
            const float gt = GATE[(size_t)be * CAP + slot];
            *(U2*)(YS + ((size_t)be * CAP + slot) * D_MODEL + nt * 128 + nl) = pack4(v * gt);
        });
    }
}
__device__ __forceinline__ void phaseO(const Params& p, int bid, int nblk, char* smem) {
    const int tid_ = opaque_tid(), lane = tid_ & 63, wave = tid_ >> 6;
    const float* MOD = WSP(float, WS_MOD); const float* H1 = WSP(float, WS_R5); const bf16_t* YS = WSP(bf16_t, WS_R2); const int* SLOTOF = WSP(int, WS_SLOT);
    int row = bid * 4 + wave;
    f32x4 n0 = f32x4{0.f, 0.f, 0.f, 0.f}, n1 = n0, n2 = n0, n3 = n0; int nslot = -1;
    if (row < MLAT) { const float* hr = H1 + (size_t)row * D_MODEL; n0 = ld4(hr + lane * 4); if (NV > 1) n1 = ld4(hr + 256 + lane * 4); if (NV > 2) { n2 = ld4(hr + 512 + lane * 4); n3 = ld4(hr + 768 + lane * 4); }
                      nslot = (lane < N_EXPERTS) ? SLOTOF[(size_t)row * N_EXPERTS + lane] : -1; }
    for (; row < MLAT; row += nblk * 4) {
        const float* md = MOD + (size_t)(row / SEQ) * 6 * D_MODEL;
        const f32x4 h0 = n0, h1 = n1, h2 = n2, h3 = n3; const int myslot = nslot;
        const int nrow = row + nblk * 4;
        if (nrow < MLAT) { const float* hr = H1 + (size_t)nrow * D_MODEL; n0 = ld4(hr + lane * 4); if (NV > 1) n1 = ld4(hr + 256 + lane * 4); if (NV > 2) { n2 = ld4(hr + 512 + lane * 4); n3 = ld4(hr + 768 + lane * 4); }
                           nslot = (lane < N_EXPERTS) ? SLOTOF[(size_t)nrow * N_EXPERTS + lane] : -1; }
        f32x4 y0 = f32x4{0.f, 0.f, 0.f, 0.f}, y1 = y0, y2 = y0, y3 = y0;
        const int bbase = (row / SEQ) * N_EXPERTS;
        for (int e = 0; e < N_EXPERTS; ++e) {
            const int sl = __shfl(myslot, e);
            if (sl >= 0) {
                const bf16_t* yr = YS + ((size_t)(bbase + e) * CAP + sl) * D_MODEL + lane * 4;
                y0 += ldb4(yr);
                if (NV > 1) y1 += ldb4(yr + 256);
                if (NV > 2) { y2 += ldb4(yr + 512); y3 += ldb4(yr + 768); }
            }
        }
        f32x4 v0, v1, v2, v3; float s = 0.f;
        v0 = ALPHA_F * h0 + ld4(md + 5 * D_MODEL + lane * 4) * y0; s += hsum4(v0);
        if (NV > 1) { v1 = ALPHA_F * h1 + ld4(md + 5 * D_MODEL + 256 + lane * 4) * y1; s += hsum4(v1); } else v1 = f32x4{0.f, 0.f, 0.f, 0.f};
        if (NV > 2) { v2 = ALPHA_F * h2 + ld4(md + 5 * D_MODEL + 512 + lane * 4) * y2; v3 = ALPHA_F * h3 + ld4(md + 5 * D_MODEL + 768 + lane * 4) * y3; s += hsum4(v2) + hsum4(v3); } else { v2 = v1; v3 = v1; }
        const float mu = wave_sum(s) * (1.0f / D_MODEL);
        v0 -= mu; float s2 = hsum4(v0 * v0);
        if (NV > 1) { v1 -= mu; s2 += hsum4(v1 * v1); }
        if (NV > 2) { v2 -= mu; v3 -= mu; s2 += hsum4(v2 * v2) + hsum4(v3 * v3); }
        const float rstd = frsq(wave_sum(s2) * (1.0f / D_MODEL) + LN_EPS);
#pragma unroll
        for (int j = 0; j < NV; ++j) {
            const int k = j * 256 + lane * 4;
            const f32x4 vv = (j == 0) ? v0 : (j == 1) ? v1 : (j == 2) ? v2 : v3;
            *(f32x4*)(p.out + (size_t)row * D_MODEL + k) = vv * rstd * ld4(p.ln2_g + k) + ld4(p.ln2_b + k);
        }
    }
}

#define XB_TMO      128
#define XB_XCNT(j)  (256  + 64 * (j))
#define XB_XSUB(j)  (1280 + 64 * (j))
#define XB_XGEN(j)  (2304 + 64 * (j))
#define XB_TOP      3328
#define XB_TOPGEN   3392
#define XCD_BAR_WORDS 3456
#define XB_SPIN_CAP (1u << 22)
#ifndef HOST_EMU
__device__ __forceinline__ unsigned xb_ld(unsigned* p) { return __hip_atomic_load(p, __ATOMIC_RELAXED, __HIP_MEMORY_SCOPE_AGENT); }
__device__ __forceinline__ unsigned xb_add(unsigned* p, unsigned v) { return __hip_atomic_fetch_add(p, v, __ATOMIC_RELAXED, __HIP_MEMORY_SCOPE_AGENT); }
__device__ __forceinline__ unsigned xb_xcc_id() { return (unsigned)__builtin_amdgcn_s_getreg((3 << 11) | 20) & 0xFu; }
#define XB_SPIN(cond, bar) do { unsigned _sp = 0; while (cond) { __builtin_amdgcn_s_sleep(1); \
    if ((++_sp & 255u) == 0u) { if (xb_ld(&(bar)[XB_TMO])) break; if (_sp > XB_SPIN_CAP) { atomicAdd(&(bar)[XB_TMO], 1u); break; } } } } while (0)
#define XB_LAS __attribute__((address_space(3)))
struct XcdBarrier { unsigned off; unsigned x; volatile XB_LAS unsigned* st; unsigned G; };
__device__ __forceinline__ XcdBarrier xcd_barrier_post(unsigned* ctrl, unsigned off, volatile XB_LAS unsigned* st, unsigned G, bool member = true) {
    XcdBarrier b; b.off = off; b.x = xb_xcc_id(); b.st = st; b.G = G; unsigned* bar = ctrl + off;
    if (!member) return b;
    if (threadIdx.x == 0) (void)xb_add(&bar[XB_XCNT(b.x)], 1u);
    return b;
}
__device__ __forceinline__ void xcd_barrier_complete(unsigned* bar, unsigned x, unsigned& nloc, unsigned& nx, unsigned G) {
    unsigned sum, cnt, mine, sp = 0u;
    for (;;) {
        sum = 0u; cnt = 0u; mine = 0u;
#pragma unroll
        for (unsigned j = 0; j < 16; ++j) { const unsigned c = xb_ld(&bar[XB_XCNT(j)]); sum += c; cnt += (c > 0u) ? 1u : 0u; mine = (j == x) ? c : mine; }
        if (sum == G) break;
        __builtin_amdgcn_s_sleep(1);
        if ((++sp & 255u) == 0u) { if (xb_ld(&bar[XB_TMO])) break; if (sp > XB_SPIN_CAP) { atomicAdd(&bar[XB_TMO], 1u); break; } }
    }
    nloc = mine > 0u ? mine : 1u; nx = cnt > 0u ? cnt : 1u;
}
__device__ __forceinline__ void grid_barrier(const XcdBarrier& b, unsigned* ctrl) {
    asm volatile("s_waitcnt vmcnt(0)" ::: "memory");
    __syncthreads();
    if (threadIdx.x == 0) {
        unsigned* bar = ctrl + b.off;
        __builtin_amdgcn_s_waitcnt(0);
        volatile XB_LAS unsigned* st = b.st;
        unsigned nloc = st[0], nx = st[1];
        if (nloc == 0u) { xcd_barrier_complete(bar, b.x, nloc, nx, b.G); st[0] = nloc; st[1] = nx; }
        const unsigned old = xb_add(&bar[XB_XSUB(b.x)], 1u);
        const unsigned gen = old / nloc;
        if (old + 1u == (gen + 1u) * nloc) {
            __builtin_amdgcn_fence(__ATOMIC_RELEASE, "agent");
            asm volatile("s_waitcnt vmcnt(0)" ::: "memory");
            const unsigned og = xb_add(&bar[XB_TOP], 1u);
            const unsigned tg = og / nx;
            if (og + 1u == (tg + 1u) * nx) xb_add(&bar[XB_TOPGEN], 1u);
            else XB_SPIN(xb_ld(&bar[XB_TOPGEN]) == tg, bar);
            __builtin_amdgcn_fence(__ATOMIC_ACQUIRE, "agent");
            xb_add(&bar[XB_XGEN(b.x)], 1u);
            asm volatile("s_waitcnt vmcnt(0)" ::: "memory");
        } else {
            XB_SPIN(xb_ld(&bar[XB_XGEN(b.x)]) == gen, bar);
            __builtin_amdgcn_fence(__ATOMIC_ACQUIRE, "agent");
            asm volatile("s_waitcnt vmcnt(0)" ::: "memory");
        }
    }
    __syncthreads();
}
#else
struct XcdBarrier { int dummy; };
__device__ __forceinline__ void grid_barrier(const XcdBarrier&, unsigned*) { __syncthreads(); }
#endif

__global__ void __launch_bounds__(256, 2) fused_forward(Params p) {
    __shared__ __attribute__((aligned(16))) char smem[SMEM_BYTES];
    __shared__ __attribute__((aligned(16))) unsigned xb_words[4];
    if (threadIdx.x == 0) { xb_words[0] = 0u; xb_words[1] = 0u; xb_words[2] = 0u; xb_words[3] = 0u; }
    __syncthreads();
    const int bid = blockIdx.x, nblk = gridDim.x;
    const bool split = nblk >= 2 * NCHAIN;
#ifdef HOST_EMU
    const XcdBarrier gb{0}; const XcdBarrier gs{0};
#else
    const XcdBarrier gb = xcd_barrier_post(WSP(unsigned, WS_CTRL), 0u, (volatile XB_LAS unsigned*)xb_words, (unsigned)nblk);
    const XcdBarrier gs = xcd_barrier_post(WSP(unsigned, WS_CTRL), (unsigned)XCD_BAR_WORDS, (volatile XB_LAS unsigned*)xb_words + 2, (unsigned)(nblk - NCHAIN), split && bid >= NCHAIN);
#endif
    phaseA(p, bid, nblk, smem); grid_barrier(gb, WSP(unsigned, WS_CTRL));
    phaseB(p, bid, nblk, smem); grid_barrier(gb, WSP(unsigned, WS_CTRL));
    phaseC(p, bid, nblk, smem); grid_barrier(gb, WSP(unsigned, WS_CTRL));
    phaseR1(p, bid, nblk, smem); grid_barrier(gb, WSP(unsigned, WS_CTRL));
    {
        const int lb = split ? bid - NCHAIN : bid, ln = split ? nblk - NCHAIN : nblk;
        const bool lru_member = !split || bid >= NCHAIN;
        if (!split || bid < NCHAIN) phaseR2(p, bid, split ? NCHAIN : nblk, smem);
        if (lru_member) phaseD(p, lb, ln, smem);
        if (split) { if (lru_member) grid_barrier(gs, WSP(unsigned, WS_CTRL)); } else grid_barrier(gb, WSP(unsigned, WS_CTRL));
        if (lru_member) phaseE(p, lb, ln, smem);
        if (split) { if (lru_member) grid_barrier(gs, WSP(unsigned, WS_CTRL)); } else grid_barrier(gb, WSP(unsigned, WS_CTRL));
        if (lru_member) phaseF(p, lb, ln, smem);
        grid_barrier(gb, WSP(unsigned, WS_CTRL));
    }
    phaseR3(p, bid, nblk, smem); grid_barrier(gb, WSP(unsigned, WS_CTRL));
    phaseJ(p, bid, nblk, smem); grid_barrier(gb, WSP(unsigned, WS_CTRL));
    phaseK(p, bid, nblk, smem); grid_barrier(gb, WSP(unsigned, WS_CTRL));
    phaseL(p, bid, nblk, smem); grid_barrier(gb, WSP(unsigned, WS_CTRL));
    phaseM(p, bid, nblk, smem); grid_barrier(gb, WSP(unsigned, WS_CTRL));
    phaseN(p, bid, nblk, smem); grid_barrier(gb, WSP(unsigned, WS_CTRL));
    phaseO(p, bid, nblk, smem);
}

#ifdef MULTI_LAUNCH
#define PHASE_KERNEL(NAME) \
    __global__ void __launch_bounds__(256) k_##NAME(Params p) { __shared__ __attribute__((aligned(16))) char smem[SMEM_BYTES]; NAME(p, blockIdx.x, gridDim.x, smem); }
PHASE_KERNEL(phaseA) PHASE_KERNEL(phaseB) PHASE_KERNEL(phaseC) PHASE_KERNEL(phaseD) PHASE_KERNEL(phaseE) PHASE_KERNEL(phaseF) PHASE_KERNEL(phaseR1) PHASE_KERNEL(phaseR2) PHASE_KERNEL(phaseR3)
PHASE_KERNEL(phaseJ) PHASE_KERNEL(phaseK) PHASE_KERNEL(phaseL) PHASE_KERNEL(phaseM) PHASE_KERNEL(phaseN) PHASE_KERNEL(phaseO)
#ifdef HOST_EMU
void emu_hook(const char* name, const Params& p);
#define LAUNCH(NAME, grid) do { EMU_LAUNCH(k_##NAME, grid, 256, p); emu_hook(#NAME, p); } while (0)
#else
#define LAUNCH(NAME, grid) hipLaunchKernelGGL(k_##NAME, dim3(grid), dim3(256), 0, stream, p)
#endif
#endif

extern "C" void kernel_launch(void* const* d_in, const int* in_sizes, int n_in, void* d_out, int out_size, void* d_ws, size_t ws_size, hipStream_t stream) {
    if (n_in != 38 || out_size != MLAT * D_MODEL || ws_size < WS_END) { fprintf(stderr, "kernel_launch: unexpected shapes (n_in %d out %d ws %zu need %zu)\n", n_in, out_size, ws_size, (size_t)WS_END); return; }
    Params p{};
    const float** f = (const float**)&p;
    for (int i = 0; i < 38; ++i) f[i] = (const float*)d_in[i];
    p.out = (float*)d_out; p.ws = (unsigned char*)d_ws;
    (void)hipMemsetAsync((char*)d_ws + WS_CTRL, 0, CTRL_ZERO_BYTES, stream);
#ifdef MULTI_LAUNCH
    const int G = 512;
    LAUNCH(phaseA, 6 * D_MODEL / 16);
    LAUNCH(phaseB, G);
    LAUNCH(phaseC, G);
    LAUNCH(phaseD, G);
    LAUNCH(phaseE, 16);
    LAUNCH(phaseF, G);
    LAUNCH(phaseR1, G);
    LAUNCH(phaseR2, NCHAIN);
    LAUNCH(phaseR3, G);
    LAUNCH(phaseJ, G);
    LAUNCH(phaseK, G);
    LAUNCH(phaseL, BATCH * N_EXPERTS);
    LAUNCH(phaseM, G);
    LAUNCH(phaseN, G);
    LAUNCH(phaseO, G);
#elif defined(HOST_EMU)
    EMU_LAUNCH(fused_forward, 1, 256, p);
#else
    static int grid_blocks = 0;
    if (!grid_blocks) {
        int dev = 0, cus = 0, per_cu = 0;
        (void)hipGetDevice(&dev);
        (void)hipDeviceGetAttribute(&cus, hipDeviceAttributeMultiprocessorCount, dev);
        (void)hipOccupancyMaxActiveBlocksPerMultiprocessor(&per_cu, fused_forward, 256, 0);
        if (per_cu > 2) per_cu = 2;
        if (per_cu < 1) { fprintf(stderr, "kernel_launch: occupancy query returned %d blocks per CU\n", per_cu); per_cu = 1; }
        grid_blocks = cus * per_cu;
    }
    void* args[] = {&p};
    hipError_t e = hipLaunchCooperativeKernel((void*)fused_forward, dim3(grid_blocks), dim3(256), args, 0, stream);
    if (e != hipSuccess) fprintf(stderr, "cooperative launch failed: %s (grid %d)\n", hipGetErrorString(e), grid_blocks);
#endif
}
```

```cpp
#ifndef HOST_EMU
#include <hip/hip_runtime.h>
#include <cstdio>
#endif
#include <cstdint>
#include <cstddef>

#ifdef CFG_SMALL
constexpr int D_MODEL = 256, BATCH = 2, SEQ = 256, GRID_W = 16, CTX_LEN = 64, LRU_BLOCKS = 2, N_EXPERTS = 4, D_EXPERT = 256;
#else
constexpr int D_MODEL = 1024, BATCH = 4, SEQ = 4096, GRID_W = 64, CTX_LEN = 256, LRU_BLOCKS = 8, N_EXPERTS = 16, D_EXPERT = 1408;
#endif
constexpr int ROWS = SEQ / GRID_W;
constexpr int D_LRU = D_MODEL / 2, LRU_BLOCK = 64;
constexpr int D_RWKV = D_MODEL / 2, HEADS = D_RWKV / 64;
constexpr int D_RWKV_IN = 3 * D_RWKV + 128 + 128 + 128;
constexpr int D_IN = 2 * D_LRU + D_RWKV_IN;
constexpr int D_MIX = D_LRU + D_RWKV;
constexpr int CAP = 2 * SEQ / N_EXPERTS;
constexpr int MLAT = BATCH * SEQ, MCTX = BATCH * CTX_LEN, MTOT = MLAT + MCTX;
constexpr int NMOD = BATCH + 1;
constexpr int RW0 = 2 * D_LRU;
constexpr float ALPHA_F = 1.189207115002721f;
constexpr float LN_EPS = 1e-5f, GN_EPS = 64e-5f, RMS_EPS = 1e-6f;
static_assert(LRU_BLOCKS * LRU_BLOCK == D_LRU, "lru blocks");
static_assert(CAP % 128 == 0 && D_IN % 128 == 0 && D_EXPERT % 64 == 0 && D_MODEL % 128 == 0 && MTOT % 128 == 0 && D_MIX % 64 == 0, "tile divisibility");

typedef unsigned short bf16_t;
typedef short bf16x8 __attribute__((ext_vector_type(8)));
typedef float f32x4 __attribute__((ext_vector_type(4)));
typedef unsigned u32x4 __attribute__((ext_vector_type(4)));
typedef float f32x2_e __attribute__((ext_vector_type(2)));
typedef unsigned U2 __attribute__((ext_vector_type(2)));

#ifdef HOST_EMU
#define MFMA16(a, b, c) emu_mfma_16x16x32_bf16(a, b, c)
#define MFMAF32(a, b, c) emu_mfma_16x16x4_f32(a, b, c)
#else
#define MFMA16(a, b, c) __builtin_amdgcn_mfma_f32_16x16x32_bf16(a, b, c, 0, 0, 0)
#define MFMAF32(a, b, c) __builtin_amdgcn_mfma_f32_16x16x4f32(a, b, c, 0, 0, 0)
#endif

__device__ __forceinline__ unsigned fbits(float f) { return __builtin_bit_cast(unsigned, f); }
__device__ __forceinline__ float bitsf(unsigned u) { return __builtin_bit_cast(float, u); }
__device__ __forceinline__ bf16_t f2bf(float f) { unsigned u = fbits(f); u += 0x7FFFu + ((u >> 16) & 1u); return (bf16_t)(u >> 16); }
__device__ __forceinline__ float bf2f(bf16_t h) { return bitsf(((unsigned)h) << 16); }
#ifdef HOST_EMU
__device__ __forceinline__ unsigned pk2(float lo, float hi) { return (unsigned)f2bf(lo) | ((unsigned)f2bf(hi) << 16); }
#else
typedef float f32x2_t __attribute__((ext_vector_type(2)));
typedef __bf16 bf16x2_t __attribute__((ext_vector_type(2)));
__device__ __forceinline__ unsigned pk2(float lo, float hi) { return __builtin_bit_cast(unsigned, __builtin_convertvector(f32x2_t{lo, hi}, bf16x2_t)); }
#endif
__device__ __forceinline__ float softplusf_(float x) { return fmaxf(x, 0.0f) + log1pf(expf(-fabsf(x))); }
#ifdef HOST_EMU
#define FEXP(x) expf(x)
#else
#define FEXP(x) __expf(x)
#endif
#ifdef HOST_EMU
__device__ __forceinline__ float frcp(float x) { return 1.0f / x; }
__device__ __forceinline__ float frsq(float x) { return 1.0f / sqrtf(x); }
__device__ __forceinline__ float fsqrt(float x) { return sqrtf(x); }
#else
__device__ __forceinline__ float frcp(float x) { return __builtin_amdgcn_rcpf(x); }
__device__ __forceinline__ float frsq(float x) { return __builtin_amdgcn_rsqf(x); }
__device__ __forceinline__ float fsqrt(float x) { return __builtin_amdgcn_sqrtf(x); }
#endif
__device__ __forceinline__ float fsigm(float x) { return frcp(1.0f + FEXP(-x)); }
__device__ __forceinline__ float siluf_(float x) { return x * fsigm(x); }
__device__ __forceinline__ float geluf_(float x) { return x * fsigm(1.5957691216057308f * (x + 0.044715f * x * x * x)); }
__device__ __forceinline__ int opaque_tid() {
    int t = threadIdx.x;
#ifndef HOST_EMU
    asm volatile("" : "+v"(t));
#endif
    return t;
}
__device__ __forceinline__ float wave_sum(float v) {
#pragma unroll
    for (int o = 1; o < 64; o <<= 1) v += __shfl_xor(v, o);
    return v;
}

constexpr size_t al256(size_t x) { return (x + 255) & ~(size_t)255; }
constexpr int NLCH = BATCH * (SEQ / 64), NCCH = BATCH * (CTX_LEN / 64), NCH = NLCH + NCCH;
constexpr int R1_POOL_WORD = 8192;
constexpr int LRU_POOL_WORD = R1_POOL_WORD + 64;
constexpr size_t CTRL_ZERO_BYTES = (LRU_POOL_WORD + 32 * 16) * 4;
constexpr size_t WS_CTRL = 0;
constexpr size_t WS_MOD = 65536;
constexpr size_t WS_STATS = al256(WS_MOD + (size_t)NMOD * 6 * D_MODEL * 4);
constexpr size_t WS_SUMA = al256(WS_STATS + (size_t)MTOT * 2 * 4);
constexpr size_t WS_SUMH = al256(WS_SUMA + (size_t)2 * NCH * D_LRU * 4);
constexpr size_t WS_CARRY = al256(WS_SUMH + (size_t)2 * NCH * D_LRU * 4);
constexpr size_t WS_SSQP = al256(WS_CARRY + (size_t)2 * NLCH * D_LRU * 4);
constexpr size_t WS_RINV = al256(WS_SSQP + (size_t)MLAT * LRU_BLOCKS * 4);
constexpr size_t WS_BON = al256(WS_RINV + (size_t)MLAT * 4);
constexpr size_t WS_AFF = al256(WS_BON + (size_t)2 * MLAT * HEADS * 4 + 4096 * 64);
constexpr size_t WS_IDX = al256(WS_AFF + (size_t)MLAT * N_EXPERTS * 4);
constexpr size_t WS_GATE = al256(WS_IDX + (size_t)BATCH * N_EXPERTS * CAP * 4);
constexpr size_t WS_SLOT = al256(WS_GATE + (size_t)BATCH * N_EXPERTS * CAP * 4);
constexpr size_t WS_WBIN = al256(WS_SLOT + (size_t)MLAT * N_EXPERTS * 4);
constexpr size_t WS_WBOUT = al256(WS_WBIN + (size_t)D_IN * D_MODEL * 2);
constexpr size_t WS_LORA = al256(WS_WBOUT + (size_t)D_MODEL * D_MIX * 2);
constexpr size_t WS_R1 = al256(WS_LORA + (size_t)2 * 2 * HEADS * 64 * 64 * 2);
constexpr size_t R1_BYTES = (size_t)MTOT * D_IN * 2 > (size_t)MLAT * D_MODEL * 4 ? ((size_t)MTOT * D_IN * 2 > (size_t)BATCH * N_EXPERTS * CAP * D_EXPERT * 2 ? (size_t)MTOT * D_IN * 2 : (size_t)BATCH * N_EXPERTS * CAP * D_EXPERT * 2)
                                                                                  : ((size_t)MLAT * D_MODEL * 4 > (size_t)BATCH * N_EXPERTS * CAP * D_EXPERT * 2 ? (size_t)MLAT * D_MODEL * 4 : (size_t)BATCH * N_EXPERTS * CAP * D_EXPERT * 2);
constexpr size_t WS_R3 = al256(WS_R1 + R1_BYTES);
constexpr int RC = 32;
constexpr int NCC = CTX_LEN / RC, NLC = SEQ / RC, NCK = NCC + NLC, NCHAIN = BATCH * HEADS * 2;
constexpr size_t CH_PM = 0, CH_SA = 8192, CH_QT = 16384, CH_Y0 = 20480, CH_BYTES = 24576;
constexpr size_t WS_CH = al256(WS_R3 + (size_t)MTOT * D_MODEL * 2);
constexpr size_t CH_TOTAL = (size_t)NCHAIN * NCK * CH_BYTES;
constexpr size_t WS_R5 = WS_CH;
constexpr size_t WS_LA = al256(WS_R5 + (size_t)MLAT * D_MODEL * 4);
constexpr size_t WS_R6 = WS_LA, WS_R2 = WS_LA;
constexpr size_t WEXP_BYTES = (size_t)D_MODEL * D_EXPERT * 2;
constexpr size_t WS_WG = al256(WS_LA + (size_t)MLAT * D_MODEL * 2);
constexpr size_t WS_WU = WS_WG + (size_t)N_EXPERTS * WEXP_BYTES;
constexpr int NE_R3 = ((size_t)MTOT * D_MODEL * 2 / WEXP_BYTES) < (size_t)N_EXPERTS ? (int)((size_t)MTOT * D_MODEL * 2 / WEXP_BYTES) : N_EXPERTS;
constexpr size_t WS_WD2 = WS_WU + (size_t)N_EXPERTS * WEXP_BYTES;
constexpr size_t WS_LATE_END = al256(WS_WD2 + (size_t)(N_EXPERTS - NE_R3) * WEXP_BYTES);
static_assert(WS_LA + (size_t)BATCH * N_EXPERTS * CAP * D_MODEL * 2 <= WS_WD2, "YS must not reach the w_down copies");
constexpr size_t WS_SG = (WS_CH + CH_TOTAL > WS_LATE_END) ? al256(WS_CH + CH_TOTAL) : WS_LATE_END;
constexpr size_t WS_LRUW = al256(WS_SG + (size_t)MLAT * 128 * 2);
constexpr size_t WS_G2T = al256(WS_LRUW + (size_t)LRU_BLOCKS * 4 * 64 * 72 * 2);
constexpr size_t WS_END = al256(WS_G2T + (size_t)HEADS * 64 * 136 * 2);
constexpr size_t WS_RBON = WS_BON;
static_assert((size_t)NCHAIN * NCK * RC * 4 <= (size_t)2 * MLAT * HEADS * 4 + 4096 * 64, "bonus buffer");

struct Params {
    const float *x, *c, *ctx, *c_ctx, *ln_in_g, *ln_in_b, *w_mod, *b_mod, *w_in, *lru_conv_w, *lru_conv_b, *lru_wa, *lru_ba, *lru_wx, *lru_bx, *lru_lam, *lru_norm_g,
        *mu_prev, *mu_next, *w0, *w2, *a0, *a2, *g2, *k_k, *k_a, *r_k, *gn_g, *gn_b, *w_out, *ln1_g, *ln1_b, *w_router, *w_gate, *w_up, *w_down, *ln2_g, *ln2_b;
    float* out;
    unsigned char* ws;
};
#define WSP(T, off) ((T*)(p.ws + (off)))
__device__ __forceinline__ size_t wdown_off(int e) { return e < NE_R3 ? WS_R3 + (size_t)e * WEXP_BYTES : WS_WD2 + (size_t)(e - NE_R3) * WEXP_BYTES; }

constexpr int SMEM_BYTES = 76 * 1024;

__device__ __forceinline__ f32x4 ld4(const float* p) { return *(const f32x4*)p; }
__device__ __forceinline__ f32x4 ldb4(const bf16_t* p) { const U2 u = *(const U2*)p; return f32x4{bitsf(u.x << 16), bitsf(u.x & 0xFFFF0000u), bitsf(u.y << 16), bitsf(u.y & 0xFFFF0000u)}; }
__device__ __forceinline__ float hsum4(f32x4 v) { return (v[0] + v[1]) + (v[2] + v[3]); }
__device__ __forceinline__ U2 pack4(f32x4 v) { U2 o; o.x = pk2(v[0], v[1]); o.y = pk2(v[2], v[3]); return o; }
#ifdef HOST_EMU
__device__ __forceinline__ void wave_lds_sync() { (void)__shfl_xor(0, 0); }
#else
__device__ __forceinline__ void wave_lds_sync() { asm volatile("s_waitcnt lgkmcnt(0)" ::: "memory"); __builtin_amdgcn_wave_barrier(); }
#endif
#ifdef HOST_EMU
#define LDS_BAR() __syncthreads()
#else
#define LDS_BAR() do { asm volatile("s_waitcnt lgkmcnt(0)" ::: "memory"); __builtin_amdgcn_s_barrier(); asm volatile("" ::: "memory"); } while (0)
#endif
__device__ __forceinline__ void convert_transpose(const float* src, bf16_t* dst, int K, int N, int t0, int t1, int tstride, char* smem) {
    float* T = (float*)smem;
    const int tid = opaque_tid(), r = tid >> 4, c4 = (tid & 15) * 4, ntn = N / 64;
    f32x4 v[4];
    if (t0 < t1) { const int kt = t0 / ntn, nt = t0 % ntn;
#pragma unroll
        for (int j = 0; j < 4; ++j) v[j] = ld4(src + (size_t)(kt * 64 + r + 16 * j) * N + nt * 64 + c4); }
    for (int t = t0; t < t1; t += tstride) {
        const int kt = t / ntn, nt = t % ntn;
        LDS_BAR();
#pragma unroll
        for (int j = 0; j < 4; ++j) { float* d = T + (r + 16 * j) * 65 + c4; d[0] = v[j][0]; d[1] = v[j][1]; d[2] = v[j][2]; d[3] = v[j][3]; }
        LDS_BAR();
        if (t + tstride < t1) { const int kt2 = (t + tstride) / ntn, nt2 = (t + tstride) % ntn;
#pragma unroll
            for (int j = 0; j < 4; ++j) v[j] = ld4(src + (size_t)(kt2 * 64 + r + 16 * j) * N + nt2 * 64 + c4); }
        const int n = tid >> 2, kc = (tid & 3) * 16;
        u32x4 o0, o1;
#pragma unroll
        for (int i = 0; i < 4; ++i) { o0[i] = pk2(T[(kc + 2 * i) * 65 + n], T[(kc + 2 * i + 1) * 65 + n]); o1[i] = pk2(T[(kc + 8 + 2 * i) * 65 + n], T[(kc + 9 + 2 * i) * 65 + n]); }
        bf16_t* d = dst + (size_t)(nt * 64 + n) * K + kt * 64 + kc;
        *(u32x4*)d = o0; *(u32x4*)(d + 8) = o1;
    }
    LDS_BAR();
}
__device__ void convert_experts(const Params& p, int vb, int nvb, char* smem, int first, int last) {
    constexpr int TPM = (D_MODEL / 64) * (D_EXPERT / 64);
    int m = 0;
    for (int e = 0; e < N_EXPERTS; ++e)
        for (int which = first; which < last; ++which, ++m) {
            const float* src = (which == 0 ? p.w_gate : which == 1 ? p.w_up : p.w_down) + (size_t)e * D_MODEL * D_EXPERT;
            bf16_t* dst = which == 0 ? WSP(bf16_t, WS_WG + (size_t)e * WEXP_BYTES) : which == 1 ? WSP(bf16_t, WS_WU + (size_t)e * WEXP_BYTES) : WSP(bf16_t, wdown_off(e));
            const int K = which == 2 ? D_EXPERT : D_MODEL, N = which == 2 ? D_MODEL : D_EXPERT;
            const int start = ((vb - (m * TPM) % nvb) % nvb + nvb) % nvb;
            convert_transpose(src, dst, K, N, start, TPM, nvb, smem);
        }
}

__device__ __forceinline__ void phaseA(const Params& p, int bid, int nblk, char* smem) {
    float* sc = (float*)smem;
    float* red = sc + NMOD * D_MODEL;
    const int tid = opaque_tid();
    constexpr int NA = 6 * D_MODEL / 16;
    {
        const bool spare = nblk > NA + 32;
        const int vb = spare ? bid - NA : bid, nvb = spare ? nblk - NA : nblk;
        if (!spare || bid >= NA) {
            constexpr int T1 = (D_MODEL / 64) * (D_IN / 64), T2 = (D_MIX / 64) * (D_MODEL / 64);
            convert_transpose(p.w_in, WSP(bf16_t, WS_WBIN), D_MODEL, D_IN, vb, T1, nvb, smem);
            convert_transpose(p.w_out, WSP(bf16_t, WS_WBOUT), D_MIX, D_MODEL, ((vb - T1 % nvb) % nvb + nvb) % nvb, T2, nvb, smem);
            for (int idx = vb * 256 + tid; idx < 2 * 2 * HEADS * 64 * 64; idx += nvb * 256) {
                const int i = idx & 63, j = (idx >> 6) & 63, hh = (idx >> 12) % HEADS, which = (idx >> 12) / HEADS % 2, dd = (idx >> 12) / HEADS / 2;
                WSP(bf16_t, WS_LORA)[idx] = f2bf((which ? p.a2 : p.w2)[((size_t)dd * 64 + i) * D_RWKV + hh * 64 + j]);
            }
            for (int idx = vb * 256 + tid; idx < HEADS * 64 * 16; idx += nvb * 256) {
                const int c8 = (idx & 15) * 8, i = (idx >> 4) & 63, hh = idx >> 10;
                const float* src = p.g2 + (size_t)c8 * D_RWKV + hh * 64 + i;
                u32x4 o;
#pragma unroll
                for (int e = 0; e < 4; ++e) o[e] = pk2(src[(size_t)(2 * e) * D_RWKV], src[(size_t)(2 * e + 1) * D_RWKV]);
                *(u32x4*)(WSP(bf16_t, WS_G2T) + ((size_t)hh * 64 + i) * 136 + c8) = o;
            }
            for (int idx = vb * 256 + tid; idx < LRU_BLOCKS * 4 * 64 * 8; idx += nvb * 256) {
                const int i8 = (idx & 7) * 8, j = (idx >> 3) & 63, m = (idx >> 9) & 3, cbw = idx >> 11, dd = m >> 1;
                const float* src = ((m & 1) ? p.lru_wx : p.lru_wa) + ((size_t)(dd * LRU_BLOCKS + cbw) * 64 + i8) * 64 + j;
                u32x4 o;
#pragma unroll
                for (int e = 0; e < 4; ++e) o[e] = pk2(src[(2 * e) * 64], src[(2 * e + 1) * 64]);
                *(u32x4*)(WSP(bf16_t, WS_LRUW) + ((size_t)(cbw * 4 + m) * 64 + j) * 72 + i8) = o;
            }
        }
        if (spare && bid >= NA) return;
    }
    if (bid >= NA) return;
    __syncthreads();
    for (int i = tid; i < NMOD * D_MODEL; i += 256) {
        const int r = i / D_MODEL, k = i % D_MODEL;
        const float v = (r < BATCH) ? p.c[r * D_MODEL + k] : p.c_ctx[k];
        sc[i] = siluf_(v);
    }
    __syncthreads();
    float* MOD = WSP(float, WS_MOD);
    const int col = tid & 15, kg = tid >> 4;
    constexpr int KPT = D_MODEL / 16;
    for (int cb = bid; cb < 6 * D_MODEL / 16; cb += nblk) {
        const int n = cb * 16 + col;
        float acc[NMOD];
#pragma unroll
        for (int r = 0; r < NMOD; ++r) acc[r] = 0.f;
        const float* wp = p.w_mod + (size_t)(kg * KPT) * (6 * D_MODEL) + n;
#pragma unroll 16
        for (int kk = 0; kk < KPT; ++kk) {
            const float w = wp[(size_t)kk * (6 * D_MODEL)];
#pragma unroll
            for (int r = 0; r < NMOD; ++r) acc[r] += sc[r * D_MODEL + kg * KPT + kk] * w;
        }
#pragma unroll
        for (int r = 0; r < NMOD; ++r) red[(kg * NMOD + r) * 16 + col] = acc[r];
        __syncthreads();
        if (tid < NMOD * 16) {
            const int r = tid >> 4, c2 = tid & 15;
            float s2 = p.b_mod[cb * 16 + c2];
#pragma unroll
            for (int g = 0; g < 16; ++g) s2 += red[(g * NMOD + r) * 16 + c2];
            MOD[(size_t)r * 6 * D_MODEL + cb * 16 + c2] = s2;
        }
        __syncthreads();
    }
}

constexpr int NV = D_MODEL / 256;
__device__ __forceinline__ void phaseB(const Params& p, int bid, int nblk, char* smem) {
    const int tid_ = opaque_tid(), lane = tid_ & 63, wave = tid_ >> 6;
    const float* MOD = WSP(float, WS_MOD);
    float* STATS = WSP(float, WS_STATS);
    bf16_t* U = WSP(bf16_t, WS_R3);
    auto rowptr = [&](int row) { return (row < MLAT) ? p.x + (size_t)row * D_MODEL : p.ctx + (size_t)(row - MLAT) * D_MODEL; };
    int row = bid * 4 + wave;
    f32x4 lg[NV], lb[NV];
#pragma unroll
    for (int j = 0; j < NV; ++j) { lg[j] = ld4(p.ln_in_g + j * 256 + lane * 4); lb[j] = ld4(p.ln_in_b + j * 256 + lane * 4); }
    f32x4 n0 = f32x4{0.f, 0.f, 0.f, 0.f}, n1 = n0, n2 = n0, n3 = n0;
    if (row < MTOT) { const float* xr = rowptr(row); n0 = ld4(xr + lane * 4); if (NV > 1) n1 = ld4(xr + 256 + lane * 4); if (NV > 2) { n2 = ld4(xr + 512 + lane * 4); n3 = ld4(xr + 768 + lane * 4); } }
    for (; row < MTOT; row += nblk * 4) {
        const int mr = (row < MLAT) ? row / SEQ : BATCH;
        const float* md = MOD + (size_t)mr * 6 * D_MODEL;
        f32x4 v0 = n0, v1 = n1, v2 = n2, v3 = n3;
        const int nrow = row + nblk * 4;
        if (nrow < MTOT) { const float* xr = rowptr(nrow); n0 = ld4(xr + lane * 4); if (NV > 1) n1 = ld4(xr + 256 + lane * 4); if (NV > 2) { n2 = ld4(xr + 512 + lane * 4); n3 = ld4(xr + 768 + lane * 4); } }
        f32x4 msc[NV], msh[NV];
#pragma unroll
        for (int j = 0; j < NV; ++j) { msc[j] = ld4(md + D_MODEL + j * 256 + lane * 4); msh[j] = ld4(md + j * 256 + lane * 4); }
        float s = hsum4(v0);
        if (NV > 1) s += hsum4(v1);
        if (NV > 2) s += hsum4(v2) + hsum4(v3);
        const float mu = wave_sum(s) * (1.0f / D_MODEL);
        v0 -= mu; float s2 = hsum4(v0 * v0);
        if (NV > 1) { v1 -= mu; s2 += hsum4(v1 * v1); }
        if (NV > 2) { v2 -= mu; v3 -= mu; s2 += hsum4(v2 * v2) + hsum4(v3 * v3); }
        const float rstd = frsq(wave_sum(s2) * (1.0f / D_MODEL) + LN_EPS);
        if (lane == 0) { STATS[row * 2] = mu; STATS[row * 2 + 1] = rstd; }
#pragma unroll
        for (int j = 0; j < NV; ++j) {
            const int k = j * 256 + lane * 4;
            const f32x4 vv = (j == 0) ? v0 : (j == 1) ? v1 : (j == 2) ? v2 : v3;
            const f32x4 h = vv * rstd * lg[j] + lb[j];
            *(U2*)(U + (size_t)row * D_MODEL + k) = pack4(h * (1.0f + msc[j]) + msh[j]);
        }
    }
}

constexpr int LDK = 64;
template <int MI, bool DUAL, class Epi, class RowP>
__device__ __forceinline__ void gemm_tile(char* smem, const bf16_t* A, int lda, const int* rowidx, int m0, const bf16_t* Bt0, const bf16_t* Bt1, int ldb, int n0, int K, Epi epi, RowP rowp, const float* rowscale = nullptr, int kscale = 0, const int* gidx = nullptr) {
    constexpr int BM = 32 * MI;
    bf16_t* As = (bf16_t*)smem;
    bf16_t* Bs = As + BM * LDK;
    int tid = threadIdx.x;
#ifndef HOST_EMU
    asm volatile("" : "+v"(tid));
#endif
    const int lane = tid & 63, wave = tid >> 6, wr = wave >> 1, wc = wave & 1, l15 = lane & 15, q = lane >> 4;
    const int ch = tid & 7, r0 = tid >> 3;
    unsigned aoff[MI], boff[4];
#pragma unroll
    for (int j = 0; j < MI; ++j) { const int r = m0 + r0 + 32 * j; aoff[j] = (unsigned)(gidx ? gidx[j] : rowidx ? rowidx[r] : r) * (unsigned)lda + ch * 8; }
#pragma unroll
    for (int j = 0; j < 4; ++j) boff[j] = (unsigned)(n0 + (DUAL ? (j >> 1) * 32 + r0 : r0 + 32 * j)) * (unsigned)ldb + ch * 8;
    const int wofs = r0 * LDK + ((ch ^ (r0 & 7)) * 8);
    u32x4 ar[MI], br[4];
    f32x4 acc[MI][4];
#pragma unroll
    for (int i = 0; i < MI; ++i)
#pragma unroll
        for (int j = 0; j < 4; ++j) acc[i][j] = f32x4{0.f, 0.f, 0.f, 0.f};
    const int nk = K / 64;
#pragma unroll
    for (int j = 0; j < MI; ++j) ar[j] = *(const u32x4*)(A + aoff[j]);
#pragma unroll
    for (int j = 0; j < 4; ++j) br[j] = *(const u32x4*)(((DUAL && (j & 1)) ? Bt1 : Bt0) + boff[j]);
    for (int kt = 0; kt < nk; ++kt) {
        __syncthreads();
#pragma unroll
        for (int j = 0; j < MI; ++j) *(u32x4*)(As + wofs + 32 * j * LDK) = ar[j];
#pragma unroll
        for (int j = 0; j < 4; ++j) *(u32x4*)(Bs + wofs + 32 * j * LDK) = br[j];
        __syncthreads();
        if (kt + 1 < nk) {
            const int ko = (kt + 1) * 64;
#pragma unroll
            for (int j = 0; j < MI; ++j) ar[j] = *(const u32x4*)(A + aoff[j] + ko);
#pragma unroll
            for (int j = 0; j < 4; ++j) br[j] = *(const u32x4*)(((DUAL && (j & 1)) ? Bt1 : Bt0) + boff[j] + ko);
        }
#pragma unroll
        for (int ks = 0; ks < 2; ++ks) {
            const int cofs = ((ks * 4 + q) ^ (l15 & 7)) * 8;
            bf16x8 bfr[4];
#pragma unroll
            for (int ni = 0; ni < 4; ++ni) bfr[ni] = *(const bf16x8*)(Bs + (wc * 64 + ni * 16 + l15) * LDK + cofs);
#pragma unroll
            for (int mi = 0; mi < MI; ++mi) {
                const bf16x8 af = *(const bf16x8*)(As + (wr * (16 * MI) + mi * 16 + l15) * LDK + cofs);
#pragma unroll
                for (int ni = 0; ni < 4; ++ni) acc[mi][ni] = MFMA16(bfr[ni], af, acc[mi][ni]);
            }
        }
        if (rowscale && kt + 1 == kscale) {
#pragma unroll
            for (int mi = 0; mi < MI; ++mi) {
                const float rs = rowscale[m0 + wr * (16 * MI) + mi * 16 + l15];
#pragma unroll
                for (int ni = 0; ni < 4; ++ni) acc[mi][ni] *= rs;
            }
        }
    }
    __syncthreads();
    if (DUAL) {
        constexpr int SP = 72;
        static_assert(2 * 16 * MI * SP * 2 <= SMEM_BYTES, "gemm epilogue staging");
        bf16_t* stg = (bf16_t*)smem + wr * (16 * MI) * SP;
#pragma unroll
        for (int mi = 0; mi < MI; ++mi) {
            const int ml = wr * (16 * MI) + mi * 16 + l15;
#pragma unroll
            for (int ni = 0; ni < 2; ++ni)
                *(U2*)(stg + (mi * 16 + l15) * SP + wc * 32 + ni * 16 + q * 4) = epi(ml, wc * 32 + ni * 16 + q * 4, acc[mi][ni], acc[mi][ni + 2]);
        }
        LDS_BAR();
#pragma unroll
        for (int pss = 0; pss < MI; ++pss) {
            const int row = wc * (8 * MI) + pss * 8 + (lane >> 3), c8 = (lane & 7) * 8;
            *(u32x4*)(rowp(wr * (16 * MI) + row) + c8) = *(const u32x4*)(stg + row * SP + c8);
        }
    } else {
        constexpr int W = 64, SP = W + 8;
        static_assert(4 * 16 * MI * SP * 2 <= SMEM_BYTES, "gemm epilogue staging");
        bf16_t* stg = (bf16_t*)smem + wave * (16 * MI) * SP;
#pragma unroll
        for (int mi = 0; mi < MI; ++mi) {
            const int ml = wr * (16 * MI) + mi * 16 + l15;
#pragma unroll
            for (int ni = 0; ni < 4; ++ni)
                *(U2*)(stg + (mi * 16 + l15) * SP + ni * 16 + q * 4) = epi(ml, wc * W + ni * 16 + q * 4, acc[mi][ni], acc[mi][ni]);
        }
        wave_lds_sync();
#pragma unroll
        for (int pss = 0; pss < 2 * MI; ++pss) {
            const int row = pss * 8 + (lane >> 3), c8 = (lane & 7) * 8;
            *(u32x4*)(rowp(wr * (16 * MI) + row) + wc * W + c8) = *(const u32x4*)(stg + row * SP + c8);
        }
    }
}

__device__ __forceinline__ int xcd_vbid(int bid, int nblk) { return (nblk % 8 == 0) ? (bid % 8) * (nblk / 8) + bid / 8 : bid; }
constexpr int MI_C = (MTOT % 256 == 0) ? 8 : 4, MI_J = (MLAT % 256 == 0) ? 8 : 4, MI_E = (CAP % 256 == 0) ? 8 : 4;
__device__ __forceinline__ void phaseC(const Params& p, int bid, int nblk, char* smem) {
    const bf16_t* U = WSP(bf16_t, WS_R3); const bf16_t* WB = WSP(bf16_t, WS_WBIN);
    bf16_t* P = WSP(bf16_t, WS_R1);
    constexpr int BM = 32 * MI_C, NTN = D_IN / 128, NTM = MTOT / BM;
    constexpr int GM = (NTM % 8 == 0) ? 8 : (NTM % 4 == 0) ? 4 : 1;
    for (int it = xcd_vbid(bid, nblk); it < NTN * NTM; it += nblk) {
        const int mg = it / (GM * NTN), r = it % (GM * NTN), nt = r / GM, mt = mg * GM + (r % GM);
        gemm_tile<MI_C, false>(smem, U, D_MODEL, nullptr, mt * BM, WB, nullptr, D_MODEL, nt * 128, D_MODEL, [&](int ml, int nl, f32x4 v, f32x4) { return pack4(v); },
            [&](int ml) { return P + (size_t)(mt * BM + ml) * D_IN + nt * 128; });
    }
}


template <int NYT, int KS>
__device__ __forceinline__ void mmT(f32x4* acc, const bf16_t* X, int ldx, int xs, const bf16_t* Y, int ldy, int lane) {
#pragma unroll
    for (int ks = 0; ks < KS; ++ks) {
        const bf16x8 xf = *(const bf16x8*)(X + (xs * 16 + (lane & 15)) * ldx + ks * 32 + 8 * (lane >> 4));
#pragma unroll
        for (int nb = 0; nb < NYT; ++nb) {
            const bf16x8 yf = *(const bf16x8*)(Y + (nb * 16 + (lane & 15)) * ldy + ks * 32 + 8 * (lane >> 4));
            acc[nb] = MFMA16(xf, yf, acc[nb]);
        }
    }
}

__device__ __forceinline__ void unpack8(const u32x4 v, float* o) {
    o[0] = bitsf(v[0] << 16); o[1] = bitsf(v[0] & 0xFFFF0000u); o[2] = bitsf(v[1] << 16); o[3] = bitsf(v[1] & 0xFFFF0000u);
    o[4] = bitsf(v[2] << 16); o[5] = bitsf(v[2] & 0xFFFF0000u); o[6] = bitsf(v[3] << 16); o[7] = bitsf(v[3] & 0xFFFF0000u);
}
struct SeqChunk { int base_row; int t0; int len; };
__device__ __forceinline__ SeqChunk lru_chunk(int cg) {
    SeqChunk s;
    if (cg < NLCH) { const int b = cg / (SEQ / 64), ck = cg % (SEQ / 64); s.base_row = b * SEQ; s.t0 = ck * 64; s.len = SEQ; }
    else { const int c2 = cg - NLCH; const int b = c2 / (CTX_LEN / 64), ck = c2 % (CTX_LEN / 64); s.base_row = MLAT + b * CTX_LEN; s.t0 = ck * 64; s.len = CTX_LEN; }
    return s;
}
constexpr int L_XIN = 0;
constexpr int L_GT = 8704;
constexpr int L_XB = L_GT + 9216;
constexpr int L_WT = L_XB + 9216;
constexpr int L_CP = L_WT + 36864;
constexpr int L_END = L_CP + 4096;
static_assert(L_END + 16 <= SMEM_BYTES && LRU_BLOCKS <= 8, "lru lds");
__device__ __forceinline__ void lru_load_w(const Params& p, char* smem, int cb) {
    bf16_t* WT = (bf16_t*)(smem + L_WT);
    const int tid = opaque_tid();
    const u32x4* src = (const u32x4*)(WSP(bf16_t, WS_LRUW) + (size_t)cb * 4 * 64 * 72);
    u32x4 w[9];
#pragma unroll
    for (int k = 0; k < 9; ++k) w[k] = src[tid + 256 * k];
#pragma unroll
    for (int k = 0; k < 9; ++k) ((u32x4*)WT)[tid + 256 * k] = w[k];
}
struct LruConst { float ba[2][4], bx[2][4], sp8[2][4], gn[4], cwv[4][8], cbv[8]; };
__device__ __forceinline__ void lru_consts(const Params& p, int cb, LruConst& K) {
    const int l15 = threadIdx.x & 15, c = threadIdx.x & 63, ch = cb * 64 + c;
#pragma unroll
    for (int d = 0; d < 2; ++d)
#pragma unroll
        for (int nb = 0; nb < 4; ++nb) { const int cc = d * D_LRU + cb * 64 + nb * 16 + l15; K.ba[d][nb] = p.lru_ba[cc]; K.bx[d][nb] = p.lru_bx[cc]; K.sp8[d][nb] = -8.0f * softplusf_(-p.lru_lam[cc]); }
#pragma unroll
    for (int nb = 0; nb < 4; ++nb) K.gn[nb] = p.lru_norm_g[cb * 64 + nb * 16 + l15];
#pragma unroll
    for (int j = 0; j < 4; ++j)
#pragma unroll
        for (int e = 0; e < 8; ++e) K.cwv[j][e] = p.lru_conv_w[j * D_LRU + cb * 64 + (threadIdx.x & 7) * 8 + e];
#pragma unroll
    for (int e = 0; e < 8; ++e) K.cbv[e] = p.lru_conv_b[cb * 64 + (threadIdx.x & 7) * 8 + e];
}
struct LruStage { u32x4 x[3]; u32x4 g[2]; };
template <bool FINAL>
__device__ __forceinline__ void lru_stage_load(const Params& p, int cg, int cb, LruStage& S) {
    const bf16_t* P = WSP(bf16_t, WS_R1);
    const SeqChunk sc = lru_chunk(cg);
    const int tid = opaque_tid();
#pragma unroll
    for (int k = 0; k < 3; ++k) {
        const int idx = tid + 256 * k, tt = idx >> 3, c8 = (idx & 7) * 8, t = sc.t0 - 1 + tt;
        S.x[k] = u32x4{0u, 0u, 0u, 0u};
        if (idx < 67 * 8 && t >= 0 && t < sc.len) S.x[k] = *(const u32x4*)(P + (size_t)(sc.base_row + t) * D_IN + cb * 64 + c8);
    }
    if (FINAL) {
#pragma unroll
        for (int k = 0; k < 2; ++k) { const int idx = tid + 256 * k, tt = idx >> 3, c8 = (idx & 7) * 8; S.g[k] = *(const u32x4*)(P + (size_t)(sc.base_row + sc.t0 + tt) * D_IN + D_LRU + cb * 64 + c8); }
    }
}
template <bool FINAL>
__device__ __forceinline__ void lru_item(const Params& p, char* smem, int cg, int cb, const LruConst& K, LruStage& S, int cg_next) {
    const bf16_t* P = WSP(bf16_t, WS_R1);
    bf16_t* XIN = (bf16_t*)(smem + L_XIN); bf16_t* GT = (bf16_t*)(smem + L_GT); bf16_t* XB = (bf16_t*)(smem + L_XB); const bf16_t* WT = (const bf16_t*)(smem + L_WT);
    float* CP = (float*)(smem + L_CP);
    const int tid = opaque_tid(), lane = tid & 63, wave = tid >> 6, q = lane >> 4, l15 = lane & 15;
    const SeqChunk sc = lru_chunk(cg);
    float cin[2][4];
    if (FINAL) {
#pragma unroll
        for (int d = 0; d < 2; ++d)
#pragma unroll
            for (int nb = 0; nb < 4; ++nb) cin[d][nb] = WSP(float, WS_CARRY)[((size_t)d * NLCH + cg) * D_LRU + cb * 64 + nb * 16 + l15];
    }
    LDS_BAR();
#pragma unroll
    for (int k = 0; k < 3; ++k) { const int idx = tid + 256 * k, tt = idx >> 3, c8 = (idx & 7) * 8; if (idx < 67 * 8) *(u32x4*)(XIN + tt * 64 + c8) = S.x[k]; }
    if (FINAL) {
#pragma unroll
        for (int k = 0; k < 2; ++k) { const int idx = tid + 256 * k, tt = idx >> 3, c8 = (idx & 7) * 8; *(u32x4*)(GT + tt * 72 + c8) = S.g[k]; }
    }
    if (cg_next >= 0) lru_stage_load<FINAL>(p, cg_next, cb, S);
    LDS_BAR();
    {
        const int c8 = (tid & 7) * 8;
        f32x4 cw0[4], cw1[4];
#pragma unroll
        for (int i = 0; i < 4; ++i) { cw0[i] = f32x4{K.cwv[i][0], K.cwv[i][1], K.cwv[i][2], K.cwv[i][3]}; cw1[i] = f32x4{K.cwv[i][4], K.cwv[i][5], K.cwv[i][6], K.cwv[i][7]}; }
        const f32x4 cb0v = f32x4{K.cbv[0], K.cbv[1], K.cbv[2], K.cbv[3]}, cb1v = f32x4{K.cbv[4], K.cbv[5], K.cbv[6], K.cbv[7]};
#pragma unroll
        for (int ps = 0; ps < 2; ++ps) {
            const int tt = (tid >> 3) + 32 * ps;
            f32x4 a0 = cb0v, a1 = cb1v;
#pragma unroll
            for (int i = 0; i < 4; ++i) {
                float z[8]; unpack8(*(const u32x4*)(XIN + (tt + i) * 64 + c8), z);
                a0 += f32x4{z[0], z[1], z[2], z[3]} * cw0[i]; a1 += f32x4{z[4], z[5], z[6], z[7]} * cw1[i];
            }
            u32x4 o; o[0] = pk2(a0[0], a0[1]); o[1] = pk2(a0[2], a0[3]); o[2] = pk2(a1[0], a1[1]); o[3] = pk2(a1[2], a1[3]);
            *(u32x4*)(XB + tt * 72 + c8) = o;
        }
    }
    LDS_BAR();
    float hs[4][4];
    float av[2][4][4], bv[2][4][4], cA[2][4], cH[2][4];
#pragma unroll
    for (int d = 0; d < 2; ++d) {
        f32x4 ga[4], gx[4];
#pragma unroll
        for (int nb = 0; nb < 4; ++nb) { ga[nb] = f32x4{0.f, 0.f, 0.f, 0.f}; gx[nb] = f32x4{0.f, 0.f, 0.f, 0.f}; }
        mmT<4, 2>(ga, XB, 72, wave, WT + (2 * d) * 64 * 72, 72, lane);
        mmT<4, 2>(gx, XB, 72, wave, WT + (2 * d + 1) * 64 * 72, 72, lane);
#pragma unroll
        for (int nb = 0; nb < 4; ++nb) {
            const float ba = K.ba[d][nb], bx = K.bx[d][nb], sp8 = K.sp8[d][nb];
#pragma unroll
            for (int r = 0; r < 4; ++r) {
                const float rg = fsigm(ga[nb][r] + ba), ig = fsigm(gx[nb][r] + bx);
                const float a = FEXP(sp8 * rg);
                const float xv = bf2f(XB[(wave * 16 + q * 4 + r) * 72 + nb * 16 + l15]);
                av[d][nb][r] = a; bv[d][nb][r] = fsqrt(fmaxf(1.0f - a * a, 0.f)) * ig * xv;
            }
            float A, H;
            if (d == 0) { A = av[d][nb][0]; H = bv[d][nb][0];
#pragma unroll
                for (int r = 1; r < 4; ++r) { H = H * av[d][nb][r] + bv[d][nb][r]; A *= av[d][nb][r]; } }
            else { A = av[d][nb][3]; H = bv[d][nb][3];
#pragma unroll
                for (int r = 2; r >= 0; --r) { H = H * av[d][nb][r] + bv[d][nb][r]; A *= av[d][nb][r]; } }
#pragma unroll
            for (int st = 1; st <= 2; st <<= 1) {
                const float pA = d == 0 ? __shfl_up(A, 16 * st) : __shfl_down(A, 16 * st), pH = d == 0 ? __shfl_up(H, 16 * st) : __shfl_down(H, 16 * st);
                const bool has = d == 0 ? (q >= st) : (q + st <= 3);
                if (has) { H = pH * A + H; A = pA * A; }
            }
            cA[d][nb] = A; cH[d][nb] = H;
            const bool last = d == 0 ? (q == 3) : (q == 0);
            if (last) { CP[((d * 4 + wave) * 64 + nb * 16 + l15) * 2] = A; CP[((d * 4 + wave) * 64 + nb * 16 + l15) * 2 + 1] = H; }
        }
    }
    LDS_BAR();
    if (!FINAL) {
        if (wave < 2 && q == 0) {
            const int d = wave;
#pragma unroll
            for (int nb = 0; nb < 4; ++nb) {
                const int c = nb * 16 + l15;
                float A = 1.f, H = 0.f;
#pragma unroll
                for (int w = 0; w < 4; ++w) { const int ww = d == 0 ? w : 3 - w; const float wa = CP[((d * 4 + ww) * 64 + c) * 2], wh = CP[((d * 4 + ww) * 64 + c) * 2 + 1]; H = H * wa + wh; A *= wa; }
                WSP(float, WS_SUMA)[((size_t)d * NCH + cg) * D_LRU + cb * 64 + c] = A;
                WSP(float, WS_SUMH)[((size_t)d * NCH + cg) * D_LRU + cb * 64 + c] = H;
            }
        }
    } else {
#pragma unroll
        for (int d = 0; d < 2; ++d) {
#pragma unroll
            for (int nb = 0; nb < 4; ++nb) {
                const int c = nb * 16 + l15;
                float h = cin[d][nb];
#pragma unroll
                for (int w = 0; w < 3; ++w) { const int ww = d == 0 ? w : 3 - w; const bool use = d == 0 ? (ww < wave) : (ww > wave);
                    if (use) h = h * CP[((d * 4 + ww) * 64 + c) * 2] + CP[((d * 4 + ww) * 64 + c) * 2 + 1]; }
                const float eA = d == 0 ? __shfl_up(cA[d][nb], 16) : __shfl_down(cA[d][nb], 16), eH = d == 0 ? __shfl_up(cH[d][nb], 16) : __shfl_down(cH[d][nb], 16);
                const bool first = d == 0 ? (q == 0) : (q == 3);
                if (!first) h = h * eA + eH;
                if (d == 0) {
#pragma unroll
                    for (int r = 0; r < 4; ++r) { h = h * av[d][nb][r] + bv[d][nb][r]; hs[nb][r] = h; }
                } else {
#pragma unroll
                    for (int r = 3; r >= 0; --r) { h = h * av[d][nb][r] + bv[d][nb][r]; hs[nb][r] += h; }
                }
            }
        }
    }
    if (FINAL) {
        float ss[4] = {0.f, 0.f, 0.f, 0.f};
#pragma unroll
        for (int nb = 0; nb < 4; ++nb) {
            const float gn = K.gn[nb];
#pragma unroll
            for (int r = 0; r < 4; ++r) {
                const int tt = wave * 16 + q * 4 + r;
                const float v = hs[nb][r] * geluf_(bf2f(GT[tt * 72 + nb * 16 + l15]));
                ss[r] += v * v;
                XB[tt * 72 + nb * 16 + l15] = f2bf(v * gn);
            }
        }
#pragma unroll
        for (int r = 0; r < 4; ++r) {
#pragma unroll
            for (int o = 1; o < 16; o <<= 1) ss[r] += __shfl_xor(ss[r], o);
            if (l15 == 0) ((float*)(smem + L_XIN))[wave * 16 + q * 4 + r] = ss[r];
        }
        LDS_BAR();
        if (tid < 64) WSP(float, WS_SSQP)[(size_t)cb * MLAT + sc.base_row + sc.t0 + tid] = ((const float*)(smem + L_XIN))[tid];
        bf16_t* MIX = WSP(bf16_t, WS_R3);
        for (int idx = tid; idx < 64 * 8; idx += 256) {
            const int tt = idx >> 3, c8 = (idx & 7) * 8;
            *(u32x4*)(MIX + (size_t)(sc.base_row + sc.t0 + tt) * D_MIX + cb * 64 + c8) = *(const u32x4*)(XB + tt * 72 + c8);
        }
    }
}
template <bool FINAL>
__device__ __forceinline__ void lru_phase(const Params& p, int bid, int nblk, char* smem, int nchunk, unsigned* ctr) {
    if (nblk % LRU_BLOCKS != 0) {
        int cur = -1; LruConst K; LruStage S;
        for (int it = bid; it < nchunk * LRU_BLOCKS; it += nblk) {
            const int cb = it % LRU_BLOCKS, cg = it / LRU_BLOCKS;
            if (cb != cur) { LDS_BAR(); lru_load_w(p, smem, cb); lru_consts(p, cb, K); lru_stage_load<FINAL>(p, cg, cb, S); cur = cb; }
            const int itn = it + nblk;
            lru_item<FINAL>(p, smem, cg, cb, K, S, (itn < nchunk * LRU_BLOCKS && itn % LRU_BLOCKS == cb) ? itn / LRU_BLOCKS : -1);
            if (itn < nchunk * LRU_BLOCKS && itn % LRU_BLOCKS != cb) cur = -1;
        }
        return;
    }
    const int cb = bid % LRU_BLOCKS;
    unsigned* c = ctr + 32 * cb;
    volatile int* nx = (volatile int*)(smem + L_END);
    LDS_BAR();
    if (threadIdx.x == 0) { const int v0 = (int)atomicAdd(c, 2u); nx[0] = v0; nx[1] = v0 + 1; }
    LDS_BAR();
    int cg = nx[0], cg1 = nx[1];
    if (cg >= nchunk) return;
    LruConst K; LruStage S;
    lru_load_w(p, smem, cb); lru_consts(p, cb, K); lru_stage_load<FINAL>(p, cg, cb, S);
    while (cg < nchunk) {
        unsigned d2 = 0u;
        if (threadIdx.x == 0) d2 = atomicAdd(c, 1u);
        lru_item<FINAL>(p, smem, cg, cb, K, S, cg1 < nchunk ? cg1 : -1);
        LDS_BAR();
        if (threadIdx.x == 0) nx[0] = (int)d2;
        LDS_BAR();
        cg = cg1; cg1 = nx[0];
    }
}
__device__ __forceinline__ void phaseD(const Params& p, int bid, int nblk, char* smem) { lru_phase<false>(p, bid, nblk, smem, NCH, WSP(unsigned, WS_CTRL) + LRU_POOL_WORD); }
__device__ __forceinline__ void phaseE(const Params& p, int bid, int nblk, char* smem) {
    const float* SUMA = WSP(float, WS_SUMA); const float* SUMH = WSP(float, WS_SUMH); float* CARRY = WSP(float, WS_CARRY);
    constexpr int NLB = SEQ / 64, NCB = CTX_LEN / 64, NSEG = 4, SL = NLB / NSEG;
    static_assert(NLB % NSEG == 0 && SL <= 16 && NCB <= 4, "phase E segments");
    float* XA = (float*)smem; float* XH = XA + NSEG * 64;
    const int tid = opaque_tid(), c64 = tid & 63, sg = tid >> 6;
    for (int it = bid; it < BATCH * 2 * (D_LRU / 64); it += nblk) {
        const int cbk = it % (D_LRU / 64), d = (it / (D_LRU / 64)) & 1, b = it / (2 * (D_LRU / 64)), c = cbk * 64 + c64;
        const float* sa = SUMA + (size_t)d * NCH * D_LRU + c; const float* sh = SUMH + (size_t)d * NCH * D_LRU + c;
        float* cr = CARRY + (size_t)d * NLCH * D_LRU + c;
        float ca[4], chh[4], va[SL], vh[SL];
#pragma unroll
        for (int i = 0; i < 4; ++i) { ca[i] = 1.f; chh[i] = 0.f; if (i < NCB && sg == 0) { const int gi = NLCH + b * NCB + (d == 0 ? i : NCB - 1 - i); ca[i] = sa[(size_t)gi * D_LRU]; chh[i] = sh[(size_t)gi * D_LRU]; } }
#pragma unroll
        for (int i = 0; i < SL; ++i) { const int q2 = sg * SL + i, gi = b * NLB + (d == 0 ? q2 : NLB - 1 - q2); va[i] = sa[(size_t)gi * D_LRU]; vh[i] = sh[(size_t)gi * D_LRU]; }
        float h0 = 0.f;
#pragma unroll
        for (int i = 0; i < 4; ++i) h0 = ca[i] * h0 + chh[i];
        float A = 1.f, H = h0;
#pragma unroll
        for (int i = 0; i < SL; ++i) { H = va[i] * H + vh[i]; A *= va[i]; }
        __syncthreads();
        XA[sg * 64 + c64] = A; XH[sg * 64 + c64] = H;
        __syncthreads();
        float h = (sg == 0) ? h0 : 0.f;
        if (sg > 0) {
            h = XH[c64];
#pragma unroll
            for (int s2 = 1; s2 < NSEG; ++s2) if (s2 < sg) h = XA[s2 * 64 + c64] * h + XH[s2 * 64 + c64];
        }
#pragma unroll
        for (int i = 0; i < SL; ++i) { const int q2 = sg * SL + i, gi = b * NLB + (d == 0 ? q2 : NLB - 1 - q2); cr[(size_t)gi * D_LRU] = h; h = va[i] * h + vh[i]; }
    }
}
__device__ __forceinline__ void phaseF(const Params& p, int bid, int nblk, char* smem) { lru_phase<true>(p, bid, nblk, smem, NLCH, WSP(unsigned, WS_CTRL) + LRU_POOL_WORD + 32 * LRU_BLOCKS); }

__device__ __forceinline__ size_t rwkv_row(int seg, int b, int s) {
    if (seg == 0) return (size_t)(MLAT + b * CTX_LEN + s);
    const int r = s % ROWS, c = s / ROWS;
    return (size_t)(b * SEQ + r * GRID_W + c);
}
__device__ __forceinline__ void chunk_info(int d, int c, int& seg, int& p0, int& len) {
    if (c < NCC) { seg = 0; len = CTX_LEN; p0 = (d == 0 ? c : NCC - 1 - c) * RC; }
    else { const int cc = c - NCC; seg = 1; len = SEQ; p0 = (d == 0 ? cc : NLC - 1 - cc) * RC; }
}
__device__ __forceinline__ void shifted8(const Params& p, const bf16_t* P, int seg, int b, int pos, int len, int ch0, float* o) {
    float z[8], zp[8], zn[8];
    unpack8(*(const u32x4*)(P + rwkv_row(seg, b, pos) * D_IN + RW0 + ch0), z);
    if (pos > 0) unpack8(*(const u32x4*)(P + rwkv_row(seg, b, pos - 1) * D_IN + RW0 + ch0), zp); else { for (int i = 0; i < 8; ++i) zp[i] = 0.f; }
    if (pos < len - 1) unpack8(*(const u32x4*)(P + rwkv_row(seg, b, pos + 1) * D_IN + RW0 + ch0), zn); else { for (int i = 0; i < 8; ++i) zn[i] = 0.f; }
    const f32x4 mp0 = ld4(p.mu_prev + ch0), mp1 = ld4(p.mu_prev + ch0 + 4), mn0 = ld4(p.mu_next + ch0), mn1 = ld4(p.mu_next + ch0 + 4);
#pragma unroll
    for (int i = 0; i < 4; ++i) { o[i] = z[i] + mp0[i] * (zp[i] - z[i]) + mn0[i] * (zn[i] - z[i]); o[4 + i] = z[4 + i] + mp1[i] * (zp[4 + i] - z[4 + i]) + mn1[i] * (zn[4 + i] - z[4 + i]); }
}
__device__ __forceinline__ void phaseG(const Params& p, int bid, int nblk, char* smem) {
    const bf16_t* P = WSP(bf16_t, WS_R1); bf16_t* SG = WSP(bf16_t, WS_SG);
    const int tid = opaque_tid(), lane = tid & 63, wave = tid >> 6;
    const int c8 = (lane & 15) * 8, ch0 = 3 * D_RWKV + 256 + c8;
    const f32x4 mp0 = ld4(p.mu_prev + ch0), mp1 = ld4(p.mu_prev + ch0 + 4), mn0 = ld4(p.mu_next + ch0), mn1 = ld4(p.mu_next + ch0 + 4);
    for (int g0 = ((bid * 4 + wave) * 4 + (lane >> 4)) * 4; g0 < MLAT; g0 += nblk * 64) {
        const int b = g0 / SEQ, pos0 = g0 % SEQ;
        u32x4 zr[6];
#pragma unroll
        for (int i = 0; i < 6; ++i) { const int pos = pos0 - 1 + i, pcl = pos < 0 ? 0 : (pos >= SEQ ? SEQ - 1 : pos); zr[i] = *(const u32x4*)(P + rwkv_row(1, b, pcl) * D_IN + RW0 + ch0); }
        float zz[3][8];
        unpack8(zr[0], zz[0]); unpack8(zr[1], zz[1]);
        if (pos0 == 0) { for (int e = 0; e < 8; ++e) zz[0][e] = 0.f; }
#pragma unroll
        for (int i = 0; i < 4; ++i) {
            unpack8(zr[i + 2], zz[(i + 2) % 3]);
            if (pos0 + i + 1 >= SEQ) { for (int e = 0; e < 8; ++e) zz[(i + 2) % 3][e] = 0.f; }
            const float* zpv = zz[i % 3]; const float* z = zz[(i + 1) % 3]; const float* znv = zz[(i + 2) % 3];
            float o[8];
#pragma unroll
            for (int e = 0; e < 4; ++e) { o[e] = z[e] + mp0[e] * (zpv[e] - z[e]) + mn0[e] * (znv[e] - z[e]); o[4 + e] = z[4 + e] + mp1[e] * (zpv[4 + e] - z[4 + e]) + mn1[e] * (znv[4 + e] - z[4 + e]); }
            u32x4 t; t[0] = pk2(fsigm(o[0]), fsigm(o[1])); t[1] = pk2(fsigm(o[2]), fsigm(o[3])); t[2] = pk2(fsigm(o[4]), fsigm(o[5])); t[3] = pk2(fsigm(o[6]), fsigm(o[7]));
            *(u32x4*)(SG + (size_t)(g0 + i) * 128 + c8) = t;
        }
    }
}
constexpr int LT = 72, LJ = 40;
constexpr int R_RF = 0, R_KF = 8192, R_VF = 16384, R_LW = 24576, R_IC = 32768;
constexpr int R_NKA = 0, R_MBR = 2560, R_MKR = 5120;
constexpr int R_XU = 7680;
constexpr int R_IA = R_XU + 8448, R_IB = R_IA + 4608, R_PA = R_IB + 4608, R_PB = R_PA + 4608;
constexpr int R_WA = R_IB, R_U0 = R_WA + 5120;
constexpr int R_TB0 = R_IB, R_TB1 = R_IB + 2560, R_PB0 = R_IB + 5120, R_PB1 = R_IB + 7680, R_PT0 = R_IB + 10240, R_PT1 = R_IB + 12800;
static_assert(R_PT1 + 2560 <= 40960, "rwkv doubling buffers");
static_assert(R_U0 + 5120 <= R_PB + 4608 && R_PB + 4608 <= 40960, "rwkv scratch");
constexpr int R_O = 40960;
constexpr int R_AH = R_O, R_BH = R_AH + 4608, R_KH = R_BH + 4608, R_RH = R_KH + 4608;
constexpr int R_VT = R_RH + 4608, R_BHT = R_VT + 5120, R_KHT = R_BHT + 5120;
constexpr int R_GC = R_KHT + 5120, R_TOT = R_GC + 256, R_PS = R_TOT + 1024, R_END = R_PS + 1024;
constexpr int R_TW = R_O, R_TA = R_TW + 4608, R_W2T = R_TA + 4608, R_A2T = R_W2T + 9216;
static_assert(R_A2T + 9216 <= R_END && R_END <= SMEM_BYTES, "rwkv lds");

__device__ __forceinline__ void phaseR1(const Params& p, int bid, int nblk, char* smem) {
    const bf16_t* P = WSP(bf16_t, WS_R1);
    unsigned char* CH = p.ws + WS_CH;
    float* RBON = WSP(float, WS_RBON);
    float* Rf = (float*)(smem + R_RF); float* Kf = (float*)(smem + R_KF); float* Vf = (float*)(smem + R_VF); float* LW = (float*)(smem + R_LW); float* IC = (float*)(smem + R_IC);
    float* IA = (float*)(smem + R_IA); float* IB = (float*)(smem + R_IB); float* PA = (float*)(smem + R_PA); float* PB = (float*)(smem + R_PB); bf16_t* NkaT = (bf16_t*)(smem + R_NKA); bf16_t* MbrT = (bf16_t*)(smem + R_MBR); bf16_t* MkrT = (bf16_t*)(smem + R_MKR);
    float* Xu = (float*)(smem + R_XU); bf16_t* Wa = (bf16_t*)(smem + R_WA); bf16_t* U0 = (bf16_t*)(smem + R_U0);
    bf16_t* Ah = (bf16_t*)(smem + R_AH); bf16_t* Bh = (bf16_t*)(smem + R_BH); bf16_t* Kh = (bf16_t*)(smem + R_KH); bf16_t* Rh = (bf16_t*)(smem + R_RH);
    bf16_t* VT = (bf16_t*)(smem + R_VT); bf16_t* BhT = (bf16_t*)(smem + R_BHT); bf16_t* KhT = (bf16_t*)(smem + R_KHT);
    float* GC = (float*)(smem + R_GC); float* TOT = (float*)(smem + R_TOT); float* PS = (float*)(smem + R_PS);
    bf16_t* TW = (bf16_t*)(smem + R_TW); bf16_t* TA = (bf16_t*)(smem + R_TA); bf16_t* W2T = (bf16_t*)(smem + R_W2T); bf16_t* A2T = (bf16_t*)(smem + R_A2T);
    constexpr int NITEM = NCHAIN * NCK;
    const int per = NITEM / nblk, nst = per > 2 ? per - 2 : 0, pool0 = nst * nblk;
    unsigned* pctr = WSP(unsigned, WS_CTRL) + R1_POOL_WORD;
    volatile int* nextw = (volatile int*)(smem + R_END);
    int it, kdone = 0;
    if (nst > 0) it = bid * nst;
    else {
        LDS_BAR();
        if (threadIdx.x == 0) { const int v = pool0 + (int)atomicAdd(pctr, 1u); *nextw = v < NITEM ? v : -1; }
        LDS_BAR();
        it = *nextw;
    }
    LDS_BAR();
    u32x4 pre[16];
    auto p1_fetch = [&](int itn) {
        const int tid = opaque_tid(), lane = tid & 63;
#ifdef HOST_EMU
        const int wave = tid >> 6;
#else
        const int wave = __builtin_amdgcn_readfirstlane(tid >> 6);
#endif
        const int chain = itn / NCK, c = itn % NCK;
        const int d = chain & 1, h = (chain >> 1) % HEADS, b = chain / (2 * HEADS);
        int seg, p0, len; chunk_info(d, c, seg, p0, len);
        if (wave == 3) {
#pragma unroll
            for (int k = 0; k < 16; ++k) {
                const int idx = lane + 64 * k, which = idx >> 9, j = (idx >> 3) & 63, c8 = (idx & 7) * 8;
                pre[k] = *(const u32x4*)(WSP(bf16_t, WS_LORA) + ((size_t)((d * 2 + which) * HEADS + h) * 64 + j) * 64 + c8);
            }
        } else {
            const int tcl = tid < 160 ? tid : 159;
            const int grp = tcl >> 5, tq = (tcl >> 3) & 3, j0 = (tcl & 7) * 8;
            const int ch0 = (grp < 3) ? grp * D_RWKV + h * 64 + j0 : (grp == 3 ? 3 * D_RWKV + d * 64 + j0 : 3 * D_RWKV + 128 + d * 64 + j0);
            const int pa = p0 + (d ? RC - 8 - 8 * tq : 8 * tq);
#pragma unroll
            for (int i = 0; i < 10; ++i) {
                const int pos = pa - 1 + i, pcl = pos < 0 ? 0 : (pos >= len ? len - 1 : pos);
                pre[i] = *(const u32x4*)(P + rwkv_row(seg, b, pcl) * D_IN + RW0 + ch0);
            }
            pre[10] = *(const u32x4*)(p.mu_prev + ch0); pre[11] = *(const u32x4*)(p.mu_prev + ch0 + 4); pre[12] = *(const u32x4*)(p.mu_next + ch0); pre[13] = *(const u32x4*)(p.mu_next + ch0 + 4);
            pre[14] = *(const u32x4*)(p.mu_prev + ch0 + 8); pre[15] = *(const u32x4*)(p.mu_next + ch0 + 8);
        }
    };
    if (it >= 0) p1_fetch(it);
    for (; it >= 0; ++kdone) {
        const bool dyn_next = kdone + 1 >= nst;
        unsigned pool_v = 0u;
        if (dyn_next && threadIdx.x == 0) pool_v = atomicAdd(pctr, 1u);
        const int tid = opaque_tid(), lane = tid & 63, wave = tid >> 6, q = lane >> 4, l15 = lane & 15;
        const int chain = it / NCK, c = it % NCK;
        const int d = chain & 1, h = (chain >> 1) % HEADS, b = chain / (2 * HEADS);
        int seg, p0, len; chunk_info(d, c, seg, p0, len);
        unsigned char* chp = CH + (size_t)it * CH_BYTES;
        const float kkc = p.k_k[h * 64 + lane], kac = p.k_a[h * 64 + lane];
        const int jp2 = wave * 16 + q * 4;
        const f32x4 w0v = ld4(p.w0 + d * D_RWKV + h * 64 + jp2), a0v = ld4(p.a0 + d * D_RWKV + h * 64 + jp2);
        const f32x4 kk4 = ld4(p.k_k + h * 64 + jp2), ka4 = ld4(p.k_a + h * 64 + jp2), rk4 = ld4(p.r_k + h * 64 + jp2);
        {
            if (wave == 3) {
#pragma unroll
                for (int k = 0; k < 16; ++k) {
                    const int idx = lane + 64 * k, which = idx >> 9, j = (idx >> 3) & 63, c8 = (idx & 7) * 8;
                    *(u32x4*)((which ? A2T : W2T) + j * LT + c8) = pre[k];
                }
            } else if (tid < 160) {
                const int grp = tid >> 5, tq = (tid >> 3) & 3, j0 = (tid & 7) * 8;
                const f32x4 mp0 = __builtin_bit_cast(f32x4, pre[10]), mp1 = __builtin_bit_cast(f32x4, pre[11]), mn0 = __builtin_bit_cast(f32x4, pre[12]), mn1 = __builtin_bit_cast(f32x4, pre[13]);
                const int pa = p0 + (d ? RC - 8 - 8 * tq : 8 * tq);
                u32x4 zr[10];
#pragma unroll
                for (int i = 0; i < 10; ++i) { const int pos = pa - 1 + i; zr[i] = (pos >= 0 && pos < len) ? pre[i] : u32x4{0u, 0u, 0u, 0u}; }
                float zz[3][8];
                unpack8(zr[0], zz[0]); unpack8(zr[1], zz[1]);
#pragma unroll
                for (int i = 0; i < 8; ++i) {
                    unpack8(zr[i + 2], zz[(i + 2) % 3]);
                    const float* zpv = zz[i % 3]; const float* z = zz[(i + 1) % 3]; const float* znv = zz[(i + 2) % 3];
                    const int tau = d ? 8 * tq + 7 - i : 8 * tq + i;
                    float o[8];
#pragma unroll
                    for (int e = 0; e < 4; ++e) { o[e] = z[e] + mp0[e] * (zpv[e] - z[e]) + mn0[e] * (znv[e] - z[e]); o[4 + e] = z[4 + e] + mp1[e] * (zpv[4 + e] - z[4 + e]) + mn1[e] * (znv[4 + e] - z[4 + e]); }
                    if (grp < 4) {
                        static_assert(R_KF == R_RF + 8192 && R_VF == R_RF + 16384 && R_LW == R_RF + 24576, "the four f32 tiles are consecutive");
                        float* dst = (float*)(smem + R_RF + grp * 8192) + tau * 64 + j0;
                        *(f32x4*)dst = f32x4{o[0], o[1], o[2], o[3]}; *(f32x4*)(dst + 4) = f32x4{o[4], o[5], o[6], o[7]};
                    } else {
                        u32x4 w; w[0] = pk2(o[0], o[1]); w[1] = pk2(o[2], o[3]); w[2] = pk2(o[4], o[5]); w[3] = pk2(o[6], o[7]);
                        *(u32x4*)(TA + tau * LT + j0) = w;
                    }
                }
            }
        }
        LDS_BAR();
        {
            const int tau = tid >> 3, j0 = (tid & 7) * 8;
            const f32x4 a = *(const f32x4*)(LW + tau * 64 + j0), b2 = *(const f32x4*)(LW + tau * 64 + j0 + 4);
            u32x4 w;
#pragma unroll
            for (int e = 0; e < 2; ++e) {
                w[e] = pk2(2.0f * frcp(1.0f + FEXP(-2.0f * a[2 * e])) - 1.0f, 2.0f * frcp(1.0f + FEXP(-2.0f * a[2 * e + 1])) - 1.0f);
                w[2 + e] = pk2(2.0f * frcp(1.0f + FEXP(-2.0f * b2[2 * e])) - 1.0f, 2.0f * frcp(1.0f + FEXP(-2.0f * b2[2 * e + 1])) - 1.0f);
            }
            *(u32x4*)(TW + tau * LT + j0) = w;
        }
        LDS_BAR();
        {
            f32x4 aw[2] = {f32x4{0.f, 0.f, 0.f, 0.f}, f32x4{0.f, 0.f, 0.f, 0.f}}, ai[2] = {f32x4{0.f, 0.f, 0.f, 0.f}, f32x4{0.f, 0.f, 0.f, 0.f}};
            mmT<2, 2>(aw, W2T, LT, wave, TW, LT, lane);
            mmT<2, 2>(ai, A2T, LT, wave, TA, LT, lane);
            const int j = wave * 16 + q * 4;
#pragma unroll
            for (int nb = 0; nb < 2; ++nb) {
                const int tau = nb * 16 + l15;
                f32x4 lw, ic;
#pragma unroll
                for (int r = 0; r < 4; ++r) { lw[r] = -0.6065306597126334f * fsigm(w0v[r] + aw[nb][r]); ic[r] = fsigm(a0v[r] + ai[nb][r]); }
                *(f32x4*)(LW + tau * 64 + j) = lw; *(f32x4*)(IC + tau * 64 + j) = ic;
                const f32x4 kr = *(const f32x4*)(Kf + tau * 64 + j), rr = *(const f32x4*)(Rf + tau * 64 + j);
                const f32x4 kd = kr * (1.0f + (ic - 1.0f) * ka4), kq = kr * kk4;
                float n2 = hsum4(kq * kq), bon = hsum4(rr * kd * rk4);
                n2 += __shfl_xor(n2, 16); n2 += __shfl_xor(n2, 32); bon += __shfl_xor(bon, 16); bon += __shfl_xor(bon, 32);
                if (q == 0) { PS[(tau * 4 + wave) * 2] = n2; PS[(tau * 4 + wave) * 2 + 1] = bon; }
            }
        }
        LDS_BAR();
        {
            const int j = lane, t0 = wave * 8;
            float cum[8], kd[8], kkn[8], icv[8], rr[8], vv[8], run = 0.f;
#pragma unroll
            for (int i = 0; i < 8; ++i) {
                const int t = t0 + i;
                run += LW[t * 64 + j]; cum[i] = run;
                const float kr = Kf[t * 64 + j]; icv[i] = IC[t * 64 + j]; rr[i] = Rf[t * 64 + j]; vv[i] = Vf[t * 64 + j];
                kd[i] = kr * (1.0f + (icv[i] - 1.0f) * kac);
                const float kk = kr * kkc;
                const f32x4 pa = *(const f32x4*)(PS + t * 8), pb = *(const f32x4*)(PS + t * 8 + 4);
                const float n2 = (pa[0] + pa[2]) + (pb[0] + pb[2]);
                kkn[i] = kk * frsq(fmaxf(n2, 1e-24f));
            }
            if (wave == 0 && lane < RC) {
                const f32x4 pa = *(const f32x4*)(PS + lane * 8), pb = *(const f32x4*)(PS + lane * 8 + 4);
                RBON[(size_t)it * RC + lane] = (pa[1] + pa[3]) + (pb[1] + pb[3]);
            }
            TOT[wave * 64 + j] = run;
            LDS_BAR();
            float off = 0.f;
            for (int w = 0; w < wave; ++w) off += TOT[w * 64 + j];
            u32x4 vt, bt, kt;
            float e_prev = 0.f;
#pragma unroll
            for (int i = 0; i < 8; ++i) {
                const int t = t0 + i;
                const float cu = off + cum[i], cprev = (i == 0) ? off : off + cum[i - 1];
                const float g = FEXP(cu), gi = FEXP(-cu), gm = FEXP(cprev);
                const float ah = -kkn[i] * gm, bh = kkn[i] * icv[i] * gi, kh = kd[i] * gi, rh = rr[i] * g;
                Ah[t * LT + j] = f2bf(ah); Bh[t * LT + j] = f2bf(bh); Kh[t * LT + j] = f2bf(kh); Rh[t * LT + j] = f2bf(rh);
                if (i & 1) { vt[i >> 1] = pk2(e_prev, vv[i]); bt[i >> 1] = (bt[i >> 1] & 0xFFFFu) | ((unsigned)f2bf(bh) << 16); kt[i >> 1] = (kt[i >> 1] & 0xFFFFu) | ((unsigned)f2bf(kh) << 16); }
                else { e_prev = vv[i]; bt[i >> 1] = f2bf(bh); kt[i >> 1] = f2bf(kh); }
                if (t == RC - 1) GC[j] = g;
            }
            *(u32x4*)(VT + j * LJ + t0) = vt; *(u32x4*)(BhT + j * LJ + t0) = bt; *(u32x4*)(KhT + j * LJ + t0) = kt;
        }
        LDS_BAR();
        {
            const bf16_t* X = (wave == 0) ? Ah : (wave & 1) ? Kh : Bh;
            const bf16_t* Y = (wave == 0) ? Bh : (wave == 1) ? Ah : Rh;
#pragma unroll
            for (int xs = 0; xs < 2; ++xs) {
                f32x4 acc[2] = {f32x4{0.f, 0.f, 0.f, 0.f}, f32x4{0.f, 0.f, 0.f, 0.f}};
                mmT<2, 2>(acc, X, LT, xs, Y, LT, lane);
#pragma unroll
                for (int nb = 0; nb < 2; ++nb) {
                    const int yy = nb * 16 + l15, x0 = xs * 16 + q * 4;
                    f32x4 v = acc[nb];
#pragma unroll
                    for (int r = 0; r < 4; ++r) { const int xx = x0 + r; const bool keep = (wave == 0) ? (yy < xx) : (wave == 1) ? (xx < yy) : (xx <= yy); v[r] = keep ? v[r] : 0.f; }
                    if (wave == 0) {
                        bf16_t* Pb0 = (bf16_t*)(smem + R_PB0); bf16_t* Pt0 = (bf16_t*)(smem + R_PT0); bf16_t* Tb0 = (bf16_t*)(smem + R_TB0);
                        *(U2*)(Pb0 + yy * LJ + x0) = pack4(v);
#pragma unroll
                        for (int r = 0; r < 4; ++r) Pt0[(x0 + r) * LJ + yy] = f2bf(v[r]);
                        f32x4 t0 = v;
#pragma unroll
                        for (int r = 0; r < 4; ++r) t0[r] += (x0 + r == yy) ? 1.0f : 0.0f;
                        *(f32x4*)(IA + yy * 36 + x0) = t0; *(U2*)(Tb0 + yy * LJ + x0) = pack4(t0);
                    }
                    else { bf16_t* dst = (wave == 1 ? NkaT : wave == 2 ? MbrT : MkrT) + yy * LJ + x0; *(U2*)dst = pack4(v); }
                }
            }
        }
        LDS_BAR();
        {
#pragma unroll
            for (int xs = 0; xs < 2; ++xs) {
                f32x4 acc[1] = {f32x4{0.f, 0.f, 0.f, 0.f}};
                mmT<1, 1>(acc, NkaT, LJ, xs, VT + wave * 16 * LJ, LJ, lane);
                const int i = wave * 16 + l15, tb = xs * 16 + q * 4;
                Xu[i * 33 + tb] = acc[0][0]; Xu[i * 33 + tb + 1] = acc[0][1]; Xu[i * 33 + tb + 2] = acc[0][2]; Xu[i * 33 + tb + 3] = acc[0][3];
            }
        }
        {
            bf16_t* Tb[2] = {(bf16_t*)(smem + R_TB0), (bf16_t*)(smem + R_TB1)};
            bf16_t* Pb[2] = {(bf16_t*)(smem + R_PB0), (bf16_t*)(smem + R_PB1)};
            bf16_t* Pt[2] = {(bf16_t*)(smem + R_PT0), (bf16_t*)(smem + R_PT1)};
            const int nb = wave >> 1, xs = wave & 1;
            const int yy = nb * 16 + l15, x0 = xs * 16 + q * 4;
            auto prod = [&](const bf16_t* L, const bf16_t* Rt, f32x4 init) {
                const bf16x8 xf = *(const bf16x8*)(Rt + (xs * 16 + l15) * LJ + 8 * q), yf = *(const bf16x8*)(L + (nb * 16 + l15) * LJ + 8 * q);
                return MFMA16(xf, yf, init);
            };
            const f32x4 zero = f32x4{0.f, 0.f, 0.f, 0.f};
#pragma unroll
            for (int k = 0; k < 5; ++k) {
                const int pc = k & 1, pn = pc ^ 1;
                f32x4 tnew = zero, pnew = zero;
                if (k >= 1) tnew = prod(Tb[pn], Pt[pc], *(const f32x4*)(IA + yy * 36 + x0));
                if (k <= 3) pnew = prod(Pb[pc], Pt[pc], zero);
                if (k >= 1) { *(f32x4*)(IA + yy * 36 + x0) = tnew; if (k <= 3) *(U2*)(Tb[pc] + yy * LJ + x0) = pack4(tnew); }
                if (k <= 3) {
                    *(U2*)(Pb[pn] + yy * LJ + x0) = pack4(pnew);
#pragma unroll
                    for (int r = 0; r < 4; ++r) Pt[pn][(x0 + r) * LJ + yy] = f2bf(pnew[r]);
                }
                LDS_BAR();
            }
            f32x4 accw[2], accu[2];
#pragma unroll
            for (int tc = 0; tc < 2; ++tc) { accw[tc] = f32x4{0.f, 0.f, 0.f, 0.f}; accu[tc] = f32x4{0.f, 0.f, 0.f, 0.f}; }
#pragma unroll
            for (int k0 = 0; k0 < 32; k0 += 4) {
                const float la = bf2f(Ah[(k0 + q) * LT + wave * 16 + l15]), lu = Xu[(wave * 16 + l15) * 33 + k0 + q];
#pragma unroll
                for (int tc = 0; tc < 2; ++tc) { const float rv = IA[(k0 + q) * 36 + tc * 16 + l15]; accw[tc] = MFMAF32(la, rv, accw[tc]); accu[tc] = MFMAF32(lu, rv, accu[tc]); }
            }
            LDS_BAR();
#pragma unroll
            for (int tc = 0; tc < 2; ++tc)
#pragma unroll
                for (int r = 0; r < 4; ++r) { const int row = wave * 16 + q * 4 + r, col = tc * 16 + l15; Wa[row * LJ + col] = f2bf(accw[tc][r]); U0[row * LJ + col] = f2bf(accu[tc][r]); }
        }
        if (threadIdx.x == 0) { const int v = pool0 + (int)pool_v; *nextw = dyn_next ? (v < NITEM ? v : -1) : it + 1; }
        LDS_BAR();
        const int itnext = *nextw;
        if (itnext >= 0) p1_fetch(itnext);
        {
            bf16_t* sPm = (bf16_t*)(smem + R_XU);
            bf16_t* sSA = (bf16_t*)(smem + R_U0 + 5120);
            bf16_t* sQT = (bf16_t*)(smem + R_AH);
            bf16_t* sY0 = sQT + 32 * 72;
            static_assert(R_XU + 64 * 72 * 2 <= R_WA && R_U0 + 5120 + 64 * 72 * 2 <= 40960 && 2 * 32 * 72 * 2 <= R_RH - R_AH, "M3 staging tiles");
            const int x0 = wave * 16 + q * 4;
            {
                f32x4 acc[4] = {f32x4{0.f, 0.f, 0.f, 0.f}, f32x4{0.f, 0.f, 0.f, 0.f}, f32x4{0.f, 0.f, 0.f, 0.f}, f32x4{0.f, 0.f, 0.f, 0.f}};
                mmT<4, 1>(acc, Wa, LJ, wave, BhT, LJ, lane);
#pragma unroll
                for (int nb = 0; nb < 4; ++nb) {
                    const int jp = nb * 16 + l15; const float g = GC[jp];
                    f32x4 v = acc[nb];
#pragma unroll
                    for (int r = 0; r < 4; ++r) v[r] = (v[r] + ((x0 + r == jp) ? 1.0f : 0.0f)) * g;
                    *(U2*)(sPm + jp * 72 + x0) = pack4(v);
                }
            }
            {
                f32x4 acc[4] = {f32x4{0.f, 0.f, 0.f, 0.f}, f32x4{0.f, 0.f, 0.f, 0.f}, f32x4{0.f, 0.f, 0.f, 0.f}, f32x4{0.f, 0.f, 0.f, 0.f}};
                mmT<4, 1>(acc, BhT, LJ, wave, U0, LJ, lane);
                mmT<4, 1>(acc, KhT, LJ, wave, VT, LJ, lane);
                const f32x4 g = *(const f32x4*)(GC + x0);
#pragma unroll
                for (int nb = 0; nb < 4; ++nb) *(U2*)(sSA + (nb * 16 + l15) * 72 + x0) = pack4(acc[nb] * g);
            }
            if (seg == 1) {
                {
                    f32x4 acc[2] = {f32x4{0.f, 0.f, 0.f, 0.f}, f32x4{0.f, 0.f, 0.f, 0.f}};
                    mmT<2, 1>(acc, Wa, LJ, wave, MbrT, LJ, lane);
#pragma unroll
                    for (int nb = 0; nb < 2; ++nb) {
                        const int t = nb * 16 + l15;
                        f32x4 v = acc[nb];
#pragma unroll
                        for (int r = 0; r < 4; ++r) v[r] += bf2f(Rh[t * LT + x0 + r]);
                        *(U2*)(sQT + t * 72 + x0) = pack4(v);
                    }
                }
                {
                    f32x4 acc[2] = {f32x4{0.f, 0.f, 0.f, 0.f}, f32x4{0.f, 0.f, 0.f, 0.f}};
                    mmT<2, 1>(acc, U0, LJ, wave, MbrT, LJ, lane);
                    mmT<2, 1>(acc, VT, LJ, wave, MkrT, LJ, lane);
#pragma unroll
                    for (int nb = 0; nb < 2; ++nb) *(U2*)(sY0 + (nb * 16 + l15) * 72 + x0) = pack4(acc[nb]);
                }
            }
            LDS_BAR();
            {
                const int rw = tid >> 3, c8 = (tid & 7) * 8;
                bf16_t* gPm = (bf16_t*)(chp + CH_PM); bf16_t* gSA = (bf16_t*)(chp + CH_SA); bf16_t* gQT = (bf16_t*)(chp + CH_QT); bf16_t* gY0 = (bf16_t*)(chp + CH_Y0);
#pragma unroll
                for (int hh = 0; hh < 2; ++hh) {
                    *(u32x4*)(gPm + (rw + 32 * hh) * 64 + c8) = *(const u32x4*)(sPm + (rw + 32 * hh) * 72 + c8);
                    *(u32x4*)(gSA + (rw + 32 * hh) * 64 + c8) = *(const u32x4*)(sSA + (rw + 32 * hh) * 72 + c8);
                }
                if (seg == 1) {
                    *(u32x4*)(gQT + rw * 64 + c8) = *(const u32x4*)(sQT + rw * 72 + c8);
                    *(u32x4*)(gY0 + rw * 64 + c8) = *(const u32x4*)(sY0 + rw * 72 + c8);
                }
            }
        }
        LDS_BAR();
        it = itnext;
    }
}

__device__ __forceinline__ U2 ldu2(const bf16_t* p) { return *(const U2*)p; }
constexpr int R2D = 6, R2LD = 72;
__device__ __forceinline__ void phaseR2(const Params& p, int bid, int nblk, char* smem) {
    unsigned char* CH = p.ws + WS_CH;
    bf16_t* PL = (bf16_t*)smem;
    bf16_t* SW = PL + 3 * 64 * R2LD;
    const int tid = opaque_tid(), lane = tid & 63, wave = tid >> 6, q = lane >> 4, l15 = lane & 15;
    const int lrow = wave * 16 + (lane >> 2), lcol = (lane & 3) * 16;
    static_assert(R2D % 6 == 0, "R2D: multiple of the LDS ring (3) and of the fragment double buffer (2)");
    for (int chain = bid; chain < NCHAIN; chain += nblk) {
        const int i = wave * 16 + l15;
        unsigned char* chbase = CH + (size_t)chain * NCK * CH_BYTES;
        f32x4 st[4];
#pragma unroll
        for (int nt = 0; nt < 4; ++nt) st[nt] = f32x4{0.f, 0.f, 0.f, 0.f};
        u32x4 pq[R2D][2]; U2 sa[R2D][4];
#define R2_LOADPQ(SLOT, STEP) do { const int cn_ = (STEP) < NCK ? (STEP) : NCK - 1; \
            const bf16_t* gp_ = (const bf16_t*)(chbase + (size_t)cn_ * CH_BYTES + CH_PM) + lrow * 64 + lcol; \
            pq[SLOT][0] = *(const u32x4*)gp_; pq[SLOT][1] = *(const u32x4*)(gp_ + 8); } while (0)
#define R2_LOADSA(SLOT, STEP) do { const int cn_ = (STEP) < NCK ? (STEP) : NCK - 1; \
            _Pragma("unroll") for (int nt = 0; nt < 4; ++nt) sa[SLOT][nt] = ldu2((const bf16_t*)(chbase + (size_t)cn_ * CH_BYTES + CH_SA) + i * 64 + nt * 16 + 4 * q); } while (0)
#define R2_STOREPL(SLOT, BUF) do { bf16_t* pl_ = PL + (BUF) * 64 * R2LD; *(u32x4*)(pl_ + lrow * R2LD + lcol) = pq[SLOT][0]; *(u32x4*)(pl_ + lrow * R2LD + lcol + 8) = pq[SLOT][1]; } while (0)
#define R2_READFR(SET, BUF) do { const bf16_t* pl_ = PL + (BUF) * 64 * R2LD; \
            _Pragma("unroll") for (int nt = 0; nt < 4; ++nt) _Pragma("unroll") for (int ks = 0; ks < 2; ++ks) { \
                const U2 lo_ = *(const U2*)(pl_ + (nt * 16 + l15) * R2LD + 32 * ks + 4 * q), hi_ = *(const U2*)(pl_ + (nt * 16 + l15) * R2LD + 32 * ks + 16 + 4 * q); \
                fr[SET][nt * 2 + ks] = u32x4{lo_.x, lo_.y, hi_.x, hi_.y}; } } while (0)
#pragma unroll
        for (int k = 0; k < R2D; ++k) { R2_LOADPQ(k, k); R2_LOADSA(k, k); }
        u32x4 fr[2][8];
        R2_STOREPL(0, 0); R2_LOADPQ(0, R2D);
        if (1 < NCK) { R2_STOREPL(1, 1); R2_LOADPQ(1, R2D + 1); }
        LDS_BAR();
        R2_READFR(0, 0);
#pragma unroll 1
        for (int c0 = 0; c0 < NCK; c0 += R2D) {
#pragma unroll
            for (int k = 0; k < R2D; ++k) {
                const int c = c0 + k;
                if (c < NCK) {
                    LDS_BAR();
                    if (c + 1 < NCK) R2_READFR((k + 1) & 1, (k + 1) % 3);
                    if (c + 2 < NCK) { R2_STOREPL((k + 2) % R2D, (k + 2) % 3); R2_LOADPQ((k + 2) % R2D, c + 2 + R2D); }
                    f32x4 ini[4];
#pragma unroll
                    for (int nt = 0; nt < 4; ++nt) ini[nt] = f32x4{bitsf(sa[k][nt].x << 16), bitsf(sa[k][nt].x & 0xFFFF0000u), bitsf(sa[k][nt].y << 16), bitsf(sa[k][nt].y & 0xFFFF0000u)};
                    R2_LOADSA(k, c + R2D);
                    bf16_t* sw = SW + wave * 16 * R2LD;
                    bf16x8 bfr[2];
#pragma unroll
                    for (int ks = 0; ks < 2; ++ks) {
                        const U2 lo = pack4(st[2 * ks]), hi = pack4(st[2 * ks + 1]);
                        bfr[ks] = __builtin_bit_cast(bf16x8, u32x4{lo.x, lo.y, hi.x, hi.y});
                        *(U2*)(sw + l15 * R2LD + (2 * ks) * 16 + 4 * q) = lo; *(U2*)(sw + l15 * R2LD + (2 * ks + 1) * 16 + 4 * q) = hi;
                    }
#pragma unroll
                    for (int nt = 0; nt < 4; ++nt) {
                        f32x4 acc = ini[nt];
#pragma unroll
                        for (int ks = 0; ks < 2; ++ks) acc = MFMA16(__builtin_bit_cast(bf16x8, fr[k & 1][nt * 2 + ks]), bfr[ks], acc);
                        st[nt] = acc;
                    }
                    {
                        wave_lds_sync();
                        const u32x4 o0 = *(const u32x4*)(sw + (lane >> 2) * R2LD + lcol), o1 = *(const u32x4*)(sw + (lane >> 2) * R2LD + lcol + 8);
                        bf16_t* gS = (bf16_t*)(chbase + (size_t)c * CH_BYTES + CH_SA) + lrow * 64 + lcol;
                        *(u32x4*)gS = o0; *(u32x4*)(gS + 8) = o1;
                    }
                }
            }
        }
#undef R2_LOADPQ
#undef R2_LOADSA
#undef R2_STOREPL
#undef R2_READFR
        LDS_BAR();
    }
}

__device__ __forceinline__ void phaseR3(const Params& p, int bid, int nblk, char* smem) {
    const bf16_t* P = WSP(bf16_t, WS_R1);
    const unsigned char* CH = p.ws + WS_CH;
    const float* RBON = WSP(float, WS_RBON);
    bf16_t* MIX = WSP(bf16_t, WS_R3);
    float* red = (float*)smem;
    const int tid = opaque_tid(), lane = tid & 63, wave = tid >> 6, q = lane >> 4, l15 = lane & 15;
    for (int m = bid * 256 + tid; m < MLAT; m += nblk * 256) {
        const float* sp = WSP(float, WS_SSQP) + m;
        float sq = 0.f;
#pragma unroll
        for (int c = 0; c < LRU_BLOCKS; ++c) sq += sp[(size_t)c * MLAT];
        WSP(float, WS_RINV)[m] = frsq(sq * (1.0f / D_LRU) + RMS_EPS);
    }
    bf16_t* G2T = (bf16_t*)(smem + 1024);
    bf16_t* OT = (bf16_t*)(smem + 32768) + (threadIdx.x >> 6) * 16 * 72;
    float* PRM = (float*)(smem + 20480);
    const int nbh = nblk / HEADS;
    const bool uniform = (nbh > 0) && (nblk % HEADS == 0);
    constexpr int NP16 = SEQ / 16, NW = BATCH * NP16;
    const int nwv = uniform ? nbh * 4 : nblk * 4;
    int hcur = -1;
    bf16x8 pyf[2], psf[8]; U2 py0[4]; float pbon = 0.f;
    auto fetch_fwd = [&](int wi_, int h_) {
        const int b_ = wi_ / NP16, p16_ = wi_ % NP16, pc_ = p16_ >> 1, tau_ = (p16_ & 1) * 16 + l15;
        const size_t item_ = (size_t)((b_ * HEADS + h_) * 2) * NCK + NCC + pc_;
        const unsigned char* chp_ = CH + item_ * CH_BYTES;
        const bf16_t* gS_ = (const bf16_t*)(chp_ + CH_SA); const bf16_t* gQT_ = (const bf16_t*)(chp_ + CH_QT); const bf16_t* gY0_ = (const bf16_t*)(chp_ + CH_Y0);
#pragma unroll
        for (int ks = 0; ks < 2; ++ks) pyf[ks] = *(const bf16x8*)(gQT_ + tau_ * 64 + ks * 32 + 8 * q);
#pragma unroll
        for (int xs = 0; xs < 4; ++xs) {
            py0[xs] = ldu2(gY0_ + tau_ * 64 + xs * 16 + 4 * q);
#pragma unroll
            for (int ks = 0; ks < 2; ++ks) psf[xs * 2 + ks] = *(const bf16x8*)(gS_ + (xs * 16 + l15) * 64 + ks * 32 + 8 * q);
        }
        pbon = RBON[item_ * RC + tau_];
    };
    if (uniform && (bid % nbh) * 4 < NW) fetch_fwd((bid % nbh) * 4 + wave, bid / nbh);
    for (int wi0 = (uniform ? (bid % nbh) : bid) * 4; wi0 < (uniform ? NW : NW * HEADS); wi0 += nwv) {
        int h; if (uniform) h = bid / nbh; else h = (wi0 / 4) % HEADS;
        if (h != hcur) {
            __syncthreads();
            {
                const u32x4* src = (const u32x4*)(WSP(bf16_t, WS_G2T) + (size_t)h * 64 * 136);
                for (int idx = tid; idx < 64 * 136 * 2 / 16; idx += 256) ((u32x4*)G2T)[idx] = src[idx];
            }
            {
                if (tid < 64) {
                    PRM[tid] = p.mu_prev[2 * D_RWKV + h * 64 + tid]; PRM[64 + tid] = p.mu_next[2 * D_RWKV + h * 64 + tid];
                    PRM[128 + tid] = p.gn_g[h * 64 + tid]; PRM[192 + tid] = p.gn_b[h * 64 + tid];
                }
            }
            hcur = h;
            __syncthreads();
        }
        const int wi = uniform ? wi0 + wave : (wi0 / 4 / HEADS) * 4 + wave;
        if (wi >= NW) continue;
        const int b = wi / NP16, p16 = wi % NP16, pc = p16 >> 1, pl = (p16 & 1) * 16 + l15, pos = pc * RC + pl;
        if (!uniform) fetch_fwd(wi, h);
        f32x4 y[4], g[4];
#pragma unroll
        for (int xs = 0; xs < 4; ++xs) { y[xs] = f32x4{0.f, 0.f, 0.f, 0.f}; g[xs] = f32x4{0.f, 0.f, 0.f, 0.f}; }
        float bon = 0.f;
#pragma unroll
        for (int d = 0; d < 2; ++d) {
            const int chain = (b * HEADS + h) * 2 + d, c = NCC + (d ? NLC - 1 - pc : pc), tau = d ? RC - 1 - pl : pl;
            const size_t item = (size_t)chain * NCK + c;
            const unsigned char* chp = CH + item * CH_BYTES;
            const bf16_t* gS = (const bf16_t*)(chp + CH_SA); const bf16_t* gQT = (const bf16_t*)(chp + CH_QT); const bf16_t* gY0 = (const bf16_t*)(chp + CH_Y0);
            bf16x8 yf[2];
#pragma unroll
            for (int ks = 0; ks < 2; ++ks) yf[ks] = (d == 0) ? pyf[ks] : *(const bf16x8*)(gQT + tau * 64 + ks * 32 + 8 * q);
#pragma unroll
            for (int xs = 0; xs < 4; ++xs) {
                const U2 y0u = (d == 0) ? py0[xs] : ldu2(gY0 + tau * 64 + xs * 16 + 4 * q);
                f32x4 acc = f32x4{bitsf(y0u.x << 16), bitsf(y0u.x & 0xFFFF0000u), bitsf(y0u.y << 16), bitsf(y0u.y & 0xFFFF0000u)};
#pragma unroll
                for (int ks = 0; ks < 2; ++ks) acc = MFMA16((d == 0) ? psf[xs * 2 + ks] : *(const bf16x8*)(gS + (xs * 16 + l15) * 64 + ks * 32 + 8 * q), yf[ks], acc);
                y[xs] += acc;
            }
            bon += (d == 0) ? pbon : RBON[item * RC + tau];
        }
        if (uniform && wi0 + nwv < NW) fetch_fwd(wi0 + nwv + wave, h);
        const size_t mrow = rwkv_row(1, b, pos);
        const size_t mprev = pos > 0 ? rwkv_row(1, b, pos - 1) : mrow, mnext = pos < SEQ - 1 ? rwkv_row(1, b, pos + 1) : mrow;
        U2 zc[4], zpv[4], znv[4];
#pragma unroll
        for (int xs = 0; xs < 4; ++xs) {
            const int i0 = xs * 16 + q * 4, chv = 2 * D_RWKV + h * 64 + i0;
            zc[xs] = ldu2(P + mrow * D_IN + RW0 + chv); zpv[xs] = ldu2(P + mprev * D_IN + RW0 + chv); znv[xs] = ldu2(P + mnext * D_IN + RW0 + chv);
        }
#pragma unroll
        for (int ks = 0; ks < 4; ++ks) {
            const bf16x8 sg = *(const bf16x8*)(WSP(bf16_t, WS_SG) + ((size_t)b * SEQ + pos) * 128 + ks * 32 + 8 * q);
#pragma unroll
            for (int xs = 0; xs < 4; ++xs) g[xs] = MFMA16(*(const bf16x8*)(G2T + (xs * 16 + l15) * 136 + ks * 32 + 8 * q), sg, g[xs]);
        }
        f32x4 pgg[4], pgb[4], pmp[4], pmn[4], vz[4];
#pragma unroll
        for (int xs = 0; xs < 4; ++xs) { const int i0 = xs * 16 + q * 4; pmp[xs] = *(const f32x4*)(PRM + i0); pmn[xs] = *(const f32x4*)(PRM + 64 + i0); pgg[xs] = *(const f32x4*)(PRM + 128 + i0); pgb[xs] = *(const f32x4*)(PRM + 192 + i0); }
#pragma unroll
        for (int xs = 0; xs < 4; ++xs) {
            const f32x4 z = f32x4{bitsf(zc[xs].x << 16), bitsf(zc[xs].x & 0xFFFF0000u), bitsf(zc[xs].y << 16), bitsf(zc[xs].y & 0xFFFF0000u)};
            f32x4 zp = f32x4{bitsf(zpv[xs].x << 16), bitsf(zpv[xs].x & 0xFFFF0000u), bitsf(zpv[xs].y << 16), bitsf(zpv[xs].y & 0xFFFF0000u)};
            f32x4 zn = f32x4{bitsf(znv[xs].x << 16), bitsf(znv[xs].x & 0xFFFF0000u), bitsf(znv[xs].y << 16), bitsf(znv[xs].y & 0xFFFF0000u)};
            if (pos == 0) zp = f32x4{0.f, 0.f, 0.f, 0.f};
            if (pos == SEQ - 1) zn = f32x4{0.f, 0.f, 0.f, 0.f};
            vz[xs] = z + pmp[xs] * (zp - z) + pmn[xs] * (zn - z);
        }
        float s1 = 0.f, s2 = 0.f;
#pragma unroll
        for (int xs = 0; xs < 4; ++xs) { s1 += hsum4(y[xs]); s2 += hsum4(y[xs] * y[xs]); }
        s1 += __shfl_xor(s1, 16); s1 += __shfl_xor(s1, 32); s2 += __shfl_xor(s2, 16); s2 += __shfl_xor(s2, 32);
        const float mu = s1 * (1.0f / 64.0f), var = fmaxf(s2 * (1.0f / 64.0f) - mu * mu, 0.f), rstd = frsq(var + GN_EPS);
#pragma unroll
        for (int xs = 0; xs < 4; ++xs) {
            const int i0 = xs * 16 + q * 4;
            const f32x4 v = vz[xs];
            const f32x4 yn = (y[xs] - mu) * rstd * pgg[xs] + pgb[xs];
            *(U2*)(OT + l15 * 72 + i0) = pack4((yn + bon * v) * g[xs]);
        }
        {
            wave_lds_sync();
#pragma unroll
            for (int hh = 0; hh < 2; ++hh) {
                const int rr = hh * 8 + (lane >> 3), c8 = (lane & 7) * 8;
                const size_t orow = rwkv_row(1, b, pc * RC + (p16 & 1) * 16 + rr);
                *(u32x4*)(MIX + orow * D_MIX + D_LRU + h * 64 + c8) = *(const u32x4*)(OT + rr * 72 + c8);
            }
            wave_lds_sync();
        }
    }
}

__device__ __forceinline__ void phaseJ(const Params& p, int bid, int nblk, char* smem) {
    const bf16_t* MIX = WSP(bf16_t, WS_R3); const bf16_t* WB = WSP(bf16_t, WS_WBOUT);
    bf16_t* YOUT = WSP(bf16_t, WS_R1);
    const float* RINV = WSP(float, WS_RINV);
    constexpr int BM = 32 * MI_J, NTN = D_MODEL / 128, NTM = MLAT / BM;
    constexpr int GM = (NTM % 8 == 0) ? 8 : 1;
    for (int it = xcd_vbid(bid, nblk); it < NTN * NTM; it += nblk) {
        const int mg = it / (GM * NTN), r = it % (GM * NTN), nt = r / GM, mt = mg * GM + (r % GM);
        gemm_tile<MI_J, false>(smem, MIX, D_MIX, nullptr, mt * BM, WB, nullptr, D_MIX, nt * 128, D_MIX, [&](int ml, int nl, f32x4 v, f32x4) { return pack4(v); },
            [&](int ml) { return YOUT + (size_t)(mt * BM + ml) * D_MODEL + nt * 128; }, RINV, D_LRU / 64);
    }
}

constexpr int KUL = D_MODEL + 2;
static_assert((16 * KUL + 4 * 256) * 4 <= SMEM_BYTES && N_EXPERTS <= 16 && MLAT % 16 == 0, "phase K lds");
__device__ __forceinline__ void phaseK(const Params& p, int bid, int nblk, char* smem) {
    const int tid = opaque_tid(), lane = tid & 63, wave = tid >> 6, q = lane >> 4, l15 = lane & 15;
    const float* MOD = WSP(float, WS_MOD); const float* STATS = WSP(float, WS_STATS);
    const bf16_t* YOUT = WSP(bf16_t, WS_R1);
    bf16_t* H1 = WSP(bf16_t, WS_R5); bf16_t* U2b = WSP(bf16_t, WS_R6); float* AFF = WSP(float, WS_AFF);
    float* UL = (float*)smem;
    float* PL = UL + 16 * KUL;
    for (int rb = bid; rb < MLAT / 16; rb += nblk) {
        LDS_BAR();
        const float* md = MOD + (size_t)((rb * 16) / SEQ) * 6 * D_MODEL;
        f32x4 pg0[NV], pb0[NV], pg1[NV], pb1[NV], mgt[NV], msc[NV], msh[NV];
#pragma unroll
        for (int j = 0; j < NV; ++j) { const int k = j * 256 + lane * 4;
            pg0[j] = ld4(p.ln_in_g + k); pb0[j] = ld4(p.ln_in_b + k); pg1[j] = ld4(p.ln1_g + k); pb1[j] = ld4(p.ln1_b + k);
            mgt[j] = ld4(md + 2 * D_MODEL + k); msc[j] = ld4(md + 4 * D_MODEL + k); msh[j] = ld4(md + 3 * D_MODEL + k); }
#pragma unroll 2
        for (int rr = 0; rr < 4; ++rr) {
            const int lr = wave * 4 + rr, row = rb * 16 + lr;
            const float* xr = p.x + (size_t)row * D_MODEL;
            const float mu0 = STATS[row * 2], rs0 = STATS[row * 2 + 1];
            f32x4 v0, v1, v2, v3; float s = 0.f;
#define PK_LOAD(V, J) { const int k = (J) * 256 + lane * 4; \
            V = ALPHA_F * ((ld4(xr + k) - mu0) * rs0 * pg0[J] + pb0[J]) + mgt[J] * ldb4(YOUT + (size_t)row * D_MODEL + k); s += hsum4(V); }
            PK_LOAD(v0, 0)
            if (NV > 1) PK_LOAD(v1, 1) else v1 = f32x4{0.f, 0.f, 0.f, 0.f};
            if (NV > 2) { PK_LOAD(v2, 2) PK_LOAD(v3, 3) } else { v2 = v1; v3 = v1; }
#undef PK_LOAD
            const float mu = wave_sum(s) * (1.0f / D_MODEL);
            v0 -= mu; float s2 = hsum4(v0 * v0);
            if (NV > 1) { v1 -= mu; s2 += hsum4(v1 * v1); }
            if (NV > 2) { v2 -= mu; v3 -= mu; s2 += hsum4(v2 * v2) + hsum4(v3 * v3); }
            const float rstd = frsq(wave_sum(s2) * (1.0f / D_MODEL) + LN_EPS);
#pragma unroll
            for (int j = 0; j < NV; ++j) {
                const int k = j * 256 + lane * 4;
                const f32x4 vv = (j == 0) ? v0 : (j == 1) ? v1 : (j == 2) ? v2 : v3;
                const f32x4 h = vv * rstd * pg1[j] + pb1[j];
                *(U2*)(H1 + (size_t)row * D_MODEL + k) = pack4(h);
                const f32x4 u = h * (1.0f + msc[j]) + msh[j];
                *(U2*)(U2b + (size_t)row * D_MODEL + k) = pack4(u);
                float* ul = UL + lr * KUL + k;
                *(f32x2_e*)ul = f32x2_e{u[0], u[1]}; *(f32x2_e*)(ul + 2) = f32x2_e{u[2], u[3]};
            }
        }
        LDS_BAR();
        {
            f32x4 acc = f32x4{0.f, 0.f, 0.f, 0.f};
            const int kq0 = wave * (D_MODEL / 4);
#pragma unroll 8
            for (int s4 = 0; s4 < D_MODEL / 16; ++s4) {
                const int k = kq0 + s4 * 4 + q;
                const float av = UL[l15 * KUL + k];
                const float bv = (l15 < N_EXPERTS) ? p.w_router[(size_t)k * N_EXPERTS + l15] : 0.f;
                acc = MFMAF32(av, bv, acc);
            }
#pragma unroll
            for (int r = 0; r < 4; ++r) PL[wave * 256 + (q * 4 + r) * 16 + l15] = acc[r];
        }
        LDS_BAR();
        {
            const int lr = tid >> 4, e = tid & 15;
            const bool valid = e < N_EXPERTS;
            float lg = PL[tid] + PL[256 + tid] + PL[512 + tid] + PL[768 + tid];
            float mx = valid ? lg : -3.0e38f;
#pragma unroll
            for (int o = 1; o < 16; o <<= 1) mx = fmaxf(mx, __shfl_xor(mx, o));
            const float ex = valid ? expf(lg - mx) : 0.f;
            float den = ex;
#pragma unroll
            for (int o = 1; o < 16; o <<= 1) den += __shfl_xor(den, o);
            if (valid) AFF[(size_t)(rb * 16 + lr) * N_EXPERTS + e] = ex / den;
        }
    }
}

__device__ __forceinline__ int block_sum_int(int v, int* red) {
    const int tid_ = opaque_tid(), lane = tid_ & 63, wave = tid_ >> 6;
#pragma unroll
    for (int o = 1; o < 64; o <<= 1) v += __shfl_xor(v, o);
    __syncthreads();
    if (lane == 0) red[wave] = v;
    __syncthreads();
    return red[0] + red[1] + red[2] + red[3];
}
__device__ __forceinline__ void phaseL(const Params& p, int bid, int nblk, char* smem) {
    const float* AFF = WSP(float, WS_AFF);
    int* IDX = WSP(int, WS_IDX); float* GATE = WSP(float, WS_GATE); int* SLOTOF = WSP(int, WS_SLOT);
    unsigned* vals = (unsigned*)smem;
    int* red = (int*)(vals + SEQ);
    int* wsum = red + 8;
    const int tid = opaque_tid(), lane = tid & 63, wave = tid >> 6;
    constexpr int PER = SEQ / 256;
    {
        constexpr int NL = BATCH * N_EXPERTS;
        const bool spare = nblk > NL + 32;
        if (spare ? (bid >= NL) : true) convert_experts(p, spare ? bid - NL : bid, spare ? nblk - NL : nblk, smem, 0, 2);
        if (spare && bid >= NL) return;
        __syncthreads();
    }
    for (int be = bid; be < BATCH * N_EXPERTS; be += nblk) {
        const int b = be / N_EXPERTS, e = be % N_EXPERTS;
        __syncthreads();
        for (int t = tid; t < SEQ; t += 256) vals[t] = fbits(AFF[((size_t)b * SEQ + t) * N_EXPERTS + e]);
        __syncthreads();
        unsigned lo = 0u, hi = 0x7F800000u;
        while (lo < hi) {
            const unsigned mid = lo + (hi - lo + 1u) / 2u;
            int c = 0;
            for (int t = tid; t < SEQ; t += 256) c += (vals[t] >= mid) ? 1 : 0;
            c = block_sum_int(c, red);
            if (c >= CAP) lo = mid; else hi = mid - 1u;
        }
        const unsigned T = lo;
        int cg = 0, ce = 0;
        for (int q = 0; q < PER; ++q) { const unsigned v = vals[tid * PER + q]; cg += (v > T) ? 1 : 0; ce += (v == T) ? 1 : 0; }
        int pg = cg, pe = ce;
#pragma unroll
        for (int o = 1; o < 64; o <<= 1) { const int a = __shfl_up(pg, o), bb = __shfl_up(pe, o); if (lane >= o) { pg += a; pe += bb; } }
        __syncthreads();
        if (lane == 63) { wsum[wave] = pg; wsum[4 + wave] = pe; }
        __syncthreads();
        int og = 0, oe = 0, totg = 0;
        for (int w = 0; w < 4; ++w) { if (w < wave) { og += wsum[w]; oe += wsum[4 + w]; } totg += wsum[w]; }
        int posg = og + pg - cg, pose = oe + pe - ce;
        const int need_eq = CAP - totg;
        for (int q = 0; q < PER; ++q) {
            const int t = tid * PER + q; const unsigned v = vals[t];
            int slot = -1;
            if (v > T) { slot = posg++; }
            else if (v == T) { if (pose < need_eq) slot = totg + pose; pose++; }
            if (slot >= 0) { IDX[(size_t)be * CAP + slot] = b * SEQ + t; GATE[(size_t)be * CAP + slot] = bitsf(v); }
            SLOTOF[((size_t)b * SEQ + t) * N_EXPERTS + e] = slot;
        }
    }
}

__device__ __forceinline__ void phaseM(const Params& p, int bid, int nblk, char* smem) {
    const bf16_t* U2b = WSP(bf16_t, WS_R6); const int* IDX = WSP(int, WS_IDX);
    bf16_t* HID = WSP(bf16_t, WS_R1);
    constexpr int BM = 32 * MI_E, NTN = D_EXPERT / 64, NTM = CAP / BM;
    constexpr int NTT = BATCH * N_EXPERTS * NTM * NTN;
    int ridx[MI_E], nidx[MI_E];
    const int r0g = threadIdx.x >> 3;
    auto gather = [&](int it_, int (&dst)[MI_E]) {
        const int mt_ = it_ % NTM, b_ = (it_ / NTM) % BATCH, e_ = it_ / (NTM * BATCH * NTN), be_ = b_ * N_EXPERTS + e_;
#pragma unroll
        for (int j = 0; j < MI_E; ++j) dst[j] = IDX[(size_t)be_ * CAP + mt_ * BM + r0g + 32 * j];
    };
    const int it0 = xcd_vbid(bid, nblk);
    if (it0 < NTT) gather(it0, ridx);
    for (int it = it0; it < NTT; it += nblk) {
        const int mt = it % NTM, b = (it / NTM) % BATCH, nt = (it / (NTM * BATCH)) % NTN, e = it / (NTM * BATCH * NTN), be = b * N_EXPERTS + e;
        const bf16_t* wg = WSP(bf16_t, WS_WG + (size_t)e * WEXP_BYTES); const bf16_t* wu = WSP(bf16_t, WS_WU + (size_t)e * WEXP_BYTES);
        if (it + nblk < NTT) gather(it + nblk, nidx);
        gemm_tile<MI_E, true>(smem, U2b, D_MODEL, IDX + (size_t)be * CAP, mt * BM, wg, wu, D_MODEL, nt * 64, D_MODEL, [&](int ml, int nl, f32x4 g, f32x4 u) {
            U2 o; o.x = pk2(siluf_(g[0]) * u[0], siluf_(g[1]) * u[1]); o.y = pk2(siluf_(g[2]) * u[2], siluf_(g[3]) * u[3]);
            return o;
        }, [&](int ml) { return HID + ((size_t)be * CAP + mt * BM + ml) * D_EXPERT + nt * 64; }, nullptr, 0, ridx);
#pragma unroll
        for (int j = 0; j < MI_E; ++j) ridx[j] = nidx[j];
    }
    {
        constexpr int NT = BATCH * N_EXPERTS * NTM * NTN;
        const int rem = NT % nblk, vb = xcd_vbid(bid, nblk);
        if (rem == 0 || nblk - rem < 32) convert_experts(p, vb, nblk, smem, 2, 3);
        else if (vb >= rem) convert_experts(p, vb - rem, nblk - rem, smem, 2, 3);
    }
}
__device__ __forceinline__ void phaseN(const Params& p, int bid, int nblk, char* smem) {
    const bf16_t* HID = WSP(bf16_t, WS_R1); const float* GATE = WSP(float, WS_GATE);
    bf16_t* YS = WSP(bf16_t, WS_R2);
    constexpr int BM = 32 * MI_E, NTN = D_MODEL / 128, NTM = CAP / BM;
    for (int it = xcd_vbid(bid, nblk); it < BATCH * N_EXPERTS * NTM * NTN; it += nblk) {
        const int mt = it % NTM, b = (it / NTM) % BATCH, nt = (it / (NTM * BATCH)) % NTN, e = it / (NTM * BATCH * NTN), be = b * N_EXPERTS + e;
        const bf16_t* wd = WSP(bf16_t, wdown_off(e));
        gemm_tile<MI_E, false>(smem, HID + (size_t)be * CAP * D_EXPERT, D_EXPERT, nullptr, mt * BM, wd, nullptr, D_EXPERT, nt * 128, D_EXPERT, [&](int ml, int nl, f32x4 v, f32x4) {
            const float gt = GATE[(size_t)be * CAP + mt * BM + ml];
            return pack4(v * gt);
        }, [&](int ml) { return YS + ((size_t)be * CAP + mt * BM + ml) * D_MODEL + nt * 128; });
    }
}
__device__ __forceinline__ void phaseO(const Params& p, int bid, int nblk, char* smem) {
    const int tid_ = opaque_tid(), lane = tid_ & 63, wave = tid_ >> 6;
    const float* MOD = WSP(float, WS_MOD); const bf16_t* H1 = WSP(bf16_t, WS_R5); const bf16_t* YS = WSP(bf16_t, WS_R2); const int* SLOTOF = WSP(int, WS_SLOT);
    int row = bid * 4 + wave;
    f32x4 l2g[NV], l2b[NV];
#pragma unroll
    for (int j = 0; j < NV; ++j) { l2g[j] = ld4(p.ln2_g + j * 256 + lane * 4); l2b[j] = ld4(p.ln2_b + j * 256 + lane * 4); }
    f32x4 n0 = f32x4{0.f, 0.f, 0.f, 0.f}, n1 = n0, n2 = n0, n3 = n0; int nslot = -1;
    if (row < MLAT) { const bf16_t* hr = H1 + (size_t)row * D_MODEL; n0 = ldb4(hr + lane * 4); if (NV > 1) n1 = ldb4(hr + 256 + lane * 4); if (NV > 2) { n2 = ldb4(hr + 512 + lane * 4); n3 = ldb4(hr + 768 + lane * 4); }
                      nslot = (lane < N_EXPERTS) ? SLOTOF[(size_t)row * N_EXPERTS + lane] : -1; }
    for (; row < MLAT; row += nblk * 4) {
        const float* md = MOD + (size_t)(row / SEQ) * 6 * D_MODEL;
        const f32x4 h0 = n0, h1 = n1, h2 = n2, h3 = n3; const int myslot = nslot;
        const int nrow = row + nblk * 4;
        if (nrow < MLAT) { const bf16_t* hr = H1 + (size_t)nrow * D_MODEL; n0 = ldb4(hr + lane * 4); if (NV > 1) n1 = ldb4(hr + 256 + lane * 4); if (NV > 2) { n2 = ldb4(hr + 512 + lane * 4); n3 = ldb4(hr + 768 + lane * 4); }
                           nslot = (lane < N_EXPERTS) ? SLOTOF[(size_t)nrow * N_EXPERTS + lane] : -1; }
        f32x4 y0 = f32x4{0.f, 0.f, 0.f, 0.f}, y1 = y0, y2 = y0, y3 = y0;
        const int bbase = (row / SEQ) * N_EXPERTS;
        for (int e = 0; e < N_EXPERTS; ++e) {
            const int sl = __shfl(myslot, e);
            if (sl >= 0) {
                const bf16_t* yr = YS + ((size_t)(bbase + e) * CAP + sl) * D_MODEL + lane * 4;
                y0 += ldb4(yr);
                if (NV > 1) y1 += ldb4(yr + 256);
                if (NV > 2) { y2 += ldb4(yr + 512); y3 += ldb4(yr + 768); }
            }
        }
        f32x4 v0, v1, v2, v3; float s = 0.f;
        v0 = ALPHA_F * h0 + ld4(md + 5 * D_MODEL + lane * 4) * y0; s += hsum4(v0);
        if (NV > 1) { v1 = ALPHA_F * h1 + ld4(md + 5 * D_MODEL + 256 + lane * 4) * y1; s += hsum4(v1); } else v1 = f32x4{0.f, 0.f, 0.f, 0.f};
        if (NV > 2) { v2 = ALPHA_F * h2 + ld4(md + 5 * D_MODEL + 512 + lane * 4) * y2; v3 = ALPHA_F * h3 + ld4(md + 5 * D_MODEL + 768 + lane * 4) * y3; s += hsum4(v2) + hsum4(v3); } else { v2 = v1; v3 = v1; }
        const float mu = wave_sum(s) * (1.0f / D_MODEL);
        v0 -= mu; float s2 = hsum4(v0 * v0);
        if (NV > 1) { v1 -= mu; s2 += hsum4(v1 * v1); }
        if (NV > 2) { v2 -= mu; v3 -= mu; s2 += hsum4(v2 * v2) + hsum4(v3 * v3); }
        const float rstd = frsq(wave_sum(s2) * (1.0f / D_MODEL) + LN_EPS);
#pragma unroll
        for (int j = 0; j < NV; ++j) {
            const int k = j * 256 + lane * 4;
            const f32x4 vv = (j == 0) ? v0 : (j == 1) ? v1 : (j == 2) ? v2 : v3;
            *(f32x4*)(p.out + (size_t)row * D_MODEL + k) = vv * rstd * l2g[j] + l2b[j];
        }
    }
}

#define XB_TMO      128
#define XB_XCNT(j)  (256  + 64 * (j))
#define XB_XSUB(j)  (1280 + 64 * (j))
#define XB_XGEN(j)  (2304 + 64 * (j))
#define XB_TOP      3328
#define XB_TOPGEN   3392
#define XCD_BAR_WORDS 3456
#define XB_SPIN_CAP (1u << 22)
#ifndef HOST_EMU
__device__ __forceinline__ unsigned xb_ld(unsigned* p) { return __hip_atomic_load(p, __ATOMIC_RELAXED, __HIP_MEMORY_SCOPE_AGENT); }
__device__ __forceinline__ unsigned xb_add(unsigned* p, unsigned v) { return __hip_atomic_fetch_add(p, v, __ATOMIC_RELAXED, __HIP_MEMORY_SCOPE_AGENT); }
__device__ __forceinline__ unsigned xb_xcc_id() { return (unsigned)__builtin_amdgcn_s_getreg((3 << 11) | 20) & 0xFu; }
#define XB_SPIN(cond, bar) do { unsigned _sp = 0; while (cond) { __builtin_amdgcn_s_sleep(1); \
    if ((++_sp & 255u) == 0u) { if (xb_ld(&(bar)[XB_TMO])) break; if (_sp > XB_SPIN_CAP) { atomicAdd(&(bar)[XB_TMO], 1u); break; } } } } while (0)
#define XB_LAS __attribute__((address_space(3)))
struct XcdBarrier { unsigned off; unsigned x; volatile XB_LAS unsigned* st; unsigned G; };
__device__ __forceinline__ XcdBarrier xcd_barrier_post(unsigned* ctrl, unsigned off, volatile XB_LAS unsigned* st, unsigned G, bool member = true) {
    XcdBarrier b; b.off = off; b.x = xb_xcc_id(); b.st = st; b.G = G; unsigned* bar = ctrl + off;
    if (!member) return b;
    if (threadIdx.x == 0) (void)xb_add(&bar[XB_XCNT(b.x)], 1u);
    return b;
}
__device__ __forceinline__ void xcd_barrier_complete(unsigned* bar, unsigned x, unsigned& nloc, unsigned& nx, unsigned G) {
    unsigned sum, cnt, mine, sp = 0u;
    for (;;) {
        sum = 0u; cnt = 0u; mine = 0u;
#pragma unroll
        for (unsigned j = 0; j < 16; ++j) { const unsigned c = xb_ld(&bar[XB_XCNT(j)]); sum += c; cnt += (c > 0u) ? 1u : 0u; mine = (j == x) ? c : mine; }
        if (sum == G) break;
        __builtin_amdgcn_s_sleep(1);
        if ((++sp & 255u) == 0u) { if (xb_ld(&bar[XB_TMO])) break; if (sp > XB_SPIN_CAP) { atomicAdd(&bar[XB_TMO], 1u); break; } }
    }
    nloc = mine > 0u ? mine : 1u; nx = cnt > 0u ? cnt : 1u;
}
__device__ __forceinline__ void grid_barrier(const XcdBarrier& b, unsigned* ctrl) {
    asm volatile("s_waitcnt vmcnt(0)" ::: "memory");
    __syncthreads();
    if (threadIdx.x == 0) {
        unsigned* bar = ctrl + b.off;
        __builtin_amdgcn_s_waitcnt(0);
        volatile XB_LAS unsigned* st = b.st;
        unsigned nloc = st[0], nx = st[1];
        if (nloc == 0u) { xcd_barrier_complete(bar, b.x, nloc, nx, b.G); st[0] = nloc; st[1] = nx; }
        const unsigned old = xb_add(&bar[XB_XSUB(b.x)], 1u);
        const unsigned gen = old / nloc;
        if (old + 1u == (gen + 1u) * nloc) {
            __builtin_amdgcn_fence(__ATOMIC_RELEASE, "agent");
            asm volatile("s_waitcnt vmcnt(0)" ::: "memory");
            const unsigned og = xb_add(&bar[XB_TOP], 1u);
            const unsigned tg = og / nx;
            if (og + 1u == (tg + 1u) * nx) xb_add(&bar[XB_TOPGEN], 1u);
            else XB_SPIN(xb_ld(&bar[XB_TOPGEN]) == tg, bar);
            __builtin_amdgcn_fence(__ATOMIC_ACQUIRE, "agent");
            xb_add(&bar[XB_XGEN(b.x)], 1u);
            asm volatile("s_waitcnt vmcnt(0)" ::: "memory");
        } else {
            XB_SPIN(xb_ld(&bar[XB_XGEN(b.x)]) == gen, bar);
            __builtin_amdgcn_fence(__ATOMIC_ACQUIRE, "agent");
            asm volatile("s_waitcnt vmcnt(0)" ::: "memory");
        }
    }
    __syncthreads();
}
#else
struct XcdBarrier { int dummy; };
__device__ __forceinline__ void grid_barrier(const XcdBarrier&, unsigned*) { __syncthreads(); }
#endif

__global__ void __launch_bounds__(256, 2) fused_forward(Params p) {
    __shared__ __attribute__((aligned(16))) char smem[SMEM_BYTES];
    __shared__ __attribute__((aligned(16))) unsigned xb_words[4];
    if (threadIdx.x == 0) { xb_words[0] = 0u; xb_words[1] = 0u; xb_words[2] = 0u; xb_words[3] = 0u; }
    __syncthreads();
    const int bid = blockIdx.x, nblk = gridDim.x;
    const bool split = nblk >= 2 * NCHAIN;
#ifdef HOST_EMU
    const XcdBarrier gb{0}; const XcdBarrier gs{0};
#else
    const XcdBarrier gb = xcd_barrier_post(WSP(unsigned, WS_CTRL), 0u, (volatile XB_LAS unsigned*)xb_words, (unsigned)nblk);
    const XcdBarrier gs = xcd_barrier_post(WSP(unsigned, WS_CTRL), (unsigned)XCD_BAR_WORDS, (volatile XB_LAS unsigned*)xb_words + 2, (unsigned)(nblk - NCHAIN), split && bid >= NCHAIN);
#endif
    phaseA(p, bid, nblk, smem); grid_barrier(gb, WSP(unsigned, WS_CTRL));
    phaseB(p, bid, nblk, smem); grid_barrier(gb, WSP(unsigned, WS_CTRL));
    phaseC(p, bid, nblk, smem); grid_barrier(gb, WSP(unsigned, WS_CTRL));
    phaseR1(p, bid, nblk, smem); grid_barrier(gb, WSP(unsigned, WS_CTRL));
    {
        const int lb = split ? bid - NCHAIN : bid, ln = split ? nblk - NCHAIN : nblk;
        const bool lru_member = !split || bid >= NCHAIN;
        if (!split || bid < NCHAIN) phaseR2(p, bid, split ? NCHAIN : nblk, smem);
        if (lru_member) phaseD(p, lb, ln, smem);
        if (split) { if (lru_member) grid_barrier(gs, WSP(unsigned, WS_CTRL)); } else grid_barrier(gb, WSP(unsigned, WS_CTRL));
        if (lru_member) phaseE(p, lb, ln, smem);
        {
            const int neb = BATCH * 2 * (D_LRU / 64);
            if (lru_member) { if (ln > 2 * neb) { if (lb >= neb) phaseG(p, lb - neb, ln - neb, smem); } else phaseG(p, lb, ln, smem); }
        }
        if (split) { if (lru_member) grid_barrier(gs, WSP(unsigned, WS_CTRL)); } else grid_barrier(gb, WSP(unsigned, WS_CTRL));
        if (lru_member) phaseF(p, lb, ln, smem);
        grid_barrier(gb, WSP(unsigned, WS_CTRL));
    }
    phaseR3(p, bid, nblk, smem); grid_barrier(gb, WSP(unsigned, WS_CTRL));
    phaseJ(p, bid, nblk, smem); grid_barrier(gb, WSP(unsigned, WS_CTRL));
    phaseK(p, bid, nblk, smem); grid_barrier(gb, WSP(unsigned, WS_CTRL));
    phaseL(p, bid, nblk, smem); grid_barrier(gb, WSP(unsigned, WS_CTRL));
    phaseM(p, bid, nblk, smem); grid_barrier(gb, WSP(unsigned, WS_CTRL));
    phaseN(p, bid, nblk, smem); grid_barrier(gb, WSP(unsigned, WS_CTRL));
    phaseO(p, bid, nblk, smem);
}

#ifdef MULTI_LAUNCH
#define PHASE_KERNEL(NAME) \
    __global__ void __launch_bounds__(256) k_##NAME(Params p) { __shared__ __attribute__((aligned(16))) char smem[SMEM_BYTES]; NAME(p, blockIdx.x, gridDim.x, smem); }
PHASE_KERNEL(phaseA) PHASE_KERNEL(phaseB) PHASE_KERNEL(phaseC) PHASE_KERNEL(phaseD) PHASE_KERNEL(phaseE) PHASE_KERNEL(phaseG) PHASE_KERNEL(phaseF) PHASE_KERNEL(phaseR1) PHASE_KERNEL(phaseR2) PHASE_KERNEL(phaseR3)
PHASE_KERNEL(phaseJ) PHASE_KERNEL(phaseK) PHASE_KERNEL(phaseL) PHASE_KERNEL(phaseM) PHASE_KERNEL(phaseN) PHASE_KERNEL(phaseO)
#ifdef HOST_EMU
void emu_hook(const char* name, const Params& p);
#define LAUNCH(NAME, grid) do { EMU_LAUNCH(k_##NAME, grid, 256, p); emu_hook(#NAME, p); } while (0)
#else
#define LAUNCH(NAME, grid) hipLaunchKernelGGL(k_##NAME, dim3(grid), dim3(256), 0, stream, p)
#endif
#endif

extern "C" void kernel_launch(void* const* d_in, const int* in_sizes, int n_in, void* d_out, int out_size, void* d_ws, size_t ws_size, hipStream_t stream) {
    if (n_in != 38 || out_size != MLAT * D_MODEL || ws_size < WS_END) { fprintf(stderr, "kernel_launch: unexpected shapes (n_in %d out %d ws %zu need %zu)\n", n_in, out_size, ws_size, (size_t)WS_END); return; }
    Params p{};
    const float** f = (const float**)&p;
    for (int i = 0; i < 38; ++i) f[i] = (const float*)d_in[i];
    p.out = (float*)d_out; p.ws = (unsigned char*)d_ws;
    (void)hipMemsetAsync((char*)d_ws + WS_CTRL, 0, CTRL_ZERO_BYTES, stream);
#ifdef MULTI_LAUNCH
    const int G = 512;
    LAUNCH(phaseA, 6 * D_MODEL / 16);
    LAUNCH(phaseB, G);
    LAUNCH(phaseC, G);
    LAUNCH(phaseD, G);
    LAUNCH(phaseE, 16);
    LAUNCH(phaseG, G);
    LAUNCH(phaseF, G);
    LAUNCH(phaseR1, G);
    LAUNCH(phaseR2, NCHAIN);
    LAUNCH(phaseR3, G);
    LAUNCH(phaseJ, G);
    LAUNCH(phaseK, G);
    LAUNCH(phaseL, BATCH * N_EXPERTS);
    LAUNCH(phaseM, G);
    LAUNCH(phaseN, G);
    LAUNCH(phaseO, G);
#elif defined(HOST_EMU)
    EMU_LAUNCH(fused_forward, 1, 256, p);
#else
    static int grid_blocks = 0;
    if (!grid_blocks) {
        int dev = 0, cus = 0, per_cu = 0;
        (void)hipGetDevice(&dev);
        (void)hipDeviceGetAttribute(&cus, hipDeviceAttributeMultiprocessorCount, dev);
        (void)hipOccupancyMaxActiveBlocksPerMultiprocessor(&per_cu, fused_forward, 256, 0);
        if (per_cu > 2) per_cu = 2;
        if (per_cu < 1) { fprintf(stderr, "kernel_launch: occupancy query returned %d blocks per CU\n", per_cu); per_cu = 1; }
        grid_blocks = cus * per_cu;
    }
    void* args[] = {&p};
    hipError_t e = hipLaunchCooperativeKernel((void*)fused_forward, dim3(grid_blocks), dim3(256), args, 0, stream);
    if (e != hipSuccess) fprintf(stderr, "cooperative launch failed: %s (grid %d)\n", hipGetErrorString(e), grid_blocks);
#endif
}
```
